# Optimizing an MI355X kernel written in HIP

```python
import math
import jax, jax.numpy as jnp
from jax import lax
import numpy as np

D_MODEL = 2048
BATCH = 1
SEQ = 16384
DEPTH = 1
DEC_BATCH = 4
DEC_SEQ = 8192
PAST_LEN = 128

A_HEADS = 8
A_HEAD_DIM = 64
A_VDIM = 2 * A_HEAD_DIM
A_WIDTH = A_HEADS * A_VDIM
A_QK_COLS = A_HEADS * 2 * A_HEAD_DIM
ROPE_THETA = 10000.0
Q_BLOCK = 128
R_HEAD = 64
R_WIDTH = 1024
R_HEADS = R_WIDTH // R_HEAD
DECAY_RANK = 64
AAA_RANK = 64
GATE_RANK = 160
R_COLS = 3 * R_WIDTH + 2 * DECAY_RANK + 2 * AAA_RANK + GATE_RANK
LNX_EPS = 64e-5
N_MEM = 256
M_HEADS = 4
M_HEAD_DIM = 256
M_WIDTH = M_HEADS * M_HEAD_DIM
N_BRANCH = 3
IN_OFFSETS = (A_QK_COLS, 2 * A_QK_COLS, 2 * A_QK_COLS + A_WIDTH,
              2 * A_QK_COLS + A_WIDTH + R_COLS,
              2 * A_QK_COLS + A_WIDTH + R_COLS + M_WIDTH)
IN_COLS = 2 * A_QK_COLS + A_WIDTH + R_COLS + M_WIDTH + N_BRANCH * D_MODEL
D_FF = 5632
CONV_W = 3
EPS = 1e-6

kernel_name = 'hybrid_diffattn_rwkv7_memxattn_convglu_encoder'


def rmsnorm(x, g, eps=EPS):
    xf = x.astype(jnp.float32)
    y = xf * lax.rsqrt(jnp.mean(xf * xf, axis=-1, keepdims=True) + eps)
    return (y * g.astype(jnp.float32)).astype(x.dtype)


def shift_prev(u):
    pad = [(0, 0)] * u.ndim
    pad[1] = (1, 0)
    return jnp.pad(u[:, :-1], pad)


def shift_next(u):
    pad = [(0, 0)] * u.ndim
    pad[1] = (0, 1)
    return jnp.pad(u[:, 1:], pad)


def rope(x, pos):
    half = x.shape[-1] // 2
    inv = jnp.power(ROPE_THETA, -jnp.arange(half, dtype=jnp.float32) / half)
    ang = pos[:, None] * inv[None, :]
    bshape = (1, x.shape[1]) + (1,) * (x.ndim - 3) + (half,)
    cos = jnp.cos(ang).reshape(bshape)
    sin = jnp.sin(ang).reshape(bshape)
    xf = x.astype(jnp.float32)
    x1, x2 = xf[..., :half], xf[..., half:]
    return jnp.concatenate([x1 * cos - x2 * sin, x2 * cos + x1 * sin], axis=-1).astype(x.dtype)


def diff_attention(q, k, v, lam, lam_init, sub_g):
    B, T = q.shape[0], q.shape[1]
    nb = T // Q_BLOCK
    scale = A_HEAD_DIM ** -0.5
    qb = q.reshape(B, nb, Q_BLOCK, A_HEADS, 2, A_HEAD_DIM).transpose(1, 0, 2, 3, 4, 5)

    def block(qi):
        s = jnp.einsum('bqhcd,bkhcd->bhcqk', qi, k, preferred_element_type=jnp.float32) * scale
        p = jax.nn.softmax(s, axis=-1)
        a = p[:, :, 0] - lam * p[:, :, 1]
        return jnp.einsum('bhqk,bkhe->bqhe', a.astype(v.dtype), v)

    o = lax.map(block, qb)
    o = o.transpose(1, 0, 2, 3, 4).reshape(B, T, A_HEADS, A_VDIM)
    o = rmsnorm(o, sub_g) * (1.0 - lam_init)
    return o.reshape(B, T, A_WIDTH)


def rwkv7_bidir(z, mu_prev, mu_next, decay_w0, decay_w2, aaa_a0, aaa_a2, gate_g2,
                k_k, k_a, r_k, lnx_w, lnx_b):
    B, T = z.shape[0], z.shape[1]
    H, N = R_HEADS, R_HEAD
    f32 = jnp.float32
    z = z + mu_prev * (shift_prev(z) - z) + mu_next * (shift_next(z) - z)
    r, k, v, zw, za, zg = jnp.split(
        z, (R_WIDTH, 2 * R_WIDTH, 3 * R_WIDTH, 3 * R_WIDTH + 2 * DECAY_RANK,
            3 * R_WIDTH + 2 * DECAY_RANK + 2 * AAA_RANK), axis=-1)
    zw = zw.reshape(B, T, 2, DECAY_RANK)
    za = za.reshape(B, T, 2, AAA_RANK)
    w = -jax.nn.softplus(-(decay_w0 + jnp.einsum('btdr,drc->btdc', jnp.tanh(zw), decay_w2))) - 0.5
    decay = jnp.exp(-jnp.exp(w.astype(f32)))
    a = jax.nn.sigmoid(aaa_a0 + jnp.einsum('btdr,drc->btdc', za, aaa_a2)).astype(f32)
    g = jax.nn.sigmoid(zg) @ gate_g2
    kk = (k * k_k).astype(f32).reshape(B, T, H, N)
    kk = kk / jnp.maximum(jnp.sqrt(jnp.sum(kk * kk, axis=-1, keepdims=True)), 1e-12)
    kk = kk.reshape(B, T, R_WIDTH)
    kd = (k[:, :, None, :] * (1.0 + (a - 1.0) * k_a)).astype(f32)

    def both(u):
        return jnp.stack([u, u], axis=2).astype(f32)

    def dirs(u):
        u = u.reshape(B, T, 2, H, N)
        u = jnp.stack([u[:, :, 0], u[:, ::-1, 1]], axis=0)
        return u.transpose(2, 0, 1, 3, 4)

    xs = (dirs(both(r)), dirs(decay), dirs(kd), dirs(both(v)), dirs(both(kk)), dirs(a))

    def step(S, inp):
        r_t, w_t, k_t, v_t, kk_t, a_t = inp
        sa = jnp.einsum('dbhij,dbhj->dbhi', S, -kk_t)
        S = (S * w_t[..., None, :] + sa[..., None] * (kk_t * a_t)[..., None, :]
             + v_t[..., None] * k_t[..., None, :])
        y = jnp.einsum('dbhij,dbhj->dbhi', S, r_t)
        return S, y

    S0 = jnp.zeros((2, B, H, N, N), f32)
    _, ys = lax.scan(step, S0, xs)
    y = (ys[:, 0] + ys[::-1, 1]).transpose(1, 0, 2, 3)
    mu = jnp.mean(y, axis=-1, keepdims=True)
    var = jnp.mean((y - mu) ** 2, axis=-1, keepdims=True)
    yn = ((y - mu) * lax.rsqrt(var + LNX_EPS)).reshape(B, T, R_WIDTH)
    yn = yn * lnx_w.astype(f32) + lnx_b.astype(f32)
    rh = r.astype(f32).reshape(B, T, 1, H, N)
    kdh = kd.reshape(B, T, 2, H, N)
    bonus = jnp.sum(rh * kdh * r_k.astype(f32), axis=(2, 4))[..., None] * v.astype(f32).reshape(B, T, H, N)
    out = (yn + bonus.reshape(B, T, R_WIDTH)) * g.astype(f32)
    return out.astype(z.dtype)


def memory_attention(q, mem, g_memnorm, w_mem_kv, mq_norm, mk_norm):
    B, T = q.shape[0], q.shape[1]
    kv = rmsnorm(mem, g_memnorm) @ w_mem_kv
    km, vm = jnp.split(kv, (M_WIDTH,), axis=-1)
    qh = rmsnorm(q.reshape(B, T, M_HEADS, M_HEAD_DIM), mq_norm)
    kh = rmsnorm(km.reshape(B, N_MEM, M_HEADS, M_HEAD_DIM), mk_norm)
    vh = vm.reshape(B, N_MEM, M_HEADS, M_HEAD_DIM)
    s = jnp.einsum('bqhd,bkhd->bhqk', qh, kh, preferred_element_type=jnp.float32) * (M_HEAD_DIM ** -0.5)
    p = jax.nn.softmax(s, axis=-1)
    o = jnp.einsum('bhqk,bkhd->bqhd', p.astype(vh.dtype), vh)
    return o.reshape(B, T, M_WIDTH)


def conv_glu_ffn(h, w_up, conv_w, conv_b, w_down):
    u = h @ w_up
    u = conv_w[0] * shift_prev(u) + conv_w[1] * u + conv_w[2] * shift_next(u) + conv_b
    gt, val = jnp.split(u, (D_FF,), axis=-1)
    return (jax.nn.silu(gt) * val) @ w_down


def encoder_layer(x, mem, p, layer_idx):
    B, T = x.shape[0], x.shape[1]
    lam_init = 0.8 - 0.6 * math.exp(-0.3 * layer_idx)
    h = rmsnorm(x, p['g_mix'])
    z = h @ p['w_in']
    zq, zk, zv, zr, zm, zg = jnp.split(z, IN_OFFSETS, axis=-1)
    pos = jnp.arange(T, dtype=jnp.float32)
    q = rope(rmsnorm(zq.reshape(B, T, A_HEADS, 2, A_HEAD_DIM), p['q_norm']), pos)
    k = rope(rmsnorm(zk.reshape(B, T, A_HEADS, 2, A_HEAD_DIM), p['k_norm']), pos)
    v = zv.reshape(B, T, A_HEADS, A_VDIM)
    f32 = jnp.float32
    lam = (jnp.exp(jnp.sum(p['lambda_q1'].astype(f32) * p['lambda_k1'].astype(f32)))
           - jnp.exp(jnp.sum(p['lambda_q2'].astype(f32) * p['lambda_k2'].astype(f32))) + lam_init)
    o_a = diff_attention(q, k, v, lam, lam_init, p['attn_subln'])
    o_r = rwkv7_bidir(zr, p['mu_prev'], p['mu_next'], p['decay_w0'], p['decay_w2'],
                      p['aaa_a0'], p['aaa_a2'], p['gate_g2'], p['k_k'], p['k_a'],
                      p['r_k'], p['lnx_w'], p['lnx_b'])
    o_m = memory_attention(zm, mem, p['g_memnorm'], p['w_mem_kv'], p['mq_norm'], p['mk_norm'])
    g_a, g_r, g_m = jnp.split(jax.nn.sigmoid(zg), N_BRANCH, axis=-1)
    merged = g_a * (o_a @ p['p_attn']) + g_r * (o_r @ p['p_rwkv']) + g_m * (o_m @ p['p_mem'])
    x = x + merged @ p['w_o']
    x = x + conv_glu_ffn(rmsnorm(x, p['g_ffn']), p['w_up'], p['conv_w'], p['conv_b'], p['w_down'])
    return x


def run_trunk(x, mem, params):
    for l in range(DEPTH):
        layer_params = {name: arr[l] for name, arr in params.items()}
        x = encoder_layer(x, mem, layer_params, l)
    return x


def setup_inputs(seed: int = 0) -> dict:
    key = jax.random.key(seed)
    ks = iter(jax.random.split(key, 48))
    f32 = jnp.float32
    L = DEPTH

    def nrm(shape, scale):
        return scale * jax.random.normal(next(ks), shape, f32)

    def gain(shape):
        return 1.0 + nrm(shape, 0.02)

    def unif(shape, lo, hi):
        return jax.random.uniform(next(ks), shape, f32, lo, hi)

    return {
        'x_prompt': nrm((BATCH, SEQ, D_MODEL), 1.0),
        'x_sample': nrm((DEC_BATCH, DEC_SEQ, D_MODEL), 1.0),
        'mem_prompt': nrm((BATCH, N_MEM, D_MODEL), 1.0),
        'mem_sample': nrm((DEC_BATCH, N_MEM, D_MODEL), 1.0),
        'g_mix': gain((L, D_MODEL)),
        'w_in': nrm((L, D_MODEL, IN_COLS), D_MODEL ** -0.5),
        'q_norm': gain((L, A_HEAD_DIM)),
        'k_norm': gain((L, A_HEAD_DIM)),
        'lambda_q1': nrm((L, A_HEAD_DIM), 0.1),
        'lambda_k1': nrm((L, A_HEAD_DIM), 0.1),
        'lambda_q2': nrm((L, A_HEAD_DIM), 0.1),
        'lambda_k2': nrm((L, A_HEAD_DIM), 0.1),
        'attn_subln': gain((L, A_VDIM)),
        'mu_prev': unif((L, R_COLS), 0.0, 0.4),
        'mu_next': unif((L, R_COLS), 0.0, 0.4),
        'decay_w0': nrm((L, 2, R_WIDTH), 0.5),
        'decay_w2': nrm((L, 2, DECAY_RANK, R_WIDTH), 0.1),
        'aaa_a0': nrm((L, 2, R_WIDTH), 0.1),
        'aaa_a2': nrm((L, 2, AAA_RANK, R_WIDTH), 0.5 * AAA_RANK ** -0.5),
        'gate_g2': nrm((L, GATE_RANK, R_WIDTH), GATE_RANK ** -0.5),
        'k_k': 0.85 + nrm((L, R_WIDTH), 0.05),
        'k_a': 1.0 + nrm((L, R_WIDTH), 0.05),
        'r_k': nrm((L, R_HEADS, R_HEAD), 0.1),
        'lnx_w': gain((L, R_WIDTH)),
        'lnx_b': nrm((L, R_WIDTH), 0.01),
        'g_memnorm': gain((L, D_MODEL)),
        'w_mem_kv': nrm((L, D_MODEL, 2 * M_WIDTH), D_MODEL ** -0.5),
        'mq_norm': gain((L, M_HEAD_DIM)),
        'mk_norm': gain((L, M_HEAD_DIM)),
        'p_attn': nrm((L, A_WIDTH, D_MODEL), A_WIDTH ** -0.5),
        'p_rwkv': nrm((L, R_WIDTH, D_MODEL), R_WIDTH ** -0.5),
        'p_mem': nrm((L, M_WIDTH, D_MODEL), M_WIDTH ** -0.5),
        'w_o': nrm((L, D_MODEL, D_MODEL), D_MODEL ** -0.5),
        'g_ffn': gain((L, D_MODEL)),
        'w_up': nrm((L, D_MODEL, 2 * D_FF), D_MODEL ** -0.5),
        'conv_w': jnp.array([0.0, 1.0, 0.0], f32)[None, :, None] + nrm((L, CONV_W, 2 * D_FF), 0.2),
        'conv_b': nrm((L, 2 * D_FF), 0.01),
        'w_down': nrm((L, D_FF, D_MODEL), D_FF ** -0.5),
    }


def reference(x_prompt, x_sample, mem_prompt, mem_sample, g_mix, w_in, q_norm, k_norm,
              lambda_q1, lambda_k1, lambda_q2, lambda_k2, attn_subln, mu_prev, mu_next,
              decay_w0, decay_w2, aaa_a0, aaa_a2, gate_g2, k_k, k_a, r_k, lnx_w, lnx_b,
              g_memnorm, w_mem_kv, mq_norm, mk_norm, p_attn, p_rwkv, p_mem, w_o,
              g_ffn, w_up, conv_w, conv_b, w_down):
    params = dict(g_mix=g_mix, w_in=w_in, q_norm=q_norm, k_norm=k_norm,
                  lambda_q1=lambda_q1, lambda_k1=lambda_k1, lambda_q2=lambda_q2,
                  lambda_k2=lambda_k2, attn_subln=attn_subln, mu_prev=mu_prev,
                  mu_next=mu_next, decay_w0=decay_w0, decay_w2=decay_w2, aaa_a0=aaa_a0,
                  aaa_a2=aaa_a2, gate_g2=gate_g2, k_k=k_k, k_a=k_a, r_k=r_k,
                  lnx_w=lnx_w, lnx_b=lnx_b, g_memnorm=g_memnorm, w_mem_kv=w_mem_kv,
                  mq_norm=mq_norm, mk_norm=mk_norm, p_attn=p_attn, p_rwkv=p_rwkv,
                  p_mem=p_mem, w_o=w_o, g_ffn=g_ffn, w_up=w_up, conv_w=conv_w,
                  conv_b=conv_b, w_down=w_down)
    y_prompt = run_trunk(x_prompt, mem_prompt, params)
    y_sample = run_trunk(x_sample, mem_sample, params)
    return (y_prompt, y_sample)
```

```cpp
#include <hip/hip_runtime.h>
#include <hip/hip_cooperative_groups.h>
#include <cstdio>
#include <cstdint>
#include <cmath>
namespace cg = cooperative_groups;

#define LAS __attribute__((address_space(3)))
typedef unsigned short bf16_t;
typedef short bf16x8 __attribute__((ext_vector_type(8)));
typedef short s16x4 __attribute__((ext_vector_type(4)));
typedef float f32x2 __attribute__((ext_vector_type(2)));
typedef float f32x4 __attribute__((ext_vector_type(4)));
typedef float f32x16 __attribute__((ext_vector_type(16)));
typedef unsigned u32x2 __attribute__((ext_vector_type(2)));
typedef unsigned u32x4 __attribute__((ext_vector_type(4)));

constexpr int NT = 49152, DM = 2048, TP = 16384, TS = 8192, NSEQ = 5;
constexpr int ZRP = 3584;
constexpr int DFF = 5632;
constexpr int NTHR = 512;
constexpr size_t MiB = 1u << 20;
constexpr size_t WS_CTL = 0, WS_WIN = 1 * MiB, WS_WG = 31 * MiB, WS_WKV = 55 * MiB, WS_PAR = 63 * MiB, WS_PM2 = 71 * MiB, WS_WO = 79 * MiB,
                 WS_WUP = 87 * MiB, WS_WDN = 131 * MiB, WS_ROPE = 153 * MiB, WS_MEMN = 157 * MiB, WS_KVM = 162 * MiB, WS_BON = 167 * MiB,
                 WS_H = 176 * MiB, WS_QK = 370 * MiB, WS_VM = 562 * MiB, WS_Y = 754 * MiB, WS_ACT = 370 * MiB, WS_MRG = 754 * MiB, WS_END = 946 * MiB;
constexpr int CW_QUEUE = 64, CW_LAM = 128;
constexpr int LDS_XCH = 131072, LDS_MISC = 131072 + 8192, LDS_BYTES = 131072 + 8192 + 256;

__device__ __forceinline__ int seq_start(int s) { return s == 0 ? 0 : TP + (s - 1) * TS; }
__device__ __forceinline__ int seq_len(int s) { return s == 0 ? TP : TS; }
__device__ __forceinline__ int tok_pos(int tok) { return tok < TP ? tok : ((tok - TP) & (TS - 1)); }

__device__ __forceinline__ unsigned cvt_pk_bf16(float lo, float hi) { unsigned r; asm volatile("v_cvt_pk_bf16_f32 %0, %1, %2" : "=v"(r) : "v"(lo), "v"(hi)); return r; }
__device__ __forceinline__ float bflo(unsigned w) { return __uint_as_float(w << 16); }
__device__ __forceinline__ float bfhi(unsigned w) { return __uint_as_float(w & 0xffff0000u); }
__device__ __forceinline__ float bf1(bf16_t b) { return __uint_as_float((unsigned)b << 16); }
__device__ __forceinline__ float sigmoidf_(float x) { return 1.f / (1.f + __expf(-x)); }
__device__ __forceinline__ float wave_sum(float v) {
#pragma unroll
    for (int o = 1; o < 64; o <<= 1) v += __shfl_xor(v, o);
    return v;
}

namespace pg8 {
constexpr int BM = 256, BK = 64, HALF = 128, HTB = HALF * BK * 2, STAGE_BYTES = 8 * HTB;
__host__ __device__ __forceinline__ int lds_byte(int r, int c) { const int st = (r >> 4) * 2 + (c >> 5), rr = r & 15, cc = c & 31, ob = rr * 64 + cc * 2; return st * 1024 + (ob ^ (((ob >> 9) & 1) << 5)); }
__host__ __device__ __forceinline__ void stage_rc(int b, int& R, int& C) { const int st = b / 1024, sb = b % 1024, swz = sb ^ (((sb >> 9) & 1) << 5); R = (st >> 1) * 16 + swz / 64; C = (st & 1) * 32 + (swz % 64) / 2; }
__host__ __device__ __forceinline__ int perm32(int rho) { const int n = rho >> 4, i = rho & 15; return 8 * (i >> 2) + 4 * n + (i & 3); }

struct Unit { const char* A; const char* B; int nt, pm, pn, kind, t0, T; };

template <class Epi, class Sched, bool ALIGN_EPI>
__device__ __forceinline__ void gemm_phase(LAS unsigned char* lds, const int ld, const Sched& S, const Epi& E) {
    const int tid = threadIdx.x, wid = __builtin_amdgcn_readfirstlane(tid >> 6), lane = tid & 63, wr = wid >> 2, wc = wid & 3, fr = lane & 15, fq = lane >> 4;
    unsigned voffA[2], voffB[2];
#pragma unroll
    for (int i = 0; i < 2; ++i) { int R, C; stage_rc(tid * 16 + i * 8192, R, C); const int Rb = (R & ~31) + perm32(R & 31);
        voffA[i] = (unsigned)(R * ld + C) * 2u; voffB[i] = (unsigned)(Rb * ld + C) * 2u; }
    const size_t kstep = (size_t)(BK * 2);
    const size_t hstep = (size_t)HALF * ld * 2;
    const unsigned ldsw = (unsigned)wid * 1024u;
    const int aoff = lds_byte(wr * 64 + fr, fq * 8), boff = lds_byte(wc * 32 + fr, fq * 8);
#define PG8_SA(b, h) (((b) * 2 + (h)) * HTB)
#define PG8_SB(b, h) ((4 + (b) * 2 + (h)) * HTB)
#define PG8_STAGE(bufoff, gbase, voff) do { _Pragma("unroll") for (int _i = 0; _i < 2; ++_i) \
        __builtin_amdgcn_global_load_lds((const unsigned*)((const char*)(gbase) + (voff)[_i]), (LAS unsigned*)(lds + (bufoff) + ldsw + _i * 8192), 16, 0, 0); } while (0)
#define PG8_LDA(dst, b, h) do { _Pragma("unroll") for (int m = 0; m < 4; ++m) _Pragma("unroll") for (int k = 0; k < 2; ++k) dst[m][k] = *(const LAS bf16x8*)(lds + PG8_SA(b, h) + aoff + m * 2048 + k * 1024); } while (0)
#define PG8_LDB(dst, b, h) do { _Pragma("unroll") for (int n = 0; n < 2; ++n) _Pragma("unroll") for (int k = 0; k < 2; ++k) dst[n][k] = *(const LAS bf16x8*)(lds + PG8_SB(b, h) + boff + n * 2048 + k * 1024); } while (0)
#define PG8_MMA(ai, bj, At, Bt) do { __builtin_amdgcn_s_setprio(1); _Pragma("unroll") for (int m = 0; m < 4; ++m) _Pragma("unroll") for (int n = 0; n < 2; ++n) _Pragma("unroll") for (int k = 0; k < 2; ++k) \
        acc[ai][bj][m][n] = __builtin_amdgcn_mfma_f32_16x16x32_bf16(Bt[n][k], At[m][k], acc[ai][bj][m][n], 0, 0, 0); __builtin_amdgcn_s_setprio(0); } while (0)
#define PG8_WAIT_V(n) asm volatile("s_waitcnt vmcnt(" #n ")" ::: "memory")
#define PG8_WAIT_L(n) asm volatile("s_waitcnt lgkmcnt(" #n ")" ::: "memory")
#define PG8_BAR __builtin_amdgcn_s_barrier()
#define PG8_SCHED __builtin_amdgcn_sched_barrier(0)
    Unit cur, nxt; int ui = 0;
    if (!S.next(0, cur)) return;
    f32x4 acc[2][2][4][2];
#pragma unroll
    for (int a = 0; a < 2; ++a)
#pragma unroll
        for (int b = 0; b < 2; ++b)
#pragma unroll
            for (int m = 0; m < 4; ++m)
#pragma unroll
                for (int n = 0; n < 2; ++n) acc[a][b][m][n] = (f32x4){0.f, 0.f, 0.f, 0.f};
    bf16x8 At[4][2], B0[2][2], B1[2][2];
    const char* cA = cur.A; const char* cB = cur.B;
    PG8_STAGE(PG8_SB(0, 0), cB, voffB); PG8_STAGE(PG8_SB(0, 1), cB + hstep, voffB); PG8_STAGE(PG8_SA(0, 0), cA, voffA); PG8_STAGE(PG8_SA(0, 1), cA + hstep, voffA);
    if (wr == 1) PG8_BAR;
    PG8_WAIT_V(2); PG8_BAR;
    PG8_STAGE(PG8_SB(1, 0), cB + kstep, voffB); PG8_STAGE(PG8_SA(1, 0), cA + kstep, voffA); PG8_STAGE(PG8_SB(1, 1), cB + hstep + kstep, voffB);
    PG8_WAIT_V(6); PG8_BAR;
    for (;;) {
        const bool has_next = S.next(ui + 1, nxt);
        const char* nA = has_next ? nxt.A : cA; const char* nB = has_next ? nxt.B : cB;
        const int nt = cur.nt;
        for (int t = 0; t < nt; t += 2) {
            const bool last = (t == nt - 2);
            const char* a1 = cA + (size_t)(t + 1) * kstep;
            const char* a2 = last ? nA : cA + (size_t)(t + 2) * kstep; const char* b2 = last ? nB : cB + (size_t)(t + 2) * kstep;
            const char* a3 = a2 + kstep; const char* b3 = b2 + kstep;
            PG8_LDB(B0, 0, 0); PG8_LDB(B1, 0, 1); PG8_SCHED; PG8_LDA(At, 0, 0); PG8_STAGE(PG8_SA(1, 1), a1 + hstep, voffA);
            PG8_WAIT_V(8); PG8_WAIT_L(0); PG8_BAR; PG8_MMA(0, 0, At, B0); PG8_MMA(0, 1, At, B1); PG8_BAR; PG8_SCHED;
            PG8_LDA(At, 0, 1); PG8_STAGE(PG8_SB(0, 0), b2, voffB); PG8_STAGE(PG8_SB(0, 1), b2 + hstep, voffB); PG8_STAGE(PG8_SA(0, 0), a2, voffA);
            PG8_WAIT_V(8); PG8_WAIT_L(0); PG8_BAR; PG8_MMA(1, 0, At, B0); PG8_MMA(1, 1, At, B1); PG8_BAR; PG8_SCHED;
            PG8_LDB(B0, 1, 0); PG8_LDB(B1, 1, 1); PG8_SCHED; PG8_LDA(At, 1, 0); PG8_STAGE(PG8_SA(0, 1), a2 + hstep, voffA);
            PG8_WAIT_V(8); PG8_WAIT_L(0); PG8_BAR; PG8_MMA(0, 0, At, B0); PG8_MMA(0, 1, At, B1); PG8_BAR; PG8_SCHED;
            PG8_LDA(At, 1, 1); PG8_STAGE(PG8_SB(1, 0), b3, voffB); PG8_STAGE(PG8_SB(1, 1), b3 + hstep, voffB); PG8_STAGE(PG8_SA(1, 0), a3, voffA);
            PG8_WAIT_V(8); PG8_WAIT_L(0); PG8_BAR; PG8_MMA(1, 0, At, B0); PG8_MMA(1, 1, At, B1); PG8_BAR; PG8_SCHED;
        }
        if constexpr (ALIGN_EPI) { if (wr == 0) PG8_BAR; }
        E(acc, cur, wr, wc, fr, fq);
        if (!has_next) break;
#pragma unroll
        for (int a = 0; a < 2; ++a)
#pragma unroll
            for (int b = 0; b < 2; ++b)
#pragma unroll
                for (int m = 0; m < 4; ++m)
#pragma unroll
                    for (int n = 0; n < 2; ++n) acc[a][b][m][n] = (f32x4){0.f, 0.f, 0.f, 0.f};
        cur = nxt; cA = nA; cB = nB; ++ui;
        if constexpr (ALIGN_EPI) { if (wr == 1) PG8_BAR; }
    }
    PG8_WAIT_V(0);
    if constexpr (!ALIGN_EPI) { if (wr == 0) PG8_BAR; }
    PG8_BAR;
#undef PG8_SA
#undef PG8_SB
#undef PG8_STAGE
#undef PG8_LDA
#undef PG8_LDB
#undef PG8_MMA
#undef PG8_WAIT_V
#undef PG8_WAIT_L
#undef PG8_BAR
#undef PG8_SCHED
}
}
using pg8::Unit;

struct TileMap {
    int nM, nN;
    __device__ __forceinline__ bool get(long L, int& pm, int& pn) const {
        if (L >= (long)nM * nN) return false;
        const int nig = 16 * nN, gid = (int)(L / nig), fm = gid * 16, gsz = (nM - fm) < 16 ? (nM - fm) : 16, r = (int)(L % nig);
        pm = fm + r % gsz; pn = r / gsz; return true;
    }
};

struct Args {
    const float* in[38];
    float* out; unsigned char* ws;
    double inv_rev[32];
    int ph_lo, ph_hi;
};

__device__ __forceinline__ void tr_item(const float* W, int N, int src_n0, bf16_t* WT, size_t ldw, int koff, int r0, int k0, LAS float* scr, int lane) {
    if (src_n0 >= 0) {
#pragma unroll 8
        for (int i = 0; i < 32; ++i) { const int kk = 2 * i + (lane >> 5); scr[kk * 33 + (lane & 31)] = W[(size_t)(k0 + kk) * N + src_n0 + (lane & 31)]; }
    } else {
#pragma unroll 8
        for (int i = 0; i < 32; ++i) { const int kk = 2 * i + (lane >> 5); scr[kk * 33 + (lane & 31)] = 0.f; }
    }
    asm volatile("s_waitcnt lgkmcnt(0)" ::: "memory");
    const int c = lane & 7;
#pragma unroll
    for (int j = 0; j < 4; ++j) { const int n = (lane >> 3) + 8 * j; const LAS float* s = scr + (8 * c) * 33 + n;
        u32x4 o; o.x = cvt_pk_bf16(s[0 * 33], s[1 * 33]); o.y = cvt_pk_bf16(s[2 * 33], s[3 * 33]); o.z = cvt_pk_bf16(s[4 * 33], s[5 * 33]); o.w = cvt_pk_bf16(s[6 * 33], s[7 * 33]);
        *(u32x4*)(WT + (size_t)(r0 + n) * ldw + koff + k0 + 8 * c) = o; }
    asm volatile("s_waitcnt lgkmcnt(0)" ::: "memory");
}
__device__ __forceinline__ void rms_row(const float* xrow, const float* g, bf16_t* orow, int lane) {
    f32x4 v[8]; float s = 0.f;
#pragma unroll
    for (int j = 0; j < 8; ++j) { v[j] = ((const f32x4*)xrow)[64 * j + lane]; s += (v[j].x * v[j].x + v[j].y * v[j].y) + (v[j].z * v[j].z + v[j].w * v[j].w); }
    const float rstd = rsqrtf(wave_sum(s) * (1.f / DM) + 1e-6f);
#pragma unroll
    for (int j = 0; j < 8; ++j) { const f32x4 gg = ((const f32x4*)g)[64 * j + lane];
        u32x2 w; w.x = cvt_pk_bf16(v[j].x * rstd * gg.x, v[j].y * rstd * gg.y); w.y = cvt_pk_bf16(v[j].z * rstd * gg.z, v[j].w * rstd * gg.w);
        ((u32x2*)orow)[64 * j + lane] = w; }
}

__device__ __forceinline__ void p0_prologue(const Args& a, LAS unsigned char* lds, int vcu, int G) {
    const int tid = threadIdx.x, lane = tid & 63, wave = tid >> 6;
    unsigned char* ws = a.ws;
    LAS float* scr = (LAS float*)(lds + wave * 16384);
    const int gw = vcu * 8 + wave, NGW = G * 8;
    constexpr int I0 = 32 * 240, I1 = 32 * 192, I2 = 32 * 64, I3 = 16 * 64, I6 = 32 * 64, I7 = 32 * 352, I8 = 88 * 64;
    constexpr int NITEMS = I0 + I1 + I2 + 3 * I3 + I6 + I7 + I8;
    for (int it = gw; it < NITEMS; it += NGW) {
        int r = it;
        if (r < I0) { const int kb = r / 240, nb = r % 240, r0 = nb * 32; int src;
            if (r0 < 2048) { const int tile = r0 >> 8, cp = r0 & 255, h = cp >> 7, g = (cp & 127) >> 5; src = tile * 256 + 64 * g + 32 * h; }
            else if (r0 < 6560) src = r0;
            else if (r0 < 6656) src = -1;
            else src = 6560 + (r0 - 6656);
            tr_item(a.in[5], 13728, src, (bf16_t*)(ws + WS_WIN), 2048, 0, r0, kb * 64, scr, lane); continue; } r -= I0;
        if (r < I1) { const int kb = r / 192, nb = r % 192; tr_item(a.in[5], 13728, 7584 + nb * 32, (bf16_t*)(ws + WS_WG), 2048, 0, nb * 32, kb * 64, scr, lane); continue; } r -= I1;
        if (r < I2) { const int kb = r / 64, nb = r % 64; tr_item(a.in[26], 2048, nb * 32, (bf16_t*)(ws + WS_WKV), 2048, 0, nb * 32, kb * 64, scr, lane); continue; } r -= I2;
        if (r < I3) { const int kb = r / 64, nb = r % 64; tr_item(a.in[29], 2048, nb * 32, (bf16_t*)(ws + WS_PAR), 2048, 0, nb * 32, kb * 64, scr, lane); continue; } r -= I3;
        if (r < I3) { const int kb = r / 64, nb = r % 64; tr_item(a.in[30], 2048, nb * 32, (bf16_t*)(ws + WS_PAR), 2048, 1024, nb * 32, kb * 64, scr, lane); continue; } r -= I3;
        if (r < I3) { const int kb = r / 64, nb = r % 64; tr_item(a.in[31], 2048, nb * 32, (bf16_t*)(ws + WS_PM2), 2048, 0, nb * 32, kb * 64, scr, lane); continue; } r -= I3;
        if (r < I6) { const int kb = r / 64, nb = r % 64; tr_item(a.in[32], 2048, nb * 32, (bf16_t*)(ws + WS_WO), 2048, 0, nb * 32, kb * 64, scr, lane); continue; } r -= I6;
        if (r < I7) { const int kb = r / 352, nb = r % 352, r0 = nb * 32, tile = r0 >> 8, bj = (r0 & 255) >> 7, j = r0 & 127;
            tr_item(a.in[34], 2 * DFF, bj * DFF + 128 * tile + j, (bf16_t*)(ws + WS_WUP), 2048, 0, r0, kb * 64, scr, lane); continue; } r -= I7;
        { const int kb = r / 64, nb = r % 64; tr_item(a.in[37], 2048, nb * 32, (bf16_t*)(ws + WS_WDN), DFF, 0, nb * 32, kb * 64, scr, lane); }
    }
    for (int m = gw; m < NT + 1280; m += NGW) {
        if (m < NT) { const float* xr = m < TP ? a.in[0] + (size_t)m * DM : a.in[1] + (size_t)(m - TP) * DM; rms_row(xr, a.in[4], (bf16_t*)(ws + WS_H) + (size_t)m * DM, lane); }
        else { const int j = m - NT; const float* xr = j < 256 ? a.in[2] + (size_t)j * DM : a.in[3] + (size_t)(j - 256) * DM; rms_row(xr, a.in[25], (bf16_t*)(ws + WS_MEMN) + (size_t)j * DM, lane); }
    }
    { float* rc = (float*)(ws + WS_ROPE); float* rs = rc + TP * 32;
      for (int e = (vcu * NTHR + tid); e < TP * 32; e += G * NTHR) { const int t = e >> 5, d = e & 31; double rev = (double)t * a.inv_rev[d]; rev -= rint(rev); const float rf = (float)rev;
          rc[e] = __builtin_amdgcn_cosf(rf); rs[e] = __builtin_amdgcn_sinf(rf); } }
    if (blockIdx.x == 0) {
        unsigned* ctl = (unsigned*)(ws + WS_CTL);
        if (tid < 64) {
            if (tid == 0) ctl[CW_QUEUE] = 0u;
            const float s1 = wave_sum(a.in[8][tid] * a.in[9][tid]), s2 = wave_sum(a.in[10][tid] * a.in[11][tid]);
            if (tid == 0) ((float*)ctl)[CW_LAM] = __expf(s1) - __expf(s2) + 0.2f;
        }
    }
}

struct SchedIn {
    int v, G; const char* H; const char* WIN; const char* MEMN; const char* WKV;
    __device__ __forceinline__ bool next(int i, Unit& u) const {
        long L = (long)i * G + v; int pm, pn;
        if (L < 5760) { TileMap{192, 30}.get(L, pm, pn); u.A = H + (size_t)pm * MiB; u.B = WIN + (size_t)pn * MiB; u.nt = 32; u.pm = pm; u.pn = pn; u.kind = 0; u.t0 = 0; u.T = 0; return true; }
        L -= 5760; if (L < 40) { pm = (int)(L % 5); pn = (int)(L / 5); u.A = MEMN + (size_t)pm * MiB; u.B = WKV + (size_t)pn * MiB; u.nt = 32; u.pm = pm; u.pn = pn; u.kind = 1; u.t0 = 0; u.T = 0; return true; }
        return false;
    }
};
struct EpiIn {
    bf16_t* QK; bf16_t* VM; bf16_t* ZR; bf16_t* KVM; const float* qn; const float* kn; const float* rc; const float* rs;
    __device__ __forceinline__ void plain(const f32x4 (&acc)[2][2][4][2], bf16_t* base, size_t ldc, int row0, int col0) const {
#pragma unroll
        for (int ai = 0; ai < 2; ++ai)
#pragma unroll
            for (int m = 0; m < 4; ++m) { bf16_t* rowp = base + (size_t)(row0 + ai * 128 + m * 16) * ldc + col0;
#pragma unroll
                for (int bj = 0; bj < 2; ++bj) { const f32x4 v0 = acc[ai][bj][m][0], v1 = acc[ai][bj][m][1];
                    u32x4 w; w.x = cvt_pk_bf16(v0[0], v0[1]); w.y = cvt_pk_bf16(v0[2], v0[3]); w.z = cvt_pk_bf16(v1[0], v1[1]); w.w = cvt_pk_bf16(v1[2], v1[3]);
                    *(u32x4*)(rowp + bj * 128) = w; } }
    }
    __device__ __forceinline__ void operator()(const f32x4 (&acc)[2][2][4][2], const Unit& u, int wr, int wc, int fr, int fq) const {
        const int row0 = u.pm * 256 + wr * 64 + fr, cin = wc * 32 + 8 * fq;
        if (u.kind == 1) { plain(acc, KVM, 2048, row0, u.pn * 256 + cin); return; }
        const int pn = u.pn;
        if (pn < 8) {
            const bool isq = pn < 4; const float* nw = isq ? qn : kn;
            const int Gq = (pn & 3) * 4 + wc, d0 = 8 * fq;
            const float qs = isq ? 0.125f * 1.4426950408889634f : 1.f;
            const f32x4 w1a = *(const f32x4*)(nw + d0), w1b = *(const f32x4*)(nw + d0 + 4), w2a = *(const f32x4*)(nw + 32 + d0), w2b = *(const f32x4*)(nw + 36 + d0);
            bf16_t* dst = QK + (isq ? 0 : 1024) + Gq * 64 + d0;
#pragma unroll
            for (int ai = 0; ai < 2; ++ai)
#pragma unroll
                for (int m = 0; m < 4; ++m) {
                    const int row = row0 + ai * 128 + m * 16, t = tok_pos(row);
                    const f32x4 xa = acc[ai][0][m][0], xb = acc[ai][0][m][1], ya = acc[ai][1][m][0], yb = acc[ai][1][m][1];
                    float ss = (xa[0] * xa[0] + xa[1] * xa[1]) + (xa[2] * xa[2] + xa[3] * xa[3]) + (xb[0] * xb[0] + xb[1] * xb[1]) + (xb[2] * xb[2] + xb[3] * xb[3])
                             + (ya[0] * ya[0] + ya[1] * ya[1]) + (ya[2] * ya[2] + ya[3] * ya[3]) + (yb[0] * yb[0] + yb[1] * yb[1]) + (yb[2] * yb[2] + yb[3] * yb[3]);
                    ss += __shfl_xor(ss, 16); ss += __shfl_xor(ss, 32);
                    const float rstd = rsqrtf(ss * (1.f / 64.f) + 1e-6f);
                    const f32x4 ca = *(const f32x4*)(rc + t * 32 + d0), cb = *(const f32x4*)(rc + t * 32 + d0 + 4), sa = *(const f32x4*)(rs + t * 32 + d0), sb = *(const f32x4*)(rs + t * 32 + d0 + 4);
                    const f32x4 x1a = xa * rstd * w1a, x1b = xb * rstd * w1b, x2a = ya * rstd * w2a, x2b = yb * rstd * w2b;
                    const f32x4 o1a = (x1a * ca - x2a * sa) * qs, o1b = (x1b * cb - x2b * sb) * qs, o2a = (x2a * ca + x1a * sa) * qs, o2b = (x2b * cb + x1b * sb) * qs;
                    u32x4 w; w.x = cvt_pk_bf16(o1a[0], o1a[1]); w.y = cvt_pk_bf16(o1a[2], o1a[3]); w.z = cvt_pk_bf16(o1b[0], o1b[1]); w.w = cvt_pk_bf16(o1b[2], o1b[3]);
                    *(u32x4*)(dst + (size_t)row * 2048) = w;
                    w.x = cvt_pk_bf16(o2a[0], o2a[1]); w.y = cvt_pk_bf16(o2a[2], o2a[3]); w.z = cvt_pk_bf16(o2b[0], o2b[1]); w.w = cvt_pk_bf16(o2b[2], o2b[3]);
                    *(u32x4*)(dst + (size_t)row * 2048 + 32) = w;
                }
        } else if (pn < 12) plain(acc, VM, 2048, row0, (pn - 8) * 256 + cin);
        else if (pn < 26) plain(acc, ZR, ZRP, row0, (pn - 12) * 256 + cin);
        else plain(acc, VM, 2048, row0, 1024 + (pn - 26) * 256 + cin);
    }
};

namespace att {
constexpr int SHM_V = 16384, SHM_K = 8192;
constexpr int OFF_V = 0, OFF_K = 32768, OFF_WS = 49152, OFF_STASH = 51200;
#define KSWZ64(row, colB) ((row) * 128 + ((colB) ^ (((row) & 7) << 4)))
#define SBAR() __builtin_amdgcn_sched_barrier(0)
__device__ __forceinline__ int crow(int r, int hi) { return (r & 3) + 8 * (r >> 2) + 4 * hi; }
constexpr float THRL = 8.f;
__device__ __forceinline__ void partialSM(f32x16& p0, f32x16& p1, float& m_reg, float& alpha) {
    float pmax = p0[0];
#pragma unroll
    for (int r = 1; r < 16; ++r) pmax = fmaxf(pmax, p0[r]);
#pragma unroll
    for (int r = 0; r < 16; ++r) pmax = fmaxf(pmax, p1[r]);
    { auto rr = __builtin_amdgcn_permlane32_swap(__float_as_uint(pmax), __float_as_uint(pmax), false, false);
      pmax = fmaxf(__uint_as_float(rr[0]), __uint_as_float(rr[1])); }
    float mn;
    if (__builtin_expect(__all(pmax - m_reg <= THRL), 1)) { mn = m_reg; alpha = 1.f; }
    else { mn = fmaxf(m_reg, pmax); alpha = __builtin_amdgcn_exp2f(m_reg - mn); m_reg = mn; }
#pragma unroll
    for (int r = 0; r < 16; ++r) p0[r] -= mn;
#pragma unroll
    for (int r = 0; r < 16; ++r) p1[r] -= mn;
#pragma unroll
    for (int r = 0; r < 16; ++r) p0[r] = __builtin_amdgcn_exp2f(p0[r]);
}
__device__ __forceinline__ void finishSM(f32x16& p0, f32x16& p1, float alpha, float& l_reg, bf16x8& pa0, bf16x8& pa1, bf16x8& pa2, bf16x8& pa3) {
#pragma unroll
    for (int r = 0; r < 16; ++r) p1[r] = __builtin_amdgcn_exp2f(p1[r]);
    float ps = 0;
#pragma unroll
    for (int r = 0; r < 16; ++r) ps += p0[r];
#pragma unroll
    for (int r = 0; r < 16; ++r) ps += p1[r];
    { auto rr = __builtin_amdgcn_permlane32_swap(__float_as_uint(ps), __float_as_uint(ps), false, false);
      ps = __uint_as_float(rr[0]) + __uint_as_float(rr[1]); }
    l_reg = l_reg * alpha + ps;
#define PK4(P, BASE, OUT) do { unsigned a0 = cvt_pk_bf16(P[BASE + 0], P[BASE + 1]), a1 = cvt_pk_bf16(P[BASE + 2], P[BASE + 3]);   \
    unsigned b0 = cvt_pk_bf16(P[BASE + 4], P[BASE + 5]), b1 = cvt_pk_bf16(P[BASE + 6], P[BASE + 7]);                              \
    auto r0 = __builtin_amdgcn_permlane32_swap(a0, b0, false, false); auto r1 = __builtin_amdgcn_permlane32_swap(a1, b1, false, false); \
    u32x4 w = {r0[0], r1[0], r0[1], r1[1]}; OUT = *reinterpret_cast<bf16x8*>(&w); } while (0)
    PK4(p0, 0, pa0); PK4(p0, 8, pa1); PK4(p1, 0, pa2); PK4(p1, 8, pa3);
#undef PK4
}
__device__ __forceinline__ void qkt64(f32x16& p0, f32x16& p1, const char* Ks, const bf16x8* qr, int r32, int hi) {
#pragma unroll
    for (int d0 = 0; d0 < 4; ++d0) { const int cb = (d0 * 16 + hi * 8) * 2;
        const bf16x8 b0 = *reinterpret_cast<const bf16x8*>(Ks + KSWZ64(r32, cb));
        const bf16x8 b1 = *reinterpret_cast<const bf16x8*>(Ks + KSWZ64(32 + r32, cb));
        p0 = __builtin_amdgcn_mfma_f32_32x32x16_bf16(b0, qr[d0], p0, 0, 0, 0);
        p1 = __builtin_amdgcn_mfma_f32_32x32x16_bf16(b1, qr[d0], p1, 0, 0, 0); }
}
__device__ __forceinline__ int v_st(int k, int c) { const int kk = (k & ~0xC) | ((k & 4) << 1) | ((k & 8) >> 1); return ((kk >> 3) * 4 + (c >> 5)) * 512 + ((kk & 7) * 32 + (c & 31)) * 2; }
__device__ __forceinline__ int v_rd_base(int lane) { return ((lane & 3) << 3) | (((lane >> 2) & 3) << 6) | (((lane >> 4) & 1) << 5) | (((lane >> 5) & 1) << 8); }
constexpr int v_rd_off(int d0, int ks, int half) { return d0 * 512 + ks * 4096 + half * 2048; }
template <int OFF> __device__ __forceinline__ s16x4 tr_read(int vb) {
    s16x4 r; asm volatile("ds_read_b64_tr_b16 %0, %1 offset:%2" : "=&v"(r) : "v"(vb), "i"(OFF) : "memory"); return r;
}
template <int D0> __device__ __forceinline__ void pv_one(f32x16& od, int vb, bf16x8 pa0, bf16x8 pa1, bf16x8 pa2, bf16x8 pa3) {
    const s16x4 l0 = tr_read<v_rd_off(D0, 0, 0)>(vb), h0 = tr_read<v_rd_off(D0, 0, 1)>(vb), l1 = tr_read<v_rd_off(D0, 1, 0)>(vb), h1 = tr_read<v_rd_off(D0, 1, 1)>(vb);
    const s16x4 l2 = tr_read<v_rd_off(D0, 2, 0)>(vb), h2 = tr_read<v_rd_off(D0, 2, 1)>(vb), l3 = tr_read<v_rd_off(D0, 3, 0)>(vb), h3 = tr_read<v_rd_off(D0, 3, 1)>(vb);
    asm volatile("s_waitcnt lgkmcnt(0)" ::: "memory"); SBAR();
#define PK(L, H) (bf16x8){L[0], L[1], L[2], L[3], H[0], H[1], H[2], H[3]}
    od = __builtin_amdgcn_mfma_f32_32x32x16_bf16(pa0, PK(l0, h0), od, 0, 0, 0);
    od = __builtin_amdgcn_mfma_f32_32x32x16_bf16(pa1, PK(l1, h1), od, 0, 0, 0);
    od = __builtin_amdgcn_mfma_f32_32x32x16_bf16(pa2, PK(l2, h2), od, 0, 0, 0);
    od = __builtin_amdgcn_mfma_f32_32x32x16_bf16(pa3, PK(l3, h3), od, 0, 0, 0);
#undef PK
}
__device__ __forceinline__ void pv_d0(f32x16* o, int vb, bf16x8 pa0, bf16x8 pa1, bf16x8 pa2, bf16x8 pa3) {
    pv_one<0>(o[0], vb, pa0, pa1, pa2, pa3); pv_one<1>(o[1], vb, pa0, pa1, pa2, pa3); pv_one<2>(o[2], vb, pa0, pa1, pa2, pa3); pv_one<3>(o[3], vb, pa0, pa1, pa2, pa3);
}

__device__ __forceinline__ void stash_store(const unsigned* stash, bf16_t* Ow, int ldo, int lane) {
#pragma unroll
    for (int i = 0; i < 8; ++i) { const int q = i * 64 + lane, rl = q >> 4, c8 = (q & 15) * 8, hh = (rl >> 2) & 1, r = (rl & 3) + 4 * (rl >> 3), d0 = c8 >> 5, cc = c8 & 31;
        const unsigned* sp = stash + (d0 * 8 + (r >> 1)) * 64 + hh * 32 + cc; const u32x4 a = *(const u32x4*)sp, b = *(const u32x4*)(sp + 4);
        u32x4 w;
        if (r & 1) { w.x = (a.x >> 16) | (a.y & 0xffff0000u); w.y = (a.z >> 16) | (a.w & 0xffff0000u); w.z = (b.x >> 16) | (b.y & 0xffff0000u); w.w = (b.z >> 16) | (b.w & 0xffff0000u); }
        else { w.x = (a.x & 0xffffu) | (a.y << 16); w.y = (a.z & 0xffffu) | (a.w << 16); w.z = (b.x & 0xffffu) | (b.y << 16); w.w = (b.z & 0xffffu) | (b.w << 16); }
        *(u32x4*)(Ow + (size_t)rl * ldo + c8) = w; }
}

__device__ __forceinline__ void diff_unit(int s, int h, int qb, bf16_t* QK, const bf16_t* VM, float lam, char* lds) {
    constexpr int LDK = 2048;
    int tid = threadIdx.x; asm volatile("" : "+v"(tid));
    const int wid = __builtin_amdgcn_readfirstlane(tid >> 6), lane = tid & 63, r32 = lane & 31, hi = lane >> 5;
    const int tok0 = seq_start(s), T = seq_len(s), NTL = T / 64;
    char* V_lds = lds + OFF_V; char* K_lds = lds + OFF_K;
    float* wsf = (float*)(lds + OFF_WS) + wid * 64; float* li_l = wsf; float* al_l = wsf + 32;
    unsigned* stash = (unsigned*)(lds + OFF_STASH) + wid * 2048;
    const int sr = tid >> 4, sc = (tid & 15) * 8, vst0 = v_st(sr, sc), vst1 = v_st(32 + sr, sc);
    const int kr = tid >> 3, kc = (tid & 7) * 8, kst = KSWZ64(kr, kc * 2);
    const int vb0 = (int)(uintptr_t)V_lds + v_rd_base(lane);
    const bf16_t* Vh = VM + (size_t)tok0 * LDK + h * 128;
    const size_t qrow = (size_t)(tok0 + qb * 256 + wid * 32);
#pragma unroll 1
    for (int c = 0; c < 2; ++c) {
        const bf16_t* Kh = QK + (size_t)tok0 * LDK + 1024 + h * 128 + c * 64;
        const bf16_t* Qw = QK + (qrow + r32) * LDK + h * 128 + c * 64 + hi * 8;
        bf16x8 qr[4];
#pragma unroll
        for (int d0 = 0; d0 < 4; ++d0) qr[d0] = *reinterpret_cast<const bf16x8*>(Qw + d0 * 16);
        float m_reg = -1e30f, l_reg = 0; f32x16 o[4] = {};
        struct { bf16x8 vs0, vs1, ks0; } sr_[2];
#define SLOAD(i, k0) do { sr_[i].vs0 = *reinterpret_cast<const bf16x8*>(&Vh[(size_t)((k0) + sr) * LDK + sc]); sr_[i].vs1 = *reinterpret_cast<const bf16x8*>(&Vh[(size_t)((k0) + 32 + sr) * LDK + sc]); \
    sr_[i].ks0 = *reinterpret_cast<const bf16x8*>(&Kh[(size_t)((k0) + kr) * LDK + kc]); } while (0)
#define SWRITE(b, i) do { *(bf16x8*)(V_lds + (b) * SHM_V + vst0) = sr_[i].vs0; *(bf16x8*)(V_lds + (b) * SHM_V + vst1) = sr_[i].vs1; *(bf16x8*)(K_lds + (b) * SHM_K + kst) = sr_[i].ks0; } while (0)
#define SWAIT() asm volatile("s_waitcnt vmcnt(3)" ::: "memory")
#define RESC(a) do { if (__any((a) < 1.f)) { if (hi == 0) al_l[r32] = (a); asm volatile("s_waitcnt lgkmcnt(0)" ::: "memory"); \
    _Pragma("unroll") for (int d = 0; d < 4; ++d) _Pragma("unroll") for (int r = 0; r < 16; ++r) o[d][r] *= al_l[crow(r, hi)]; } } while (0)
        f32x16 pA0, pA1, pB0, pB1; float alA, alB; bf16x8 pa0, pa1, pa2, pa3;
        SLOAD(0, 0); asm volatile("s_waitcnt vmcnt(0)" ::: "memory"); SWRITE(0, 0); __syncthreads();
        pA0 = f32x16{}; pA1 = f32x16{}; qkt64(pA0, pA1, K_lds, qr, r32, hi); partialSM(pA0, pA1, m_reg, alA);
        SLOAD(1, 64); if (2 < NTL) SLOAD(0, 128);
        SWAIT(); SWRITE(1, 1); __syncthreads();
        for (int j = 1; j + 1 < NTL; j += 2) {
            SBAR(); pB0 = f32x16{}; pB1 = f32x16{}; qkt64(pB0, pB1, K_lds + SHM_K, qr, r32, hi);
            finishSM(pA0, pA1, alA, l_reg, pa0, pa1, pa2, pa3); SBAR();
            SLOAD(1, (j + 2) * 64); SBAR();
            pv_d0(o, vb0, pa0, pa1, pa2, pa3); partialSM(pB0, pB1, m_reg, alB);
            __syncthreads(); SWAIT(); SWRITE(0, 0);
            RESC(alB); __syncthreads();
            SBAR(); pA0 = f32x16{}; pA1 = f32x16{}; qkt64(pA0, pA1, K_lds, qr, r32, hi);
            finishSM(pB0, pB1, alB, l_reg, pa0, pa1, pa2, pa3); SBAR();
            if (j + 3 < NTL) SLOAD(0, (j + 3) * 64); SBAR();
            pv_d0(o, vb0 + SHM_V, pa0, pa1, pa2, pa3); partialSM(pA0, pA1, m_reg, alA);
            __syncthreads(); SWAIT(); SWRITE(1, 1);
            RESC(alA); __syncthreads();
        }
        SBAR(); pB0 = f32x16{}; pB1 = f32x16{}; qkt64(pB0, pB1, K_lds + SHM_K, qr, r32, hi);
        finishSM(pA0, pA1, alA, l_reg, pa0, pa1, pa2, pa3); SBAR();
        pv_d0(o, vb0, pa0, pa1, pa2, pa3); partialSM(pB0, pB1, m_reg, alB);
        __syncthreads(); RESC(alB);
        finishSM(pB0, pB1, alB, l_reg, pa0, pa1, pa2, pa3); SBAR();
        pv_d0(o, vb0 + SHM_V, pa0, pa1, pa2, pa3);
#undef SLOAD
#undef SWRITE
#undef SWAIT
#undef RESC
        if (hi == 0) li_l[r32] = l_reg; asm volatile("s_waitcnt lgkmcnt(0)" ::: "memory");
        float rli[16];
#pragma unroll
        for (int r = 0; r < 16; ++r) rli[r] = __builtin_amdgcn_rcpf(li_l[crow(r, hi)]);
        { const float coef = c == 0 ? 1.f : -lam;
#pragma unroll
          for (int d0 = 0; d0 < 4; ++d0)
#pragma unroll
              for (int r = 0; r < 16; r += 2) { const int idx = (d0 * 8 + (r >> 1)) * 64 + lane; const unsigned w = c == 0 ? 0u : stash[idx];
                  stash[idx] = cvt_pk_bf16(bflo(w) + coef * o[d0][r] * rli[r], bfhi(w) + coef * o[d0][r + 1] * rli[r + 1]); } }
        __syncthreads();
    }
    stash_store(stash, QK + qrow * LDK + h * 128, LDK, lane);
    __syncthreads();
}

constexpr int MOFF_V = 0, MOFF_K = 32768, MOFF_WS = 65536, MOFF_RK = 67584, MOFF_G = 68608, MOFF_STASH = 69632;
__device__ __forceinline__ void mem_unit(int s, int mh, int qb, bf16_t* VM, const bf16_t* KVM, const float* mqn, const float* mkn, char* lds) {
    int tid = threadIdx.x; asm volatile("" : "+v"(tid));
    const int wid = __builtin_amdgcn_readfirstlane(tid >> 6), lane = tid & 63, r32 = lane & 31, hi = lane >> 5;
    const int tok0 = seq_start(s);
    char* V_lds = lds + MOFF_V; char* K_lds = lds + MOFF_K;
    float* wsf = (float*)(lds + MOFF_WS) + wid * 64; float* li_l = wsf; float* al_l = wsf + 32;
    float* rk_l = (float*)(lds + MOFF_RK); float* g_l = (float*)(lds + MOFF_G);
    const bf16_t* Kh = KVM + (size_t)(s * 256) * 2048 + mh * 256;
    const bf16_t* Vh = KVM + (size_t)(s * 256) * 2048 + 1024 + mh * 256;
    if (tid < 256) g_l[tid] = mqn[tid] * mkn[tid];
    {
        const bf16_t* kp = Kh + (size_t)(wid * 32 + r32) * 2048 + hi * 128; float ss = 0.f;
#pragma unroll
        for (int i = 0; i < 16; ++i) { const u32x4 w = *(const u32x4*)(kp + i * 8);
            ss += bflo(w.x) * bflo(w.x) + bfhi(w.x) * bfhi(w.x) + bflo(w.y) * bflo(w.y) + bfhi(w.y) * bfhi(w.y) + bflo(w.z) * bflo(w.z) + bfhi(w.z) * bfhi(w.z) + bflo(w.w) * bflo(w.w) + bfhi(w.w) * bfhi(w.w); }
        ss += __shfl_xor(ss, 32);
        if (hi == 0) rk_l[wid * 32 + r32] = rsqrtf(ss * (1.f / 256.f) + 1e-6f);
    }
    const size_t qrow = (size_t)(tok0 + qb * 256 + wid * 32);
    bf16_t* Qw = VM + (qrow + r32) * 2048 + 1024 + mh * 256 + hi * 8;
    float rqC;
    { float ss = 0.f;
#pragma unroll
      for (int i = 0; i < 16; ++i) { const u32x4 w = *(const u32x4*)(Qw + i * 16);
          ss += bflo(w.x) * bflo(w.x) + bfhi(w.x) * bfhi(w.x) + bflo(w.y) * bflo(w.y) + bfhi(w.y) * bfhi(w.y) + bflo(w.z) * bflo(w.z) + bfhi(w.z) * bfhi(w.z) + bflo(w.w) * bflo(w.w) + bfhi(w.w) * bfhi(w.w); }
      ss += __shfl_xor(ss, 32);
      rqC = rsqrtf(ss * (1.f / 256.f) + 1e-6f) * (0.0625f * 1.4426950408889634f); }
    const int sr = tid >> 4, sc = (tid & 15) * 8, vst0 = v_st(sr, sc), vst1 = v_st(32 + sr, sc);
    const int kr = tid >> 3, kc = (tid & 7) * 8, kst = KSWZ64(kr, kc * 2);
    const int vb0 = (int)(uintptr_t)V_lds + v_rd_base(lane);
    unsigned* stash = (unsigned*)(lds + MOFF_STASH) + wid * 2048;
    __syncthreads();
#pragma unroll 1
    for (int hv = 0; hv < 2; ++hv) {
    float m_reg = -1e30f, l_reg = 0.f; f32x16 o[4] = {};
#pragma unroll 1
    for (int t = 0; t < 4; ++t) {
        const int k0 = t * 64;
#pragma unroll
        for (int ds = 0; ds < 4; ++ds) { const u32x4 w = *(const u32x4*)(Kh + (size_t)(k0 + kr) * 2048 + ds * 64 + kc); const float* g = g_l + ds * 64 + kc;
            u32x4 o4; o4.x = cvt_pk_bf16(bflo(w.x) * g[0], bfhi(w.x) * g[1]); o4.y = cvt_pk_bf16(bflo(w.y) * g[2], bfhi(w.y) * g[3]);
            o4.z = cvt_pk_bf16(bflo(w.z) * g[4], bfhi(w.z) * g[5]); o4.w = cvt_pk_bf16(bflo(w.w) * g[6], bfhi(w.w) * g[7]);
            *(u32x4*)(K_lds + ds * 8192 + kst) = o4; asm volatile("" ::: "memory"); }
        *(u32x4*)(V_lds + vst0) = *(const u32x4*)(Vh + (size_t)(k0 + sr) * 2048 + hv * 128 + sc);
        *(u32x4*)(V_lds + vst1) = *(const u32x4*)(Vh + (size_t)(k0 + 32 + sr) * 2048 + hv * 128 + sc);
        __syncthreads();
        f32x16 p0 = {}, p1 = {};
#pragma unroll
        for (int ds = 0; ds < 4; ++ds) { bf16x8 qr[4];
#pragma unroll
            for (int d0 = 0; d0 < 4; ++d0) qr[d0] = *reinterpret_cast<const bf16x8*>(Qw + ds * 64 + d0 * 16);
            qkt64(p0, p1, K_lds + ds * 8192, qr, r32, hi); }
#pragma unroll
        for (int r = 0; r < 16; ++r) { p0[r] *= rk_l[k0 + crow(r, hi)] * rqC; p1[r] *= rk_l[k0 + 32 + crow(r, hi)] * rqC; }
        float pmax = p0[0];
#pragma unroll
        for (int r = 1; r < 16; ++r) pmax = fmaxf(pmax, p0[r]);
#pragma unroll
        for (int r = 0; r < 16; ++r) pmax = fmaxf(pmax, p1[r]);
        pmax = fmaxf(pmax, __shfl_xor(pmax, 32));
        const float mn = fmaxf(m_reg, pmax), alpha = __builtin_amdgcn_exp2f(m_reg - mn); m_reg = mn;
        float ps = 0.f;
#pragma unroll
        for (int r = 0; r < 16; ++r) { p0[r] = __builtin_amdgcn_exp2f(p0[r] - mn); p1[r] = __builtin_amdgcn_exp2f(p1[r] - mn); ps += p0[r] + p1[r]; }
        ps += __shfl_xor(ps, 32);
        l_reg = l_reg * alpha + ps;
        if (hi == 0) al_l[r32] = alpha; asm volatile("s_waitcnt lgkmcnt(0)" ::: "memory");
#pragma unroll
        for (int d = 0; d < 4; ++d)
#pragma unroll
            for (int r = 0; r < 16; ++r) o[d][r] *= al_l[crow(r, hi)];
        bf16x8 pa0, pa1, pa2, pa3;
#define PK4(P, BASE, OUT) do { unsigned a0 = cvt_pk_bf16(P[BASE + 0], P[BASE + 1]), a1 = cvt_pk_bf16(P[BASE + 2], P[BASE + 3]);   \
    unsigned b0 = cvt_pk_bf16(P[BASE + 4], P[BASE + 5]), b1 = cvt_pk_bf16(P[BASE + 6], P[BASE + 7]);                              \
    auto r0 = __builtin_amdgcn_permlane32_swap(a0, b0, false, false); auto r1 = __builtin_amdgcn_permlane32_swap(a1, b1, false, false); \
    u32x4 w = {r0[0], r1[0], r0[1], r1[1]}; OUT = *reinterpret_cast<bf16x8*>(&w); } while (0)
        PK4(p0, 0, pa0); PK4(p0, 8, pa1); PK4(p1, 0, pa2); PK4(p1, 8, pa3);
#undef PK4
        pv_d0(o, vb0, pa0, pa1, pa2, pa3);
        __syncthreads();
    }
    if (hi == 0) li_l[r32] = l_reg; asm volatile("s_waitcnt lgkmcnt(0)" ::: "memory");
    if (hv == 1) stash_store(stash, VM + qrow * 2048 + 1024 + mh * 256, 2048, lane);
#pragma unroll
    for (int d0 = 0; d0 < 4; ++d0)
#pragma unroll
        for (int r = 0; r < 16; r += 2) stash[(d0 * 8 + (r >> 1)) * 64 + lane] = cvt_pk_bf16(o[d0][r] * __builtin_amdgcn_rcpf(li_l[crow(r, hi)]), o[d0][r + 1] * __builtin_amdgcn_rcpf(li_l[crow(r + 1, hi)]));
    }
    stash_store(stash, VM + qrow * 2048 + 1024 + mh * 256 + 128, 2048, lane);
    __syncthreads();
}
#undef SBAR
}

namespace scan {
constexpr int TC = 32;
constexpr int O_R = 0, O_KD = 8192, O_V = 16384, O_KK = 24576, O_W = 32768, O_KA = 40960, O_Y = 49152, O_AW = 57344, O_AA = 61440;
__device__ __forceinline__ float dpp_red8(float x) {
    x += __uint_as_float(__builtin_amdgcn_update_dpp(0u, __float_as_uint(x), 0xB1, 0xf, 0xf, false));
    x += __uint_as_float(__builtin_amdgcn_update_dpp(0u, __float_as_uint(x), 0x4E, 0xf, 0xf, false));
    x += __uint_as_float(__builtin_amdgcn_update_dpp(0u, __float_as_uint(x), 0x141, 0xf, 0xf, false));
    return x;
}
struct P {
    const bf16_t* ZR; bf16_t* YB; float* BON;
    const float *mup, *mun, *w0, *w2, *a0, *a2, *kk_w, *ka_w, *rk_w;
};
__device__ __forceinline__ void job(int s, int dir, int head, const P& p, char* lds) {
    int tid = threadIdx.x; asm volatile("" : "+v"(tid));
    const int wid = __builtin_amdgcn_readfirstlane(tid >> 6), lane = tid & 63, r32 = lane & 31, hi = lane >> 5;
    const int tok0 = seq_start(s), T = seq_len(s), NCH = T / TC;
    float* Rl = (float*)(lds + O_R); float* KDl = (float*)(lds + O_KD); float* Vl = (float*)(lds + O_V); float* KKl = (float*)(lds + O_KK);
    float* Wl = (float*)(lds + O_W); float* KAl = (float*)(lds + O_KA); float* Yl = (float*)(lds + O_Y);
    bf16_t* AWl = (bf16_t*)(lds + O_AW); bf16_t* AAl = (bf16_t*)(lds + O_AA);
    bf16x8 Bf[4]; float bias = 0.f;
    if (wid < 4) {
        const int mat = wid >> 1, cb = wid & 1; const float* W2 = (mat == 0 ? p.w2 : p.a2) + (size_t)dir * 64 * 1024 + head * 64 + cb * 32 + r32;
#pragma unroll
        for (int ks = 0; ks < 4; ++ks) { float f[8];
#pragma unroll
            for (int e = 0; e < 8; ++e) f[e] = W2[(size_t)(ks * 16 + hi * 8 + e) * 1024];
            u32x4 w; w.x = cvt_pk_bf16(f[0], f[1]); w.y = cvt_pk_bf16(f[2], f[3]); w.z = cvt_pk_bf16(f[4], f[5]); w.w = cvt_pk_bf16(f[6], f[7]); Bf[ks] = *reinterpret_cast<bf16x8*>(&w); }
        bias = (mat == 0 ? p.w0 : p.a0)[dir * 1024 + head * 64 + cb * 32 + r32];
    } else {
#pragma unroll
        for (int ks = 0; ks < 4; ++ks) Bf[ks] = bf16x8{};
    }
    const int e_tok = tid >> 4, e_c0 = (tid & 15) * 4;
    const f32x4 kkw = *(const f32x4*)(p.kk_w + head * 64 + e_c0), kaw = *(const f32x4*)(p.ka_w + head * 64 + e_c0), rkw = *(const f32x4*)(p.rk_w + head * 64 + e_c0);
    const int si = tid >> 3, seg = tid & 7;
    float S[8];
#pragma unroll
    for (int j = 0; j < 8; ++j) S[j] = 0.f;
    bf16_t* yb = p.YB + (size_t)dir * NT * 1024; float* bon = p.BON + (size_t)dir * NT * 16;
    int tprev = -1;
    for (int ch = 0; ch < NCH; ++ch) {
        const int tfirst = dir ? T - TC * (ch + 1) : TC * ch;
        if (tprev >= 0) { const f32x4 y4 = *(const f32x4*)(Yl + e_tok * 64 + e_c0); u32x2 w; w.x = cvt_pk_bf16(y4[0], y4[1]); w.y = cvt_pk_bf16(y4[2], y4[3]);
            *(u32x2*)(yb + (size_t)(tok0 + tprev + e_tok) * 1024 + head * 64 + e_c0) = w; }
        for (int it = tid; it < TC * 40; it += NTHR) {
            const int tl = it / 40, chh = it % 40, which = chh >> 3, j0 = (chh & 7) * 8;
            const int col = which < 3 ? which * 1024 + head * 64 + j0 : (which == 3 ? 3072 : 3200) + dir * 64 + j0;
            const int t = tfirst + tl; const bf16_t* zp = p.ZR + (size_t)(tok0 + t) * ZRP + col;
            const u32x4 z = *(const u32x4*)zp;
            u32x4 zm = {0u, 0u, 0u, 0u}, zn = {0u, 0u, 0u, 0u};
            if (t > 0) zm = *(const u32x4*)(zp - ZRP);
            if (t < T - 1) zn = *(const u32x4*)(zp + ZRP);
            const f32x4 mpa = *(const f32x4*)(p.mup + col), mpb = *(const f32x4*)(p.mup + col + 4), mna = *(const f32x4*)(p.mun + col), mnb = *(const f32x4*)(p.mun + col + 4);
            float v[8];
#define SH(i, zw, zmw, znw, lohi, mp_, mn_) { const float zz = lohi(zw), a_ = lohi(zmw), b_ = lohi(znw); v[i] = zz + mp_ * (a_ - zz) + mn_ * (b_ - zz); }
            SH(0, z.x, zm.x, zn.x, bflo, mpa[0], mna[0]) SH(1, z.x, zm.x, zn.x, bfhi, mpa[1], mna[1]) SH(2, z.y, zm.y, zn.y, bflo, mpa[2], mna[2]) SH(3, z.y, zm.y, zn.y, bfhi, mpa[3], mna[3])
            SH(4, z.z, zm.z, zn.z, bflo, mpb[0], mnb[0]) SH(5, z.z, zm.z, zn.z, bfhi, mpb[1], mnb[1]) SH(6, z.w, zm.w, zn.w, bflo, mpb[2], mnb[2]) SH(7, z.w, zm.w, zn.w, bfhi, mpb[3], mnb[3])
#undef SH
            if (which < 3) { float* dst = (which == 0 ? Rl : which == 1 ? KDl : Vl) + tl * 64 + j0;
                *(f32x4*)dst = (f32x4){v[0], v[1], v[2], v[3]}; *(f32x4*)(dst + 4) = (f32x4){v[4], v[5], v[6], v[7]}; }
            else { if (which == 3) {
#pragma unroll
                    for (int i = 0; i < 8; ++i) { const float e2 = __expf(2.f * v[i]); v[i] = 1.f - 2.f / (e2 + 1.f); } }
                u32x4 w; w.x = cvt_pk_bf16(v[0], v[1]); w.y = cvt_pk_bf16(v[2], v[3]); w.z = cvt_pk_bf16(v[4], v[5]); w.w = cvt_pk_bf16(v[6], v[7]);
                *(u32x4*)((which == 3 ? AWl : AAl) + tl * 64 + j0) = w; }
        }
        __syncthreads();
        if (wid < 4) {
            const int mat = wid >> 1, cb = wid & 1; const bf16_t* Am = (mat == 0 ? AWl : AAl) + r32 * 64 + hi * 8;
            f32x16 acc = {};
#pragma unroll
            for (int ks = 0; ks < 4; ++ks) { const bf16x8 af = *reinterpret_cast<const bf16x8*>(Am + ks * 16); acc = __builtin_amdgcn_mfma_f32_32x32x16_bf16(af, Bf[ks], acc, 0, 0, 0); }
            float* dst = (mat == 0 ? Wl : KAl) + cb * 32 + r32;
#pragma unroll
            for (int r = 0; r < 16; ++r) { const float u = acc[r] + bias; float res;
                if (mat == 0) { const float sp = fmaxf(-u, 0.f) + log1pf(__expf(-fabsf(u))); const float w = -sp - 0.5f; res = __expf(-__expf(w)); }
                else res = 1.f / (1.f + __expf(-u));
                dst[att::crow(r, hi) * 64] = res; }
        }
        __syncthreads();
        { const f32x4 k4 = *(const f32x4*)(KDl + e_tok * 64 + e_c0), a4 = *(const f32x4*)(KAl + e_tok * 64 + e_c0), r4 = *(const f32x4*)(Rl + e_tok * 64 + e_c0);
          const f32x4 kr = k4 * kkw; float ss = (kr[0] * kr[0] + kr[1] * kr[1]) + (kr[2] * kr[2] + kr[3] * kr[3]);
          ss += __shfl_xor(ss, 1); ss += __shfl_xor(ss, 2); ss += __shfl_xor(ss, 4); ss += __shfl_xor(ss, 8);
          const float inv = 1.f / fmaxf(sqrtf(ss), 1e-12f);
          const f32x4 kk = kr * inv, kd = k4 * (1.f + (a4 - 1.f) * kaw), kka = kk * a4;
          const f32x4 bb = r4 * kd * rkw; float bs = (bb[0] + bb[1]) + (bb[2] + bb[3]);
          bs += __shfl_xor(bs, 1); bs += __shfl_xor(bs, 2); bs += __shfl_xor(bs, 4); bs += __shfl_xor(bs, 8);
          *(f32x4*)(KKl + e_tok * 64 + e_c0) = kk; *(f32x4*)(KDl + e_tok * 64 + e_c0) = kd; *(f32x4*)(KAl + e_tok * 64 + e_c0) = kka;
          if ((tid & 15) == 0) bon[(size_t)(tok0 + tfirst + e_tok) * 16 + head] = bs; }
        __syncthreads();
#pragma unroll 2
        for (int st = 0; st < TC; ++st) {
            const int tl = dir ? TC - 1 - st : st; const int o8 = tl * 64 + seg * 8;
            const f32x4 kka_ = *(const f32x4*)(KKl + o8), kkb_ = *(const f32x4*)(KKl + o8 + 4), wa = *(const f32x4*)(Wl + o8), wb = *(const f32x4*)(Wl + o8 + 4);
            const f32x4 aa = *(const f32x4*)(KAl + o8), ab = *(const f32x4*)(KAl + o8 + 4), da = *(const f32x4*)(KDl + o8), db = *(const f32x4*)(KDl + o8 + 4);
            const f32x4 ra = *(const f32x4*)(Rl + o8), rb = *(const f32x4*)(Rl + o8 + 4);
            const float vv = Vl[tl * 64 + si];
            float d = (S[0] * kka_[0] + S[1] * kka_[1]) + (S[2] * kka_[2] + S[3] * kka_[3]) + (S[4] * kkb_[0] + S[5] * kkb_[1]) + (S[6] * kkb_[2] + S[7] * kkb_[3]);
            d = dpp_red8(d); const float sa = -d;
            S[0] = S[0] * wa[0] + vv * da[0] + sa * aa[0]; S[1] = S[1] * wa[1] + vv * da[1] + sa * aa[1]; S[2] = S[2] * wa[2] + vv * da[2] + sa * aa[2]; S[3] = S[3] * wa[3] + vv * da[3] + sa * aa[3];
            S[4] = S[4] * wb[0] + vv * db[0] + sa * ab[0]; S[5] = S[5] * wb[1] + vv * db[1] + sa * ab[1]; S[6] = S[6] * wb[2] + vv * db[2] + sa * ab[2]; S[7] = S[7] * wb[3] + vv * db[3] + sa * ab[3];
            float y = (S[0] * ra[0] + S[1] * ra[1]) + (S[2] * ra[2] + S[3] * ra[3]) + (S[4] * rb[0] + S[5] * rb[1]) + (S[6] * rb[2] + S[7] * rb[3]);
            y = dpp_red8(y);
            if (seg == 0) Yl[tl * 64 + si] = y;
        }
        __syncthreads();
        tprev = tfirst;
    }
    { const f32x4 y4 = *(const f32x4*)(Yl + e_tok * 64 + e_c0); u32x2 w; w.x = cvt_pk_bf16(y4[0], y4[1]); w.y = cvt_pk_bf16(y4[2], y4[3]);
      *(u32x2*)(yb + (size_t)(tok0 + tprev + e_tok) * 1024 + head * 64 + e_c0) = w; }
    __syncthreads();
}
}

__device__ __forceinline__ void p4_post(const Args& a, char* lds, int vcu, int G) {
    const int tid = threadIdx.x, lane = tid & 63;
    unsigned char* ws = a.ws;
    const bf16_t* ZR = (const bf16_t*)a.out; bf16_t* QK = (bf16_t*)(ws + WS_QK);
    const bf16_t* Y0 = (const bf16_t*)(ws + WS_Y); const bf16_t* Y1 = Y0 + (size_t)NT * 1024;
    const float* BON = (const float*)(ws + WS_BON);
    const float* mup = a.in[13]; const float* mun = a.in[14]; const float* G2 = a.in[19]; const float* lnw = a.in[23]; const float* lnb = a.in[24]; const float* subg = a.in[12];
    float* SG = (float*)lds; float* BL = (float*)(lds + 20480);
    for (int tile = vcu; tile < NT / 32; tile += G) {
        const int tk0 = tile * 32;
        __syncthreads();
        for (int it = tid; it < 32 * 20; it += NTHR) {
            const int tl = it / 20, j0 = (it % 20) * 8, col = 3328 + j0, tok = tk0 + tl, t = tok_pos(tok), T = tok < TP ? TP : TS;
            const bf16_t* zp = ZR + (size_t)tok * ZRP + col; const u32x4 z = *(const u32x4*)zp; u32x4 zm = {0u, 0u, 0u, 0u}, zn = {0u, 0u, 0u, 0u};
            if (t > 0) zm = *(const u32x4*)(zp - ZRP);
            if (t < T - 1) zn = *(const u32x4*)(zp + ZRP);
            float v[8];
#define SH(i, zw, zmw, znw, lohi) { const float zz = lohi(zw), a_ = lohi(zmw), b_ = lohi(znw), mp_ = mup[col + i], mn_ = mun[col + i]; v[i] = sigmoidf_(zz + mp_ * (a_ - zz) + mn_ * (b_ - zz)); }
            SH(0, z.x, zm.x, zn.x, bflo) SH(1, z.x, zm.x, zn.x, bfhi) SH(2, z.y, zm.y, zn.y, bflo) SH(3, z.y, zm.y, zn.y, bfhi)
            SH(4, z.z, zm.z, zn.z, bflo) SH(5, z.z, zm.z, zn.z, bfhi) SH(6, z.w, zm.w, zn.w, bflo) SH(7, z.w, zm.w, zn.w, bfhi)
#undef SH
            *(f32x4*)(SG + tl * 160 + j0) = (f32x4){v[0], v[1], v[2], v[3]}; *(f32x4*)(SG + tl * 160 + j0 + 4) = (f32x4){v[4], v[5], v[6], v[7]};
        }
        { const int tl = tid >> 4, hd = tid & 15; BL[tid] = BON[(size_t)(tk0 + tl) * 16 + hd] + BON[(size_t)NT * 16 + (size_t)(tk0 + tl) * 16 + hd]; }
        { const int pr = tid >> 1, half = tid & 1, tl = pr >> 3, hd = pr & 7; bf16_t* op = QK + (size_t)(tk0 + tl) * 2048 + hd * 128 + half * 64;
          u32x4 w[8]; float ss = 0.f;
#pragma unroll
          for (int i = 0; i < 8; ++i) { w[i] = *(const u32x4*)(op + i * 8);
              ss += bflo(w[i].x) * bflo(w[i].x) + bfhi(w[i].x) * bfhi(w[i].x) + bflo(w[i].y) * bflo(w[i].y) + bfhi(w[i].y) * bfhi(w[i].y) + bflo(w[i].z) * bflo(w[i].z) + bfhi(w[i].z) * bfhi(w[i].z) + bflo(w[i].w) * bflo(w[i].w) + bfhi(w[i].w) * bfhi(w[i].w); }
          ss += __shfl_xor(ss, 1);
          const float rstd = rsqrtf(ss * (1.f / 128.f) + 1e-6f) * 0.8f; const float* sg = subg + half * 64;
#pragma unroll
          for (int i = 0; i < 8; ++i) { u32x4 o;
              o.x = cvt_pk_bf16(bflo(w[i].x) * rstd * sg[i * 8 + 0], bfhi(w[i].x) * rstd * sg[i * 8 + 1]); o.y = cvt_pk_bf16(bflo(w[i].y) * rstd * sg[i * 8 + 2], bfhi(w[i].y) * rstd * sg[i * 8 + 3]);
              o.z = cvt_pk_bf16(bflo(w[i].z) * rstd * sg[i * 8 + 4], bfhi(w[i].z) * rstd * sg[i * 8 + 5]); o.w = cvt_pk_bf16(bflo(w[i].w) * rstd * sg[i * 8 + 6], bfhi(w[i].w) * rstd * sg[i * 8 + 7]);
              *(u32x4*)(op + i * 8) = o; } }
        __syncthreads();
        const int c0 = tid * 2;
        float acc[32][2];
#pragma unroll
        for (int i = 0; i < 32; ++i) { acc[i][0] = 0.f; acc[i][1] = 0.f; }
#pragma unroll 1
        for (int k = 0; k < 160; k += 4) {
            const f32x2 g0 = *(const f32x2*)(G2 + (size_t)(k + 0) * 1024 + c0), g1 = *(const f32x2*)(G2 + (size_t)(k + 1) * 1024 + c0), g2 = *(const f32x2*)(G2 + (size_t)(k + 2) * 1024 + c0), g3 = *(const f32x2*)(G2 + (size_t)(k + 3) * 1024 + c0);
#pragma unroll
            for (int i = 0; i < 32; ++i) { const f32x4 s4 = *(const f32x4*)(SG + i * 160 + k);
                acc[i][0] += s4[0] * g0[0] + s4[1] * g1[0] + s4[2] * g2[0] + s4[3] * g3[0];
                acc[i][1] += s4[0] * g0[1] + s4[1] * g1[1] + s4[2] * g2[1] + s4[3] * g3[1]; }
        }
        const int hd = tid >> 5;
        const float lw0 = lnw[c0], lw1 = lnw[c0 + 1], lb0 = lnb[c0], lb1 = lnb[c0 + 1];
        const float mp0 = mup[2048 + c0], mp1 = mup[2048 + c0 + 1], mn0 = mun[2048 + c0], mn1 = mun[2048 + c0 + 1];
#pragma unroll
        for (int i = 0; i < 32; ++i) {
            const int tok = tk0 + i, t = tok_pos(tok), T = tok < TP ? TP : TS;
            const unsigned ya = *(const unsigned*)(Y0 + (size_t)tok * 1024 + c0), yb = *(const unsigned*)(Y1 + (size_t)tok * 1024 + c0);
            const float y0 = bflo(ya) + bflo(yb), y1 = bfhi(ya) + bfhi(yb);
            float s = y0 + y1, q = y0 * y0 + y1 * y1;
#pragma unroll
            for (int o = 1; o < 32; o <<= 1) { s += __shfl_xor(s, o); q += __shfl_xor(q, o); }
            const float mean = s * (1.f / 64.f), var = fmaxf(q * (1.f / 64.f) - mean * mean, 0.f), rstd = rsqrtf(var + 64e-5f);
            const bf16_t* zp = ZR + (size_t)tok * ZRP + 2048 + c0; const unsigned z = *(const unsigned*)zp;
            unsigned zm = 0u, zn = 0u;
            if (t > 0) zm = *(const unsigned*)(zp - ZRP);
            if (t < T - 1) zn = *(const unsigned*)(zp + ZRP);
            const float v0 = bflo(z) + mp0 * (bflo(zm) - bflo(z)) + mn0 * (bflo(zn) - bflo(z)), v1 = bfhi(z) + mp1 * (bfhi(zm) - bfhi(z)) + mn1 * (bfhi(zn) - bfhi(z));
            const float bo = BL[i * 16 + hd];
            const float o0 = ((y0 - mean) * rstd * lw0 + lb0 + bo * v0) * acc[i][0], o1 = ((y1 - mean) * rstd * lw1 + lb1 + bo * v1) * acc[i][1];
            *(unsigned*)(QK + (size_t)tok * 2048 + 1024 + c0) = cvt_pk_bf16(o0, o1);
        }
    }
    __syncthreads();
}

struct SchedMerge {
    int v, G; const char* H; const char* WG; const char* QK; const char* VM; const char* PAR; const char* PM2;
    __device__ __forceinline__ bool next(int i, Unit& u) const {
        const int ti = i / 6, kind = i - ti * 6; const long L = (long)ti * G + v; int pm, pn;
        if (!TileMap{192, 8}.get(L, pm, pn)) return false;
        u.pm = pm; u.pn = pn; u.kind = kind; u.t0 = 0; u.T = 0;
        const size_t bo = (size_t)pn * MiB;
        switch (kind) {
            case 0: u.A = H + (size_t)pm * MiB; u.B = WG + bo; u.nt = 32; break;
            case 1: u.A = QK + (size_t)pm * MiB; u.B = PAR + bo; u.nt = 16; break;
            case 2: u.A = H + (size_t)pm * MiB; u.B = WG + 8 * MiB + bo; u.nt = 32; break;
            case 3: u.A = QK + (size_t)pm * MiB + 2048; u.B = PAR + bo + 2048; u.nt = 16; break;
            case 4: u.A = H + (size_t)pm * MiB; u.B = WG + 16 * MiB + bo; u.nt = 32; break;
            default: u.A = VM + (size_t)pm * MiB + 2048; u.B = PM2 + bo; u.nt = 16; break;
        }
        return true;
    }
};
struct EpiMerge {
    u32x4* scrG; f32x4* scrP; bf16_t* MRG;
    __device__ __forceinline__ void operator()(const f32x4 (&acc)[2][2][4][2], const Unit& u, int wr, int wc, int fr, int fq) const {
        const int tid = threadIdx.x, kind = u.kind;
        u32x4* gp = scrG + tid; f32x4* pp = scrP + tid;
        if ((kind & 1) == 0) {
#pragma unroll
            for (int ai = 0; ai < 2; ++ai)
#pragma unroll
                for (int bj = 0; bj < 2; ++bj)
#pragma unroll
                    for (int m = 0; m < 4; ++m) { const f32x4 v0 = acc[ai][bj][m][0], v1 = acc[ai][bj][m][1]; u32x4 w;
                        w.x = cvt_pk_bf16(sigmoidf_(v0[0]), sigmoidf_(v0[1])); w.y = cvt_pk_bf16(sigmoidf_(v0[2]), sigmoidf_(v0[3]));
                        w.z = cvt_pk_bf16(sigmoidf_(v1[0]), sigmoidf_(v1[1])); w.w = cvt_pk_bf16(sigmoidf_(v1[2]), sigmoidf_(v1[3]));
                        *gp = w; gp += NTHR; asm volatile("" : "+v"(gp) :: "memory"); }
        } else {
            const int row0 = u.pm * 256 + wr * 64 + fr, col0 = u.pn * 256 + wc * 32 + 8 * fq;
#pragma unroll
            for (int ai = 0; ai < 2; ++ai)
#pragma unroll
                for (int bj = 0; bj < 2; ++bj) {
                    bf16_t* mp = MRG + (size_t)(row0 + ai * 128) * 2048 + col0 + bj * 128;
#pragma unroll
                    for (int m = 0; m < 4; ++m) { const u32x4 g = *gp;
                        f32x4 p0 = acc[ai][bj][m][0] * (f32x4){bflo(g.x), bfhi(g.x), bflo(g.y), bfhi(g.y)}, p1 = acc[ai][bj][m][1] * (f32x4){bflo(g.z), bfhi(g.z), bflo(g.w), bfhi(g.w)};
                        if (kind > 1) { p0 += pp[0]; p1 += pp[NTHR]; }
                        if (kind < 5) { pp[0] = p0; pp[NTHR] = p1; }
                        else { u32x4 w; w.x = cvt_pk_bf16(p0[0], p0[1]); w.y = cvt_pk_bf16(p0[2], p0[3]); w.z = cvt_pk_bf16(p1[0], p1[1]); w.w = cvt_pk_bf16(p1[2], p1[3]);
                            *(u32x4*)mp = w; }
                        gp += NTHR; pp += 2 * NTHR; mp += 16 * 2048; asm volatile("" : "+v"(gp), "+v"(pp), "+v"(mp) :: "memory"); } }
        }
    }
};

struct SchedSq {
    int v, G; const char* A; const char* B; size_t astep, bstep; int nt;
    __device__ __forceinline__ bool next(int i, Unit& u) const {
        const long L = (long)i * G + v; int pm, pn; if (!TileMap{192, 8}.get(L, pm, pn)) return false;
        u.A = A + (size_t)pm * astep; u.B = B + (size_t)pn * bstep; u.nt = nt; u.pm = pm; u.pn = pn; u.kind = 0; u.t0 = 0; u.T = 0; return true;
    }
};
struct EpiWo {
    const float* xp; const float* xs; float* out;
    __device__ __forceinline__ void operator()(const f32x4 (&acc)[2][2][4][2], const Unit& u, int wr, int wc, int fr, int fq) const {
        const int row0 = u.pm * 256 + wr * 64 + fr, col0 = u.pn * 256 + wc * 32 + 8 * fq;
#pragma unroll
        for (int ai = 0; ai < 2; ++ai)
#pragma unroll
            for (int m = 0; m < 4; ++m) { const int row = row0 + ai * 128 + m * 16;
                const float* xr = (row < TP ? xp + (size_t)row * DM : xs + (size_t)(row - TP) * DM) + col0; float* orow = out + (size_t)row * DM + col0;
#pragma unroll
                for (int bj = 0; bj < 2; ++bj) { const f32x4 x0 = *(const f32x4*)(xr + bj * 128), x1 = *(const f32x4*)(xr + bj * 128 + 4);
                    *(f32x4*)(orow + bj * 128) = x0 + acc[ai][bj][m][0]; *(f32x4*)(orow + bj * 128 + 4) = x1 + acc[ai][bj][m][1]; } }
    }
};
struct EpiDown {
    float* out;
    __device__ __forceinline__ void operator()(const f32x4 (&acc)[2][2][4][2], const Unit& u, int wr, int wc, int fr, int fq) const {
        const int row0 = u.pm * 256 + wr * 64 + fr, col0 = u.pn * 256 + wc * 32 + 8 * fq;
#pragma unroll
        for (int ai = 0; ai < 2; ++ai)
#pragma unroll
            for (int m = 0; m < 4; ++m) { float* orow = out + (size_t)(row0 + ai * 128 + m * 16) * DM + col0;
#pragma unroll
                for (int bj = 0; bj < 2; ++bj) { const f32x4 x0 = *(const f32x4*)(orow + bj * 128), x1 = *(const f32x4*)(orow + bj * 128 + 4);
                    *(f32x4*)(orow + bj * 128) = x0 + acc[ai][bj][m][0]; *(f32x4*)(orow + bj * 128 + 4) = x1 + acc[ai][bj][m][1]; } }
    }
};

struct SchedUp {
    int v, G; const char* HN; const char* WUP;
    __device__ __forceinline__ bool next(int i, Unit& u) const {
        const long L = (long)i * G + v; int pm, pn; if (!TileMap{197, 44}.get(L, pm, pn)) return false;
        int s, ti; if (pm < 65) { s = 0; ti = pm; } else { s = 1 + (pm - 65) / 33; ti = (pm - 65) % 33; }
        const int T = seq_len(s); int t0 = 254 * ti - 1; if (t0 > T - 255) t0 = T - 255;
        u.pm = seq_start(s); u.pn = pn; u.kind = 0; u.t0 = t0; u.T = T; u.nt = 32;
        u.A = HN + ((long)u.pm + t0) * 4096; u.B = WUP + (size_t)pn * MiB; return true;
    }
};
struct EpiUp {
    bf16_t* ACT; const float* cw; const float* cb; LAS float* xch;
    __device__ __forceinline__ void operator()(const f32x4 (&acc)[2][2][4][2], const Unit& u, int wr, int wc, int fr, int fq) const {
        const int lane = threadIdx.x & 63;
        const int cin = wc * 32 + 8 * fq;
#pragma unroll
        for (int ai = 0; ai < 2; ++ai) { const int rg = 2 * ai + wr;
#pragma unroll
            for (int bj = 0; bj < 2; ++bj)
#pragma unroll
                for (int n = 0; n < 2; ++n) {
                    if (fr == 0) *(LAS f32x4*)(xch + (rg * 2 + 0) * 256 + bj * 128 + cin + 4 * n) = acc[ai][bj][0][n];
                    if (fr == 15) *(LAS f32x4*)(xch + (rg * 2 + 1) * 256 + bj * 128 + cin + 4 * n) = acc[ai][bj][3][n]; } }
        asm volatile("s_waitcnt lgkmcnt(0)" ::: "memory"); __builtin_amdgcn_s_barrier(); asm volatile("" ::: "memory");
        const int srcR = (lane & 48) | ((lane - 1) & 15), srcL = (lane & 48) | ((lane + 1) & 15);
        const int gc = u.pn * 128 + cin;
#pragma unroll
        for (int n = 0; n < 2; ++n) {
            const int wcol = gc + 4 * n;
            const f32x4 g0 = *(const f32x4*)(cw + wcol), g1 = *(const f32x4*)(cw + 2 * DFF + wcol), g2 = *(const f32x4*)(cw + 4 * DFF + wcol), gb = *(const f32x4*)(cb + wcol);
            const f32x4 v0 = *(const f32x4*)(cw + DFF + wcol), v1 = *(const f32x4*)(cw + 3 * DFF + wcol), v2 = *(const f32x4*)(cw + 5 * DFF + wcol), vb = *(const f32x4*)(cb + DFF + wcol);
#pragma unroll
            for (int ai = 0; ai < 2; ++ai) { const int rg = 2 * ai + wr;
                bf16_t* ap = ACT + ((long)u.pm + u.t0 + 128 * ai + 64 * wr + fr) * DFF + gc + 4 * n;
#pragma unroll
                for (int m = 0; m < 4; ++m) {
                    const int j = 128 * ai + 64 * wr + 16 * m + fr, t = u.t0 + j;
                    f32x4 res;
#pragma unroll
                    for (int bj = 0; bj < 2; ++bj) {
                        const f32x4 cur = acc[ai][bj][m][n];
                        const f32x4 sp = (m > 0 && fr == 15) ? acc[ai][bj][m > 0 ? m - 1 : 0][n] : cur;
                        const f32x4 sn = (m < 3 && fr == 0) ? acc[ai][bj][m < 3 ? m + 1 : 3][n] : cur;
                        f32x4 pv, nv;
#pragma unroll
                        for (int i = 0; i < 4; ++i) { pv[i] = __shfl(sp[i], srcR); nv[i] = __shfl(sn[i], srcL); }
                        if (m == 0) { const f32x4 xprev = rg > 0 ? *(const LAS f32x4*)(xch + ((rg - 1) * 2 + 1) * 256 + bj * 128 + cin + 4 * n) : (f32x4){0.f, 0.f, 0.f, 0.f}; if (fr == 0) pv = xprev; }
                        if (m == 3) { const f32x4 xnext = rg < 3 ? *(const LAS f32x4*)(xch + ((rg + 1) * 2 + 0) * 256 + bj * 128 + cin + 4 * n) : (f32x4){0.f, 0.f, 0.f, 0.f}; if (fr == 15) nv = xnext; }
                        if (t < 1) pv = (f32x4){0.f, 0.f, 0.f, 0.f};
                        if (t >= u.T - 1) nv = (f32x4){0.f, 0.f, 0.f, 0.f};
                        if (bj == 0) { const f32x4 cv = g0 * pv + g1 * cur + g2 * nv + gb; res = (f32x4){cv[0] * sigmoidf_(cv[0]), cv[1] * sigmoidf_(cv[1]), cv[2] * sigmoidf_(cv[2]), cv[3] * sigmoidf_(cv[3])}; }
                        else { const f32x4 cv = v0 * pv + v1 * cur + v2 * nv + vb; res = res * cv; }
                    }
                    if (j >= 1 && j <= 254) { u32x2 w; w.x = cvt_pk_bf16(res[0], res[1]); w.y = cvt_pk_bf16(res[2], res[3]); *(u32x2*)ap = w; }
                    ap += 16 * DFF; asm volatile("" : "+v"(ap) :: "memory");
                }
            }
        }
    }
};

__global__ void __launch_bounds__(NTHR, 2) enc_fwd(Args args) {
    extern __shared__ __attribute__((aligned(16))) unsigned char lds_raw[];
    cg::grid_group grid = cg::this_grid();
    LAS unsigned char* lds = (LAS unsigned char*)lds_raw;
    const int tid = threadIdx.x;
    const int G = gridDim.x, bx = blockIdx.x, vcu = (G % 8 == 0) ? (bx % 8) * (G / 8) + bx / 8 : bx;
    unsigned char* ws = args.ws;
    const int lo = args.ph_lo, hi = args.ph_hi;
#ifndef P2M
#define P2M 7
#endif
#ifndef PH_MASK
#define PH_MASK 0x1ff
#endif
#define IN(k) (((PH_MASK >> (k)) & 1) && lo <= (k) && (k) < hi)
#define SEAM(k) do { if (IN(k) && IN((k) + 1)) grid.sync(); } while (0)

    if (IN(0)) p0_prologue(args, lds, vcu, G);
    SEAM(0);
    if (IN(1)) {
        SchedIn S{vcu, G, (const char*)(ws + WS_H), (const char*)(ws + WS_WIN), (const char*)(ws + WS_MEMN), (const char*)(ws + WS_WKV)};
        EpiIn E{(bf16_t*)(ws + WS_QK), (bf16_t*)(ws + WS_VM), (bf16_t*)args.out, (bf16_t*)(ws + WS_KVM), args.in[6], args.in[7], (const float*)(ws + WS_ROPE), (const float*)(ws + WS_ROPE) + TP * 32};
        pg8::gemm_phase<EpiIn, SchedIn, true>(lds, 2048, S, E);
    }
    SEAM(1);
    if (IN(2)) {
        unsigned* ctl = (unsigned*)(ws + WS_CTL);
        volatile LAS unsigned* jobw = (volatile LAS unsigned*)(lds + LDS_MISC);
        const float lam = ((const float*)ctl)[CW_LAM];
        scan::P sp{(const bf16_t*)args.out, (bf16_t*)(ws + WS_Y), (float*)(ws + WS_BON), args.in[13], args.in[14], args.in[15], args.in[16], args.in[17], args.in[18], args.in[20], args.in[21], args.in[22]};
        for (;;) {
            __syncthreads();
            if (tid == 0) jobw[0] = atomicAdd(ctl + CW_QUEUE, 1u);
            __syncthreads();
            const int jb = (int)jobw[0];
            if (jb >= 160 + 1536 + 768) break;
            if (((P2M) & 1) && jb < 160) {
                int s, r; if (jb < 32) { s = 0; r = jb; } else { s = 1 + (jb - 32) / 32; r = (jb - 32) % 32; }
                scan::job(s, r & 1, r >> 1, sp, (char*)lds_raw);
            } else if (((P2M) & 2) && jb < 160 + 1536) {
                const int a = jb - 160; int s, h, qb;
                if (a < 512) { s = 0; h = a / 64; qb = a % 64; } else { const int b = a - 512; s = 1 + b / 256; h = (b % 256) / 32; qb = b % 32; }
                att::diff_unit(s, h, qb, (bf16_t*)(ws + WS_QK), (const bf16_t*)(ws + WS_VM), lam, (char*)lds_raw);
            } else if ((P2M) & 4) {
                const int a = jb - 160 - 1536; int s, mh, qb;
                if (a < 256) { s = 0; mh = a / 64; qb = a % 64; } else { const int b = a - 256; s = 1 + b / 128; mh = (b % 128) / 32; qb = b % 32; }
                att::mem_unit(s, mh, qb, (bf16_t*)(ws + WS_VM), (const bf16_t*)(ws + WS_KVM), args.in[27], args.in[28], (char*)lds_raw);
            }
        }
    }
    SEAM(2);
    if (IN(3)) p4_post(args, (char*)lds_raw, vcu, G);
    SEAM(3);
    if (IN(4)) {
        SchedMerge S{vcu, G, (const char*)(ws + WS_H), (const char*)(ws + WS_WG), (const char*)(ws + WS_QK), (const char*)(ws + WS_VM), (const char*)(ws + WS_PAR), (const char*)(ws + WS_PM2)};
        unsigned char* scr = (unsigned char*)args.out + (size_t)bx * (384 * 1024);
        EpiMerge E{(u32x4*)scr, (f32x4*)(scr + 128 * 1024), (bf16_t*)(ws + WS_MRG)};
        pg8::gemm_phase<EpiMerge, SchedMerge, true>(lds, 2048, S, E);
    }
    SEAM(4);
    if (IN(5)) {
        SchedSq S{vcu, G, (const char*)(ws + WS_MRG), (const char*)(ws + WS_WO), MiB, MiB, 32};
        EpiWo E{args.in[0], args.in[1], args.out};
        pg8::gemm_phase<EpiWo, SchedSq, true>(lds, 2048, S, E);
    }
    SEAM(5);
    if (IN(6)) {
        const int lane = tid & 63, gw = vcu * 8 + (tid >> 6), NGW = G * 8;
        for (int m = gw; m < NT; m += NGW) rms_row(args.out + (size_t)m * DM, args.in[33], (bf16_t*)(ws + WS_H) + (size_t)m * DM, lane);
    }
    SEAM(6);
    if (IN(7)) {
        SchedUp S{vcu, G, (const char*)(ws + WS_H), (const char*)(ws + WS_WUP)};
        EpiUp E{(bf16_t*)(ws + WS_ACT), args.in[35], args.in[36], (LAS float*)(lds + LDS_XCH)};
        pg8::gemm_phase<EpiUp, SchedUp, true>(lds, 2048, S, E);
    }
    SEAM(7);
    if (IN(8)) {
        SchedSq S{vcu, G, (const char*)(ws + WS_ACT), (const char*)(ws + WS_WDN), (size_t)256 * DFF * 2, (size_t)256 * DFF * 2, 88};
        EpiDown E{args.out};
        pg8::gemm_phase<EpiDown, SchedSq, true>(lds, DFF, S, E);
    }
#undef IN
#undef SEAM
}

#ifndef MK_SPLIT
#define MK_SPLIT 0
#endif
extern "C" void kernel_launch(void* const* d_in, const int* in_sizes, int n_in, void* d_out, int out_size, void* d_ws, size_t ws_size, hipStream_t stream) {
    static int grid = 0;
    if (grid == 0) {
        if (n_in != 38 || out_size != NT * DM || ws_size < WS_END) { fprintf(stderr, "kernel_launch: unexpected shapes n_in %d out %d ws %zu\n", n_in, out_size, ws_size); grid = -1; return; }
        int dev = 0, cus = 0, per_cu = 0;
        hipGetDevice(&dev); hipDeviceGetAttribute(&cus, hipDeviceAttributeMultiprocessorCount, dev);
        if (hipFuncSetAttribute((const void*)enc_fwd, hipFuncAttributeMaxDynamicSharedMemorySize, LDS_BYTES) != hipSuccess) { fprintf(stderr, "kernel_launch: hipFuncSetAttribute failed\n"); grid = -1; return; }
        if (hipOccupancyMaxActiveBlocksPerMultiprocessor(&per_cu, (const void*)enc_fwd, NTHR, LDS_BYTES) != hipSuccess || per_cu < 1) { fprintf(stderr, "kernel_launch: occupancy query failed (%d)\n", per_cu); per_cu = 1; }
        (void)hipGetLastError();
        grid = cus * 1;
    }
    if (grid < 0) return;
    Args a{};
    for (int i = 0; i < 38; ++i) a.in[i] = (const float*)d_in[i];
    a.out = (float*)d_out; a.ws = (unsigned char*)d_ws;
    for (int d = 0; d < 32; ++d) a.inv_rev[d] = pow(10000.0, -(double)d / 32.0) / 6.283185307179586476925286766559;
#if MK_SPLIT
    for (int ph = 0; ph < 9; ++ph) { a.ph_lo = ph; a.ph_hi = ph + 1; void* kargs[] = {&a};
        hipError_t e = hipLaunchCooperativeKernel((const void*)enc_fwd, dim3(grid), dim3(NTHR), kargs, LDS_BYTES, stream);
        if (e != hipSuccess) { fprintf(stderr, "launch %d failed: %s\n", ph, hipGetErrorString(e)); break; } }
#else
    a.ph_lo = 0; a.ph_hi = 9;
    void* kargs[] = {&a};
    hipError_t e = hipLaunchCooperativeKernel((const void*)enc_fwd, dim3(grid), dim3(NTHR), kargs, LDS_BYTES, stream);
    if (e != hipSuccess) fprintf(stderr, "cooperative launch failed: %s (grid %d)\n", hipGetErrorString(e), grid);
#endif
}
```

```cpp
#include <hip/hip_runtime.h>
#include <hip/hip_cooperative_groups.h>
#include <cstdio>
#include <cstdint>
#include <cmath>
namespace cg = cooperative_groups;

#define LAS __attribute__((address_space(3)))
typedef unsigned short bf16_t;
typedef short bf16x8 __attribute__((ext_vector_type(8)));
typedef short s16x4 __attribute__((ext_vector_type(4)));
typedef float f32x2 __attribute__((ext_vector_type(2)));
typedef float f32x4 __attribute__((ext_vector_type(4)));
typedef float f32x16 __attribute__((ext_vector_type(16)));
typedef unsigned u32x2 __attribute__((ext_vector_type(2)));
typedef unsigned u32x4 __attribute__((ext_vector_type(4)));

constexpr int NT = 49152, DM = 2048, TP = 16384, TS = 8192, NSEQ = 5;
constexpr int ZRP = 3584;
constexpr int DFF = 5632;
constexpr int NTHR = 512;
constexpr size_t MiB = 1u << 20;
constexpr size_t WS_CTL = 0, WS_WIN = 1 * MiB, WS_WG = 31 * MiB, WS_WKV = 55 * MiB, WS_PAR = 63 * MiB, WS_PM2 = 71 * MiB, WS_WO = 79 * MiB,
                 WS_WUP = 87 * MiB, WS_WDN = 131 * MiB, WS_ROPE = 153 * MiB, WS_MEMN = 157 * MiB, WS_KVM = 162 * MiB, WS_BON = 167 * MiB,
                 WS_H = 176 * MiB, WS_QK = 370 * MiB, WS_VM = 562 * MiB, WS_Y = 754 * MiB, WS_ACT = 370 * MiB, WS_MRG = 754 * MiB, WS_END = 946 * MiB;
constexpr int CW_QUEUE = 64, CW_LAM = 128;
constexpr int LDS_XCH = 131072, LDS_MISC = 131072 + 8192, LDS_BYTES = 131072 + 8192 + 256;

__device__ __forceinline__ int seq_start(int s) { return s == 0 ? 0 : TP + (s - 1) * TS; }
__device__ __forceinline__ int seq_len(int s) { return s == 0 ? TP : TS; }
__device__ __forceinline__ int tok_pos(int tok) { return tok < TP ? tok : ((tok - TP) & (TS - 1)); }

__device__ __forceinline__ unsigned cvt_pk_bf16(float lo, float hi) { unsigned r; asm volatile("v_cvt_pk_bf16_f32 %0, %1, %2" : "=v"(r) : "v"(lo), "v"(hi)); return r; }
__device__ __forceinline__ float bflo(unsigned w) { return __uint_as_float(w << 16); }
__device__ __forceinline__ float bfhi(unsigned w) { return __uint_as_float(w & 0xffff0000u); }
__device__ __forceinline__ float bf1(bf16_t b) { return __uint_as_float((unsigned)b << 16); }
__device__ __forceinline__ float sigmoidf_(float x) { return 1.f / (1.f + __expf(-x)); }
__device__ __forceinline__ float wave_sum(float v) {
#pragma unroll
    for (int o = 1; o < 64; o <<= 1) v += __shfl_xor(v, o);
    return v;
}

namespace pg8 {
constexpr int BM = 256, BK = 64, HALF = 128, HTB = HALF * BK * 2, STAGE_BYTES = 8 * HTB;
__host__ __device__ __forceinline__ int lds_byte(int r, int c) { const int st = (r >> 4) * 2 + (c >> 5), rr = r & 15, cc = c & 31, ob = rr * 64 + cc * 2; return st * 1024 + (ob ^ (((ob >> 9) & 1) << 5)); }
__host__ __device__ __forceinline__ void stage_rc(int b, int& R, int& C) { const int st = b / 1024, sb = b % 1024, swz = sb ^ (((sb >> 9) & 1) << 5); R = (st >> 1) * 16 + swz / 64; C = (st & 1) * 32 + (swz % 64) / 2; }
__host__ __device__ __forceinline__ int perm32(int rho) { const int n = rho >> 4, i = rho & 15; return 8 * (i >> 2) + 4 * n + (i & 3); }

struct Unit { const char* A; const char* B; int nt, pm, pn, kind, t0, T; };

template <class Epi, class Sched, bool ALIGN_EPI>
__device__ __forceinline__ void gemm_phase(LAS unsigned char* lds, const int ld, const Sched& S, const Epi& E) {
    const int tid = threadIdx.x, wid = __builtin_amdgcn_readfirstlane(tid >> 6), lane = tid & 63, wr = wid >> 2, wc = wid & 3, fr = lane & 15, fq = lane >> 4;
    unsigned voffA[2], voffB[2];
#pragma unroll
    for (int i = 0; i < 2; ++i) { int R, C; stage_rc(tid * 16 + i * 8192, R, C); const int Rb = (R & ~31) + perm32(R & 31);
        voffA[i] = (unsigned)(R * ld + C) * 2u; voffB[i] = (unsigned)(Rb * ld + C) * 2u; }
    const size_t kstep = (size_t)(BK * 2);
    const size_t hstep = (size_t)HALF * ld * 2;
    const unsigned ldsw = (unsigned)wid * 1024u;
    const int aoff = lds_byte(wr * 64 + fr, fq * 8), boff = lds_byte(wc * 32 + fr, fq * 8);
#define PG8_SA(b, h) (((b) * 2 + (h)) * HTB)
#define PG8_SB(b, h) ((4 + (b) * 2 + (h)) * HTB)
#define PG8_STAGE(bufoff, gbase, voff) do { _Pragma("unroll") for (int _i = 0; _i < 2; ++_i) \
        __builtin_amdgcn_global_load_lds((const unsigned*)((const char*)(gbase) + (voff)[_i]), (LAS unsigned*)(lds + (bufoff) + ldsw + _i * 8192), 16, 0, 0); } while (0)
#define PG8_LDA(dst, b, h) do { _Pragma("unroll") for (int m = 0; m < 4; ++m) _Pragma("unroll") for (int k = 0; k < 2; ++k) dst[m][k] = *(const LAS bf16x8*)(lds + PG8_SA(b, h) + aoff + m * 2048 + k * 1024); } while (0)
#define PG8_LDB(dst, b, h) do { _Pragma("unroll") for (int n = 0; n < 2; ++n) _Pragma("unroll") for (int k = 0; k < 2; ++k) dst[n][k] = *(const LAS bf16x8*)(lds + PG8_SB(b, h) + boff + n * 2048 + k * 1024); } while (0)
#define PG8_MMA(ai, bj, At, Bt) do { __builtin_amdgcn_s_setprio(1); _Pragma("unroll") for (int m = 0; m < 4; ++m) _Pragma("unroll") for (int n = 0; n < 2; ++n) _Pragma("unroll") for (int k = 0; k < 2; ++k) \
        acc[ai][bj][m][n] = __builtin_amdgcn_mfma_f32_16x16x32_bf16(Bt[n][k], At[m][k], acc[ai][bj][m][n], 0, 0, 0); __builtin_amdgcn_s_setprio(0); } while (0)
#define PG8_WAIT_V(n) asm volatile("s_waitcnt vmcnt(" #n ")" ::: "memory")
#define PG8_WAIT_L(n) asm volatile("s_waitcnt lgkmcnt(" #n ")" ::: "memory")
#define PG8_BAR __builtin_amdgcn_s_barrier()
#define PG8_SCHED __builtin_amdgcn_sched_barrier(0)
    Unit cur, nxt; int ui = 0;
    if (!S.next(0, cur)) return;
    f32x4 acc[2][2][4][2];
#pragma unroll
    for (int a = 0; a < 2; ++a)
#pragma unroll
        for (int b = 0; b < 2; ++b)
#pragma unroll
            for (int m = 0; m < 4; ++m)
#pragma unroll
                for (int n = 0; n < 2; ++n) acc[a][b][m][n] = (f32x4){0.f, 0.f, 0.f, 0.f};
    bf16x8 At[4][2], B0[2][2], B1[2][2];
    const char* cA = cur.A; const char* cB = cur.B;
    PG8_STAGE(PG8_SB(0, 0), cB, voffB); PG8_STAGE(PG8_SB(0, 1), cB + hstep, voffB); PG8_STAGE(PG8_SA(0, 0), cA, voffA); PG8_STAGE(PG8_SA(0, 1), cA + hstep, voffA);
    if (wr == 1) PG8_BAR;
    PG8_WAIT_V(2); PG8_BAR;
    PG8_STAGE(PG8_SB(1, 0), cB + kstep, voffB); PG8_STAGE(PG8_SA(1, 0), cA + kstep, voffA); PG8_STAGE(PG8_SB(1, 1), cB + hstep + kstep, voffB);
    PG8_WAIT_V(6); PG8_BAR;
    for (;;) {
        const bool has_next = S.next(ui + 1, nxt);
        const char* nA = has_next ? nxt.A : cA; const char* nB = has_next ? nxt.B : cB;
        const int nt = cur.nt;
        for (int t = 0; t < nt; t += 2) {
            const bool last = (t == nt - 2);
            const char* a1 = cA + (size_t)(t + 1) * kstep;
            const char* a2 = last ? nA : cA + (size_t)(t + 2) * kstep; const char* b2 = last ? nB : cB + (size_t)(t + 2) * kstep;
            const char* a3 = a2 + kstep; const char* b3 = b2 + kstep;
            PG8_LDB(B0, 0, 0); PG8_LDB(B1, 0, 1); PG8_SCHED; PG8_LDA(At, 0, 0); PG8_STAGE(PG8_SA(1, 1), a1 + hstep, voffA);
            PG8_WAIT_V(8); PG8_WAIT_L(0); PG8_BAR; PG8_MMA(0, 0, At, B0); PG8_MMA(0, 1, At, B1); PG8_BAR; PG8_SCHED;
            PG8_LDA(At, 0, 1); PG8_STAGE(PG8_SB(0, 0), b2, voffB); PG8_STAGE(PG8_SB(0, 1), b2 + hstep, voffB); PG8_STAGE(PG8_SA(0, 0), a2, voffA);
            PG8_WAIT_V(8); PG8_WAIT_L(0); PG8_BAR; PG8_MMA(1, 0, At, B0); PG8_MMA(1, 1, At, B1); PG8_BAR; PG8_SCHED;
            PG8_LDB(B0, 1, 0); PG8_LDB(B1, 1, 1); PG8_SCHED; PG8_LDA(At, 1, 0); PG8_STAGE(PG8_SA(0, 1), a2 + hstep, voffA);
            PG8_WAIT_V(8); PG8_WAIT_L(0); PG8_BAR; PG8_MMA(0, 0, At, B0); PG8_MMA(0, 1, At, B1); PG8_BAR; PG8_SCHED;
            PG8_LDA(At, 1, 1); PG8_STAGE(PG8_SB(1, 0), b3, voffB); PG8_STAGE(PG8_SB(1, 1), b3 + hstep, voffB); PG8_STAGE(PG8_SA(1, 0), a3, voffA);
            PG8_WAIT_V(8); PG8_WAIT_L(0); PG8_BAR; PG8_MMA(1, 0, At, B0); PG8_MMA(1, 1, At, B1); PG8_BAR; PG8_SCHED;
        }
        if constexpr (ALIGN_EPI) { if (wr == 0) PG8_BAR; }
        E(acc, cur, wr, wc, fr, fq);
        if (!has_next) break;
#pragma unroll
        for (int a = 0; a < 2; ++a)
#pragma unroll
            for (int b = 0; b < 2; ++b)
#pragma unroll
                for (int m = 0; m < 4; ++m)
#pragma unroll
                    for (int n = 0; n < 2; ++n) acc[a][b][m][n] = (f32x4){0.f, 0.f, 0.f, 0.f};
        cur = nxt; cA = nA; cB = nB; ++ui;
        if constexpr (ALIGN_EPI) { if (wr == 1) PG8_BAR; }
    }
    PG8_WAIT_V(0);
    if constexpr (!ALIGN_EPI) { if (wr == 0) PG8_BAR; }
    PG8_BAR;
#undef PG8_SA
#undef PG8_SB
#undef PG8_STAGE
#undef PG8_LDA
#undef PG8_LDB
#undef PG8_MMA
#undef PG8_WAIT_V
#undef PG8_WAIT_L
#undef PG8_BAR
#undef PG8_SCHED
}
}
using pg8::Unit;

struct TileMap {
    int nM, nN;
    __device__ __forceinline__ bool get(long L, int& pm, int& pn) const {
        if (L >= (long)nM * nN) return false;
        const int nig = 16 * nN, gid = (int)(L / nig), fm = gid * 16, gsz = (nM - fm) < 16 ? (nM - fm) : 16, r = (int)(L % nig);
        pm = fm + r % gsz; pn = r / gsz; return true;
    }
};

struct Args {
    const float* in[38];
    float* out; unsigned char* ws;
    double inv_rev[32];
    int ph_lo, ph_hi;
};

__device__ __forceinline__ void tr_item(const float* W, int N, int src_n0, bf16_t* WT, size_t ldw, int koff, int r0, int k0, LAS float* scr, int lane) {
    if (src_n0 >= 0) {
#pragma unroll 8
        for (int i = 0; i < 32; ++i) { const int kk = 2 * i + (lane >> 5); scr[kk * 33 + (lane & 31)] = W[(size_t)(k0 + kk) * N + src_n0 + (lane & 31)]; }
    } else {
#pragma unroll 8
        for (int i = 0; i < 32; ++i) { const int kk = 2 * i + (lane >> 5); scr[kk * 33 + (lane & 31)] = 0.f; }
    }
    asm volatile("s_waitcnt lgkmcnt(0)" ::: "memory");
    const int c = lane & 7;
#pragma unroll
    for (int j = 0; j < 4; ++j) { const int n = (lane >> 3) + 8 * j; const LAS float* s = scr + (8 * c) * 33 + n;
        u32x4 o; o.x = cvt_pk_bf16(s[0 * 33], s[1 * 33]); o.y = cvt_pk_bf16(s[2 * 33], s[3 * 33]); o.z = cvt_pk_bf16(s[4 * 33], s[5 * 33]); o.w = cvt_pk_bf16(s[6 * 33], s[7 * 33]);
        *(u32x4*)(WT + (size_t)(r0 + n) * ldw + koff + k0 + 8 * c) = o; }
    asm volatile("s_waitcnt lgkmcnt(0)" ::: "memory");
}
__device__ __forceinline__ void rms_row(const float* xrow, const float* g, bf16_t* orow, int lane) {
    f32x4 v[8]; float s = 0.f;
#pragma unroll
    for (int j = 0; j < 8; ++j) { v[j] = ((const f32x4*)xrow)[64 * j + lane]; s += (v[j].x * v[j].x + v[j].y * v[j].y) + (v[j].z * v[j].z + v[j].w * v[j].w); }
    const float rstd = rsqrtf(wave_sum(s) * (1.f / DM) + 1e-6f);
#pragma unroll
    for (int j = 0; j < 8; ++j) { const f32x4 gg = ((const f32x4*)g)[64 * j + lane];
        u32x2 w; w.x = cvt_pk_bf16(v[j].x * rstd * gg.x, v[j].y * rstd * gg.y); w.y = cvt_pk_bf16(v[j].z * rstd * gg.z, v[j].w * rstd * gg.w);
        ((u32x2*)orow)[64 * j + lane] = w; }
}

__device__ __forceinline__ void p0_prologue(const Args& a, LAS unsigned char* lds, int vcu, int G) {
    const int tid = threadIdx.x, lane = tid & 63, wave = tid >> 6;
    unsigned char* ws = a.ws;
    LAS float* scr = (LAS float*)(lds + wave * 16384);
    const int gw = vcu * 8 + wave, NGW = G * 8;
    constexpr int I0 = 32 * 240, I1 = 32 * 192, I2 = 32 * 64, I3 = 16 * 64, I6 = 32 * 64, I7 = 32 * 352, I8 = 88 * 64;
    constexpr int NITEMS = I0 + I1 + I2 + 3 * I3 + I6 + I7 + I8;
    for (int it = gw; it < NITEMS; it += NGW) {
        int r = it;
        if (r < I0) { const int kb = r / 240, nb = r % 240, r0 = nb * 32; int src;
            if (r0 < 2048) { const int tile = r0 >> 8, cp = r0 & 255, h = cp >> 7, g = (cp & 127) >> 5; src = tile * 256 + 64 * g + 32 * h; }
            else if (r0 < 6560) src = r0;
            else if (r0 < 6656) src = -1;
            else src = 6560 + (r0 - 6656);
            tr_item(a.in[5], 13728, src, (bf16_t*)(ws + WS_WIN), 2048, 0, r0, kb * 64, scr, lane); continue; } r -= I0;
        if (r < I1) { const int kb = r / 192, nb = r % 192; tr_item(a.in[5], 13728, 7584 + nb * 32, (bf16_t*)(ws + WS_WG), 2048, 0, nb * 32, kb * 64, scr, lane); continue; } r -= I1;
        if (r < I2) { const int kb = r / 64, nb = r % 64; tr_item(a.in[26], 2048, nb * 32, (bf16_t*)(ws + WS_WKV), 2048, 0, nb * 32, kb * 64, scr, lane); continue; } r -= I2;
        if (r < I3) { const int kb = r / 64, nb = r % 64; tr_item(a.in[29], 2048, nb * 32, (bf16_t*)(ws + WS_PAR), 2048, 0, nb * 32, kb * 64, scr, lane); continue; } r -= I3;
        if (r < I3) { const int kb = r / 64, nb = r % 64; tr_item(a.in[30], 2048, nb * 32, (bf16_t*)(ws + WS_PAR), 2048, 1024, nb * 32, kb * 64, scr, lane); continue; } r -= I3;
        if (r < I3) { const int kb = r / 64, nb = r % 64; tr_item(a.in[31], 2048, nb * 32, (bf16_t*)(ws + WS_PM2), 2048, 0, nb * 32, kb * 64, scr, lane); continue; } r -= I3;
        if (r < I6) { const int kb = r / 64, nb = r % 64; tr_item(a.in[32], 2048, nb * 32, (bf16_t*)(ws + WS_WO), 2048, 0, nb * 32, kb * 64, scr, lane); continue; } r -= I6;
        if (r < I7) { const int kb = r / 352, nb = r % 352, r0 = nb * 32, tile = r0 >> 8, bj = (r0 & 255) >> 7, j = r0 & 127;
            tr_item(a.in[34], 2 * DFF, bj * DFF + 128 * tile + j, (bf16_t*)(ws + WS_WUP), 2048, 0, r0, kb * 64, scr, lane); continue; } r -= I7;
        { const int kb = r / 64, nb = r % 64; tr_item(a.in[37], 2048, nb * 32, (bf16_t*)(ws + WS_WDN), DFF, 0, nb * 32, kb * 64, scr, lane); }
    }
    for (int m = gw; m < NT + 1280; m += NGW) {
        if (m < NT) { const float* xr = m < TP ? a.in[0] + (size_t)m * DM : a.in[1] + (size_t)(m - TP) * DM; rms_row(xr, a.in[4], (bf16_t*)(ws + WS_H) + (size_t)m * DM, lane); }
        else { const int j = m - NT; const float* xr = j < 256 ? a.in[2] + (size_t)j * DM : a.in[3] + (size_t)(j - 256) * DM; rms_row(xr, a.in[25], (bf16_t*)(ws + WS_MEMN) + (size_t)j * DM, lane); }
    }
    { float* rc = (float*)(ws + WS_ROPE); float* rs = rc + TP * 32;
      for (int e = (vcu * NTHR + tid); e < TP * 32; e += G * NTHR) { const int t = e >> 5, d = e & 31; double rev = (double)t * a.inv_rev[d]; rev -= rint(rev); const float rf = (float)rev;
          rc[e] = __builtin_amdgcn_cosf(rf); rs[e] = __builtin_amdgcn_sinf(rf); } }
    if (blockIdx.x == 0) {
        unsigned* ctl = (unsigned*)(ws + WS_CTL);
        if (tid < 64) {
            if (tid == 0) { ctl[CW_QUEUE] = 0u; ctl[256] = 0u; ctl[257] = 0u; }
            const float s1 = wave_sum(a.in[8][tid] * a.in[9][tid]), s2 = wave_sum(a.in[10][tid] * a.in[11][tid]);
            if (tid == 0) ((float*)ctl)[CW_LAM] = __expf(s1) - __expf(s2) + 0.2f;
        }
    }
}

struct SchedIn {
    int v, G; const char* H; const char* WIN; const char* MEMN; const char* WKV;
    __device__ __forceinline__ bool next(int i, Unit& u) const {
        long L = (long)i * G + v; int pm, pn;
        if (L < 5760) { TileMap{192, 30}.get(L, pm, pn); u.A = H + (size_t)pm * MiB; u.B = WIN + (size_t)pn * MiB; u.nt = 32; u.pm = pm; u.pn = pn; u.kind = 0; u.t0 = 0; u.T = 0; return true; }
        L -= 5760; if (L < 40) { pm = (int)(L % 5); pn = (int)(L / 5); u.A = MEMN + (size_t)pm * MiB; u.B = WKV + (size_t)pn * MiB; u.nt = 32; u.pm = pm; u.pn = pn; u.kind = 1; u.t0 = 0; u.T = 0; return true; }
        return false;
    }
};
struct EpiIn {
    bf16_t* QK; bf16_t* VM; bf16_t* ZR; bf16_t* KVM; const float* qn; const float* kn; const float* rc; const float* rs;
    __device__ __forceinline__ void plain(const f32x4 (&acc)[2][2][4][2], bf16_t* base, size_t ldc, int row0, int col0) const {
#pragma unroll
        for (int ai = 0; ai < 2; ++ai)
#pragma unroll
            for (int m = 0; m < 4; ++m) { bf16_t* rowp = base + (size_t)(row0 + ai * 128 + m * 16) * ldc + col0;
#pragma unroll
                for (int bj = 0; bj < 2; ++bj) { const f32x4 v0 = acc[ai][bj][m][0], v1 = acc[ai][bj][m][1];
                    u32x4 w; w.x = cvt_pk_bf16(v0[0], v0[1]); w.y = cvt_pk_bf16(v0[2], v0[3]); w.z = cvt_pk_bf16(v1[0], v1[1]); w.w = cvt_pk_bf16(v1[2], v1[3]);
                    *(u32x4*)(rowp + bj * 128) = w; } }
    }
    __device__ __forceinline__ void operator()(const f32x4 (&acc)[2][2][4][2], const Unit& u, int wr, int wc, int fr, int fq) const {
        const int row0 = u.pm * 256 + wr * 64 + fr, cin = wc * 32 + 8 * fq;
        if (u.kind == 1) { plain(acc, KVM, 2048, row0, u.pn * 256 + cin); return; }
        const int pn = u.pn;
        if (pn < 8) {
            const bool isq = pn < 4; const float* nw = isq ? qn : kn;
            const int Gq = (pn & 3) * 4 + wc, d0 = 8 * fq;
            const float qs = isq ? 0.125f * 1.4426950408889634f : 1.f;
            const f32x4 w1a = *(const f32x4*)(nw + d0), w1b = *(const f32x4*)(nw + d0 + 4), w2a = *(const f32x4*)(nw + 32 + d0), w2b = *(const f32x4*)(nw + 36 + d0);
            bf16_t* dst = QK + (isq ? 0 : 1024) + Gq * 64 + d0;
#pragma unroll
            for (int ai = 0; ai < 2; ++ai)
#pragma unroll
                for (int m = 0; m < 4; ++m) {
                    const int row = row0 + ai * 128 + m * 16, t = tok_pos(row);
                    const f32x4 xa = acc[ai][0][m][0], xb = acc[ai][0][m][1], ya = acc[ai][1][m][0], yb = acc[ai][1][m][1];
                    float ss = (xa[0] * xa[0] + xa[1] * xa[1]) + (xa[2] * xa[2] + xa[3] * xa[3]) + (xb[0] * xb[0] + xb[1] * xb[1]) + (xb[2] * xb[2] + xb[3] * xb[3])
                             + (ya[0] * ya[0] + ya[1] * ya[1]) + (ya[2] * ya[2] + ya[3] * ya[3]) + (yb[0] * yb[0] + yb[1] * yb[1]) + (yb[2] * yb[2] + yb[3] * yb[3]);
                    ss += __shfl_xor(ss, 16); ss += __shfl_xor(ss, 32);
                    const float rstd = rsqrtf(ss * (1.f / 64.f) + 1e-6f);
                    const f32x4 ca = *(const f32x4*)(rc + t * 32 + d0), cb = *(const f32x4*)(rc + t * 32 + d0 + 4), sa = *(const f32x4*)(rs + t * 32 + d0), sb = *(const f32x4*)(rs + t * 32 + d0 + 4);
                    const f32x4 x1a = xa * rstd * w1a, x1b = xb * rstd * w1b, x2a = ya * rstd * w2a, x2b = yb * rstd * w2b;
                    const f32x4 o1a = (x1a * ca - x2a * sa) * qs, o1b = (x1b * cb - x2b * sb) * qs, o2a = (x2a * ca + x1a * sa) * qs, o2b = (x2b * cb + x1b * sb) * qs;
                    u32x4 w; w.x = cvt_pk_bf16(o1a[0], o1a[1]); w.y = cvt_pk_bf16(o1a[2], o1a[3]); w.z = cvt_pk_bf16(o1b[0], o1b[1]); w.w = cvt_pk_bf16(o1b[2], o1b[3]);
                    *(u32x4*)(dst + (size_t)row * 2048) = w;
                    w.x = cvt_pk_bf16(o2a[0], o2a[1]); w.y = cvt_pk_bf16(o2a[2], o2a[3]); w.z = cvt_pk_bf16(o2b[0], o2b[1]); w.w = cvt_pk_bf16(o2b[2], o2b[3]);
                    *(u32x4*)(dst + (size_t)row * 2048 + 32) = w;
                }
        } else if (pn < 12) plain(acc, VM, 2048, row0, (pn - 8) * 256 + cin);
        else if (pn < 26) plain(acc, ZR, ZRP, row0, (pn - 12) * 256 + cin);
        else plain(acc, VM, 2048, row0, 1024 + (pn - 26) * 256 + cin);
    }
};

namespace att {
constexpr int SHM_V = 16384, SHM_K = 8192;
constexpr int OFF_V = 0, OFF_K = 32768, OFF_WS = 49152, OFF_STASH = 51200;
#define KSWZ64(row, colB) ((row) * 128 + ((colB) ^ (((row) & 7) << 4)))
#define SBAR() __builtin_amdgcn_sched_barrier(0)
__device__ __forceinline__ int crow(int r, int hi) { return (r & 3) + 8 * (r >> 2) + 4 * hi; }
constexpr float THRL = 8.f;
__device__ __forceinline__ void partialSM(f32x16& p0, f32x16& p1, float& m_reg, float& alpha) {
    float pmax = p0[0];
#pragma unroll
    for (int r = 1; r < 16; ++r) pmax = fmaxf(pmax, p0[r]);
#pragma unroll
    for (int r = 0; r < 16; ++r) pmax = fmaxf(pmax, p1[r]);
    { auto rr = __builtin_amdgcn_permlane32_swap(__float_as_uint(pmax), __float_as_uint(pmax), false, false);
      pmax = fmaxf(__uint_as_float(rr[0]), __uint_as_float(rr[1])); }
    float mn;
    if (__builtin_expect(__all(pmax - m_reg <= THRL), 1)) { mn = m_reg; alpha = 1.f; }
    else { mn = fmaxf(m_reg, pmax); alpha = __builtin_amdgcn_exp2f(m_reg - mn); m_reg = mn; }
#pragma unroll
    for (int r = 0; r < 16; ++r) p0[r] -= mn;
#pragma unroll
    for (int r = 0; r < 16; ++r) p1[r] -= mn;
#pragma unroll
    for (int r = 0; r < 16; ++r) p0[r] = __builtin_amdgcn_exp2f(p0[r]);
}
__device__ __forceinline__ void finishSM(f32x16& p0, f32x16& p1, float alpha, float& l_reg, bf16x8& pa0, bf16x8& pa1, bf16x8& pa2, bf16x8& pa3) {
#pragma unroll
    for (int r = 0; r < 16; ++r) p1[r] = __builtin_amdgcn_exp2f(p1[r]);
    float ps = 0;
#pragma unroll
    for (int r = 0; r < 16; ++r) ps += p0[r];
#pragma unroll
    for (int r = 0; r < 16; ++r) ps += p1[r];
    { auto rr = __builtin_amdgcn_permlane32_swap(__float_as_uint(ps), __float_as_uint(ps), false, false);
      ps = __uint_as_float(rr[0]) + __uint_as_float(rr[1]); }
    l_reg = l_reg * alpha + ps;
#define PK4(P, BASE, OUT) do { unsigned a0 = cvt_pk_bf16(P[BASE + 0], P[BASE + 1]), a1 = cvt_pk_bf16(P[BASE + 2], P[BASE + 3]);   \
    unsigned b0 = cvt_pk_bf16(P[BASE + 4], P[BASE + 5]), b1 = cvt_pk_bf16(P[BASE + 6], P[BASE + 7]);                              \
    auto r0 = __builtin_amdgcn_permlane32_swap(a0, b0, false, false); auto r1 = __builtin_amdgcn_permlane32_swap(a1, b1, false, false); \
    u32x4 w = {r0[0], r1[0], r0[1], r1[1]}; OUT = *reinterpret_cast<bf16x8*>(&w); } while (0)
    PK4(p0, 0, pa0); PK4(p0, 8, pa1); PK4(p1, 0, pa2); PK4(p1, 8, pa3);
#undef PK4
}
__device__ __forceinline__ void qkt64(f32x16& p0, f32x16& p1, const char* Ks, const bf16x8* qr, int r32, int hi) {
#pragma unroll
    for (int d0 = 0; d0 < 4; ++d0) { const int cb = (d0 * 16 + hi * 8) * 2;
        const bf16x8 b0 = *reinterpret_cast<const bf16x8*>(Ks + KSWZ64(r32, cb));
        const bf16x8 b1 = *reinterpret_cast<const bf16x8*>(Ks + KSWZ64(32 + r32, cb));
        p0 = __builtin_amdgcn_mfma_f32_32x32x16_bf16(b0, qr[d0], p0, 0, 0, 0);
        p1 = __builtin_amdgcn_mfma_f32_32x32x16_bf16(b1, qr[d0], p1, 0, 0, 0); }
}
__device__ __forceinline__ int v_st(int k, int c) { const int kk = (k & ~0xC) | ((k & 4) << 1) | ((k & 8) >> 1); return ((kk >> 3) * 4 + (c >> 5)) * 512 + ((kk & 7) * 32 + (c & 31)) * 2; }
__device__ __forceinline__ int v_rd_base(int lane) { return ((lane & 3) << 3) | (((lane >> 2) & 3) << 6) | (((lane >> 4) & 1) << 5) | (((lane >> 5) & 1) << 8); }
constexpr int v_rd_off(int d0, int ks, int half) { return d0 * 512 + ks * 4096 + half * 2048; }
template <int OFF> __device__ __forceinline__ s16x4 tr_read(int vb) {
    s16x4 r; asm volatile("ds_read_b64_tr_b16 %0, %1 offset:%2" : "=&v"(r) : "v"(vb), "i"(OFF) : "memory"); return r;
}
template <int D0> __device__ __forceinline__ void pv_one(f32x16& od, int vb, bf16x8 pa0, bf16x8 pa1, bf16x8 pa2, bf16x8 pa3) {
    const s16x4 l0 = tr_read<v_rd_off(D0, 0, 0)>(vb), h0 = tr_read<v_rd_off(D0, 0, 1)>(vb), l1 = tr_read<v_rd_off(D0, 1, 0)>(vb), h1 = tr_read<v_rd_off(D0, 1, 1)>(vb);
    const s16x4 l2 = tr_read<v_rd_off(D0, 2, 0)>(vb), h2 = tr_read<v_rd_off(D0, 2, 1)>(vb), l3 = tr_read<v_rd_off(D0, 3, 0)>(vb), h3 = tr_read<v_rd_off(D0, 3, 1)>(vb);
    asm volatile("s_waitcnt lgkmcnt(0)" ::: "memory"); SBAR();
#define PK(L, H) (bf16x8){L[0], L[1], L[2], L[3], H[0], H[1], H[2], H[3]}
    od = __builtin_amdgcn_mfma_f32_32x32x16_bf16(pa0, PK(l0, h0), od, 0, 0, 0);
    od = __builtin_amdgcn_mfma_f32_32x32x16_bf16(pa1, PK(l1, h1), od, 0, 0, 0);
    od = __builtin_amdgcn_mfma_f32_32x32x16_bf16(pa2, PK(l2, h2), od, 0, 0, 0);
    od = __builtin_amdgcn_mfma_f32_32x32x16_bf16(pa3, PK(l3, h3), od, 0, 0, 0);
#undef PK
}
__device__ __forceinline__ void pv_d0(f32x16* o, int vb, bf16x8 pa0, bf16x8 pa1, bf16x8 pa2, bf16x8 pa3) {
    pv_one<0>(o[0], vb, pa0, pa1, pa2, pa3); pv_one<1>(o[1], vb, pa0, pa1, pa2, pa3); pv_one<2>(o[2], vb, pa0, pa1, pa2, pa3); pv_one<3>(o[3], vb, pa0, pa1, pa2, pa3);
}

__device__ __forceinline__ void stash_store(const unsigned* stash, bf16_t* Ow, int ldo, int lane) {
#pragma unroll
    for (int i = 0; i < 8; ++i) { const int q = i * 64 + lane, rl = q >> 4, c8 = (q & 15) * 8, hh = (rl >> 2) & 1, r = (rl & 3) + 4 * (rl >> 3), d0 = c8 >> 5, cc = c8 & 31;
        const unsigned* sp = stash + (d0 * 8 + (r >> 1)) * 64 + hh * 32 + cc; const u32x4 a = *(const u32x4*)sp, b = *(const u32x4*)(sp + 4);
        u32x4 w;
        if (r & 1) { w.x = (a.x >> 16) | (a.y & 0xffff0000u); w.y = (a.z >> 16) | (a.w & 0xffff0000u); w.z = (b.x >> 16) | (b.y & 0xffff0000u); w.w = (b.z >> 16) | (b.w & 0xffff0000u); }
        else { w.x = (a.x & 0xffffu) | (a.y << 16); w.y = (a.z & 0xffffu) | (a.w << 16); w.z = (b.x & 0xffffu) | (b.y << 16); w.w = (b.z & 0xffffu) | (b.w << 16); }
        *(u32x4*)(Ow + (size_t)rl * ldo + c8) = w; }
}

__device__ __forceinline__ void diff_unit(int s, int h, int qb, bf16_t* QK, const bf16_t* VM, float lam, char* lds) {
    constexpr int LDK = 2048;
    int tid = threadIdx.x; asm volatile("" : "+v"(tid));
    const int wid = __builtin_amdgcn_readfirstlane(tid >> 6), lane = tid & 63, r32 = lane & 31, hi = lane >> 5;
    const int tok0 = seq_start(s), T = seq_len(s), NTL = T / 64;
    char* V_lds = lds + OFF_V; char* K_lds = lds + OFF_K;
    float* wsf = (float*)(lds + OFF_WS) + wid * 64; float* li_l = wsf; float* al_l = wsf + 32;
    unsigned* stash = (unsigned*)(lds + OFF_STASH) + wid * 2048;
    const int sr = tid >> 4, sc = (tid & 15) * 8, vst0 = v_st(sr, sc), vst1 = v_st(32 + sr, sc);
    const int kr = tid >> 3, kc = (tid & 7) * 8, kst = KSWZ64(kr, kc * 2);
    const int vb0 = (int)(uintptr_t)V_lds + v_rd_base(lane);
    const bf16_t* Vh = VM + (size_t)tok0 * LDK + h * 128;
    const size_t qrow = (size_t)(tok0 + qb * 256 + wid * 32);
#pragma unroll 1
    for (int c = 0; c < 2; ++c) {
        const bf16_t* Kh = QK + (size_t)tok0 * LDK + 1024 + h * 128 + c * 64;
        const bf16_t* Qw = QK + (qrow + r32) * LDK + h * 128 + c * 64 + hi * 8;
        bf16x8 qr[4];
#pragma unroll
        for (int d0 = 0; d0 < 4; ++d0) qr[d0] = *reinterpret_cast<const bf16x8*>(Qw + d0 * 16);
        float m_reg = -1e30f, l_reg = 0; f32x16 o[4] = {};
        struct { bf16x8 vs0, vs1, ks0; } sr_[2];
#define SLOAD(i, k0) do { sr_[i].vs0 = *reinterpret_cast<const bf16x8*>(&Vh[(size_t)((k0) + sr) * LDK + sc]); sr_[i].vs1 = *reinterpret_cast<const bf16x8*>(&Vh[(size_t)((k0) + 32 + sr) * LDK + sc]); \
    sr_[i].ks0 = *reinterpret_cast<const bf16x8*>(&Kh[(size_t)((k0) + kr) * LDK + kc]); } while (0)
#define SWRITE(b, i) do { *(bf16x8*)(V_lds + (b) * SHM_V + vst0) = sr_[i].vs0; *(bf16x8*)(V_lds + (b) * SHM_V + vst1) = sr_[i].vs1; *(bf16x8*)(K_lds + (b) * SHM_K + kst) = sr_[i].ks0; } while (0)
#define SWAIT() asm volatile("s_waitcnt vmcnt(3)" ::: "memory")
#define RESC(a) do { if (__any((a) < 1.f)) { if (hi == 0) al_l[r32] = (a); asm volatile("s_waitcnt lgkmcnt(0)" ::: "memory"); \
    _Pragma("unroll") for (int d = 0; d < 4; ++d) _Pragma("unroll") for (int r = 0; r < 16; ++r) o[d][r] *= al_l[crow(r, hi)]; } } while (0)
        f32x16 pA0, pA1, pB0, pB1; float alA, alB; bf16x8 pa0, pa1, pa2, pa3;
        SLOAD(0, 0); asm volatile("s_waitcnt vmcnt(0)" ::: "memory"); SWRITE(0, 0); __syncthreads();
        pA0 = f32x16{}; pA1 = f32x16{}; qkt64(pA0, pA1, K_lds, qr, r32, hi); partialSM(pA0, pA1, m_reg, alA);
        SLOAD(1, 64); if (2 < NTL) SLOAD(0, 128);
        SWAIT(); SWRITE(1, 1); __syncthreads();
        for (int j = 1; j + 1 < NTL; j += 2) {
            SBAR(); pB0 = f32x16{}; pB1 = f32x16{}; qkt64(pB0, pB1, K_lds + SHM_K, qr, r32, hi);
            finishSM(pA0, pA1, alA, l_reg, pa0, pa1, pa2, pa3); SBAR();
            SLOAD(1, (j + 2) * 64); SBAR();
            pv_d0(o, vb0, pa0, pa1, pa2, pa3); partialSM(pB0, pB1, m_reg, alB);
            __syncthreads(); SWAIT(); SWRITE(0, 0);
            RESC(alB); __syncthreads();
            SBAR(); pA0 = f32x16{}; pA1 = f32x16{}; qkt64(pA0, pA1, K_lds, qr, r32, hi);
            finishSM(pB0, pB1, alB, l_reg, pa0, pa1, pa2, pa3); SBAR();
            if (j + 3 < NTL) SLOAD(0, (j + 3) * 64); SBAR();
            pv_d0(o, vb0 + SHM_V, pa0, pa1, pa2, pa3); partialSM(pA0, pA1, m_reg, alA);
            __syncthreads(); SWAIT(); SWRITE(1, 1);
            RESC(alA); __syncthreads();
        }
        SBAR(); pB0 = f32x16{}; pB1 = f32x16{}; qkt64(pB0, pB1, K_lds + SHM_K, qr, r32, hi);
        finishSM(pA0, pA1, alA, l_reg, pa0, pa1, pa2, pa3); SBAR();
        pv_d0(o, vb0, pa0, pa1, pa2, pa3); partialSM(pB0, pB1, m_reg, alB);
        __syncthreads(); RESC(alB);
        finishSM(pB0, pB1, alB, l_reg, pa0, pa1, pa2, pa3); SBAR();
        pv_d0(o, vb0 + SHM_V, pa0, pa1, pa2, pa3);
#undef SLOAD
#undef SWRITE
#undef SWAIT
#undef RESC
        if (hi == 0) li_l[r32] = l_reg; asm volatile("s_waitcnt lgkmcnt(0)" ::: "memory");
        float rli[16];
#pragma unroll
        for (int r = 0; r < 16; ++r) rli[r] = __builtin_amdgcn_rcpf(li_l[crow(r, hi)]);
        { const float coef = c == 0 ? 1.f : -lam;
#pragma unroll
          for (int d0 = 0; d0 < 4; ++d0)
#pragma unroll
              for (int r = 0; r < 16; r += 2) { const int idx = (d0 * 8 + (r >> 1)) * 64 + lane; const unsigned w = c == 0 ? 0u : stash[idx];
                  stash[idx] = cvt_pk_bf16(bflo(w) + coef * o[d0][r] * rli[r], bfhi(w) + coef * o[d0][r + 1] * rli[r + 1]); } }
        __syncthreads();
    }
    stash_store(stash, QK + qrow * LDK + h * 128, LDK, lane);
    __syncthreads();
}

constexpr int MOFF_V = 0, MOFF_K = 32768, MOFF_WS = 65536, MOFF_RK = 67584, MOFF_G = 68608, MOFF_STASH = 69632;
__device__ __forceinline__ void mem_unit(int s, int mh, int qb, bf16_t* VM, const bf16_t* KVM, const float* mqn, const float* mkn, char* lds) {
    int tid = threadIdx.x; asm volatile("" : "+v"(tid));
    const int wid = __builtin_amdgcn_readfirstlane(tid >> 6), lane = tid & 63, r32 = lane & 31, hi = lane >> 5;
    const int tok0 = seq_start(s);
    char* V_lds = lds + MOFF_V; char* K_lds = lds + MOFF_K;
    float* wsf = (float*)(lds + MOFF_WS) + wid * 64; float* li_l = wsf; float* al_l = wsf + 32;
    float* rk_l = (float*)(lds + MOFF_RK); float* g_l = (float*)(lds + MOFF_G);
    const bf16_t* Kh = KVM + (size_t)(s * 256) * 2048 + mh * 256;
    const bf16_t* Vh = KVM + (size_t)(s * 256) * 2048 + 1024 + mh * 256;
    if (tid < 256) g_l[tid] = mqn[tid] * mkn[tid];
    {
        const bf16_t* kp = Kh + (size_t)(wid * 32 + r32) * 2048 + hi * 128; float ss = 0.f;
#pragma unroll
        for (int i = 0; i < 16; ++i) { const u32x4 w = *(const u32x4*)(kp + i * 8);
            ss += bflo(w.x) * bflo(w.x) + bfhi(w.x) * bfhi(w.x) + bflo(w.y) * bflo(w.y) + bfhi(w.y) * bfhi(w.y) + bflo(w.z) * bflo(w.z) + bfhi(w.z) * bfhi(w.z) + bflo(w.w) * bflo(w.w) + bfhi(w.w) * bfhi(w.w); }
        ss += __shfl_xor(ss, 32);
        if (hi == 0) rk_l[wid * 32 + r32] = rsqrtf(ss * (1.f / 256.f) + 1e-6f);
    }
    const size_t qrow = (size_t)(tok0 + qb * 256 + wid * 32);
    bf16_t* Qw = VM + (qrow + r32) * 2048 + 1024 + mh * 256 + hi * 8;
    float rqC;
    { float ss = 0.f;
#pragma unroll
      for (int i = 0; i < 16; ++i) { const u32x4 w = *(const u32x4*)(Qw + i * 16);
          ss += bflo(w.x) * bflo(w.x) + bfhi(w.x) * bfhi(w.x) + bflo(w.y) * bflo(w.y) + bfhi(w.y) * bfhi(w.y) + bflo(w.z) * bflo(w.z) + bfhi(w.z) * bfhi(w.z) + bflo(w.w) * bflo(w.w) + bfhi(w.w) * bfhi(w.w); }
      ss += __shfl_xor(ss, 32);
      rqC = rsqrtf(ss * (1.f / 256.f) + 1e-6f) * (0.0625f * 1.4426950408889634f); }
    const int sr = tid >> 4, sc = (tid & 15) * 8, vst0 = v_st(sr, sc), vst1 = v_st(32 + sr, sc);
    const int kr = tid >> 3, kc = (tid & 7) * 8, kst = KSWZ64(kr, kc * 2);
    const int vb0 = (int)(uintptr_t)V_lds + v_rd_base(lane);
    unsigned* stash = (unsigned*)(lds + MOFF_STASH) + wid * 2048;
    __syncthreads();
#pragma unroll 1
    for (int hv = 0; hv < 2; ++hv) {
    float m_reg = -1e30f, l_reg = 0.f; f32x16 o[4] = {};
#pragma unroll 1
    for (int t = 0; t < 4; ++t) {
        const int k0 = t * 64;
#pragma unroll
        for (int ds = 0; ds < 4; ++ds) { const u32x4 w = *(const u32x4*)(Kh + (size_t)(k0 + kr) * 2048 + ds * 64 + kc); const float* g = g_l + ds * 64 + kc;
            u32x4 o4; o4.x = cvt_pk_bf16(bflo(w.x) * g[0], bfhi(w.x) * g[1]); o4.y = cvt_pk_bf16(bflo(w.y) * g[2], bfhi(w.y) * g[3]);
            o4.z = cvt_pk_bf16(bflo(w.z) * g[4], bfhi(w.z) * g[5]); o4.w = cvt_pk_bf16(bflo(w.w) * g[6], bfhi(w.w) * g[7]);
            *(u32x4*)(K_lds + ds * 8192 + kst) = o4; asm volatile("" ::: "memory"); }
        *(u32x4*)(V_lds + vst0) = *(const u32x4*)(Vh + (size_t)(k0 + sr) * 2048 + hv * 128 + sc);
        *(u32x4*)(V_lds + vst1) = *(const u32x4*)(Vh + (size_t)(k0 + 32 + sr) * 2048 + hv * 128 + sc);
        __syncthreads();
        f32x16 p0 = {}, p1 = {};
#pragma unroll
        for (int ds = 0; ds < 4; ++ds) { bf16x8 qr[4];
#pragma unroll
            for (int d0 = 0; d0 < 4; ++d0) qr[d0] = *reinterpret_cast<const bf16x8*>(Qw + ds * 64 + d0 * 16);
            qkt64(p0, p1, K_lds + ds * 8192, qr, r32, hi); }
#pragma unroll
        for (int r = 0; r < 16; ++r) { p0[r] *= rk_l[k0 + crow(r, hi)] * rqC; p1[r] *= rk_l[k0 + 32 + crow(r, hi)] * rqC; }
        float pmax = p0[0];
#pragma unroll
        for (int r = 1; r < 16; ++r) pmax = fmaxf(pmax, p0[r]);
#pragma unroll
        for (int r = 0; r < 16; ++r) pmax = fmaxf(pmax, p1[r]);
        pmax = fmaxf(pmax, __shfl_xor(pmax, 32));
        const float mn = fmaxf(m_reg, pmax), alpha = __builtin_amdgcn_exp2f(m_reg - mn); m_reg = mn;
        float ps = 0.f;
#pragma unroll
        for (int r = 0; r < 16; ++r) { p0[r] = __builtin_amdgcn_exp2f(p0[r] - mn); p1[r] = __builtin_amdgcn_exp2f(p1[r] - mn); ps += p0[r] + p1[r]; }
        ps += __shfl_xor(ps, 32);
        l_reg = l_reg * alpha + ps;
        if (hi == 0) al_l[r32] = alpha; asm volatile("s_waitcnt lgkmcnt(0)" ::: "memory");
#pragma unroll
        for (int d = 0; d < 4; ++d)
#pragma unroll
            for (int r = 0; r < 16; ++r) o[d][r] *= al_l[crow(r, hi)];
        bf16x8 pa0, pa1, pa2, pa3;
#define PK4(P, BASE, OUT) do { unsigned a0 = cvt_pk_bf16(P[BASE + 0], P[BASE + 1]), a1 = cvt_pk_bf16(P[BASE + 2], P[BASE + 3]);   \
    unsigned b0 = cvt_pk_bf16(P[BASE + 4], P[BASE + 5]), b1 = cvt_pk_bf16(P[BASE + 6], P[BASE + 7]);                              \
    auto r0 = __builtin_amdgcn_permlane32_swap(a0, b0, false, false); auto r1 = __builtin_amdgcn_permlane32_swap(a1, b1, false, false); \
    u32x4 w = {r0[0], r1[0], r0[1], r1[1]}; OUT = *reinterpret_cast<bf16x8*>(&w); } while (0)
        PK4(p0, 0, pa0); PK4(p0, 8, pa1); PK4(p1, 0, pa2); PK4(p1, 8, pa3);
#undef PK4
        pv_d0(o, vb0, pa0, pa1, pa2, pa3);
        __syncthreads();
    }
    if (hi == 0) li_l[r32] = l_reg; asm volatile("s_waitcnt lgkmcnt(0)" ::: "memory");
    if (hv == 1) stash_store(stash, VM + qrow * 2048 + 1024 + mh * 256, 2048, lane);
#pragma unroll
    for (int d0 = 0; d0 < 4; ++d0)
#pragma unroll
        for (int r = 0; r < 16; r += 2) stash[(d0 * 8 + (r >> 1)) * 64 + lane] = cvt_pk_bf16(o[d0][r] * __builtin_amdgcn_rcpf(li_l[crow(r, hi)]), o[d0][r + 1] * __builtin_amdgcn_rcpf(li_l[crow(r + 1, hi)]));
    }
    stash_store(stash, VM + qrow * 2048 + 1024 + mh * 256 + 128, 2048, lane);
    __syncthreads();
}
#undef SBAR
}

namespace scan {
constexpr int TC = 32;
constexpr int BUFB = 49152, O_R = 0, O_KD = 8192, O_KK = 16384, O_W = 24576, O_KA = 32768, O_V = 40960, O_Y = 45056;
constexpr int O_PRIV = 98304;
constexpr int O_TBL = 98304 + 8192;
__device__ __forceinline__ float dpp_red8(float x) {
    x += __uint_as_float(__builtin_amdgcn_update_dpp(0u, __float_as_uint(x), 0xB1, 0xf, 0xf, false));
    x += __uint_as_float(__builtin_amdgcn_update_dpp(0u, __float_as_uint(x), 0x4E, 0xf, 0xf, false));
    x += __uint_as_float(__builtin_amdgcn_update_dpp(0u, __float_as_uint(x), 0x141, 0xf, 0xf, false));
    return x;
}
struct P {
    const bf16_t* ZR; bf16_t* YB; float* BON;
    const float *mup, *mun, *w0, *w2, *a0, *a2, *kk_w, *ka_w, *rk_w;
};
__device__ __forceinline__ void job(int s, int dir, int head, int rh, const P& p, char* lds) {
    int tid = threadIdx.x; asm volatile("" : "+v"(tid));
    const int wid = __builtin_amdgcn_readfirstlane(tid >> 6), lane = tid & 63;
    const int tok0 = seq_start(s), T = seq_len(s), NCH = T / TC;
    float* TBL = (float*)(lds + O_TBL);
    float* MUP = TBL; float* MUN = TBL + 320; float* KKW = TBL + 640; float* KAW = TBL + 704; float* RKW = TBL + 768; float* BW = TBL + 832; float* BA = TBL + 896;
    __syncthreads();
    if (tid < 320) { const int which = tid >> 6, j = tid & 63; const int col = which < 3 ? which * 1024 + head * 64 + j : (which == 3 ? 3072 : 3200) + dir * 64 + j; MUP[tid] = p.mup[col]; MUN[tid] = p.mun[col]; }
    if (tid >= 320 && tid < 384) { const int j = tid - 320; KKW[j] = p.kk_w[head * 64 + j]; KAW[j] = p.ka_w[head * 64 + j]; RKW[j] = p.rk_w[head * 64 + j];
        BW[j] = p.w0[dir * 1024 + head * 64 + j]; BA[j] = p.a0[dir * 1024 + head * 64 + j]; }
    bf16_t* yb = p.YB + (size_t)dir * NT * 1024; float* bon = p.BON + (size_t)dir * NT * 16;
    if (wid >= 4) {
        const int pw = wid - 4;
        bf16_t* AWl = (bf16_t*)(lds + O_PRIV + pw * 2048); bf16_t* AAl = AWl + 512;
        bf16x8 Bf[2][4][2];
#pragma unroll
        for (int mat = 0; mat < 2; ++mat)
#pragma unroll
            for (int cbk = 0; cbk < 4; ++cbk)
#pragma unroll
                for (int ks = 0; ks < 2; ++ks) { const float* W2 = (mat == 0 ? p.w2 : p.a2) + (size_t)dir * 64 * 1024 + head * 64 + cbk * 16 + (lane & 15) + (size_t)(ks * 32 + (lane >> 4) * 8) * 1024;
                    float f[8];
#pragma unroll
                    for (int e = 0; e < 8; ++e) f[e] = W2[(size_t)e * 1024];
                    u32x4 w; w.x = cvt_pk_bf16(f[0], f[1]); w.y = cvt_pk_bf16(f[2], f[3]); w.z = cvt_pk_bf16(f[4], f[5]); w.w = cvt_pk_bf16(f[6], f[7]); Bf[mat][cbk][ks] = *reinterpret_cast<bf16x8*>(&w); }
        __syncthreads();
        const int pt = tid - 256;
        for (int c = -1; c < NCH; ++c) {
            if (c >= 1) { const int cb_ = (c - 1) & 1, tf = dir ? T - TC * c : TC * (c - 1); const int tl = pt >> 3, c4 = (pt & 7) * 4;
                const f32x4 y4 = *(const f32x4*)((const float*)(lds + cb_ * BUFB + O_Y) + tl * 32 + c4); u32x2 w; w.x = cvt_pk_bf16(y4[0], y4[1]); w.y = cvt_pk_bf16(y4[2], y4[3]);
                *(u32x2*)(yb + (size_t)(tok0 + tf + tl) * 1024 + head * 64 + rh * 32 + c4) = w; }
            if (c + 1 < NCH) {
                const int nb = (c + 1) & 1, tfirst = dir ? T - TC * (c + 2) : TC * (c + 1);
                char* B_ = lds + nb * BUFB;
                float* Rl = (float*)(B_ + O_R); float* KDl = (float*)(B_ + O_KD); float* KKl = (float*)(B_ + O_KK); float* Wl = (float*)(B_ + O_W); float* KAl = (float*)(B_ + O_KA); float* Vl = (float*)(B_ + O_V);
                u32x4 zc[5], zm[5], zn[5];
#pragma unroll
                for (int k = 0; k < 5; ++k) { const int item = lane + 64 * k, tl8 = item / 40, chh = item - tl8 * 40, which = chh >> 3, j0 = (chh & 7) * 8;
                    const int col = which < 3 ? which * 1024 + head * 64 + j0 : (which == 3 ? 3072 : 3200) + dir * 64 + j0;
                    const int t = tfirst + 8 * pw + tl8; const bf16_t* zp = p.ZR + (size_t)(tok0 + t) * ZRP + col;
                    zc[k] = *(const u32x4*)zp; zm[k] = (u32x4){0u, 0u, 0u, 0u}; zn[k] = (u32x4){0u, 0u, 0u, 0u};
                    if (t > 0) zm[k] = *(const u32x4*)(zp - ZRP);
                    if (t < T - 1) zn[k] = *(const u32x4*)(zp + ZRP); }
#pragma unroll
                for (int k = 0; k < 5; ++k) { const int item = lane + 64 * k, tl8 = item / 40, chh = item - tl8 * 40, which = chh >> 3, j0 = (chh & 7) * 8, tl = 8 * pw + tl8;
                    const f32x4 mpa = *(const f32x4*)(MUP + which * 64 + j0), mpb = *(const f32x4*)(MUP + which * 64 + j0 + 4), mna = *(const f32x4*)(MUN + which * 64 + j0), mnb = *(const f32x4*)(MUN + which * 64 + j0 + 4);
                    const u32x4 z = zc[k], zmm = zm[k], znn = zn[k];
                    float v[8];
#define SH(i, zw, zmw, znw, lohi, mp_, mn_) { const float zz = lohi(zw), a_ = lohi(zmw), b_ = lohi(znw); v[i] = zz + mp_ * (a_ - zz) + mn_ * (b_ - zz); }
                    SH(0, z.x, zmm.x, znn.x, bflo, mpa[0], mna[0]) SH(1, z.x, zmm.x, znn.x, bfhi, mpa[1], mna[1]) SH(2, z.y, zmm.y, znn.y, bflo, mpa[2], mna[2]) SH(3, z.y, zmm.y, znn.y, bfhi, mpa[3], mna[3])
                    SH(4, z.z, zmm.z, znn.z, bflo, mpb[0], mnb[0]) SH(5, z.z, zmm.z, znn.z, bfhi, mpb[1], mnb[1]) SH(6, z.w, zmm.w, znn.w, bflo, mpb[2], mnb[2]) SH(7, z.w, zmm.w, znn.w, bfhi, mpb[3], mnb[3])
#undef SH
                    if (which < 2) { float* dst = (which == 0 ? Rl : KDl) + tl * 64 + j0;
                        *(f32x4*)dst = (f32x4){v[0], v[1], v[2], v[3]}; *(f32x4*)(dst + 4) = (f32x4){v[4], v[5], v[6], v[7]}; }
                    else if (which == 2) { if ((j0 >> 5) == rh) { float* dst = Vl + tl * 32 + (j0 & 31);
                        *(f32x4*)dst = (f32x4){v[0], v[1], v[2], v[3]}; *(f32x4*)(dst + 4) = (f32x4){v[4], v[5], v[6], v[7]}; } }
                    else { if (which == 3) {
#pragma unroll
                            for (int i = 0; i < 8; ++i) { const float e2 = __expf(2.f * v[i]); v[i] = 1.f - 2.f / (e2 + 1.f); } }
                        u32x4 w; w.x = cvt_pk_bf16(v[0], v[1]); w.y = cvt_pk_bf16(v[2], v[3]); w.z = cvt_pk_bf16(v[4], v[5]); w.w = cvt_pk_bf16(v[6], v[7]);
                        *(u32x4*)((which == 3 ? AWl : AAl) + tl8 * 64 + j0) = w; }
                }
                { const int tj = lane & 7, kq = lane >> 4;
#pragma unroll
                  for (int mat = 0; mat < 2; ++mat) { const bf16_t* Am = (mat == 0 ? AWl : AAl) + tj * 64 + kq * 8;
                      const bf16x8 y0 = *reinterpret_cast<const bf16x8*>(Am), y1 = *reinterpret_cast<const bf16x8*>(Am + 32);
#pragma unroll
                      for (int cbk = 0; cbk < 4; ++cbk) { f32x4 acc = {0.f, 0.f, 0.f, 0.f};
                          acc = __builtin_amdgcn_mfma_f32_16x16x32_bf16(Bf[mat][cbk][0], y0, acc, 0, 0, 0);
                          acc = __builtin_amdgcn_mfma_f32_16x16x32_bf16(Bf[mat][cbk][1], y1, acc, 0, 0, 0);
                          const int col = cbk * 16 + 4 * kq; const f32x4 bias = *(const f32x4*)((mat == 0 ? BW : BA) + col); f32x4 res;
#pragma unroll
                          for (int r = 0; r < 4; ++r) { const float u = acc[r] + bias[r];
                              if (mat == 0) { const float sp = fmaxf(-u, 0.f) + log1pf(__expf(-fabsf(u))); res[r] = __expf(-__expf(-sp - 0.5f)); }
                              else res[r] = 1.f / (1.f + __expf(-u)); }
                          if ((lane & 15) < 8) *(f32x4*)((mat == 0 ? Wl : KAl) + (8 * pw + tj) * 64 + col) = res; } } }
                { const int tl = 8 * pw + (lane >> 3), c0 = (lane & 7) * 8; const int o = tl * 64 + c0;
                  float bs = 0.f, ss = 0.f; f32x4 kr[2], k4[2], a4[2];
#pragma unroll
                  for (int q = 0; q < 2; ++q) { k4[q] = *(const f32x4*)(KDl + o + 4 * q); a4[q] = *(const f32x4*)(KAl + o + 4 * q);
                      kr[q] = k4[q] * *(const f32x4*)(KKW + c0 + 4 * q); ss += (kr[q][0] * kr[q][0] + kr[q][1] * kr[q][1]) + (kr[q][2] * kr[q][2] + kr[q][3] * kr[q][3]); }
                  ss = dpp_red8(ss);
                  const float inv = 1.f / fmaxf(sqrtf(ss), 1e-12f);
#pragma unroll
                  for (int q = 0; q < 2; ++q) { const f32x4 kk = kr[q] * inv, kd = k4[q] * (1.f + (a4[q] - 1.f) * *(const f32x4*)(KAW + c0 + 4 * q)), kka = kk * a4[q];
                      const f32x4 bb = *(const f32x4*)(Rl + o + 4 * q) * kd * *(const f32x4*)(RKW + c0 + 4 * q); bs += (bb[0] + bb[1]) + (bb[2] + bb[3]);
                      *(f32x4*)(KKl + o + 4 * q) = kk; *(f32x4*)(KDl + o + 4 * q) = kd; *(f32x4*)(KAl + o + 4 * q) = kka; }
                  bs = dpp_red8(bs);
                  if (rh == 0 && (lane & 7) == 0) bon[(size_t)(tok0 + tfirst + tl) * 16 + head] = bs; }
            }
            __syncthreads();
        }
    } else {
        __syncthreads();
        const int row = tid >> 3, seg = tid & 7;
        f32x2 S[4];
#pragma unroll
        for (int q = 0; q < 4; ++q) S[q] = (f32x2){0.f, 0.f};
        __syncthreads();
        for (int c = 0; c < NCH; ++c) {
            const char* B_ = lds + (c & 1) * BUFB;
            const float* Rl = (const float*)(B_ + O_R); const float* KDl = (const float*)(B_ + O_KD); const float* KKl = (const float*)(B_ + O_KK); const float* Wl = (const float*)(B_ + O_W); const float* KAl = (const float*)(B_ + O_KA);
            const float* Vl = (const float*)(B_ + O_V); float* Yl = (float*)(B_ + O_Y);
            f32x4 ck[2], cw[2], ca[2], cd[2], cr[2]; float cv;
#define LOADV(tl_) do { const int o8 = (tl_) * 64 + seg * 8; ck[0] = *(const f32x4*)(KKl + o8); ck[1] = *(const f32x4*)(KKl + o8 + 4); cw[0] = *(const f32x4*)(Wl + o8); cw[1] = *(const f32x4*)(Wl + o8 + 4); \
    ca[0] = *(const f32x4*)(KAl + o8); ca[1] = *(const f32x4*)(KAl + o8 + 4); cd[0] = *(const f32x4*)(KDl + o8); cd[1] = *(const f32x4*)(KDl + o8 + 4); cr[0] = *(const f32x4*)(Rl + o8); cr[1] = *(const f32x4*)(Rl + o8 + 4); \
    cv = Vl[(tl_) * 32 + row]; } while (0)
            LOADV(dir ? TC - 1 : 0);
#pragma unroll 2
            for (int st = 0; st < TC; ++st) {
                const int tl = dir ? TC - 1 - st : st;
                const f32x2 k0 = {ck[0][0], ck[0][1]}, k1 = {ck[0][2], ck[0][3]}, k2 = {ck[1][0], ck[1][1]}, k3 = {ck[1][2], ck[1][3]};
                const f32x2 w0 = {cw[0][0], cw[0][1]}, w1 = {cw[0][2], cw[0][3]}, w2 = {cw[1][0], cw[1][1]}, w3 = {cw[1][2], cw[1][3]};
                const f32x2 a0 = {ca[0][0], ca[0][1]}, a1 = {ca[0][2], ca[0][3]}, a2 = {ca[1][0], ca[1][1]}, a3 = {ca[1][2], ca[1][3]};
                const f32x2 d0 = {cd[0][0], cd[0][1]}, d1 = {cd[0][2], cd[0][3]}, d2 = {cd[1][0], cd[1][1]}, d3 = {cd[1][2], cd[1][3]};
                const f32x2 r0 = {cr[0][0], cr[0][1]}, r1 = {cr[0][2], cr[0][3]}, r2 = {cr[1][0], cr[1][1]}, r3 = {cr[1][2], cr[1][3]};
                const f32x2 vv = {cv, cv};
                if (st + 1 < TC) LOADV(dir ? TC - 2 - st : st + 1);
                f32x2 t2 = S[0] * k0 + S[1] * k1; const f32x2 t3 = S[2] * k2 + S[3] * k3; t2 = t2 + t3;
                float d = dpp_red8(t2[0] + t2[1]);
                const f32x2 p0 = S[0] * w0 + vv * d0, p1 = S[1] * w1 + vv * d1, p2 = S[2] * w2 + vv * d2, p3 = S[3] * w3 + vv * d3;
                const f32x2 sa = {-d, -d};
                S[0] = p0 + sa * a0; S[1] = p1 + sa * a1; S[2] = p2 + sa * a2; S[3] = p3 + sa * a3;
                f32x2 y2 = S[0] * r0 + S[1] * r1; const f32x2 y3 = S[2] * r2 + S[3] * r3; y2 = y2 + y3;
                const float y = dpp_red8(y2[0] + y2[1]);
                if (seg == 0) Yl[tl * 32 + row] = y;
            }
#undef LOADV
            __syncthreads();
        }
    }
    if (wid >= 4) {
        const int pt = tid - 256, c = NCH, cb_ = (c - 1) & 1, tf = dir ? T - TC * c : TC * (c - 1); const int tl = pt >> 3, c4 = (pt & 7) * 4;
        const f32x4 y4 = *(const f32x4*)((const float*)(lds + cb_ * BUFB + O_Y) + tl * 32 + c4); u32x2 w; w.x = cvt_pk_bf16(y4[0], y4[1]); w.y = cvt_pk_bf16(y4[2], y4[3]);
        *(u32x2*)(yb + (size_t)(tok0 + tf + tl) * 1024 + head * 64 + rh * 32 + c4) = w;
    }
    __syncthreads();
}
}

__device__ __forceinline__ void p4_post(const Args& a, char* lds, int vcu, int G) {
    const int tid = threadIdx.x, lane = tid & 63;
    unsigned char* ws = a.ws;
    const bf16_t* ZR = (const bf16_t*)a.out; bf16_t* QK = (bf16_t*)(ws + WS_QK);
    const bf16_t* Y0 = (const bf16_t*)(ws + WS_Y); const bf16_t* Y1 = Y0 + (size_t)NT * 1024;
    const float* BON = (const float*)(ws + WS_BON);
    const float* mup = a.in[13]; const float* mun = a.in[14]; const float* G2 = a.in[19]; const float* lnw = a.in[23]; const float* lnb = a.in[24]; const float* subg = a.in[12];
    float* SG = (float*)lds; float* BL = (float*)(lds + 20480);
    for (int tile = vcu; tile < NT / 32; tile += G) {
        const int tk0 = tile * 32;
        __syncthreads();
        for (int it = tid; it < 32 * 20; it += NTHR) {
            const int tl = it / 20, j0 = (it % 20) * 8, col = 3328 + j0, tok = tk0 + tl, t = tok_pos(tok), T = tok < TP ? TP : TS;
            const bf16_t* zp = ZR + (size_t)tok * ZRP + col; const u32x4 z = *(const u32x4*)zp; u32x4 zm = {0u, 0u, 0u, 0u}, zn = {0u, 0u, 0u, 0u};
            if (t > 0) zm = *(const u32x4*)(zp - ZRP);
            if (t < T - 1) zn = *(const u32x4*)(zp + ZRP);
            float v[8];
#define SH(i, zw, zmw, znw, lohi) { const float zz = lohi(zw), a_ = lohi(zmw), b_ = lohi(znw), mp_ = mup[col + i], mn_ = mun[col + i]; v[i] = sigmoidf_(zz + mp_ * (a_ - zz) + mn_ * (b_ - zz)); }
            SH(0, z.x, zm.x, zn.x, bflo) SH(1, z.x, zm.x, zn.x, bfhi) SH(2, z.y, zm.y, zn.y, bflo) SH(3, z.y, zm.y, zn.y, bfhi)
            SH(4, z.z, zm.z, zn.z, bflo) SH(5, z.z, zm.z, zn.z, bfhi) SH(6, z.w, zm.w, zn.w, bflo) SH(7, z.w, zm.w, zn.w, bfhi)
#undef SH
            *(f32x4*)(SG + tl * 160 + j0) = (f32x4){v[0], v[1], v[2], v[3]}; *(f32x4*)(SG + tl * 160 + j0 + 4) = (f32x4){v[4], v[5], v[6], v[7]};
        }
        { const int tl = tid >> 4, hd = tid & 15; BL[tid] = BON[(size_t)(tk0 + tl) * 16 + hd] + BON[(size_t)NT * 16 + (size_t)(tk0 + tl) * 16 + hd]; }
        { const int pr = tid >> 1, half = tid & 1, tl = pr >> 3, hd = pr & 7; bf16_t* op = QK + (size_t)(tk0 + tl) * 2048 + hd * 128 + half * 64;
          u32x4 w[8]; float ss = 0.f;
#pragma unroll
          for (int i = 0; i < 8; ++i) { w[i] = *(const u32x4*)(op + i * 8);
              ss += bflo(w[i].x) * bflo(w[i].x) + bfhi(w[i].x) * bfhi(w[i].x) + bflo(w[i].y) * bflo(w[i].y) + bfhi(w[i].y) * bfhi(w[i].y) + bflo(w[i].z) * bflo(w[i].z) + bfhi(w[i].z) * bfhi(w[i].z) + bflo(w[i].w) * bflo(w[i].w) + bfhi(w[i].w) * bfhi(w[i].w); }
          ss += __shfl_xor(ss, 1);
          const float rstd = rsqrtf(ss * (1.f / 128.f) + 1e-6f) * 0.8f; const float* sg = subg + half * 64;
#pragma unroll
          for (int i = 0; i < 8; ++i) { u32x4 o;
              o.x = cvt_pk_bf16(bflo(w[i].x) * rstd * sg[i * 8 + 0], bfhi(w[i].x) * rstd * sg[i * 8 + 1]); o.y = cvt_pk_bf16(bflo(w[i].y) * rstd * sg[i * 8 + 2], bfhi(w[i].y) * rstd * sg[i * 8 + 3]);
              o.z = cvt_pk_bf16(bflo(w[i].z) * rstd * sg[i * 8 + 4], bfhi(w[i].z) * rstd * sg[i * 8 + 5]); o.w = cvt_pk_bf16(bflo(w[i].w) * rstd * sg[i * 8 + 6], bfhi(w[i].w) * rstd * sg[i * 8 + 7]);
              *(u32x4*)(op + i * 8) = o; } }
        __syncthreads();
        const int c0 = tid * 2;
        float acc[32][2];
#pragma unroll
        for (int i = 0; i < 32; ++i) { acc[i][0] = 0.f; acc[i][1] = 0.f; }
#pragma unroll 1
        for (int k = 0; k < 160; k += 4) {
            const f32x2 g0 = *(const f32x2*)(G2 + (size_t)(k + 0) * 1024 + c0), g1 = *(const f32x2*)(G2 + (size_t)(k + 1) * 1024 + c0), g2 = *(const f32x2*)(G2 + (size_t)(k + 2) * 1024 + c0), g3 = *(const f32x2*)(G2 + (size_t)(k + 3) * 1024 + c0);
#pragma unroll
            for (int i = 0; i < 32; ++i) { const f32x4 s4 = *(const f32x4*)(SG + i * 160 + k);
                acc[i][0] += s4[0] * g0[0] + s4[1] * g1[0] + s4[2] * g2[0] + s4[3] * g3[0];
                acc[i][1] += s4[0] * g0[1] + s4[1] * g1[1] + s4[2] * g2[1] + s4[3] * g3[1]; }
        }
        const int hd = tid >> 5;
        const float lw0 = lnw[c0], lw1 = lnw[c0 + 1], lb0 = lnb[c0], lb1 = lnb[c0 + 1];
        const float mp0 = mup[2048 + c0], mp1 = mup[2048 + c0 + 1], mn0 = mun[2048 + c0], mn1 = mun[2048 + c0 + 1];
#pragma unroll
        for (int i = 0; i < 32; ++i) {
            const int tok = tk0 + i, t = tok_pos(tok), T = tok < TP ? TP : TS;
            const unsigned ya = *(const unsigned*)(Y0 + (size_t)tok * 1024 + c0), yb = *(const unsigned*)(Y1 + (size_t)tok * 1024 + c0);
            const float y0 = bflo(ya) + bflo(yb), y1 = bfhi(ya) + bfhi(yb);
            float s = y0 + y1, q = y0 * y0 + y1 * y1;
#pragma unroll
            for (int o = 1; o < 32; o <<= 1) { s += __shfl_xor(s, o); q += __shfl_xor(q, o); }
            const float mean = s * (1.f / 64.f), var = fmaxf(q * (1.f / 64.f) - mean * mean, 0.f), rstd = rsqrtf(var + 64e-5f);
            const bf16_t* zp = ZR + (size_t)tok * ZRP + 2048 + c0; const unsigned z = *(const unsigned*)zp;
            unsigned zm = 0u, zn = 0u;
            if (t > 0) zm = *(const unsigned*)(zp - ZRP);
            if (t < T - 1) zn = *(const unsigned*)(zp + ZRP);
            const float v0 = bflo(z) + mp0 * (bflo(zm) - bflo(z)) + mn0 * (bflo(zn) - bflo(z)), v1 = bfhi(z) + mp1 * (bfhi(zm) - bfhi(z)) + mn1 * (bfhi(zn) - bfhi(z));
            const float bo = BL[i * 16 + hd];
            const float o0 = ((y0 - mean) * rstd * lw0 + lb0 + bo * v0) * acc[i][0], o1 = ((y1 - mean) * rstd * lw1 + lb1 + bo * v1) * acc[i][1];
            *(unsigned*)(QK + (size_t)tok * 2048 + 1024 + c0) = cvt_pk_bf16(o0, o1);
        }
    }
    __syncthreads();
}

struct SchedMerge {
    int v, G; const char* H; const char* WG; const char* QK; const char* VM; const char* PAR; const char* PM2;
    __device__ __forceinline__ bool next(int i, Unit& u) const {
        const int ti = i / 6, kind = i - ti * 6; const long L = (long)ti * G + v; int pm, pn;
        if (!TileMap{192, 8}.get(L, pm, pn)) return false;
        u.pm = pm; u.pn = pn; u.kind = kind; u.t0 = 0; u.T = 0;
        const size_t bo = (size_t)pn * MiB;
        switch (kind) {
            case 0: u.A = H + (size_t)pm * MiB; u.B = WG + bo; u.nt = 32; break;
            case 1: u.A = QK + (size_t)pm * MiB; u.B = PAR + bo; u.nt = 16; break;
            case 2: u.A = H + (size_t)pm * MiB; u.B = WG + 8 * MiB + bo; u.nt = 32; break;
            case 3: u.A = QK + (size_t)pm * MiB + 2048; u.B = PAR + bo + 2048; u.nt = 16; break;
            case 4: u.A = H + (size_t)pm * MiB; u.B = WG + 16 * MiB + bo; u.nt = 32; break;
            default: u.A = VM + (size_t)pm * MiB + 2048; u.B = PM2 + bo; u.nt = 16; break;
        }
        return true;
    }
};
struct EpiMerge {
    u32x4* scrG; f32x4* scrP; bf16_t* MRG;
    __device__ __forceinline__ void operator()(const f32x4 (&acc)[2][2][4][2], const Unit& u, int wr, int wc, int fr, int fq) const {
        const int tid = threadIdx.x, kind = u.kind;
        u32x4* gp = scrG + tid; f32x4* pp = scrP + tid;
        if ((kind & 1) == 0) {
#pragma unroll
            for (int ai = 0; ai < 2; ++ai)
#pragma unroll
                for (int bj = 0; bj < 2; ++bj)
#pragma unroll
                    for (int m = 0; m < 4; ++m) { const f32x4 v0 = acc[ai][bj][m][0], v1 = acc[ai][bj][m][1]; u32x4 w;
                        w.x = cvt_pk_bf16(sigmoidf_(v0[0]), sigmoidf_(v0[1])); w.y = cvt_pk_bf16(sigmoidf_(v0[2]), sigmoidf_(v0[3]));
                        w.z = cvt_pk_bf16(sigmoidf_(v1[0]), sigmoidf_(v1[1])); w.w = cvt_pk_bf16(sigmoidf_(v1[2]), sigmoidf_(v1[3]));
                        *gp = w; gp += NTHR; asm volatile("" : "+v"(gp) :: "memory"); }
        } else {
            const int row0 = u.pm * 256 + wr * 64 + fr, col0 = u.pn * 256 + wc * 32 + 8 * fq;
#pragma unroll
            for (int ai = 0; ai < 2; ++ai)
#pragma unroll
                for (int bj = 0; bj < 2; ++bj) {
                    bf16_t* mp = MRG + (size_t)(row0 + ai * 128) * 2048 + col0 + bj * 128;
#pragma unroll
                    for (int m = 0; m < 4; ++m) { const u32x4 g = *gp;
                        f32x4 p0 = acc[ai][bj][m][0] * (f32x4){bflo(g.x), bfhi(g.x), bflo(g.y), bfhi(g.y)}, p1 = acc[ai][bj][m][1] * (f32x4){bflo(g.z), bfhi(g.z), bflo(g.w), bfhi(g.w)};
                        if (kind > 1) { p0 += pp[0]; p1 += pp[NTHR]; }
                        if (kind < 5) { pp[0] = p0; pp[NTHR] = p1; }
                        else { u32x4 w; w.x = cvt_pk_bf16(p0[0], p0[1]); w.y = cvt_pk_bf16(p0[2], p0[3]); w.z = cvt_pk_bf16(p1[0], p1[1]); w.w = cvt_pk_bf16(p1[2], p1[3]);
                            *(u32x4*)mp = w; }
                        gp += NTHR; pp += 2 * NTHR; mp += 16 * 2048; asm volatile("" : "+v"(gp), "+v"(pp), "+v"(mp) :: "memory"); } }
        }
    }
};

struct SchedSq {
    int v, G; const char* A; const char* B; size_t astep, bstep; int nt;
    __device__ __forceinline__ bool next(int i, Unit& u) const {
        const long L = (long)i * G + v; int pm, pn; if (!TileMap{192, 8}.get(L, pm, pn)) return false;
        u.A = A + (size_t)pm * astep; u.B = B + (size_t)pn * bstep; u.nt = nt; u.pm = pm; u.pn = pn; u.kind = 0; u.t0 = 0; u.T = 0; return true;
    }
};
struct EpiWo {
    const float* xp; const float* xs; float* out;
    __device__ __forceinline__ void operator()(const f32x4 (&acc)[2][2][4][2], const Unit& u, int wr, int wc, int fr, int fq) const {
        const int row0 = u.pm * 256 + wr * 64 + fr, col0 = u.pn * 256 + wc * 32 + 8 * fq;
#pragma unroll
        for (int ai = 0; ai < 2; ++ai)
#pragma unroll
            for (int m = 0; m < 4; ++m) { const int row = row0 + ai * 128 + m * 16;
                const float* xr = (row < TP ? xp + (size_t)row * DM : xs + (size_t)(row - TP) * DM) + col0; float* orow = out + (size_t)row * DM + col0;
#pragma unroll
                for (int bj = 0; bj < 2; ++bj) { const f32x4 x0 = *(const f32x4*)(xr + bj * 128), x1 = *(const f32x4*)(xr + bj * 128 + 4);
                    *(f32x4*)(orow + bj * 128) = x0 + acc[ai][bj][m][0]; *(f32x4*)(orow + bj * 128 + 4) = x1 + acc[ai][bj][m][1]; } }
    }
};
struct EpiDown {
    float* out;
    __device__ __forceinline__ void operator()(const f32x4 (&acc)[2][2][4][2], const Unit& u, int wr, int wc, int fr, int fq) const {
        const int row0 = u.pm * 256 + wr * 64 + fr, col0 = u.pn * 256 + wc * 32 + 8 * fq;
#pragma unroll
        for (int ai = 0; ai < 2; ++ai)
#pragma unroll
            for (int m = 0; m < 4; ++m) { float* orow = out + (size_t)(row0 + ai * 128 + m * 16) * DM + col0;
#pragma unroll
                for (int bj = 0; bj < 2; ++bj) { const f32x4 x0 = *(const f32x4*)(orow + bj * 128), x1 = *(const f32x4*)(orow + bj * 128 + 4);
                    *(f32x4*)(orow + bj * 128) = x0 + acc[ai][bj][m][0]; *(f32x4*)(orow + bj * 128 + 4) = x1 + acc[ai][bj][m][1]; } }
    }
};

struct SchedUp {
    int v, G; const char* HN; const char* WUP;
    __device__ __forceinline__ bool next(int i, Unit& u) const {
        const long L = (long)i * G + v; int pm, pn; if (!TileMap{197, 44}.get(L, pm, pn)) return false;
        int s, ti; if (pm < 65) { s = 0; ti = pm; } else { s = 1 + (pm - 65) / 33; ti = (pm - 65) % 33; }
        const int T = seq_len(s); int t0 = 254 * ti - 1; if (t0 > T - 255) t0 = T - 255;
        u.pm = seq_start(s); u.pn = pn; u.kind = 0; u.t0 = t0; u.T = T; u.nt = 32;
        u.A = HN + ((long)u.pm + t0) * 4096; u.B = WUP + (size_t)pn * MiB; return true;
    }
};
struct EpiUp {
    bf16_t* ACT; const float* cw; const float* cb; LAS float* xch;
    __device__ __forceinline__ void operator()(const f32x4 (&acc)[2][2][4][2], const Unit& u, int wr, int wc, int fr, int fq) const {
        const int lane = threadIdx.x & 63;
        const int cin = wc * 32 + 8 * fq;
#pragma unroll
        for (int ai = 0; ai < 2; ++ai) { const int rg = 2 * ai + wr;
#pragma unroll
            for (int bj = 0; bj < 2; ++bj)
#pragma unroll
                for (int n = 0; n < 2; ++n) {
                    if (fr == 0) *(LAS f32x4*)(xch + (rg * 2 + 0) * 256 + bj * 128 + cin + 4 * n) = acc[ai][bj][0][n];
                    if (fr == 15) *(LAS f32x4*)(xch + (rg * 2 + 1) * 256 + bj * 128 + cin + 4 * n) = acc[ai][bj][3][n]; } }
        asm volatile("s_waitcnt lgkmcnt(0)" ::: "memory"); __builtin_amdgcn_s_barrier(); asm volatile("" ::: "memory");
        const int srcR = (lane & 48) | ((lane - 1) & 15), srcL = (lane & 48) | ((lane + 1) & 15);
        const int gc = u.pn * 128 + cin;
#pragma unroll
        for (int n = 0; n < 2; ++n) {
            const int wcol = gc + 4 * n;
            const f32x4 g0 = *(const f32x4*)(cw + wcol), g1 = *(const f32x4*)(cw + 2 * DFF + wcol), g2 = *(const f32x4*)(cw + 4 * DFF + wcol), gb = *(const f32x4*)(cb + wcol);
            const f32x4 v0 = *(const f32x4*)(cw + DFF + wcol), v1 = *(const f32x4*)(cw + 3 * DFF + wcol), v2 = *(const f32x4*)(cw + 5 * DFF + wcol), vb = *(const f32x4*)(cb + DFF + wcol);
#pragma unroll
            for (int ai = 0; ai < 2; ++ai) { const int rg = 2 * ai + wr;
                bf16_t* ap = ACT + ((long)u.pm + u.t0 + 128 * ai + 64 * wr + fr) * DFF + gc + 4 * n;
#pragma unroll
                for (int m = 0; m < 4; ++m) {
                    const int j = 128 * ai + 64 * wr + 16 * m + fr, t = u.t0 + j;
                    f32x4 res;
#pragma unroll
                    for (int bj = 0; bj < 2; ++bj) {
                        const f32x4 cur = acc[ai][bj][m][n];
                        const f32x4 sp = (m > 0 && fr == 15) ? acc[ai][bj][m > 0 ? m - 1 : 0][n] : cur;
                        const f32x4 sn = (m < 3 && fr == 0) ? acc[ai][bj][m < 3 ? m + 1 : 3][n] : cur;
                        f32x4 pv, nv;
#pragma unroll
                        for (int i = 0; i < 4; ++i) { pv[i] = __shfl(sp[i], srcR); nv[i] = __shfl(sn[i], srcL); }
                        if (m == 0) { const f32x4 xprev = rg > 0 ? *(const LAS f32x4*)(xch + ((rg - 1) * 2 + 1) * 256 + bj * 128 + cin + 4 * n) : (f32x4){0.f, 0.f, 0.f, 0.f}; if (fr == 0) pv = xprev; }
                        if (m == 3) { const f32x4 xnext = rg < 3 ? *(const LAS f32x4*)(xch + ((rg + 1) * 2 + 0) * 256 + bj * 128 + cin + 4 * n) : (f32x4){0.f, 0.f, 0.f, 0.f}; if (fr == 15) nv = xnext; }
                        if (t < 1) pv = (f32x4){0.f, 0.f, 0.f, 0.f};
                        if (t >= u.T - 1) nv = (f32x4){0.f, 0.f, 0.f, 0.f};
                        if (bj == 0) { const f32x4 cv = g0 * pv + g1 * cur + g2 * nv + gb; res = (f32x4){cv[0] * sigmoidf_(cv[0]), cv[1] * sigmoidf_(cv[1]), cv[2] * sigmoidf_(cv[2]), cv[3] * sigmoidf_(cv[3])}; }
                        else { const f32x4 cv = v0 * pv + v1 * cur + v2 * nv + vb; res = res * cv; }
                    }
                    if (j >= 1 && j <= 254) { u32x2 w; w.x = cvt_pk_bf16(res[0], res[1]); w.y = cvt_pk_bf16(res[2], res[3]); *(u32x2*)ap = w; }
                    ap += 16 * DFF; asm volatile("" : "+v"(ap) :: "memory");
                }
            }
        }
    }
};

__global__ void __launch_bounds__(NTHR, 2) enc_fwd(Args args) {
    extern __shared__ __attribute__((aligned(16))) unsigned char lds_raw[];
    cg::grid_group grid = cg::this_grid();
    LAS unsigned char* lds = (LAS unsigned char*)lds_raw;
    const int tid = threadIdx.x;
    const int G = gridDim.x, bx = blockIdx.x, vcu = (G % 8 == 0) ? (bx % 8) * (G / 8) + bx / 8 : bx;
    unsigned char* ws = args.ws;
    const int lo = args.ph_lo, hi = args.ph_hi;
#ifndef P2M
#define P2M 7
#endif
#ifndef PH_MASK
#define PH_MASK 0x1ff
#endif
#define IN(k) (((PH_MASK >> (k)) & 1) && lo <= (k) && (k) < hi)
#define SEAM(k) do { if (IN(k) && IN((k) + 1)) grid.sync(); } while (0)
#ifndef PROBE
#define PROBE 0
#endif
    unsigned long long tp0 = 0, tp1 = 0;
#define TSTAMP(v) do { if (PROBE) { v = __builtin_amdgcn_s_memrealtime(); } } while (0)

    if (IN(0)) p0_prologue(args, lds, vcu, G);
    SEAM(0);
    if (IN(1)) {
        SchedIn S{vcu, G, (const char*)(ws + WS_H), (const char*)(ws + WS_WIN), (const char*)(ws + WS_MEMN), (const char*)(ws + WS_WKV)};
        EpiIn E{(bf16_t*)(ws + WS_QK), (bf16_t*)(ws + WS_VM), (bf16_t*)args.out, (bf16_t*)(ws + WS_KVM), args.in[6], args.in[7], (const float*)(ws + WS_ROPE), (const float*)(ws + WS_ROPE) + TP * 32};
        pg8::gemm_phase<EpiIn, SchedIn, true>(lds, 2048, S, E);
    }
    SEAM(1);
    if (PROBE == 1 || PROBE == 2) TSTAMP(tp0);
    if (IN(2)) {
        unsigned* ctl = (unsigned*)(ws + WS_CTL);
        volatile LAS unsigned* jobw = (volatile LAS unsigned*)(lds + LDS_MISC);
        const float lam = ((const float*)ctl)[CW_LAM];
        scan::P sp{(const bf16_t*)args.out, (bf16_t*)(ws + WS_Y), (float*)(ws + WS_BON), args.in[13], args.in[14], args.in[15], args.in[16], args.in[17], args.in[18], args.in[20], args.in[21], args.in[22]};
        for (;;) {
            __syncthreads();
            if (tid == 0) jobw[0] = atomicAdd(ctl + CW_QUEUE, 1u);
            __syncthreads();
            const int jb = (int)jobw[0];
            if (jb >= 320 + 1536 + 768) break;
            if (((P2M) & 1) && jb < 320) {
                int s, r; if (jb < 64) { s = 0; r = jb; } else { s = 1 + (jb - 64) / 64; r = (jb - 64) % 64; }
                scan::job(s, r & 1, (r >> 1) & 15, r >> 5, sp, (char*)lds_raw);
                if (PROBE == 2 && tid == 0) atomicMax((unsigned long long*)(ctl + 256), (unsigned long long)__builtin_amdgcn_s_memrealtime());
            } else if (((P2M) & 2) && jb < 320 + 1536) {
                const int a = jb - 320; int s, h, qb;
                if (a < 512) { s = 0; h = a / 64; qb = a % 64; } else { const int b = a - 512; s = 1 + b / 256; h = (b % 256) / 32; qb = b % 32; }
                att::diff_unit(s, h, qb, (bf16_t*)(ws + WS_QK), (const bf16_t*)(ws + WS_VM), lam, (char*)lds_raw);
            } else if ((P2M) & 4) {
                const int a = jb - 320 - 1536; int s, mh, qb;
                if (a < 256) { s = 0; mh = a / 64; qb = a % 64; } else { const int b = a - 256; s = 1 + b / 128; mh = (b % 128) / 32; qb = b % 32; }
                att::mem_unit(s, mh, qb, (bf16_t*)(ws + WS_VM), (const bf16_t*)(ws + WS_KVM), args.in[27], args.in[28], (char*)lds_raw);
            }
        }
    }
    SEAM(2);
    if (PROBE == 1) TSTAMP(tp1);
    if (IN(3)) p4_post(args, (char*)lds_raw, vcu, G);
    SEAM(3);
    if (IN(4)) {
        SchedMerge S{vcu, G, (const char*)(ws + WS_H), (const char*)(ws + WS_WG), (const char*)(ws + WS_QK), (const char*)(ws + WS_VM), (const char*)(ws + WS_PAR), (const char*)(ws + WS_PM2)};
        unsigned char* scr = (unsigned char*)args.out + (size_t)bx * (384 * 1024);
        EpiMerge E{(u32x4*)scr, (f32x4*)(scr + 128 * 1024), (bf16_t*)(ws + WS_MRG)};
        pg8::gemm_phase<EpiMerge, SchedMerge, true>(lds, 2048, S, E);
    }
    SEAM(4);
    if (IN(5)) {
        SchedSq S{vcu, G, (const char*)(ws + WS_MRG), (const char*)(ws + WS_WO), MiB, MiB, 32};
        EpiWo E{args.in[0], args.in[1], args.out};
        pg8::gemm_phase<EpiWo, SchedSq, true>(lds, 2048, S, E);
    }
    SEAM(5);
    if (IN(6)) {
        const int lane = tid & 63, gw = vcu * 8 + (tid >> 6), NGW = G * 8;
        for (int m = gw; m < NT; m += NGW) rms_row(args.out + (size_t)m * DM, args.in[33], (bf16_t*)(ws + WS_H) + (size_t)m * DM, lane);
    }
    SEAM(6);
    if (IN(7)) {
        SchedUp S{vcu, G, (const char*)(ws + WS_H), (const char*)(ws + WS_WUP)};
        EpiUp E{(bf16_t*)(ws + WS_ACT), args.in[35], args.in[36], (LAS float*)(lds + LDS_XCH)};
        pg8::gemm_phase<EpiUp, SchedUp, true>(lds, 2048, S, E);
    }
    SEAM(7);
    if (IN(8)) {
        SchedSq S{vcu, G, (const char*)(ws + WS_ACT), (const char*)(ws + WS_WDN), (size_t)256 * DFF * 2, (size_t)256 * DFF * 2, 88};
        EpiDown E{args.out};
        pg8::gemm_phase<EpiDown, SchedSq, true>(lds, DFF, S, E);
    }
    if (PROBE && bx == 0 && tid == 0) {
        if (PROBE == 2) tp1 = __hip_atomic_load((unsigned long long*)(ws + WS_CTL) + 128, __ATOMIC_RELAXED, __HIP_MEMORY_SCOPE_AGENT);
        const unsigned long long target = __builtin_amdgcn_s_memrealtime() + (tp1 > tp0 ? tp1 - tp0 : 0);
        while (__builtin_amdgcn_s_memrealtime() < target) __builtin_amdgcn_s_sleep(16);
    }
#undef IN
#undef SEAM
}

#ifndef MK_SPLIT
#define MK_SPLIT 0
#endif
extern "C" void kernel_launch(void* const* d_in, const int* in_sizes, int n_in, void* d_out, int out_size, void* d_ws, size_t ws_size, hipStream_t stream) {
    static int grid = 0;
    if (grid == 0) {
        if (n_in != 38 || out_size != NT * DM || ws_size < WS_END) { fprintf(stderr, "kernel_launch: unexpected shapes n_in %d out %d ws %zu\n", n_in, out_size, ws_size); grid = -1; return; }
        int dev = 0, cus = 0, per_cu = 0;
        hipGetDevice(&dev); hipDeviceGetAttribute(&cus, hipDeviceAttributeMultiprocessorCount, dev);
        if (hipFuncSetAttribute((const void*)enc_fwd, hipFuncAttributeMaxDynamicSharedMemorySize, LDS_BYTES) != hipSuccess) { fprintf(stderr, "kernel_launch: hipFuncSetAttribute failed\n"); grid = -1; return; }
        if (hipOccupancyMaxActiveBlocksPerMultiprocessor(&per_cu, (const void*)enc_fwd, NTHR, LDS_BYTES) != hipSuccess || per_cu < 1) { fprintf(stderr, "kernel_launch: occupancy query failed (%d)\n", per_cu); per_cu = 1; }
        (void)hipGetLastError();
        grid = cus * 1;
    }
    if (grid < 0) return;
    Args a{};
    for (int i = 0; i < 38; ++i) a.in[i] = (const float*)d_in[i];
    a.out = (float*)d_out; a.ws = (unsigned char*)d_ws;
    for (int d = 0; d < 32; ++d) a.inv_rev[d] = pow(10000.0, -(double)d / 32.0) / 6.283185307179586476925286766559;
#if MK_SPLIT
    for (int ph = 0; ph < 9; ++ph) { a.ph_lo = ph; a.ph_hi = ph + 1; void* kargs[] = {&a};
        hipError_t e = hipLaunchCooperativeKernel((const void*)enc_fwd, dim3(grid), dim3(NTHR), kargs, LDS_BYTES, stream);
        if (e != hipSuccess) { fprintf(stderr, "launch %d failed: %s\n", ph, hipGetErrorString(e)); break; } }
#else
    a.ph_lo = 0; a.ph_hi = 9;
    void* kargs[] = {&a};
    hipError_t e = hipLaunchCooperativeKernel((const void*)enc_fwd, dim3(grid), dim3(NTHR), kargs, LDS_BYTES, stream);
    if (e != hipSuccess) fprintf(stderr, "cooperative launch failed: %s (grid %d)\n", hipGetErrorString(e), grid);
#endif
}
```

```cpp
#include <hip/hip_runtime.h>
#include <hip/hip_cooperative_groups.h>
#include <cstdio>
#include <cstdint>
#include <cmath>
namespace cg = cooperative_groups;

#define LAS __attribute__((address_space(3)))
typedef unsigned short bf16_t;
typedef short bf16x8 __attribute__((ext_vector_type(8)));
typedef short s16x4 __attribute__((ext_vector_type(4)));
typedef float f32x2 __attribute__((ext_vector_type(2)));
typedef float f32x4 __attribute__((ext_vector_type(4)));
typedef float f32x16 __attribute__((ext_vector_type(16)));
typedef unsigned u32x2 __attribute__((ext_vector_type(2)));
typedef unsigned u32x4 __attribute__((ext_vector_type(4)));

constexpr int NT = 49152, DM = 2048, TP = 16384, TS = 8192, NSEQ = 5;
constexpr int ZRP = 3584;
constexpr int DFF = 5632;
constexpr int NTHR = 512;
constexpr size_t MiB = 1u << 20;
constexpr size_t WS_CTL = 0, WS_WIN = 1 * MiB, WS_WG = 31 * MiB, WS_WKV = 55 * MiB, WS_PAR = 63 * MiB, WS_PM2 = 71 * MiB, WS_WO = 79 * MiB,
                 WS_WUP = 87 * MiB, WS_WDN = 131 * MiB, WS_ROPE = 153 * MiB, WS_MEMN = 157 * MiB, WS_KVM = 162 * MiB, WS_BON = 167 * MiB,
                 WS_H = 176 * MiB, WS_QK = 370 * MiB, WS_VM = 562 * MiB, WS_Y = 754 * MiB, WS_ACT = 370 * MiB, WS_MRG = 754 * MiB, WS_END = 946 * MiB;
constexpr int CW_QUEUE = 64, CW_LAM = 128;
constexpr int LDS_XCH = 131072, LDS_MISC = 131072 + 8192, LDS_BYTES = 131072 + 8192 + 256;

__device__ __forceinline__ int seq_start(int s) { return s == 0 ? 0 : TP + (s - 1) * TS; }
__device__ __forceinline__ int seq_len(int s) { return s == 0 ? TP : TS; }
__device__ __forceinline__ int tok_pos(int tok) { return tok < TP ? tok : ((tok - TP) & (TS - 1)); }

__device__ __forceinline__ unsigned cvt_pk_bf16(float lo, float hi) { unsigned r; asm volatile("v_cvt_pk_bf16_f32 %0, %1, %2" : "=v"(r) : "v"(lo), "v"(hi)); return r; }
__device__ __forceinline__ float bflo(unsigned w) { return __uint_as_float(w << 16); }
__device__ __forceinline__ float bfhi(unsigned w) { return __uint_as_float(w & 0xffff0000u); }
__device__ __forceinline__ float bf1(bf16_t b) { return __uint_as_float((unsigned)b << 16); }
__device__ __forceinline__ float sigmoidf_(float x) { return 1.f / (1.f + __expf(-x)); }
__device__ __forceinline__ float wave_sum(float v) {
#pragma unroll
    for (int o = 1; o < 64; o <<= 1) v += __shfl_xor(v, o);
    return v;
}

namespace pg8 {
constexpr int BM = 256, BK = 64, HALF = 128, HTB = HALF * BK * 2, STAGE_BYTES = 8 * HTB;
__host__ __device__ __forceinline__ int lds_byte(int r, int c) { const int st = (r >> 4) * 2 + (c >> 5), rr = r & 15, cc = c & 31, ob = rr * 64 + cc * 2; return st * 1024 + (ob ^ (((ob >> 9) & 1) << 5)); }
__host__ __device__ __forceinline__ void stage_rc(int b, int& R, int& C) { const int st = b / 1024, sb = b % 1024, swz = sb ^ (((sb >> 9) & 1) << 5); R = (st >> 1) * 16 + swz / 64; C = (st & 1) * 32 + (swz % 64) / 2; }
__host__ __device__ __forceinline__ int perm32(int rho) { const int n = rho >> 4, i = rho & 15; return 8 * (i >> 2) + 4 * n + (i & 3); }

struct Unit { const char* A; const char* B; int nt, pm, pn, kind, t0, T; };

template <class Epi, class Sched, bool ALIGN_EPI>
__device__ __forceinline__ void gemm_phase(LAS unsigned char* lds, const int ld, const Sched& S, const Epi& E) {
    const int tid = threadIdx.x, wid = __builtin_amdgcn_readfirstlane(tid >> 6), lane = tid & 63, wr = wid >> 2, wc = wid & 3, fr = lane & 15, fq = lane >> 4;
    unsigned voffA[2], voffB[2];
#pragma unroll
    for (int i = 0; i < 2; ++i) { int R, C; stage_rc(tid * 16 + i * 8192, R, C); const int Rb = (R & ~31) + perm32(R & 31);
        voffA[i] = (unsigned)(R * ld + C) * 2u; voffB[i] = (unsigned)(Rb * ld + C) * 2u; }
    const size_t kstep = (size_t)(BK * 2);
    const size_t hstep = (size_t)HALF * ld * 2;
    const unsigned ldsw = (unsigned)wid * 1024u;
    const int aoff = lds_byte(wr * 64 + fr, fq * 8), boff = lds_byte(wc * 32 + fr, fq * 8);
#define PG8_SA(b, h) (((b) * 2 + (h)) * HTB)
#define PG8_SB(b, h) ((4 + (b) * 2 + (h)) * HTB)
#define PG8_STAGE(bufoff, gbase, voff) do { _Pragma("unroll") for (int _i = 0; _i < 2; ++_i) \
        __builtin_amdgcn_global_load_lds((const unsigned*)((const char*)(gbase) + (voff)[_i]), (LAS unsigned*)(lds + (bufoff) + ldsw + _i * 8192), 16, 0, 0); } while (0)
#define PG8_LDA(dst, b, h) do { _Pragma("unroll") for (int m = 0; m < 4; ++m) _Pragma("unroll") for (int k = 0; k < 2; ++k) dst[m][k] = *(const LAS bf16x8*)(lds + PG8_SA(b, h) + aoff + m * 2048 + k * 1024); } while (0)
#define PG8_LDB(dst, b, h) do { _Pragma("unroll") for (int n = 0; n < 2; ++n) _Pragma("unroll") for (int k = 0; k < 2; ++k) dst[n][k] = *(const LAS bf16x8*)(lds + PG8_SB(b, h) + boff + n * 2048 + k * 1024); } while (0)
#define PG8_MMA(ai, bj, At, Bt) do { __builtin_amdgcn_s_setprio(1); _Pragma("unroll") for (int m = 0; m < 4; ++m) _Pragma("unroll") for (int n = 0; n < 2; ++n) _Pragma("unroll") for (int k = 0; k < 2; ++k) \
        acc[ai][bj][m][n] = __builtin_amdgcn_mfma_f32_16x16x32_bf16(Bt[n][k], At[m][k], acc[ai][bj][m][n], 0, 0, 0); __builtin_amdgcn_s_setprio(0); } while (0)
#define PG8_WAIT_V(n) asm volatile("s_waitcnt vmcnt(" #n ")" ::: "memory")
#define PG8_WAIT_L(n) asm volatile("s_waitcnt lgkmcnt(" #n ")" ::: "memory")
#define PG8_BAR __builtin_amdgcn_s_barrier()
#define PG8_SCHED __builtin_amdgcn_sched_barrier(0)
    Unit cur, nxt; int ui = 0;
    if (!S.next(0, cur)) return;
    f32x4 acc[2][2][4][2];
#pragma unroll
    for (int a = 0; a < 2; ++a)
#pragma unroll
        for (int b = 0; b < 2; ++b)
#pragma unroll
            for (int m = 0; m < 4; ++m)
#pragma unroll
                for (int n = 0; n < 2; ++n) acc[a][b][m][n] = (f32x4){0.f, 0.f, 0.f, 0.f};
    bf16x8 At[4][2], B0[2][2], B1[2][2];
    const char* cA = cur.A; const char* cB = cur.B;
    PG8_STAGE(PG8_SB(0, 0), cB, voffB); PG8_STAGE(PG8_SB(0, 1), cB + hstep, voffB); PG8_STAGE(PG8_SA(0, 0), cA, voffA); PG8_STAGE(PG8_SA(0, 1), cA + hstep, voffA);
    if (wr == 1) PG8_BAR;
    PG8_WAIT_V(2); PG8_BAR;
    PG8_STAGE(PG8_SB(1, 0), cB + kstep, voffB); PG8_STAGE(PG8_SA(1, 0), cA + kstep, voffA); PG8_STAGE(PG8_SB(1, 1), cB + hstep + kstep, voffB);
    PG8_WAIT_V(6); PG8_BAR;
    for (;;) {
        const bool has_next = S.next(ui + 1, nxt);
        const char* nA = has_next ? nxt.A : cA; const char* nB = has_next ? nxt.B : cB;
        const int nt = cur.nt;
        for (int t = 0; t < nt; t += 2) {
            const bool last = (t == nt - 2);
            const char* a1 = cA + (size_t)(t + 1) * kstep;
            const char* a2 = last ? nA : cA + (size_t)(t + 2) * kstep; const char* b2 = last ? nB : cB + (size_t)(t + 2) * kstep;
            const char* a3 = a2 + kstep; const char* b3 = b2 + kstep;
            PG8_LDB(B0, 0, 0); PG8_LDB(B1, 0, 1); PG8_SCHED; PG8_LDA(At, 0, 0); PG8_STAGE(PG8_SA(1, 1), a1 + hstep, voffA);
            PG8_WAIT_V(8); PG8_WAIT_L(0); PG8_BAR; PG8_MMA(0, 0, At, B0); PG8_MMA(0, 1, At, B1); PG8_BAR; PG8_SCHED;
            PG8_LDA(At, 0, 1); PG8_STAGE(PG8_SB(0, 0), b2, voffB); PG8_STAGE(PG8_SB(0, 1), b2 + hstep, voffB); PG8_STAGE(PG8_SA(0, 0), a2, voffA);
            PG8_WAIT_V(8); PG8_WAIT_L(0); PG8_BAR; PG8_MMA(1, 0, At, B0); PG8_MMA(1, 1, At, B1); PG8_BAR; PG8_SCHED;
            PG8_LDB(B0, 1, 0); PG8_LDB(B1, 1, 1); PG8_SCHED; PG8_LDA(At, 1, 0); PG8_STAGE(PG8_SA(0, 1), a2 + hstep, voffA);
            PG8_WAIT_V(8); PG8_WAIT_L(0); PG8_BAR; PG8_MMA(0, 0, At, B0); PG8_MMA(0, 1, At, B1); PG8_BAR; PG8_SCHED;
            PG8_LDA(At, 1, 1); PG8_STAGE(PG8_SB(1, 0), b3, voffB); PG8_STAGE(PG8_SB(1, 1), b3 + hstep, voffB); PG8_STAGE(PG8_SA(1, 0), a3, voffA);
            PG8_WAIT_V(8); PG8_WAIT_L(0); PG8_BAR; PG8_MMA(1, 0, At, B0); PG8_MMA(1, 1, At, B1); PG8_BAR; PG8_SCHED;
        }
        if constexpr (ALIGN_EPI) { if (wr == 0) PG8_BAR; }
        E(acc, cur, wr, wc, fr, fq);
        if (!has_next) break;
#pragma unroll
        for (int a = 0; a < 2; ++a)
#pragma unroll
            for (int b = 0; b < 2; ++b)
#pragma unroll
                for (int m = 0; m < 4; ++m)
#pragma unroll
                    for (int n = 0; n < 2; ++n) acc[a][b][m][n] = (f32x4){0.f, 0.f, 0.f, 0.f};
        cur = nxt; cA = nA; cB = nB; ++ui;
        if constexpr (ALIGN_EPI) { if (wr == 1) PG8_BAR; }
    }
    PG8_WAIT_V(0);
    if constexpr (!ALIGN_EPI) { if (wr == 0) PG8_BAR; }
    PG8_BAR;
#undef PG8_SA
#undef PG8_SB
#undef PG8_STAGE
#undef PG8_LDA
#undef PG8_LDB
#undef PG8_MMA
#undef PG8_WAIT_V
#undef PG8_WAIT_L
#undef PG8_BAR
#undef PG8_SCHED
}
}
using pg8::Unit;

struct TileMap {
    int nM, nN;
    __device__ __forceinline__ bool get(long L, int& pm, int& pn) const {
        if (L >= (long)nM * nN) return false;
        const int nig = 16 * nN, gid = (int)(L / nig), fm = gid * 16, gsz = (nM - fm) < 16 ? (nM - fm) : 16, r = (int)(L % nig);
        pm = fm + r % gsz; pn = r / gsz; return true;
    }
};

struct Args {
    const float* in[38];
    float* out; unsigned char* ws;
    double inv_rev[32];
    int ph_lo, ph_hi;
};

__device__ __forceinline__ void tr_item(const float* W, int N, int src_n0, bf16_t* WT, size_t ldw, int koff, int r0, int k0, LAS float* scr, int lane) {
    if (src_n0 >= 0) {
#pragma unroll 8
        for (int i = 0; i < 32; ++i) { const int kk = 2 * i + (lane >> 5); scr[kk * 33 + (lane & 31)] = W[(size_t)(k0 + kk) * N + src_n0 + (lane & 31)]; }
    } else {
#pragma unroll 8
        for (int i = 0; i < 32; ++i) { const int kk = 2 * i + (lane >> 5); scr[kk * 33 + (lane & 31)] = 0.f; }
    }
    asm volatile("s_waitcnt lgkmcnt(0)" ::: "memory");
    const int c = lane & 7;
#pragma unroll
    for (int j = 0; j < 4; ++j) { const int n = (lane >> 3) + 8 * j; const LAS float* s = scr + (8 * c) * 33 + n;
        u32x4 o; o.x = cvt_pk_bf16(s[0 * 33], s[1 * 33]); o.y = cvt_pk_bf16(s[2 * 33], s[3 * 33]); o.z = cvt_pk_bf16(s[4 * 33], s[5 * 33]); o.w = cvt_pk_bf16(s[6 * 33], s[7 * 33]);
        *(u32x4*)(WT + (size_t)(r0 + n) * ldw + koff + k0 + 8 * c) = o; }
    asm volatile("s_waitcnt lgkmcnt(0)" ::: "memory");
}
__device__ __forceinline__ void rms_row(const float* xrow, const float* g, bf16_t* orow, int lane) {
    f32x4 v[8]; float s = 0.f;
#pragma unroll
    for (int j = 0; j < 8; ++j) { v[j] = ((const f32x4*)xrow)[64 * j + lane]; s += (v[j].x * v[j].x + v[j].y * v[j].y) + (v[j].z * v[j].z + v[j].w * v[j].w); }
    const float rstd = rsqrtf(wave_sum(s) * (1.f / DM) + 1e-6f);
#pragma unroll
    for (int j = 0; j < 8; ++j) { const f32x4 gg = ((const f32x4*)g)[64 * j + lane];
        u32x2 w; w.x = cvt_pk_bf16(v[j].x * rstd * gg.x, v[j].y * rstd * gg.y); w.y = cvt_pk_bf16(v[j].z * rstd * gg.z, v[j].w * rstd * gg.w);
        ((u32x2*)orow)[64 * j + lane] = w; }
}

__device__ __forceinline__ void p0_prologue(const Args& a, LAS unsigned char* lds, int vcu, int G) {
    const int tid = threadIdx.x, lane = tid & 63, wave = tid >> 6;
    unsigned char* ws = a.ws;
    LAS float* scr = (LAS float*)(lds + wave * 16384);
    const int gw = vcu * 8 + wave, NGW = G * 8;
    constexpr int I0 = 32 * 240, I1 = 32 * 192, I2 = 32 * 64, I3 = 16 * 64, I6 = 32 * 64, I7 = 32 * 352, I8 = 88 * 64;
    constexpr int NITEMS = I0 + I1 + I2 + 3 * I3 + I6 + I7 + I8;
    for (int it = gw; it < NITEMS; it += NGW) {
        int r = it;
        if (r < I0) { const int kb = r / 240, nb = r % 240, r0 = nb * 32; int src;
            if (r0 < 2048) { const int tile = r0 >> 8, cp = r0 & 255, h = cp >> 7, g = (cp & 127) >> 5; src = tile * 256 + 64 * g + 32 * h; }
            else if (r0 < 6560) src = r0;
            else if (r0 < 6656) src = -1;
            else src = 6560 + (r0 - 6656);
            tr_item(a.in[5], 13728, src, (bf16_t*)(ws + WS_WIN), 2048, 0, r0, kb * 64, scr, lane); continue; } r -= I0;
        if (r < I1) { const int kb = r / 192, nb = r % 192; tr_item(a.in[5], 13728, 7584 + nb * 32, (bf16_t*)(ws + WS_WG), 2048, 0, nb * 32, kb * 64, scr, lane); continue; } r -= I1;
        if (r < I2) { const int kb = r / 64, nb = r % 64; tr_item(a.in[26], 2048, nb * 32, (bf16_t*)(ws + WS_WKV), 2048, 0, nb * 32, kb * 64, scr, lane); continue; } r -= I2;
        if (r < I3) { const int kb = r / 64, nb = r % 64; tr_item(a.in[29], 2048, nb * 32, (bf16_t*)(ws + WS_PAR), 2048, 0, nb * 32, kb * 64, scr, lane); continue; } r -= I3;
        if (r < I3) { const int kb = r / 64, nb = r % 64; tr_item(a.in[30], 2048, nb * 32, (bf16_t*)(ws + WS_PAR), 2048, 1024, nb * 32, kb * 64, scr, lane); continue; } r -= I3;
        if (r < I3) { const int kb = r / 64, nb = r % 64; tr_item(a.in[31], 2048, nb * 32, (bf16_t*)(ws + WS_PM2), 2048, 0, nb * 32, kb * 64, scr, lane); continue; } r -= I3;
        if (r < I6) { const int kb = r / 64, nb = r % 64; tr_item(a.in[32], 2048, nb * 32, (bf16_t*)(ws + WS_WO), 2048, 0, nb * 32, kb * 64, scr, lane); continue; } r -= I6;
        if (r < I7) { const int kb = r / 352, nb = r % 352, r0 = nb * 32, tile = r0 >> 8, bj = (r0 & 255) >> 7, j = r0 & 127;
            tr_item(a.in[34], 2 * DFF, bj * DFF + 128 * tile + j, (bf16_t*)(ws + WS_WUP), 2048, 0, r0, kb * 64, scr, lane); continue; } r -= I7;
        { const int kb = r / 64, nb = r % 64; tr_item(a.in[37], 2048, nb * 32, (bf16_t*)(ws + WS_WDN), DFF, 0, nb * 32, kb * 64, scr, lane); }
    }
    for (int m = gw; m < NT + 1280; m += NGW) {
        if (m < NT) { const float* xr = m < TP ? a.in[0] + (size_t)m * DM : a.in[1] + (size_t)(m - TP) * DM; rms_row(xr, a.in[4], (bf16_t*)(ws + WS_H) + (size_t)m * DM, lane); }
        else { const int j = m - NT; const float* xr = j < 256 ? a.in[2] + (size_t)j * DM : a.in[3] + (size_t)(j - 256) * DM; rms_row(xr, a.in[25], (bf16_t*)(ws + WS_MEMN) + (size_t)j * DM, lane); }
    }
    { float* rc = (float*)(ws + WS_ROPE); float* rs = rc + TP * 32;
      for (int e = (vcu * NTHR + tid); e < TP * 32; e += G * NTHR) { const int t = e >> 5, d = e & 31; double rev = (double)t * a.inv_rev[d]; rev -= rint(rev); const float rf = (float)rev;
          rc[e] = __builtin_amdgcn_cosf(rf); rs[e] = __builtin_amdgcn_sinf(rf); } }
    if (blockIdx.x == 0) {
        unsigned* ctl = (unsigned*)(ws + WS_CTL);
        if (tid < 64) {
            if (tid == 0) { ctl[CW_QUEUE] = 0u; ctl[256] = 0u; ctl[257] = 0u; }
            const float s1 = wave_sum(a.in[8][tid] * a.in[9][tid]), s2 = wave_sum(a.in[10][tid] * a.in[11][tid]);
            if (tid == 0) ((float*)ctl)[CW_LAM] = __expf(s1) - __expf(s2) + 0.2f;
        }
    }
}

struct SchedIn {
    int v, G; const char* H; const char* WIN; const char* MEMN; const char* WKV;
    __device__ __forceinline__ bool next(int i, Unit& u) const {
        long L = (long)i * G + v; int pm, pn;
        if (L < 5760) { TileMap{192, 30}.get(L, pm, pn); u.A = H + (size_t)pm * MiB; u.B = WIN + (size_t)pn * MiB; u.nt = 32; u.pm = pm; u.pn = pn; u.kind = 0; u.t0 = 0; u.T = 0; return true; }
        L -= 5760; if (L < 40) { pm = (int)(L % 5); pn = (int)(L / 5); u.A = MEMN + (size_t)pm * MiB; u.B = WKV + (size_t)pn * MiB; u.nt = 32; u.pm = pm; u.pn = pn; u.kind = 1; u.t0 = 0; u.T = 0; return true; }
        return false;
    }
};
struct EpiIn {
    bf16_t* QK; bf16_t* VM; bf16_t* ZR; bf16_t* KVM; const float* qn; const float* kn; const float* rc; const float* rs;
    __device__ __forceinline__ void plain(const f32x4 (&acc)[2][2][4][2], bf16_t* base, size_t ldc, int row0, int col0) const {
#pragma unroll
        for (int ai = 0; ai < 2; ++ai)
#pragma unroll
            for (int m = 0; m < 4; ++m) { bf16_t* rowp = base + (size_t)(row0 + ai * 128 + m * 16) * ldc + col0;
#pragma unroll
                for (int bj = 0; bj < 2; ++bj) { const f32x4 v0 = acc[ai][bj][m][0], v1 = acc[ai][bj][m][1];
                    u32x4 w; w.x = cvt_pk_bf16(v0[0], v0[1]); w.y = cvt_pk_bf16(v0[2], v0[3]); w.z = cvt_pk_bf16(v1[0], v1[1]); w.w = cvt_pk_bf16(v1[2], v1[3]);
                    *(u32x4*)(rowp + bj * 128) = w; } }
    }
    __device__ __forceinline__ void operator()(const f32x4 (&acc)[2][2][4][2], const Unit& u, int wr, int wc, int fr, int fq) const {
        const int row0 = u.pm * 256 + wr * 64 + fr, cin = wc * 32 + 8 * fq;
        if (u.kind == 1) { plain(acc, KVM, 2048, row0, u.pn * 256 + cin); return; }
        const int pn = u.pn;
        if (pn < 8) {
            const bool isq = pn < 4; const float* nw = isq ? qn : kn;
            const int Gq = (pn & 3) * 4 + wc, d0 = 8 * fq;
            const float qs = isq ? 0.125f * 1.4426950408889634f : 1.f;
            const f32x4 w1a = *(const f32x4*)(nw + d0), w1b = *(const f32x4*)(nw + d0 + 4), w2a = *(const f32x4*)(nw + 32 + d0), w2b = *(const f32x4*)(nw + 36 + d0);
            bf16_t* dst = QK + (isq ? 0 : 1024) + Gq * 64 + d0;
#pragma unroll
            for (int ai = 0; ai < 2; ++ai)
#pragma unroll
                for (int m = 0; m < 4; ++m) {
                    const int row = row0 + ai * 128 + m * 16, t = tok_pos(row);
                    const f32x4 xa = acc[ai][0][m][0], xb = acc[ai][0][m][1], ya = acc[ai][1][m][0], yb = acc[ai][1][m][1];
                    float ss = (xa[0] * xa[0] + xa[1] * xa[1]) + (xa[2] * xa[2] + xa[3] * xa[3]) + (xb[0] * xb[0] + xb[1] * xb[1]) + (xb[2] * xb[2] + xb[3] * xb[3])
                             + (ya[0] * ya[0] + ya[1] * ya[1]) + (ya[2] * ya[2] + ya[3] * ya[3]) + (yb[0] * yb[0] + yb[1] * yb[1]) + (yb[2] * yb[2] + yb[3] * yb[3]);
                    ss += __shfl_xor(ss, 16); ss += __shfl_xor(ss, 32);
                    const float rstd = rsqrtf(ss * (1.f / 64.f) + 1e-6f);
                    const f32x4 ca = *(const f32x4*)(rc + t * 32 + d0), cb = *(const f32x4*)(rc + t * 32 + d0 + 4), sa = *(const f32x4*)(rs + t * 32 + d0), sb = *(const f32x4*)(rs + t * 32 + d0 + 4);
                    const f32x4 x1a = xa * rstd * w1a, x1b = xb * rstd * w1b, x2a = ya * rstd * w2a, x2b = yb * rstd * w2b;
                    const f32x4 o1a = (x1a * ca - x2a * sa) * qs, o1b = (x1b * cb - x2b * sb) * qs, o2a = (x2a * ca + x1a * sa) * qs, o2b = (x2b * cb + x1b * sb) * qs;
                    u32x4 w; w.x = cvt_pk_bf16(o1a[0], o1a[1]); w.y = cvt_pk_bf16(o1a[2], o1a[3]); w.z = cvt_pk_bf16(o1b[0], o1b[1]); w.w = cvt_pk_bf16(o1b[2], o1b[3]);
                    *(u32x4*)(dst + (size_t)row * 2048) = w;
                    w.x = cvt_pk_bf16(o2a[0], o2a[1]); w.y = cvt_pk_bf16(o2a[2], o2a[3]); w.z = cvt_pk_bf16(o2b[0], o2b[1]); w.w = cvt_pk_bf16(o2b[2], o2b[3]);
                    *(u32x4*)(dst + (size_t)row * 2048 + 32) = w;
                }
        } else if (pn < 12) plain(acc, VM, 2048, row0, (pn - 8) * 256 + cin);
        else if (pn < 26) plain(acc, ZR, ZRP, row0, (pn - 12) * 256 + cin);
        else plain(acc, VM, 2048, row0, 1024 + (pn - 26) * 256 + cin);
    }
};

namespace att {
constexpr int SHM_V = 16384, SHM_K = 8192;
constexpr int OFF_V = 0, OFF_K = 32768, OFF_WS = 49152, OFF_STASH = 51200;
#define KSWZ64(row, colB) ((row) * 128 + ((colB) ^ (((row) & 7) << 4)))
#define SBAR() __builtin_amdgcn_sched_barrier(0)
__device__ __forceinline__ int crow(int r, int hi) { return (r & 3) + 8 * (r >> 2) + 4 * hi; }
constexpr float THRL = 8.f;
__device__ __forceinline__ void partialSM(f32x16& p0, f32x16& p1, float& m_reg, float& alpha) {
    float pmax = p0[0];
#pragma unroll
    for (int r = 1; r < 16; ++r) pmax = fmaxf(pmax, p0[r]);
#pragma unroll
    for (int r = 0; r < 16; ++r) pmax = fmaxf(pmax, p1[r]);
    { auto rr = __builtin_amdgcn_permlane32_swap(__float_as_uint(pmax), __float_as_uint(pmax), false, false);
      pmax = fmaxf(__uint_as_float(rr[0]), __uint_as_float(rr[1])); }
    float mn;
    if (__builtin_expect(__all(pmax - m_reg <= THRL), 1)) { mn = m_reg; alpha = 1.f; }
    else { mn = fmaxf(m_reg, pmax); alpha = __builtin_amdgcn_exp2f(m_reg - mn); m_reg = mn; }
#pragma unroll
    for (int r = 0; r < 16; ++r) p0[r] -= mn;
#pragma unroll
    for (int r = 0; r < 16; ++r) p1[r] -= mn;
#pragma unroll
    for (int r = 0; r < 16; ++r) p0[r] = __builtin_amdgcn_exp2f(p0[r]);
}
__device__ __forceinline__ void finishSM(f32x16& p0, f32x16& p1, float alpha, float& l_reg, bf16x8& pa0, bf16x8& pa1, bf16x8& pa2, bf16x8& pa3) {
#pragma unroll
    for (int r = 0; r < 16; ++r) p1[r] = __builtin_amdgcn_exp2f(p1[r]);
    float ps = 0;
#pragma unroll
    for (int r = 0; r < 16; ++r) ps += p0[r];
#pragma unroll
    for (int r = 0; r < 16; ++r) ps += p1[r];
    { auto rr = __builtin_amdgcn_permlane32_swap(__float_as_uint(ps), __float_as_uint(ps), false, false);
      ps = __uint_as_float(rr[0]) + __uint_as_float(rr[1]); }
    l_reg = l_reg * alpha + ps;
#define PK4(P, BASE, OUT) do { unsigned a0 = cvt_pk_bf16(P[BASE + 0], P[BASE + 1]), a1 = cvt_pk_bf16(P[BASE + 2], P[BASE + 3]);   \
    unsigned b0 = cvt_pk_bf16(P[BASE + 4], P[BASE + 5]), b1 = cvt_pk_bf16(P[BASE + 6], P[BASE + 7]);                              \
    auto r0 = __builtin_amdgcn_permlane32_swap(a0, b0, false, false); auto r1 = __builtin_amdgcn_permlane32_swap(a1, b1, false, false); \
    u32x4 w = {r0[0], r1[0], r0[1], r1[1]}; OUT = *reinterpret_cast<bf16x8*>(&w); } while (0)
    PK4(p0, 0, pa0); PK4(p0, 8, pa1); PK4(p1, 0, pa2); PK4(p1, 8, pa3);
#undef PK4
}
__device__ __forceinline__ void qkt64(f32x16& p0, f32x16& p1, const char* Ks, const bf16x8* qr, int r32, int hi) {
#pragma unroll
    for (int d0 = 0; d0 < 4; ++d0) { const int cb = (d0 * 16 + hi * 8) * 2;
        const bf16x8 b0 = *reinterpret_cast<const bf16x8*>(Ks + KSWZ64(r32, cb));
        const bf16x8 b1 = *reinterpret_cast<const bf16x8*>(Ks + KSWZ64(32 + r32, cb));
        p0 = __builtin_amdgcn_mfma_f32_32x32x16_bf16(b0, qr[d0], p0, 0, 0, 0);
        p1 = __builtin_amdgcn_mfma_f32_32x32x16_bf16(b1, qr[d0], p1, 0, 0, 0); }
}
__device__ __forceinline__ int v_st(int k, int c) { const int kk = (k & ~0xC) | ((k & 4) << 1) | ((k & 8) >> 1); return ((kk >> 3) * 4 + (c >> 5)) * 512 + ((kk & 7) * 32 + (c & 31)) * 2; }
__device__ __forceinline__ int v_rd_base(int lane) { return ((lane & 3) << 3) | (((lane >> 2) & 3) << 6) | (((lane >> 4) & 1) << 5) | (((lane >> 5) & 1) << 8); }
constexpr int v_rd_off(int d0, int ks, int half) { return d0 * 512 + ks * 4096 + half * 2048; }
template <int OFF> __device__ __forceinline__ s16x4 tr_read(int vb) {
    s16x4 r; asm volatile("ds_read_b64_tr_b16 %0, %1 offset:%2" : "=&v"(r) : "v"(vb), "i"(OFF) : "memory"); return r;
}
template <int D0> __device__ __forceinline__ void pv_one(f32x16& od, int vb, bf16x8 pa0, bf16x8 pa1, bf16x8 pa2, bf16x8 pa3) {
    const s16x4 l0 = tr_read<v_rd_off(D0, 0, 0)>(vb), h0 = tr_read<v_rd_off(D0, 0, 1)>(vb), l1 = tr_read<v_rd_off(D0, 1, 0)>(vb), h1 = tr_read<v_rd_off(D0, 1, 1)>(vb);
    const s16x4 l2 = tr_read<v_rd_off(D0, 2, 0)>(vb), h2 = tr_read<v_rd_off(D0, 2, 1)>(vb), l3 = tr_read<v_rd_off(D0, 3, 0)>(vb), h3 = tr_read<v_rd_off(D0, 3, 1)>(vb);
    asm volatile("s_waitcnt lgkmcnt(0)" ::: "memory"); SBAR();
#define PK(L, H) (bf16x8){L[0], L[1], L[2], L[3], H[0], H[1], H[2], H[3]}
    od = __builtin_amdgcn_mfma_f32_32x32x16_bf16(pa0, PK(l0, h0), od, 0, 0, 0);
    od = __builtin_amdgcn_mfma_f32_32x32x16_bf16(pa1, PK(l1, h1), od, 0, 0, 0);
    od = __builtin_amdgcn_mfma_f32_32x32x16_bf16(pa2, PK(l2, h2), od, 0, 0, 0);
    od = __builtin_amdgcn_mfma_f32_32x32x16_bf16(pa3, PK(l3, h3), od, 0, 0, 0);
#undef PK
}
__device__ __forceinline__ void pv_d0(f32x16* o, int vb, bf16x8 pa0, bf16x8 pa1, bf16x8 pa2, bf16x8 pa3) {
    pv_one<0>(o[0], vb, pa0, pa1, pa2, pa3); pv_one<1>(o[1], vb, pa0, pa1, pa2, pa3); pv_one<2>(o[2], vb, pa0, pa1, pa2, pa3); pv_one<3>(o[3], vb, pa0, pa1, pa2, pa3);
}

__device__ __forceinline__ void stash_store(const unsigned* stash, bf16_t* Ow, int ldo, int lane) {
#pragma unroll
    for (int i = 0; i < 8; ++i) { const int q = i * 64 + lane, rl = q >> 4, c8 = (q & 15) * 8, hh = (rl >> 2) & 1, r = (rl & 3) + 4 * (rl >> 3), d0 = c8 >> 5, cc = c8 & 31;
        const unsigned* sp = stash + (d0 * 8 + (r >> 1)) * 64 + hh * 32 + cc; const u32x4 a = *(const u32x4*)sp, b = *(const u32x4*)(sp + 4);
        u32x4 w;
        if (r & 1) { w.x = (a.x >> 16) | (a.y & 0xffff0000u); w.y = (a.z >> 16) | (a.w & 0xffff0000u); w.z = (b.x >> 16) | (b.y & 0xffff0000u); w.w = (b.z >> 16) | (b.w & 0xffff0000u); }
        else { w.x = (a.x & 0xffffu) | (a.y << 16); w.y = (a.z & 0xffffu) | (a.w << 16); w.z = (b.x & 0xffffu) | (b.y << 16); w.w = (b.z & 0xffffu) | (b.w << 16); }
        *(u32x4*)(Ow + (size_t)rl * ldo + c8) = w; }
}

__device__ __forceinline__ void diff_unit(int s, int h, int qb, bf16_t* QK, const bf16_t* VM, float lam, char* lds) {
    constexpr int LDK = 2048;
    int tid = threadIdx.x; asm volatile("" : "+v"(tid));
    const int wid = __builtin_amdgcn_readfirstlane(tid >> 6), lane = tid & 63, r32 = lane & 31, hi = lane >> 5;
    const int tok0 = seq_start(s), T = seq_len(s), NTL = T / 64;
    char* V_lds = lds + OFF_V; char* K_lds = lds + OFF_K;
    float* wsf = (float*)(lds + OFF_WS) + wid * 64; float* li_l = wsf; float* al_l = wsf + 32;
    unsigned* stash = (unsigned*)(lds + OFF_STASH) + wid * 2048;
    const int sr = tid >> 4, sc = (tid & 15) * 8, vst0 = v_st(sr, sc), vst1 = v_st(32 + sr, sc);
    const int kr = tid >> 3, kc = (tid & 7) * 8, kst = KSWZ64(kr, kc * 2);
    const int vb0 = (int)(uintptr_t)V_lds + v_rd_base(lane);
    const bf16_t* Vh = VM + (size_t)tok0 * LDK + h * 128;
    const size_t qrow = (size_t)(tok0 + qb * 256 + wid * 32);
#pragma unroll 1
    for (int c = 0; c < 2; ++c) {
        const bf16_t* Kh = QK + (size_t)tok0 * LDK + 1024 + h * 128 + c * 64;
        const bf16_t* Qw = QK + (qrow + r32) * LDK + h * 128 + c * 64 + hi * 8;
        bf16x8 qr[4];
#pragma unroll
        for (int d0 = 0; d0 < 4; ++d0) qr[d0] = *reinterpret_cast<const bf16x8*>(Qw + d0 * 16);
        float m_reg = -1e30f, l_reg = 0; f32x16 o[4] = {};
        struct { bf16x8 vs0, vs1, ks0; } sr_[2];
#define SLOAD(i, k0) do { sr_[i].vs0 = *reinterpret_cast<const bf16x8*>(&Vh[(size_t)((k0) + sr) * LDK + sc]); sr_[i].vs1 = *reinterpret_cast<const bf16x8*>(&Vh[(size_t)((k0) + 32 + sr) * LDK + sc]); \
    sr_[i].ks0 = *reinterpret_cast<const bf16x8*>(&Kh[(size_t)((k0) + kr) * LDK + kc]); } while (0)
#define SWRITE(b, i) do { *(bf16x8*)(V_lds + (b) * SHM_V + vst0) = sr_[i].vs0; *(bf16x8*)(V_lds + (b) * SHM_V + vst1) = sr_[i].vs1; *(bf16x8*)(K_lds + (b) * SHM_K + kst) = sr_[i].ks0; } while (0)
#define SWAIT() asm volatile("s_waitcnt vmcnt(3)" ::: "memory")
#define RESC(a) do { if (__any((a) < 1.f)) { if (hi == 0) al_l[r32] = (a); asm volatile("s_waitcnt lgkmcnt(0)" ::: "memory"); \
    _Pragma("unroll") for (int d = 0; d < 4; ++d) _Pragma("unroll") for (int r = 0; r < 16; ++r) o[d][r] *= al_l[crow(r, hi)]; } } while (0)
        f32x16 pA0, pA1, pB0, pB1; float alA, alB; bf16x8 pa0, pa1, pa2, pa3;
        SLOAD(0, 0); asm volatile("s_waitcnt vmcnt(0)" ::: "memory"); SWRITE(0, 0); __syncthreads();
        pA0 = f32x16{}; pA1 = f32x16{}; qkt64(pA0, pA1, K_lds, qr, r32, hi); partialSM(pA0, pA1, m_reg, alA);
        SLOAD(1, 64); if (2 < NTL) SLOAD(0, 128);
        SWAIT(); SWRITE(1, 1); __syncthreads();
        for (int j = 1; j + 1 < NTL; j += 2) {
            SBAR(); pB0 = f32x16{}; pB1 = f32x16{}; qkt64(pB0, pB1, K_lds + SHM_K, qr, r32, hi);
            finishSM(pA0, pA1, alA, l_reg, pa0, pa1, pa2, pa3); SBAR();
            SLOAD(1, (j + 2) * 64); SBAR();
            pv_d0(o, vb0, pa0, pa1, pa2, pa3); partialSM(pB0, pB1, m_reg, alB);
            __syncthreads(); SWAIT(); SWRITE(0, 0);
            RESC(alB); __syncthreads();
            SBAR(); pA0 = f32x16{}; pA1 = f32x16{}; qkt64(pA0, pA1, K_lds, qr, r32, hi);
            finishSM(pB0, pB1, alB, l_reg, pa0, pa1, pa2, pa3); SBAR();
            if (j + 3 < NTL) SLOAD(0, (j + 3) * 64); SBAR();
            pv_d0(o, vb0 + SHM_V, pa0, pa1, pa2, pa3); partialSM(pA0, pA1, m_reg, alA);
            __syncthreads(); SWAIT(); SWRITE(1, 1);
            RESC(alA); __syncthreads();
        }
        SBAR(); pB0 = f32x16{}; pB1 = f32x16{}; qkt64(pB0, pB1, K_lds + SHM_K, qr, r32, hi);
        finishSM(pA0, pA1, alA, l_reg, pa0, pa1, pa2, pa3); SBAR();
        pv_d0(o, vb0, pa0, pa1, pa2, pa3); partialSM(pB0, pB1, m_reg, alB);
        __syncthreads(); RESC(alB);
        finishSM(pB0, pB1, alB, l_reg, pa0, pa1, pa2, pa3); SBAR();
        pv_d0(o, vb0 + SHM_V, pa0, pa1, pa2, pa3);
#undef SLOAD
#undef SWRITE
#undef SWAIT
#undef RESC
        if (hi == 0) li_l[r32] = l_reg; asm volatile("s_waitcnt lgkmcnt(0)" ::: "memory");
        float rli[16];
#pragma unroll
        for (int r = 0; r < 16; ++r) rli[r] = __builtin_amdgcn_rcpf(li_l[crow(r, hi)]);
        { const float coef = c == 0 ? 1.f : -lam;
#pragma unroll
          for (int d0 = 0; d0 < 4; ++d0)
#pragma unroll
              for (int r = 0; r < 16; r += 2) { const int idx = (d0 * 8 + (r >> 1)) * 64 + lane; const unsigned w = c == 0 ? 0u : stash[idx];
                  stash[idx] = cvt_pk_bf16(bflo(w) + coef * o[d0][r] * rli[r], bfhi(w) + coef * o[d0][r + 1] * rli[r + 1]); } }
        __syncthreads();
    }
    stash_store(stash, QK + qrow * LDK + h * 128, LDK, lane);
    __syncthreads();
}

constexpr int MOFF_V = 0, MOFF_K = 32768, MOFF_WS = 65536, MOFF_RK = 67584, MOFF_G = 68608, MOFF_STASH = 69632;
__device__ __forceinline__ void mem_unit(int s, int mh, int qb, bf16_t* VM, const bf16_t* KVM, const float* mqn, const float* mkn, char* lds) {
    int tid = threadIdx.x; asm volatile("" : "+v"(tid));
    const int wid = __builtin_amdgcn_readfirstlane(tid >> 6), lane = tid & 63, r32 = lane & 31, hi = lane >> 5;
    const int tok0 = seq_start(s);
    char* V_lds = lds + MOFF_V; char* K_lds = lds + MOFF_K;
    float* wsf = (float*)(lds + MOFF_WS) + wid * 64; float* li_l = wsf; float* al_l = wsf + 32;
    float* rk_l = (float*)(lds + MOFF_RK); float* g_l = (float*)(lds + MOFF_G);
    const bf16_t* Kh = KVM + (size_t)(s * 256) * 2048 + mh * 256;
    const bf16_t* Vh = KVM + (size_t)(s * 256) * 2048 + 1024 + mh * 256;
    if (tid < 256) g_l[tid] = mqn[tid] * mkn[tid];
    {
        const bf16_t* kp = Kh + (size_t)(wid * 32 + r32) * 2048 + hi * 128; float ss = 0.f;
#pragma unroll
        for (int i = 0; i < 16; ++i) { const u32x4 w = *(const u32x4*)(kp + i * 8);
            ss += bflo(w.x) * bflo(w.x) + bfhi(w.x) * bfhi(w.x) + bflo(w.y) * bflo(w.y) + bfhi(w.y) * bfhi(w.y) + bflo(w.z) * bflo(w.z) + bfhi(w.z) * bfhi(w.z) + bflo(w.w) * bflo(w.w) + bfhi(w.w) * bfhi(w.w); }
        ss += __shfl_xor(ss, 32);
        if (hi == 0) rk_l[wid * 32 + r32] = rsqrtf(ss * (1.f / 256.f) + 1e-6f);
    }
    const size_t qrow = (size_t)(tok0 + qb * 256 + wid * 32);
    bf16_t* Qw = VM + (qrow + r32) * 2048 + 1024 + mh * 256 + hi * 8;
    float rqC;
    { float ss = 0.f;
#pragma unroll
      for (int i = 0; i < 16; ++i) { const u32x4 w = *(const u32x4*)(Qw + i * 16);
          ss += bflo(w.x) * bflo(w.x) + bfhi(w.x) * bfhi(w.x) + bflo(w.y) * bflo(w.y) + bfhi(w.y) * bfhi(w.y) + bflo(w.z) * bflo(w.z) + bfhi(w.z) * bfhi(w.z) + bflo(w.w) * bflo(w.w) + bfhi(w.w) * bfhi(w.w); }
      ss += __shfl_xor(ss, 32);
      rqC = rsqrtf(ss * (1.f / 256.f) + 1e-6f) * (0.0625f * 1.4426950408889634f); }
    const int sr = tid >> 4, sc = (tid & 15) * 8, vst0 = v_st(sr, sc), vst1 = v_st(32 + sr, sc);
    const int kr = tid >> 3, kc = (tid & 7) * 8, kst = KSWZ64(kr, kc * 2);
    const int vb0 = (int)(uintptr_t)V_lds + v_rd_base(lane);
    unsigned* stash = (unsigned*)(lds + MOFF_STASH) + wid * 2048;
    __syncthreads();
#pragma unroll 1
    for (int hv = 0; hv < 2; ++hv) {
    float m_reg = -1e30f, l_reg = 0.f; f32x16 o[4] = {};
#pragma unroll 1
    for (int t = 0; t < 4; ++t) {
        const int k0 = t * 64;
#pragma unroll
        for (int ds = 0; ds < 4; ++ds) { const u32x4 w = *(const u32x4*)(Kh + (size_t)(k0 + kr) * 2048 + ds * 64 + kc); const float* g = g_l + ds * 64 + kc;
            u32x4 o4; o4.x = cvt_pk_bf16(bflo(w.x) * g[0], bfhi(w.x) * g[1]); o4.y = cvt_pk_bf16(bflo(w.y) * g[2], bfhi(w.y) * g[3]);
            o4.z = cvt_pk_bf16(bflo(w.z) * g[4], bfhi(w.z) * g[5]); o4.w = cvt_pk_bf16(bflo(w.w) * g[6], bfhi(w.w) * g[7]);
            *(u32x4*)(K_lds + ds * 8192 + kst) = o4; asm volatile("" ::: "memory"); }
        *(u32x4*)(V_lds + vst0) = *(const u32x4*)(Vh + (size_t)(k0 + sr) * 2048 + hv * 128 + sc);
        *(u32x4*)(V_lds + vst1) = *(const u32x4*)(Vh + (size_t)(k0 + 32 + sr) * 2048 + hv * 128 + sc);
        __syncthreads();
        f32x16 p0 = {}, p1 = {};
#pragma unroll
        for (int ds = 0; ds < 4; ++ds) { bf16x8 qr[4];
#pragma unroll
            for (int d0 = 0; d0 < 4; ++d0) qr[d0] = *reinterpret_cast<const bf16x8*>(Qw + ds * 64 + d0 * 16);
            qkt64(p0, p1, K_lds + ds * 8192, qr, r32, hi); }
#pragma unroll
        for (int r = 0; r < 16; ++r) { p0[r] *= rk_l[k0 + crow(r, hi)] * rqC; p1[r] *= rk_l[k0 + 32 + crow(r, hi)] * rqC; }
        float pmax = p0[0];
#pragma unroll
        for (int r = 1; r < 16; ++r) pmax = fmaxf(pmax, p0[r]);
#pragma unroll
        for (int r = 0; r < 16; ++r) pmax = fmaxf(pmax, p1[r]);
        pmax = fmaxf(pmax, __shfl_xor(pmax, 32));
        const float mn = fmaxf(m_reg, pmax), alpha = __builtin_amdgcn_exp2f(m_reg - mn); m_reg = mn;
        float ps = 0.f;
#pragma unroll
        for (int r = 0; r < 16; ++r) { p0[r] = __builtin_amdgcn_exp2f(p0[r] - mn); p1[r] = __builtin_amdgcn_exp2f(p1[r] - mn); ps += p0[r] + p1[r]; }
        ps += __shfl_xor(ps, 32);
        l_reg = l_reg * alpha + ps;
        if (hi == 0) al_l[r32] = alpha; asm volatile("s_waitcnt lgkmcnt(0)" ::: "memory");
#pragma unroll
        for (int d = 0; d < 4; ++d)
#pragma unroll
            for (int r = 0; r < 16; ++r) o[d][r] *= al_l[crow(r, hi)];
        bf16x8 pa0, pa1, pa2, pa3;
#define PK4(P, BASE, OUT) do { unsigned a0 = cvt_pk_bf16(P[BASE + 0], P[BASE + 1]), a1 = cvt_pk_bf16(P[BASE + 2], P[BASE + 3]);   \
    unsigned b0 = cvt_pk_bf16(P[BASE + 4], P[BASE + 5]), b1 = cvt_pk_bf16(P[BASE + 6], P[BASE + 7]);                              \
    auto r0 = __builtin_amdgcn_permlane32_swap(a0, b0, false, false); auto r1 = __builtin_amdgcn_permlane32_swap(a1, b1, false, false); \
    u32x4 w = {r0[0], r1[0], r0[1], r1[1]}; OUT = *reinterpret_cast<bf16x8*>(&w); } while (0)
        PK4(p0, 0, pa0); PK4(p0, 8, pa1); PK4(p1, 0, pa2); PK4(p1, 8, pa3);
#undef PK4
        pv_d0(o, vb0, pa0, pa1, pa2, pa3);
        __syncthreads();
    }
    if (hi == 0) li_l[r32] = l_reg; asm volatile("s_waitcnt lgkmcnt(0)" ::: "memory");
    if (hv == 1) stash_store(stash, VM + qrow * 2048 + 1024 + mh * 256, 2048, lane);
#pragma unroll
    for (int d0 = 0; d0 < 4; ++d0)
#pragma unroll
        for (int r = 0; r < 16; r += 2) stash[(d0 * 8 + (r >> 1)) * 64 + lane] = cvt_pk_bf16(o[d0][r] * __builtin_amdgcn_rcpf(li_l[crow(r, hi)]), o[d0][r + 1] * __builtin_amdgcn_rcpf(li_l[crow(r + 1, hi)]));
    }
    stash_store(stash, VM + qrow * 2048 + 1024 + mh * 256 + 128, 2048, lane);
    __syncthreads();
}
#undef SBAR
}

namespace scan {
constexpr int TC = 32;
constexpr int BUFB = 49152, O_R = 0, O_KD = 8192, O_KK = 16384, O_W = 24576, O_KA = 32768, O_V = 40960, O_Y = 45056;
constexpr int O_PRIV = 98304;
constexpr int O_TBL = 98304 + 8192;
__device__ __forceinline__ float dpp_red8(float x) {
    x += __uint_as_float(__builtin_amdgcn_update_dpp(0u, __float_as_uint(x), 0xB1, 0xf, 0xf, false));
    x += __uint_as_float(__builtin_amdgcn_update_dpp(0u, __float_as_uint(x), 0x4E, 0xf, 0xf, false));
    x += __uint_as_float(__builtin_amdgcn_update_dpp(0u, __float_as_uint(x), 0x141, 0xf, 0xf, false));
    return x;
}
struct P {
    const bf16_t* ZR; bf16_t* YB; float* BON;
    const float *mup, *mun, *w0, *w2, *a0, *a2, *kk_w, *ka_w, *rk_w;
};
__device__ __forceinline__ void job(int s, int dir, int head, int rh, const P& p, char* lds) {
    int tid = threadIdx.x; asm volatile("" : "+v"(tid));
    const int wid = __builtin_amdgcn_readfirstlane(tid >> 6), lane = tid & 63;
    const int tok0 = seq_start(s), T = seq_len(s), NCH = T / TC;
    float* TBL = (float*)(lds + O_TBL);
    float* MUP = TBL; float* MUN = TBL + 320; float* KKW = TBL + 640; float* KAW = TBL + 704; float* RKW = TBL + 768; float* BW = TBL + 832; float* BA = TBL + 896;
    __syncthreads();
    if (tid < 320) { const int which = tid >> 6, j = tid & 63; const int col = which < 3 ? which * 1024 + head * 64 + j : (which == 3 ? 3072 : 3200) + dir * 64 + j; MUP[tid] = p.mup[col]; MUN[tid] = p.mun[col]; }
    if (tid >= 320 && tid < 384) { const int j = tid - 320; KKW[j] = p.kk_w[head * 64 + j]; KAW[j] = p.ka_w[head * 64 + j]; RKW[j] = p.rk_w[head * 64 + j];
        BW[j] = p.w0[dir * 1024 + head * 64 + j]; BA[j] = p.a0[dir * 1024 + head * 64 + j]; }
    bf16_t* yb = p.YB + (size_t)dir * NT * 1024; float* bon = p.BON + (size_t)dir * NT * 16;
    if (wid >= 4) {
        const int pw = wid - 4;
        bf16_t* AWl = (bf16_t*)(lds + O_PRIV + pw * 2048); bf16_t* AAl = AWl + 512;
        bf16x8 Bf[2][4][2];
#pragma unroll
        for (int mat = 0; mat < 2; ++mat)
#pragma unroll
            for (int cbk = 0; cbk < 4; ++cbk)
#pragma unroll
                for (int ks = 0; ks < 2; ++ks) { const float* W2 = (mat == 0 ? p.w2 : p.a2) + (size_t)dir * 64 * 1024 + head * 64 + cbk * 16 + (lane & 15) + (size_t)(ks * 32 + (lane >> 4) * 8) * 1024;
                    float f[8];
#pragma unroll
                    for (int e = 0; e < 8; ++e) f[e] = W2[(size_t)e * 1024];
                    u32x4 w; w.x = cvt_pk_bf16(f[0], f[1]); w.y = cvt_pk_bf16(f[2], f[3]); w.z = cvt_pk_bf16(f[4], f[5]); w.w = cvt_pk_bf16(f[6], f[7]); Bf[mat][cbk][ks] = *reinterpret_cast<bf16x8*>(&w); }
        __syncthreads();
        const int pt = tid - 256;
        u32x4 zc[5], zm[5], zn[5];
#define PLOAD(cc) do { const int tf_ = dir ? T - TC * ((cc) + 1) : TC * (cc); \
    _Pragma("unroll") for (int k = 0; k < 5; ++k) { const int item = lane + 64 * k, tl8 = item / 40, chh = item - tl8 * 40, which = chh >> 3, j0 = (chh & 7) * 8; \
        const int col = which < 3 ? which * 1024 + head * 64 + j0 : (which == 3 ? 3072 : 3200) + dir * 64 + j0; \
        const int t = tf_ + 8 * pw + tl8; const bf16_t* zp = p.ZR + (size_t)(tok0 + t) * ZRP + col; \
        zc[k] = *(const u32x4*)zp; zm[k] = (u32x4){0u, 0u, 0u, 0u}; zn[k] = (u32x4){0u, 0u, 0u, 0u}; \
        if (t > 0) zm[k] = *(const u32x4*)(zp - ZRP); \
        if (t < T - 1) zn[k] = *(const u32x4*)(zp + ZRP); } } while (0)
        PLOAD(0);
        for (int c = -1; c < NCH; ++c) {
            if (c >= 1) { const int cb_ = (c - 1) & 1, tf = dir ? T - TC * c : TC * (c - 1); const int tl = pt >> 3, c4 = (pt & 7) * 4;
                const f32x4 y4 = *(const f32x4*)((const float*)(lds + cb_ * BUFB + O_Y) + tl * 32 + c4); u32x2 w; w.x = cvt_pk_bf16(y4[0], y4[1]); w.y = cvt_pk_bf16(y4[2], y4[3]);
                *(u32x2*)(yb + (size_t)(tok0 + tf + tl) * 1024 + head * 64 + rh * 32 + c4) = w; }
            if (c + 1 < NCH) {
                const int nb = (c + 1) & 1, tfirst = dir ? T - TC * (c + 2) : TC * (c + 1);
                char* B_ = lds + nb * BUFB;
                float* Rl = (float*)(B_ + O_R); float* KDl = (float*)(B_ + O_KD); float* KKl = (float*)(B_ + O_KK); float* Wl = (float*)(B_ + O_W); float* KAl = (float*)(B_ + O_KA); float* Vl = (float*)(B_ + O_V);
#pragma unroll
                for (int k = 0; k < 5; ++k) { const int item = lane + 64 * k, tl8 = item / 40, chh = item - tl8 * 40, which = chh >> 3, j0 = (chh & 7) * 8, tl = 8 * pw + tl8;
                    const f32x4 mpa = *(const f32x4*)(MUP + which * 64 + j0), mpb = *(const f32x4*)(MUP + which * 64 + j0 + 4), mna = *(const f32x4*)(MUN + which * 64 + j0), mnb = *(const f32x4*)(MUN + which * 64 + j0 + 4);
                    const u32x4 z = zc[k], zmm = zm[k], znn = zn[k];
                    float v[8];
#define SH(i, zw, zmw, znw, lohi, mp_, mn_) { const float zz = lohi(zw), a_ = lohi(zmw), b_ = lohi(znw); v[i] = zz + mp_ * (a_ - zz) + mn_ * (b_ - zz); }
                    SH(0, z.x, zmm.x, znn.x, bflo, mpa[0], mna[0]) SH(1, z.x, zmm.x, znn.x, bfhi, mpa[1], mna[1]) SH(2, z.y, zmm.y, znn.y, bflo, mpa[2], mna[2]) SH(3, z.y, zmm.y, znn.y, bfhi, mpa[3], mna[3])
                    SH(4, z.z, zmm.z, znn.z, bflo, mpb[0], mnb[0]) SH(5, z.z, zmm.z, znn.z, bfhi, mpb[1], mnb[1]) SH(6, z.w, zmm.w, znn.w, bflo, mpb[2], mnb[2]) SH(7, z.w, zmm.w, znn.w, bfhi, mpb[3], mnb[3])
#undef SH
                    if (which < 2) { float* dst = (which == 0 ? Rl : KDl) + tl * 64 + j0;
                        *(f32x4*)dst = (f32x4){v[0], v[1], v[2], v[3]}; *(f32x4*)(dst + 4) = (f32x4){v[4], v[5], v[6], v[7]}; }
                    else if (which == 2) { if ((j0 >> 5) == rh) { float* dst = Vl + tl * 32 + (j0 & 31);
                        *(f32x4*)dst = (f32x4){v[0], v[1], v[2], v[3]}; *(f32x4*)(dst + 4) = (f32x4){v[4], v[5], v[6], v[7]}; } }
                    else { if (which == 3) {
#pragma unroll
                            for (int i = 0; i < 8; ++i) { const float e2 = __expf(2.f * v[i]); v[i] = 1.f - 2.f * __builtin_amdgcn_rcpf(e2 + 1.f); } }
                        u32x4 w; w.x = cvt_pk_bf16(v[0], v[1]); w.y = cvt_pk_bf16(v[2], v[3]); w.z = cvt_pk_bf16(v[4], v[5]); w.w = cvt_pk_bf16(v[6], v[7]);
                        *(u32x4*)((which == 3 ? AWl : AAl) + tl8 * 64 + j0) = w; }
                }
                { const int tj = lane & 7, kq = lane >> 4;
#pragma unroll
                  for (int mat = 0; mat < 2; ++mat) { const bf16_t* Am = (mat == 0 ? AWl : AAl) + tj * 64 + kq * 8;
                      const bf16x8 y0 = *reinterpret_cast<const bf16x8*>(Am), y1 = *reinterpret_cast<const bf16x8*>(Am + 32);
#pragma unroll
                      for (int cbk = 0; cbk < 4; ++cbk) { f32x4 acc = {0.f, 0.f, 0.f, 0.f};
                          acc = __builtin_amdgcn_mfma_f32_16x16x32_bf16(Bf[mat][cbk][0], y0, acc, 0, 0, 0);
                          acc = __builtin_amdgcn_mfma_f32_16x16x32_bf16(Bf[mat][cbk][1], y1, acc, 0, 0, 0);
                          const int col = cbk * 16 + 4 * kq; const f32x4 bias = *(const f32x4*)((mat == 0 ? BW : BA) + col); f32x4 res;
#pragma unroll
                          for (int r = 0; r < 4; ++r) { const float u = acc[r] + bias[r];
                              const float sg = __builtin_amdgcn_rcpf(1.f + __expf(-u));
                              res[r] = mat == 0 ? __expf(-0.60653065971263342f * sg) : sg; }
                          if ((lane & 15) < 8) *(f32x4*)((mat == 0 ? Wl : KAl) + (8 * pw + tj) * 64 + col) = res; } } }
                { const int tl = 8 * pw + (lane >> 3), c0 = (lane & 7) * 8; const int o = tl * 64 + c0;
                  float bs = 0.f, ss = 0.f; f32x4 kr[2], k4[2], a4[2];
#pragma unroll
                  for (int q = 0; q < 2; ++q) { k4[q] = *(const f32x4*)(KDl + o + 4 * q); a4[q] = *(const f32x4*)(KAl + o + 4 * q);
                      kr[q] = k4[q] * *(const f32x4*)(KKW + c0 + 4 * q); ss += (kr[q][0] * kr[q][0] + kr[q][1] * kr[q][1]) + (kr[q][2] * kr[q][2] + kr[q][3] * kr[q][3]); }
                  ss = dpp_red8(ss);
                  const float inv = __builtin_amdgcn_rsqf(fmaxf(ss, 1e-24f));
#pragma unroll
                  for (int q = 0; q < 2; ++q) { const f32x4 kk = kr[q] * inv, kd = k4[q] * (1.f + (a4[q] - 1.f) * *(const f32x4*)(KAW + c0 + 4 * q)), kka = kk * a4[q];
                      const f32x4 bb = *(const f32x4*)(Rl + o + 4 * q) * kd * *(const f32x4*)(RKW + c0 + 4 * q); bs += (bb[0] + bb[1]) + (bb[2] + bb[3]);
                      *(f32x4*)(KKl + o + 4 * q) = kk; *(f32x4*)(KDl + o + 4 * q) = kd; *(f32x4*)(KAl + o + 4 * q) = kka; }
                  bs = dpp_red8(bs);
                  if (rh == 0 && (lane & 7) == 0) bon[(size_t)(tok0 + tfirst + tl) * 16 + head] = bs; }
                if (c + 2 < NCH) PLOAD(c + 2);
            }
            asm volatile("s_waitcnt lgkmcnt(0)" ::: "memory"); __builtin_amdgcn_s_barrier(); asm volatile("" ::: "memory");
        }
#undef PLOAD
    } else {
        __syncthreads();
        const int row = tid >> 3, seg = tid & 7;
        f32x2 S[4];
#pragma unroll
        for (int q = 0; q < 4; ++q) S[q] = (f32x2){0.f, 0.f};
        asm volatile("s_waitcnt lgkmcnt(0)" ::: "memory"); __builtin_amdgcn_s_barrier(); asm volatile("" ::: "memory");
        for (int c = 0; c < NCH; ++c) {
            const char* B_ = lds + (c & 1) * BUFB;
            const float* Rl = (const float*)(B_ + O_R); const float* KDl = (const float*)(B_ + O_KD); const float* KKl = (const float*)(B_ + O_KK); const float* Wl = (const float*)(B_ + O_W); const float* KAl = (const float*)(B_ + O_KA);
            const float* Vl = (const float*)(B_ + O_V); float* Yl = (float*)(B_ + O_Y);
            f32x4 ck[2], cw[2], ca[2], cd[2], cr[2]; float cv;
#define LOADV(tl_) do { const int o8 = (tl_) * 64 + seg * 8; ck[0] = *(const f32x4*)(KKl + o8); ck[1] = *(const f32x4*)(KKl + o8 + 4); cw[0] = *(const f32x4*)(Wl + o8); cw[1] = *(const f32x4*)(Wl + o8 + 4); \
    ca[0] = *(const f32x4*)(KAl + o8); ca[1] = *(const f32x4*)(KAl + o8 + 4); cd[0] = *(const f32x4*)(KDl + o8); cd[1] = *(const f32x4*)(KDl + o8 + 4); cr[0] = *(const f32x4*)(Rl + o8); cr[1] = *(const f32x4*)(Rl + o8 + 4); \
    cv = Vl[(tl_) * 32 + row]; } while (0)
            LOADV(dir ? TC - 1 : 0);
#pragma unroll 2
            for (int st = 0; st < TC; ++st) {
                const int tl = dir ? TC - 1 - st : st;
                const f32x2 k0 = {ck[0][0], ck[0][1]}, k1 = {ck[0][2], ck[0][3]}, k2 = {ck[1][0], ck[1][1]}, k3 = {ck[1][2], ck[1][3]};
                const f32x2 w0 = {cw[0][0], cw[0][1]}, w1 = {cw[0][2], cw[0][3]}, w2 = {cw[1][0], cw[1][1]}, w3 = {cw[1][2], cw[1][3]};
                const f32x2 a0 = {ca[0][0], ca[0][1]}, a1 = {ca[0][2], ca[0][3]}, a2 = {ca[1][0], ca[1][1]}, a3 = {ca[1][2], ca[1][3]};
                const f32x2 d0 = {cd[0][0], cd[0][1]}, d1 = {cd[0][2], cd[0][3]}, d2 = {cd[1][0], cd[1][1]}, d3 = {cd[1][2], cd[1][3]};
                const f32x2 r0 = {cr[0][0], cr[0][1]}, r1 = {cr[0][2], cr[0][3]}, r2 = {cr[1][0], cr[1][1]}, r3 = {cr[1][2], cr[1][3]};
                const f32x2 vv = {cv, cv};
                if (st + 1 < TC) LOADV(dir ? TC - 2 - st : st + 1);
                f32x2 t2 = S[0] * k0 + S[1] * k1; const f32x2 t3 = S[2] * k2 + S[3] * k3; t2 = t2 + t3;
                float d = dpp_red8(t2[0] + t2[1]);
                const f32x2 p0 = S[0] * w0 + vv * d0, p1 = S[1] * w1 + vv * d1, p2 = S[2] * w2 + vv * d2, p3 = S[3] * w3 + vv * d3;
                const f32x2 sa = {-d, -d};
                S[0] = p0 + sa * a0; S[1] = p1 + sa * a1; S[2] = p2 + sa * a2; S[3] = p3 + sa * a3;
                f32x2 y2 = S[0] * r0 + S[1] * r1; const f32x2 y3 = S[2] * r2 + S[3] * r3; y2 = y2 + y3;
                const float y = dpp_red8(y2[0] + y2[1]);
                if (seg == 0) Yl[tl * 32 + row] = y;
            }
#undef LOADV
            asm volatile("s_waitcnt lgkmcnt(0)" ::: "memory"); __builtin_amdgcn_s_barrier(); asm volatile("" ::: "memory");
        }
    }
    if (wid >= 4) {
        const int pt = tid - 256, c = NCH, cb_ = (c - 1) & 1, tf = dir ? T - TC * c : TC * (c - 1); const int tl = pt >> 3, c4 = (pt & 7) * 4;
        const f32x4 y4 = *(const f32x4*)((const float*)(lds + cb_ * BUFB + O_Y) + tl * 32 + c4); u32x2 w; w.x = cvt_pk_bf16(y4[0], y4[1]); w.y = cvt_pk_bf16(y4[2], y4[3]);
        *(u32x2*)(yb + (size_t)(tok0 + tf + tl) * 1024 + head * 64 + rh * 32 + c4) = w;
    }
    __syncthreads();
}
}

__device__ __forceinline__ void p4_post(const Args& a, char* lds, int vcu, int G) {
    const int tid = threadIdx.x, lane = tid & 63;
    unsigned char* ws = a.ws;
    const bf16_t* ZR = (const bf16_t*)a.out; bf16_t* QK = (bf16_t*)(ws + WS_QK);
    const bf16_t* Y0 = (const bf16_t*)(ws + WS_Y); const bf16_t* Y1 = Y0 + (size_t)NT * 1024;
    const float* BON = (const float*)(ws + WS_BON);
    const float* mup = a.in[13]; const float* mun = a.in[14]; const float* G2 = a.in[19]; const float* lnw = a.in[23]; const float* lnb = a.in[24]; const float* subg = a.in[12];
    float* SG = (float*)lds; float* BL = (float*)(lds + 20480);
    for (int tile = vcu; tile < NT / 32; tile += G) {
        const int tk0 = tile * 32;
        __syncthreads();
        for (int it = tid; it < 32 * 20; it += NTHR) {
            const int tl = it / 20, j0 = (it % 20) * 8, col = 3328 + j0, tok = tk0 + tl, t = tok_pos(tok), T = tok < TP ? TP : TS;
            const bf16_t* zp = ZR + (size_t)tok * ZRP + col; const u32x4 z = *(const u32x4*)zp; u32x4 zm = {0u, 0u, 0u, 0u}, zn = {0u, 0u, 0u, 0u};
            if (t > 0) zm = *(const u32x4*)(zp - ZRP);
            if (t < T - 1) zn = *(const u32x4*)(zp + ZRP);
            float v[8];
#define SH(i, zw, zmw, znw, lohi) { const float zz = lohi(zw), a_ = lohi(zmw), b_ = lohi(znw), mp_ = mup[col + i], mn_ = mun[col + i]; v[i] = sigmoidf_(zz + mp_ * (a_ - zz) + mn_ * (b_ - zz)); }
            SH(0, z.x, zm.x, zn.x, bflo) SH(1, z.x, zm.x, zn.x, bfhi) SH(2, z.y, zm.y, zn.y, bflo) SH(3, z.y, zm.y, zn.y, bfhi)
            SH(4, z.z, zm.z, zn.z, bflo) SH(5, z.z, zm.z, zn.z, bfhi) SH(6, z.w, zm.w, zn.w, bflo) SH(7, z.w, zm.w, zn.w, bfhi)
#undef SH
            *(f32x4*)(SG + tl * 160 + j0) = (f32x4){v[0], v[1], v[2], v[3]}; *(f32x4*)(SG + tl * 160 + j0 + 4) = (f32x4){v[4], v[5], v[6], v[7]};
        }
        { const int tl = tid >> 4, hd = tid & 15; BL[tid] = BON[(size_t)(tk0 + tl) * 16 + hd] + BON[(size_t)NT * 16 + (size_t)(tk0 + tl) * 16 + hd]; }
        { const int pr = tid >> 1, half = tid & 1, tl = pr >> 3, hd = pr & 7; bf16_t* op = QK + (size_t)(tk0 + tl) * 2048 + hd * 128 + half * 64;
          u32x4 w[8]; float ss = 0.f;
#pragma unroll
          for (int i = 0; i < 8; ++i) { w[i] = *(const u32x4*)(op + i * 8);
              ss += bflo(w[i].x) * bflo(w[i].x) + bfhi(w[i].x) * bfhi(w[i].x) + bflo(w[i].y) * bflo(w[i].y) + bfhi(w[i].y) * bfhi(w[i].y) + bflo(w[i].z) * bflo(w[i].z) + bfhi(w[i].z) * bfhi(w[i].z) + bflo(w[i].w) * bflo(w[i].w) + bfhi(w[i].w) * bfhi(w[i].w); }
          ss += __shfl_xor(ss, 1);
          const float rstd = rsqrtf(ss * (1.f / 128.f) + 1e-6f) * 0.8f; const float* sg = subg + half * 64;
#pragma unroll
          for (int i = 0; i < 8; ++i) { u32x4 o;
              o.x = cvt_pk_bf16(bflo(w[i].x) * rstd * sg[i * 8 + 0], bfhi(w[i].x) * rstd * sg[i * 8 + 1]); o.y = cvt_pk_bf16(bflo(w[i].y) * rstd * sg[i * 8 + 2], bfhi(w[i].y) * rstd * sg[i * 8 + 3]);
              o.z = cvt_pk_bf16(bflo(w[i].z) * rstd * sg[i * 8 + 4], bfhi(w[i].z) * rstd * sg[i * 8 + 5]); o.w = cvt_pk_bf16(bflo(w[i].w) * rstd * sg[i * 8 + 6], bfhi(w[i].w) * rstd * sg[i * 8 + 7]);
              *(u32x4*)(op + i * 8) = o; } }
        __syncthreads();
        const int c0 = tid * 2;
        float acc[32][2];
#pragma unroll
        for (int i = 0; i < 32; ++i) { acc[i][0] = 0.f; acc[i][1] = 0.f; }
#pragma unroll 1
        for (int k = 0; k < 160; k += 4) {
            const f32x2 g0 = *(const f32x2*)(G2 + (size_t)(k + 0) * 1024 + c0), g1 = *(const f32x2*)(G2 + (size_t)(k + 1) * 1024 + c0), g2 = *(const f32x2*)(G2 + (size_t)(k + 2) * 1024 + c0), g3 = *(const f32x2*)(G2 + (size_t)(k + 3) * 1024 + c0);
#pragma unroll
            for (int i = 0; i < 32; ++i) { const f32x4 s4 = *(const f32x4*)(SG + i * 160 + k);
                acc[i][0] += s4[0] * g0[0] + s4[1] * g1[0] + s4[2] * g2[0] + s4[3] * g3[0];
                acc[i][1] += s4[0] * g0[1] + s4[1] * g1[1] + s4[2] * g2[1] + s4[3] * g3[1]; }
        }
        const int hd = tid >> 5;
        const float lw0 = lnw[c0], lw1 = lnw[c0 + 1], lb0 = lnb[c0], lb1 = lnb[c0 + 1];
        const float mp0 = mup[2048 + c0], mp1 = mup[2048 + c0 + 1], mn0 = mun[2048 + c0], mn1 = mun[2048 + c0 + 1];
#pragma unroll
        for (int i = 0; i < 32; ++i) {
            const int tok = tk0 + i, t = tok_pos(tok), T = tok < TP ? TP : TS;
            const unsigned ya = *(const unsigned*)(Y0 + (size_t)tok * 1024 + c0), yb = *(const unsigned*)(Y1 + (size_t)tok * 1024 + c0);
            const float y0 = bflo(ya) + bflo(yb), y1 = bfhi(ya) + bfhi(yb);
            float s = y0 + y1, q = y0 * y0 + y1 * y1;
#pragma unroll
            for (int o = 1; o < 32; o <<= 1) { s += __shfl_xor(s, o); q += __shfl_xor(q, o); }
            const float mean = s * (1.f / 64.f), var = fmaxf(q * (1.f / 64.f) - mean * mean, 0.f), rstd = rsqrtf(var + 64e-5f);
            const bf16_t* zp = ZR + (size_t)tok * ZRP + 2048 + c0; const unsigned z = *(const unsigned*)zp;
            unsigned zm = 0u, zn = 0u;
            if (t > 0) zm = *(const unsigned*)(zp - ZRP);
            if (t < T - 1) zn = *(const unsigned*)(zp + ZRP);
            const float v0 = bflo(z) + mp0 * (bflo(zm) - bflo(z)) + mn0 * (bflo(zn) - bflo(z)), v1 = bfhi(z) + mp1 * (bfhi(zm) - bfhi(z)) + mn1 * (bfhi(zn) - bfhi(z));
            const float bo = BL[i * 16 + hd];
            const float o0 = ((y0 - mean) * rstd * lw0 + lb0 + bo * v0) * acc[i][0], o1 = ((y1 - mean) * rstd * lw1 + lb1 + bo * v1) * acc[i][1];
            *(unsigned*)(QK + (size_t)tok * 2048 + 1024 + c0) = cvt_pk_bf16(o0, o1);
        }
    }
    __syncthreads();
}

struct SchedMerge {
    int v, G; const char* H; const char* WG; const char* QK; const char* VM; const char* PAR; const char* PM2;
    __device__ __forceinline__ bool next(int i, Unit& u) const {
        const int ti = i / 6, kind = i - ti * 6; const long L = (long)ti * G + v; int pm, pn;
        if (!TileMap{192, 8}.get(L, pm, pn)) return false;
        u.pm = pm; u.pn = pn; u.kind = kind; u.t0 = 0; u.T = 0;
        const size_t bo = (size_t)pn * MiB;
        switch (kind) {
            case 0: u.A = H + (size_t)pm * MiB; u.B = WG + bo; u.nt = 32; break;
            case 1: u.A = QK + (size_t)pm * MiB; u.B = PAR + bo; u.nt = 16; break;
            case 2: u.A = H + (size_t)pm * MiB; u.B = WG + 8 * MiB + bo; u.nt = 32; break;
            case 3: u.A = QK + (size_t)pm * MiB + 2048; u.B = PAR + bo + 2048; u.nt = 16; break;
            case 4: u.A = H + (size_t)pm * MiB; u.B = WG + 16 * MiB + bo; u.nt = 32; break;
            default: u.A = VM + (size_t)pm * MiB + 2048; u.B = PM2 + bo; u.nt = 16; break;
        }
        return true;
    }
};
struct EpiMerge {
    u32x4* scrG; f32x4* scrP; bf16_t* MRG;
    __device__ __forceinline__ void operator()(const f32x4 (&acc)[2][2][4][2], const Unit& u, int wr, int wc, int fr, int fq) const {
        const int tid = threadIdx.x, kind = u.kind;
        u32x4* gp = scrG + tid; f32x4* pp = scrP + tid;
        if ((kind & 1) == 0) {
#pragma unroll
            for (int ai = 0; ai < 2; ++ai)
#pragma unroll
                for (int bj = 0; bj < 2; ++bj)
#pragma unroll
                    for (int m = 0; m < 4; ++m) { const f32x4 v0 = acc[ai][bj][m][0], v1 = acc[ai][bj][m][1]; u32x4 w;
                        w.x = cvt_pk_bf16(sigmoidf_(v0[0]), sigmoidf_(v0[1])); w.y = cvt_pk_bf16(sigmoidf_(v0[2]), sigmoidf_(v0[3]));
                        w.z = cvt_pk_bf16(sigmoidf_(v1[0]), sigmoidf_(v1[1])); w.w = cvt_pk_bf16(sigmoidf_(v1[2]), sigmoidf_(v1[3]));
                        *gp = w; gp += NTHR; asm volatile("" : "+v"(gp) :: "memory"); }
        } else {
            const int row0 = u.pm * 256 + wr * 64 + fr, col0 = u.pn * 256 + wc * 32 + 8 * fq;
#pragma unroll
            for (int ai = 0; ai < 2; ++ai)
#pragma unroll
                for (int bj = 0; bj < 2; ++bj) {
                    bf16_t* mp = MRG + (size_t)(row0 + ai * 128) * 2048 + col0 + bj * 128;
#pragma unroll
                    for (int m = 0; m < 4; ++m) { const u32x4 g = *gp;
                        f32x4 p0 = acc[ai][bj][m][0] * (f32x4){bflo(g.x), bfhi(g.x), bflo(g.y), bfhi(g.y)}, p1 = acc[ai][bj][m][1] * (f32x4){bflo(g.z), bfhi(g.z), bflo(g.w), bfhi(g.w)};
                        if (kind > 1) { p0 += pp[0]; p1 += pp[NTHR]; }
                        if (kind < 5) { pp[0] = p0; pp[NTHR] = p1; }
                        else { u32x4 w; w.x = cvt_pk_bf16(p0[0], p0[1]); w.y = cvt_pk_bf16(p0[2], p0[3]); w.z = cvt_pk_bf16(p1[0], p1[1]); w.w = cvt_pk_bf16(p1[2], p1[3]);
                            *(u32x4*)mp = w; }
                        gp += NTHR; pp += 2 * NTHR; mp += 16 * 2048; asm volatile("" : "+v"(gp), "+v"(pp), "+v"(mp) :: "memory"); } }
        }
    }
};

struct SchedSq {
    int v, G; const char* A; const char* B; size_t astep, bstep; int nt;
    __device__ __forceinline__ bool next(int i, Unit& u) const {
        const long L = (long)i * G + v; int pm, pn; if (!TileMap{192, 8}.get(L, pm, pn)) return false;
        u.A = A + (size_t)pm * astep; u.B = B + (size_t)pn * bstep; u.nt = nt; u.pm = pm; u.pn = pn; u.kind = 0; u.t0 = 0; u.T = 0; return true;
    }
};
struct EpiWo {
    const float* xp; const float* xs; float* out;
    __device__ __forceinline__ void operator()(const f32x4 (&acc)[2][2][4][2], const Unit& u, int wr, int wc, int fr, int fq) const {
        const int row0 = u.pm * 256 + wr * 64 + fr, col0 = u.pn * 256 + wc * 32 + 8 * fq;
#pragma unroll
        for (int ai = 0; ai < 2; ++ai)
#pragma unroll
            for (int m = 0; m < 4; ++m) { const int row = row0 + ai * 128 + m * 16;
                const float* xr = (row < TP ? xp + (size_t)row * DM : xs + (size_t)(row - TP) * DM) + col0; float* orow = out + (size_t)row * DM + col0;
#pragma unroll
                for (int bj = 0; bj < 2; ++bj) { const f32x4 x0 = *(const f32x4*)(xr + bj * 128), x1 = *(const f32x4*)(xr + bj * 128 + 4);
                    *(f32x4*)(orow + bj * 128) = x0 + acc[ai][bj][m][0]; *(f32x4*)(orow + bj * 128 + 4) = x1 + acc[ai][bj][m][1]; } }
    }
};
struct EpiDown {
    float* out;
    __device__ __forceinline__ void operator()(const f32x4 (&acc)[2][2][4][2], const Unit& u, int wr, int wc, int fr, int fq) const {
        const int row0 = u.pm * 256 + wr * 64 + fr, col0 = u.pn * 256 + wc * 32 + 8 * fq;
#pragma unroll
        for (int ai = 0; ai < 2; ++ai)
#pragma unroll
            for (int m = 0; m < 4; ++m) { float* orow = out + (size_t)(row0 + ai * 128 + m * 16) * DM + col0;
#pragma unroll
                for (int bj = 0; bj < 2; ++bj) { const f32x4 x0 = *(const f32x4*)(orow + bj * 128), x1 = *(const f32x4*)(orow + bj * 128 + 4);
                    *(f32x4*)(orow + bj * 128) = x0 + acc[ai][bj][m][0]; *(f32x4*)(orow + bj * 128 + 4) = x1 + acc[ai][bj][m][1]; } }
    }
};

struct SchedUp {
    int v, G; const char* HN; const char* WUP;
    __device__ __forceinline__ bool next(int i, Unit& u) const {
        const long L = (long)i * G + v; int pm, pn; if (!TileMap{197, 44}.get(L, pm, pn)) return false;
        int s, ti; if (pm < 65) { s = 0; ti = pm; } else { s = 1 + (pm - 65) / 33; ti = (pm - 65) % 33; }
        const int T = seq_len(s); int t0 = 254 * ti - 1; if (t0 > T - 255) t0 = T - 255;
        u.pm = seq_start(s); u.pn = pn; u.kind = 0; u.t0 = t0; u.T = T; u.nt = 32;
        u.A = HN + ((long)u.pm + t0) * 4096; u.B = WUP + (size_t)pn * MiB; return true;
    }
};
struct EpiUp {
    bf16_t* ACT; const float* cw; const float* cb; LAS float* xch;
    __device__ __forceinline__ void operator()(const f32x4 (&acc)[2][2][4][2], const Unit& u, int wr, int wc, int fr, int fq) const {
        const int lane = threadIdx.x & 63;
        const int cin = wc * 32 + 8 * fq;
#pragma unroll
        for (int ai = 0; ai < 2; ++ai) { const int rg = 2 * ai + wr;
#pragma unroll
            for (int bj = 0; bj < 2; ++bj)
#pragma unroll
                for (int n = 0; n < 2; ++n) {
                    if (fr == 0) *(LAS f32x4*)(xch + (rg * 2 + 0) * 256 + bj * 128 + cin + 4 * n) = acc[ai][bj][0][n];
                    if (fr == 15) *(LAS f32x4*)(xch + (rg * 2 + 1) * 256 + bj * 128 + cin + 4 * n) = acc[ai][bj][3][n]; } }
        asm volatile("s_waitcnt lgkmcnt(0)" ::: "memory"); __builtin_amdgcn_s_barrier(); asm volatile("" ::: "memory");
        const int srcR = (lane & 48) | ((lane - 1) & 15), srcL = (lane & 48) | ((lane + 1) & 15);
        const int gc = u.pn * 128 + cin;
#pragma unroll
        for (int n = 0; n < 2; ++n) {
            const int wcol = gc + 4 * n;
            const f32x4 g0 = *(const f32x4*)(cw + wcol), g1 = *(const f32x4*)(cw + 2 * DFF + wcol), g2 = *(const f32x4*)(cw + 4 * DFF + wcol), gb = *(const f32x4*)(cb + wcol);
            const f32x4 v0 = *(const f32x4*)(cw + DFF + wcol), v1 = *(const f32x4*)(cw + 3 * DFF + wcol), v2 = *(const f32x4*)(cw + 5 * DFF + wcol), vb = *(const f32x4*)(cb + DFF + wcol);
#pragma unroll
            for (int ai = 0; ai < 2; ++ai) { const int rg = 2 * ai + wr;
                bf16_t* ap = ACT + ((long)u.pm + u.t0 + 128 * ai + 64 * wr + fr) * DFF + gc + 4 * n;
#pragma unroll
                for (int m = 0; m < 4; ++m) {
                    const int j = 128 * ai + 64 * wr + 16 * m + fr, t = u.t0 + j;
                    f32x4 res;
#pragma unroll
                    for (int bj = 0; bj < 2; ++bj) {
                        const f32x4 cur = acc[ai][bj][m][n];
                        const f32x4 sp = (m > 0 && fr == 15) ? acc[ai][bj][m > 0 ? m - 1 : 0][n] : cur;
                        const f32x4 sn = (m < 3 && fr == 0) ? acc[ai][bj][m < 3 ? m + 1 : 3][n] : cur;
                        f32x4 pv, nv;
#pragma unroll
                        for (int i = 0; i < 4; ++i) { pv[i] = __shfl(sp[i], srcR); nv[i] = __shfl(sn[i], srcL); }
                        if (m == 0) { const f32x4 xprev = rg > 0 ? *(const LAS f32x4*)(xch + ((rg - 1) * 2 + 1) * 256 + bj * 128 + cin + 4 * n) : (f32x4){0.f, 0.f, 0.f, 0.f}; if (fr == 0) pv = xprev; }
                        if (m == 3) { const f32x4 xnext = rg < 3 ? *(const LAS f32x4*)(xch + ((rg + 1) * 2 + 0) * 256 + bj * 128 + cin + 4 * n) : (f32x4){0.f, 0.f, 0.f, 0.f}; if (fr == 15) nv = xnext; }
                        if (t < 1) pv = (f32x4){0.f, 0.f, 0.f, 0.f};
                        if (t >= u.T - 1) nv = (f32x4){0.f, 0.f, 0.f, 0.f};
                        if (bj == 0) { const f32x4 cv = g0 * pv + g1 * cur + g2 * nv + gb; res = (f32x4){cv[0] * sigmoidf_(cv[0]), cv[1] * sigmoidf_(cv[1]), cv[2] * sigmoidf_(cv[2]), cv[3] * sigmoidf_(cv[3])}; }
                        else { const f32x4 cv = v0 * pv + v1 * cur + v2 * nv + vb; res = res * cv; }
                    }
                    if (j >= 1 && j <= 254) { u32x2 w; w.x = cvt_pk_bf16(res[0], res[1]); w.y = cvt_pk_bf16(res[2], res[3]); *(u32x2*)ap = w; }
                    ap += 16 * DFF; asm volatile("" : "+v"(ap) :: "memory");
                }
            }
        }
    }
};

__global__ void __launch_bounds__(NTHR, 2) enc_fwd(Args args) {
    extern __shared__ __attribute__((aligned(16))) unsigned char lds_raw[];
    cg::grid_group grid = cg::this_grid();
    LAS unsigned char* lds = (LAS unsigned char*)lds_raw;
    const int tid = threadIdx.x;
    const int G = gridDim.x, bx = blockIdx.x, vcu = (G % 8 == 0) ? (bx % 8) * (G / 8) + bx / 8 : bx;
    unsigned char* ws = args.ws;
    const int lo = args.ph_lo, hi = args.ph_hi;
#ifndef P2M
#define P2M 7
#endif
#ifndef PH_MASK
#define PH_MASK 0x1ff
#endif
#define IN(k) (((PH_MASK >> (k)) & 1) && lo <= (k) && (k) < hi)
#define SEAM(k) do { if (IN(k) && IN((k) + 1)) grid.sync(); } while (0)
#ifndef PROBE
#define PROBE 0
#endif
    unsigned long long tp0 = 0, tp1 = 0;
#define TSTAMP(v) do { if (PROBE) { v = __builtin_amdgcn_s_memrealtime(); } } while (0)

    if (IN(0)) p0_prologue(args, lds, vcu, G);
    SEAM(0);
    if (IN(1)) {
        SchedIn S{vcu, G, (const char*)(ws + WS_H), (const char*)(ws + WS_WIN), (const char*)(ws + WS_MEMN), (const char*)(ws + WS_WKV)};
        EpiIn E{(bf16_t*)(ws + WS_QK), (bf16_t*)(ws + WS_VM), (bf16_t*)args.out, (bf16_t*)(ws + WS_KVM), args.in[6], args.in[7], (const float*)(ws + WS_ROPE), (const float*)(ws + WS_ROPE) + TP * 32};
        pg8::gemm_phase<EpiIn, SchedIn, true>(lds, 2048, S, E);
    }
    SEAM(1);
    if (PROBE == 1 || PROBE == 2) TSTAMP(tp0);
    if (IN(2)) {
        unsigned* ctl = (unsigned*)(ws + WS_CTL);
        volatile LAS unsigned* jobw = (volatile LAS unsigned*)(lds + LDS_MISC);
        const float lam = ((const float*)ctl)[CW_LAM];
        scan::P sp{(const bf16_t*)args.out, (bf16_t*)(ws + WS_Y), (float*)(ws + WS_BON), args.in[13], args.in[14], args.in[15], args.in[16], args.in[17], args.in[18], args.in[20], args.in[21], args.in[22]};
        for (;;) {
            __syncthreads();
            if (tid == 0) jobw[0] = atomicAdd(ctl + CW_QUEUE, 1u);
            __syncthreads();
            const int jb = (int)jobw[0];
            if (jb >= 320 + 1536 + 768) break;
            if (((P2M) & 1) && jb < 320) {
                int s, r; if (jb < 64) { s = 0; r = jb; } else { s = 1 + (jb - 64) / 64; r = (jb - 64) % 64; }
                scan::job(s, r & 1, (r >> 1) & 15, r >> 5, sp, (char*)lds_raw);
                if (PROBE == 2 && tid == 0) atomicMax((unsigned long long*)(ctl + 256), (unsigned long long)__builtin_amdgcn_s_memrealtime());
            } else if (((P2M) & 2) && jb < 320 + 1536) {
                const int a = jb - 320; int s, h, qb;
                if (a < 512) { s = 0; h = a / 64; qb = a % 64; } else { const int b = a - 512; s = 1 + b / 256; h = (b % 256) / 32; qb = b % 32; }
                att::diff_unit(s, h, qb, (bf16_t*)(ws + WS_QK), (const bf16_t*)(ws + WS_VM), lam, (char*)lds_raw);
            } else if ((P2M) & 4) {
                const int a = jb - 320 - 1536; int s, mh, qb;
                if (a < 256) { s = 0; mh = a / 64; qb = a % 64; } else { const int b = a - 256; s = 1 + b / 128; mh = (b % 128) / 32; qb = b % 32; }
                att::mem_unit(s, mh, qb, (bf16_t*)(ws + WS_VM), (const bf16_t*)(ws + WS_KVM), args.in[27], args.in[28], (char*)lds_raw);
            }
        }
    }
    SEAM(2);
    if (PROBE == 1) TSTAMP(tp1);
    if (IN(3)) p4_post(args, (char*)lds_raw, vcu, G);
    SEAM(3);
    if (IN(4)) {
        SchedMerge S{vcu, G, (const char*)(ws + WS_H), (const char*)(ws + WS_WG), (const char*)(ws + WS_QK), (const char*)(ws + WS_VM), (const char*)(ws + WS_PAR), (const char*)(ws + WS_PM2)};
        unsigned char* scr = (unsigned char*)args.out + (size_t)bx * (384 * 1024);
        EpiMerge E{(u32x4*)scr, (f32x4*)(scr + 128 * 1024), (bf16_t*)(ws + WS_MRG)};
        pg8::gemm_phase<EpiMerge, SchedMerge, true>(lds, 2048, S, E);
    }
    SEAM(4);
    if (IN(5)) {
        SchedSq S{vcu, G, (const char*)(ws + WS_MRG), (const char*)(ws + WS_WO), MiB, MiB, 32};
        EpiWo E{args.in[0], args.in[1], args.out};
        pg8::gemm_phase<EpiWo, SchedSq, true>(lds, 2048, S, E);
    }
    SEAM(5);
    if (IN(6)) {
        const int lane = tid & 63, gw = vcu * 8 + (tid >> 6), NGW = G * 8;
        for (int m = gw; m < NT; m += NGW) rms_row(args.out + (size_t)m * DM, args.in[33], (bf16_t*)(ws + WS_H) + (size_t)m * DM, lane);
    }
    SEAM(6);
    if (IN(7)) {
        SchedUp S{vcu, G, (const char*)(ws + WS_H), (const char*)(ws + WS_WUP)};
        EpiUp E{(bf16_t*)(ws + WS_ACT), args.in[35], args.in[36], (LAS float*)(lds + LDS_XCH)};
        pg8::gemm_phase<EpiUp, SchedUp, true>(lds, 2048, S, E);
    }
    SEAM(7);
    if (IN(8)) {
        SchedSq S{vcu, G, (const char*)(ws + WS_ACT), (const char*)(ws + WS_WDN), (size_t)256 * DFF * 2, (size_t)256 * DFF * 2, 88};
        EpiDown E{args.out};
        pg8::gemm_phase<EpiDown, SchedSq, true>(lds, DFF, S, E);
    }
    if (PROBE && bx == 0 && tid == 0) {
        if (PROBE == 2) tp1 = __hip_atomic_load((unsigned long long*)(ws + WS_CTL) + 128, __ATOMIC_RELAXED, __HIP_MEMORY_SCOPE_AGENT);
        const unsigned long long target = __builtin_amdgcn_s_memrealtime() + (tp1 > tp0 ? tp1 - tp0 : 0);
        while (__builtin_amdgcn_s_memrealtime() < target) __builtin_amdgcn_s_sleep(16);
    }
#undef IN
#undef SEAM
}

#ifndef MK_SPLIT
#define MK_SPLIT 0
#endif
extern "C" void kernel_launch(void* const* d_in, const int* in_sizes, int n_in, void* d_out, int out_size, void* d_ws, size_t ws_size, hipStream_t stream) {
    static int grid = 0;
    if (grid == 0) {
        if (n_in != 38 || out_size != NT * DM || ws_size < WS_END) { fprintf(stderr, "kernel_launch: unexpected shapes n_in %d out %d ws %zu\n", n_in, out_size, ws_size); grid = -1; return; }
        int dev = 0, cus = 0, per_cu = 0;
        hipGetDevice(&dev); hipDeviceGetAttribute(&cus, hipDeviceAttributeMultiprocessorCount, dev);
        if (hipFuncSetAttribute((const void*)enc_fwd, hipFuncAttributeMaxDynamicSharedMemorySize, LDS_BYTES) != hipSuccess) { fprintf(stderr, "kernel_launch: hipFuncSetAttribute failed\n"); grid = -1; return; }
        if (hipOccupancyMaxActiveBlocksPerMultiprocessor(&per_cu, (const void*)enc_fwd, NTHR, LDS_BYTES) != hipSuccess || per_cu < 1) { fprintf(stderr, "kernel_launch: occupancy query failed (%d)\n", per_cu); per_cu = 1; }
        (void)hipGetLastError();
        grid = cus * 1;
    }
    if (grid < 0) return;
    Args a{};
    for (int i = 0; i < 38; ++i) a.in[i] = (const float*)d_in[i];
    a.out = (float*)d_out; a.ws = (unsigned char*)d_ws;
    for (int d = 0; d < 32; ++d) a.inv_rev[d] = pow(10000.0, -(double)d / 32.0) / 6.283185307179586476925286766559;
#if MK_SPLIT
    for (int ph = 0; ph < 9; ++ph) { a.ph_lo = ph; a.ph_hi = ph + 1; void* kargs[] = {&a};
        hipError_t e = hipLaunchCooperativeKernel((const void*)enc_fwd, dim3(grid), dim3(NTHR), kargs, LDS_BYTES, stream);
        if (e != hipSuccess) { fprintf(stderr, "launch %d failed: %s\n", ph, hipGetErrorString(e)); break; } }
#else
    a.ph_lo = 0; a.ph_hi = 9;
    void* kargs[] = {&a};
    hipError_t e = hipLaunchCooperativeKernel((const void*)enc_fwd, dim3(grid), dim3(NTHR), kargs, LDS_BYTES, stream);
    if (e != hipSuccess) fprintf(stderr, "cooperative launch failed: %s (grid %d)\n", hipGetErrorString(e), grid);
#endif
}
```

```cpp
#include <hip/hip_runtime.h>
#include <hip/hip_cooperative_groups.h>
#include <cstdio>
#include <cstdint>
#include <cmath>
namespace cg = cooperative_groups;

#define LAS __attribute__((address_space(3)))
typedef unsigned short bf16_t;
typedef short bf16x8 __attribute__((ext_vector_type(8)));
typedef short s16x4 __attribute__((ext_vector_type(4)));
typedef float f32x2 __attribute__((ext_vector_type(2)));
typedef float f32x4 __attribute__((ext_vector_type(4)));
typedef float f32x16 __attribute__((ext_vector_type(16)));
typedef unsigned u32x2 __attribute__((ext_vector_type(2)));
typedef unsigned u32x4 __attribute__((ext_vector_type(4)));

constexpr int NT = 49152, DM = 2048, TP = 16384, TS = 8192, NSEQ = 5;
constexpr int ZRP = 3584;
constexpr int DFF = 5632;
constexpr int NTHR = 512;
constexpr size_t MiB = 1u << 20;
constexpr size_t WS_CTL = 0, WS_WIN = 1 * MiB, WS_WG = 31 * MiB, WS_WKV = 55 * MiB, WS_PAR = 63 * MiB, WS_PM2 = 71 * MiB, WS_WO = 79 * MiB,
                 WS_WUP = 87 * MiB, WS_WDN = 131 * MiB, WS_ROPE = 153 * MiB, WS_MEMN = 157 * MiB, WS_KVM = 162 * MiB, WS_BON = 167 * MiB,
                 WS_H = 176 * MiB, WS_QK = 370 * MiB, WS_VM = 562 * MiB, WS_Y = 754 * MiB, WS_ACT = 370 * MiB, WS_MRG = 754 * MiB, WS_END = 946 * MiB;
constexpr int CW_QUEUE = 64, CW_LAM = 128;
constexpr int LDS_XCH = 131072, LDS_MISC = 131072 + 8192, LDS_BYTES = 131072 + 8192 + 256;

__device__ __forceinline__ int seq_start(int s) { return s == 0 ? 0 : TP + (s - 1) * TS; }
__device__ __forceinline__ int seq_len(int s) { return s == 0 ? TP : TS; }
__device__ __forceinline__ int tok_pos(int tok) { return tok < TP ? tok : ((tok - TP) & (TS - 1)); }

__device__ __forceinline__ unsigned cvt_pk_bf16(float lo, float hi) { unsigned r; asm volatile("v_cvt_pk_bf16_f32 %0, %1, %2" : "=v"(r) : "v"(lo), "v"(hi)); return r; }
__device__ __forceinline__ float bflo(unsigned w) { return __uint_as_float(w << 16); }
__device__ __forceinline__ float bfhi(unsigned w) { return __uint_as_float(w & 0xffff0000u); }
__device__ __forceinline__ float bf1(bf16_t b) { return __uint_as_float((unsigned)b << 16); }
__device__ __forceinline__ float sigmoidf_(float x) { return 1.f / (1.f + __expf(-x)); }
__device__ __forceinline__ float wave_sum(float v) {
#pragma unroll
    for (int o = 1; o < 64; o <<= 1) v += __shfl_xor(v, o);
    return v;
}

namespace pg8 {
constexpr int BM = 256, BK = 64, HALF = 128, HTB = HALF * BK * 2, STAGE_BYTES = 8 * HTB;
__host__ __device__ __forceinline__ int lds_byte(int r, int c) { const int st = (r >> 4) * 2 + (c >> 5), rr = r & 15, cc = c & 31, ob = rr * 64 + cc * 2; return st * 1024 + (ob ^ (((ob >> 9) & 1) << 5)); }
__host__ __device__ __forceinline__ void stage_rc(int b, int& R, int& C) { const int st = b / 1024, sb = b % 1024, swz = sb ^ (((sb >> 9) & 1) << 5); R = (st >> 1) * 16 + swz / 64; C = (st & 1) * 32 + (swz % 64) / 2; }
__host__ __device__ __forceinline__ int perm32(int rho) { const int n = rho >> 4, i = rho & 15; return 8 * (i >> 2) + 4 * n + (i & 3); }

struct Unit { const char* A; const char* B; int nt, pm, pn, kind, t0, T; };

template <class Epi, class Sched, bool ALIGN_EPI>
__device__ __forceinline__ void gemm_phase(LAS unsigned char* lds, const int ld, const Sched& S, const Epi& E) {
    const int tid = threadIdx.x, wid = __builtin_amdgcn_readfirstlane(tid >> 6), lane = tid & 63, wr = wid >> 2, wc = wid & 3, fr = lane & 15, fq = lane >> 4;
    unsigned voffA[2], voffB[2];
#pragma unroll
    for (int i = 0; i < 2; ++i) { int R, C; stage_rc(tid * 16 + i * 8192, R, C); const int Rb = (R & ~31) + perm32(R & 31);
        voffA[i] = (unsigned)(R * ld + C) * 2u; voffB[i] = (unsigned)(Rb * ld + C) * 2u; }
    const size_t kstep = (size_t)(BK * 2);
    const size_t hstep = (size_t)HALF * ld * 2;
    const unsigned ldsw = (unsigned)wid * 1024u;
    const int aoff = lds_byte(wr * 64 + fr, fq * 8), boff = lds_byte(wc * 32 + fr, fq * 8);
#define PG8_SA(b, h) (((b) * 2 + (h)) * HTB)
#define PG8_SB(b, h) ((4 + (b) * 2 + (h)) * HTB)
#define PG8_STAGE(bufoff, gbase, voff) do { _Pragma("unroll") for (int _i = 0; _i < 2; ++_i) \
        __builtin_amdgcn_global_load_lds((const unsigned*)((const char*)(gbase) + (voff)[_i]), (LAS unsigned*)(lds + (bufoff) + ldsw + _i * 8192), 16, 0, 0); } while (0)
#define PG8_LDA(dst, b, h) do { _Pragma("unroll") for (int m = 0; m < 4; ++m) _Pragma("unroll") for (int k = 0; k < 2; ++k) dst[m][k] = *(const LAS bf16x8*)(lds + PG8_SA(b, h) + aoff + m * 2048 + k * 1024); } while (0)
#define PG8_LDB(dst, b, h) do { _Pragma("unroll") for (int n = 0; n < 2; ++n) _Pragma("unroll") for (int k = 0; k < 2; ++k) dst[n][k] = *(const LAS bf16x8*)(lds + PG8_SB(b, h) + boff + n * 2048 + k * 1024); } while (0)
#define PG8_MMA(ai, bj, At, Bt) do { __builtin_amdgcn_s_setprio(1); _Pragma("unroll") for (int m = 0; m < 4; ++m) _Pragma("unroll") for (int n = 0; n < 2; ++n) _Pragma("unroll") for (int k = 0; k < 2; ++k) \
        acc[ai][bj][m][n] = __builtin_amdgcn_mfma_f32_16x16x32_bf16(Bt[n][k], At[m][k], acc[ai][bj][m][n], 0, 0, 0); __builtin_amdgcn_s_setprio(0); } while (0)
#define PG8_WAIT_V(n) asm volatile("s_waitcnt vmcnt(" #n ")" ::: "memory")
#define PG8_WAIT_L(n) asm volatile("s_waitcnt lgkmcnt(" #n ")" ::: "memory")
#define PG8_BAR __builtin_amdgcn_s_barrier()
#define PG8_SCHED __builtin_amdgcn_sched_barrier(0)
    Unit cur, nxt; int ui = 0;
    if (!S.next(0, cur)) return;
    f32x4 acc[2][2][4][2];
#pragma unroll
    for (int a = 0; a < 2; ++a)
#pragma unroll
        for (int b = 0; b < 2; ++b)
#pragma unroll
            for (int m = 0; m < 4; ++m)
#pragma unroll
                for (int n = 0; n < 2; ++n) acc[a][b][m][n] = (f32x4){0.f, 0.f, 0.f, 0.f};
    bf16x8 At[4][2], B0[2][2], B1[2][2];
    const char* cA = cur.A; const char* cB = cur.B;
    PG8_STAGE(PG8_SB(0, 0), cB, voffB); PG8_STAGE(PG8_SB(0, 1), cB + hstep, voffB); PG8_STAGE(PG8_SA(0, 0), cA, voffA); PG8_STAGE(PG8_SA(0, 1), cA + hstep, voffA);
    if (wr == 1) PG8_BAR;
    PG8_WAIT_V(2); PG8_BAR;
    PG8_STAGE(PG8_SB(1, 0), cB + kstep, voffB); PG8_STAGE(PG8_SA(1, 0), cA + kstep, voffA); PG8_STAGE(PG8_SB(1, 1), cB + hstep + kstep, voffB);
    PG8_WAIT_V(6); PG8_BAR;
    for (;;) {
        const bool has_next = S.next(ui + 1, nxt);
        const char* nA = has_next ? nxt.A : cA; const char* nB = has_next ? nxt.B : cB;
        const int nt = cur.nt;
        for (int t = 0; t < nt; t += 2) {
            const bool last = (t == nt - 2);
            const char* a1 = cA + (size_t)(t + 1) * kstep;
            const char* a2 = last ? nA : cA + (size_t)(t + 2) * kstep; const char* b2 = last ? nB : cB + (size_t)(t + 2) * kstep;
            const char* a3 = a2 + kstep; const char* b3 = b2 + kstep;
            PG8_LDB(B0, 0, 0); PG8_LDB(B1, 0, 1); PG8_SCHED; PG8_LDA(At, 0, 0); PG8_STAGE(PG8_SA(1, 1), a1 + hstep, voffA);
            PG8_WAIT_V(8); PG8_WAIT_L(0); PG8_BAR; PG8_MMA(0, 0, At, B0); PG8_MMA(0, 1, At, B1); PG8_BAR; PG8_SCHED;
            PG8_LDA(At, 0, 1); PG8_STAGE(PG8_SB(0, 0), b2, voffB); PG8_STAGE(PG8_SB(0, 1), b2 + hstep, voffB); PG8_STAGE(PG8_SA(0, 0), a2, voffA);
            PG8_WAIT_V(8); PG8_WAIT_L(0); PG8_BAR; PG8_MMA(1, 0, At, B0); PG8_MMA(1, 1, At, B1); PG8_BAR; PG8_SCHED;
            PG8_LDB(B0, 1, 0); PG8_LDB(B1, 1, 1); PG8_SCHED; PG8_LDA(At, 1, 0); PG8_STAGE(PG8_SA(0, 1), a2 + hstep, voffA);
            PG8_WAIT_V(8); PG8_WAIT_L(0); PG8_BAR; PG8_MMA(0, 0, At, B0); PG8_MMA(0, 1, At, B1); PG8_BAR; PG8_SCHED;
            PG8_LDA(At, 1, 1); PG8_STAGE(PG8_SB(1, 0), b3, voffB); PG8_STAGE(PG8_SB(1, 1), b3 + hstep, voffB); PG8_STAGE(PG8_SA(1, 0), a3, voffA);
            PG8_WAIT_V(8); PG8_WAIT_L(0); PG8_BAR; PG8_MMA(1, 0, At, B0); PG8_MMA(1, 1, At, B1); PG8_BAR; PG8_SCHED;
        }
        if constexpr (ALIGN_EPI) { if (wr == 0) PG8_BAR; }
        E(acc, cur, wr, wc, fr, fq);
        if (!has_next) break;
#pragma unroll
        for (int a = 0; a < 2; ++a)
#pragma unroll
            for (int b = 0; b < 2; ++b)
#pragma unroll
                for (int m = 0; m < 4; ++m)
#pragma unroll
                    for (int n = 0; n < 2; ++n) acc[a][b][m][n] = (f32x4){0.f, 0.f, 0.f, 0.f};
        cur = nxt; cA = nA; cB = nB; ++ui;
        if constexpr (ALIGN_EPI) { if (wr == 1) PG8_BAR; }
    }
    PG8_WAIT_V(0);
    if constexpr (!ALIGN_EPI) { if (wr == 0) PG8_BAR; }
    PG8_BAR;
#undef PG8_SA
#undef PG8_SB
#undef PG8_STAGE
#undef PG8_LDA
#undef PG8_LDB
#undef PG8_MMA
#undef PG8_WAIT_V
#undef PG8_WAIT_L
#undef PG8_BAR
#undef PG8_SCHED
}
}
using pg8::Unit;

struct TileMap {
    int nM, nN;
    __device__ __forceinline__ bool get(long L, int& pm, int& pn) const {
        if (L >= (long)nM * nN) return false;
        const int nig = 16 * nN, gid = (int)(L / nig), fm = gid * 16, gsz = (nM - fm) < 16 ? (nM - fm) : 16, r = (int)(L % nig);
        pm = fm + r % gsz; pn = r / gsz; return true;
    }
};

struct Args {
    const float* in[38];
    float* out; unsigned char* ws;
    double inv_rev[32];
    int ph_lo, ph_hi;
};

__device__ __forceinline__ void tr_item(const float* W, int N, int src_n0, bf16_t* WT, size_t ldw, int koff, int r0, int k0, LAS float* scr, int lane) {
    if (src_n0 >= 0) {
#pragma unroll 8
        for (int i = 0; i < 32; ++i) { const int kk = 2 * i + (lane >> 5); scr[kk * 33 + (lane & 31)] = W[(size_t)(k0 + kk) * N + src_n0 + (lane & 31)]; }
    } else {
#pragma unroll 8
        for (int i = 0; i < 32; ++i) { const int kk = 2 * i + (lane >> 5); scr[kk * 33 + (lane & 31)] = 0.f; }
    }
    asm volatile("s_waitcnt lgkmcnt(0)" ::: "memory");
    const int c = lane & 7;
#pragma unroll
    for (int j = 0; j < 4; ++j) { const int n = (lane >> 3) + 8 * j; const LAS float* s = scr + (8 * c) * 33 + n;
        u32x4 o; o.x = cvt_pk_bf16(s[0 * 33], s[1 * 33]); o.y = cvt_pk_bf16(s[2 * 33], s[3 * 33]); o.z = cvt_pk_bf16(s[4 * 33], s[5 * 33]); o.w = cvt_pk_bf16(s[6 * 33], s[7 * 33]);
        *(u32x4*)(WT + (size_t)(r0 + n) * ldw + koff + k0 + 8 * c) = o; }
    asm volatile("s_waitcnt lgkmcnt(0)" ::: "memory");
}
__device__ __forceinline__ void rms_row(const float* xrow, const float* g, bf16_t* orow, int lane) {
    f32x4 v[8]; float s = 0.f;
#pragma unroll
    for (int j = 0; j < 8; ++j) { v[j] = ((const f32x4*)xrow)[64 * j + lane]; s += (v[j].x * v[j].x + v[j].y * v[j].y) + (v[j].z * v[j].z + v[j].w * v[j].w); }
    const float rstd = rsqrtf(wave_sum(s) * (1.f / DM) + 1e-6f);
#pragma unroll
    for (int j = 0; j < 8; ++j) { const f32x4 gg = ((const f32x4*)g)[64 * j + lane];
        u32x2 w; w.x = cvt_pk_bf16(v[j].x * rstd * gg.x, v[j].y * rstd * gg.y); w.y = cvt_pk_bf16(v[j].z * rstd * gg.z, v[j].w * rstd * gg.w);
        ((u32x2*)orow)[64 * j + lane] = w; }
}

__device__ __forceinline__ void p0_prologue(const Args& a, LAS unsigned char* lds, int vcu, int G) {
    const int tid = threadIdx.x, lane = tid & 63, wave = tid >> 6;
    unsigned char* ws = a.ws;
    LAS float* scr = (LAS float*)(lds + wave * 16384);
    const int gw = vcu * 8 + wave, NGW = G * 8;
    constexpr int I0 = 32 * 240, I1 = 32 * 192, I2 = 32 * 64, I3 = 16 * 64, I6 = 32 * 64, I7 = 32 * 352, I8 = 88 * 64;
    constexpr int NITEMS = I0 + I1 + I2 + 3 * I3 + I6 + I7 + I8;
    for (int it = gw; it < NITEMS; it += NGW) {
        int r = it;
        if (r < I0) { const int kb = r / 240, nb = r % 240, r0 = nb * 32; int src;
            if (r0 < 2048) { const int tile = r0 >> 8, cp = r0 & 255, h = cp >> 7, g = (cp & 127) >> 5; src = tile * 256 + 64 * g + 32 * h; }
            else if (r0 < 6560) src = r0;
            else if (r0 < 6656) src = -1;
            else src = 6560 + (r0 - 6656);
            tr_item(a.in[5], 13728, src, (bf16_t*)(ws + WS_WIN), 2048, 0, r0, kb * 64, scr, lane); continue; } r -= I0;
        if (r < I1) { const int kb = r / 192, nb = r % 192; tr_item(a.in[5], 13728, 7584 + nb * 32, (bf16_t*)(ws + WS_WG), 2048, 0, nb * 32, kb * 64, scr, lane); continue; } r -= I1;
        if (r < I2) { const int kb = r / 64, nb = r % 64; tr_item(a.in[26], 2048, nb * 32, (bf16_t*)(ws + WS_WKV), 2048, 0, nb * 32, kb * 64, scr, lane); continue; } r -= I2;
        if (r < I3) { const int kb = r / 64, nb = r % 64; tr_item(a.in[29], 2048, nb * 32, (bf16_t*)(ws + WS_PAR), 2048, 0, nb * 32, kb * 64, scr, lane); continue; } r -= I3;
        if (r < I3) { const int kb = r / 64, nb = r % 64; tr_item(a.in[30], 2048, nb * 32, (bf16_t*)(ws + WS_PAR), 2048, 1024, nb * 32, kb * 64, scr, lane); continue; } r -= I3;
        if (r < I3) { const int kb = r / 64, nb = r % 64; tr_item(a.in[31], 2048, nb * 32, (bf16_t*)(ws + WS_PM2), 2048, 0, nb * 32, kb * 64, scr, lane); continue; } r -= I3;
        if (r < I6) { const int kb = r / 64, nb = r % 64; tr_item(a.in[32], 2048, nb * 32, (bf16_t*)(ws + WS_WO), 2048, 0, nb * 32, kb * 64, scr, lane); continue; } r -= I6;
        if (r < I7) { const int kb = r / 352, nb = r % 352, r0 = nb * 32, tile = r0 >> 8, bj = (r0 & 255) >> 7, j = r0 & 127;
            tr_item(a.in[34], 2 * DFF, bj * DFF + 128 * tile + j, (bf16_t*)(ws + WS_WUP), 2048, 0, r0, kb * 64, scr, lane); continue; } r -= I7;
        { const int kb = r / 64, nb = r % 64; tr_item(a.in[37], 2048, nb * 32, (bf16_t*)(ws + WS_WDN), DFF, 0, nb * 32, kb * 64, scr, lane); }
    }
    for (int m = gw; m < NT + 1280; m += NGW) {
        if (m < NT) { const float* xr = m < TP ? a.in[0] + (size_t)m * DM : a.in[1] + (size_t)(m - TP) * DM; rms_row(xr, a.in[4], (bf16_t*)(ws + WS_H) + (size_t)m * DM, lane); }
        else { const int j = m - NT; const float* xr = j < 256 ? a.in[2] + (size_t)j * DM : a.in[3] + (size_t)(j - 256) * DM; rms_row(xr, a.in[25], (bf16_t*)(ws + WS_MEMN) + (size_t)j * DM, lane); }
    }
    { float* rc = (float*)(ws + WS_ROPE); float* rs = rc + TP * 32;
      for (int e = (vcu * NTHR + tid); e < TP * 32; e += G * NTHR) { const int t = e >> 5, d = e & 31; double rev = (double)t * a.inv_rev[d]; rev -= rint(rev); const float rf = (float)rev;
          rc[e] = __builtin_amdgcn_cosf(rf); rs[e] = __builtin_amdgcn_sinf(rf); } }
    if (blockIdx.x == 0) {
        unsigned* ctl = (unsigned*)(ws + WS_CTL);
        if (tid < 64) {
            if (tid == 0) { ctl[CW_QUEUE] = 0u; ctl[256] = 0u; ctl[257] = 0u; }
            const float s1 = wave_sum(a.in[8][tid] * a.in[9][tid]), s2 = wave_sum(a.in[10][tid] * a.in[11][tid]);
            if (tid == 0) ((float*)ctl)[CW_LAM] = __expf(s1) - __expf(s2) + 0.2f;
        }
    }
}

struct SchedIn {
    int v, G; const char* H; const char* WIN; const char* MEMN; const char* WKV;
    __device__ __forceinline__ bool next(int i, Unit& u) const {
        long L = (long)i * G + v; int pm, pn;
        if (L < 5760) { TileMap{192, 30}.get(L, pm, pn); u.A = H + (size_t)pm * MiB; u.B = WIN + (size_t)pn * MiB; u.nt = 32; u.pm = pm; u.pn = pn; u.kind = 0; u.t0 = 0; u.T = 0; return true; }
        L -= 5760; if (L < 40) { pm = (int)(L % 5); pn = (int)(L / 5); u.A = MEMN + (size_t)pm * MiB; u.B = WKV + (size_t)pn * MiB; u.nt = 32; u.pm = pm; u.pn = pn; u.kind = 1; u.t0 = 0; u.T = 0; return true; }
        return false;
    }
};
struct EpiIn {
    bf16_t* QK; bf16_t* VM; bf16_t* ZR; bf16_t* KVM; const float* qn; const float* kn; const float* rc; const float* rs;
    __device__ __forceinline__ void plain(const f32x4 (&acc)[2][2][4][2], bf16_t* base, size_t ldc, int row0, int col0) const {
#pragma unroll
        for (int ai = 0; ai < 2; ++ai)
#pragma unroll
            for (int m = 0; m < 4; ++m) { bf16_t* rowp = base + (size_t)(row0 + ai * 128 + m * 16) * ldc + col0;
#pragma unroll
                for (int bj = 0; bj < 2; ++bj) { const f32x4 v0 = acc[ai][bj][m][0], v1 = acc[ai][bj][m][1];
                    u32x4 w; w.x = cvt_pk_bf16(v0[0], v0[1]); w.y = cvt_pk_bf16(v0[2], v0[3]); w.z = cvt_pk_bf16(v1[0], v1[1]); w.w = cvt_pk_bf16(v1[2], v1[3]);
                    *(u32x4*)(rowp + bj * 128) = w; } }
    }
    __device__ __forceinline__ void operator()(const f32x4 (&acc)[2][2][4][2], const Unit& u, int wr, int wc, int fr, int fq) const {
        const int row0 = u.pm * 256 + wr * 64 + fr, cin = wc * 32 + 8 * fq;
        if (u.kind == 1) { plain(acc, KVM, 2048, row0, u.pn * 256 + cin); return; }
        const int pn = u.pn;
        if (pn < 8) {
            const bool isq = pn < 4; const float* nw = isq ? qn : kn;
            const int Gq = (pn & 3) * 4 + wc, d0 = 8 * fq;
            const float qs = isq ? 0.125f * 1.4426950408889634f : 1.f;
            const f32x4 w1a = *(const f32x4*)(nw + d0), w1b = *(const f32x4*)(nw + d0 + 4), w2a = *(const f32x4*)(nw + 32 + d0), w2b = *(const f32x4*)(nw + 36 + d0);
            bf16_t* dst = QK + (isq ? 0 : 1024) + Gq * 64 + d0;
#pragma unroll
            for (int ai = 0; ai < 2; ++ai)
#pragma unroll
                for (int m = 0; m < 4; ++m) {
                    const int row = row0 + ai * 128 + m * 16, t = tok_pos(row);
                    const f32x4 xa = acc[ai][0][m][0], xb = acc[ai][0][m][1], ya = acc[ai][1][m][0], yb = acc[ai][1][m][1];
                    float ss = (xa[0] * xa[0] + xa[1] * xa[1]) + (xa[2] * xa[2] + xa[3] * xa[3]) + (xb[0] * xb[0] + xb[1] * xb[1]) + (xb[2] * xb[2] + xb[3] * xb[3])
                             + (ya[0] * ya[0] + ya[1] * ya[1]) + (ya[2] * ya[2] + ya[3] * ya[3]) + (yb[0] * yb[0] + yb[1] * yb[1]) + (yb[2] * yb[2] + yb[3] * yb[3]);
                    ss += __shfl_xor(ss, 16); ss += __shfl_xor(ss, 32);
                    const float rstd = rsqrtf(ss * (1.f / 64.f) + 1e-6f);
                    const f32x4 ca = *(const f32x4*)(rc + t * 32 + d0), cb = *(const f32x4*)(rc + t * 32 + d0 + 4), sa = *(const f32x4*)(rs + t * 32 + d0), sb = *(const f32x4*)(rs + t * 32 + d0 + 4);
                    const f32x4 x1a = xa * rstd * w1a, x1b = xb * rstd * w1b, x2a = ya * rstd * w2a, x2b = yb * rstd * w2b;
                    const f32x4 o1a = (x1a * ca - x2a * sa) * qs, o1b = (x1b * cb - x2b * sb) * qs, o2a = (x2a * ca + x1a * sa) * qs, o2b = (x2b * cb + x1b * sb) * qs;
                    u32x4 w; w.x = cvt_pk_bf16(o1a[0], o1a[1]); w.y = cvt_pk_bf16(o1a[2], o1a[3]); w.z = cvt_pk_bf16(o1b[0], o1b[1]); w.w = cvt_pk_bf16(o1b[2], o1b[3]);
                    *(u32x4*)(dst + (size_t)row * 2048) = w;
                    w.x = cvt_pk_bf16(o2a[0], o2a[1]); w.y = cvt_pk_bf16(o2a[2], o2a[3]); w.z = cvt_pk_bf16(o2b[0], o2b[1]); w.w = cvt_pk_bf16(o2b[2], o2b[3]);
                    *(u32x4*)(dst + (size_t)row * 2048 + 32) = w;
                }
        } else if (pn < 12) plain(acc, VM, 2048, row0, (pn - 8) * 256 + cin);
        else if (pn < 26) plain(acc, ZR, ZRP, row0, (pn - 12) * 256 + cin);
        else plain(acc, VM, 2048, row0, 1024 + (pn - 26) * 256 + cin);
    }
};

namespace att {
constexpr int SHM_V = 16384, SHM_K = 8192;
constexpr int OFF_V = 0, OFF_K = 32768, OFF_WS = 49152, OFF_STASH = 51200;
#define KSWZ64(row, colB) ((row) * 128 + ((colB) ^ (((row) & 7) << 4)))
#define SBAR() __builtin_amdgcn_sched_barrier(0)
__device__ __forceinline__ int crow(int r, int hi) { return (r & 3) + 8 * (r >> 2) + 4 * hi; }
constexpr float THRL = 8.f;
__device__ __forceinline__ void partialSM(f32x16& p0, f32x16& p1, float& m_reg, float& alpha) {
    float pmax = p0[0];
#pragma unroll
    for (int r = 1; r < 16; ++r) pmax = fmaxf(pmax, p0[r]);
#pragma unroll
    for (int r = 0; r < 16; ++r) pmax = fmaxf(pmax, p1[r]);
    { auto rr = __builtin_amdgcn_permlane32_swap(__float_as_uint(pmax), __float_as_uint(pmax), false, false);
      pmax = fmaxf(__uint_as_float(rr[0]), __uint_as_float(rr[1])); }
    float mn;
    if (__builtin_expect(__all(pmax - m_reg <= THRL), 1)) { mn = m_reg; alpha = 1.f; }
    else { mn = fmaxf(m_reg, pmax); alpha = __builtin_amdgcn_exp2f(m_reg - mn); m_reg = mn; }
#pragma unroll
    for (int r = 0; r < 16; ++r) p0[r] -= mn;
#pragma unroll
    for (int r = 0; r < 16; ++r) p1[r] -= mn;
#pragma unroll
    for (int r = 0; r < 16; ++r) p0[r] = __builtin_amdgcn_exp2f(p0[r]);
}
__device__ __forceinline__ void finishSM(f32x16& p0, f32x16& p1, float alpha, float& l_reg, bf16x8& pa0, bf16x8& pa1, bf16x8& pa2, bf16x8& pa3) {
#pragma unroll
    for (int r = 0; r < 16; ++r) p1[r] = __builtin_amdgcn_exp2f(p1[r]);
    float ps = 0;
#pragma unroll
    for (int r = 0; r < 16; ++r) ps += p0[r];
#pragma unroll
    for (int r = 0; r < 16; ++r) ps += p1[r];
    { auto rr = __builtin_amdgcn_permlane32_swap(__float_as_uint(ps), __float_as_uint(ps), false, false);
      ps = __uint_as_float(rr[0]) + __uint_as_float(rr[1]); }
    l_reg = l_reg * alpha + ps;
#define PK4(P, BASE, OUT) do { unsigned a0 = cvt_pk_bf16(P[BASE + 0], P[BASE + 1]), a1 = cvt_pk_bf16(P[BASE + 2], P[BASE + 3]);   \
    unsigned b0 = cvt_pk_bf16(P[BASE + 4], P[BASE + 5]), b1 = cvt_pk_bf16(P[BASE + 6], P[BASE + 7]);                              \
    auto r0 = __builtin_amdgcn_permlane32_swap(a0, b0, false, false); auto r1 = __builtin_amdgcn_permlane32_swap(a1, b1, false, false); \
    u32x4 w = {r0[0], r1[0], r0[1], r1[1]}; OUT = *reinterpret_cast<bf16x8*>(&w); } while (0)
    PK4(p0, 0, pa0); PK4(p0, 8, pa1); PK4(p1, 0, pa2); PK4(p1, 8, pa3);
#undef PK4
}
__device__ __forceinline__ void qkt64(f32x16& p0, f32x16& p1, const char* Ks, const bf16x8* qr, int r32, int hi) {
#pragma unroll
    for (int d0 = 0; d0 < 4; ++d0) { const int cb = (d0 * 16 + hi * 8) * 2;
        const bf16x8 b0 = *reinterpret_cast<const bf16x8*>(Ks + KSWZ64(r32, cb));
        const bf16x8 b1 = *reinterpret_cast<const bf16x8*>(Ks + KSWZ64(32 + r32, cb));
        p0 = __builtin_amdgcn_mfma_f32_32x32x16_bf16(b0, qr[d0], p0, 0, 0, 0);
        p1 = __builtin_amdgcn_mfma_f32_32x32x16_bf16(b1, qr[d0], p1, 0, 0, 0); }
}
__device__ __forceinline__ int v_st(int k, int c) { const int kk = (k & ~0xC) | ((k & 4) << 1) | ((k & 8) >> 1); return ((kk >> 3) * 4 + (c >> 5)) * 512 + ((kk & 7) * 32 + (c & 31)) * 2; }
__device__ __forceinline__ int v_rd_base(int lane) { return ((lane & 3) << 3) | (((lane >> 2) & 3) << 6) | (((lane >> 4) & 1) << 5) | (((lane >> 5) & 1) << 8); }
constexpr int v_rd_off(int d0, int ks, int half) { return d0 * 512 + ks * 4096 + half * 2048; }
template <int OFF> __device__ __forceinline__ s16x4 tr_read(int vb) {
    s16x4 r; asm volatile("ds_read_b64_tr_b16 %0, %1 offset:%2" : "=&v"(r) : "v"(vb), "i"(OFF) : "memory"); return r;
}
template <int D0> __device__ __forceinline__ void pv_one(f32x16& od, int vb, bf16x8 pa0, bf16x8 pa1, bf16x8 pa2, bf16x8 pa3) {
    const s16x4 l0 = tr_read<v_rd_off(D0, 0, 0)>(vb), h0 = tr_read<v_rd_off(D0, 0, 1)>(vb), l1 = tr_read<v_rd_off(D0, 1, 0)>(vb), h1 = tr_read<v_rd_off(D0, 1, 1)>(vb);
    const s16x4 l2 = tr_read<v_rd_off(D0, 2, 0)>(vb), h2 = tr_read<v_rd_off(D0, 2, 1)>(vb), l3 = tr_read<v_rd_off(D0, 3, 0)>(vb), h3 = tr_read<v_rd_off(D0, 3, 1)>(vb);
    asm volatile("s_waitcnt lgkmcnt(0)" ::: "memory"); SBAR();
#define PK(L, H) (bf16x8){L[0], L[1], L[2], L[3], H[0], H[1], H[2], H[3]}
    od = __builtin_amdgcn_mfma_f32_32x32x16_bf16(pa0, PK(l0, h0), od, 0, 0, 0);
    od = __builtin_amdgcn_mfma_f32_32x32x16_bf16(pa1, PK(l1, h1), od, 0, 0, 0);
    od = __builtin_amdgcn_mfma_f32_32x32x16_bf16(pa2, PK(l2, h2), od, 0, 0, 0);
    od = __builtin_amdgcn_mfma_f32_32x32x16_bf16(pa3, PK(l3, h3), od, 0, 0, 0);
#undef PK
}
__device__ __forceinline__ void pv_d0(f32x16* o, int vb, bf16x8 pa0, bf16x8 pa1, bf16x8 pa2, bf16x8 pa3) {
    pv_one<0>(o[0], vb, pa0, pa1, pa2, pa3); pv_one<1>(o[1], vb, pa0, pa1, pa2, pa3); pv_one<2>(o[2], vb, pa0, pa1, pa2, pa3); pv_one<3>(o[3], vb, pa0, pa1, pa2, pa3);
}

__device__ __forceinline__ void stash_store(const unsigned* stash, bf16_t* Ow, int ldo, int lane) {
#pragma unroll
    for (int i = 0; i < 8; ++i) { const int q = i * 64 + lane, rl = q >> 4, c8 = (q & 15) * 8, hh = (rl >> 2) & 1, r = (rl & 3) + 4 * (rl >> 3), d0 = c8 >> 5, cc = c8 & 31;
        const unsigned* sp = stash + (d0 * 8 + (r >> 1)) * 64 + hh * 32 + cc; const u32x4 a = *(const u32x4*)sp, b = *(const u32x4*)(sp + 4);
        u32x4 w;
        if (r & 1) { w.x = (a.x >> 16) | (a.y & 0xffff0000u); w.y = (a.z >> 16) | (a.w & 0xffff0000u); w.z = (b.x >> 16) | (b.y & 0xffff0000u); w.w = (b.z >> 16) | (b.w & 0xffff0000u); }
        else { w.x = (a.x & 0xffffu) | (a.y << 16); w.y = (a.z & 0xffffu) | (a.w << 16); w.z = (b.x & 0xffffu) | (b.y << 16); w.w = (b.z & 0xffffu) | (b.w << 16); }
        *(u32x4*)(Ow + (size_t)rl * ldo + c8) = w; }
}

__device__ __forceinline__ void diff_unit(int s, int h, int qb, bf16_t* QK, const bf16_t* VM, float lam, char* lds) {
    constexpr int LDK = 2048;
    int tid = threadIdx.x; asm volatile("" : "+v"(tid));
    const int wid = __builtin_amdgcn_readfirstlane(tid >> 6), lane = tid & 63, r32 = lane & 31, hi = lane >> 5;
    const int tok0 = seq_start(s), T = seq_len(s), NTL = T / 64;
    char* V_lds = lds + OFF_V; char* K_lds = lds + OFF_K;
    float* wsf = (float*)(lds + OFF_WS) + wid * 64; float* li_l = wsf; float* al_l = wsf + 32;
    unsigned* stash = (unsigned*)(lds + OFF_STASH) + wid * 2048;
    const int sr = tid >> 4, sc = (tid & 15) * 8, vst0 = v_st(sr, sc), vst1 = v_st(32 + sr, sc);
    const int kr = tid >> 3, kc = (tid & 7) * 8, kst = KSWZ64(kr, kc * 2);
    const int vb0 = (int)(uintptr_t)V_lds + v_rd_base(lane);
    const bf16_t* Vh = VM + (size_t)tok0 * LDK + h * 128;
    const size_t qrow = (size_t)(tok0 + qb * 256 + wid * 32);
#pragma unroll 1
    for (int c = 0; c < 2; ++c) {
        const bf16_t* Kh = QK + (size_t)tok0 * LDK + 1024 + h * 128 + c * 64;
        const bf16_t* Qw = QK + (qrow + r32) * LDK + h * 128 + c * 64 + hi * 8;
        bf16x8 qr[4];
#pragma unroll
        for (int d0 = 0; d0 < 4; ++d0) qr[d0] = *reinterpret_cast<const bf16x8*>(Qw + d0 * 16);
        float m_reg = -1e30f, l_reg = 0; f32x16 o[4] = {};
        struct { bf16x8 vs0, vs1, ks0; } sr_[2];
#define SLOAD(i, k0) do { sr_[i].vs0 = *reinterpret_cast<const bf16x8*>(&Vh[(size_t)((k0) + sr) * LDK + sc]); sr_[i].vs1 = *reinterpret_cast<const bf16x8*>(&Vh[(size_t)((k0) + 32 + sr) * LDK + sc]); \
    sr_[i].ks0 = *reinterpret_cast<const bf16x8*>(&Kh[(size_t)((k0) + kr) * LDK + kc]); } while (0)
#define SWRITE(b, i) do { *(bf16x8*)(V_lds + (b) * SHM_V + vst0) = sr_[i].vs0; *(bf16x8*)(V_lds + (b) * SHM_V + vst1) = sr_[i].vs1; *(bf16x8*)(K_lds + (b) * SHM_K + kst) = sr_[i].ks0; } while (0)
#define SWAIT() asm volatile("s_waitcnt vmcnt(3)" ::: "memory")
#define RESC(a) do { if (__any((a) < 1.f)) { if (hi == 0) al_l[r32] = (a); asm volatile("s_waitcnt lgkmcnt(0)" ::: "memory"); \
    _Pragma("unroll") for (int d = 0; d < 4; ++d) _Pragma("unroll") for (int r = 0; r < 16; ++r) o[d][r] *= al_l[crow(r, hi)]; } } while (0)
        f32x16 pA0, pA1, pB0, pB1; float alA, alB; bf16x8 pa0, pa1, pa2, pa3;
        SLOAD(0, 0); asm volatile("s_waitcnt vmcnt(0)" ::: "memory"); SWRITE(0, 0); __syncthreads();
        pA0 = f32x16{}; pA1 = f32x16{}; qkt64(pA0, pA1, K_lds, qr, r32, hi); partialSM(pA0, pA1, m_reg, alA);
        SLOAD(1, 64); if (2 < NTL) SLOAD(0, 128);
        SWAIT(); SWRITE(1, 1); __syncthreads();
        for (int j = 1; j + 1 < NTL; j += 2) {
            SBAR(); pB0 = f32x16{}; pB1 = f32x16{}; qkt64(pB0, pB1, K_lds + SHM_K, qr, r32, hi);
            finishSM(pA0, pA1, alA, l_reg, pa0, pa1, pa2, pa3); SBAR();
            SLOAD(1, (j + 2) * 64); SBAR();
            pv_d0(o, vb0, pa0, pa1, pa2, pa3); partialSM(pB0, pB1, m_reg, alB);
            __syncthreads(); SWAIT(); SWRITE(0, 0);
            RESC(alB); __syncthreads();
            SBAR(); pA0 = f32x16{}; pA1 = f32x16{}; qkt64(pA0, pA1, K_lds, qr, r32, hi);
            finishSM(pB0, pB1, alB, l_reg, pa0, pa1, pa2, pa3); SBAR();
            if (j + 3 < NTL) SLOAD(0, (j + 3) * 64); SBAR();
            pv_d0(o, vb0 + SHM_V, pa0, pa1, pa2, pa3); partialSM(pA0, pA1, m_reg, alA);
            __syncthreads(); SWAIT(); SWRITE(1, 1);
            RESC(alA); __syncthreads();
        }
        SBAR(); pB0 = f32x16{}; pB1 = f32x16{}; qkt64(pB0, pB1, K_lds + SHM_K, qr, r32, hi);
        finishSM(pA0, pA1, alA, l_reg, pa0, pa1, pa2, pa3); SBAR();
        pv_d0(o, vb0, pa0, pa1, pa2, pa3); partialSM(pB0, pB1, m_reg, alB);
        __syncthreads(); RESC(alB);
        finishSM(pB0, pB1, alB, l_reg, pa0, pa1, pa2, pa3); SBAR();
        pv_d0(o, vb0 + SHM_V, pa0, pa1, pa2, pa3);
#undef SLOAD
#undef SWRITE
#undef SWAIT
#undef RESC
        if (hi == 0) li_l[r32] = l_reg; asm volatile("s_waitcnt lgkmcnt(0)" ::: "memory");
        float rli[16];
#pragma unroll
        for (int r = 0; r < 16; ++r) rli[r] = __builtin_amdgcn_rcpf(li_l[crow(r, hi)]);
        { const float coef = c == 0 ? 1.f : -lam;
#pragma unroll
          for (int d0 = 0; d0 < 4; ++d0)
#pragma unroll
              for (int r = 0; r < 16; r += 2) { const int idx = (d0 * 8 + (r >> 1)) * 64 + lane; const unsigned w = c == 0 ? 0u : stash[idx];
                  stash[idx] = cvt_pk_bf16(bflo(w) + coef * o[d0][r] * rli[r], bfhi(w) + coef * o[d0][r + 1] * rli[r + 1]); } }
        __syncthreads();
    }
    stash_store(stash, QK + qrow * LDK + h * 128, LDK, lane);
    __syncthreads();
}

constexpr int MOFF_V = 0, MOFF_K = 32768, MOFF_WS = 65536, MOFF_RK = 67584, MOFF_G = 68608, MOFF_STASH = 69632;
__device__ __forceinline__ void mem_unit(int s, int mh, int qb, bf16_t* VM, const bf16_t* KVM, const float* mqn, const float* mkn, char* lds) {
    int tid = threadIdx.x; asm volatile("" : "+v"(tid));
    const int wid = __builtin_amdgcn_readfirstlane(tid >> 6), lane = tid & 63, r32 = lane & 31, hi = lane >> 5;
    const int tok0 = seq_start(s);
    char* V_lds = lds + MOFF_V; char* K_lds = lds + MOFF_K;
    float* wsf = (float*)(lds + MOFF_WS) + wid * 64; float* li_l = wsf; float* al_l = wsf + 32;
    float* rk_l = (float*)(lds + MOFF_RK); float* g_l = (float*)(lds + MOFF_G);
    const bf16_t* Kh = KVM + (size_t)(s * 256) * 2048 + mh * 256;
    const bf16_t* Vh = KVM + (size_t)(s * 256) * 2048 + 1024 + mh * 256;
    if (tid < 256) g_l[tid] = mqn[tid] * mkn[tid];
    {
        const bf16_t* kp = Kh + (size_t)(wid * 32 + r32) * 2048 + hi * 128; float ss = 0.f;
#pragma unroll
        for (int i = 0; i < 16; ++i) { const u32x4 w = *(const u32x4*)(kp + i * 8);
            ss += bflo(w.x) * bflo(w.x) + bfhi(w.x) * bfhi(w.x) + bflo(w.y) * bflo(w.y) + bfhi(w.y) * bfhi(w.y) + bflo(w.z) * bflo(w.z) + bfhi(w.z) * bfhi(w.z) + bflo(w.w) * bflo(w.w) + bfhi(w.w) * bfhi(w.w); }
        ss += __shfl_xor(ss, 32);
        if (hi == 0) rk_l[wid * 32 + r32] = rsqrtf(ss * (1.f / 256.f) + 1e-6f);
    }
    const size_t qrow = (size_t)(tok0 + qb * 256 + wid * 32);
    bf16_t* Qw = VM + (qrow + r32) * 2048 + 1024 + mh * 256 + hi * 8;
    float rqC;
    { float ss = 0.f;
#pragma unroll
      for (int i = 0; i < 16; ++i) { const u32x4 w = *(const u32x4*)(Qw + i * 16);
          ss += bflo(w.x) * bflo(w.x) + bfhi(w.x) * bfhi(w.x) + bflo(w.y) * bflo(w.y) + bfhi(w.y) * bfhi(w.y) + bflo(w.z) * bflo(w.z) + bfhi(w.z) * bfhi(w.z) + bflo(w.w) * bflo(w.w) + bfhi(w.w) * bfhi(w.w); }
      ss += __shfl_xor(ss, 32);
      rqC = rsqrtf(ss * (1.f / 256.f) + 1e-6f) * (0.0625f * 1.4426950408889634f); }
    const int sr = tid >> 4, sc = (tid & 15) * 8, vst0 = v_st(sr, sc), vst1 = v_st(32 + sr, sc);
    const int kr = tid >> 3, kc = (tid & 7) * 8, kst = KSWZ64(kr, kc * 2);
    const int vb0 = (int)(uintptr_t)V_lds + v_rd_base(lane);
    unsigned* stash = (unsigned*)(lds + MOFF_STASH) + wid * 2048;
    __syncthreads();
#pragma unroll 1
    for (int hv = 0; hv < 2; ++hv) {
    float m_reg = -1e30f, l_reg = 0.f; f32x16 o[4] = {};
#pragma unroll 1
    for (int t = 0; t < 4; ++t) {
        const int k0 = t * 64;
#pragma unroll
        for (int ds = 0; ds < 4; ++ds) { const u32x4 w = *(const u32x4*)(Kh + (size_t)(k0 + kr) * 2048 + ds * 64 + kc); const float* g = g_l + ds * 64 + kc;
            u32x4 o4; o4.x = cvt_pk_bf16(bflo(w.x) * g[0], bfhi(w.x) * g[1]); o4.y = cvt_pk_bf16(bflo(w.y) * g[2], bfhi(w.y) * g[3]);
            o4.z = cvt_pk_bf16(bflo(w.z) * g[4], bfhi(w.z) * g[5]); o4.w = cvt_pk_bf16(bflo(w.w) * g[6], bfhi(w.w) * g[7]);
            *(u32x4*)(K_lds + ds * 8192 + kst) = o4; asm volatile("" ::: "memory"); }
        *(u32x4*)(V_lds + vst0) = *(const u32x4*)(Vh + (size_t)(k0 + sr) * 2048 + hv * 128 + sc);
        *(u32x4*)(V_lds + vst1) = *(const u32x4*)(Vh + (size_t)(k0 + 32 + sr) * 2048 + hv * 128 + sc);
        __syncthreads();
        f32x16 p0 = {}, p1 = {};
#pragma unroll
        for (int ds = 0; ds < 4; ++ds) { bf16x8 qr[4];
#pragma unroll
            for (int d0 = 0; d0 < 4; ++d0) qr[d0] = *reinterpret_cast<const bf16x8*>(Qw + ds * 64 + d0 * 16);
            qkt64(p0, p1, K_lds + ds * 8192, qr, r32, hi); }
#pragma unroll
        for (int r = 0; r < 16; ++r) { p0[r] *= rk_l[k0 + crow(r, hi)] * rqC; p1[r] *= rk_l[k0 + 32 + crow(r, hi)] * rqC; }
        float pmax = p0[0];
#pragma unroll
        for (int r = 1; r < 16; ++r) pmax = fmaxf(pmax, p0[r]);
#pragma unroll
        for (int r = 0; r < 16; ++r) pmax = fmaxf(pmax, p1[r]);
        pmax = fmaxf(pmax, __shfl_xor(pmax, 32));
        const float mn = fmaxf(m_reg, pmax), alpha = __builtin_amdgcn_exp2f(m_reg - mn); m_reg = mn;
        float ps = 0.f;
#pragma unroll
        for (int r = 0; r < 16; ++r) { p0[r] = __builtin_amdgcn_exp2f(p0[r] - mn); p1[r] = __builtin_amdgcn_exp2f(p1[r] - mn); ps += p0[r] + p1[r]; }
        ps += __shfl_xor(ps, 32);
        l_reg = l_reg * alpha + ps;
        if (hi == 0) al_l[r32] = alpha; asm volatile("s_waitcnt lgkmcnt(0)" ::: "memory");
#pragma unroll
        for (int d = 0; d < 4; ++d)
#pragma unroll
            for (int r = 0; r < 16; ++r) o[d][r] *= al_l[crow(r, hi)];
        bf16x8 pa0, pa1, pa2, pa3;
#define PK4(P, BASE, OUT) do { unsigned a0 = cvt_pk_bf16(P[BASE + 0], P[BASE + 1]), a1 = cvt_pk_bf16(P[BASE + 2], P[BASE + 3]);   \
    unsigned b0 = cvt_pk_bf16(P[BASE + 4], P[BASE + 5]), b1 = cvt_pk_bf16(P[BASE + 6], P[BASE + 7]);                              \
    auto r0 = __builtin_amdgcn_permlane32_swap(a0, b0, false, false); auto r1 = __builtin_amdgcn_permlane32_swap(a1, b1, false, false); \
    u32x4 w = {r0[0], r1[0], r0[1], r1[1]}; OUT = *reinterpret_cast<bf16x8*>(&w); } while (0)
        PK4(p0, 0, pa0); PK4(p0, 8, pa1); PK4(p1, 0, pa2); PK4(p1, 8, pa3);
#undef PK4
        pv_d0(o, vb0, pa0, pa1, pa2, pa3);
        __syncthreads();
    }
    if (hi == 0) li_l[r32] = l_reg; asm volatile("s_waitcnt lgkmcnt(0)" ::: "memory");
    if (hv == 1) stash_store(stash, VM + qrow * 2048 + 1024 + mh * 256, 2048, lane);
#pragma unroll
    for (int d0 = 0; d0 < 4; ++d0)
#pragma unroll
        for (int r = 0; r < 16; r += 2) stash[(d0 * 8 + (r >> 1)) * 64 + lane] = cvt_pk_bf16(o[d0][r] * __builtin_amdgcn_rcpf(li_l[crow(r, hi)]), o[d0][r + 1] * __builtin_amdgcn_rcpf(li_l[crow(r + 1, hi)]));
    }
    stash_store(stash, VM + qrow * 2048 + 1024 + mh * 256 + 128, 2048, lane);
    __syncthreads();
}
#undef SBAR
}

namespace scan {
constexpr int TC = 32;
constexpr int BUFB = 57344, O_R = 0, O_KD = 8192, O_KK = 16384, O_W = 24576, O_KA = 32768, O_V = 40960, O_Y = 49152;
constexpr int O_PRIV = 114688;
constexpr int O_TBL = 114688 + 8192;
__device__ __forceinline__ float dpp_red8(float x) {
    x += __uint_as_float(__builtin_amdgcn_update_dpp(0u, __float_as_uint(x), 0xB1, 0xf, 0xf, false));
    x += __uint_as_float(__builtin_amdgcn_update_dpp(0u, __float_as_uint(x), 0x4E, 0xf, 0xf, false));
    x += __uint_as_float(__builtin_amdgcn_update_dpp(0u, __float_as_uint(x), 0x141, 0xf, 0xf, false));
    return x;
}
struct P {
    const bf16_t* ZR; bf16_t* YB; float* BON;
    const float *mup, *mun, *w0, *w2, *a0, *a2, *kk_w, *ka_w, *rk_w;
};
__device__ __forceinline__ void job(int s, int dir, int head, const P& p, char* lds) {
    int tid = threadIdx.x; asm volatile("" : "+v"(tid));
    const int wid = __builtin_amdgcn_readfirstlane(tid >> 6), lane = tid & 63;
    const int tok0 = seq_start(s), T = seq_len(s), NCH = T / TC;
    float* TBL = (float*)(lds + O_TBL);
    float* MUP = TBL; float* MUN = TBL + 320; float* KKW = TBL + 640; float* KAW = TBL + 704; float* RKW = TBL + 768; float* BW = TBL + 832; float* BA = TBL + 896;
    __syncthreads();
    if (tid < 320) { const int which = tid >> 6, j = tid & 63; const int col = which < 3 ? which * 1024 + head * 64 + j : (which == 3 ? 3072 : 3200) + dir * 64 + j; MUP[tid] = p.mup[col]; MUN[tid] = p.mun[col]; }
    if (tid >= 320 && tid < 384) { const int j = tid - 320; KKW[j] = p.kk_w[head * 64 + j]; KAW[j] = p.ka_w[head * 64 + j]; RKW[j] = p.rk_w[head * 64 + j];
        BW[j] = p.w0[dir * 1024 + head * 64 + j]; BA[j] = p.a0[dir * 1024 + head * 64 + j]; }
    bf16_t* yb = p.YB + (size_t)dir * NT * 1024; float* bon = p.BON + (size_t)dir * NT * 16;
    if (wid >= 4) {
        const int pw = wid - 4;
        bf16_t* AWl = (bf16_t*)(lds + O_PRIV + pw * 2048); bf16_t* AAl = AWl + 512;
        bf16x8 Bf[2][4][2];
#pragma unroll
        for (int mat = 0; mat < 2; ++mat)
#pragma unroll
            for (int cbk = 0; cbk < 4; ++cbk)
#pragma unroll
                for (int ks = 0; ks < 2; ++ks) { const float* W2 = (mat == 0 ? p.w2 : p.a2) + (size_t)dir * 64 * 1024 + head * 64 + cbk * 16 + (lane & 15) + (size_t)(ks * 32 + (lane >> 4) * 8) * 1024;
                    float f[8];
#pragma unroll
                    for (int e = 0; e < 8; ++e) f[e] = W2[(size_t)e * 1024];
                    u32x4 w; w.x = cvt_pk_bf16(f[0], f[1]); w.y = cvt_pk_bf16(f[2], f[3]); w.z = cvt_pk_bf16(f[4], f[5]); w.w = cvt_pk_bf16(f[6], f[7]); Bf[mat][cbk][ks] = *reinterpret_cast<bf16x8*>(&w); }
        __syncthreads();
        const int pt = tid - 256;
        u32x4 zc[5], zm[5], zn[5];
#define PLOAD(cc) do { const int tf_ = dir ? T - TC * ((cc) + 1) : TC * (cc); \
    _Pragma("unroll") for (int k = 0; k < 5; ++k) { const int item = lane + 64 * k, tl8 = item / 40, chh = item - tl8 * 40, which = chh >> 3, j0 = (chh & 7) * 8; \
        const int col = which < 3 ? which * 1024 + head * 64 + j0 : (which == 3 ? 3072 : 3200) + dir * 64 + j0; \
        const int t = tf_ + 8 * pw + tl8; const bf16_t* zp = p.ZR + (size_t)(tok0 + t) * ZRP + col; \
        zc[k] = *(const u32x4*)zp; zm[k] = (u32x4){0u, 0u, 0u, 0u}; zn[k] = (u32x4){0u, 0u, 0u, 0u}; \
        if (t > 0) zm[k] = *(const u32x4*)(zp - ZRP); \
        if (t < T - 1) zn[k] = *(const u32x4*)(zp + ZRP); } } while (0)
        PLOAD(0);
        for (int c = -1; c < NCH; ++c) {
            if (c >= 1) { const int cb_ = (c - 1) & 1, tf = dir ? T - TC * c : TC * (c - 1); const int tl = pt >> 3, c8 = (pt & 7) * 8;
                const float* yp = (const float*)(lds + cb_ * BUFB + O_Y) + tl * 64 + c8; const f32x4 y4 = *(const f32x4*)yp, y5 = *(const f32x4*)(yp + 4);
                u32x4 w; w.x = cvt_pk_bf16(y4[0], y4[1]); w.y = cvt_pk_bf16(y4[2], y4[3]); w.z = cvt_pk_bf16(y5[0], y5[1]); w.w = cvt_pk_bf16(y5[2], y5[3]);
                *(u32x4*)(yb + (size_t)(tok0 + tf + tl) * 1024 + head * 64 + c8) = w; }
            if (c + 1 < NCH) {
                const int nb = (c + 1) & 1, tfirst = dir ? T - TC * (c + 2) : TC * (c + 1);
                char* B_ = lds + nb * BUFB;
                float* Rl = (float*)(B_ + O_R); float* KDl = (float*)(B_ + O_KD); float* KKl = (float*)(B_ + O_KK); float* Wl = (float*)(B_ + O_W); float* KAl = (float*)(B_ + O_KA); float* Vl = (float*)(B_ + O_V);
#pragma unroll
                for (int k = 0; k < 5; ++k) { const int item = lane + 64 * k, tl8 = item / 40, chh = item - tl8 * 40, which = chh >> 3, j0 = (chh & 7) * 8, tl = 8 * pw + tl8;
                    const f32x4 mpa = *(const f32x4*)(MUP + which * 64 + j0), mpb = *(const f32x4*)(MUP + which * 64 + j0 + 4), mna = *(const f32x4*)(MUN + which * 64 + j0), mnb = *(const f32x4*)(MUN + which * 64 + j0 + 4);
                    const u32x4 z = zc[k], zmm = zm[k], znn = zn[k];
                    float v[8];
#define SH(i, zw, zmw, znw, lohi, mp_, mn_) { const float zz = lohi(zw), a_ = lohi(zmw), b_ = lohi(znw); v[i] = zz + mp_ * (a_ - zz) + mn_ * (b_ - zz); }
                    SH(0, z.x, zmm.x, znn.x, bflo, mpa[0], mna[0]) SH(1, z.x, zmm.x, znn.x, bfhi, mpa[1], mna[1]) SH(2, z.y, zmm.y, znn.y, bflo, mpa[2], mna[2]) SH(3, z.y, zmm.y, znn.y, bfhi, mpa[3], mna[3])
                    SH(4, z.z, zmm.z, znn.z, bflo, mpb[0], mnb[0]) SH(5, z.z, zmm.z, znn.z, bfhi, mpb[1], mnb[1]) SH(6, z.w, zmm.w, znn.w, bflo, mpb[2], mnb[2]) SH(7, z.w, zmm.w, znn.w, bfhi, mpb[3], mnb[3])
#undef SH
                    if (which < 2) { float* dst = (which == 0 ? Rl : KDl) + tl * 64 + j0;
                        *(f32x4*)dst = (f32x4){v[0], v[1], v[2], v[3]}; *(f32x4*)(dst + 4) = (f32x4){v[4], v[5], v[6], v[7]}; }
                    else if (which == 2) { float* dst = Vl + tl * 64 + j0;
                        *(f32x4*)dst = (f32x4){v[0], v[1], v[2], v[3]}; *(f32x4*)(dst + 4) = (f32x4){v[4], v[5], v[6], v[7]}; }
                    else { if (which == 3) {
#pragma unroll
                            for (int i = 0; i < 8; ++i) { const float e2 = __expf(2.f * v[i]); v[i] = 1.f - 2.f * __builtin_amdgcn_rcpf(e2 + 1.f); } }
                        u32x4 w; w.x = cvt_pk_bf16(v[0], v[1]); w.y = cvt_pk_bf16(v[2], v[3]); w.z = cvt_pk_bf16(v[4], v[5]); w.w = cvt_pk_bf16(v[6], v[7]);
                        *(u32x4*)((which == 3 ? AWl : AAl) + tl8 * 64 + j0) = w; }
                }
                { const int tj = lane & 7, kq = lane >> 4;
#pragma unroll
                  for (int mat = 0; mat < 2; ++mat) { const bf16_t* Am = (mat == 0 ? AWl : AAl) + tj * 64 + kq * 8;
                      const bf16x8 y0 = *reinterpret_cast<const bf16x8*>(Am), y1 = *reinterpret_cast<const bf16x8*>(Am + 32);
#pragma unroll
                      for (int cbk = 0; cbk < 4; ++cbk) { f32x4 acc = {0.f, 0.f, 0.f, 0.f};
                          acc = __builtin_amdgcn_mfma_f32_16x16x32_bf16(Bf[mat][cbk][0], y0, acc, 0, 0, 0);
                          acc = __builtin_amdgcn_mfma_f32_16x16x32_bf16(Bf[mat][cbk][1], y1, acc, 0, 0, 0);
                          const int col = cbk * 16 + 4 * kq; const f32x4 bias = *(const f32x4*)((mat == 0 ? BW : BA) + col); f32x4 res;
#pragma unroll
                          for (int r = 0; r < 4; ++r) { const float u = acc[r] + bias[r];
                              const float sg = __builtin_amdgcn_rcpf(1.f + __expf(-u));
                              res[r] = mat == 0 ? __expf(-0.60653065971263342f * sg) : sg; }
                          if ((lane & 15) < 8) *(f32x4*)((mat == 0 ? Wl : KAl) + (8 * pw + tj) * 64 + col) = res; } } }
                { const int tl = 8 * pw + (lane >> 3), c0 = (lane & 7) * 8; const int o = tl * 64 + c0;
                  float bs = 0.f, ss = 0.f; f32x4 kr[2], k4[2], a4[2];
#pragma unroll
                  for (int q = 0; q < 2; ++q) { k4[q] = *(const f32x4*)(KDl + o + 4 * q); a4[q] = *(const f32x4*)(KAl + o + 4 * q);
                      kr[q] = k4[q] * *(const f32x4*)(KKW + c0 + 4 * q); ss += (kr[q][0] * kr[q][0] + kr[q][1] * kr[q][1]) + (kr[q][2] * kr[q][2] + kr[q][3] * kr[q][3]); }
                  ss = dpp_red8(ss);
                  const float inv = __builtin_amdgcn_rsqf(fmaxf(ss, 1e-24f));
#pragma unroll
                  for (int q = 0; q < 2; ++q) { const f32x4 kk = kr[q] * inv, kd = k4[q] * (1.f + (a4[q] - 1.f) * *(const f32x4*)(KAW + c0 + 4 * q)), kka = kk * a4[q];
                      const f32x4 bb = *(const f32x4*)(Rl + o + 4 * q) * kd * *(const f32x4*)(RKW + c0 + 4 * q); bs += (bb[0] + bb[1]) + (bb[2] + bb[3]);
                      *(f32x4*)(KKl + o + 4 * q) = kk; *(f32x4*)(KDl + o + 4 * q) = kd; *(f32x4*)(KAl + o + 4 * q) = kka; }
                  bs = dpp_red8(bs);
                  if ((lane & 7) == 0) bon[(size_t)(tok0 + tfirst + tl) * 16 + head] = bs; }
                if (c + 2 < NCH) PLOAD(c + 2);
            }
            asm volatile("s_waitcnt lgkmcnt(0)" ::: "memory"); __builtin_amdgcn_s_barrier(); asm volatile("" ::: "memory");
        }
#undef PLOAD
    } else {
        __syncthreads();
        const int row0 = wid * 16 + (lane >> 3) * 2, seg = lane & 7;
        f32x2 S[2][4];
#pragma unroll
        for (int h2 = 0; h2 < 2; ++h2)
#pragma unroll
            for (int q = 0; q < 4; ++q) S[h2][q] = (f32x2){0.f, 0.f};
        asm volatile("s_waitcnt lgkmcnt(0)" ::: "memory"); __builtin_amdgcn_s_barrier(); asm volatile("" ::: "memory");
        for (int c = 0; c < NCH; ++c) {
            const char* B_ = lds + (c & 1) * BUFB;
            const float* Rl = (const float*)(B_ + O_R); const float* KDl = (const float*)(B_ + O_KD); const float* KKl = (const float*)(B_ + O_KK); const float* Wl = (const float*)(B_ + O_W); const float* KAl = (const float*)(B_ + O_KA);
            const float* Vl = (const float*)(B_ + O_V); float* Yl = (float*)(B_ + O_Y);
            f32x4 ck[2], cw[2], ca[2], cd[2], cr[2]; f32x2 cv;
#define LOADV(tl_) do { const int o8 = (tl_) * 64 + seg * 8; ck[0] = *(const f32x4*)(KKl + o8); ck[1] = *(const f32x4*)(KKl + o8 + 4); cw[0] = *(const f32x4*)(Wl + o8); cw[1] = *(const f32x4*)(Wl + o8 + 4); \
    ca[0] = *(const f32x4*)(KAl + o8); ca[1] = *(const f32x4*)(KAl + o8 + 4); cd[0] = *(const f32x4*)(KDl + o8); cd[1] = *(const f32x4*)(KDl + o8 + 4); cr[0] = *(const f32x4*)(Rl + o8); cr[1] = *(const f32x4*)(Rl + o8 + 4); \
    cv = *(const f32x2*)(Vl + (tl_) * 64 + row0); } while (0)
            LOADV(dir ? TC - 1 : 0);
#pragma unroll 2
            for (int st = 0; st < TC; ++st) {
                const int tl = dir ? TC - 1 - st : st;
                const f32x2 k0 = {ck[0][0], ck[0][1]}, k1 = {ck[0][2], ck[0][3]}, k2 = {ck[1][0], ck[1][1]}, k3 = {ck[1][2], ck[1][3]};
                const f32x2 w0 = {cw[0][0], cw[0][1]}, w1 = {cw[0][2], cw[0][3]}, w2 = {cw[1][0], cw[1][1]}, w3 = {cw[1][2], cw[1][3]};
                const f32x2 a0 = {ca[0][0], ca[0][1]}, a1 = {ca[0][2], ca[0][3]}, a2 = {ca[1][0], ca[1][1]}, a3 = {ca[1][2], ca[1][3]};
                const f32x2 d0 = {cd[0][0], cd[0][1]}, d1 = {cd[0][2], cd[0][3]}, d2 = {cd[1][0], cd[1][1]}, d3 = {cd[1][2], cd[1][3]};
                const f32x2 r0 = {cr[0][0], cr[0][1]}, r1 = {cr[0][2], cr[0][3]}, r2 = {cr[1][0], cr[1][1]}, r3 = {cr[1][2], cr[1][3]};
                const f32x2 cvv = cv;
                if (st + 1 < TC) LOADV(dir ? TC - 2 - st : st + 1);
                f32x2 yo;
#pragma unroll
                for (int h2 = 0; h2 < 2; ++h2) {
                    const f32x2 vv = {cvv[h2], cvv[h2]};
                    f32x2 t2 = S[h2][0] * k0 + S[h2][1] * k1; const f32x2 t3 = S[h2][2] * k2 + S[h2][3] * k3; t2 = t2 + t3;
                    const float d = dpp_red8(t2[0] + t2[1]);
                    const f32x2 p0 = S[h2][0] * w0 + vv * d0, p1 = S[h2][1] * w1 + vv * d1, p2 = S[h2][2] * w2 + vv * d2, p3 = S[h2][3] * w3 + vv * d3;
                    const f32x2 sa = {-d, -d};
                    S[h2][0] = p0 + sa * a0; S[h2][1] = p1 + sa * a1; S[h2][2] = p2 + sa * a2; S[h2][3] = p3 + sa * a3;
                    f32x2 y2 = S[h2][0] * r0 + S[h2][1] * r1; const f32x2 y3 = S[h2][2] * r2 + S[h2][3] * r3; y2 = y2 + y3;
                    yo[h2] = dpp_red8(y2[0] + y2[1]);
                }
                if (seg == 0) *(f32x2*)(Yl + tl * 64 + row0) = yo;
            }
#undef LOADV
            asm volatile("s_waitcnt lgkmcnt(0)" ::: "memory"); __builtin_amdgcn_s_barrier(); asm volatile("" ::: "memory");
        }
    }
    if (wid >= 4) {
        const int pt = tid - 256, c = NCH, cb_ = (c - 1) & 1, tf = dir ? T - TC * c : TC * (c - 1); const int tl = pt >> 3, c8 = (pt & 7) * 8;
        const float* yp = (const float*)(lds + cb_ * BUFB + O_Y) + tl * 64 + c8; const f32x4 y4 = *(const f32x4*)yp, y5 = *(const f32x4*)(yp + 4);
        u32x4 w; w.x = cvt_pk_bf16(y4[0], y4[1]); w.y = cvt_pk_bf16(y4[2], y4[3]); w.z = cvt_pk_bf16(y5[0], y5[1]); w.w = cvt_pk_bf16(y5[2], y5[3]);
        *(u32x4*)(yb + (size_t)(tok0 + tf + tl) * 1024 + head * 64 + c8) = w;
    }
    __syncthreads();
}
}

__device__ __forceinline__ void p4_post(const Args& a, char* lds, int vcu, int G) {
    const int tid = threadIdx.x, lane = tid & 63;
    unsigned char* ws = a.ws;
    const bf16_t* ZR = (const bf16_t*)a.out; bf16_t* QK = (bf16_t*)(ws + WS_QK);
    const bf16_t* Y0 = (const bf16_t*)(ws + WS_Y); const bf16_t* Y1 = Y0 + (size_t)NT * 1024;
    const float* BON = (const float*)(ws + WS_BON);
    const float* mup = a.in[13]; const float* mun = a.in[14]; const float* G2 = a.in[19]; const float* lnw = a.in[23]; const float* lnb = a.in[24]; const float* subg = a.in[12];
    float* SG = (float*)lds; float* BL = (float*)(lds + 20480);
    for (int tile = vcu; tile < NT / 32; tile += G) {
        const int tk0 = tile * 32;
        __syncthreads();
        for (int it = tid; it < 32 * 20; it += NTHR) {
            const int tl = it / 20, j0 = (it % 20) * 8, col = 3328 + j0, tok = tk0 + tl, t = tok_pos(tok), T = tok < TP ? TP : TS;
            const bf16_t* zp = ZR + (size_t)tok * ZRP + col; const u32x4 z = *(const u32x4*)zp; u32x4 zm = {0u, 0u, 0u, 0u}, zn = {0u, 0u, 0u, 0u};
            if (t > 0) zm = *(const u32x4*)(zp - ZRP);
            if (t < T - 1) zn = *(const u32x4*)(zp + ZRP);
            float v[8];
#define SH(i, zw, zmw, znw, lohi) { const float zz = lohi(zw), a_ = lohi(zmw), b_ = lohi(znw), mp_ = mup[col + i], mn_ = mun[col + i]; v[i] = sigmoidf_(zz + mp_ * (a_ - zz) + mn_ * (b_ - zz)); }
            SH(0, z.x, zm.x, zn.x, bflo) SH(1, z.x, zm.x, zn.x, bfhi) SH(2, z.y, zm.y, zn.y, bflo) SH(3, z.y, zm.y, zn.y, bfhi)
            SH(4, z.z, zm.z, zn.z, bflo) SH(5, z.z, zm.z, zn.z, bfhi) SH(6, z.w, zm.w, zn.w, bflo) SH(7, z.w, zm.w, zn.w, bfhi)
#undef SH
            *(f32x4*)(SG + tl * 160 + j0) = (f32x4){v[0], v[1], v[2], v[3]}; *(f32x4*)(SG + tl * 160 + j0 + 4) = (f32x4){v[4], v[5], v[6], v[7]};
        }
        { const int tl = tid >> 4, hd = tid & 15; BL[tid] = BON[(size_t)(tk0 + tl) * 16 + hd] + BON[(size_t)NT * 16 + (size_t)(tk0 + tl) * 16 + hd]; }
        { const int pr = tid >> 1, half = tid & 1, tl = pr >> 3, hd = pr & 7; bf16_t* op = QK + (size_t)(tk0 + tl) * 2048 + hd * 128 + half * 64;
          u32x4 w[8]; float ss = 0.f;
#pragma unroll
          for (int i = 0; i < 8; ++i) { w[i] = *(const u32x4*)(op + i * 8);
              ss += bflo(w[i].x) * bflo(w[i].x) + bfhi(w[i].x) * bfhi(w[i].x) + bflo(w[i].y) * bflo(w[i].y) + bfhi(w[i].y) * bfhi(w[i].y) + bflo(w[i].z) * bflo(w[i].z) + bfhi(w[i].z) * bfhi(w[i].z) + bflo(w[i].w) * bflo(w[i].w) + bfhi(w[i].w) * bfhi(w[i].w); }
          ss += __shfl_xor(ss, 1);
          const float rstd = rsqrtf(ss * (1.f / 128.f) + 1e-6f) * 0.8f; const float* sg = subg + half * 64;
#pragma unroll
          for (int i = 0; i < 8; ++i) { u32x4 o;
              o.x = cvt_pk_bf16(bflo(w[i].x) * rstd * sg[i * 8 + 0], bfhi(w[i].x) * rstd * sg[i * 8 + 1]); o.y = cvt_pk_bf16(bflo(w[i].y) * rstd * sg[i * 8 + 2], bfhi(w[i].y) * rstd * sg[i * 8 + 3]);
              o.z = cvt_pk_bf16(bflo(w[i].z) * rstd * sg[i * 8 + 4], bfhi(w[i].z) * rstd * sg[i * 8 + 5]); o.w = cvt_pk_bf16(bflo(w[i].w) * rstd * sg[i * 8 + 6], bfhi(w[i].w) * rstd * sg[i * 8 + 7]);
              *(u32x4*)(op + i * 8) = o; } }
        __syncthreads();
        const int c0 = tid * 2;
        float acc[32][2];
#pragma unroll
        for (int i = 0; i < 32; ++i) { acc[i][0] = 0.f; acc[i][1] = 0.f; }
#pragma unroll 1
        for (int k = 0; k < 160; k += 4) {
            const f32x2 g0 = *(const f32x2*)(G2 + (size_t)(k + 0) * 1024 + c0), g1 = *(const f32x2*)(G2 + (size_t)(k + 1) * 1024 + c0), g2 = *(const f32x2*)(G2 + (size_t)(k + 2) * 1024 + c0), g3 = *(const f32x2*)(G2 + (size_t)(k + 3) * 1024 + c0);
#pragma unroll
            for (int i = 0; i < 32; ++i) { const f32x4 s4 = *(const f32x4*)(SG + i * 160 + k);
                acc[i][0] += s4[0] * g0[0] + s4[1] * g1[0] + s4[2] * g2[0] + s4[3] * g3[0];
                acc[i][1] += s4[0] * g0[1] + s4[1] * g1[1] + s4[2] * g2[1] + s4[3] * g3[1]; }
        }
        const int hd = tid >> 5;
        const float lw0 = lnw[c0], lw1 = lnw[c0 + 1], lb0 = lnb[c0], lb1 = lnb[c0 + 1];
        const float mp0 = mup[2048 + c0], mp1 = mup[2048 + c0 + 1], mn0 = mun[2048 + c0], mn1 = mun[2048 + c0 + 1];
#pragma unroll
        for (int i = 0; i < 32; ++i) {
            const int tok = tk0 + i, t = tok_pos(tok), T = tok < TP ? TP : TS;
            const unsigned ya = *(const unsigned*)(Y0 + (size_t)tok * 1024 + c0), yb = *(const unsigned*)(Y1 + (size_t)tok * 1024 + c0);
            const float y0 = bflo(ya) + bflo(yb), y1 = bfhi(ya) + bfhi(yb);
            float s = y0 + y1, q = y0 * y0 + y1 * y1;
#pragma unroll
            for (int o = 1; o < 32; o <<= 1) { s += __shfl_xor(s, o); q += __shfl_xor(q, o); }
            const float mean = s * (1.f / 64.f), var = fmaxf(q * (1.f / 64.f) - mean * mean, 0.f), rstd = rsqrtf(var + 64e-5f);
            const bf16_t* zp = ZR + (size_t)tok * ZRP + 2048 + c0; const unsigned z = *(const unsigned*)zp;
            unsigned zm = 0u, zn = 0u;
            if (t > 0) zm = *(const unsigned*)(zp - ZRP);
            if (t < T - 1) zn = *(const unsigned*)(zp + ZRP);
            const float v0 = bflo(z) + mp0 * (bflo(zm) - bflo(z)) + mn0 * (bflo(zn) - bflo(z)), v1 = bfhi(z) + mp1 * (bfhi(zm) - bfhi(z)) + mn1 * (bfhi(zn) - bfhi(z));
            const float bo = BL[i * 16 + hd];
            const float o0 = ((y0 - mean) * rstd * lw0 + lb0 + bo * v0) * acc[i][0], o1 = ((y1 - mean) * rstd * lw1 + lb1 + bo * v1) * acc[i][1];
            *(unsigned*)(QK + (size_t)tok * 2048 + 1024 + c0) = cvt_pk_bf16(o0, o1);
        }
    }
    __syncthreads();
}

struct SchedMerge {
    int v, G; const char* H; const char* WG; const char* QK; const char* VM; const char* PAR; const char* PM2;
    __device__ __forceinline__ bool next(int i, Unit& u) const {
        const int ti = i / 6, kind = i - ti * 6; const long L = (long)ti * G + v; int pm, pn;
        if (!TileMap{192, 8}.get(L, pm, pn)) return false;
        u.pm = pm; u.pn = pn; u.kind = kind; u.t0 = 0; u.T = 0;
        const size_t bo = (size_t)pn * MiB;
        switch (kind) {
            case 0: u.A = H + (size_t)pm * MiB; u.B = WG + bo; u.nt = 32; break;
            case 1: u.A = QK + (size_t)pm * MiB; u.B = PAR + bo; u.nt = 16; break;
            case 2: u.A = H + (size_t)pm * MiB; u.B = WG + 8 * MiB + bo; u.nt = 32; break;
            case 3: u.A = QK + (size_t)pm * MiB + 2048; u.B = PAR + bo + 2048; u.nt = 16; break;
            case 4: u.A = H + (size_t)pm * MiB; u.B = WG + 16 * MiB + bo; u.nt = 32; break;
            default: u.A = VM + (size_t)pm * MiB + 2048; u.B = PM2 + bo; u.nt = 16; break;
        }
        return true;
    }
};
struct EpiMerge {
    u32x4* scrG; f32x4* scrP; bf16_t* MRG;
    __device__ __forceinline__ void operator()(const f32x4 (&acc)[2][2][4][2], const Unit& u, int wr, int wc, int fr, int fq) const {
        const int tid = threadIdx.x, kind = u.kind;
        u32x4* gp = scrG + tid; f32x4* pp = scrP + tid;
        if ((kind & 1) == 0) {
#pragma unroll
            for (int ai = 0; ai < 2; ++ai)
#pragma unroll
                for (int bj = 0; bj < 2; ++bj)
#pragma unroll
                    for (int m = 0; m < 4; ++m) { const f32x4 v0 = acc[ai][bj][m][0], v1 = acc[ai][bj][m][1]; u32x4 w;
                        w.x = cvt_pk_bf16(sigmoidf_(v0[0]), sigmoidf_(v0[1])); w.y = cvt_pk_bf16(sigmoidf_(v0[2]), sigmoidf_(v0[3]));
                        w.z = cvt_pk_bf16(sigmoidf_(v1[0]), sigmoidf_(v1[1])); w.w = cvt_pk_bf16(sigmoidf_(v1[2]), sigmoidf_(v1[3]));
                        *gp = w; gp += NTHR; asm volatile("" : "+v"(gp) :: "memory"); }
        } else {
            const int row0 = u.pm * 256 + wr * 64 + fr, col0 = u.pn * 256 + wc * 32 + 8 * fq;
#pragma unroll
            for (int ai = 0; ai < 2; ++ai)
#pragma unroll
                for (int bj = 0; bj < 2; ++bj) {
                    bf16_t* mp = MRG + (size_t)(row0 + ai * 128) * 2048 + col0 + bj * 128;
#pragma unroll
                    for (int m = 0; m < 4; ++m) { const u32x4 g = *gp;
                        f32x4 p0 = acc[ai][bj][m][0] * (f32x4){bflo(g.x), bfhi(g.x), bflo(g.y), bfhi(g.y)}, p1 = acc[ai][bj][m][1] * (f32x4){bflo(g.z), bfhi(g.z), bflo(g.w), bfhi(g.w)};
                        if (kind > 1) { p0 += pp[0]; p1 += pp[NTHR]; }
                        if (kind < 5) { pp[0] = p0; pp[NTHR] = p1; }
                        else { u32x4 w; w.x = cvt_pk_bf16(p0[0], p0[1]); w.y = cvt_pk_bf16(p0[2], p0[3]); w.z = cvt_pk_bf16(p1[0], p1[1]); w.w = cvt_pk_bf16(p1[2], p1[3]);
                            *(u32x4*)mp = w; }
                        gp += NTHR; pp += 2 * NTHR; mp += 16 * 2048; asm volatile("" : "+v"(gp), "+v"(pp), "+v"(mp) :: "memory"); } }
        }
    }
};

struct SchedSq {
    int v, G; const char* A; const char* B; size_t astep, bstep; int nt;
    __device__ __forceinline__ bool next(int i, Unit& u) const {
        const long L = (long)i * G + v; int pm, pn; if (!TileMap{192, 8}.get(L, pm, pn)) return false;
        u.A = A + (size_t)pm * astep; u.B = B + (size_t)pn * bstep; u.nt = nt; u.pm = pm; u.pn = pn; u.kind = 0; u.t0 = 0; u.T = 0; return true;
    }
};
struct EpiWo {
    const float* xp; const float* xs; float* out;
    __device__ __forceinline__ void operator()(const f32x4 (&acc)[2][2][4][2], const Unit& u, int wr, int wc, int fr, int fq) const {
        const int row0 = u.pm * 256 + wr * 64 + fr, col0 = u.pn * 256 + wc * 32 + 8 * fq;
#pragma unroll
        for (int ai = 0; ai < 2; ++ai)
#pragma unroll
            for (int m = 0; m < 4; ++m) { const int row = row0 + ai * 128 + m * 16;
                const float* xr = (row < TP ? xp + (size_t)row * DM : xs + (size_t)(row - TP) * DM) + col0; float* orow = out + (size_t)row * DM + col0;
#pragma unroll
                for (int bj = 0; bj < 2; ++bj) { const f32x4 x0 = *(const f32x4*)(xr + bj * 128), x1 = *(const f32x4*)(xr + bj * 128 + 4);
                    *(f32x4*)(orow + bj * 128) = x0 + acc[ai][bj][m][0]; *(f32x4*)(orow + bj * 128 + 4) = x1 + acc[ai][bj][m][1]; } }
    }
};
struct EpiDown {
    float* out;
    __device__ __forceinline__ void operator()(const f32x4 (&acc)[2][2][4][2], const Unit& u, int wr, int wc, int fr, int fq) const {
        const int row0 = u.pm * 256 + wr * 64 + fr, col0 = u.pn * 256 + wc * 32 + 8 * fq;
#pragma unroll
        for (int ai = 0; ai < 2; ++ai)
#pragma unroll
            for (int m = 0; m < 4; ++m) { float* orow = out + (size_t)(row0 + ai * 128 + m * 16) * DM + col0;
#pragma unroll
                for (int bj = 0; bj < 2; ++bj) { const f32x4 x0 = *(const f32x4*)(orow + bj * 128), x1 = *(const f32x4*)(orow + bj * 128 + 4);
                    *(f32x4*)(orow + bj * 128) = x0 + acc[ai][bj][m][0]; *(f32x4*)(orow + bj * 128 + 4) = x1 + acc[ai][bj][m][1]; } }
    }
};

struct SchedUp {
    int v, G; const char* HN; const char* WUP;
    __device__ __forceinline__ bool next(int i, Unit& u) const {
        const long L = (long)i * G + v; int pm, pn; if (!TileMap{197, 44}.get(L, pm, pn)) return false;
        int s, ti; if (pm < 65) { s = 0; ti = pm; } else { s = 1 + (pm - 65) / 33; ti = (pm - 65) % 33; }
        const int T = seq_len(s); int t0 = 254 * ti - 1; if (t0 > T - 255) t0 = T - 255;
        u.pm = seq_start(s); u.pn = pn; u.kind = 0; u.t0 = t0; u.T = T; u.nt = 32;
        u.A = HN + ((long)u.pm + t0) * 4096; u.B = WUP + (size_t)pn * MiB; return true;
    }
};
struct EpiUp {
    bf16_t* ACT; const float* cw; const float* cb; LAS float* xch;
    __device__ __forceinline__ void operator()(const f32x4 (&acc)[2][2][4][2], const Unit& u, int wr, int wc, int fr, int fq) const {
        const int lane = threadIdx.x & 63;
        const int cin = wc * 32 + 8 * fq;
#pragma unroll
        for (int ai = 0; ai < 2; ++ai) { const int rg = 2 * ai + wr;
#pragma unroll
            for (int bj = 0; bj < 2; ++bj)
#pragma unroll
                for (int n = 0; n < 2; ++n) {
                    if (fr == 0) *(LAS f32x4*)(xch + (rg * 2 + 0) * 256 + bj * 128 + cin + 4 * n) = acc[ai][bj][0][n];
                    if (fr == 15) *(LAS f32x4*)(xch + (rg * 2 + 1) * 256 + bj * 128 + cin + 4 * n) = acc[ai][bj][3][n]; } }
        asm volatile("s_waitcnt lgkmcnt(0)" ::: "memory"); __builtin_amdgcn_s_barrier(); asm volatile("" ::: "memory");
        const int srcR = (lane & 48) | ((lane - 1) & 15), srcL = (lane & 48) | ((lane + 1) & 15);
        const int gc = u.pn * 128 + cin;
#pragma unroll
        for (int n = 0; n < 2; ++n) {
            const int wcol = gc + 4 * n;
            const f32x4 g0 = *(const f32x4*)(cw + wcol), g1 = *(const f32x4*)(cw + 2 * DFF + wcol), g2 = *(const f32x4*)(cw + 4 * DFF + wcol), gb = *(const f32x4*)(cb + wcol);
            const f32x4 v0 = *(const f32x4*)(cw + DFF + wcol), v1 = *(const f32x4*)(cw + 3 * DFF + wcol), v2 = *(const f32x4*)(cw + 5 * DFF + wcol), vb = *(const f32x4*)(cb + DFF + wcol);
#pragma unroll
            for (int ai = 0; ai < 2; ++ai) { const int rg = 2 * ai + wr;
                bf16_t* ap = ACT + ((long)u.pm + u.t0 + 128 * ai + 64 * wr + fr) * DFF + gc + 4 * n;
#pragma unroll
                for (int m = 0; m < 4; ++m) {
                    const int j = 128 * ai + 64 * wr + 16 * m + fr, t = u.t0 + j;
                    f32x4 res;
#pragma unroll
                    for (int bj = 0; bj < 2; ++bj) {
                        const f32x4 cur = acc[ai][bj][m][n];
                        const f32x4 sp = (m > 0 && fr == 15) ? acc[ai][bj][m > 0 ? m - 1 : 0][n] : cur;
                        const f32x4 sn = (m < 3 && fr == 0) ? acc[ai][bj][m < 3 ? m + 1 : 3][n] : cur;
                        f32x4 pv, nv;
#pragma unroll
                        for (int i = 0; i < 4; ++i) { pv[i] = __shfl(sp[i], srcR); nv[i] = __shfl(sn[i], srcL); }
                        if (m == 0) { const f32x4 xprev = rg > 0 ? *(const LAS f32x4*)(xch + ((rg - 1) * 2 + 1) * 256 + bj * 128 + cin + 4 * n) : (f32x4){0.f, 0.f, 0.f, 0.f}; if (fr == 0) pv = xprev; }
                        if (m == 3) { const f32x4 xnext = rg < 3 ? *(const LAS f32x4*)(xch + ((rg + 1) * 2 + 0) * 256 + bj * 128 + cin + 4 * n) : (f32x4){0.f, 0.f, 0.f, 0.f}; if (fr == 15) nv = xnext; }
                        if (t < 1) pv = (f32x4){0.f, 0.f, 0.f, 0.f};
                        if (t >= u.T - 1) nv = (f32x4){0.f, 0.f, 0.f, 0.f};
                        if (bj == 0) { const f32x4 cv = g0 * pv + g1 * cur + g2 * nv + gb; res = (f32x4){cv[0] * sigmoidf_(cv[0]), cv[1] * sigmoidf_(cv[1]), cv[2] * sigmoidf_(cv[2]), cv[3] * sigmoidf_(cv[3])}; }
                        else { const f32x4 cv = v0 * pv + v1 * cur + v2 * nv + vb; res = res * cv; }
                    }
                    if (j >= 1 && j <= 254) { u32x2 w; w.x = cvt_pk_bf16(res[0], res[1]); w.y = cvt_pk_bf16(res[2], res[3]); *(u32x2*)ap = w; }
                    ap += 16 * DFF; asm volatile("" : "+v"(ap) :: "memory");
                }
            }
        }
    }
};

__global__ void __launch_bounds__(NTHR, 2) enc_fwd(Args args) {
    extern __shared__ __attribute__((aligned(16))) unsigned char lds_raw[];
    cg::grid_group grid = cg::this_grid();
    LAS unsigned char* lds = (LAS unsigned char*)lds_raw;
    const int tid = threadIdx.x;
    const int G = gridDim.x, bx = blockIdx.x, vcu = (G % 8 == 0) ? (bx % 8) * (G / 8) + bx / 8 : bx;
    unsigned char* ws = args.ws;
    const int lo = args.ph_lo, hi = args.ph_hi;
#ifndef P2M
#define P2M 7
#endif
#ifndef PH_MASK
#define PH_MASK 0x1ff
#endif
#define IN(k) (((PH_MASK >> (k)) & 1) && lo <= (k) && (k) < hi)
#define SEAM(k) do { if (IN(k) && IN((k) + 1)) grid.sync(); } while (0)
#ifndef PROBE
#define PROBE 0
#endif
    unsigned long long tp0 = 0, tp1 = 0;
#define TSTAMP(v) do { if (PROBE) { v = __builtin_amdgcn_s_memrealtime(); } } while (0)

    if (IN(0)) p0_prologue(args, lds, vcu, G);
    SEAM(0);
    if (IN(1)) {
        SchedIn S{vcu, G, (const char*)(ws + WS_H), (const char*)(ws + WS_WIN), (const char*)(ws + WS_MEMN), (const char*)(ws + WS_WKV)};
        EpiIn E{(bf16_t*)(ws + WS_QK), (bf16_t*)(ws + WS_VM), (bf16_t*)args.out, (bf16_t*)(ws + WS_KVM), args.in[6], args.in[7], (const float*)(ws + WS_ROPE), (const float*)(ws + WS_ROPE) + TP * 32};
        pg8::gemm_phase<EpiIn, SchedIn, true>(lds, 2048, S, E);
    }
    SEAM(1);
    if (PROBE == 1 || PROBE == 2) TSTAMP(tp0);
    if (IN(2)) {
        unsigned* ctl = (unsigned*)(ws + WS_CTL);
        volatile LAS unsigned* jobw = (volatile LAS unsigned*)(lds + LDS_MISC);
        const float lam = ((const float*)ctl)[CW_LAM];
        scan::P sp{(const bf16_t*)args.out, (bf16_t*)(ws + WS_Y), (float*)(ws + WS_BON), args.in[13], args.in[14], args.in[15], args.in[16], args.in[17], args.in[18], args.in[20], args.in[21], args.in[22]};
        for (;;) {
            __syncthreads();
            if (tid == 0) jobw[0] = atomicAdd(ctl + CW_QUEUE, 1u);
            __syncthreads();
            const int jb = (int)jobw[0];
            if (jb >= 160 + 1536 + 768) break;
            if (((P2M) & 1) && jb < 160) {
                int s, r; if (jb < 32) { s = 0; r = jb; } else { s = 1 + (jb - 32) / 32; r = (jb - 32) % 32; }
                scan::job(s, r & 1, r >> 1, sp, (char*)lds_raw);
                if (PROBE == 2 && tid == 0) atomicMax((unsigned long long*)(ctl + 256), (unsigned long long)__builtin_amdgcn_s_memrealtime());
            } else if (((P2M) & 2) && jb < 160 + 1536) {
                const int a = jb - 160; int s, h, qb;
                if (a < 512) { s = 0; h = a / 64; qb = a % 64; } else { const int b = a - 512; s = 1 + b / 256; h = (b % 256) / 32; qb = b % 32; }
                att::diff_unit(s, h, qb, (bf16_t*)(ws + WS_QK), (const bf16_t*)(ws + WS_VM), lam, (char*)lds_raw);
            } else if ((P2M) & 4) {
                const int a = jb - 160 - 1536; int s, mh, qb;
                if (a < 256) { s = 0; mh = a / 64; qb = a % 64; } else { const int b = a - 256; s = 1 + b / 128; mh = (b % 128) / 32; qb = b % 32; }
                att::mem_unit(s, mh, qb, (bf16_t*)(ws + WS_VM), (const bf16_t*)(ws + WS_KVM), args.in[27], args.in[28], (char*)lds_raw);
            }
        }
    }
    SEAM(2);
    if (PROBE == 1) TSTAMP(tp1);
    if (IN(3)) p4_post(args, (char*)lds_raw, vcu, G);
    SEAM(3);
    if (IN(4)) {
        SchedMerge S{vcu, G, (const char*)(ws + WS_H), (const char*)(ws + WS_WG), (const char*)(ws + WS_QK), (const char*)(ws + WS_VM), (const char*)(ws + WS_PAR), (const char*)(ws + WS_PM2)};
        unsigned char* scr = (unsigned char*)args.out + (size_t)bx * (384 * 1024);
        EpiMerge E{(u32x4*)scr, (f32x4*)(scr + 128 * 1024), (bf16_t*)(ws + WS_MRG)};
        pg8::gemm_phase<EpiMerge, SchedMerge, true>(lds, 2048, S, E);
    }
    SEAM(4);
    if (IN(5)) {
        SchedSq S{vcu, G, (const char*)(ws + WS_MRG), (const char*)(ws + WS_WO), MiB, MiB, 32};
        EpiWo E{args.in[0], args.in[1], args.out};
        pg8::gemm_phase<EpiWo, SchedSq, true>(lds, 2048, S, E);
    }
    SEAM(5);
    if (IN(6)) {
        const int lane = tid & 63, gw = vcu * 8 + (tid >> 6), NGW = G * 8;
        for (int m = gw; m < NT; m += NGW) rms_row(args.out + (size_t)m * DM, args.in[33], (bf16_t*)(ws + WS_H) + (size_t)m * DM, lane);
    }
    SEAM(6);
    if (IN(7)) {
        SchedUp S{vcu, G, (const char*)(ws + WS_H), (const char*)(ws + WS_WUP)};
        EpiUp E{(bf16_t*)(ws + WS_ACT), args.in[35], args.in[36], (LAS float*)(lds + LDS_XCH)};
        pg8::gemm_phase<EpiUp, SchedUp, true>(lds, 2048, S, E);
    }
    SEAM(7);
    if (IN(8)) {
        SchedSq S{vcu, G, (const char*)(ws + WS_ACT), (const char*)(ws + WS_WDN), (size_t)256 * DFF * 2, (size_t)256 * DFF * 2, 88};
        EpiDown E{args.out};
        pg8::gemm_phase<EpiDown, SchedSq, true>(lds, DFF, S, E);
    }
    if (PROBE && bx == 0 && tid == 0) {
        if (PROBE == 2) tp1 = __hip_atomic_load((unsigned long long*)(ws + WS_CTL) + 128, __ATOMIC_RELAXED, __HIP_MEMORY_SCOPE_AGENT);
        const unsigned long long target = __builtin_amdgcn_s_memrealtime() + (tp1 > tp0 ? tp1 - tp0 : 0);
        while (__builtin_amdgcn_s_memrealtime() < target) __builtin_amdgcn_s_sleep(16);
    }
#undef IN
#undef SEAM
}

#ifndef MK_SPLIT
#define MK_SPLIT 0
#endif
extern "C" void kernel_launch(void* const* d_in, const int* in_sizes, int n_in, void* d_out, int out_size, void* d_ws, size_t ws_size, hipStream_t stream) {
    static int grid = 0;
    if (grid == 0) {
        if (n_in != 38 || out_size != NT * DM || ws_size < WS_END) { fprintf(stderr, "kernel_launch: unexpected shapes n_in %d out %d ws %zu\n", n_in, out_size, ws_size); grid = -1; return; }
        int dev = 0, cus = 0, per_cu = 0;
        hipGetDevice(&dev); hipDeviceGetAttribute(&cus, hipDeviceAttributeMultiprocessorCount, dev);
        if (hipFuncSetAttribute((const void*)enc_fwd, hipFuncAttributeMaxDynamicSharedMemorySize, LDS_BYTES) != hipSuccess) { fprintf(stderr, "kernel_launch: hipFuncSetAttribute failed\n"); grid = -1; return; }
        if (hipOccupancyMaxActiveBlocksPerMultiprocessor(&per_cu, (const void*)enc_fwd, NTHR, LDS_BYTES) != hipSuccess || per_cu < 1) { fprintf(stderr, "kernel_launch: occupancy query failed (%d)\n", per_cu); per_cu = 1; }
        (void)hipGetLastError();
        grid = cus * 1;
    }
    if (grid < 0) return;
    Args a{};
    for (int i = 0; i < 38; ++i) a.in[i] = (const float*)d_in[i];
    a.out = (float*)d_out; a.ws = (unsigned char*)d_ws;
    for (int d = 0; d < 32; ++d) a.inv_rev[d] = pow(10000.0, -(double)d / 32.0) / 6.283185307179586476925286766559;
#if MK_SPLIT
    for (int ph = 0; ph < 9; ++ph) { a.ph_lo = ph; a.ph_hi = ph + 1; void* kargs[] = {&a};
        hipError_t e = hipLaunchCooperativeKernel((const void*)enc_fwd, dim3(grid), dim3(NTHR), kargs, LDS_BYTES, stream);
        if (e != hipSuccess) { fprintf(stderr, "launch %d failed: %s\n", ph, hipGetErrorString(e)); break; } }
#else
    a.ph_lo = 0; a.ph_hi = 9;
    void* kargs[] = {&a};
    hipError_t e = hipLaunchCooperativeKernel((const void*)enc_fwd, dim3(grid), dim3(NTHR), kargs, LDS_BYTES, stream);
    if (e != hipSuccess) fprintf(stderr, "cooperative launch failed: %s (grid %d)\n", hipGetErrorString(e), grid);
#endif
}
```

```cpp
#include <hip/hip_runtime.h>
#include <hip/hip_cooperative_groups.h>
#include <cstdio>
#include <cstdint>
#include <cmath>
namespace cg = cooperative_groups;

#define LAS __attribute__((address_space(3)))
typedef unsigned short bf16_t;
typedef short bf16x8 __attribute__((ext_vector_type(8)));
typedef short s16x4 __attribute__((ext_vector_type(4)));
typedef float f32x2 __attribute__((ext_vector_type(2)));
typedef float f32x4 __attribute__((ext_vector_type(4)));
typedef float f32x16 __attribute__((ext_vector_type(16)));
typedef unsigned u32x2 __attribute__((ext_vector_type(2)));
typedef unsigned u32x4 __attribute__((ext_vector_type(4)));

constexpr int NT = 49152, DM = 2048, TP = 16384, TS = 8192, NSEQ = 5;
constexpr int ZRP = 3584;
constexpr int DFF = 5632;
constexpr int NTHR = 512;
constexpr size_t MiB = 1u << 20;
constexpr size_t WS_CTL = 0, WS_WIN = 1 * MiB, WS_WG = 31 * MiB, WS_WKV = 55 * MiB, WS_PAR = 63 * MiB, WS_PM2 = 71 * MiB, WS_WO = 79 * MiB,
                 WS_WUP = 87 * MiB, WS_WDN = 131 * MiB, WS_ROPE = 153 * MiB, WS_MEMN = 157 * MiB, WS_KVM = 162 * MiB, WS_BON = 167 * MiB,
                 WS_H = 176 * MiB, WS_QK = 370 * MiB, WS_VM = 562 * MiB, WS_Y = 754 * MiB, WS_ACT = 370 * MiB, WS_MRG = 754 * MiB, WS_END = 946 * MiB;
constexpr int CW_QUEUE = 64, CW_LAM = 128;
constexpr int LDS_XCH = 131072, LDS_MISC = 131072 + 8192, LDS_BYTES = 131072 + 8192 + 256;

__device__ __forceinline__ int seq_start(int s) { return s == 0 ? 0 : TP + (s - 1) * TS; }
__device__ __forceinline__ int seq_len(int s) { return s == 0 ? TP : TS; }
__device__ __forceinline__ int tok_pos(int tok) { return tok < TP ? tok : ((tok - TP) & (TS - 1)); }

__device__ __forceinline__ unsigned cvt_pk_bf16(float lo, float hi) { unsigned r; asm volatile("v_cvt_pk_bf16_f32 %0, %1, %2" : "=v"(r) : "v"(lo), "v"(hi)); return r; }
__device__ __forceinline__ float bflo(unsigned w) { return __uint_as_float(w << 16); }
__device__ __forceinline__ float bfhi(unsigned w) { return __uint_as_float(w & 0xffff0000u); }
__device__ __forceinline__ float bf1(bf16_t b) { return __uint_as_float((unsigned)b << 16); }
__device__ __forceinline__ float sigmoidf_(float x) { return 1.f / (1.f + __expf(-x)); }
__device__ __forceinline__ float wave_sum(float v) {
#pragma unroll
    for (int o = 1; o < 64; o <<= 1) v += __shfl_xor(v, o);
    return v;
}

namespace pg8 {
constexpr int BM = 256, BK = 64, HALF = 128, HTB = HALF * BK * 2, STAGE_BYTES = 8 * HTB;
__host__ __device__ __forceinline__ int lds_byte(int r, int c) { const int st = (r >> 4) * 2 + (c >> 5), rr = r & 15, cc = c & 31, ob = rr * 64 + cc * 2; return st * 1024 + (ob ^ (((ob >> 9) & 1) << 5)); }
__host__ __device__ __forceinline__ void stage_rc(int b, int& R, int& C) { const int st = b / 1024, sb = b % 1024, swz = sb ^ (((sb >> 9) & 1) << 5); R = (st >> 1) * 16 + swz / 64; C = (st & 1) * 32 + (swz % 64) / 2; }
__host__ __device__ __forceinline__ int perm32(int rho) { const int n = rho >> 4, i = rho & 15; return 8 * (i >> 2) + 4 * n + (i & 3); }

struct Unit { const char* A; const char* B; int nt, pm, pn, kind, t0, T; };

template <class Epi, class Sched, bool ALIGN_EPI>
__device__ __forceinline__ void gemm_phase(LAS unsigned char* lds, const int ld, const Sched& S, const Epi& E) {
    const int tid = threadIdx.x, wid = __builtin_amdgcn_readfirstlane(tid >> 6), lane = tid & 63, wr = wid >> 2, wc = wid & 3, fr = lane & 15, fq = lane >> 4;
    unsigned voffA[2], voffB[2];
#pragma unroll
    for (int i = 0; i < 2; ++i) { int R, C; stage_rc(tid * 16 + i * 8192, R, C); const int Rb = (R & ~31) + perm32(R & 31);
        voffA[i] = (unsigned)(R * ld + C) * 2u; voffB[i] = (unsigned)(Rb * ld + C) * 2u; }
    const size_t kstep = (size_t)(BK * 2);
    const size_t hstep = (size_t)HALF * ld * 2;
    const unsigned ldsw = (unsigned)wid * 1024u;
    const int aoff = lds_byte(wr * 64 + fr, fq * 8), boff = lds_byte(wc * 32 + fr, fq * 8);
#define PG8_SA(b, h) (((b) * 2 + (h)) * HTB)
#define PG8_SB(b, h) ((4 + (b) * 2 + (h)) * HTB)
#define PG8_STAGE(bufoff, gbase, voff) do { _Pragma("unroll") for (int _i = 0; _i < 2; ++_i) \
        __builtin_amdgcn_global_load_lds((const unsigned*)((const char*)(gbase) + (voff)[_i]), (LAS unsigned*)(lds + (bufoff) + ldsw + _i * 8192), 16, 0, 0); } while (0)
#define PG8_LDA(dst, b, h) do { _Pragma("unroll") for (int m = 0; m < 4; ++m) _Pragma("unroll") for (int k = 0; k < 2; ++k) dst[m][k] = *(const LAS bf16x8*)(lds + PG8_SA(b, h) + aoff + m * 2048 + k * 1024); } while (0)
#define PG8_LDB(dst, b, h) do { _Pragma("unroll") for (int n = 0; n < 2; ++n) _Pragma("unroll") for (int k = 0; k < 2; ++k) dst[n][k] = *(const LAS bf16x8*)(lds + PG8_SB(b, h) + boff + n * 2048 + k * 1024); } while (0)
#define PG8_MMA(ai, bj, At, Bt) do { __builtin_amdgcn_s_setprio(1); _Pragma("unroll") for (int m = 0; m < 4; ++m) _Pragma("unroll") for (int n = 0; n < 2; ++n) _Pragma("unroll") for (int k = 0; k < 2; ++k) \
        acc[ai][bj][m][n] = __builtin_amdgcn_mfma_f32_16x16x32_bf16(Bt[n][k], At[m][k], acc[ai][bj][m][n], 0, 0, 0); __builtin_amdgcn_s_setprio(0); } while (0)
#define PG8_WAIT_V(n) asm volatile("s_waitcnt vmcnt(" #n ")" ::: "memory")
#define PG8_WAIT_L(n) asm volatile("s_waitcnt lgkmcnt(" #n ")" ::: "memory")
#define PG8_BAR __builtin_amdgcn_s_barrier()
#define PG8_SCHED __builtin_amdgcn_sched_barrier(0)
    Unit cur, nxt; int ui = 0;
    if (!S.next(0, cur)) return;
    f32x4 acc[2][2][4][2];
#pragma unroll
    for (int a = 0; a < 2; ++a)
#pragma unroll
        for (int b = 0; b < 2; ++b)
#pragma unroll
            for (int m = 0; m < 4; ++m)
#pragma unroll
                for (int n = 0; n < 2; ++n) acc[a][b][m][n] = (f32x4){0.f, 0.f, 0.f, 0.f};
    bf16x8 At[4][2], B0[2][2], B1[2][2];
    const char* cA = cur.A; const char* cB = cur.B;
    PG8_STAGE(PG8_SB(0, 0), cB, voffB); PG8_STAGE(PG8_SB(0, 1), cB + hstep, voffB); PG8_STAGE(PG8_SA(0, 0), cA, voffA); PG8_STAGE(PG8_SA(0, 1), cA + hstep, voffA);
    if (wr == 1) PG8_BAR;
    PG8_WAIT_V(2); PG8_BAR;
    PG8_STAGE(PG8_SB(1, 0), cB + kstep, voffB); PG8_STAGE(PG8_SA(1, 0), cA + kstep, voffA); PG8_STAGE(PG8_SB(1, 1), cB + hstep + kstep, voffB);
    PG8_WAIT_V(6); PG8_BAR;
    for (;;) {
        const bool has_next = S.next(ui + 1, nxt);
        const char* nA = has_next ? nxt.A : cA; const char* nB = has_next ? nxt.B : cB;
        const int nt = cur.nt;
        for (int t = 0; t < nt; t += 2) {
            const bool last = (t == nt - 2);
            const char* a1 = cA + (size_t)(t + 1) * kstep;
            const char* a2 = last ? nA : cA + (size_t)(t + 2) * kstep; const char* b2 = last ? nB : cB + (size_t)(t + 2) * kstep;
            const char* a3 = a2 + kstep; const char* b3 = b2 + kstep;
            PG8_LDB(B0, 0, 0); PG8_LDB(B1, 0, 1); PG8_SCHED; PG8_LDA(At, 0, 0); PG8_STAGE(PG8_SA(1, 1), a1 + hstep, voffA);
            PG8_WAIT_V(8); PG8_WAIT_L(0); PG8_BAR; PG8_MMA(0, 0, At, B0); PG8_MMA(0, 1, At, B1); PG8_BAR; PG8_SCHED;
            PG8_LDA(At, 0, 1); PG8_STAGE(PG8_SB(0, 0), b2, voffB); PG8_STAGE(PG8_SB(0, 1), b2 + hstep, voffB); PG8_STAGE(PG8_SA(0, 0), a2, voffA);
            PG8_WAIT_V(8); PG8_WAIT_L(0); PG8_BAR; PG8_MMA(1, 0, At, B0); PG8_MMA(1, 1, At, B1); PG8_BAR; PG8_SCHED;
            PG8_LDB(B0, 1, 0); PG8_LDB(B1, 1, 1); PG8_SCHED; PG8_LDA(At, 1, 0); PG8_STAGE(PG8_SA(0, 1), a2 + hstep, voffA);
            PG8_WAIT_V(8); PG8_WAIT_L(0); PG8_BAR; PG8_MMA(0, 0, At, B0); PG8_MMA(0, 1, At, B1); PG8_BAR; PG8_SCHED;
            PG8_LDA(At, 1, 1); PG8_STAGE(PG8_SB(1, 0), b3, voffB); PG8_STAGE(PG8_SB(1, 1), b3 + hstep, voffB); PG8_STAGE(PG8_SA(1, 0), a3, voffA);
            PG8_WAIT_V(8); PG8_WAIT_L(0); PG8_BAR; PG8_MMA(1, 0, At, B0); PG8_MMA(1, 1, At, B1); PG8_BAR; PG8_SCHED;
        }
        if constexpr (ALIGN_EPI) { if (wr == 0) PG8_BAR; }
        E(acc, cur, wr, wc, fr, fq);
        if (!has_next) break;
#pragma unroll
        for (int a = 0; a < 2; ++a)
#pragma unroll
            for (int b = 0; b < 2; ++b)
#pragma unroll
                for (int m = 0; m < 4; ++m)
#pragma unroll
                    for (int n = 0; n < 2; ++n) acc[a][b][m][n] = (f32x4){0.f, 0.f, 0.f, 0.f};
        cur = nxt; cA = nA; cB = nB; ++ui;
        if constexpr (ALIGN_EPI) { if (wr == 1) PG8_BAR; }
    }
    PG8_WAIT_V(0);
    if constexpr (!ALIGN_EPI) { if (wr == 0) PG8_BAR; }
    PG8_BAR;
#undef PG8_SA
#undef PG8_SB
#undef PG8_STAGE
#undef PG8_LDA
#undef PG8_LDB
#undef PG8_MMA
#undef PG8_WAIT_V
#undef PG8_WAIT_L
#undef PG8_BAR
#undef PG8_SCHED
}
}
using pg8::Unit;

struct TileMap {
    int nM, nN;
    __device__ __forceinline__ bool get(long L, int& pm, int& pn) const {
        if (L >= (long)nM * nN) return false;
        const int nig = 16 * nN, gid = (int)(L / nig), fm = gid * 16, gsz = (nM - fm) < 16 ? (nM - fm) : 16, r = (int)(L % nig);
        pm = fm + r % gsz; pn = r / gsz; return true;
    }
};

struct Args {
    const float* in[38];
    float* out; unsigned char* ws;
    double inv_rev[32];
    int ph_lo, ph_hi;
};

__device__ __forceinline__ void tr_item(const float* W, int N, int src_n0, bf16_t* WT, size_t ldw, int koff, int r0, int k0, LAS float* scr, int lane) {
    if (src_n0 >= 0) {
#pragma unroll 8
        for (int i = 0; i < 32; ++i) { const int kk = 2 * i + (lane >> 5); scr[kk * 33 + (lane & 31)] = W[(size_t)(k0 + kk) * N + src_n0 + (lane & 31)]; }
    } else {
#pragma unroll 8
        for (int i = 0; i < 32; ++i) { const int kk = 2 * i + (lane >> 5); scr[kk * 33 + (lane & 31)] = 0.f; }
    }
    asm volatile("s_waitcnt lgkmcnt(0)" ::: "memory");
    const int c = lane & 7;
#pragma unroll
    for (int j = 0; j < 4; ++j) { const int n = (lane >> 3) + 8 * j; const LAS float* s = scr + (8 * c) * 33 + n;
        u32x4 o; o.x = cvt_pk_bf16(s[0 * 33], s[1 * 33]); o.y = cvt_pk_bf16(s[2 * 33], s[3 * 33]); o.z = cvt_pk_bf16(s[4 * 33], s[5 * 33]); o.w = cvt_pk_bf16(s[6 * 33], s[7 * 33]);
        *(u32x4*)(WT + (size_t)(r0 + n) * ldw + koff + k0 + 8 * c) = o; }
    asm volatile("s_waitcnt lgkmcnt(0)" ::: "memory");
}
__device__ __forceinline__ void rms_row(const float* xrow, const float* g, bf16_t* orow, int lane) {
    f32x4 v[8]; float s = 0.f;
#pragma unroll
    for (int j = 0; j < 8; ++j) { v[j] = ((const f32x4*)xrow)[64 * j + lane]; s += (v[j].x * v[j].x + v[j].y * v[j].y) + (v[j].z * v[j].z + v[j].w * v[j].w); }
    const float rstd = rsqrtf(wave_sum(s) * (1.f / DM) + 1e-6f);
#pragma unroll
    for (int j = 0; j < 8; ++j) { const f32x4 gg = ((const f32x4*)g)[64 * j + lane];
        u32x2 w; w.x = cvt_pk_bf16(v[j].x * rstd * gg.x, v[j].y * rstd * gg.y); w.y = cvt_pk_bf16(v[j].z * rstd * gg.z, v[j].w * rstd * gg.w);
        ((u32x2*)orow)[64 * j + lane] = w; }
}

__device__ __forceinline__ void p0_prologue(const Args& a, LAS unsigned char* lds, int vcu, int G) {
    const int tid = threadIdx.x, lane = tid & 63, wave = tid >> 6;
    unsigned char* ws = a.ws;
    LAS float* scr = (LAS float*)(lds + wave * 16384);
    const int gw = vcu * 8 + wave, NGW = G * 8;
    constexpr int I0 = 32 * 240, I1 = 32 * 192, I2 = 32 * 64, I3 = 16 * 64, I6 = 32 * 64, I7 = 32 * 352, I8 = 88 * 64;
    constexpr int NITEMS = I0 + I1 + I2 + 3 * I3 + I6 + I7 + I8;
    for (int it = gw; it < NITEMS; it += NGW) {
        int r = it;
        if (r < I0) { const int kb = r / 240, nb = r % 240, r0 = nb * 32; int src;
            if (r0 < 2048) { const int tile = r0 >> 8, cp = r0 & 255, h = cp >> 7, g = (cp & 127) >> 5; src = tile * 256 + 64 * g + 32 * h; }
            else if (r0 < 6560) src = r0;
            else if (r0 < 6656) src = -1;
            else src = 6560 + (r0 - 6656);
            tr_item(a.in[5], 13728, src, (bf16_t*)(ws + WS_WIN), 2048, 0, r0, kb * 64, scr, lane); continue; } r -= I0;
        if (r < I1) { const int kb = r / 192, nb = r % 192; tr_item(a.in[5], 13728, 7584 + nb * 32, (bf16_t*)(ws + WS_WG), 2048, 0, nb * 32, kb * 64, scr, lane); continue; } r -= I1;
        if (r < I2) { const int kb = r / 64, nb = r % 64; tr_item(a.in[26], 2048, nb * 32, (bf16_t*)(ws + WS_WKV), 2048, 0, nb * 32, kb * 64, scr, lane); continue; } r -= I2;
        if (r < I3) { const int kb = r / 64, nb = r % 64; tr_item(a.in[29], 2048, nb * 32, (bf16_t*)(ws + WS_PAR), 2048, 0, nb * 32, kb * 64, scr, lane); continue; } r -= I3;
        if (r < I3) { const int kb = r / 64, nb = r % 64; tr_item(a.in[30], 2048, nb * 32, (bf16_t*)(ws + WS_PAR), 2048, 1024, nb * 32, kb * 64, scr, lane); continue; } r -= I3;
        if (r < I3) { const int kb = r / 64, nb = r % 64; tr_item(a.in[31], 2048, nb * 32, (bf16_t*)(ws + WS_PM2), 2048, 0, nb * 32, kb * 64, scr, lane); continue; } r -= I3;
        if (r < I6) { const int kb = r / 64, nb = r % 64; tr_item(a.in[32], 2048, nb * 32, (bf16_t*)(ws + WS_WO), 2048, 0, nb * 32, kb * 64, scr, lane); continue; } r -= I6;
        if (r < I7) { const int kb = r / 352, nb = r % 352, r0 = nb * 32, tile = r0 >> 8, bj = (r0 & 255) >> 7, j = r0 & 127;
            tr_item(a.in[34], 2 * DFF, bj * DFF + 128 * tile + j, (bf16_t*)(ws + WS_WUP), 2048, 0, r0, kb * 64, scr, lane); continue; } r -= I7;
        { const int kb = r / 64, nb = r % 64; tr_item(a.in[37], 2048, nb * 32, (bf16_t*)(ws + WS_WDN), DFF, 0, nb * 32, kb * 64, scr, lane); }
    }
    for (int m = gw; m < NT + 1280; m += NGW) {
        if (m < NT) { const float* xr = m < TP ? a.in[0] + (size_t)m * DM : a.in[1] + (size_t)(m - TP) * DM; rms_row(xr, a.in[4], (bf16_t*)(ws + WS_H) + (size_t)m * DM, lane); }
        else { const int j = m - NT; const float* xr = j < 256 ? a.in[2] + (size_t)j * DM : a.in[3] + (size_t)(j - 256) * DM; rms_row(xr, a.in[25], (bf16_t*)(ws + WS_MEMN) + (size_t)j * DM, lane); }
    }
    { float* rc = (float*)(ws + WS_ROPE); float* rs = rc + TP * 32;
      for (int e = (vcu * NTHR + tid); e < TP * 32; e += G * NTHR) { const int t = e >> 5, d = e & 31; double rev = (double)t * a.inv_rev[d]; rev -= rint(rev); const float rf = (float)rev;
          rc[e] = __builtin_amdgcn_cosf(rf); rs[e] = __builtin_amdgcn_sinf(rf); } }
    if (blockIdx.x == 0) {
        unsigned* ctl = (unsigned*)(ws + WS_CTL);
        if (tid < 64) {
            if (tid == 0) { ctl[CW_QUEUE] = 0u; ctl[256] = 0u; ctl[257] = 0u; }
            const float s1 = wave_sum(a.in[8][tid] * a.in[9][tid]), s2 = wave_sum(a.in[10][tid] * a.in[11][tid]);
            if (tid == 0) ((float*)ctl)[CW_LAM] = __expf(s1) - __expf(s2) + 0.2f;
        }
    }
}

struct SchedIn {
    int v, G; const char* H; const char* WIN; const char* MEMN; const char* WKV;
    __device__ __forceinline__ bool next(int i, Unit& u) const {
        long L = (long)i * G + v; int pm, pn;
        if (L < 5760) { TileMap{192, 30}.get(L, pm, pn); u.A = H + (size_t)pm * MiB; u.B = WIN + (size_t)pn * MiB; u.nt = 32; u.pm = pm; u.pn = pn; u.kind = 0; u.t0 = 0; u.T = 0; return true; }
        L -= 5760; if (L < 40) { pm = (int)(L % 5); pn = (int)(L / 5); u.A = MEMN + (size_t)pm * MiB; u.B = WKV + (size_t)pn * MiB; u.nt = 32; u.pm = pm; u.pn = pn; u.kind = 1; u.t0 = 0; u.T = 0; return true; }
        return false;
    }
};
struct EpiIn {
    bf16_t* QK; bf16_t* VM; bf16_t* ZR; bf16_t* KVM; const float* qn; const float* kn; const float* rc; const float* rs;
    __device__ __forceinline__ void plain(const f32x4 (&acc)[2][2][4][2], bf16_t* base, size_t ldc, int row0, int col0) const {
#pragma unroll
        for (int ai = 0; ai < 2; ++ai)
#pragma unroll
            for (int m = 0; m < 4; ++m) { bf16_t* rowp = base + (size_t)(row0 + ai * 128 + m * 16) * ldc + col0;
#pragma unroll
                for (int bj = 0; bj < 2; ++bj) { const f32x4 v0 = acc[ai][bj][m][0], v1 = acc[ai][bj][m][1];
                    u32x4 w; w.x = cvt_pk_bf16(v0[0], v0[1]); w.y = cvt_pk_bf16(v0[2], v0[3]); w.z = cvt_pk_bf16(v1[0], v1[1]); w.w = cvt_pk_bf16(v1[2], v1[3]);
                    *(u32x4*)(rowp + bj * 128) = w; } }
    }
    __device__ __forceinline__ void operator()(const f32x4 (&acc)[2][2][4][2], const Unit& u, int wr, int wc, int fr, int fq) const {
        const int row0 = u.pm * 256 + wr * 64 + fr, cin = wc * 32 + 8 * fq;
        if (u.kind == 1) { plain(acc, KVM, 2048, row0, u.pn * 256 + cin); return; }
        const int pn = u.pn;
        if (pn < 8) {
            const bool isq = pn < 4; const float* nw = isq ? qn : kn;
            const int Gq = (pn & 3) * 4 + wc, d0 = 8 * fq;
            const float qs = isq ? 0.125f * 1.4426950408889634f : 1.f;
            const f32x4 w1a = *(const f32x4*)(nw + d0), w1b = *(const f32x4*)(nw + d0 + 4), w2a = *(const f32x4*)(nw + 32 + d0), w2b = *(const f32x4*)(nw + 36 + d0);
            bf16_t* dst = QK + (isq ? 0 : 1024) + Gq * 64 + d0;
#pragma unroll
            for (int ai = 0; ai < 2; ++ai)
#pragma unroll
                for (int m = 0; m < 4; ++m) {
                    const int row = row0 + ai * 128 + m * 16, t = tok_pos(row);
                    const f32x4 xa = acc[ai][0][m][0], xb = acc[ai][0][m][1], ya = acc[ai][1][m][0], yb = acc[ai][1][m][1];
                    float ss = (xa[0] * xa[0] + xa[1] * xa[1]) + (xa[2] * xa[2] + xa[3] * xa[3]) + (xb[0] * xb[0] + xb[1] * xb[1]) + (xb[2] * xb[2] + xb[3] * xb[3])
                             + (ya[0] * ya[0] + ya[1] * ya[1]) + (ya[2] * ya[2] + ya[3] * ya[3]) + (yb[0] * yb[0] + yb[1] * yb[1]) + (yb[2] * yb[2] + yb[3] * yb[3]);
                    ss += __shfl_xor(ss, 16); ss += __shfl_xor(ss, 32);
                    const float rstd = rsqrtf(ss * (1.f / 64.f) + 1e-6f);
                    const f32x4 ca = *(const f32x4*)(rc + t * 32 + d0), cb = *(const f32x4*)(rc + t * 32 + d0 + 4), sa = *(const f32x4*)(rs + t * 32 + d0), sb = *(const f32x4*)(rs + t * 32 + d0 + 4);
                    const f32x4 x1a = xa * rstd * w1a, x1b = xb * rstd * w1b, x2a = ya * rstd * w2a, x2b = yb * rstd * w2b;
                    const f32x4 o1a = (x1a * ca - x2a * sa) * qs, o1b = (x1b * cb - x2b * sb) * qs, o2a = (x2a * ca + x1a * sa) * qs, o2b = (x2b * cb + x1b * sb) * qs;
                    u32x4 w; w.x = cvt_pk_bf16(o1a[0], o1a[1]); w.y = cvt_pk_bf16(o1a[2], o1a[3]); w.z = cvt_pk_bf16(o1b[0], o1b[1]); w.w = cvt_pk_bf16(o1b[2], o1b[3]);
                    *(u32x4*)(dst + (size_t)row * 2048) = w;
                    w.x = cvt_pk_bf16(o2a[0], o2a[1]); w.y = cvt_pk_bf16(o2a[2], o2a[3]); w.z = cvt_pk_bf16(o2b[0], o2b[1]); w.w = cvt_pk_bf16(o2b[2], o2b[3]);
                    *(u32x4*)(dst + (size_t)row * 2048 + 32) = w;
                }
        } else if (pn < 12) plain(acc, VM, 2048, row0, (pn - 8) * 256 + cin);
        else if (pn < 26) plain(acc, ZR, ZRP, row0, (pn - 12) * 256 + cin);
        else plain(acc, VM, 2048, row0, 1024 + (pn - 26) * 256 + cin);
    }
};

namespace att {
constexpr int SHM_V = 16384, SHM_K = 8192;
constexpr int OFF_V = 0, OFF_K = 32768, OFF_WS = 49152, OFF_STASH = 51200;
#define KSWZ64(row, colB) ((row) * 128 + ((colB) ^ (((row) & 7) << 4)))
#define SBAR() __builtin_amdgcn_sched_barrier(0)
__device__ __forceinline__ int crow(int r, int hi) { return (r & 3) + 8 * (r >> 2) + 4 * hi; }
constexpr float THRL = 8.f;
__device__ __forceinline__ void partialSM(f32x16& p0, f32x16& p1, float& m_reg, float& alpha) {
    float pmax = fmaxf(fmaxf(p0[0], p0[1]), p0[2]);
#pragma unroll
    for (int r = 3; r < 15; r += 2) pmax = fmaxf(fmaxf(pmax, p0[r]), p0[r + 1]);
    pmax = fmaxf(fmaxf(pmax, p0[15]), p1[0]);
#pragma unroll
    for (int r = 1; r < 15; r += 2) pmax = fmaxf(fmaxf(pmax, p1[r]), p1[r + 1]);
    pmax = fmaxf(pmax, p1[15]);
    { auto rr = __builtin_amdgcn_permlane32_swap(__float_as_uint(pmax), __float_as_uint(pmax), false, false);
      pmax = fmaxf(__uint_as_float(rr[0]), __uint_as_float(rr[1])); }
    if (__builtin_expect(__all(pmax <= THRL), 1)) { alpha = 1.f; }
    else { const float dl = fmaxf(pmax, 0.f); alpha = __builtin_amdgcn_exp2f(-dl); m_reg += dl;
#pragma unroll
        for (int r = 0; r < 16; ++r) { p0[r] -= dl; p1[r] -= dl; } }
#pragma unroll
    for (int r = 0; r < 16; ++r) p0[r] = __builtin_amdgcn_exp2f(p0[r]);
}
__device__ __forceinline__ void finishSM(f32x16& p0, f32x16& p1, float alpha, float& l_reg, bf16x8& pa0, bf16x8& pa1, bf16x8& pa2, bf16x8& pa3) {
#pragma unroll
    for (int r = 0; r < 16; ++r) p1[r] = __builtin_amdgcn_exp2f(p1[r]);
    f32x2 s2 = (f32x2){p0[0], p0[1]} + (f32x2){p1[0], p1[1]};
#pragma unroll
    for (int r = 2; r < 16; r += 2) { s2 = s2 + (f32x2){p0[r], p0[r + 1]}; s2 = s2 + (f32x2){p1[r], p1[r + 1]}; }
    float ps = s2[0] + s2[1];
    { auto rr = __builtin_amdgcn_permlane32_swap(__float_as_uint(ps), __float_as_uint(ps), false, false);
      ps = __uint_as_float(rr[0]) + __uint_as_float(rr[1]); }
    l_reg = l_reg * alpha + ps;
#define PK4(P, BASE, OUT) do { unsigned a0 = cvt_pk_bf16(P[BASE + 0], P[BASE + 1]), a1 = cvt_pk_bf16(P[BASE + 2], P[BASE + 3]);   \
    unsigned b0 = cvt_pk_bf16(P[BASE + 4], P[BASE + 5]), b1 = cvt_pk_bf16(P[BASE + 6], P[BASE + 7]);                              \
    auto r0 = __builtin_amdgcn_permlane32_swap(a0, b0, false, false); auto r1 = __builtin_amdgcn_permlane32_swap(a1, b1, false, false); \
    u32x4 w = {r0[0], r1[0], r0[1], r1[1]}; OUT = *reinterpret_cast<bf16x8*>(&w); } while (0)
    PK4(p0, 0, pa0); PK4(p0, 8, pa1); PK4(p1, 0, pa2); PK4(p1, 8, pa3);
#undef PK4
}
__device__ __forceinline__ void qkt64(f32x16& p0, f32x16& p1, const char* Ks, const bf16x8* qr, int r32, int hi) {
#pragma unroll
    for (int d0 = 0; d0 < 4; ++d0) { const int cb = (d0 * 16 + hi * 8) * 2;
        const bf16x8 b0 = *reinterpret_cast<const bf16x8*>(Ks + KSWZ64(r32, cb));
        const bf16x8 b1 = *reinterpret_cast<const bf16x8*>(Ks + KSWZ64(32 + r32, cb));
        p0 = __builtin_amdgcn_mfma_f32_32x32x16_bf16(b0, qr[d0], p0, 0, 0, 0);
        p1 = __builtin_amdgcn_mfma_f32_32x32x16_bf16(b1, qr[d0], p1, 0, 0, 0); }
}
__device__ __forceinline__ int v_st(int k, int c) { const int kk = (k & ~0xC) | ((k & 4) << 1) | ((k & 8) >> 1); return ((kk >> 3) * 4 + (c >> 5)) * 512 + ((kk & 7) * 32 + (c & 31)) * 2; }
__device__ __forceinline__ int v_rd_base(int lane) { return ((lane & 3) << 3) | (((lane >> 2) & 3) << 6) | (((lane >> 4) & 1) << 5) | (((lane >> 5) & 1) << 8); }
constexpr int v_rd_off(int d0, int ks, int half) { return d0 * 512 + ks * 4096 + half * 2048; }
template <int OFF> __device__ __forceinline__ s16x4 tr_read(int vb) {
    s16x4 r; asm volatile("ds_read_b64_tr_b16 %0, %1 offset:%2" : "=&v"(r) : "v"(vb), "i"(OFF) : "memory"); return r;
}
template <int D0> __device__ __forceinline__ void pv_one(f32x16& od, int vb, bf16x8 pa0, bf16x8 pa1, bf16x8 pa2, bf16x8 pa3) {
    const s16x4 l0 = tr_read<v_rd_off(D0, 0, 0)>(vb), h0 = tr_read<v_rd_off(D0, 0, 1)>(vb), l1 = tr_read<v_rd_off(D0, 1, 0)>(vb), h1 = tr_read<v_rd_off(D0, 1, 1)>(vb);
    const s16x4 l2 = tr_read<v_rd_off(D0, 2, 0)>(vb), h2 = tr_read<v_rd_off(D0, 2, 1)>(vb), l3 = tr_read<v_rd_off(D0, 3, 0)>(vb), h3 = tr_read<v_rd_off(D0, 3, 1)>(vb);
    asm volatile("s_waitcnt lgkmcnt(0)" ::: "memory"); SBAR();
#define PK(L, H) (bf16x8){L[0], L[1], L[2], L[3], H[0], H[1], H[2], H[3]}
    od = __builtin_amdgcn_mfma_f32_32x32x16_bf16(pa0, PK(l0, h0), od, 0, 0, 0);
    od = __builtin_amdgcn_mfma_f32_32x32x16_bf16(pa1, PK(l1, h1), od, 0, 0, 0);
    od = __builtin_amdgcn_mfma_f32_32x32x16_bf16(pa2, PK(l2, h2), od, 0, 0, 0);
    od = __builtin_amdgcn_mfma_f32_32x32x16_bf16(pa3, PK(l3, h3), od, 0, 0, 0);
#undef PK
}
__device__ __forceinline__ void pv_d0(f32x16* o, int vb, bf16x8 pa0, bf16x8 pa1, bf16x8 pa2, bf16x8 pa3) {
    pv_one<0>(o[0], vb, pa0, pa1, pa2, pa3); pv_one<1>(o[1], vb, pa0, pa1, pa2, pa3); pv_one<2>(o[2], vb, pa0, pa1, pa2, pa3); pv_one<3>(o[3], vb, pa0, pa1, pa2, pa3);
}

__device__ __forceinline__ void stash_store(const unsigned* stash, bf16_t* Ow, int ldo, int lane) {
#pragma unroll
    for (int i = 0; i < 8; ++i) { const int q = i * 64 + lane, rl = q >> 4, c8 = (q & 15) * 8, hh = (rl >> 2) & 1, r = (rl & 3) + 4 * (rl >> 3), d0 = c8 >> 5, cc = c8 & 31;
        const unsigned* sp = stash + (d0 * 8 + (r >> 1)) * 64 + hh * 32 + cc; const u32x4 a = *(const u32x4*)sp, b = *(const u32x4*)(sp + 4);
        u32x4 w;
        if (r & 1) { w.x = (a.x >> 16) | (a.y & 0xffff0000u); w.y = (a.z >> 16) | (a.w & 0xffff0000u); w.z = (b.x >> 16) | (b.y & 0xffff0000u); w.w = (b.z >> 16) | (b.w & 0xffff0000u); }
        else { w.x = (a.x & 0xffffu) | (a.y << 16); w.y = (a.z & 0xffffu) | (a.w << 16); w.z = (b.x & 0xffffu) | (b.y << 16); w.w = (b.z & 0xffffu) | (b.w << 16); }
        *(u32x4*)(Ow + (size_t)rl * ldo + c8) = w; }
}

__device__ __forceinline__ void diff_unit(int s, int h, int qb, bf16_t* QK, const bf16_t* VM, float lam, char* lds) {
    constexpr int LDK = 2048;
    int tid = threadIdx.x; asm volatile("" : "+v"(tid));
    const int wid = __builtin_amdgcn_readfirstlane(tid >> 6), lane = tid & 63, r32 = lane & 31, hi = lane >> 5;
    const int tok0 = seq_start(s), T = seq_len(s), NTL = T / 64;
    char* V_lds = lds + OFF_V; char* K_lds = lds + OFF_K;
    float* wsf = (float*)(lds + OFF_WS) + wid * 64; float* li_l = wsf; float* al_l = wsf + 32;
    unsigned* stash = (unsigned*)(lds + OFF_STASH) + wid * 2048;
    const int sr = tid >> 4, sc = (tid & 15) * 8, vst0 = v_st(sr, sc), vst1 = v_st(32 + sr, sc);
    const int kr = tid >> 3, kc = (tid & 7) * 8, kst = KSWZ64(kr, kc * 2);
    const int vb0 = (int)(uintptr_t)V_lds + v_rd_base(lane);
    const bf16_t* Vh = VM + (size_t)tok0 * LDK + h * 128;
    const size_t qrow = (size_t)(tok0 + qb * 256 + wid * 32);
#pragma unroll 1
    for (int c = 0; c < 2; ++c) {
        const bf16_t* Kh = QK + (size_t)tok0 * LDK + 1024 + h * 128 + c * 64;
        const bf16_t* Qw = QK + (qrow + r32) * LDK + h * 128 + c * 64 + hi * 8;
        bf16x8 qr[4];
#pragma unroll
        for (int d0 = 0; d0 < 4; ++d0) qr[d0] = *reinterpret_cast<const bf16x8*>(Qw + d0 * 16);
        float m_reg = 0.f, l_reg = 0; f32x16 o[4] = {};
        struct { bf16x8 vs0, vs1, ks0; } sr_[2];
#define NEGM(P) do { const float nm_ = -m_reg; _Pragma("unroll") for (int r_ = 0; r_ < 16; ++r_) P[r_] = nm_; } while (0)
#define SLOAD(i, k0) do { sr_[i].vs0 = *reinterpret_cast<const bf16x8*>(&Vh[(size_t)((k0) + sr) * LDK + sc]); sr_[i].vs1 = *reinterpret_cast<const bf16x8*>(&Vh[(size_t)((k0) + 32 + sr) * LDK + sc]); \
    sr_[i].ks0 = *reinterpret_cast<const bf16x8*>(&Kh[(size_t)((k0) + kr) * LDK + kc]); } while (0)
#define SWRITE(b, i) do { *(bf16x8*)(V_lds + (b) * SHM_V + vst0) = sr_[i].vs0; *(bf16x8*)(V_lds + (b) * SHM_V + vst1) = sr_[i].vs1; *(bf16x8*)(K_lds + (b) * SHM_K + kst) = sr_[i].ks0; } while (0)
#define SWAIT() asm volatile("s_waitcnt vmcnt(3)" ::: "memory")
#define RESC(a) do { if (__any((a) < 1.f)) { if (hi == 0) al_l[r32] = (a); asm volatile("s_waitcnt lgkmcnt(0)" ::: "memory"); \
    _Pragma("unroll") for (int d = 0; d < 4; ++d) _Pragma("unroll") for (int r = 0; r < 16; ++r) o[d][r] *= al_l[crow(r, hi)]; } } while (0)
        f32x16 pA0, pA1, pB0, pB1; float alA, alB; bf16x8 pa0, pa1, pa2, pa3;
        SLOAD(0, 0); asm volatile("s_waitcnt vmcnt(0)" ::: "memory"); SWRITE(0, 0); __syncthreads();
        NEGM(pA0); NEGM(pA1); qkt64(pA0, pA1, K_lds, qr, r32, hi); partialSM(pA0, pA1, m_reg, alA);
        SLOAD(1, 64); if (2 < NTL) SLOAD(0, 128);
        SWAIT(); SWRITE(1, 1); __syncthreads();
        for (int j = 1; j + 1 < NTL; j += 2) {
            SBAR(); NEGM(pB0); NEGM(pB1); qkt64(pB0, pB1, K_lds + SHM_K, qr, r32, hi);
            finishSM(pA0, pA1, alA, l_reg, pa0, pa1, pa2, pa3); SBAR();
            SLOAD(1, (j + 2) * 64); SBAR();
            pv_d0(o, vb0, pa0, pa1, pa2, pa3); partialSM(pB0, pB1, m_reg, alB);
            __syncthreads(); SWAIT(); SWRITE(0, 0);
            RESC(alB); __syncthreads();
            SBAR(); NEGM(pA0); NEGM(pA1); qkt64(pA0, pA1, K_lds, qr, r32, hi);
            finishSM(pB0, pB1, alB, l_reg, pa0, pa1, pa2, pa3); SBAR();
            if (j + 3 < NTL) SLOAD(0, (j + 3) * 64); SBAR();
            pv_d0(o, vb0 + SHM_V, pa0, pa1, pa2, pa3); partialSM(pA0, pA1, m_reg, alA);
            __syncthreads(); SWAIT(); SWRITE(1, 1);
            RESC(alA); __syncthreads();
        }
        SBAR(); NEGM(pB0); NEGM(pB1); qkt64(pB0, pB1, K_lds + SHM_K, qr, r32, hi);
        finishSM(pA0, pA1, alA, l_reg, pa0, pa1, pa2, pa3); SBAR();
        pv_d0(o, vb0, pa0, pa1, pa2, pa3); partialSM(pB0, pB1, m_reg, alB);
        __syncthreads(); RESC(alB);
        finishSM(pB0, pB1, alB, l_reg, pa0, pa1, pa2, pa3); SBAR();
        pv_d0(o, vb0 + SHM_V, pa0, pa1, pa2, pa3);
#undef SLOAD
#undef SWRITE
#undef SWAIT
#undef RESC
#undef NEGM
        if (hi == 0) li_l[r32] = l_reg; asm volatile("s_waitcnt lgkmcnt(0)" ::: "memory");
        float rli[16];
#pragma unroll
        for (int r = 0; r < 16; ++r) rli[r] = __builtin_amdgcn_rcpf(li_l[crow(r, hi)]);
        { const float coef = c == 0 ? 1.f : -lam;
#pragma unroll
          for (int d0 = 0; d0 < 4; ++d0)
#pragma unroll
              for (int r = 0; r < 16; r += 2) { const int idx = (d0 * 8 + (r >> 1)) * 64 + lane; const unsigned w = c == 0 ? 0u : stash[idx];
                  stash[idx] = cvt_pk_bf16(bflo(w) + coef * o[d0][r] * rli[r], bfhi(w) + coef * o[d0][r + 1] * rli[r + 1]); } }
        __syncthreads();
    }
    stash_store(stash, QK + qrow * LDK + h * 128, LDK, lane);
    __syncthreads();
}

constexpr int MOFF_V = 0, MOFF_K = 32768, MOFF_WS = 65536, MOFF_RK = 67584, MOFF_G = 68608, MOFF_STASH = 69632;
__device__ __forceinline__ void mem_unit(int s, int mh, int qb, bf16_t* VM, const bf16_t* KVM, const float* mqn, const float* mkn, char* lds) {
    int tid = threadIdx.x; asm volatile("" : "+v"(tid));
    const int wid = __builtin_amdgcn_readfirstlane(tid >> 6), lane = tid & 63, r32 = lane & 31, hi = lane >> 5;
    const int tok0 = seq_start(s);
    char* V_lds = lds + MOFF_V; char* K_lds = lds + MOFF_K;
    float* wsf = (float*)(lds + MOFF_WS) + wid * 64; float* li_l = wsf; float* al_l = wsf + 32;
    float* rk_l = (float*)(lds + MOFF_RK); float* g_l = (float*)(lds + MOFF_G);
    const bf16_t* Kh = KVM + (size_t)(s * 256) * 2048 + mh * 256;
    const bf16_t* Vh = KVM + (size_t)(s * 256) * 2048 + 1024 + mh * 256;
    if (tid < 256) g_l[tid] = mqn[tid] * mkn[tid];
    {
        const bf16_t* kp = Kh + (size_t)(wid * 32 + r32) * 2048 + hi * 128; float ss = 0.f;
#pragma unroll
        for (int i = 0; i < 16; ++i) { const u32x4 w = *(const u32x4*)(kp + i * 8);
            ss += bflo(w.x) * bflo(w.x) + bfhi(w.x) * bfhi(w.x) + bflo(w.y) * bflo(w.y) + bfhi(w.y) * bfhi(w.y) + bflo(w.z) * bflo(w.z) + bfhi(w.z) * bfhi(w.z) + bflo(w.w) * bflo(w.w) + bfhi(w.w) * bfhi(w.w); }
        ss += __shfl_xor(ss, 32);
        if (hi == 0) rk_l[wid * 32 + r32] = rsqrtf(ss * (1.f / 256.f) + 1e-6f);
    }
    const size_t qrow = (size_t)(tok0 + qb * 256 + wid * 32);
    bf16_t* Qw = VM + (qrow + r32) * 2048 + 1024 + mh * 256 + hi * 8;
    float rqC;
    { float ss = 0.f;
#pragma unroll
      for (int i = 0; i < 16; ++i) { const u32x4 w = *(const u32x4*)(Qw + i * 16);
          ss += bflo(w.x) * bflo(w.x) + bfhi(w.x) * bfhi(w.x) + bflo(w.y) * bflo(w.y) + bfhi(w.y) * bfhi(w.y) + bflo(w.z) * bflo(w.z) + bfhi(w.z) * bfhi(w.z) + bflo(w.w) * bflo(w.w) + bfhi(w.w) * bfhi(w.w); }
      ss += __shfl_xor(ss, 32);
      rqC = rsqrtf(ss * (1.f / 256.f) + 1e-6f) * (0.0625f * 1.4426950408889634f); }
    const int sr = tid >> 4, sc = (tid & 15) * 8, vst0 = v_st(sr, sc), vst1 = v_st(32 + sr, sc);
    const int kr = tid >> 3, kc = (tid & 7) * 8, kst = KSWZ64(kr, kc * 2);
    const int vb0 = (int)(uintptr_t)V_lds + v_rd_base(lane);
    unsigned* stash = (unsigned*)(lds + MOFF_STASH) + wid * 2048;
    __syncthreads();
#pragma unroll 1
    for (int hv = 0; hv < 2; ++hv) {
    float m_reg = -1e30f, l_reg = 0.f; f32x16 o[4] = {};
#pragma unroll 1
    for (int t = 0; t < 4; ++t) {
        const int k0 = t * 64;
#pragma unroll
        for (int ds = 0; ds < 4; ++ds) { const u32x4 w = *(const u32x4*)(Kh + (size_t)(k0 + kr) * 2048 + ds * 64 + kc); const float* g = g_l + ds * 64 + kc;
            u32x4 o4; o4.x = cvt_pk_bf16(bflo(w.x) * g[0], bfhi(w.x) * g[1]); o4.y = cvt_pk_bf16(bflo(w.y) * g[2], bfhi(w.y) * g[3]);
            o4.z = cvt_pk_bf16(bflo(w.z) * g[4], bfhi(w.z) * g[5]); o4.w = cvt_pk_bf16(bflo(w.w) * g[6], bfhi(w.w) * g[7]);
            *(u32x4*)(K_lds + ds * 8192 + kst) = o4; asm volatile("" ::: "memory"); }
        *(u32x4*)(V_lds + vst0) = *(const u32x4*)(Vh + (size_t)(k0 + sr) * 2048 + hv * 128 + sc);
        *(u32x4*)(V_lds + vst1) = *(const u32x4*)(Vh + (size_t)(k0 + 32 + sr) * 2048 + hv * 128 + sc);
        __syncthreads();
        f32x16 p0 = {}, p1 = {};
#pragma unroll
        for (int ds = 0; ds < 4; ++ds) { bf16x8 qr[4];
#pragma unroll
            for (int d0 = 0; d0 < 4; ++d0) qr[d0] = *reinterpret_cast<const bf16x8*>(Qw + ds * 64 + d0 * 16);
            qkt64(p0, p1, K_lds + ds * 8192, qr, r32, hi); }
#pragma unroll
        for (int r = 0; r < 16; ++r) { p0[r] *= rk_l[k0 + crow(r, hi)] * rqC; p1[r] *= rk_l[k0 + 32 + crow(r, hi)] * rqC; }
        float pmax = p0[0];
#pragma unroll
        for (int r = 1; r < 16; ++r) pmax = fmaxf(pmax, p0[r]);
#pragma unroll
        for (int r = 0; r < 16; ++r) pmax = fmaxf(pmax, p1[r]);
        pmax = fmaxf(pmax, __shfl_xor(pmax, 32));
        const float mn = fmaxf(m_reg, pmax), alpha = __builtin_amdgcn_exp2f(m_reg - mn); m_reg = mn;
        float ps = 0.f;
#pragma unroll
        for (int r = 0; r < 16; ++r) { p0[r] = __builtin_amdgcn_exp2f(p0[r] - mn); p1[r] = __builtin_amdgcn_exp2f(p1[r] - mn); ps += p0[r] + p1[r]; }
        ps += __shfl_xor(ps, 32);
        l_reg = l_reg * alpha + ps;
        if (hi == 0) al_l[r32] = alpha; asm volatile("s_waitcnt lgkmcnt(0)" ::: "memory");
#pragma unroll
        for (int d = 0; d < 4; ++d)
#pragma unroll
            for (int r = 0; r < 16; ++r) o[d][r] *= al_l[crow(r, hi)];
        bf16x8 pa0, pa1, pa2, pa3;
#define PK4(P, BASE, OUT) do { unsigned a0 = cvt_pk_bf16(P[BASE + 0], P[BASE + 1]), a1 = cvt_pk_bf16(P[BASE + 2], P[BASE + 3]);   \
    unsigned b0 = cvt_pk_bf16(P[BASE + 4], P[BASE + 5]), b1 = cvt_pk_bf16(P[BASE + 6], P[BASE + 7]);                              \
    auto r0 = __builtin_amdgcn_permlane32_swap(a0, b0, false, false); auto r1 = __builtin_amdgcn_permlane32_swap(a1, b1, false, false); \
    u32x4 w = {r0[0], r1[0], r0[1], r1[1]}; OUT = *reinterpret_cast<bf16x8*>(&w); } while (0)
        PK4(p0, 0, pa0); PK4(p0, 8, pa1); PK4(p1, 0, pa2); PK4(p1, 8, pa3);
#undef PK4
        pv_d0(o, vb0, pa0, pa1, pa2, pa3);
        __syncthreads();
    }
    if (hi == 0) li_l[r32] = l_reg; asm volatile("s_waitcnt lgkmcnt(0)" ::: "memory");
    if (hv == 1) stash_store(stash, VM + qrow * 2048 + 1024 + mh * 256, 2048, lane);
#pragma unroll
    for (int d0 = 0; d0 < 4; ++d0)
#pragma unroll
        for (int r = 0; r < 16; r += 2) stash[(d0 * 8 + (r >> 1)) * 64 + lane] = cvt_pk_bf16(o[d0][r] * __builtin_amdgcn_rcpf(li_l[crow(r, hi)]), o[d0][r + 1] * __builtin_amdgcn_rcpf(li_l[crow(r + 1, hi)]));
    }
    stash_store(stash, VM + qrow * 2048 + 1024 + mh * 256 + 128, 2048, lane);
    __syncthreads();
}
#undef SBAR
}

namespace scan {
constexpr int TC = 32;
constexpr int BUFB = 57344, O_R = 0, O_KD = 8192, O_KK = 16384, O_W = 24576, O_KA = 32768, O_V = 40960, O_Y = 49152;
constexpr int O_PRIV = 114688;
constexpr int O_TBL = 114688 + 8192;
__device__ __forceinline__ float dpp_red8(float x) {
    x += __uint_as_float(__builtin_amdgcn_update_dpp(0u, __float_as_uint(x), 0xB1, 0xf, 0xf, false));
    x += __uint_as_float(__builtin_amdgcn_update_dpp(0u, __float_as_uint(x), 0x4E, 0xf, 0xf, false));
    x += __uint_as_float(__builtin_amdgcn_update_dpp(0u, __float_as_uint(x), 0x141, 0xf, 0xf, false));
    return x;
}
template <int DIR> __device__ __forceinline__ void scan_chunk(const char* B_, f32x2 (&S)[2][4], int seg, int row0) {
    const char* base = B_ + seg * 32; const char* vbase = B_ + O_V + row0 * 4; char* ybase = (char*)B_ + O_Y + row0 * 4;
    f32x4 ck[2][2], cw[2][2], ca[2][2], cd[2][2], cr[2][2]; f32x2 cv[2];
#define LDSET(set, tl_) do { ck[set][0] = *(const f32x4*)(base + O_KK + (tl_) * 256); ck[set][1] = *(const f32x4*)(base + O_KK + (tl_) * 256 + 16); \
    cw[set][0] = *(const f32x4*)(base + O_W + (tl_) * 256); cw[set][1] = *(const f32x4*)(base + O_W + (tl_) * 256 + 16); \
    ca[set][0] = *(const f32x4*)(base + O_KA + (tl_) * 256); ca[set][1] = *(const f32x4*)(base + O_KA + (tl_) * 256 + 16); \
    cd[set][0] = *(const f32x4*)(base + O_KD + (tl_) * 256); cd[set][1] = *(const f32x4*)(base + O_KD + (tl_) * 256 + 16); \
    cr[set][0] = *(const f32x4*)(base + O_R + (tl_) * 256); cr[set][1] = *(const f32x4*)(base + O_R + (tl_) * 256 + 16); \
    cv[set] = *(const f32x2*)(vbase + (tl_) * 256); } while (0)
    LDSET(0, DIR ? TC - 1 : 0);
#pragma unroll
    for (int st = 0; st < TC; ++st) {
        const int tl = DIR ? TC - 1 - st : st, cs = st & 1;
        if (st + 1 < TC) LDSET(cs ^ 1, DIR ? TC - 2 - st : st + 1);
        const f32x2 k0 = {ck[cs][0][0], ck[cs][0][1]}, k1 = {ck[cs][0][2], ck[cs][0][3]}, k2 = {ck[cs][1][0], ck[cs][1][1]}, k3 = {ck[cs][1][2], ck[cs][1][3]};
        const f32x2 w0 = {cw[cs][0][0], cw[cs][0][1]}, w1 = {cw[cs][0][2], cw[cs][0][3]}, w2 = {cw[cs][1][0], cw[cs][1][1]}, w3 = {cw[cs][1][2], cw[cs][1][3]};
        const f32x2 a0 = {ca[cs][0][0], ca[cs][0][1]}, a1 = {ca[cs][0][2], ca[cs][0][3]}, a2 = {ca[cs][1][0], ca[cs][1][1]}, a3 = {ca[cs][1][2], ca[cs][1][3]};
        const f32x2 d0 = {cd[cs][0][0], cd[cs][0][1]}, d1 = {cd[cs][0][2], cd[cs][0][3]}, d2 = {cd[cs][1][0], cd[cs][1][1]}, d3 = {cd[cs][1][2], cd[cs][1][3]};
        const f32x2 r0 = {cr[cs][0][0], cr[cs][0][1]}, r1 = {cr[cs][0][2], cr[cs][0][3]}, r2 = {cr[cs][1][0], cr[cs][1][1]}, r3 = {cr[cs][1][2], cr[cs][1][3]};
        f32x2 yo;
#pragma unroll
        for (int h2 = 0; h2 < 2; ++h2) {
            const f32x2 vv = {cv[cs][h2], cv[cs][h2]};
            f32x2 t2 = S[h2][0] * k0 + S[h2][1] * k1; const f32x2 t3 = S[h2][2] * k2 + S[h2][3] * k3; t2 = t2 + t3;
            const float d = dpp_red8(t2[0] + t2[1]);
            const f32x2 p0 = S[h2][0] * w0 + vv * d0, p1 = S[h2][1] * w1 + vv * d1, p2 = S[h2][2] * w2 + vv * d2, p3 = S[h2][3] * w3 + vv * d3;
            const f32x2 sa = {-d, -d};
            S[h2][0] = p0 + sa * a0; S[h2][1] = p1 + sa * a1; S[h2][2] = p2 + sa * a2; S[h2][3] = p3 + sa * a3;
            f32x2 y2 = S[h2][0] * r0 + S[h2][1] * r1; const f32x2 y3 = S[h2][2] * r2 + S[h2][3] * r3; y2 = y2 + y3;
            yo[h2] = dpp_red8(y2[0] + y2[1]);
        }
        if (seg == 0) *(f32x2*)(ybase + tl * 256) = yo;
    }
#undef LDSET
}
struct P {
    const bf16_t* ZR; bf16_t* YB; float* BON;
    const float *mup, *mun, *w0, *w2, *a0, *a2, *kk_w, *ka_w, *rk_w;
};
__device__ __forceinline__ void job(int s, int dir, int head, const P& p, char* lds) {
    int tid = threadIdx.x; asm volatile("" : "+v"(tid));
    const int wid = __builtin_amdgcn_readfirstlane(tid >> 6), lane = tid & 63;
    const int tok0 = seq_start(s), T = seq_len(s), NCH = T / TC;
    float* TBL = (float*)(lds + O_TBL);
    float* MUP = TBL; float* MUN = TBL + 320; float* KKW = TBL + 640; float* KAW = TBL + 704; float* RKW = TBL + 768; float* BW = TBL + 832; float* BA = TBL + 896;
    __syncthreads();
    if (tid < 320) { const int which = tid >> 6, j = tid & 63; const int col = which < 3 ? which * 1024 + head * 64 + j : (which == 3 ? 3072 : 3200) + dir * 64 + j; MUP[tid] = p.mup[col]; MUN[tid] = p.mun[col]; }
    if (tid >= 320 && tid < 384) { const int j = tid - 320; KKW[j] = p.kk_w[head * 64 + j]; KAW[j] = p.ka_w[head * 64 + j]; RKW[j] = p.rk_w[head * 64 + j];
        BW[j] = p.w0[dir * 1024 + head * 64 + j]; BA[j] = p.a0[dir * 1024 + head * 64 + j]; }
    bf16_t* yb = p.YB + (size_t)dir * NT * 1024; float* bon = p.BON + (size_t)dir * NT * 16;
    if (wid >= 4) {
        const int pw = wid - 4;
        bf16_t* AWl = (bf16_t*)(lds + O_PRIV + pw * 2048); bf16_t* AAl = AWl + 512;
        bf16x8 Bf[2][4][2];
#pragma unroll
        for (int mat = 0; mat < 2; ++mat)
#pragma unroll
            for (int cbk = 0; cbk < 4; ++cbk)
#pragma unroll
                for (int ks = 0; ks < 2; ++ks) { const float* W2 = (mat == 0 ? p.w2 : p.a2) + (size_t)dir * 64 * 1024 + head * 64 + cbk * 16 + (lane & 15) + (size_t)(ks * 32 + (lane >> 4) * 8) * 1024;
                    float f[8];
#pragma unroll
                    for (int e = 0; e < 8; ++e) f[e] = W2[(size_t)e * 1024];
                    u32x4 w; w.x = cvt_pk_bf16(f[0], f[1]); w.y = cvt_pk_bf16(f[2], f[3]); w.z = cvt_pk_bf16(f[4], f[5]); w.w = cvt_pk_bf16(f[6], f[7]); Bf[mat][cbk][ks] = *reinterpret_cast<bf16x8*>(&w); }
        __syncthreads();
        const int pt = tid - 256;
        u32x4 zc[5], zm[5], zn[5];
#define PLOAD(cc) do { const int tf_ = dir ? T - TC * ((cc) + 1) : TC * (cc); \
    _Pragma("unroll") for (int k = 0; k < 5; ++k) { const int item = lane + 64 * k, tl8 = item / 40, chh = item - tl8 * 40, which = chh >> 3, j0 = (chh & 7) * 8; \
        const int col = which < 3 ? which * 1024 + head * 64 + j0 : (which == 3 ? 3072 : 3200) + dir * 64 + j0; \
        const int t = tf_ + 8 * pw + tl8; const bf16_t* zp = p.ZR + (size_t)(tok0 + t) * ZRP + col; \
        zc[k] = *(const u32x4*)zp; zm[k] = (u32x4){0u, 0u, 0u, 0u}; zn[k] = (u32x4){0u, 0u, 0u, 0u}; \
        if (t > 0) zm[k] = *(const u32x4*)(zp - ZRP); \
        if (t < T - 1) zn[k] = *(const u32x4*)(zp + ZRP); } } while (0)
        PLOAD(0);
        for (int c = -1; c < NCH; ++c) {
            if (c >= 1) { const int cb_ = (c - 1) & 1, tf = dir ? T - TC * c : TC * (c - 1); const int tl = pt >> 3, c8 = (pt & 7) * 8;
                const float* yp = (const float*)(lds + cb_ * BUFB + O_Y) + tl * 64 + c8; const f32x4 y4 = *(const f32x4*)yp, y5 = *(const f32x4*)(yp + 4);
                u32x4 w; w.x = cvt_pk_bf16(y4[0], y4[1]); w.y = cvt_pk_bf16(y4[2], y4[3]); w.z = cvt_pk_bf16(y5[0], y5[1]); w.w = cvt_pk_bf16(y5[2], y5[3]);
                *(u32x4*)(yb + (size_t)(tok0 + tf + tl) * 1024 + head * 64 + c8) = w; }
            if (c + 1 < NCH) {
                const int nb = (c + 1) & 1, tfirst = dir ? T - TC * (c + 2) : TC * (c + 1);
                char* B_ = lds + nb * BUFB;
                float* Rl = (float*)(B_ + O_R); float* KDl = (float*)(B_ + O_KD); float* KKl = (float*)(B_ + O_KK); float* Wl = (float*)(B_ + O_W); float* KAl = (float*)(B_ + O_KA); float* Vl = (float*)(B_ + O_V);
#pragma unroll
                for (int k = 0; k < 5; ++k) { const int item = lane + 64 * k, tl8 = item / 40, chh = item - tl8 * 40, which = chh >> 3, j0 = (chh & 7) * 8, tl = 8 * pw + tl8;
                    const f32x4 mpa = *(const f32x4*)(MUP + which * 64 + j0), mpb = *(const f32x4*)(MUP + which * 64 + j0 + 4), mna = *(const f32x4*)(MUN + which * 64 + j0), mnb = *(const f32x4*)(MUN + which * 64 + j0 + 4);
                    const u32x4 z = zc[k], zmm = zm[k], znn = zn[k];
                    float v[8];
#define SH(i, zw, zmw, znw, lohi, mp_, mn_) { const float zz = lohi(zw), a_ = lohi(zmw), b_ = lohi(znw); v[i] = zz + mp_ * (a_ - zz) + mn_ * (b_ - zz); }
                    SH(0, z.x, zmm.x, znn.x, bflo, mpa[0], mna[0]) SH(1, z.x, zmm.x, znn.x, bfhi, mpa[1], mna[1]) SH(2, z.y, zmm.y, znn.y, bflo, mpa[2], mna[2]) SH(3, z.y, zmm.y, znn.y, bfhi, mpa[3], mna[3])
                    SH(4, z.z, zmm.z, znn.z, bflo, mpb[0], mnb[0]) SH(5, z.z, zmm.z, znn.z, bfhi, mpb[1], mnb[1]) SH(6, z.w, zmm.w, znn.w, bflo, mpb[2], mnb[2]) SH(7, z.w, zmm.w, znn.w, bfhi, mpb[3], mnb[3])
#undef SH
                    if (which < 2) { float* dst = (which == 0 ? Rl : KDl) + tl * 64 + j0;
                        *(f32x4*)dst = (f32x4){v[0], v[1], v[2], v[3]}; *(f32x4*)(dst + 4) = (f32x4){v[4], v[5], v[6], v[7]}; }
                    else if (which == 2) { float* dst = Vl + tl * 64 + j0;
                        *(f32x4*)dst = (f32x4){v[0], v[1], v[2], v[3]}; *(f32x4*)(dst + 4) = (f32x4){v[4], v[5], v[6], v[7]}; }
                    else { if (which == 3) {
#pragma unroll
                            for (int i = 0; i < 8; ++i) { const float e2 = __expf(2.f * v[i]); v[i] = 1.f - 2.f * __builtin_amdgcn_rcpf(e2 + 1.f); } }
                        u32x4 w; w.x = cvt_pk_bf16(v[0], v[1]); w.y = cvt_pk_bf16(v[2], v[3]); w.z = cvt_pk_bf16(v[4], v[5]); w.w = cvt_pk_bf16(v[6], v[7]);
                        *(u32x4*)((which == 3 ? AWl : AAl) + tl8 * 64 + j0) = w; }
                }
                { const int tj = lane & 7, kq = lane >> 4;
#pragma unroll
                  for (int mat = 0; mat < 2; ++mat) { const bf16_t* Am = (mat == 0 ? AWl : AAl) + tj * 64 + kq * 8;
                      const bf16x8 y0 = *reinterpret_cast<const bf16x8*>(Am), y1 = *reinterpret_cast<const bf16x8*>(Am + 32);
#pragma unroll
                      for (int cbk = 0; cbk < 4; ++cbk) { f32x4 acc = {0.f, 0.f, 0.f, 0.f};
                          acc = __builtin_amdgcn_mfma_f32_16x16x32_bf16(Bf[mat][cbk][0], y0, acc, 0, 0, 0);
                          acc = __builtin_amdgcn_mfma_f32_16x16x32_bf16(Bf[mat][cbk][1], y1, acc, 0, 0, 0);
                          const int col = cbk * 16 + 4 * kq; const f32x4 bias = *(const f32x4*)((mat == 0 ? BW : BA) + col); f32x4 res;
#pragma unroll
                          for (int r = 0; r < 4; ++r) { const float u = acc[r] + bias[r];
                              const float sg = __builtin_amdgcn_rcpf(1.f + __expf(-u));
                              res[r] = mat == 0 ? __expf(-0.60653065971263342f * sg) : sg; }
                          if ((lane & 15) < 8) *(f32x4*)((mat == 0 ? Wl : KAl) + (8 * pw + tj) * 64 + col) = res; } } }
                { const int tl = 8 * pw + (lane >> 3), c0 = (lane & 7) * 8; const int o = tl * 64 + c0;
                  float bs = 0.f, ss = 0.f; f32x4 kr[2], k4[2], a4[2];
#pragma unroll
                  for (int q = 0; q < 2; ++q) { k4[q] = *(const f32x4*)(KDl + o + 4 * q); a4[q] = *(const f32x4*)(KAl + o + 4 * q);
                      kr[q] = k4[q] * *(const f32x4*)(KKW + c0 + 4 * q); ss += (kr[q][0] * kr[q][0] + kr[q][1] * kr[q][1]) + (kr[q][2] * kr[q][2] + kr[q][3] * kr[q][3]); }
                  ss = dpp_red8(ss);
                  const float inv = __builtin_amdgcn_rsqf(fmaxf(ss, 1e-24f));
#pragma unroll
                  for (int q = 0; q < 2; ++q) { const f32x4 kk = kr[q] * inv, kd = k4[q] * (1.f + (a4[q] - 1.f) * *(const f32x4*)(KAW + c0 + 4 * q)), kka = kk * a4[q];
                      const f32x4 bb = *(const f32x4*)(Rl + o + 4 * q) * kd * *(const f32x4*)(RKW + c0 + 4 * q); bs += (bb[0] + bb[1]) + (bb[2] + bb[3]);
                      *(f32x4*)(KKl + o + 4 * q) = kk; *(f32x4*)(KDl + o + 4 * q) = kd; *(f32x4*)(KAl + o + 4 * q) = kka; }
                  bs = dpp_red8(bs);
                  if ((lane & 7) == 0) bon[(size_t)(tok0 + tfirst + tl) * 16 + head] = bs; }
                if (c + 2 < NCH) PLOAD(c + 2);
            }
            asm volatile("s_waitcnt lgkmcnt(0)" ::: "memory"); __builtin_amdgcn_s_barrier(); asm volatile("" ::: "memory");
        }
#undef PLOAD
    } else {
        __syncthreads();
        const int row0 = wid * 16 + (lane >> 3) * 2, seg = lane & 7;
        f32x2 S[2][4];
#pragma unroll
        for (int h2 = 0; h2 < 2; ++h2)
#pragma unroll
            for (int q = 0; q < 4; ++q) S[h2][q] = (f32x2){0.f, 0.f};
        asm volatile("s_waitcnt lgkmcnt(0)" ::: "memory"); __builtin_amdgcn_s_barrier(); asm volatile("" ::: "memory");
        for (int c = 0; c < NCH; ++c) {
            const char* B_ = lds + (c & 1) * BUFB;
            if (dir) scan_chunk<1>(B_, S, seg, row0); else scan_chunk<0>(B_, S, seg, row0);
            asm volatile("s_waitcnt lgkmcnt(0)" ::: "memory"); __builtin_amdgcn_s_barrier(); asm volatile("" ::: "memory");
        }
    }
    if (wid >= 4) {
        const int pt = tid - 256, c = NCH, cb_ = (c - 1) & 1, tf = dir ? T - TC * c : TC * (c - 1); const int tl = pt >> 3, c8 = (pt & 7) * 8;
        const float* yp = (const float*)(lds + cb_ * BUFB + O_Y) + tl * 64 + c8; const f32x4 y4 = *(const f32x4*)yp, y5 = *(const f32x4*)(yp + 4);
        u32x4 w; w.x = cvt_pk_bf16(y4[0], y4[1]); w.y = cvt_pk_bf16(y4[2], y4[3]); w.z = cvt_pk_bf16(y5[0], y5[1]); w.w = cvt_pk_bf16(y5[2], y5[3]);
        *(u32x4*)(yb + (size_t)(tok0 + tf + tl) * 1024 + head * 64 + c8) = w;
    }
    __syncthreads();
}
}

__device__ __forceinline__ void p4_post(const Args& a, char* lds, int vcu, int G) {
    const int tid = threadIdx.x, lane = tid & 63;
    unsigned char* ws = a.ws;
    const bf16_t* ZR = (const bf16_t*)a.out; bf16_t* QK = (bf16_t*)(ws + WS_QK);
    const bf16_t* Y0 = (const bf16_t*)(ws + WS_Y); const bf16_t* Y1 = Y0 + (size_t)NT * 1024;
    const float* BON = (const float*)(ws + WS_BON);
    const float* mup = a.in[13]; const float* mun = a.in[14]; const float* G2 = a.in[19]; const float* lnw = a.in[23]; const float* lnb = a.in[24]; const float* subg = a.in[12];
    float* SG = (float*)lds; float* BL = (float*)(lds + 20480);
    for (int tile = vcu; tile < NT / 32; tile += G) {
        const int tk0 = tile * 32;
        __syncthreads();
        for (int it = tid; it < 32 * 20; it += NTHR) {
            const int tl = it / 20, j0 = (it % 20) * 8, col = 3328 + j0, tok = tk0 + tl, t = tok_pos(tok), T = tok < TP ? TP : TS;
            const bf16_t* zp = ZR + (size_t)tok * ZRP + col; const u32x4 z = *(const u32x4*)zp; u32x4 zm = {0u, 0u, 0u, 0u}, zn = {0u, 0u, 0u, 0u};
            if (t > 0) zm = *(const u32x4*)(zp - ZRP);
            if (t < T - 1) zn = *(const u32x4*)(zp + ZRP);
            float v[8];
#define SH(i, zw, zmw, znw, lohi) { const float zz = lohi(zw), a_ = lohi(zmw), b_ = lohi(znw), mp_ = mup[col + i], mn_ = mun[col + i]; v[i] = sigmoidf_(zz + mp_ * (a_ - zz) + mn_ * (b_ - zz)); }
            SH(0, z.x, zm.x, zn.x, bflo) SH(1, z.x, zm.x, zn.x, bfhi) SH(2, z.y, zm.y, zn.y, bflo) SH(3, z.y, zm.y, zn.y, bfhi)
            SH(4, z.z, zm.z, zn.z, bflo) SH(5, z.z, zm.z, zn.z, bfhi) SH(6, z.w, zm.w, zn.w, bflo) SH(7, z.w, zm.w, zn.w, bfhi)
#undef SH
            *(f32x4*)(SG + tl * 160 + j0) = (f32x4){v[0], v[1], v[2], v[3]}; *(f32x4*)(SG + tl * 160 + j0 + 4) = (f32x4){v[4], v[5], v[6], v[7]};
        }
        { const int tl = tid >> 4, hd = tid & 15; BL[tid] = BON[(size_t)(tk0 + tl) * 16 + hd] + BON[(size_t)NT * 16 + (size_t)(tk0 + tl) * 16 + hd]; }
        { const int pr = tid >> 1, half = tid & 1, tl = pr >> 3, hd = pr & 7; bf16_t* op = QK + (size_t)(tk0 + tl) * 2048 + hd * 128 + half * 64;
          u32x4 w[8]; float ss = 0.f;
#pragma unroll
          for (int i = 0; i < 8; ++i) { w[i] = *(const u32x4*)(op + i * 8);
              ss += bflo(w[i].x) * bflo(w[i].x) + bfhi(w[i].x) * bfhi(w[i].x) + bflo(w[i].y) * bflo(w[i].y) + bfhi(w[i].y) * bfhi(w[i].y) + bflo(w[i].z) * bflo(w[i].z) + bfhi(w[i].z) * bfhi(w[i].z) + bflo(w[i].w) * bflo(w[i].w) + bfhi(w[i].w) * bfhi(w[i].w); }
          ss += __shfl_xor(ss, 1);
          const float rstd = rsqrtf(ss * (1.f / 128.f) + 1e-6f) * 0.8f; const float* sg = subg + half * 64;
#pragma unroll
          for (int i = 0; i < 8; ++i) { u32x4 o;
              o.x = cvt_pk_bf16(bflo(w[i].x) * rstd * sg[i * 8 + 0], bfhi(w[i].x) * rstd * sg[i * 8 + 1]); o.y = cvt_pk_bf16(bflo(w[i].y) * rstd * sg[i * 8 + 2], bfhi(w[i].y) * rstd * sg[i * 8 + 3]);
              o.z = cvt_pk_bf16(bflo(w[i].z) * rstd * sg[i * 8 + 4], bfhi(w[i].z) * rstd * sg[i * 8 + 5]); o.w = cvt_pk_bf16(bflo(w[i].w) * rstd * sg[i * 8 + 6], bfhi(w[i].w) * rstd * sg[i * 8 + 7]);
              *(u32x4*)(op + i * 8) = o; } }
        __syncthreads();
        const int c0 = tid * 2;
        float acc[32][2];
#pragma unroll
        for (int i = 0; i < 32; ++i) { acc[i][0] = 0.f; acc[i][1] = 0.f; }
#pragma unroll 1
        for (int k = 0; k < 160; k += 4) {
            const f32x2 g0 = *(const f32x2*)(G2 + (size_t)(k + 0) * 1024 + c0), g1 = *(const f32x2*)(G2 + (size_t)(k + 1) * 1024 + c0), g2 = *(const f32x2*)(G2 + (size_t)(k + 2) * 1024 + c0), g3 = *(const f32x2*)(G2 + (size_t)(k + 3) * 1024 + c0);
#pragma unroll
            for (int i = 0; i < 32; ++i) { const f32x4 s4 = *(const f32x4*)(SG + i * 160 + k);
                acc[i][0] += s4[0] * g0[0] + s4[1] * g1[0] + s4[2] * g2[0] + s4[3] * g3[0];
                acc[i][1] += s4[0] * g0[1] + s4[1] * g1[1] + s4[2] * g2[1] + s4[3] * g3[1]; }
        }
        const int hd = tid >> 5;
        const float lw0 = lnw[c0], lw1 = lnw[c0 + 1], lb0 = lnb[c0], lb1 = lnb[c0 + 1];
        const float mp0 = mup[2048 + c0], mp1 = mup[2048 + c0 + 1], mn0 = mun[2048 + c0], mn1 = mun[2048 + c0 + 1];
#pragma unroll
        for (int i = 0; i < 32; ++i) {
            const int tok = tk0 + i, t = tok_pos(tok), T = tok < TP ? TP : TS;
            const unsigned ya = *(const unsigned*)(Y0 + (size_t)tok * 1024 + c0), yb = *(const unsigned*)(Y1 + (size_t)tok * 1024 + c0);
            const float y0 = bflo(ya) + bflo(yb), y1 = bfhi(ya) + bfhi(yb);
            float s = y0 + y1, q = y0 * y0 + y1 * y1;
#pragma unroll
            for (int o = 1; o < 32; o <<= 1) { s += __shfl_xor(s, o); q += __shfl_xor(q, o); }
            const float mean = s * (1.f / 64.f), var = fmaxf(q * (1.f / 64.f) - mean * mean, 0.f), rstd = rsqrtf(var + 64e-5f);
            const bf16_t* zp = ZR + (size_t)tok * ZRP + 2048 + c0; const unsigned z = *(const unsigned*)zp;
            unsigned zm = 0u, zn = 0u;
            if (t > 0) zm = *(const unsigned*)(zp - ZRP);
            if (t < T - 1) zn = *(const unsigned*)(zp + ZRP);
            const float v0 = bflo(z) + mp0 * (bflo(zm) - bflo(z)) + mn0 * (bflo(zn) - bflo(z)), v1 = bfhi(z) + mp1 * (bfhi(zm) - bfhi(z)) + mn1 * (bfhi(zn) - bfhi(z));
            const float bo = BL[i * 16 + hd];
            const float o0 = ((y0 - mean) * rstd * lw0 + lb0 + bo * v0) * acc[i][0], o1 = ((y1 - mean) * rstd * lw1 + lb1 + bo * v1) * acc[i][1];
            *(unsigned*)(QK + (size_t)tok * 2048 + 1024 + c0) = cvt_pk_bf16(o0, o1);
        }
    }
    __syncthreads();
}

struct SchedMerge {
    int v, G; const char* H; const char* WG; const char* QK; const char* VM; const char* PAR; const char* PM2;
    __device__ __forceinline__ bool next(int i, Unit& u) const {
        const int ti = i / 6, kind = i - ti * 6; const long L = (long)ti * G + v; int pm, pn;
        if (!TileMap{192, 8}.get(L, pm, pn)) return false;
        u.pm = pm; u.pn = pn; u.kind = kind; u.t0 = 0; u.T = 0;
        const size_t bo = (size_t)pn * MiB;
        switch (kind) {
            case 0: u.A = H + (size_t)pm * MiB; u.B = WG + bo; u.nt = 32; break;
            case 1: u.A = QK + (size_t)pm * MiB; u.B = PAR + bo; u.nt = 16; break;
            case 2: u.A = H + (size_t)pm * MiB; u.B = WG + 8 * MiB + bo; u.nt = 32; break;
            case 3: u.A = QK + (size_t)pm * MiB + 2048; u.B = PAR + bo + 2048; u.nt = 16; break;
            case 4: u.A = H + (size_t)pm * MiB; u.B = WG + 16 * MiB + bo; u.nt = 32; break;
            default: u.A = VM + (size_t)pm * MiB + 2048; u.B = PM2 + bo; u.nt = 16; break;
        }
        return true;
    }
};
struct EpiMerge {
    u32x4* scrG; f32x4* scrP; bf16_t* MRG;
    __device__ __forceinline__ void operator()(const f32x4 (&acc)[2][2][4][2], const Unit& u, int wr, int wc, int fr, int fq) const {
        const int tid = threadIdx.x, kind = u.kind;
        u32x4* gp = scrG + tid; f32x4* pp = scrP + tid;
        if ((kind & 1) == 0) {
#pragma unroll
            for (int ai = 0; ai < 2; ++ai)
#pragma unroll
                for (int bj = 0; bj < 2; ++bj)
#pragma unroll
                    for (int m = 0; m < 4; ++m) { const f32x4 v0 = acc[ai][bj][m][0], v1 = acc[ai][bj][m][1]; u32x4 w;
                        w.x = cvt_pk_bf16(sigmoidf_(v0[0]), sigmoidf_(v0[1])); w.y = cvt_pk_bf16(sigmoidf_(v0[2]), sigmoidf_(v0[3]));
                        w.z = cvt_pk_bf16(sigmoidf_(v1[0]), sigmoidf_(v1[1])); w.w = cvt_pk_bf16(sigmoidf_(v1[2]), sigmoidf_(v1[3]));
                        *gp = w; gp += NTHR; asm volatile("" : "+v"(gp) :: "memory"); }
        } else {
            const int row0 = u.pm * 256 + wr * 64 + fr, col0 = u.pn * 256 + wc * 32 + 8 * fq;
#pragma unroll
            for (int ai = 0; ai < 2; ++ai)
#pragma unroll
                for (int bj = 0; bj < 2; ++bj) {
                    bf16_t* mp = MRG + (size_t)(row0 + ai * 128) * 2048 + col0 + bj * 128;
#pragma unroll
                    for (int m = 0; m < 4; ++m) { const u32x4 g = *gp;
                        f32x4 p0 = acc[ai][bj][m][0] * (f32x4){bflo(g.x), bfhi(g.x), bflo(g.y), bfhi(g.y)}, p1 = acc[ai][bj][m][1] * (f32x4){bflo(g.z), bfhi(g.z), bflo(g.w), bfhi(g.w)};
                        if (kind > 1) { p0 += pp[0]; p1 += pp[NTHR]; }
                        if (kind < 5) { pp[0] = p0; pp[NTHR] = p1; }
                        else { u32x4 w; w.x = cvt_pk_bf16(p0[0], p0[1]); w.y = cvt_pk_bf16(p0[2], p0[3]); w.z = cvt_pk_bf16(p1[0], p1[1]); w.w = cvt_pk_bf16(p1[2], p1[3]);
                            *(u32x4*)mp = w; }
                        gp += NTHR; pp += 2 * NTHR; mp += 16 * 2048; asm volatile("" : "+v"(gp), "+v"(pp), "+v"(mp) :: "memory"); } }
        }
    }
};

struct SchedSq {
    int v, G; const char* A; const char* B; size_t astep, bstep; int nt;
    __device__ __forceinline__ bool next(int i, Unit& u) const {
        const long L = (long)i * G + v; int pm, pn; if (!TileMap{192, 8}.get(L, pm, pn)) return false;
        u.A = A + (size_t)pm * astep; u.B = B + (size_t)pn * bstep; u.nt = nt; u.pm = pm; u.pn = pn; u.kind = 0; u.t0 = 0; u.T = 0; return true;
    }
};
struct EpiWo {
    const float* xp; const float* xs; float* out;
    __device__ __forceinline__ void operator()(const f32x4 (&acc)[2][2][4][2], const Unit& u, int wr, int wc, int fr, int fq) const {
        const int row0 = u.pm * 256 + wr * 64 + fr, col0 = u.pn * 256 + wc * 32 + 8 * fq;
#pragma unroll
        for (int ai = 0; ai < 2; ++ai)
#pragma unroll
            for (int m = 0; m < 4; ++m) { const int row = row0 + ai * 128 + m * 16;
                const float* xr = (row < TP ? xp + (size_t)row * DM : xs + (size_t)(row - TP) * DM) + col0; float* orow = out + (size_t)row * DM + col0;
#pragma unroll
                for (int bj = 0; bj < 2; ++bj) { const f32x4 x0 = *(const f32x4*)(xr + bj * 128), x1 = *(const f32x4*)(xr + bj * 128 + 4);
                    *(f32x4*)(orow + bj * 128) = x0 + acc[ai][bj][m][0]; *(f32x4*)(orow + bj * 128 + 4) = x1 + acc[ai][bj][m][1]; } }
    }
};
struct EpiDown {
    float* out;
    __device__ __forceinline__ void operator()(const f32x4 (&acc)[2][2][4][2], const Unit& u, int wr, int wc, int fr, int fq) const {
        const int row0 = u.pm * 256 + wr * 64 + fr, col0 = u.pn * 256 + wc * 32 + 8 * fq;
#pragma unroll
        for (int ai = 0; ai < 2; ++ai)
#pragma unroll
            for (int m = 0; m < 4; ++m) { float* orow = out + (size_t)(row0 + ai * 128 + m * 16) * DM + col0;
#pragma unroll
                for (int bj = 0; bj < 2; ++bj) { const f32x4 x0 = *(const f32x4*)(orow + bj * 128), x1 = *(const f32x4*)(orow + bj * 128 + 4);
                    *(f32x4*)(orow + bj * 128) = x0 + acc[ai][bj][m][0]; *(f32x4*)(orow + bj * 128 + 4) = x1 + acc[ai][bj][m][1]; } }
    }
};

struct SchedUp {
    int v, G; const char* HN; const char* WUP;
    __device__ __forceinline__ bool next(int i, Unit& u) const {
        const long L = (long)i * G + v; int pm, pn; if (!TileMap{197, 44}.get(L, pm, pn)) return false;
        int s, ti; if (pm < 65) { s = 0; ti = pm; } else { s = 1 + (pm - 65) / 33; ti = (pm - 65) % 33; }
        const int T = seq_len(s); int t0 = 254 * ti - 1; if (t0 > T - 255) t0 = T - 255;
        u.pm = seq_start(s); u.pn = pn; u.kind = 0; u.t0 = t0; u.T = T; u.nt = 32;
        u.A = HN + ((long)u.pm + t0) * 4096; u.B = WUP + (size_t)pn * MiB; return true;
    }
};
struct EpiUp {
    bf16_t* ACT; const float* cw; const float* cb; LAS float* xch;
    __device__ __forceinline__ void operator()(const f32x4 (&acc)[2][2][4][2], const Unit& u, int wr, int wc, int fr, int fq) const {
        const int lane = threadIdx.x & 63;
        const int cin = wc * 32 + 8 * fq;
#pragma unroll
        for (int ai = 0; ai < 2; ++ai) { const int rg = 2 * ai + wr;
#pragma unroll
            for (int bj = 0; bj < 2; ++bj)
#pragma unroll
                for (int n = 0; n < 2; ++n) {
                    if (fr == 0) *(LAS f32x4*)(xch + (rg * 2 + 0) * 256 + bj * 128 + cin + 4 * n) = acc[ai][bj][0][n];
                    if (fr == 15) *(LAS f32x4*)(xch + (rg * 2 + 1) * 256 + bj * 128 + cin + 4 * n) = acc[ai][bj][3][n]; } }
        asm volatile("s_waitcnt lgkmcnt(0)" ::: "memory"); __builtin_amdgcn_s_barrier(); asm volatile("" ::: "memory");
        const int srcR = (lane & 48) | ((lane - 1) & 15), srcL = (lane & 48) | ((lane + 1) & 15);
        const int gc = u.pn * 128 + cin;
#pragma unroll
        for (int n = 0; n < 2; ++n) {
            const int wcol = gc + 4 * n;
            const f32x4 g0 = *(const f32x4*)(cw + wcol), g1 = *(const f32x4*)(cw + 2 * DFF + wcol), g2 = *(const f32x4*)(cw + 4 * DFF + wcol), gb = *(const f32x4*)(cb + wcol);
            const f32x4 v0 = *(const f32x4*)(cw + DFF + wcol), v1 = *(const f32x4*)(cw + 3 * DFF + wcol), v2 = *(const f32x4*)(cw + 5 * DFF + wcol), vb = *(const f32x4*)(cb + DFF + wcol);
#pragma unroll
            for (int ai = 0; ai < 2; ++ai) { const int rg = 2 * ai + wr;
                bf16_t* ap = ACT + ((long)u.pm + u.t0 + 128 * ai + 64 * wr + fr) * DFF + gc + 4 * n;
#pragma unroll
                for (int m = 0; m < 4; ++m) {
                    const int j = 128 * ai + 64 * wr + 16 * m + fr, t = u.t0 + j;
                    f32x4 res;
#pragma unroll
                    for (int bj = 0; bj < 2; ++bj) {
                        const f32x4 cur = acc[ai][bj][m][n];
                        const f32x4 sp = (m > 0 && fr == 15) ? acc[ai][bj][m > 0 ? m - 1 : 0][n] : cur;
                        const f32x4 sn = (m < 3 && fr == 0) ? acc[ai][bj][m < 3 ? m + 1 : 3][n] : cur;
                        f32x4 pv, nv;
#pragma unroll
                        for (int i = 0; i < 4; ++i) { pv[i] = __shfl(sp[i], srcR); nv[i] = __shfl(sn[i], srcL); }
                        if (m == 0) { const f32x4 xprev = rg > 0 ? *(const LAS f32x4*)(xch + ((rg - 1) * 2 + 1) * 256 + bj * 128 + cin + 4 * n) : (f32x4){0.f, 0.f, 0.f, 0.f}; if (fr == 0) pv = xprev; }
                        if (m == 3) { const f32x4 xnext = rg < 3 ? *(const LAS f32x4*)(xch + ((rg + 1) * 2 + 0) * 256 + bj * 128 + cin + 4 * n) : (f32x4){0.f, 0.f, 0.f, 0.f}; if (fr == 15) nv = xnext; }
                        if (t < 1) pv = (f32x4){0.f, 0.f, 0.f, 0.f};
                        if (t >= u.T - 1) nv = (f32x4){0.f, 0.f, 0.f, 0.f};
                        if (bj == 0) { const f32x4 cv = g0 * pv + g1 * cur + g2 * nv + gb; res = (f32x4){cv[0] * sigmoidf_(cv[0]), cv[1] * sigmoidf_(cv[1]), cv[2] * sigmoidf_(cv[2]), cv[3] * sigmoidf_(cv[3])}; }
                        else { const f32x4 cv = v0 * pv + v1 * cur + v2 * nv + vb; res = res * cv; }
                    }
                    if (j >= 1 && j <= 254) { u32x2 w; w.x = cvt_pk_bf16(res[0], res[1]); w.y = cvt_pk_bf16(res[2], res[3]); *(u32x2*)ap = w; }
                    ap += 16 * DFF; asm volatile("" : "+v"(ap) :: "memory");
                }
            }
        }
    }
};

__global__ void __launch_bounds__(NTHR, 2) enc_fwd(Args args) {
    extern __shared__ __attribute__((aligned(16))) unsigned char lds_raw[];
    cg::grid_group grid = cg::this_grid();
    LAS unsigned char* lds = (LAS unsigned char*)lds_raw;
    const int tid = threadIdx.x;
    const int G = gridDim.x, bx = blockIdx.x, vcu = (G % 8 == 0) ? (bx % 8) * (G / 8) + bx / 8 : bx;
    unsigned char* ws = args.ws;
    const int lo = args.ph_lo, hi = args.ph_hi;
#ifndef P2M
#define P2M 7
#endif
#ifndef PH_MASK
#define PH_MASK 0x1ff
#endif
#define IN(k) (((PH_MASK >> (k)) & 1) && lo <= (k) && (k) < hi)
#define SEAM(k) do { if (IN(k) && IN((k) + 1)) grid.sync(); } while (0)
#ifndef PROBE
#define PROBE 0
#endif
    unsigned long long tp0 = 0, tp1 = 0;
#define TSTAMP(v) do { if (PROBE) { v = __builtin_amdgcn_s_memrealtime(); } } while (0)

    if (IN(0)) p0_prologue(args, lds, vcu, G);
    SEAM(0);
    if (IN(1)) {
        SchedIn S{vcu, G, (const char*)(ws + WS_H), (const char*)(ws + WS_WIN), (const char*)(ws + WS_MEMN), (const char*)(ws + WS_WKV)};
        EpiIn E{(bf16_t*)(ws + WS_QK), (bf16_t*)(ws + WS_VM), (bf16_t*)args.out, (bf16_t*)(ws + WS_KVM), args.in[6], args.in[7], (const float*)(ws + WS_ROPE), (const float*)(ws + WS_ROPE) + TP * 32};
        pg8::gemm_phase<EpiIn, SchedIn, true>(lds, 2048, S, E);
    }
    SEAM(1);
    if (PROBE == 1 || PROBE == 2) TSTAMP(tp0);
    if (IN(2)) {
        unsigned* ctl = (unsigned*)(ws + WS_CTL);
        volatile LAS unsigned* jobw = (volatile LAS unsigned*)(lds + LDS_MISC);
        const float lam = ((const float*)ctl)[CW_LAM];
        scan::P sp{(const bf16_t*)args.out, (bf16_t*)(ws + WS_Y), (float*)(ws + WS_BON), args.in[13], args.in[14], args.in[15], args.in[16], args.in[17], args.in[18], args.in[20], args.in[21], args.in[22]};
        for (;;) {
            __syncthreads();
            if (tid == 0) jobw[0] = atomicAdd(ctl + CW_QUEUE, 1u);
            __syncthreads();
            const int jb = (int)jobw[0];
            if (jb >= 160 + 1536 + 768) break;
            if (((P2M) & 1) && jb < 160) {
                int s, r; if (jb < 32) { s = 0; r = jb; } else { s = 1 + (jb - 32) / 32; r = (jb - 32) % 32; }
                scan::job(s, r & 1, r >> 1, sp, (char*)lds_raw);
                if (PROBE == 2 && tid == 0) atomicMax((unsigned long long*)(ctl + 256), (unsigned long long)__builtin_amdgcn_s_memrealtime());
            } else if (((P2M) & 2) && jb < 160 + 1536) {
                const int a = jb - 160; int s, h, qb;
                if (a < 512) { s = 0; h = a / 64; qb = a % 64; } else { const int b = a - 512; s = 1 + b / 256; h = (b % 256) / 32; qb = b % 32; }
                att::diff_unit(s, h, qb, (bf16_t*)(ws + WS_QK), (const bf16_t*)(ws + WS_VM), lam, (char*)lds_raw);
            } else if ((P2M) & 4) {
                const int a = jb - 160 - 1536; int s, mh, qb;
                if (a < 256) { s = 0; mh = a / 64; qb = a % 64; } else { const int b = a - 256; s = 1 + b / 128; mh = (b % 128) / 32; qb = b % 32; }
                att::mem_unit(s, mh, qb, (bf16_t*)(ws + WS_VM), (const bf16_t*)(ws + WS_KVM), args.in[27], args.in[28], (char*)lds_raw);
            }
        }
    }
    SEAM(2);
    if (PROBE == 1) TSTAMP(tp1);
    if (IN(3)) p4_post(args, (char*)lds_raw, vcu, G);
    SEAM(3);
    if (IN(4)) {
        SchedMerge S{vcu, G, (const char*)(ws + WS_H), (const char*)(ws + WS_WG), (const char*)(ws + WS_QK), (const char*)(ws + WS_VM), (const char*)(ws + WS_PAR), (const char*)(ws + WS_PM2)};
        unsigned char* scr = (unsigned char*)args.out + (size_t)bx * (384 * 1024);
        EpiMerge E{(u32x4*)scr, (f32x4*)(scr + 128 * 1024), (bf16_t*)(ws + WS_MRG)};
        pg8::gemm_phase<EpiMerge, SchedMerge, true>(lds, 2048, S, E);
    }
    SEAM(4);
    if (IN(5)) {
        SchedSq S{vcu, G, (const char*)(ws + WS_MRG), (const char*)(ws + WS_WO), MiB, MiB, 32};
        EpiWo E{args.in[0], args.in[1], args.out};
        pg8::gemm_phase<EpiWo, SchedSq, true>(lds, 2048, S, E);
    }
    SEAM(5);
    if (IN(6)) {
        const int lane = tid & 63, gw = vcu * 8 + (tid >> 6), NGW = G * 8;
        for (int m = gw; m < NT; m += NGW) rms_row(args.out + (size_t)m * DM, args.in[33], (bf16_t*)(ws + WS_H) + (size_t)m * DM, lane);
    }
    SEAM(6);
    if (IN(7)) {
        SchedUp S{vcu, G, (const char*)(ws + WS_H), (const char*)(ws + WS_WUP)};
        EpiUp E{(bf16_t*)(ws + WS_ACT), args.in[35], args.in[36], (LAS float*)(lds + LDS_XCH)};
        pg8::gemm_phase<EpiUp, SchedUp, true>(lds, 2048, S, E);
    }
    SEAM(7);
    if (IN(8)) {
        SchedSq S{vcu, G, (const char*)(ws + WS_ACT), (const char*)(ws + WS_WDN), (size_t)256 * DFF * 2, (size_t)256 * DFF * 2, 88};
        EpiDown E{args.out};
        pg8::gemm_phase<EpiDown, SchedSq, true>(lds, DFF, S, E);
    }
    if (PROBE && bx == 0 && tid == 0) {
        if (PROBE == 2) tp1 = __hip_atomic_load((unsigned long long*)(ws + WS_CTL) + 128, __ATOMIC_RELAXED, __HIP_MEMORY_SCOPE_AGENT);
        const unsigned long long target = __builtin_amdgcn_s_memrealtime() + (tp1 > tp0 ? tp1 - tp0 : 0);
        while (__builtin_amdgcn_s_memrealtime() < target) __builtin_amdgcn_s_sleep(16);
    }
#undef IN
#undef SEAM
}

#ifndef MK_SPLIT
#define MK_SPLIT 0
#endif
extern "C" void kernel_launch(void* const* d_in, const int* in_sizes, int n_in, void* d_out, int out_size, void* d_ws, size_t ws_size, hipStream_t stream) {
    static int grid = 0;
    if (grid == 0) {
        if (n_in != 38 || out_size != NT * DM || ws_size < WS_END) { fprintf(stderr, "kernel_launch: unexpected shapes n_in %d out %d ws %zu\n", n_in, out_size, ws_size); grid = -1; return; }
        int dev = 0, cus = 0, per_cu = 0;
        hipGetDevice(&dev); hipDeviceGetAttribute(&cus, hipDeviceAttributeMultiprocessorCount, dev);
        if (hipFuncSetAttribute((const void*)enc_fwd, hipFuncAttributeMaxDynamicSharedMemorySize, LDS_BYTES) != hipSuccess) { fprintf(stderr, "kernel_launch: hipFuncSetAttribute failed\n"); grid = -1; return; }
        if (hipOccupancyMaxActiveBlocksPerMultiprocessor(&per_cu, (const void*)enc_fwd, NTHR, LDS_BYTES) != hipSuccess || per_cu < 1) { fprintf(stderr, "kernel_launch: occupancy query failed (%d)\n", per_cu); per_cu = 1; }
        (void)hipGetLastError();
        grid = cus * 1;
    }
    if (grid < 0) return;
    Args a{};
    for (int i = 0; i < 38; ++i) a.in[i] = (const float*)d_in[i];
    a.out = (float*)d_out; a.ws = (unsigned char*)d_ws;
    for (int d = 0; d < 32; ++d) a.inv_rev[d] = pow(10000.0, -(double)d / 32.0) / 6.283185307179586476925286766559;
#if MK_SPLIT
    for (int ph = 0; ph < 9; ++ph) { a.ph_lo = ph; a.ph_hi = ph + 1; void* kargs[] = {&a};
        hipError_t e = hipLaunchCooperativeKernel((const void*)enc_fwd, dim3(grid), dim3(NTHR), kargs, LDS_BYTES, stream);
        if (e != hipSuccess) { fprintf(stderr, "launch %d failed: %s\n", ph, hipGetErrorString(e)); break; } }
#else
    a.ph_lo = 0; a.ph_hi = 9;
    void* kargs[] = {&a};
    hipError_t e = hipLaunchCooperativeKernel((const void*)enc_fwd, dim3(grid), dim3(NTHR), kargs, LDS_BYTES, stream);
    if (e != hipSuccess) fprintf(stderr, "cooperative launch failed: %s (grid %d)\n", hipGetErrorString(e), grid);
#endif
}
```

```cpp
#include <hip/hip_runtime.h>
#include <hip/hip_cooperative_groups.h>
#include <cstdio>
#include <cstdint>
#include <cmath>
namespace cg = cooperative_groups;

#define LAS __attribute__((address_space(3)))
typedef unsigned short bf16_t;
typedef short bf16x8 __attribute__((ext_vector_type(8)));
typedef short s16x4 __attribute__((ext_vector_type(4)));
typedef float f32x2 __attribute__((ext_vector_type(2)));
typedef float f32x4 __attribute__((ext_vector_type(4)));
typedef float f32x16 __attribute__((ext_vector_type(16)));
typedef unsigned u32x2 __attribute__((ext_vector_type(2)));
typedef unsigned u32x4 __attribute__((ext_vector_type(4)));

constexpr int NT = 49152, DM = 2048, TP = 16384, TS = 8192, NSEQ = 5;
constexpr int ZRP = 3584;
constexpr int DFF = 5632;
constexpr int NTHR = 512;
constexpr size_t MiB = 1u << 20;
constexpr size_t WS_CTL = 0, WS_WIN = 1 * MiB, WS_WG = 31 * MiB, WS_WKV = 55 * MiB, WS_PAR = 63 * MiB, WS_PM2 = 71 * MiB, WS_WO = 79 * MiB,
                 WS_WUP = 87 * MiB, WS_WDN = 131 * MiB, WS_ROPE = 153 * MiB, WS_MEMN = 157 * MiB, WS_KVM = 162 * MiB, WS_BON = 167 * MiB,
                 WS_H = 176 * MiB, WS_QK = 370 * MiB, WS_VM = 562 * MiB, WS_Y = 754 * MiB, WS_ACT = 370 * MiB, WS_MRG = 754 * MiB, WS_END = 946 * MiB;
constexpr int CW_QUEUE = 64, CW_LAM = 128;
constexpr int LDS_XCH = 131072, LDS_MISC = 131072 + 8192, LDS_BYTES = 131072 + 8192 + 256;

__device__ __forceinline__ int seq_start(int s) { return s == 0 ? 0 : TP + (s - 1) * TS; }
__device__ __forceinline__ int seq_len(int s) { return s == 0 ? TP : TS; }
__device__ __forceinline__ int tok_pos(int tok) { return tok < TP ? tok : ((tok - TP) & (TS - 1)); }

__device__ __forceinline__ unsigned cvt_pk_bf16(float lo, float hi) { unsigned r; asm volatile("v_cvt_pk_bf16_f32 %0, %1, %2" : "=v"(r) : "v"(lo), "v"(hi)); return r; }
__device__ __forceinline__ float bflo(unsigned w) { return __uint_as_float(w << 16); }
__device__ __forceinline__ float bfhi(unsigned w) { return __uint_as_float(w & 0xffff0000u); }
__device__ __forceinline__ float bf1(bf16_t b) { return __uint_as_float((unsigned)b << 16); }
__device__ __forceinline__ float sigmoidf_(float x) { return 1.f / (1.f + __expf(-x)); }
__device__ __forceinline__ float wave_sum(float v) {
#pragma unroll
    for (int o = 1; o < 64; o <<= 1) v += __shfl_xor(v, o);
    return v;
}

namespace pg8 {
constexpr int BM = 256, BK = 64, HALF = 128, HTB = HALF * BK * 2, STAGE_BYTES = 8 * HTB;
__host__ __device__ __forceinline__ int lds_byte(int r, int c) { const int st = (r >> 4) * 2 + (c >> 5), rr = r & 15, cc = c & 31, ob = rr * 64 + cc * 2; return st * 1024 + (ob ^ (((ob >> 9) & 1) << 5)); }
__host__ __device__ __forceinline__ void stage_rc(int b, int& R, int& C) { const int st = b / 1024, sb = b % 1024, swz = sb ^ (((sb >> 9) & 1) << 5); R = (st >> 1) * 16 + swz / 64; C = (st & 1) * 32 + (swz % 64) / 2; }
__host__ __device__ __forceinline__ int perm32(int rho) { const int n = rho >> 4, i = rho & 15; return 8 * (i >> 2) + 4 * n + (i & 3); }

struct Unit { const char* A; const char* B; int nt, pm, pn, kind, t0, T; };

template <class Epi, class Sched, bool ALIGN_EPI>
__device__ __forceinline__ void gemm_phase(LAS unsigned char* lds, const int ld, const Sched& S, const Epi& E) {
    const int tid = threadIdx.x, wid = __builtin_amdgcn_readfirstlane(tid >> 6), lane = tid & 63, wr = wid >> 2, wc = wid & 3, fr = lane & 15, fq = lane >> 4;
    unsigned voffA[2], voffB[2];
#pragma unroll
    for (int i = 0; i < 2; ++i) { int R, C; stage_rc(tid * 16 + i * 8192, R, C); const int Rb = (R & ~31) + perm32(R & 31);
        voffA[i] = (unsigned)(R * ld + C) * 2u; voffB[i] = (unsigned)(Rb * ld + C) * 2u; }
    const size_t kstep = (size_t)(BK * 2);
    const size_t hstep = (size_t)HALF * ld * 2;
    const unsigned ldsw = (unsigned)wid * 1024u;
    const int aoff = lds_byte(wr * 64 + fr, fq * 8), boff = lds_byte(wc * 32 + fr, fq * 8);
#define PG8_SA(b, h) (((b) * 2 + (h)) * HTB)
#define PG8_SB(b, h) ((4 + (b) * 2 + (h)) * HTB)
#define PG8_STAGE(bufoff, gbase, voff) do { _Pragma("unroll") for (int _i = 0; _i < 2; ++_i) \
        __builtin_amdgcn_global_load_lds((const unsigned*)((const char*)(gbase) + (voff)[_i]), (LAS unsigned*)(lds + (bufoff) + ldsw + _i * 8192), 16, 0, 0); } while (0)
#define PG8_LDA(dst, b, h) do { _Pragma("unroll") for (int m = 0; m < 4; ++m) _Pragma("unroll") for (int k = 0; k < 2; ++k) dst[m][k] = *(const LAS bf16x8*)(lds + PG8_SA(b, h) + aoff + m * 2048 + k * 1024); } while (0)
#define PG8_LDB(dst, b, h) do { _Pragma("unroll") for (int n = 0; n < 2; ++n) _Pragma("unroll") for (int k = 0; k < 2; ++k) dst[n][k] = *(const LAS bf16x8*)(lds + PG8_SB(b, h) + boff + n * 2048 + k * 1024); } while (0)
#define PG8_MMA(ai, bj, At, Bt) do { __builtin_amdgcn_s_setprio(1); _Pragma("unroll") for (int m = 0; m < 4; ++m) _Pragma("unroll") for (int n = 0; n < 2; ++n) _Pragma("unroll") for (int k = 0; k < 2; ++k) \
        acc[ai][bj][m][n] = __builtin_amdgcn_mfma_f32_16x16x32_bf16(Bt[n][k], At[m][k], acc[ai][bj][m][n], 0, 0, 0); __builtin_amdgcn_s_setprio(0); } while (0)
#define PG8_WAIT_V(n) asm volatile("s_waitcnt vmcnt(" #n ")" ::: "memory")
#define PG8_WAIT_L(n) asm volatile("s_waitcnt lgkmcnt(" #n ")" ::: "memory")
#define PG8_BAR __builtin_amdgcn_s_barrier()
#define PG8_SCHED __builtin_amdgcn_sched_barrier(0)
    Unit cur, nxt; int ui = 0;
    if (!S.next(0, cur)) return;
    f32x4 acc[2][2][4][2];
#pragma unroll
    for (int a = 0; a < 2; ++a)
#pragma unroll
        for (int b = 0; b < 2; ++b)
#pragma unroll
            for (int m = 0; m < 4; ++m)
#pragma unroll
                for (int n = 0; n < 2; ++n) acc[a][b][m][n] = (f32x4){0.f, 0.f, 0.f, 0.f};
    bf16x8 At[4][2], B0[2][2], B1[2][2];
    const char* cA = cur.A; const char* cB = cur.B;
    PG8_STAGE(PG8_SB(0, 0), cB, voffB); PG8_STAGE(PG8_SB(0, 1), cB + hstep, voffB); PG8_STAGE(PG8_SA(0, 0), cA, voffA); PG8_STAGE(PG8_SA(0, 1), cA + hstep, voffA);
    if (wr == 1) PG8_BAR;
    PG8_WAIT_V(2); PG8_BAR;
    PG8_STAGE(PG8_SB(1, 0), cB + kstep, voffB); PG8_STAGE(PG8_SA(1, 0), cA + kstep, voffA); PG8_STAGE(PG8_SB(1, 1), cB + hstep + kstep, voffB);
    PG8_WAIT_V(6); PG8_BAR;
    for (;;) {
        const bool has_next = S.next(ui + 1, nxt);
        const char* nA = has_next ? nxt.A : cA; const char* nB = has_next ? nxt.B : cB;
        const int nt = cur.nt;
        for (int t = 0; t < nt; t += 2) {
            const bool last = (t == nt - 2);
            const char* a1 = cA + (size_t)(t + 1) * kstep;
            const char* a2 = last ? nA : cA + (size_t)(t + 2) * kstep; const char* b2 = last ? nB : cB + (size_t)(t + 2) * kstep;
            const char* a3 = a2 + kstep; const char* b3 = b2 + kstep;
            PG8_LDB(B0, 0, 0); PG8_LDB(B1, 0, 1); PG8_SCHED; PG8_LDA(At, 0, 0); PG8_STAGE(PG8_SA(1, 1), a1 + hstep, voffA);
            PG8_WAIT_V(8); PG8_WAIT_L(0); PG8_BAR; PG8_MMA(0, 0, At, B0); PG8_MMA(0, 1, At, B1); PG8_BAR; PG8_SCHED;
            PG8_LDA(At, 0, 1); PG8_STAGE(PG8_SB(0, 0), b2, voffB); PG8_STAGE(PG8_SB(0, 1), b2 + hstep, voffB); PG8_STAGE(PG8_SA(0, 0), a2, voffA);
            PG8_WAIT_V(8); PG8_WAIT_L(0); PG8_BAR; PG8_MMA(1, 0, At, B0); PG8_MMA(1, 1, At, B1); PG8_BAR; PG8_SCHED;
            PG8_LDB(B0, 1, 0); PG8_LDB(B1, 1, 1); PG8_SCHED; PG8_LDA(At, 1, 0); PG8_STAGE(PG8_SA(0, 1), a2 + hstep, voffA);
            PG8_WAIT_V(8); PG8_WAIT_L(0); PG8_BAR; PG8_MMA(0, 0, At, B0); PG8_MMA(0, 1, At, B1); PG8_BAR; PG8_SCHED;
            PG8_LDA(At, 1, 1); PG8_STAGE(PG8_SB(1, 0), b3, voffB); PG8_STAGE(PG8_SB(1, 1), b3 + hstep, voffB); PG8_STAGE(PG8_SA(1, 0), a3, voffA);
            PG8_WAIT_V(8); PG8_WAIT_L(0); PG8_BAR; PG8_MMA(1, 0, At, B0); PG8_MMA(1, 1, At, B1); PG8_BAR; PG8_SCHED;
        }
        if constexpr (ALIGN_EPI) { if (wr == 0) PG8_BAR; }
        E(acc, cur, wr, wc, fr, fq);
        if (!has_next) break;
#pragma unroll
        for (int a = 0; a < 2; ++a)
#pragma unroll
            for (int b = 0; b < 2; ++b)
#pragma unroll
                for (int m = 0; m < 4; ++m)
#pragma unroll
                    for (int n = 0; n < 2; ++n) acc[a][b][m][n] = (f32x4){0.f, 0.f, 0.f, 0.f};
        cur = nxt; cA = nA; cB = nB; ++ui;
        if constexpr (ALIGN_EPI) { if (wr == 1) PG8_BAR; }
    }
    PG8_WAIT_V(0);
    if constexpr (!ALIGN_EPI) { if (wr == 0) PG8_BAR; }
    PG8_BAR;
#undef PG8_SA
#undef PG8_SB
#undef PG8_STAGE
#undef PG8_LDA
#undef PG8_LDB
#undef PG8_MMA
#undef PG8_WAIT_V
#undef PG8_WAIT_L
#undef PG8_BAR
#undef PG8_SCHED
}
}
using pg8::Unit;

struct TileMap {
    int nM, nN;
    __device__ __forceinline__ bool get(long L, int& pm, int& pn) const {
        if (L >= (long)nM * nN) return false;
        const int nig = 16 * nN, gid = (int)(L / nig), fm = gid * 16, gsz = (nM - fm) < 16 ? (nM - fm) : 16, r = (int)(L % nig);
        pm = fm + r % gsz; pn = r / gsz; return true;
    }
};

struct Args {
    const float* in[38];
    float* out; unsigned char* ws;
    double inv_rev[32];
    int ph_lo, ph_hi;
};

__device__ __forceinline__ void tr_item(const float* W, int N, int src_n0, bf16_t* WT, size_t ldw, int koff, int r0, int k0, LAS float* scr, int lane) {
    if (src_n0 >= 0) {
#pragma unroll 8
        for (int i = 0; i < 32; ++i) { const int kk = 2 * i + (lane >> 5); scr[kk * 33 + (lane & 31)] = W[(size_t)(k0 + kk) * N + src_n0 + (lane & 31)]; }
    } else {
#pragma unroll 8
        for (int i = 0; i < 32; ++i) { const int kk = 2 * i + (lane >> 5); scr[kk * 33 + (lane & 31)] = 0.f; }
    }
    asm volatile("s_waitcnt lgkmcnt(0)" ::: "memory");
    const int c = lane & 7;
#pragma unroll
    for (int j = 0; j < 4; ++j) { const int n = (lane >> 3) + 8 * j; const LAS float* s = scr + (8 * c) * 33 + n;
        u32x4 o; o.x = cvt_pk_bf16(s[0 * 33], s[1 * 33]); o.y = cvt_pk_bf16(s[2 * 33], s[3 * 33]); o.z = cvt_pk_bf16(s[4 * 33], s[5 * 33]); o.w = cvt_pk_bf16(s[6 * 33], s[7 * 33]);
        *(u32x4*)(WT + (size_t)(r0 + n) * ldw + koff + k0 + 8 * c) = o; }
    asm volatile("s_waitcnt lgkmcnt(0)" ::: "memory");
}
__device__ __forceinline__ void rms_row(const float* xrow, const float* g, bf16_t* orow, int lane) {
    f32x4 v[8]; float s = 0.f;
#pragma unroll
    for (int j = 0; j < 8; ++j) { v[j] = ((const f32x4*)xrow)[64 * j + lane]; s += (v[j].x * v[j].x + v[j].y * v[j].y) + (v[j].z * v[j].z + v[j].w * v[j].w); }
    const float rstd = rsqrtf(wave_sum(s) * (1.f / DM) + 1e-6f);
#pragma unroll
    for (int j = 0; j < 8; ++j) { const f32x4 gg = ((const f32x4*)g)[64 * j + lane];
        u32x2 w; w.x = cvt_pk_bf16(v[j].x * rstd * gg.x, v[j].y * rstd * gg.y); w.y = cvt_pk_bf16(v[j].z * rstd * gg.z, v[j].w * rstd * gg.w);
        ((u32x2*)orow)[64 * j + lane] = w; }
}

__device__ __forceinline__ void p0_prologue(const Args& a, LAS unsigned char* lds, int vcu, int G) {
    const int tid = threadIdx.x, lane = tid & 63, wave = tid >> 6;
    unsigned char* ws = a.ws;
    LAS float* scr = (LAS float*)(lds + wave * 16384);
    const int gw = vcu * 8 + wave, NGW = G * 8;
    constexpr int I0 = 32 * 240, I1 = 32 * 192, I2 = 32 * 64, I3 = 16 * 64, I6 = 32 * 64, I7 = 32 * 352, I8 = 88 * 64;
    constexpr int NITEMS = I0 + I1 + I2 + 3 * I3 + I6 + I7 + I8;
    for (int it = gw; it < NITEMS; it += NGW) {
        int r = it;
        if (r < I0) { const int kb = r / 240, nb = r % 240, r0 = nb * 32; int src;
            if (r0 < 2048) { const int tile = r0 >> 8, cp = r0 & 255, h = cp >> 7, g = (cp & 127) >> 5; src = tile * 256 + 64 * g + 32 * h; }
            else if (r0 < 6560) src = r0;
            else if (r0 < 6656) src = -1;
            else src = 6560 + (r0 - 6656);
            tr_item(a.in[5], 13728, src, (bf16_t*)(ws + WS_WIN), 2048, 0, r0, kb * 64, scr, lane); continue; } r -= I0;
        if (r < I1) { const int kb = r / 192, nb = r % 192; tr_item(a.in[5], 13728, 7584 + nb * 32, (bf16_t*)(ws + WS_WG), 2048, 0, nb * 32, kb * 64, scr, lane); continue; } r -= I1;
        if (r < I2) { const int kb = r / 64, nb = r % 64; tr_item(a.in[26], 2048, nb * 32, (bf16_t*)(ws + WS_WKV), 2048, 0, nb * 32, kb * 64, scr, lane); continue; } r -= I2;
        if (r < I3) { const int kb = r / 64, nb = r % 64; tr_item(a.in[29], 2048, nb * 32, (bf16_t*)(ws + WS_PAR), 2048, 0, nb * 32, kb * 64, scr, lane); continue; } r -= I3;
        if (r < I3) { const int kb = r / 64, nb = r % 64; tr_item(a.in[30], 2048, nb * 32, (bf16_t*)(ws + WS_PAR), 2048, 1024, nb * 32, kb * 64, scr, lane); continue; } r -= I3;
        if (r < I3) { const int kb = r / 64, nb = r % 64; tr_item(a.in[31], 2048, nb * 32, (bf16_t*)(ws + WS_PM2), 2048, 0, nb * 32, kb * 64, scr, lane); continue; } r -= I3;
        if (r < I6) { const int kb = r / 64, nb = r % 64; tr_item(a.in[32], 2048, nb * 32, (bf16_t*)(ws + WS_WO), 2048, 0, nb * 32, kb * 64, scr, lane); continue; } r -= I6;
        if (r < I7) { const int kb = r / 352, nb = r % 352, r0 = nb * 32, tile = r0 >> 8, bj = (r0 & 255) >> 7, j = r0 & 127;
            tr_item(a.in[34], 2 * DFF, bj * DFF + 128 * tile + j, (bf16_t*)(ws + WS_WUP), 2048, 0, r0, kb * 64, scr, lane); continue; } r -= I7;
        { const int kb = r / 64, nb = r % 64; tr_item(a.in[37], 2048, nb * 32, (bf16_t*)(ws + WS_WDN), DFF, 0, nb * 32, kb * 64, scr, lane); }
    }
    for (int m = gw; m < NT + 1280; m += NGW) {
        if (m < NT) { const float* xr = m < TP ? a.in[0] + (size_t)m * DM : a.in[1] + (size_t)(m - TP) * DM; rms_row(xr, a.in[4], (bf16_t*)(ws + WS_H) + (size_t)m * DM, lane); }
        else { const int j = m - NT; const float* xr = j < 256 ? a.in[2] + (size_t)j * DM : a.in[3] + (size_t)(j - 256) * DM; rms_row(xr, a.in[25], (bf16_t*)(ws + WS_MEMN) + (size_t)j * DM, lane); }
    }
    { float* rc = (float*)(ws + WS_ROPE); float* rs = rc + TP * 32;
      for (int e = (vcu * NTHR + tid); e < TP * 32; e += G * NTHR) { const int t = e >> 5, d = e & 31; double rev = (double)t * a.inv_rev[d]; rev -= rint(rev); const float rf = (float)rev;
          rc[e] = __builtin_amdgcn_cosf(rf); rs[e] = __builtin_amdgcn_sinf(rf); } }
    if (blockIdx.x == 0) {
        unsigned* ctl = (unsigned*)(ws + WS_CTL);
        if (tid < 64) {
            if (tid == 0) { ctl[CW_QUEUE] = 0u; ctl[256] = 0u; ctl[257] = 0u; }
            const float s1 = wave_sum(a.in[8][tid] * a.in[9][tid]), s2 = wave_sum(a.in[10][tid] * a.in[11][tid]);
            if (tid == 0) ((float*)ctl)[CW_LAM] = __expf(s1) - __expf(s2) + 0.2f;
        }
    }
}

struct SchedIn {
    int v, G; const char* H; const char* WIN; const char* MEMN; const char* WKV;
    __device__ __forceinline__ bool next(int i, Unit& u) const {
        long L = (long)i * G + v; int pm, pn;
        if (L < 5760) { TileMap{192, 30}.get(L, pm, pn); u.A = H + (size_t)pm * MiB; u.B = WIN + (size_t)pn * MiB; u.nt = 32; u.pm = pm; u.pn = pn; u.kind = 0; u.t0 = 0; u.T = 0; return true; }
        L -= 5760; if (L < 40) { pm = (int)(L % 5); pn = (int)(L / 5); u.A = MEMN + (size_t)pm * MiB; u.B = WKV + (size_t)pn * MiB; u.nt = 32; u.pm = pm; u.pn = pn; u.kind = 1; u.t0 = 0; u.T = 0; return true; }
        return false;
    }
};
struct EpiIn {
    bf16_t* QK; bf16_t* VM; bf16_t* ZR; bf16_t* KVM; const float* qn; const float* kn; const float* rc; const float* rs;
    __device__ __forceinline__ void plain(const f32x4 (&acc)[2][2][4][2], bf16_t* base, size_t ldc, int row0, int col0) const {
#pragma unroll
        for (int ai = 0; ai < 2; ++ai)
#pragma unroll
            for (int m = 0; m < 4; ++m) { bf16_t* rowp = base + (size_t)(row0 + ai * 128 + m * 16) * ldc + col0;
#pragma unroll
                for (int bj = 0; bj < 2; ++bj) { const f32x4 v0 = acc[ai][bj][m][0], v1 = acc[ai][bj][m][1];
                    u32x4 w; w.x = cvt_pk_bf16(v0[0], v0[1]); w.y = cvt_pk_bf16(v0[2], v0[3]); w.z = cvt_pk_bf16(v1[0], v1[1]); w.w = cvt_pk_bf16(v1[2], v1[3]);
                    *(u32x4*)(rowp + bj * 128) = w; } }
    }
    __device__ __forceinline__ void operator()(const f32x4 (&acc)[2][2][4][2], const Unit& u, int wr, int wc, int fr, int fq) const {
        const int row0 = u.pm * 256 + wr * 64 + fr, cin = wc * 32 + 8 * fq;
        if (u.kind == 1) { plain(acc, KVM, 2048, row0, u.pn * 256 + cin); return; }
        const int pn = u.pn;
        if (pn < 8) {
            const bool isq = pn < 4; const float* nw = isq ? qn : kn;
            const int Gq = (pn & 3) * 4 + wc, d0 = 8 * fq;
            const float qs = isq ? 0.125f * 1.4426950408889634f : 1.f;
            const f32x4 w1a = *(const f32x4*)(nw + d0), w1b = *(const f32x4*)(nw + d0 + 4), w2a = *(const f32x4*)(nw + 32 + d0), w2b = *(const f32x4*)(nw + 36 + d0);
            bf16_t* dst = QK + (isq ? 0 : 1024) + Gq * 64 + d0;
#pragma unroll
            for (int ai = 0; ai < 2; ++ai)
#pragma unroll
                for (int m = 0; m < 4; ++m) {
                    const int row = row0 + ai * 128 + m * 16, t = tok_pos(row);
                    const f32x4 xa = acc[ai][0][m][0], xb = acc[ai][0][m][1], ya = acc[ai][1][m][0], yb = acc[ai][1][m][1];
                    float ss = (xa[0] * xa[0] + xa[1] * xa[1]) + (xa[2] * xa[2] + xa[3] * xa[3]) + (xb[0] * xb[0] + xb[1] * xb[1]) + (xb[2] * xb[2] + xb[3] * xb[3])
                             + (ya[0] * ya[0] + ya[1] * ya[1]) + (ya[2] * ya[2] + ya[3] * ya[3]) + (yb[0] * yb[0] + yb[1] * yb[1]) + (yb[2] * yb[2] + yb[3] * yb[3]);
                    ss += __shfl_xor(ss, 16); ss += __shfl_xor(ss, 32);
                    const float rstd = rsqrtf(ss * (1.f / 64.f) + 1e-6f);
                    const f32x4 ca = *(const f32x4*)(rc + t * 32 + d0), cb = *(const f32x4*)(rc + t * 32 + d0 + 4), sa = *(const f32x4*)(rs + t * 32 + d0), sb = *(const f32x4*)(rs + t * 32 + d0 + 4);
                    const f32x4 x1a = xa * rstd * w1a, x1b = xb * rstd * w1b, x2a = ya * rstd * w2a, x2b = yb * rstd * w2b;
                    const f32x4 o1a = (x1a * ca - x2a * sa) * qs, o1b = (x1b * cb - x2b * sb) * qs, o2a = (x2a * ca + x1a * sa) * qs, o2b = (x2b * cb + x1b * sb) * qs;
                    u32x4 w; w.x = cvt_pk_bf16(o1a[0], o1a[1]); w.y = cvt_pk_bf16(o1a[2], o1a[3]); w.z = cvt_pk_bf16(o1b[0], o1b[1]); w.w = cvt_pk_bf16(o1b[2], o1b[3]);
                    *(u32x4*)(dst + (size_t)row * 2048) = w;
                    w.x = cvt_pk_bf16(o2a[0], o2a[1]); w.y = cvt_pk_bf16(o2a[2], o2a[3]); w.z = cvt_pk_bf16(o2b[0], o2b[1]); w.w = cvt_pk_bf16(o2b[2], o2b[3]);
                    *(u32x4*)(dst + (size_t)row * 2048 + 32) = w;
                }
        } else if (pn < 12) plain(acc, VM, 2048, row0, (pn - 8) * 256 + cin);
        else if (pn < 26) plain(acc, ZR, ZRP, row0, (pn - 12) * 256 + cin);
        else plain(acc, VM, 2048, row0, 1024 + (pn - 26) * 256 + cin);
    }
};

namespace att {
constexpr int SHM_V = 16384, SHM_K = 8192;
constexpr int OFF_V = 0, OFF_K = 32768, OFF_WS = 49152, OFF_STASH = 51200;
#define KSWZ64(row, colB) ((row) * 128 + ((colB) ^ (((row) & 7) << 4)))
#define SBAR() __builtin_amdgcn_sched_barrier(0)
__device__ __forceinline__ int crow(int r, int hi) { return (r & 3) + 8 * (r >> 2) + 4 * hi; }
constexpr float THRL = 8.f;
__device__ __forceinline__ void partialSM(f32x16& p0, f32x16& p1, float& m_reg, float& alpha) {
    float pmax = fmaxf(fmaxf(p0[0], p0[1]), p0[2]);
#pragma unroll
    for (int r = 3; r < 15; r += 2) pmax = fmaxf(fmaxf(pmax, p0[r]), p0[r + 1]);
    pmax = fmaxf(fmaxf(pmax, p0[15]), p1[0]);
#pragma unroll
    for (int r = 1; r < 15; r += 2) pmax = fmaxf(fmaxf(pmax, p1[r]), p1[r + 1]);
    pmax = fmaxf(pmax, p1[15]);
    { auto rr = __builtin_amdgcn_permlane32_swap(__float_as_uint(pmax), __float_as_uint(pmax), false, false);
      pmax = fmaxf(__uint_as_float(rr[0]), __uint_as_float(rr[1])); }
    if (__builtin_expect(__all(pmax <= THRL), 1)) { alpha = 1.f; }
    else { const float dl = fmaxf(pmax, 0.f); alpha = __builtin_amdgcn_exp2f(-dl); m_reg += dl;
#pragma unroll
        for (int r = 0; r < 16; ++r) { p0[r] -= dl; p1[r] -= dl; } }
#pragma unroll
    for (int r = 0; r < 16; ++r) p0[r] = __builtin_amdgcn_exp2f(p0[r]);
}
__device__ __forceinline__ void finishSM(f32x16& p0, f32x16& p1, float alpha, float& l_reg, bf16x8& pa0, bf16x8& pa1, bf16x8& pa2, bf16x8& pa3) {
#pragma unroll
    for (int r = 0; r < 16; ++r) p1[r] = __builtin_amdgcn_exp2f(p1[r]);
    f32x2 s2 = (f32x2){p0[0], p0[1]} + (f32x2){p1[0], p1[1]};
#pragma unroll
    for (int r = 2; r < 16; r += 2) { s2 = s2 + (f32x2){p0[r], p0[r + 1]}; s2 = s2 + (f32x2){p1[r], p1[r + 1]}; }
    float ps = s2[0] + s2[1];
    { auto rr = __builtin_amdgcn_permlane32_swap(__float_as_uint(ps), __float_as_uint(ps), false, false);
      ps = __uint_as_float(rr[0]) + __uint_as_float(rr[1]); }
    l_reg = l_reg * alpha + ps;
#define PK4(P, BASE, OUT) do { unsigned a0 = cvt_pk_bf16(P[BASE + 0], P[BASE + 1]), a1 = cvt_pk_bf16(P[BASE + 2], P[BASE + 3]);   \
    unsigned b0 = cvt_pk_bf16(P[BASE + 4], P[BASE + 5]), b1 = cvt_pk_bf16(P[BASE + 6], P[BASE + 7]);                              \
    auto r0 = __builtin_amdgcn_permlane32_swap(a0, b0, false, false); auto r1 = __builtin_amdgcn_permlane32_swap(a1, b1, false, false); \
    u32x4 w = {r0[0], r1[0], r0[1], r1[1]}; OUT = *reinterpret_cast<bf16x8*>(&w); } while (0)
    PK4(p0, 0, pa0); PK4(p0, 8, pa1); PK4(p1, 0, pa2); PK4(p1, 8, pa3);
#undef PK4
}
__device__ __forceinline__ void qkt64(f32x16& p0, f32x16& p1, const char* Ks, const bf16x8* qr, int r32, int hi) {
#pragma unroll
    for (int d0 = 0; d0 < 4; ++d0) { const int cb = (d0 * 16 + hi * 8) * 2;
        const bf16x8 b0 = *reinterpret_cast<const bf16x8*>(Ks + KSWZ64(r32, cb));
        const bf16x8 b1 = *reinterpret_cast<const bf16x8*>(Ks + KSWZ64(32 + r32, cb));
        p0 = __builtin_amdgcn_mfma_f32_32x32x16_bf16(b0, qr[d0], p0, 0, 0, 0);
        p1 = __builtin_amdgcn_mfma_f32_32x32x16_bf16(b1, qr[d0], p1, 0, 0, 0); }
}
__device__ __forceinline__ int v_st(int k, int c) { const int kk = (k & ~0xC) | ((k & 4) << 1) | ((k & 8) >> 1); return ((kk >> 3) * 4 + (c >> 5)) * 512 + ((kk & 7) * 32 + (c & 31)) * 2; }
__device__ __forceinline__ int v_rd_base(int lane) { return ((lane & 3) << 3) | (((lane >> 2) & 3) << 6) | (((lane >> 4) & 1) << 5) | (((lane >> 5) & 1) << 8); }
constexpr int v_rd_off(int d0, int ks, int half) { return d0 * 512 + ks * 4096 + half * 2048; }
template <int OFF> __device__ __forceinline__ s16x4 tr_read(int vb) {
    s16x4 r; asm volatile("ds_read_b64_tr_b16 %0, %1 offset:%2" : "=&v"(r) : "v"(vb), "i"(OFF) : "memory"); return r;
}
template <int D0> __device__ __forceinline__ void pv_one(f32x16& od, int vb, bf16x8 pa0, bf16x8 pa1, bf16x8 pa2, bf16x8 pa3) {
    const s16x4 l0 = tr_read<v_rd_off(D0, 0, 0)>(vb), h0 = tr_read<v_rd_off(D0, 0, 1)>(vb), l1 = tr_read<v_rd_off(D0, 1, 0)>(vb), h1 = tr_read<v_rd_off(D0, 1, 1)>(vb);
    const s16x4 l2 = tr_read<v_rd_off(D0, 2, 0)>(vb), h2 = tr_read<v_rd_off(D0, 2, 1)>(vb), l3 = tr_read<v_rd_off(D0, 3, 0)>(vb), h3 = tr_read<v_rd_off(D0, 3, 1)>(vb);
    asm volatile("s_waitcnt lgkmcnt(0)" ::: "memory"); SBAR();
#define PK(L, H) (bf16x8){L[0], L[1], L[2], L[3], H[0], H[1], H[2], H[3]}
    od = __builtin_amdgcn_mfma_f32_32x32x16_bf16(pa0, PK(l0, h0), od, 0, 0, 0);
    od = __builtin_amdgcn_mfma_f32_32x32x16_bf16(pa1, PK(l1, h1), od, 0, 0, 0);
    od = __builtin_amdgcn_mfma_f32_32x32x16_bf16(pa2, PK(l2, h2), od, 0, 0, 0);
    od = __builtin_amdgcn_mfma_f32_32x32x16_bf16(pa3, PK(l3, h3), od, 0, 0, 0);
#undef PK
}
__device__ __forceinline__ void pv_d0(f32x16* o, int vb, bf16x8 pa0, bf16x8 pa1, bf16x8 pa2, bf16x8 pa3) {
    pv_one<0>(o[0], vb, pa0, pa1, pa2, pa3); pv_one<1>(o[1], vb, pa0, pa1, pa2, pa3); pv_one<2>(o[2], vb, pa0, pa1, pa2, pa3); pv_one<3>(o[3], vb, pa0, pa1, pa2, pa3);
}

__device__ __forceinline__ void stash_store(const unsigned* stash, bf16_t* Ow, int ldo, int lane) {
#pragma unroll
    for (int i = 0; i < 8; ++i) { const int q = i * 64 + lane, rl = q >> 4, c8 = (q & 15) * 8, hh = (rl >> 2) & 1, r = (rl & 3) + 4 * (rl >> 3), d0 = c8 >> 5, cc = c8 & 31;
        const unsigned* sp = stash + (d0 * 8 + (r >> 1)) * 64 + hh * 32 + cc; const u32x4 a = *(const u32x4*)sp, b = *(const u32x4*)(sp + 4);
        u32x4 w;
        if (r & 1) { w.x = (a.x >> 16) | (a.y & 0xffff0000u); w.y = (a.z >> 16) | (a.w & 0xffff0000u); w.z = (b.x >> 16) | (b.y & 0xffff0000u); w.w = (b.z >> 16) | (b.w & 0xffff0000u); }
        else { w.x = (a.x & 0xffffu) | (a.y << 16); w.y = (a.z & 0xffffu) | (a.w << 16); w.z = (b.x & 0xffffu) | (b.y << 16); w.w = (b.z & 0xffffu) | (b.w << 16); }
        *(u32x4*)(Ow + (size_t)rl * ldo + c8) = w; }
}

__device__ __forceinline__ void diff_unit(int s, int h, int qb, bf16_t* QK, const bf16_t* VM, float lam, char* lds) {
    constexpr int LDK = 2048;
    int tid = threadIdx.x; asm volatile("" : "+v"(tid));
    const int wid = __builtin_amdgcn_readfirstlane(tid >> 6), lane = tid & 63, r32 = lane & 31, hi = lane >> 5;
    const int tok0 = seq_start(s), T = seq_len(s), NTL = T / 64;
    char* V_lds = lds + OFF_V; char* K_lds = lds + OFF_K;
    float* wsf = (float*)(lds + OFF_WS) + wid * 64; float* li_l = wsf; float* al_l = wsf + 32;
    unsigned* stash = (unsigned*)(lds + OFF_STASH) + wid * 2048;
    const int sr = tid >> 4, sc = (tid & 15) * 8, vst0 = v_st(sr, sc), vst1 = v_st(32 + sr, sc);
    const int kr = tid >> 3, kc = (tid & 7) * 8, kst = KSWZ64(kr, kc * 2);
    const int vb0 = (int)(uintptr_t)V_lds + v_rd_base(lane);
    const bf16_t* Vh = VM + (size_t)tok0 * LDK + h * 128;
    const size_t qrow = (size_t)(tok0 + qb * 256 + wid * 32);
#pragma unroll 1
    for (int c = 0; c < 2; ++c) {
        const bf16_t* Kh = QK + (size_t)tok0 * LDK + 1024 + h * 128 + c * 64;
        const bf16_t* Qw = QK + (qrow + r32) * LDK + h * 128 + c * 64 + hi * 8;
        bf16x8 qr[4];
#pragma unroll
        for (int d0 = 0; d0 < 4; ++d0) qr[d0] = *reinterpret_cast<const bf16x8*>(Qw + d0 * 16);
        float m_reg = 0.f, l_reg = 0; f32x16 o[4] = {};
        struct { bf16x8 vs0, vs1, ks0; } sr_[2];
#define NEGM(P) do { const float nm_ = -m_reg; _Pragma("unroll") for (int r_ = 0; r_ < 16; ++r_) P[r_] = nm_; } while (0)
#define SLOAD(i, k0) do { sr_[i].vs0 = *reinterpret_cast<const bf16x8*>(&Vh[(size_t)((k0) + sr) * LDK + sc]); sr_[i].vs1 = *reinterpret_cast<const bf16x8*>(&Vh[(size_t)((k0) + 32 + sr) * LDK + sc]); \
    sr_[i].ks0 = *reinterpret_cast<const bf16x8*>(&Kh[(size_t)((k0) + kr) * LDK + kc]); } while (0)
#define SWRITE(b, i) do { *(bf16x8*)(V_lds + (b) * SHM_V + vst0) = sr_[i].vs0; *(bf16x8*)(V_lds + (b) * SHM_V + vst1) = sr_[i].vs1; *(bf16x8*)(K_lds + (b) * SHM_K + kst) = sr_[i].ks0; } while (0)
#define SWAIT() asm volatile("s_waitcnt vmcnt(3)" ::: "memory")
#define RESC(a) do { if (__any((a) < 1.f)) { if (hi == 0) al_l[r32] = (a); asm volatile("s_waitcnt lgkmcnt(0)" ::: "memory"); \
    _Pragma("unroll") for (int d = 0; d < 4; ++d) _Pragma("unroll") for (int r = 0; r < 16; ++r) o[d][r] *= al_l[crow(r, hi)]; } } while (0)
        f32x16 pA0, pA1, pB0, pB1; float alA, alB; bf16x8 pa0, pa1, pa2, pa3;
        SLOAD(0, 0); asm volatile("s_waitcnt vmcnt(0)" ::: "memory"); SWRITE(0, 0); __syncthreads();
        NEGM(pA0); NEGM(pA1); qkt64(pA0, pA1, K_lds, qr, r32, hi); partialSM(pA0, pA1, m_reg, alA);
        SLOAD(1, 64); if (2 < NTL) SLOAD(0, 128);
        SWAIT(); SWRITE(1, 1); __syncthreads();
        for (int j = 1; j + 1 < NTL; j += 2) {
            SBAR(); NEGM(pB0); NEGM(pB1); qkt64(pB0, pB1, K_lds + SHM_K, qr, r32, hi);
            finishSM(pA0, pA1, alA, l_reg, pa0, pa1, pa2, pa3); SBAR();
            SLOAD(1, (j + 2) * 64); SBAR();
            pv_d0(o, vb0, pa0, pa1, pa2, pa3); partialSM(pB0, pB1, m_reg, alB);
            __syncthreads(); SWAIT(); SWRITE(0, 0);
            RESC(alB); __syncthreads();
            SBAR(); NEGM(pA0); NEGM(pA1); qkt64(pA0, pA1, K_lds, qr, r32, hi);
            finishSM(pB0, pB1, alB, l_reg, pa0, pa1, pa2, pa3); SBAR();
            if (j + 3 < NTL) SLOAD(0, (j + 3) * 64); SBAR();
            pv_d0(o, vb0 + SHM_V, pa0, pa1, pa2, pa3); partialSM(pA0, pA1, m_reg, alA);
            __syncthreads(); SWAIT(); SWRITE(1, 1);
            RESC(alA); __syncthreads();
        }
        SBAR(); NEGM(pB0); NEGM(pB1); qkt64(pB0, pB1, K_lds + SHM_K, qr, r32, hi);
        finishSM(pA0, pA1, alA, l_reg, pa0, pa1, pa2, pa3); SBAR();
        pv_d0(o, vb0, pa0, pa1, pa2, pa3); partialSM(pB0, pB1, m_reg, alB);
        __syncthreads(); RESC(alB);
        finishSM(pB0, pB1, alB, l_reg, pa0, pa1, pa2, pa3); SBAR();
        pv_d0(o, vb0 + SHM_V, pa0, pa1, pa2, pa3);
#undef SLOAD
#undef SWRITE
#undef SWAIT
#undef RESC
#undef NEGM
        if (hi == 0) li_l[r32] = l_reg; asm volatile("s_waitcnt lgkmcnt(0)" ::: "memory");
        float rli[16];
#pragma unroll
        for (int r = 0; r < 16; ++r) rli[r] = __builtin_amdgcn_rcpf(li_l[crow(r, hi)]);
        { const float coef = c == 0 ? 1.f : -lam;
#pragma unroll
          for (int d0 = 0; d0 < 4; ++d0)
#pragma unroll
              for (int r = 0; r < 16; r += 2) { const int idx = (d0 * 8 + (r >> 1)) * 64 + lane; const unsigned w = c == 0 ? 0u : stash[idx];
                  stash[idx] = cvt_pk_bf16(bflo(w) + coef * o[d0][r] * rli[r], bfhi(w) + coef * o[d0][r + 1] * rli[r + 1]); } }
        __syncthreads();
    }
    stash_store(stash, QK + qrow * LDK + h * 128, LDK, lane);
    __syncthreads();
}

constexpr int MOFF_V = 0, MOFF_K = 32768, MOFF_WS = 65536, MOFF_RK = 67584, MOFF_G = 68608, MOFF_STASH = 69632;
__device__ __forceinline__ void mem_unit(int s, int mh, int qb, bf16_t* VM, const bf16_t* KVM, const float* mqn, const float* mkn, char* lds) {
    int tid = threadIdx.x; asm volatile("" : "+v"(tid));
    const int wid = __builtin_amdgcn_readfirstlane(tid >> 6), lane = tid & 63, r32 = lane & 31, hi = lane >> 5;
    const int tok0 = seq_start(s);
    char* V_lds = lds + MOFF_V; char* K_lds = lds + MOFF_K;
    float* wsf = (float*)(lds + MOFF_WS) + wid * 64; float* li_l = wsf; float* al_l = wsf + 32;
    float* rk_l = (float*)(lds + MOFF_RK); float* g_l = (float*)(lds + MOFF_G);
    const bf16_t* Kh = KVM + (size_t)(s * 256) * 2048 + mh * 256;
    const bf16_t* Vh = KVM + (size_t)(s * 256) * 2048 + 1024 + mh * 256;
    if (tid < 256) g_l[tid] = mqn[tid] * mkn[tid];
    {
        const bf16_t* kp = Kh + (size_t)(wid * 32 + r32) * 2048 + hi * 128; float ss = 0.f;
#pragma unroll
        for (int i = 0; i < 16; ++i) { const u32x4 w = *(const u32x4*)(kp + i * 8);
            ss += bflo(w.x) * bflo(w.x) + bfhi(w.x) * bfhi(w.x) + bflo(w.y) * bflo(w.y) + bfhi(w.y) * bfhi(w.y) + bflo(w.z) * bflo(w.z) + bfhi(w.z) * bfhi(w.z) + bflo(w.w) * bflo(w.w) + bfhi(w.w) * bfhi(w.w); }
        ss += __shfl_xor(ss, 32);
        if (hi == 0) rk_l[wid * 32 + r32] = rsqrtf(ss * (1.f / 256.f) + 1e-6f);
    }
    const size_t qrow = (size_t)(tok0 + qb * 256 + wid * 32);
    bf16_t* Qw = VM + (qrow + r32) * 2048 + 1024 + mh * 256 + hi * 8;
    float rqC;
    { float ss = 0.f;
#pragma unroll
      for (int i = 0; i < 16; ++i) { const u32x4 w = *(const u32x4*)(Qw + i * 16);
          ss += bflo(w.x) * bflo(w.x) + bfhi(w.x) * bfhi(w.x) + bflo(w.y) * bflo(w.y) + bfhi(w.y) * bfhi(w.y) + bflo(w.z) * bflo(w.z) + bfhi(w.z) * bfhi(w.z) + bflo(w.w) * bflo(w.w) + bfhi(w.w) * bfhi(w.w); }
      ss += __shfl_xor(ss, 32);
      rqC = rsqrtf(ss * (1.f / 256.f) + 1e-6f) * (0.0625f * 1.4426950408889634f); }
    const int sr = tid >> 4, sc = (tid & 15) * 8, vst0 = v_st(sr, sc), vst1 = v_st(32 + sr, sc);
    const int kr = tid >> 3, kc = (tid & 7) * 8, kst = KSWZ64(kr, kc * 2);
    const int vb0 = (int)(uintptr_t)V_lds + v_rd_base(lane);
    unsigned* stash = (unsigned*)(lds + MOFF_STASH) + wid * 2048;
    __syncthreads();
#pragma unroll 1
    for (int hv = 0; hv < 2; ++hv) {
    float m_reg = -1e30f, l_reg = 0.f; f32x16 o[4] = {};
#pragma unroll 1
    for (int t = 0; t < 4; ++t) {
        const int k0 = t * 64;
#pragma unroll
        for (int ds = 0; ds < 4; ++ds) { const u32x4 w = *(const u32x4*)(Kh + (size_t)(k0 + kr) * 2048 + ds * 64 + kc); const float* g = g_l + ds * 64 + kc;
            u32x4 o4; o4.x = cvt_pk_bf16(bflo(w.x) * g[0], bfhi(w.x) * g[1]); o4.y = cvt_pk_bf16(bflo(w.y) * g[2], bfhi(w.y) * g[3]);
            o4.z = cvt_pk_bf16(bflo(w.z) * g[4], bfhi(w.z) * g[5]); o4.w = cvt_pk_bf16(bflo(w.w) * g[6], bfhi(w.w) * g[7]);
            *(u32x4*)(K_lds + ds * 8192 + kst) = o4; asm volatile("" ::: "memory"); }
        *(u32x4*)(V_lds + vst0) = *(const u32x4*)(Vh + (size_t)(k0 + sr) * 2048 + hv * 128 + sc);
        *(u32x4*)(V_lds + vst1) = *(const u32x4*)(Vh + (size_t)(k0 + 32 + sr) * 2048 + hv * 128 + sc);
        __syncthreads();
        f32x16 p0 = {}, p1 = {};
#pragma unroll
        for (int ds = 0; ds < 4; ++ds) { bf16x8 qr[4];
#pragma unroll
            for (int d0 = 0; d0 < 4; ++d0) qr[d0] = *reinterpret_cast<const bf16x8*>(Qw + ds * 64 + d0 * 16);
            qkt64(p0, p1, K_lds + ds * 8192, qr, r32, hi); }
#pragma unroll
        for (int r = 0; r < 16; ++r) { p0[r] *= rk_l[k0 + crow(r, hi)] * rqC; p1[r] *= rk_l[k0 + 32 + crow(r, hi)] * rqC; }
        float pmax = p0[0];
#pragma unroll
        for (int r = 1; r < 16; ++r) pmax = fmaxf(pmax, p0[r]);
#pragma unroll
        for (int r = 0; r < 16; ++r) pmax = fmaxf(pmax, p1[r]);
        pmax = fmaxf(pmax, __shfl_xor(pmax, 32));
        const float mn = fmaxf(m_reg, pmax), alpha = __builtin_amdgcn_exp2f(m_reg - mn); m_reg = mn;
        float ps = 0.f;
#pragma unroll
        for (int r = 0; r < 16; ++r) { p0[r] = __builtin_amdgcn_exp2f(p0[r] - mn); p1[r] = __builtin_amdgcn_exp2f(p1[r] - mn); ps += p0[r] + p1[r]; }
        ps += __shfl_xor(ps, 32);
        l_reg = l_reg * alpha + ps;
        if (hi == 0) al_l[r32] = alpha; asm volatile("s_waitcnt lgkmcnt(0)" ::: "memory");
#pragma unroll
        for (int d = 0; d < 4; ++d)
#pragma unroll
            for (int r = 0; r < 16; ++r) o[d][r] *= al_l[crow(r, hi)];
        bf16x8 pa0, pa1, pa2, pa3;
#define PK4(P, BASE, OUT) do { unsigned a0 = cvt_pk_bf16(P[BASE + 0], P[BASE + 1]), a1 = cvt_pk_bf16(P[BASE + 2], P[BASE + 3]);   \
    unsigned b0 = cvt_pk_bf16(P[BASE + 4], P[BASE + 5]), b1 = cvt_pk_bf16(P[BASE + 6], P[BASE + 7]);                              \
    auto r0 = __builtin_amdgcn_permlane32_swap(a0, b0, false, false); auto r1 = __builtin_amdgcn_permlane32_swap(a1, b1, false, false); \
    u32x4 w = {r0[0], r1[0], r0[1], r1[1]}; OUT = *reinterpret_cast<bf16x8*>(&w); } while (0)
        PK4(p0, 0, pa0); PK4(p0, 8, pa1); PK4(p1, 0, pa2); PK4(p1, 8, pa3);
#undef PK4
        pv_d0(o, vb0, pa0, pa1, pa2, pa3);
        __syncthreads();
    }
    if (hi == 0) li_l[r32] = l_reg; asm volatile("s_waitcnt lgkmcnt(0)" ::: "memory");
    if (hv == 1) stash_store(stash, VM + qrow * 2048 + 1024 + mh * 256, 2048, lane);
#pragma unroll
    for (int d0 = 0; d0 < 4; ++d0)
#pragma unroll
        for (int r = 0; r < 16; r += 2) stash[(d0 * 8 + (r >> 1)) * 64 + lane] = cvt_pk_bf16(o[d0][r] * __builtin_amdgcn_rcpf(li_l[crow(r, hi)]), o[d0][r + 1] * __builtin_amdgcn_rcpf(li_l[crow(r + 1, hi)]));
    }
    stash_store(stash, VM + qrow * 2048 + 1024 + mh * 256 + 128, 2048, lane);
    __syncthreads();
}
#undef SBAR
}

namespace scan {
constexpr int TC = 32;
constexpr int BUFB = 57344, O_R = 0, O_KD = 8192, O_KK = 16384, O_W = 24576, O_KA = 32768, O_V = 40960, O_Y = 49152;
constexpr int O_PRIV = 114688;
constexpr int O_TBL = 114688 + 8192;
__device__ __forceinline__ float dpp_red8(float x) {
    x += __uint_as_float(__builtin_amdgcn_update_dpp(0u, __float_as_uint(x), 0xB1, 0xf, 0xf, false));
    x += __uint_as_float(__builtin_amdgcn_update_dpp(0u, __float_as_uint(x), 0x4E, 0xf, 0xf, false));
    x += __uint_as_float(__builtin_amdgcn_update_dpp(0u, __float_as_uint(x), 0x141, 0xf, 0xf, false));
    return x;
}
template <int DIR> __device__ __forceinline__ void scan_chunk(const char* B_, f32x2 (&S)[2][4], int seg, int row0) {
    const char* base = B_ + seg * 32; const char* vbase = B_ + O_V + row0 * 4; char* ybase = (char*)B_ + O_Y + row0 * 4;
    f32x4 ck[2][2], cw[2][2], ca[2][2], cd[2][2], cr[2][2]; f32x2 cv[2];
#define LDSET(set, tl_) do { ck[set][0] = *(const f32x4*)(base + O_KK + (tl_) * 256); ck[set][1] = *(const f32x4*)(base + O_KK + (tl_) * 256 + 16); \
    cw[set][0] = *(const f32x4*)(base + O_W + (tl_) * 256); cw[set][1] = *(const f32x4*)(base + O_W + (tl_) * 256 + 16); \
    ca[set][0] = *(const f32x4*)(base + O_KA + (tl_) * 256); ca[set][1] = *(const f32x4*)(base + O_KA + (tl_) * 256 + 16); \
    cd[set][0] = *(const f32x4*)(base + O_KD + (tl_) * 256); cd[set][1] = *(const f32x4*)(base + O_KD + (tl_) * 256 + 16); \
    cr[set][0] = *(const f32x4*)(base + O_R + (tl_) * 256); cr[set][1] = *(const f32x4*)(base + O_R + (tl_) * 256 + 16); \
    cv[set] = *(const f32x2*)(vbase + (tl_) * 256); } while (0)
    LDSET(0, DIR ? TC - 1 : 0);
#pragma unroll
    for (int st = 0; st < TC; ++st) {
        const int tl = DIR ? TC - 1 - st : st, cs = st & 1;
        if (st + 1 < TC) LDSET(cs ^ 1, DIR ? TC - 2 - st : st + 1);
        const f32x2 k0 = {ck[cs][0][0], ck[cs][0][1]}, k1 = {ck[cs][0][2], ck[cs][0][3]}, k2 = {ck[cs][1][0], ck[cs][1][1]}, k3 = {ck[cs][1][2], ck[cs][1][3]};
        const f32x2 w0 = {cw[cs][0][0], cw[cs][0][1]}, w1 = {cw[cs][0][2], cw[cs][0][3]}, w2 = {cw[cs][1][0], cw[cs][1][1]}, w3 = {cw[cs][1][2], cw[cs][1][3]};
        const f32x2 a0 = {ca[cs][0][0], ca[cs][0][1]}, a1 = {ca[cs][0][2], ca[cs][0][3]}, a2 = {ca[cs][1][0], ca[cs][1][1]}, a3 = {ca[cs][1][2], ca[cs][1][3]};
        const f32x2 d0 = {cd[cs][0][0], cd[cs][0][1]}, d1 = {cd[cs][0][2], cd[cs][0][3]}, d2 = {cd[cs][1][0], cd[cs][1][1]}, d3 = {cd[cs][1][2], cd[cs][1][3]};
        const f32x2 r0 = {cr[cs][0][0], cr[cs][0][1]}, r1 = {cr[cs][0][2], cr[cs][0][3]}, r2 = {cr[cs][1][0], cr[cs][1][1]}, r3 = {cr[cs][1][2], cr[cs][1][3]};
        f32x2 yo;
#pragma unroll
        for (int h2 = 0; h2 < 2; ++h2) {
            const f32x2 vv = {cv[cs][h2], cv[cs][h2]};
            f32x2 t2 = S[h2][0] * k0 + S[h2][1] * k1; const f32x2 t3 = S[h2][2] * k2 + S[h2][3] * k3; t2 = t2 + t3;
            const float d = dpp_red8(t2[0] + t2[1]);
            const f32x2 p0 = S[h2][0] * w0 + vv * d0, p1 = S[h2][1] * w1 + vv * d1, p2 = S[h2][2] * w2 + vv * d2, p3 = S[h2][3] * w3 + vv * d3;
            const f32x2 sa = {-d, -d};
            S[h2][0] = p0 + sa * a0; S[h2][1] = p1 + sa * a1; S[h2][2] = p2 + sa * a2; S[h2][3] = p3 + sa * a3;
            f32x2 y2 = S[h2][0] * r0 + S[h2][1] * r1; const f32x2 y3 = S[h2][2] * r2 + S[h2][3] * r3; y2 = y2 + y3;
            yo[h2] = dpp_red8(y2[0] + y2[1]);
        }
        if (seg == 0) *(f32x2*)(ybase + tl * 256) = yo;
    }
#undef LDSET
}
struct P {
    const bf16_t* ZR; bf16_t* YB; float* BON;
    const float *mup, *mun, *w0, *w2, *a0, *a2, *kk_w, *ka_w, *rk_w;
};
__device__ __forceinline__ void job(int s, int dir, int head, const P& p, char* lds) {
    int tid = threadIdx.x; asm volatile("" : "+v"(tid));
    const int wid = __builtin_amdgcn_readfirstlane(tid >> 6), lane = tid & 63;
    const int tok0 = seq_start(s), T = seq_len(s), NCH = T / TC;
    float* TBL = (float*)(lds + O_TBL);
    float* MUP = TBL; float* MUN = TBL + 320; float* KKW = TBL + 640; float* KAW = TBL + 704; float* RKW = TBL + 768; float* BW = TBL + 832; float* BA = TBL + 896;
    __syncthreads();
    if (tid < 320) { const int which = tid >> 6, j = tid & 63; const int col = which < 3 ? which * 1024 + head * 64 + j : (which == 3 ? 3072 : 3200) + dir * 64 + j; MUP[tid] = p.mup[col]; MUN[tid] = p.mun[col]; }
    if (tid >= 320 && tid < 384) { const int j = tid - 320; KKW[j] = p.kk_w[head * 64 + j]; KAW[j] = p.ka_w[head * 64 + j]; RKW[j] = p.rk_w[head * 64 + j];
        BW[j] = p.w0[dir * 1024 + head * 64 + j]; BA[j] = p.a0[dir * 1024 + head * 64 + j]; }
    bf16_t* yb = p.YB + (size_t)dir * NT * 1024; float* bon = p.BON + (size_t)dir * NT * 16;
    if (wid >= 4) {
        const int pw = wid - 4;
        bf16_t* AWl = (bf16_t*)(lds + O_PRIV + pw * 2048); bf16_t* AAl = AWl + 512;
        bf16x8 Bf[2][4][2];
#pragma unroll
        for (int mat = 0; mat < 2; ++mat)
#pragma unroll
            for (int cbk = 0; cbk < 4; ++cbk)
#pragma unroll
                for (int ks = 0; ks < 2; ++ks) { const float* W2 = (mat == 0 ? p.w2 : p.a2) + (size_t)dir * 64 * 1024 + head * 64 + cbk * 16 + (lane & 15) + (size_t)(ks * 32 + (lane >> 4) * 8) * 1024;
                    float f[8];
#pragma unroll
                    for (int e = 0; e < 8; ++e) f[e] = W2[(size_t)e * 1024];
                    u32x4 w; w.x = cvt_pk_bf16(f[0], f[1]); w.y = cvt_pk_bf16(f[2], f[3]); w.z = cvt_pk_bf16(f[4], f[5]); w.w = cvt_pk_bf16(f[6], f[7]); Bf[mat][cbk][ks] = *reinterpret_cast<bf16x8*>(&w); }
        __syncthreads();
        const int pt = tid - 256;
        u32x4 zc[5], zm[5], zn[5];
#define PLOAD(cc) do { const int tf_ = dir ? T - TC * ((cc) + 1) : TC * (cc); \
    _Pragma("unroll") for (int k = 0; k < 5; ++k) { const int item = lane + 64 * k, tl8 = item / 40, chh = item - tl8 * 40, which = chh >> 3, j0 = (chh & 7) * 8; \
        const int col = which < 3 ? which * 1024 + head * 64 + j0 : (which == 3 ? 3072 : 3200) + dir * 64 + j0; \
        const int t = tf_ + 8 * pw + tl8; const bf16_t* zp = p.ZR + (size_t)(tok0 + t) * ZRP + col; \
        zc[k] = *(const u32x4*)zp; zm[k] = (u32x4){0u, 0u, 0u, 0u}; zn[k] = (u32x4){0u, 0u, 0u, 0u}; \
        if (t > 0) zm[k] = *(const u32x4*)(zp - ZRP); \
        if (t < T - 1) zn[k] = *(const u32x4*)(zp + ZRP); } } while (0)
        PLOAD(0);
        for (int c = -1; c < NCH; ++c) {
            if (c >= 1) { const int cb_ = (c - 1) & 1, tf = dir ? T - TC * c : TC * (c - 1); const int tl = pt >> 3, c8 = (pt & 7) * 8;
                const float* yp = (const float*)(lds + cb_ * BUFB + O_Y) + tl * 64 + c8; const f32x4 y4 = *(const f32x4*)yp, y5 = *(const f32x4*)(yp + 4);
                u32x4 w; w.x = cvt_pk_bf16(y4[0], y4[1]); w.y = cvt_pk_bf16(y4[2], y4[3]); w.z = cvt_pk_bf16(y5[0], y5[1]); w.w = cvt_pk_bf16(y5[2], y5[3]);
                *(u32x4*)(yb + (size_t)(tok0 + tf + tl) * 1024 + head * 64 + c8) = w; }
            if (c + 1 < NCH) {
                const int nb = (c + 1) & 1, tfirst = dir ? T - TC * (c + 2) : TC * (c + 1);
                char* B_ = lds + nb * BUFB;
                float* Rl = (float*)(B_ + O_R); float* KDl = (float*)(B_ + O_KD); float* KKl = (float*)(B_ + O_KK); float* Wl = (float*)(B_ + O_W); float* KAl = (float*)(B_ + O_KA); float* Vl = (float*)(B_ + O_V);
#pragma unroll
                for (int k = 0; k < 5; ++k) { const int item = lane + 64 * k, tl8 = item / 40, chh = item - tl8 * 40, which = chh >> 3, j0 = (chh & 7) * 8, tl = 8 * pw + tl8;
                    const f32x4 mpa = *(const f32x4*)(MUP + which * 64 + j0), mpb = *(const f32x4*)(MUP + which * 64 + j0 + 4), mna = *(const f32x4*)(MUN + which * 64 + j0), mnb = *(const f32x4*)(MUN + which * 64 + j0 + 4);
                    const u32x4 z = zc[k], zmm = zm[k], znn = zn[k];
                    float v[8];
#define SH(i, zw, zmw, znw, lohi, mp_, mn_) { const float zz = lohi(zw), a_ = lohi(zmw), b_ = lohi(znw); v[i] = zz + mp_ * (a_ - zz) + mn_ * (b_ - zz); }
                    SH(0, z.x, zmm.x, znn.x, bflo, mpa[0], mna[0]) SH(1, z.x, zmm.x, znn.x, bfhi, mpa[1], mna[1]) SH(2, z.y, zmm.y, znn.y, bflo, mpa[2], mna[2]) SH(3, z.y, zmm.y, znn.y, bfhi, mpa[3], mna[3])
                    SH(4, z.z, zmm.z, znn.z, bflo, mpb[0], mnb[0]) SH(5, z.z, zmm.z, znn.z, bfhi, mpb[1], mnb[1]) SH(6, z.w, zmm.w, znn.w, bflo, mpb[2], mnb[2]) SH(7, z.w, zmm.w, znn.w, bfhi, mpb[3], mnb[3])
#undef SH
                    if (which < 2) { float* dst = (which == 0 ? Rl : KDl) + tl * 64 + j0;
                        *(f32x4*)dst = (f32x4){v[0], v[1], v[2], v[3]}; *(f32x4*)(dst + 4) = (f32x4){v[4], v[5], v[6], v[7]}; }
                    else if (which == 2) { float* dst = Vl + tl * 64 + j0;
                        *(f32x4*)dst = (f32x4){v[0], v[1], v[2], v[3]}; *(f32x4*)(dst + 4) = (f32x4){v[4], v[5], v[6], v[7]}; }
                    else { if (which == 3) {
#pragma unroll
                            for (int i = 0; i < 8; ++i) { const float e2 = __expf(2.f * v[i]); v[i] = 1.f - 2.f * __builtin_amdgcn_rcpf(e2 + 1.f); } }
                        u32x4 w; w.x = cvt_pk_bf16(v[0], v[1]); w.y = cvt_pk_bf16(v[2], v[3]); w.z = cvt_pk_bf16(v[4], v[5]); w.w = cvt_pk_bf16(v[6], v[7]);
                        *(u32x4*)((which == 3 ? AWl : AAl) + tl8 * 64 + j0) = w; }
                }
                { const int tj = lane & 7, kq = lane >> 4;
#pragma unroll
                  for (int mat = 0; mat < 2; ++mat) { const bf16_t* Am = (mat == 0 ? AWl : AAl) + tj * 64 + kq * 8;
                      const bf16x8 y0 = *reinterpret_cast<const bf16x8*>(Am), y1 = *reinterpret_cast<const bf16x8*>(Am + 32);
#pragma unroll
                      for (int cbk = 0; cbk < 4; ++cbk) { f32x4 acc = {0.f, 0.f, 0.f, 0.f};
                          acc = __builtin_amdgcn_mfma_f32_16x16x32_bf16(Bf[mat][cbk][0], y0, acc, 0, 0, 0);
                          acc = __builtin_amdgcn_mfma_f32_16x16x32_bf16(Bf[mat][cbk][1], y1, acc, 0, 0, 0);
                          const int col = cbk * 16 + 4 * kq; const f32x4 bias = *(const f32x4*)((mat == 0 ? BW : BA) + col); f32x4 res;
#pragma unroll
                          for (int r = 0; r < 4; ++r) { const float u = acc[r] + bias[r];
                              const float sg = __builtin_amdgcn_rcpf(1.f + __expf(-u));
                              res[r] = mat == 0 ? __expf(-0.60653065971263342f * sg) : sg; }
                          if ((lane & 15) < 8) *(f32x4*)((mat == 0 ? Wl : KAl) + (8 * pw + tj) * 64 + col) = res; } } }
                { const int tl = 8 * pw + (lane >> 3), c0 = (lane & 7) * 8; const int o = tl * 64 + c0;
                  float bs = 0.f, ss = 0.f; f32x4 kr[2], k4[2], a4[2];
#pragma unroll
                  for (int q = 0; q < 2; ++q) { k4[q] = *(const f32x4*)(KDl + o + 4 * q); a4[q] = *(const f32x4*)(KAl + o + 4 * q);
                      kr[q] = k4[q] * *(const f32x4*)(KKW + c0 + 4 * q); ss += (kr[q][0] * kr[q][0] + kr[q][1] * kr[q][1]) + (kr[q][2] * kr[q][2] + kr[q][3] * kr[q][3]); }
                  ss = dpp_red8(ss);
                  const float inv = __builtin_amdgcn_rsqf(fmaxf(ss, 1e-24f));
#pragma unroll
                  for (int q = 0; q < 2; ++q) { const f32x4 kk = kr[q] * inv, kd = k4[q] * (1.f + (a4[q] - 1.f) * *(const f32x4*)(KAW + c0 + 4 * q)), kka = kk * a4[q];
                      const f32x4 bb = *(const f32x4*)(Rl + o + 4 * q) * kd * *(const f32x4*)(RKW + c0 + 4 * q); bs += (bb[0] + bb[1]) + (bb[2] + bb[3]);
                      *(f32x4*)(KKl + o + 4 * q) = kk; *(f32x4*)(KDl + o + 4 * q) = kd; *(f32x4*)(KAl + o + 4 * q) = kka; }
                  bs = dpp_red8(bs);
                  if ((lane & 7) == 0) bon[(size_t)(tok0 + tfirst + tl) * 16 + head] = bs; }
                if (c + 2 < NCH) PLOAD(c + 2);
            }
            asm volatile("s_waitcnt lgkmcnt(0)" ::: "memory"); __builtin_amdgcn_s_barrier(); asm volatile("" ::: "memory");
        }
#undef PLOAD
    } else {
        __syncthreads();
        const int row0 = wid * 16 + (lane >> 3) * 2, seg = lane & 7;
        f32x2 S[2][4];
#pragma unroll
        for (int h2 = 0; h2 < 2; ++h2)
#pragma unroll
            for (int q = 0; q < 4; ++q) S[h2][q] = (f32x2){0.f, 0.f};
        asm volatile("s_waitcnt lgkmcnt(0)" ::: "memory"); __builtin_amdgcn_s_barrier(); asm volatile("" ::: "memory");
        for (int c = 0; c < NCH; ++c) {
            const char* B_ = lds + (c & 1) * BUFB;
            if (dir) scan_chunk<1>(B_, S, seg, row0); else scan_chunk<0>(B_, S, seg, row0);
            asm volatile("s_waitcnt lgkmcnt(0)" ::: "memory"); __builtin_amdgcn_s_barrier(); asm volatile("" ::: "memory");
        }
    }
    if (wid >= 4) {
        const int pt = tid - 256, c = NCH, cb_ = (c - 1) & 1, tf = dir ? T - TC * c : TC * (c - 1); const int tl = pt >> 3, c8 = (pt & 7) * 8;
        const float* yp = (const float*)(lds + cb_ * BUFB + O_Y) + tl * 64 + c8; const f32x4 y4 = *(const f32x4*)yp, y5 = *(const f32x4*)(yp + 4);
        u32x4 w; w.x = cvt_pk_bf16(y4[0], y4[1]); w.y = cvt_pk_bf16(y4[2], y4[3]); w.z = cvt_pk_bf16(y5[0], y5[1]); w.w = cvt_pk_bf16(y5[2], y5[3]);
        *(u32x4*)(yb + (size_t)(tok0 + tf + tl) * 1024 + head * 64 + c8) = w;
    }
    __syncthreads();
}
}

__device__ __forceinline__ void p4_post(const Args& a, char* lds, int vcu, int G) {
    const int tid = threadIdx.x, lane = tid & 63;
    unsigned char* ws = a.ws;
    const bf16_t* ZR = (const bf16_t*)a.out; bf16_t* QK = (bf16_t*)(ws + WS_QK);
    const bf16_t* Y0 = (const bf16_t*)(ws + WS_Y); const bf16_t* Y1 = Y0 + (size_t)NT * 1024;
    const float* BON = (const float*)(ws + WS_BON);
    const float* mup = a.in[13]; const float* mun = a.in[14]; const float* G2 = a.in[19]; const float* lnw = a.in[23]; const float* lnb = a.in[24]; const float* subg = a.in[12];
    float* SG = (float*)lds; float* BL = (float*)(lds + 20480);
    for (int tile = vcu; tile < NT / 32; tile += G) {
        const int tk0 = tile * 32;
        __syncthreads();
        for (int it = tid; it < 32 * 20; it += NTHR) {
            const int tl = it / 20, j0 = (it % 20) * 8, col = 3328 + j0, tok = tk0 + tl, t = tok_pos(tok), T = tok < TP ? TP : TS;
            const bf16_t* zp = ZR + (size_t)tok * ZRP + col; const u32x4 z = *(const u32x4*)zp; u32x4 zm = {0u, 0u, 0u, 0u}, zn = {0u, 0u, 0u, 0u};
            if (t > 0) zm = *(const u32x4*)(zp - ZRP);
            if (t < T - 1) zn = *(const u32x4*)(zp + ZRP);
            float v[8];
#define SH(i, zw, zmw, znw, lohi) { const float zz = lohi(zw), a_ = lohi(zmw), b_ = lohi(znw), mp_ = mup[col + i], mn_ = mun[col + i]; v[i] = sigmoidf_(zz + mp_ * (a_ - zz) + mn_ * (b_ - zz)); }
            SH(0, z.x, zm.x, zn.x, bflo) SH(1, z.x, zm.x, zn.x, bfhi) SH(2, z.y, zm.y, zn.y, bflo) SH(3, z.y, zm.y, zn.y, bfhi)
            SH(4, z.z, zm.z, zn.z, bflo) SH(5, z.z, zm.z, zn.z, bfhi) SH(6, z.w, zm.w, zn.w, bflo) SH(7, z.w, zm.w, zn.w, bfhi)
#undef SH
            *(f32x4*)(SG + tl * 160 + j0) = (f32x4){v[0], v[1], v[2], v[3]}; *(f32x4*)(SG + tl * 160 + j0 + 4) = (f32x4){v[4], v[5], v[6], v[7]};
        }
        { const int tl = tid >> 4, hd = tid & 15; BL[tid] = BON[(size_t)(tk0 + tl) * 16 + hd] + BON[(size_t)NT * 16 + (size_t)(tk0 + tl) * 16 + hd]; }
        { const int pr = tid >> 1, half = tid & 1, tl = pr >> 3, hd = pr & 7; bf16_t* op = QK + (size_t)(tk0 + tl) * 2048 + hd * 128 + half * 64;
          u32x4 w[8]; float ss = 0.f;
#pragma unroll
          for (int i = 0; i < 8; ++i) { w[i] = *(const u32x4*)(op + i * 8);
              ss += bflo(w[i].x) * bflo(w[i].x) + bfhi(w[i].x) * bfhi(w[i].x) + bflo(w[i].y) * bflo(w[i].y) + bfhi(w[i].y) * bfhi(w[i].y) + bflo(w[i].z) * bflo(w[i].z) + bfhi(w[i].z) * bfhi(w[i].z) + bflo(w[i].w) * bflo(w[i].w) + bfhi(w[i].w) * bfhi(w[i].w); }
          ss += __shfl_xor(ss, 1);
          const float rstd = rsqrtf(ss * (1.f / 128.f) + 1e-6f) * 0.8f; const float* sg = subg + half * 64;
#pragma unroll
          for (int i = 0; i < 8; ++i) { u32x4 o;
              o.x = cvt_pk_bf16(bflo(w[i].x) * rstd * sg[i * 8 + 0], bfhi(w[i].x) * rstd * sg[i * 8 + 1]); o.y = cvt_pk_bf16(bflo(w[i].y) * rstd * sg[i * 8 + 2], bfhi(w[i].y) * rstd * sg[i * 8 + 3]);
              o.z = cvt_pk_bf16(bflo(w[i].z) * rstd * sg[i * 8 + 4], bfhi(w[i].z) * rstd * sg[i * 8 + 5]); o.w = cvt_pk_bf16(bflo(w[i].w) * rstd * sg[i * 8 + 6], bfhi(w[i].w) * rstd * sg[i * 8 + 7]);
              *(u32x4*)(op + i * 8) = o; } }
        __syncthreads();
        const int c0 = tid * 2;
        float acc[32][2];
#pragma unroll
        for (int i = 0; i < 32; ++i) { acc[i][0] = 0.f; acc[i][1] = 0.f; }
#pragma unroll 1
        for (int k = 0; k < 160; k += 4) {
            const f32x2 g0 = *(const f32x2*)(G2 + (size_t)(k + 0) * 1024 + c0), g1 = *(const f32x2*)(G2 + (size_t)(k + 1) * 1024 + c0), g2 = *(const f32x2*)(G2 + (size_t)(k + 2) * 1024 + c0), g3 = *(const f32x2*)(G2 + (size_t)(k + 3) * 1024 + c0);
#pragma unroll
            for (int i = 0; i < 32; ++i) { const f32x4 s4 = *(const f32x4*)(SG + i * 160 + k);
                acc[i][0] += s4[0] * g0[0] + s4[1] * g1[0] + s4[2] * g2[0] + s4[3] * g3[0];
                acc[i][1] += s4[0] * g0[1] + s4[1] * g1[1] + s4[2] * g2[1] + s4[3] * g3[1]; }
        }
        const int hd = tid >> 5;
        const float lw0 = lnw[c0], lw1 = lnw[c0 + 1], lb0 = lnb[c0], lb1 = lnb[c0 + 1];
        const float mp0 = mup[2048 + c0], mp1 = mup[2048 + c0 + 1], mn0 = mun[2048 + c0], mn1 = mun[2048 + c0 + 1];
#pragma unroll
        for (int i = 0; i < 32; ++i) {
            const int tok = tk0 + i, t = tok_pos(tok), T = tok < TP ? TP : TS;
            const unsigned ya = *(const unsigned*)(Y0 + (size_t)tok * 1024 + c0), yb = *(const unsigned*)(Y1 + (size_t)tok * 1024 + c0);
            const float y0 = bflo(ya) + bflo(yb), y1 = bfhi(ya) + bfhi(yb);
            float s = y0 + y1, q = y0 * y0 + y1 * y1;
#pragma unroll
            for (int o = 1; o < 32; o <<= 1) { s += __shfl_xor(s, o); q += __shfl_xor(q, o); }
            const float mean = s * (1.f / 64.f), var = fmaxf(q * (1.f / 64.f) - mean * mean, 0.f), rstd = rsqrtf(var + 64e-5f);
            const bf16_t* zp = ZR + (size_t)tok * ZRP + 2048 + c0; const unsigned z = *(const unsigned*)zp;
            unsigned zm = 0u, zn = 0u;
            if (t > 0) zm = *(const unsigned*)(zp - ZRP);
            if (t < T - 1) zn = *(const unsigned*)(zp + ZRP);
            const float v0 = bflo(z) + mp0 * (bflo(zm) - bflo(z)) + mn0 * (bflo(zn) - bflo(z)), v1 = bfhi(z) + mp1 * (bfhi(zm) - bfhi(z)) + mn1 * (bfhi(zn) - bfhi(z));
            const float bo = BL[i * 16 + hd];
            const float o0 = ((y0 - mean) * rstd * lw0 + lb0 + bo * v0) * acc[i][0], o1 = ((y1 - mean) * rstd * lw1 + lb1 + bo * v1) * acc[i][1];
            *(unsigned*)(QK + (size_t)tok * 2048 + 1024 + c0) = cvt_pk_bf16(o0, o1);
        }
    }
    __syncthreads();
}

struct SchedMerge {
    int v, G; const char* H; const char* WG; const char* QK; const char* VM; const char* PAR; const char* PM2;
    __device__ __forceinline__ bool next(int i, Unit& u) const {
        const int ti = i / 6, kind = i - ti * 6; const long L = (long)ti * G + v; int pm, pn;
        if (!TileMap{192, 8}.get(L, pm, pn)) return false;
        u.pm = pm; u.pn = pn; u.kind = kind; u.t0 = 0; u.T = 0;
        const size_t bo = (size_t)pn * MiB;
        switch (kind) {
            case 0: u.A = H + (size_t)pm * MiB; u.B = WG + bo; u.nt = 32; break;
            case 1: u.A = QK + (size_t)pm * MiB; u.B = PAR + bo; u.nt = 16; break;
            case 2: u.A = H + (size_t)pm * MiB; u.B = WG + 8 * MiB + bo; u.nt = 32; break;
            case 3: u.A = QK + (size_t)pm * MiB + 2048; u.B = PAR + bo + 2048; u.nt = 16; break;
            case 4: u.A = H + (size_t)pm * MiB; u.B = WG + 16 * MiB + bo; u.nt = 32; break;
            default: u.A = VM + (size_t)pm * MiB + 2048; u.B = PM2 + bo; u.nt = 16; break;
        }
        return true;
    }
};
struct EpiMerge {
    u32x4* scrG; f32x4* scrP; bf16_t* MRG;
    __device__ __forceinline__ void operator()(const f32x4 (&acc)[2][2][4][2], const Unit& u, int wr, int wc, int fr, int fq) const {
        const int tid = threadIdx.x, kind = u.kind;
        u32x4* gp = scrG + tid; f32x4* pp = scrP + tid;
        if ((kind & 1) == 0) {
#pragma unroll
            for (int ai = 0; ai < 2; ++ai)
#pragma unroll
                for (int bj = 0; bj < 2; ++bj)
#pragma unroll
                    for (int m = 0; m < 4; ++m) { const f32x4 v0 = acc[ai][bj][m][0], v1 = acc[ai][bj][m][1]; u32x4 w;
                        w.x = cvt_pk_bf16(sigmoidf_(v0[0]), sigmoidf_(v0[1])); w.y = cvt_pk_bf16(sigmoidf_(v0[2]), sigmoidf_(v0[3]));
                        w.z = cvt_pk_bf16(sigmoidf_(v1[0]), sigmoidf_(v1[1])); w.w = cvt_pk_bf16(sigmoidf_(v1[2]), sigmoidf_(v1[3]));
                        *gp = w; gp += NTHR; asm volatile("" : "+v"(gp) :: "memory"); }
        } else {
            const int row0 = u.pm * 256 + wr * 64 + fr, col0 = u.pn * 256 + wc * 32 + 8 * fq;
#pragma unroll
            for (int ai = 0; ai < 2; ++ai)
#pragma unroll
                for (int bj = 0; bj < 2; ++bj) {
                    bf16_t* mp = MRG + (size_t)(row0 + ai * 128) * 2048 + col0 + bj * 128;
#pragma unroll
                    for (int m = 0; m < 4; ++m) { const u32x4 g = *gp;
                        f32x4 p0 = acc[ai][bj][m][0] * (f32x4){bflo(g.x), bfhi(g.x), bflo(g.y), bfhi(g.y)}, p1 = acc[ai][bj][m][1] * (f32x4){bflo(g.z), bfhi(g.z), bflo(g.w), bfhi(g.w)};
                        if (kind > 1) { p0 += pp[0]; p1 += pp[NTHR]; }
                        if (kind < 5) { pp[0] = p0; pp[NTHR] = p1; }
                        else { u32x4 w; w.x = cvt_pk_bf16(p0[0], p0[1]); w.y = cvt_pk_bf16(p0[2], p0[3]); w.z = cvt_pk_bf16(p1[0], p1[1]); w.w = cvt_pk_bf16(p1[2], p1[3]);
                            *(u32x4*)mp = w; }
                        gp += NTHR; pp += 2 * NTHR; mp += 16 * 2048; asm volatile("" : "+v"(gp), "+v"(pp), "+v"(mp) :: "memory"); } }
        }
    }
};

struct SchedSq {
    int v, G; const char* A; const char* B; size_t astep, bstep; int nt;
    __device__ __forceinline__ bool next(int i, Unit& u) const {
        const long L = (long)i * G + v; int pm, pn; if (!TileMap{192, 8}.get(L, pm, pn)) return false;
        u.A = A + (size_t)pm * astep; u.B = B + (size_t)pn * bstep; u.nt = nt; u.pm = pm; u.pn = pn; u.kind = 0; u.t0 = 0; u.T = 0; return true;
    }
};
struct EpiWo {
    const float* xp; const float* xs; float* out;
    __device__ __forceinline__ void operator()(const f32x4 (&acc)[2][2][4][2], const Unit& u, int wr, int wc, int fr, int fq) const {
        const int row0 = u.pm * 256 + wr * 64 + fr, col0 = u.pn * 256 + wc * 32 + 8 * fq;
#pragma unroll
        for (int ai = 0; ai < 2; ++ai)
#pragma unroll
            for (int m = 0; m < 4; ++m) { const int row = row0 + ai * 128 + m * 16;
                const float* xr = (row < TP ? xp + (size_t)row * DM : xs + (size_t)(row - TP) * DM) + col0; float* orow = out + (size_t)row * DM + col0;
#pragma unroll
                for (int bj = 0; bj < 2; ++bj) { const f32x4 x0 = *(const f32x4*)(xr + bj * 128), x1 = *(const f32x4*)(xr + bj * 128 + 4);
                    *(f32x4*)(orow + bj * 128) = x0 + acc[ai][bj][m][0]; *(f32x4*)(orow + bj * 128 + 4) = x1 + acc[ai][bj][m][1]; } }
    }
};
struct EpiDown {
    float* out;
    __device__ __forceinline__ void operator()(const f32x4 (&acc)[2][2][4][2], const Unit& u, int wr, int wc, int fr, int fq) const {
        const int row0 = u.pm * 256 + wr * 64 + fr, col0 = u.pn * 256 + wc * 32 + 8 * fq;
#pragma unroll
        for (int ai = 0; ai < 2; ++ai)
#pragma unroll
            for (int m = 0; m < 4; ++m) { float* orow = out + (size_t)(row0 + ai * 128 + m * 16) * DM + col0;
#pragma unroll
                for (int bj = 0; bj < 2; ++bj) { const f32x4 x0 = *(const f32x4*)(orow + bj * 128), x1 = *(const f32x4*)(orow + bj * 128 + 4);
                    *(f32x4*)(orow + bj * 128) = x0 + acc[ai][bj][m][0]; *(f32x4*)(orow + bj * 128 + 4) = x1 + acc[ai][bj][m][1]; } }
    }
};

struct SchedUp {
    int v, G; const char* HN; const char* WUP;
    __device__ __forceinline__ bool next(int i, Unit& u) const {
        const long L = (long)i * G + v; int pm, pn; if (!TileMap{197, 44}.get(L, pm, pn)) return false;
        int s, ti; if (pm < 65) { s = 0; ti = pm; } else { s = 1 + (pm - 65) / 33; ti = (pm - 65) % 33; }
        const int T = seq_len(s); int t0 = 254 * ti - 1; if (t0 > T - 255) t0 = T - 255;
        u.pm = seq_start(s); u.pn = pn; u.kind = 0; u.t0 = t0; u.T = T; u.nt = 32;
        u.A = HN + ((long)u.pm + t0) * 4096; u.B = WUP + (size_t)pn * MiB; return true;
    }
};
struct EpiUp {
    bf16_t* ACT; const float* cw; const float* cb; LAS float* xch;
    __device__ __forceinline__ void operator()(const f32x4 (&acc)[2][2][4][2], const Unit& u, int wr, int wc, int fr, int fq) const {
        const int lane = threadIdx.x & 63;
        const int cin = wc * 32 + 8 * fq;
#pragma unroll
        for (int ai = 0; ai < 2; ++ai) { const int rg = 2 * ai + wr;
#pragma unroll
            for (int bj = 0; bj < 2; ++bj)
#pragma unroll
                for (int n = 0; n < 2; ++n) {
                    if (fr == 0) *(LAS f32x4*)(xch + (rg * 2 + 0) * 256 + bj * 128 + cin + 4 * n) = acc[ai][bj][0][n];
                    if (fr == 15) *(LAS f32x4*)(xch + (rg * 2 + 1) * 256 + bj * 128 + cin + 4 * n) = acc[ai][bj][3][n]; } }
        asm volatile("s_waitcnt lgkmcnt(0)" ::: "memory"); __builtin_amdgcn_s_barrier(); asm volatile("" ::: "memory");
        const int gc = u.pn * 128 + cin;
#pragma unroll
        for (int n = 0; n < 2; ++n) {
            const int wcol = gc + 4 * n;
            const f32x4 g0 = *(const f32x4*)(cw + wcol), g1 = *(const f32x4*)(cw + 2 * DFF + wcol), g2 = *(const f32x4*)(cw + 4 * DFF + wcol), gb = *(const f32x4*)(cb + wcol);
            const f32x4 v0 = *(const f32x4*)(cw + DFF + wcol), v1 = *(const f32x4*)(cw + 3 * DFF + wcol), v2 = *(const f32x4*)(cw + 5 * DFF + wcol), vb = *(const f32x4*)(cb + DFF + wcol);
#pragma unroll
            for (int ai = 0; ai < 2; ++ai) { const int rg = 2 * ai + wr;
                bf16_t* ap = ACT + ((long)u.pm + u.t0 + 128 * ai + 64 * wr + fr) * DFF + gc + 4 * n;
#pragma unroll
                for (int m = 0; m < 4; ++m) {
                    const int j = 128 * ai + 64 * wr + 16 * m + fr, t = u.t0 + j;
                    f32x4 res;
#pragma unroll
                    for (int bj = 0; bj < 2; ++bj) {
                        const f32x4 cur = acc[ai][bj][m][n];
                        const f32x4 sp = (m > 0 && fr == 15) ? acc[ai][bj][m > 0 ? m - 1 : 0][n] : cur;
                        const f32x4 sn = (m < 3 && fr == 0) ? acc[ai][bj][m < 3 ? m + 1 : 3][n] : cur;
                        f32x4 pv, nv;
#pragma unroll
                        for (int i = 0; i < 4; ++i) { pv[i] = __uint_as_float(__builtin_amdgcn_update_dpp(0u, __float_as_uint(sp[i]), 0x121, 0xf, 0xf, false));
                                                       nv[i] = __uint_as_float(__builtin_amdgcn_update_dpp(0u, __float_as_uint(sn[i]), 0x12F, 0xf, 0xf, false)); }
                        if (m == 0) { const f32x4 xprev = rg > 0 ? *(const LAS f32x4*)(xch + ((rg - 1) * 2 + 1) * 256 + bj * 128 + cin + 4 * n) : (f32x4){0.f, 0.f, 0.f, 0.f}; if (fr == 0) pv = xprev; }
                        if (m == 3) { const f32x4 xnext = rg < 3 ? *(const LAS f32x4*)(xch + ((rg + 1) * 2 + 0) * 256 + bj * 128 + cin + 4 * n) : (f32x4){0.f, 0.f, 0.f, 0.f}; if (fr == 15) nv = xnext; }
                        if (t < 1) pv = (f32x4){0.f, 0.f, 0.f, 0.f};
                        if (t >= u.T - 1) nv = (f32x4){0.f, 0.f, 0.f, 0.f};
                        if (bj == 0) { const f32x4 cv = g0 * pv + g1 * cur + g2 * nv + gb; res = (f32x4){cv[0] * sigmoidf_(cv[0]), cv[1] * sigmoidf_(cv[1]), cv[2] * sigmoidf_(cv[2]), cv[3] * sigmoidf_(cv[3])}; }
                        else { const f32x4 cv = v0 * pv + v1 * cur + v2 * nv + vb; res = res * cv; }
                    }
                    if (j >= 1 && j <= 254) { u32x2 w; w.x = cvt_pk_bf16(res[0], res[1]); w.y = cvt_pk_bf16(res[2], res[3]); *(u32x2*)ap = w; }
                    ap += 16 * DFF; asm volatile("" : "+v"(ap) :: "memory");
                }
            }
        }
    }
};

__global__ void __launch_bounds__(NTHR, 2) enc_fwd(Args args) {
    extern __shared__ __attribute__((aligned(16))) unsigned char lds_raw[];
    cg::grid_group grid = cg::this_grid();
    LAS unsigned char* lds = (LAS unsigned char*)lds_raw;
    const int tid = threadIdx.x;
    const int G = gridDim.x, bx = blockIdx.x, vcu = (G % 8 == 0) ? (bx % 8) * (G / 8) + bx / 8 : bx;
    unsigned char* ws = args.ws;
    const int lo = args.ph_lo, hi = args.ph_hi;
#ifndef P2M
#define P2M 7
#endif
#ifndef PH_MASK
#define PH_MASK 0x1ff
#endif
#define IN(k) (((PH_MASK >> (k)) & 1) && lo <= (k) && (k) < hi)
#define SEAM(k) do { if (IN(k) && IN((k) + 1)) grid.sync(); } while (0)
#ifndef PROBE
#define PROBE 0
#endif
    unsigned long long tp0 = 0, tp1 = 0;
#define TSTAMP(v) do { if (PROBE) { v = __builtin_amdgcn_s_memrealtime(); } } while (0)

    if (IN(0)) p0_prologue(args, lds, vcu, G);
    SEAM(0);
    if (IN(1)) {
        SchedIn S{vcu, G, (const char*)(ws + WS_H), (const char*)(ws + WS_WIN), (const char*)(ws + WS_MEMN), (const char*)(ws + WS_WKV)};
        EpiIn E{(bf16_t*)(ws + WS_QK), (bf16_t*)(ws + WS_VM), (bf16_t*)args.out, (bf16_t*)(ws + WS_KVM), args.in[6], args.in[7], (const float*)(ws + WS_ROPE), (const float*)(ws + WS_ROPE) + TP * 32};
        pg8::gemm_phase<EpiIn, SchedIn, true>(lds, 2048, S, E);
    }
    SEAM(1);
    if (PROBE == 1 || PROBE == 2) TSTAMP(tp0);
    if (IN(2)) {
        unsigned* ctl = (unsigned*)(ws + WS_CTL);
        volatile LAS unsigned* jobw = (volatile LAS unsigned*)(lds + LDS_MISC);
        const float lam = ((const float*)ctl)[CW_LAM];
        scan::P sp{(const bf16_t*)args.out, (bf16_t*)(ws + WS_Y), (float*)(ws + WS_BON), args.in[13], args.in[14], args.in[15], args.in[16], args.in[17], args.in[18], args.in[20], args.in[21], args.in[22]};
        for (;;) {
            __syncthreads();
            if (tid == 0) jobw[0] = atomicAdd(ctl + CW_QUEUE, 1u);
            __syncthreads();
            const int jb = (int)jobw[0];
            if (jb >= 160 + 1536 + 768) break;
            if (((P2M) & 1) && jb < 160) {
                int s, r; if (jb < 32) { s = 0; r = jb; } else { s = 1 + (jb - 32) / 32; r = (jb - 32) % 32; }
                scan::job(s, r & 1, r >> 1, sp, (char*)lds_raw);
                if (PROBE == 2 && tid == 0) atomicMax((unsigned long long*)(ctl + 256), (unsigned long long)__builtin_amdgcn_s_memrealtime());
            } else if (((P2M) & 2) && jb < 160 + 1536) {
                const int a = jb - 160; int s, h, qb;
                if (a < 512) { s = 0; h = a / 64; qb = a % 64; } else { const int b = a - 512; s = 1 + b / 256; h = (b % 256) / 32; qb = b % 32; }
                att::diff_unit(s, h, qb, (bf16_t*)(ws + WS_QK), (const bf16_t*)(ws + WS_VM), lam, (char*)lds_raw);
            } else if ((P2M) & 4) {
                const int a = jb - 160 - 1536; int s, mh, qb;
                if (a < 256) { s = 0; mh = a / 64; qb = a % 64; } else { const int b = a - 256; s = 1 + b / 128; mh = (b % 128) / 32; qb = b % 32; }
                att::mem_unit(s, mh, qb, (bf16_t*)(ws + WS_VM), (const bf16_t*)(ws + WS_KVM), args.in[27], args.in[28], (char*)lds_raw);
            }
        }
    }
    SEAM(2);
    if (PROBE == 1) TSTAMP(tp1);
    if (IN(3)) p4_post(args, (char*)lds_raw, vcu, G);
    SEAM(3);
    if (IN(4)) {
        SchedMerge S{vcu, G, (const char*)(ws + WS_H), (const char*)(ws + WS_WG), (const char*)(ws + WS_QK), (const char*)(ws + WS_VM), (const char*)(ws + WS_PAR), (const char*)(ws + WS_PM2)};
        unsigned char* scr = (unsigned char*)args.out + (size_t)bx * (384 * 1024);
        EpiMerge E{(u32x4*)scr, (f32x4*)(scr + 128 * 1024), (bf16_t*)(ws + WS_MRG)};
        pg8::gemm_phase<EpiMerge, SchedMerge, true>(lds, 2048, S, E);
    }
    SEAM(4);
    if (IN(5)) {
        SchedSq S{vcu, G, (const char*)(ws + WS_MRG), (const char*)(ws + WS_WO), MiB, MiB, 32};
        EpiWo E{args.in[0], args.in[1], args.out};
        pg8::gemm_phase<EpiWo, SchedSq, true>(lds, 2048, S, E);
    }
    SEAM(5);
    if (IN(6)) {
        const int lane = tid & 63, gw = vcu * 8 + (tid >> 6), NGW = G * 8;
        for (int m = gw; m < NT; m += NGW) rms_row(args.out + (size_t)m * DM, args.in[33], (bf16_t*)(ws + WS_H) + (size_t)m * DM, lane);
    }
    SEAM(6);
    if (IN(7)) {
        SchedUp S{vcu, G, (const char*)(ws + WS_H), (const char*)(ws + WS_WUP)};
        EpiUp E{(bf16_t*)(ws + WS_ACT), args.in[35], args.in[36], (LAS float*)(lds + LDS_XCH)};
        pg8::gemm_phase<EpiUp, SchedUp, true>(lds, 2048, S, E);
    }
    SEAM(7);
    if (IN(8)) {
        SchedSq S{vcu, G, (const char*)(ws + WS_ACT), (const char*)(ws + WS_WDN), (size_t)256 * DFF * 2, (size_t)256 * DFF * 2, 88};
        EpiDown E{args.out};
        pg8::gemm_phase<EpiDown, SchedSq, true>(lds, DFF, S, E);
    }
    if (PROBE && bx == 0 && tid == 0) {
        if (PROBE == 2) tp1 = __hip_atomic_load((unsigned long long*)(ws + WS_CTL) + 128, __ATOMIC_RELAXED, __HIP_MEMORY_SCOPE_AGENT);
        const unsigned long long target = __builtin_amdgcn_s_memrealtime() + (tp1 > tp0 ? tp1 - tp0 : 0);
        while (__builtin_amdgcn_s_memrealtime() < target) __builtin_amdgcn_s_sleep(16);
    }
#undef IN
#undef SEAM
}

#ifndef MK_SPLIT
#define MK_SPLIT 0
#endif
extern "C" void kernel_launch(void* const* d_in, const int* in_sizes, int n_in, void* d_out, int out_size, void* d_ws, size_t ws_size, hipStream_t stream) {
    static int grid = 0;
    if (grid == 0) {
        if (n_in != 38 || out_size != NT * DM || ws_size < WS_END) { fprintf(stderr, "kernel_launch: unexpected shapes n_in %d out %d ws %zu\n", n_in, out_size, ws_size); grid = -1; return; }
        int dev = 0, cus = 0, per_cu = 0;
        hipGetDevice(&dev); hipDeviceGetAttribute(&cus, hipDeviceAttributeMultiprocessorCount, dev);
        if (hipFuncSetAttribute((const void*)enc_fwd, hipFuncAttributeMaxDynamicSharedMemorySize, LDS_BYTES) != hipSuccess) { fprintf(stderr, "kernel_launch: hipFuncSetAttribute failed\n"); grid = -1; return; }
        if (hipOccupancyMaxActiveBlocksPerMultiprocessor(&per_cu, (const void*)enc_fwd, NTHR, LDS_BYTES) != hipSuccess || per_cu < 1) { fprintf(stderr, "kernel_launch: occupancy query failed (%d)\n", per_cu); per_cu = 1; }
        (void)hipGetLastError();
        grid = cus * 1;
    }
    if (grid < 0) return;
    Args a{};
    for (int i = 0; i < 38; ++i) a.in[i] = (const float*)d_in[i];
    a.out = (float*)d_out; a.ws = (unsigned char*)d_ws;
    for (int d = 0; d < 32; ++d) a.inv_rev[d] = pow(10000.0, -(double)d / 32.0) / 6.283185307179586476925286766559;
#if MK_SPLIT
    for (int ph = 0; ph < 9; ++ph) { a.ph_lo = ph; a.ph_hi = ph + 1; void* kargs[] = {&a};
        hipError_t e = hipLaunchCooperativeKernel((const void*)enc_fwd, dim3(grid), dim3(NTHR), kargs, LDS_BYTES, stream);
        if (e != hipSuccess) { fprintf(stderr, "launch %d failed: %s\n", ph, hipGetErrorString(e)); break; } }
#else
    a.ph_lo = 0; a.ph_hi = 9;
    void* kargs[] = {&a};
    hipError_t e = hipLaunchCooperativeKernel((const void*)enc_fwd, dim3(grid), dim3(NTHR), kargs, LDS_BYTES, stream);
    if (e != hipSuccess) fprintf(stderr, "cooperative launch failed: %s (grid %d)\n", hipGetErrorString(e), grid);
#endif
}
```

```cpp
#include <hip/hip_runtime.h>
#include <hip/hip_cooperative_groups.h>
#include <cstdio>
#include <cstdint>
#include <cmath>
namespace cg = cooperative_groups;

#define LAS __attribute__((address_space(3)))
typedef unsigned short bf16_t;
typedef short bf16x8 __attribute__((ext_vector_type(8)));
typedef short s16x4 __attribute__((ext_vector_type(4)));
typedef float f32x2 __attribute__((ext_vector_type(2)));
typedef float f32x4 __attribute__((ext_vector_type(4)));
typedef float f32x16 __attribute__((ext_vector_type(16)));
typedef unsigned u32x2 __attribute__((ext_vector_type(2)));
typedef unsigned u32x4 __attribute__((ext_vector_type(4)));

constexpr int NT = 49152, DM = 2048, TP = 16384, TS = 8192, NSEQ = 5;
constexpr int ZRP = 3584;
constexpr int DFF = 5632;
constexpr int NTHR = 512;
constexpr size_t MiB = 1u << 20;
constexpr size_t WS_CTL = 0, WS_WIN = 1 * MiB, WS_WG = 31 * MiB, WS_WKV = 55 * MiB, WS_PAR = 63 * MiB, WS_PM2 = 71 * MiB, WS_WO = 79 * MiB,
                 WS_WUP = 87 * MiB, WS_WDN = 131 * MiB, WS_ROPE = 153 * MiB, WS_MEMN = 157 * MiB, WS_KVM = 162 * MiB, WS_BON = 167 * MiB,
                 WS_H = 176 * MiB, WS_QK = 370 * MiB, WS_VM = 562 * MiB, WS_Y = 754 * MiB, WS_ACT = 370 * MiB, WS_MRG = 754 * MiB, WS_END = 946 * MiB;
constexpr int CW_QUEUE = 64, CW_LAM = 128;
constexpr int LDS_XCH = 131072, LDS_MISC = 131072 + 8192, LDS_BYTES = 131072 + 8192 + 256;

__device__ __forceinline__ int seq_start(int s) { return s == 0 ? 0 : TP + (s - 1) * TS; }
__device__ __forceinline__ int seq_len(int s) { return s == 0 ? TP : TS; }
__device__ __forceinline__ int tok_pos(int tok) { return tok < TP ? tok : ((tok - TP) & (TS - 1)); }

__device__ __forceinline__ unsigned cvt_pk_bf16(float lo, float hi) { unsigned r; asm volatile("v_cvt_pk_bf16_f32 %0, %1, %2" : "=v"(r) : "v"(lo), "v"(hi)); return r; }
__device__ __forceinline__ float bflo(unsigned w) { return __uint_as_float(w << 16); }
__device__ __forceinline__ float bfhi(unsigned w) { return __uint_as_float(w & 0xffff0000u); }
__device__ __forceinline__ float bf1(bf16_t b) { return __uint_as_float((unsigned)b << 16); }
__device__ __forceinline__ float sigmoidf_(float x) { return 1.f / (1.f + __expf(-x)); }
__device__ __forceinline__ float wave_sum(float v) {
#pragma unroll
    for (int o = 1; o < 64; o <<= 1) v += __shfl_xor(v, o);
    return v;
}

namespace pg8 {
constexpr int BM = 256, BK = 64, HALF = 128, HTB = HALF * BK * 2, STAGE_BYTES = 8 * HTB;
__host__ __device__ __forceinline__ int lds_byte(int r, int c) { const int st = (r >> 4) * 2 + (c >> 5), rr = r & 15, cc = c & 31, ob = rr * 64 + cc * 2; return st * 1024 + (ob ^ (((ob >> 9) & 1) << 5)); }
__host__ __device__ __forceinline__ void stage_rc(int b, int& R, int& C) { const int st = b / 1024, sb = b % 1024, swz = sb ^ (((sb >> 9) & 1) << 5); R = (st >> 1) * 16 + swz / 64; C = (st & 1) * 32 + (swz % 64) / 2; }
__host__ __device__ __forceinline__ int perm32(int rho) { const int n = rho >> 4, i = rho & 15; return 8 * (i >> 2) + 4 * n + (i & 3); }

struct Unit { const char* A; const char* B; int nt, pm, pn, kind, t0, T; };

template <class Epi, class Sched, bool ALIGN_EPI>
__device__ __forceinline__ void gemm_phase(LAS unsigned char* lds, const int ld, const Sched& S, const Epi& E) {
    const int tid = threadIdx.x, wid = __builtin_amdgcn_readfirstlane(tid >> 6), lane = tid & 63, wr = wid >> 2, wc = wid & 3, fr = lane & 15, fq = lane >> 4;
    unsigned voffA[2], voffB[2];
#pragma unroll
    for (int i = 0; i < 2; ++i) { int R, C; stage_rc(tid * 16 + i * 8192, R, C); const int Rb = (R & ~31) + perm32(R & 31);
        voffA[i] = (unsigned)(R * ld + C) * 2u; voffB[i] = (unsigned)(Rb * ld + C) * 2u; }
    const size_t kstep = (size_t)(BK * 2);
    const size_t hstep = (size_t)HALF * ld * 2;
    const unsigned ldsw = (unsigned)wid * 1024u;
    const int aoff = lds_byte(wr * 64 + fr, fq * 8), boff = lds_byte(wc * 32 + fr, fq * 8);
#define PG8_SA(b, h) (((b) * 2 + (h)) * HTB)
#define PG8_SB(b, h) ((4 + (b) * 2 + (h)) * HTB)
#define PG8_STAGE(bufoff, gbase, voff) do { _Pragma("unroll") for (int _i = 0; _i < 2; ++_i) \
        __builtin_amdgcn_global_load_lds((const unsigned*)((const char*)(gbase) + (voff)[_i]), (LAS unsigned*)(lds + (bufoff) + ldsw + _i * 8192), 16, 0, 0); } while (0)
#define PG8_LDA(dst, b, h) do { _Pragma("unroll") for (int m = 0; m < 4; ++m) _Pragma("unroll") for (int k = 0; k < 2; ++k) dst[m][k] = *(const LAS bf16x8*)(lds + PG8_SA(b, h) + aoff + m * 2048 + k * 1024); } while (0)
#define PG8_LDB(dst, b, h) do { _Pragma("unroll") for (int n = 0; n < 2; ++n) _Pragma("unroll") for (int k = 0; k < 2; ++k) dst[n][k] = *(const LAS bf16x8*)(lds + PG8_SB(b, h) + boff + n * 2048 + k * 1024); } while (0)
#define PG8_MMA(ai, bj, At, Bt) do { __builtin_amdgcn_s_setprio(1); _Pragma("unroll") for (int m = 0; m < 4; ++m) _Pragma("unroll") for (int n = 0; n < 2; ++n) _Pragma("unroll") for (int k = 0; k < 2; ++k) \
        acc[ai][bj][m][n] = __builtin_amdgcn_mfma_f32_16x16x32_bf16(Bt[n][k], At[m][k], acc[ai][bj][m][n], 0, 0, 0); __builtin_amdgcn_s_setprio(0); } while (0)
#define PG8_WAIT_V(n) asm volatile("s_waitcnt vmcnt(" #n ")" ::: "memory")
#define PG8_WAIT_L(n) asm volatile("s_waitcnt lgkmcnt(" #n ")" ::: "memory")
#define PG8_BAR __builtin_amdgcn_s_barrier()
#define PG8_SCHED __builtin_amdgcn_sched_barrier(0)
    Unit cur, nxt; int ui = 0;
    if (!S.next(0, cur)) return;
    f32x4 acc[2][2][4][2];
#pragma unroll
    for (int a = 0; a < 2; ++a)
#pragma unroll
        for (int b = 0; b < 2; ++b)
#pragma unroll
            for (int m = 0; m < 4; ++m)
#pragma unroll
                for (int n = 0; n < 2; ++n) acc[a][b][m][n] = (f32x4){0.f, 0.f, 0.f, 0.f};
    bf16x8 At[4][2], B0[2][2], B1[2][2];
    const char* cA = cur.A; const char* cB = cur.B;
    PG8_STAGE(PG8_SB(0, 0), cB, voffB); PG8_STAGE(PG8_SB(0, 1), cB + hstep, voffB); PG8_STAGE(PG8_SA(0, 0), cA, voffA); PG8_STAGE(PG8_SA(0, 1), cA + hstep, voffA);
    if (wr == 1) PG8_BAR;
    PG8_WAIT_V(2); PG8_BAR;
    PG8_STAGE(PG8_SB(1, 0), cB + kstep, voffB); PG8_STAGE(PG8_SA(1, 0), cA + kstep, voffA); PG8_STAGE(PG8_SB(1, 1), cB + hstep + kstep, voffB);
    PG8_WAIT_V(6); PG8_BAR;
    for (;;) {
        const bool has_next = S.next(ui + 1, nxt);
        const char* nA = has_next ? nxt.A : cA; const char* nB = has_next ? nxt.B : cB;
        const int nt = cur.nt;
        for (int t = 0; t < nt; t += 2) {
            const bool last = (t == nt - 2);
            const char* a1 = cA + (size_t)(t + 1) * kstep;
            const char* a2 = last ? nA : cA + (size_t)(t + 2) * kstep; const char* b2 = last ? nB : cB + (size_t)(t + 2) * kstep;
            const char* a3 = a2 + kstep; const char* b3 = b2 + kstep;
            PG8_LDB(B0, 0, 0); PG8_LDB(B1, 0, 1); PG8_SCHED; PG8_LDA(At, 0, 0); PG8_STAGE(PG8_SA(1, 1), a1 + hstep, voffA);
            PG8_WAIT_V(8); PG8_WAIT_L(0); PG8_BAR; PG8_MMA(0, 0, At, B0); PG8_MMA(0, 1, At, B1); PG8_BAR; PG8_SCHED;
            PG8_LDA(At, 0, 1); PG8_STAGE(PG8_SB(0, 0), b2, voffB); PG8_STAGE(PG8_SB(0, 1), b2 + hstep, voffB); PG8_STAGE(PG8_SA(0, 0), a2, voffA);
            PG8_WAIT_V(8); PG8_WAIT_L(0); PG8_BAR; PG8_MMA(1, 0, At, B0); PG8_MMA(1, 1, At, B1); PG8_BAR; PG8_SCHED;
            PG8_LDB(B0, 1, 0); PG8_LDB(B1, 1, 1); PG8_SCHED; PG8_LDA(At, 1, 0); PG8_STAGE(PG8_SA(0, 1), a2 + hstep, voffA);
            PG8_WAIT_V(8); PG8_WAIT_L(0); PG8_BAR; PG8_MMA(0, 0, At, B0); PG8_MMA(0, 1, At, B1); PG8_BAR; PG8_SCHED;
            PG8_LDA(At, 1, 1); PG8_STAGE(PG8_SB(1, 0), b3, voffB); PG8_STAGE(PG8_SB(1, 1), b3 + hstep, voffB); PG8_STAGE(PG8_SA(1, 0), a3, voffA);
            PG8_WAIT_V(8); PG8_WAIT_L(0); PG8_BAR; PG8_MMA(1, 0, At, B0); PG8_MMA(1, 1, At, B1); PG8_BAR; PG8_SCHED;
        }
        if constexpr (ALIGN_EPI) { if (wr == 0) PG8_BAR; }
        E(acc, cur, wr, wc, fr, fq);
        if (!has_next) break;
#pragma unroll
        for (int a = 0; a < 2; ++a)
#pragma unroll
            for (int b = 0; b < 2; ++b)
#pragma unroll
                for (int m = 0; m < 4; ++m)
#pragma unroll
                    for (int n = 0; n < 2; ++n) acc[a][b][m][n] = (f32x4){0.f, 0.f, 0.f, 0.f};
        cur = nxt; cA = nA; cB = nB; ++ui;
        if constexpr (ALIGN_EPI) { if (wr == 1) PG8_BAR; }
    }
    PG8_WAIT_V(0);
    if constexpr (!ALIGN_EPI) { if (wr == 0) PG8_BAR; }
    PG8_BAR;
#undef PG8_SA
#undef PG8_SB
#undef PG8_STAGE
#undef PG8_LDA
#undef PG8_LDB
#undef PG8_MMA
#undef PG8_WAIT_V
#undef PG8_WAIT_L
#undef PG8_BAR
#undef PG8_SCHED
}
}
using pg8::Unit;

struct TileMap {
    int nM, nN;
    __device__ __forceinline__ bool get(long L, int& pm, int& pn) const {
        if (L >= (long)nM * nN) return false;
        const int nig = 16 * nN, gid = (int)(L / nig), fm = gid * 16, gsz = (nM - fm) < 16 ? (nM - fm) : 16, r = (int)(L % nig);
        pm = fm + r % gsz; pn = r / gsz; return true;
    }
};

struct Args {
    const float* in[38];
    float* out; unsigned char* ws;
    double inv_rev[32];
    int ph_lo, ph_hi;
};

__device__ __forceinline__ void tr_item(const float* W, int N, int src_n0, bf16_t* WT, size_t ldw, int koff, int r0, int k0, LAS float* scr, int lane) {
    if (src_n0 >= 0) {
#pragma unroll 8
        for (int i = 0; i < 32; ++i) { const int kk = 2 * i + (lane >> 5); scr[kk * 33 + (lane & 31)] = W[(size_t)(k0 + kk) * N + src_n0 + (lane & 31)]; }
    } else {
#pragma unroll 8
        for (int i = 0; i < 32; ++i) { const int kk = 2 * i + (lane >> 5); scr[kk * 33 + (lane & 31)] = 0.f; }
    }
    asm volatile("s_waitcnt lgkmcnt(0)" ::: "memory");
    const int c = lane & 7;
#pragma unroll
    for (int j = 0; j < 4; ++j) { const int n = (lane >> 3) + 8 * j; const LAS float* s = scr + (8 * c) * 33 + n;
        u32x4 o; o.x = cvt_pk_bf16(s[0 * 33], s[1 * 33]); o.y = cvt_pk_bf16(s[2 * 33], s[3 * 33]); o.z = cvt_pk_bf16(s[4 * 33], s[5 * 33]); o.w = cvt_pk_bf16(s[6 * 33], s[7 * 33]);
        *(u32x4*)(WT + (size_t)(r0 + n) * ldw + koff + k0 + 8 * c) = o; }
    asm volatile("s_waitcnt lgkmcnt(0)" ::: "memory");
}
__device__ __forceinline__ void rms_row(const float* xrow, const float* g, bf16_t* orow, int lane) {
    f32x4 v[8]; float s = 0.f;
#pragma unroll
    for (int j = 0; j < 8; ++j) { v[j] = ((const f32x4*)xrow)[64 * j + lane]; s += (v[j].x * v[j].x + v[j].y * v[j].y) + (v[j].z * v[j].z + v[j].w * v[j].w); }
    const float rstd = rsqrtf(wave_sum(s) * (1.f / DM) + 1e-6f);
#pragma unroll
    for (int j = 0; j < 8; ++j) { const f32x4 gg = ((const f32x4*)g)[64 * j + lane];
        u32x2 w; w.x = cvt_pk_bf16(v[j].x * rstd * gg.x, v[j].y * rstd * gg.y); w.y = cvt_pk_bf16(v[j].z * rstd * gg.z, v[j].w * rstd * gg.w);
        ((u32x2*)orow)[64 * j + lane] = w; }
}

__device__ __forceinline__ void p0_prologue(const Args& a, LAS unsigned char* lds, int vcu, int G) {
    const int tid = threadIdx.x, lane = tid & 63, wave = tid >> 6;
    unsigned char* ws = a.ws;
    LAS float* scr = (LAS float*)(lds + wave * 16384);
    const int gw = vcu * 8 + wave, NGW = G * 8;
    constexpr int I0 = 32 * 240, I1 = 32 * 192, I2 = 32 * 64, I3 = 16 * 64, I6 = 32 * 64, I7 = 32 * 352, I8 = 88 * 64;
    constexpr int NITEMS = I0 + I1 + I2 + 3 * I3 + I6 + I7 + I8;
    for (int it = gw; it < NITEMS; it += NGW) {
        int r = it;
        if (r < I0) { const int kb = r / 240, nb = r % 240, r0 = nb * 32; int src;
            if (r0 < 2048) { const int tile = r0 >> 8, cp = r0 & 255, h = cp >> 7, g = (cp & 127) >> 5; src = tile * 256 + 64 * g + 32 * h; }
            else if (r0 < 6560) src = r0;
            else if (r0 < 6656) src = -1;
            else src = 6560 + (r0 - 6656);
            tr_item(a.in[5], 13728, src, (bf16_t*)(ws + WS_WIN), 2048, 0, r0, kb * 64, scr, lane); continue; } r -= I0;
        if (r < I1) { const int kb = r / 192, nb = r % 192; tr_item(a.in[5], 13728, 7584 + nb * 32, (bf16_t*)(ws + WS_WG), 2048, 0, nb * 32, kb * 64, scr, lane); continue; } r -= I1;
        if (r < I2) { const int kb = r / 64, nb = r % 64; tr_item(a.in[26], 2048, nb * 32, (bf16_t*)(ws + WS_WKV), 2048, 0, nb * 32, kb * 64, scr, lane); continue; } r -= I2;
        if (r < I3) { const int kb = r / 64, nb = r % 64; tr_item(a.in[29], 2048, nb * 32, (bf16_t*)(ws + WS_PAR), 2048, 0, nb * 32, kb * 64, scr, lane); continue; } r -= I3;
        if (r < I3) { const int kb = r / 64, nb = r % 64; tr_item(a.in[30], 2048, nb * 32, (bf16_t*)(ws + WS_PAR), 2048, 1024, nb * 32, kb * 64, scr, lane); continue; } r -= I3;
        if (r < I3) { const int kb = r / 64, nb = r % 64; tr_item(a.in[31], 2048, nb * 32, (bf16_t*)(ws + WS_PM2), 2048, 0, nb * 32, kb * 64, scr, lane); continue; } r -= I3;
        if (r < I6) { const int kb = r / 64, nb = r % 64; tr_item(a.in[32], 2048, nb * 32, (bf16_t*)(ws + WS_WO), 2048, 0, nb * 32, kb * 64, scr, lane); continue; } r -= I6;
        if (r < I7) { const int kb = r / 352, nb = r % 352, r0 = nb * 32, tile = r0 >> 8, bj = (r0 & 255) >> 7, j = r0 & 127;
            tr_item(a.in[34], 2 * DFF, bj * DFF + 128 * tile + j, (bf16_t*)(ws + WS_WUP), 2048, 0, r0, kb * 64, scr, lane); continue; } r -= I7;
        { const int kb = r / 64, nb = r % 64; tr_item(a.in[37], 2048, nb * 32, (bf16_t*)(ws + WS_WDN), DFF, 0, nb * 32, kb * 64, scr, lane); }
    }
    for (int m = gw; m < NT + 1280; m += NGW) {
        if (m < NT) { const float* xr = m < TP ? a.in[0] + (size_t)m * DM : a.in[1] + (size_t)(m - TP) * DM; rms_row(xr, a.in[4], (bf16_t*)(ws + WS_H) + (size_t)m * DM, lane); }
        else { const int j = m - NT; const float* xr = j < 256 ? a.in[2] + (size_t)j * DM : a.in[3] + (size_t)(j - 256) * DM; rms_row(xr, a.in[25], (bf16_t*)(ws + WS_MEMN) + (size_t)j * DM, lane); }
    }
    { float* rc = (float*)(ws + WS_ROPE); float* rs = rc + TP * 32;
      for (int e = (vcu * NTHR + tid); e < TP * 32; e += G * NTHR) { const int t = e >> 5, d = e & 31; double rev = (double)t * a.inv_rev[d]; rev -= rint(rev); const float rf = (float)rev;
          rc[e] = __builtin_amdgcn_cosf(rf); rs[e] = __builtin_amdgcn_sinf(rf); } }
    if (blockIdx.x == 0) {
        unsigned* ctl = (unsigned*)(ws + WS_CTL);
        if (tid < 64) {
            if (tid == 0) { ctl[CW_QUEUE] = 0u; ctl[256] = 0u; ctl[257] = 0u; }
            const float s1 = wave_sum(a.in[8][tid] * a.in[9][tid]), s2 = wave_sum(a.in[10][tid] * a.in[11][tid]);
            if (tid == 0) ((float*)ctl)[CW_LAM] = __expf(s1) - __expf(s2) + 0.2f;
        }
    }
}

struct SchedIn {
    int v, G; const char* H; const char* WIN; const char* MEMN; const char* WKV;
    __device__ __forceinline__ bool next(int i, Unit& u) const {
        long L = (long)i * G + v; int pm, pn;
        if (L < 5760) { TileMap{192, 30}.get(L, pm, pn); u.A = H + (size_t)pm * MiB; u.B = WIN + (size_t)pn * MiB; u.nt = 32; u.pm = pm; u.pn = pn; u.kind = 0; u.t0 = 0; u.T = 0; return true; }
        L -= 5760; if (L < 40) { pm = (int)(L % 5); pn = (int)(L / 5); u.A = MEMN + (size_t)pm * MiB; u.B = WKV + (size_t)pn * MiB; u.nt = 32; u.pm = pm; u.pn = pn; u.kind = 1; u.t0 = 0; u.T = 0; return true; }
        return false;
    }
};
struct EpiIn {
    bf16_t* QK; bf16_t* VM; bf16_t* ZR; bf16_t* KVM; const float* qn; const float* kn; const float* rc; const float* rs;
    __device__ __forceinline__ void plain(const f32x4 (&acc)[2][2][4][2], bf16_t* base, size_t ldc, int row0, int col0) const {
#pragma unroll
        for (int ai = 0; ai < 2; ++ai)
#pragma unroll
            for (int m = 0; m < 4; ++m) { bf16_t* rowp = base + (size_t)(row0 + ai * 128 + m * 16) * ldc + col0;
#pragma unroll
                for (int bj = 0; bj < 2; ++bj) { const f32x4 v0 = acc[ai][bj][m][0], v1 = acc[ai][bj][m][1];
                    u32x4 w; w.x = cvt_pk_bf16(v0[0], v0[1]); w.y = cvt_pk_bf16(v0[2], v0[3]); w.z = cvt_pk_bf16(v1[0], v1[1]); w.w = cvt_pk_bf16(v1[2], v1[3]);
                    *(u32x4*)(rowp + bj * 128) = w; } }
    }
    __device__ __forceinline__ void operator()(const f32x4 (&acc)[2][2][4][2], const Unit& u, int wr, int wc, int fr, int fq) const {
        const int row0 = u.pm * 256 + wr * 64 + fr, cin = wc * 32 + 8 * fq;
        if (u.kind == 1) { plain(acc, KVM, 2048, row0, u.pn * 256 + cin); return; }
        const int pn = u.pn;
        if (pn < 8) {
            const bool isq = pn < 4; const float* nw = isq ? qn : kn;
            const int Gq = (pn & 3) * 4 + wc, d0 = 8 * fq;
            const float qs = isq ? 0.125f * 1.4426950408889634f : 1.f;
            const f32x4 w1a = *(const f32x4*)(nw + d0), w1b = *(const f32x4*)(nw + d0 + 4), w2a = *(const f32x4*)(nw + 32 + d0), w2b = *(const f32x4*)(nw + 36 + d0);
            bf16_t* dst = QK + (isq ? 0 : 1024) + Gq * 64 + d0;
#pragma unroll
            for (int ai = 0; ai < 2; ++ai)
#pragma unroll
                for (int m = 0; m < 4; ++m) {
                    const int row = row0 + ai * 128 + m * 16, t = tok_pos(row);
                    const f32x4 xa = acc[ai][0][m][0], xb = acc[ai][0][m][1], ya = acc[ai][1][m][0], yb = acc[ai][1][m][1];
                    float ss = (xa[0] * xa[0] + xa[1] * xa[1]) + (xa[2] * xa[2] + xa[3] * xa[3]) + (xb[0] * xb[0] + xb[1] * xb[1]) + (xb[2] * xb[2] + xb[3] * xb[3])
                             + (ya[0] * ya[0] + ya[1] * ya[1]) + (ya[2] * ya[2] + ya[3] * ya[3]) + (yb[0] * yb[0] + yb[1] * yb[1]) + (yb[2] * yb[2] + yb[3] * yb[3]);
                    ss += __shfl_xor(ss, 16); ss += __shfl_xor(ss, 32);
                    const float rstd = rsqrtf(ss * (1.f / 64.f) + 1e-6f);
                    const f32x4 ca = *(const f32x4*)(rc + t * 32 + d0), cb = *(const f32x4*)(rc + t * 32 + d0 + 4), sa = *(const f32x4*)(rs + t * 32 + d0), sb = *(const f32x4*)(rs + t * 32 + d0 + 4);
                    const f32x4 x1a = xa * rstd * w1a, x1b = xb * rstd * w1b, x2a = ya * rstd * w2a, x2b = yb * rstd * w2b;
                    const f32x4 o1a = (x1a * ca - x2a * sa) * qs, o1b = (x1b * cb - x2b * sb) * qs, o2a = (x2a * ca + x1a * sa) * qs, o2b = (x2b * cb + x1b * sb) * qs;
                    u32x4 w; w.x = cvt_pk_bf16(o1a[0], o1a[1]); w.y = cvt_pk_bf16(o1a[2], o1a[3]); w.z = cvt_pk_bf16(o1b[0], o1b[1]); w.w = cvt_pk_bf16(o1b[2], o1b[3]);
                    *(u32x4*)(dst + (size_t)row * 2048) = w;
                    w.x = cvt_pk_bf16(o2a[0], o2a[1]); w.y = cvt_pk_bf16(o2a[2], o2a[3]); w.z = cvt_pk_bf16(o2b[0], o2b[1]); w.w = cvt_pk_bf16(o2b[2], o2b[3]);
                    *(u32x4*)(dst + (size_t)row * 2048 + 32) = w;
                }
        } else if (pn < 12) plain(acc, VM, 2048, row0, (pn - 8) * 256 + cin);
        else if (pn < 26) plain(acc, ZR, ZRP, row0, (pn - 12) * 256 + cin);
        else plain(acc, VM, 2048, row0, 1024 + (pn - 26) * 256 + cin);
    }
};

namespace att {
constexpr int SHM_V = 16384, SHM_K = 8192;
constexpr int OFF_V = 0, OFF_K = 32768, OFF_WS = 49152, OFF_STASH = 51200;
#define KSWZ64(row, colB) ((row) * 128 + ((colB) ^ (((row) & 7) << 4)))
#define SBAR() __builtin_amdgcn_sched_barrier(0)
__device__ __forceinline__ int crow(int r, int hi) { return (r & 3) + 8 * (r >> 2) + 4 * hi; }
constexpr float THRL = 8.f;
__device__ __forceinline__ void partialSM(f32x16& p0, f32x16& p1, float& m_reg, float& alpha) {
    float pmax = fmaxf(fmaxf(p0[0], p0[1]), p0[2]);
#pragma unroll
    for (int r = 3; r < 15; r += 2) pmax = fmaxf(fmaxf(pmax, p0[r]), p0[r + 1]);
    pmax = fmaxf(fmaxf(pmax, p0[15]), p1[0]);
#pragma unroll
    for (int r = 1; r < 15; r += 2) pmax = fmaxf(fmaxf(pmax, p1[r]), p1[r + 1]);
    pmax = fmaxf(pmax, p1[15]);
    { auto rr = __builtin_amdgcn_permlane32_swap(__float_as_uint(pmax), __float_as_uint(pmax), false, false);
      pmax = fmaxf(__uint_as_float(rr[0]), __uint_as_float(rr[1])); }
    if (__builtin_expect(__all(pmax <= THRL), 1)) { alpha = 1.f; }
    else { const float dl = fmaxf(pmax, 0.f); alpha = __builtin_amdgcn_exp2f(-dl); m_reg += dl;
#pragma unroll
        for (int r = 0; r < 16; ++r) { p0[r] -= dl; p1[r] -= dl; } }
#pragma unroll
    for (int r = 0; r < 16; ++r) p0[r] = __builtin_amdgcn_exp2f(p0[r]);
}
__device__ __forceinline__ void finishSM(f32x16& p0, f32x16& p1, float alpha, float& l_reg, bf16x8& pa0, bf16x8& pa1, bf16x8& pa2, bf16x8& pa3) {
#pragma unroll
    for (int r = 0; r < 16; ++r) p1[r] = __builtin_amdgcn_exp2f(p1[r]);
    f32x2 s2 = (f32x2){p0[0], p0[1]} + (f32x2){p1[0], p1[1]};
#pragma unroll
    for (int r = 2; r < 16; r += 2) { s2 = s2 + (f32x2){p0[r], p0[r + 1]}; s2 = s2 + (f32x2){p1[r], p1[r + 1]}; }
    float ps = s2[0] + s2[1];
    { auto rr = __builtin_amdgcn_permlane32_swap(__float_as_uint(ps), __float_as_uint(ps), false, false);
      ps = __uint_as_float(rr[0]) + __uint_as_float(rr[1]); }
    l_reg = l_reg * alpha + ps;
#define PK4(P, BASE, OUT) do { unsigned a0 = cvt_pk_bf16(P[BASE + 0], P[BASE + 1]), a1 = cvt_pk_bf16(P[BASE + 2], P[BASE + 3]);   \
    unsigned b0 = cvt_pk_bf16(P[BASE + 4], P[BASE + 5]), b1 = cvt_pk_bf16(P[BASE + 6], P[BASE + 7]);                              \
    auto r0 = __builtin_amdgcn_permlane32_swap(a0, b0, false, false); auto r1 = __builtin_amdgcn_permlane32_swap(a1, b1, false, false); \
    u32x4 w = {r0[0], r1[0], r0[1], r1[1]}; OUT = *reinterpret_cast<bf16x8*>(&w); } while (0)
    PK4(p0, 0, pa0); PK4(p0, 8, pa1); PK4(p1, 0, pa2); PK4(p1, 8, pa3);
#undef PK4
}
__device__ __forceinline__ void qkt64(f32x16& p0, f32x16& p1, const char* Ks, const bf16x8* qr, int r32, int hi) {
#pragma unroll
    for (int d0 = 0; d0 < 4; ++d0) { const int cb = (d0 * 16 + hi * 8) * 2;
        const bf16x8 b0 = *reinterpret_cast<const bf16x8*>(Ks + KSWZ64(r32, cb));
        const bf16x8 b1 = *reinterpret_cast<const bf16x8*>(Ks + KSWZ64(32 + r32, cb));
        p0 = __builtin_amdgcn_mfma_f32_32x32x16_bf16(b0, qr[d0], p0, 0, 0, 0);
        p1 = __builtin_amdgcn_mfma_f32_32x32x16_bf16(b1, qr[d0], p1, 0, 0, 0); }
}
__device__ __forceinline__ int v_st(int k, int c) { const int kk = (k & ~0xC) | ((k & 4) << 1) | ((k & 8) >> 1); return ((kk >> 3) * 4 + (c >> 5)) * 512 + ((kk & 7) * 32 + (c & 31)) * 2; }
__device__ __forceinline__ int v_rd_base(int lane) { return ((lane & 3) << 3) | (((lane >> 2) & 3) << 6) | (((lane >> 4) & 1) << 5) | (((lane >> 5) & 1) << 8); }
constexpr int v_rd_off(int d0, int ks, int half) { return d0 * 512 + ks * 4096 + half * 2048; }
template <int OFF> __device__ __forceinline__ s16x4 tr_read(int vb) {
    s16x4 r; asm volatile("ds_read_b64_tr_b16 %0, %1 offset:%2" : "=&v"(r) : "v"(vb), "i"(OFF) : "memory"); return r;
}
template <int KS> __device__ __forceinline__ void pv_ks(f32x16* o, int vb, bf16x8 pa) {
    const s16x4 l0 = tr_read<v_rd_off(0, KS, 0)>(vb), h0 = tr_read<v_rd_off(0, KS, 1)>(vb), l1 = tr_read<v_rd_off(1, KS, 0)>(vb), h1 = tr_read<v_rd_off(1, KS, 1)>(vb);
    const s16x4 l2 = tr_read<v_rd_off(2, KS, 0)>(vb), h2 = tr_read<v_rd_off(2, KS, 1)>(vb), l3 = tr_read<v_rd_off(3, KS, 0)>(vb), h3 = tr_read<v_rd_off(3, KS, 1)>(vb);
    asm volatile("s_waitcnt lgkmcnt(0)" ::: "memory"); SBAR();
#define PK(L, H) (bf16x8){L[0], L[1], L[2], L[3], H[0], H[1], H[2], H[3]}
    o[0] = __builtin_amdgcn_mfma_f32_32x32x16_bf16(pa, PK(l0, h0), o[0], 0, 0, 0);
    o[1] = __builtin_amdgcn_mfma_f32_32x32x16_bf16(pa, PK(l1, h1), o[1], 0, 0, 0);
    o[2] = __builtin_amdgcn_mfma_f32_32x32x16_bf16(pa, PK(l2, h2), o[2], 0, 0, 0);
    o[3] = __builtin_amdgcn_mfma_f32_32x32x16_bf16(pa, PK(l3, h3), o[3], 0, 0, 0);
#undef PK
}
__device__ __forceinline__ void pv_d0(f32x16* o, int vb, bf16x8 pa0, bf16x8 pa1, bf16x8 pa2, bf16x8 pa3) {
    pv_ks<0>(o, vb, pa0); pv_ks<1>(o, vb, pa1); pv_ks<2>(o, vb, pa2); pv_ks<3>(o, vb, pa3);
}

__device__ __forceinline__ void stash_store(const unsigned* stash, bf16_t* Ow, int ldo, int lane) {
#pragma unroll
    for (int i = 0; i < 8; ++i) { const int q = i * 64 + lane, rl = q >> 4, c8 = (q & 15) * 8, hh = (rl >> 2) & 1, r = (rl & 3) + 4 * (rl >> 3), d0 = c8 >> 5, cc = c8 & 31;
        const unsigned* sp = stash + (d0 * 8 + (r >> 1)) * 64 + hh * 32 + cc; const u32x4 a = *(const u32x4*)sp, b = *(const u32x4*)(sp + 4);
        u32x4 w;
        if (r & 1) { w.x = (a.x >> 16) | (a.y & 0xffff0000u); w.y = (a.z >> 16) | (a.w & 0xffff0000u); w.z = (b.x >> 16) | (b.y & 0xffff0000u); w.w = (b.z >> 16) | (b.w & 0xffff0000u); }
        else { w.x = (a.x & 0xffffu) | (a.y << 16); w.y = (a.z & 0xffffu) | (a.w << 16); w.z = (b.x & 0xffffu) | (b.y << 16); w.w = (b.z & 0xffffu) | (b.w << 16); }
        *(u32x4*)(Ow + (size_t)rl * ldo + c8) = w; }
}

__device__ __forceinline__ void diff_unit(int s, int h, int qb, bf16_t* QK, const bf16_t* VM, float lam, char* lds) {
    constexpr int LDK = 2048;
    int tid = threadIdx.x; asm volatile("" : "+v"(tid));
    const int wid = __builtin_amdgcn_readfirstlane(tid >> 6), lane = tid & 63, r32 = lane & 31, hi = lane >> 5;
    const int tok0 = seq_start(s), T = seq_len(s), NTL = T / 64;
    char* V_lds = lds + OFF_V; char* K_lds = lds + OFF_K;
    float* wsf = (float*)(lds + OFF_WS) + wid * 64; float* li_l = wsf; float* al_l = wsf + 32;
    unsigned* stash = (unsigned*)(lds + OFF_STASH) + wid * 2048;
    const int sr = tid >> 4, sc = (tid & 15) * 8, vst0 = v_st(sr, sc), vst1 = v_st(32 + sr, sc);
    const int kr = tid >> 3, kc = (tid & 7) * 8, kst = KSWZ64(kr, kc * 2);
    const int vb0 = (int)(uintptr_t)V_lds + v_rd_base(lane);
    const bf16_t* Vh = VM + (size_t)tok0 * LDK + h * 128;
    const size_t qrow = (size_t)(tok0 + qb * 256 + wid * 32);
#pragma unroll 1
    for (int c = 0; c < 2; ++c) {
        const bf16_t* Kh = QK + (size_t)tok0 * LDK + 1024 + h * 128 + c * 64;
        const bf16_t* Qw = QK + (qrow + r32) * LDK + h * 128 + c * 64 + hi * 8;
        bf16x8 qr[4];
#pragma unroll
        for (int d0 = 0; d0 < 4; ++d0) qr[d0] = *reinterpret_cast<const bf16x8*>(Qw + d0 * 16);
        float m_reg = 0.f, l_reg = 0; f32x16 o[4] = {};
        struct { bf16x8 vs0, vs1, ks0; } sr_[2];
#define NEGM(P) do { const float nm_ = -m_reg; _Pragma("unroll") for (int r_ = 0; r_ < 16; ++r_) P[r_] = nm_; } while (0)
#define SLOAD(i, k0) do { sr_[i].vs0 = *reinterpret_cast<const bf16x8*>(&Vh[(size_t)((k0) + sr) * LDK + sc]); sr_[i].vs1 = *reinterpret_cast<const bf16x8*>(&Vh[(size_t)((k0) + 32 + sr) * LDK + sc]); \
    sr_[i].ks0 = *reinterpret_cast<const bf16x8*>(&Kh[(size_t)((k0) + kr) * LDK + kc]); } while (0)
#define SWRITE(b, i) do { *(bf16x8*)(V_lds + (b) * SHM_V + vst0) = sr_[i].vs0; *(bf16x8*)(V_lds + (b) * SHM_V + vst1) = sr_[i].vs1; *(bf16x8*)(K_lds + (b) * SHM_K + kst) = sr_[i].ks0; } while (0)
#define SWAIT() asm volatile("s_waitcnt vmcnt(3)" ::: "memory")
#define RESC(a) do { if (__any((a) < 1.f)) { if (hi == 0) al_l[r32] = (a); asm volatile("s_waitcnt lgkmcnt(0)" ::: "memory"); \
    _Pragma("unroll") for (int d = 0; d < 4; ++d) _Pragma("unroll") for (int r = 0; r < 16; ++r) o[d][r] *= al_l[crow(r, hi)]; } } while (0)
        f32x16 pA0, pA1, pB0, pB1; float alA, alB; bf16x8 pa0, pa1, pa2, pa3;
        SLOAD(0, 0); asm volatile("s_waitcnt vmcnt(0)" ::: "memory"); SWRITE(0, 0); __syncthreads();
        NEGM(pA0); NEGM(pA1); qkt64(pA0, pA1, K_lds, qr, r32, hi); partialSM(pA0, pA1, m_reg, alA);
        SLOAD(1, 64); if (2 < NTL) SLOAD(0, 128);
        SWAIT(); SWRITE(1, 1); __syncthreads();
        for (int j = 1; j + 1 < NTL; j += 2) {
            SBAR(); NEGM(pB0); NEGM(pB1); qkt64(pB0, pB1, K_lds + SHM_K, qr, r32, hi);
            finishSM(pA0, pA1, alA, l_reg, pa0, pa1, pa2, pa3); SBAR();
            SLOAD(1, (j + 2) * 64); SBAR();
            pv_d0(o, vb0, pa0, pa1, pa2, pa3); partialSM(pB0, pB1, m_reg, alB);
            __syncthreads(); SWAIT(); SWRITE(0, 0);
            RESC(alB); __syncthreads();
            SBAR(); NEGM(pA0); NEGM(pA1); qkt64(pA0, pA1, K_lds, qr, r32, hi);
            finishSM(pB0, pB1, alB, l_reg, pa0, pa1, pa2, pa3); SBAR();
            if (j + 3 < NTL) SLOAD(0, (j + 3) * 64); SBAR();
            pv_d0(o, vb0 + SHM_V, pa0, pa1, pa2, pa3); partialSM(pA0, pA1, m_reg, alA);
            __syncthreads(); SWAIT(); SWRITE(1, 1);
            RESC(alA); __syncthreads();
        }
        SBAR(); NEGM(pB0); NEGM(pB1); qkt64(pB0, pB1, K_lds + SHM_K, qr, r32, hi);
        finishSM(pA0, pA1, alA, l_reg, pa0, pa1, pa2, pa3); SBAR();
        pv_d0(o, vb0, pa0, pa1, pa2, pa3); partialSM(pB0, pB1, m_reg, alB);
        __syncthreads(); RESC(alB);
        finishSM(pB0, pB1, alB, l_reg, pa0, pa1, pa2, pa3); SBAR();
        pv_d0(o, vb0 + SHM_V, pa0, pa1, pa2, pa3);
#undef SLOAD
#undef SWRITE
#undef SWAIT
#undef RESC
#undef NEGM
        if (hi == 0) li_l[r32] = l_reg; asm volatile("s_waitcnt lgkmcnt(0)" ::: "memory");
        float rli[16];
#pragma unroll
        for (int r = 0; r < 16; ++r) rli[r] = __builtin_amdgcn_rcpf(li_l[crow(r, hi)]);
        { const float coef = c == 0 ? 1.f : -lam;
#pragma unroll
          for (int d0 = 0; d0 < 4; ++d0)
#pragma unroll
              for (int r = 0; r < 16; r += 2) { const int idx = (d0 * 8 + (r >> 1)) * 64 + lane; const unsigned w = c == 0 ? 0u : stash[idx];
                  stash[idx] = cvt_pk_bf16(bflo(w) + coef * o[d0][r] * rli[r], bfhi(w) + coef * o[d0][r + 1] * rli[r + 1]); } }
        __syncthreads();
    }
    stash_store(stash, QK + qrow * LDK + h * 128, LDK, lane);
    __syncthreads();
}

constexpr int MOFF_V = 0, MOFF_K = 32768, MOFF_WS = 65536, MOFF_RK = 67584, MOFF_G = 68608, MOFF_STASH = 69632;
__device__ __forceinline__ void mem_unit(int s, int mh, int qb, bf16_t* VM, const bf16_t* KVM, const float* mqn, const float* mkn, char* lds) {
    int tid = threadIdx.x; asm volatile("" : "+v"(tid));
    const int wid = __builtin_amdgcn_readfirstlane(tid >> 6), lane = tid & 63, r32 = lane & 31, hi = lane >> 5;
    const int tok0 = seq_start(s);
    char* V_lds = lds + MOFF_V; char* K_lds = lds + MOFF_K;
    float* wsf = (float*)(lds + MOFF_WS) + wid * 64; float* li_l = wsf; float* al_l = wsf + 32;
    float* rk_l = (float*)(lds + MOFF_RK); float* g_l = (float*)(lds + MOFF_G);
    const bf16_t* Kh = KVM + (size_t)(s * 256) * 2048 + mh * 256;
    const bf16_t* Vh = KVM + (size_t)(s * 256) * 2048 + 1024 + mh * 256;
    if (tid < 256) g_l[tid] = mqn[tid] * mkn[tid];
    {
        const bf16_t* kp = Kh + (size_t)(wid * 32 + r32) * 2048 + hi * 128; float ss = 0.f;
#pragma unroll
        for (int i = 0; i < 16; ++i) { const u32x4 w = *(const u32x4*)(kp + i * 8);
            ss += bflo(w.x) * bflo(w.x) + bfhi(w.x) * bfhi(w.x) + bflo(w.y) * bflo(w.y) + bfhi(w.y) * bfhi(w.y) + bflo(w.z) * bflo(w.z) + bfhi(w.z) * bfhi(w.z) + bflo(w.w) * bflo(w.w) + bfhi(w.w) * bfhi(w.w); }
        ss += __shfl_xor(ss, 32);
        if (hi == 0) rk_l[wid * 32 + r32] = rsqrtf(ss * (1.f / 256.f) + 1e-6f);
    }
    const size_t qrow = (size_t)(tok0 + qb * 256 + wid * 32);
    bf16_t* Qw = VM + (qrow + r32) * 2048 + 1024 + mh * 256 + hi * 8;
    float rqC;
    { float ss = 0.f;
#pragma unroll
      for (int i = 0; i < 16; ++i) { const u32x4 w = *(const u32x4*)(Qw + i * 16);
          ss += bflo(w.x) * bflo(w.x) + bfhi(w.x) * bfhi(w.x) + bflo(w.y) * bflo(w.y) + bfhi(w.y) * bfhi(w.y) + bflo(w.z) * bflo(w.z) + bfhi(w.z) * bfhi(w.z) + bflo(w.w) * bflo(w.w) + bfhi(w.w) * bfhi(w.w); }
      ss += __shfl_xor(ss, 32);
      rqC = rsqrtf(ss * (1.f / 256.f) + 1e-6f) * (0.0625f * 1.4426950408889634f); }
    const int sr = tid >> 4, sc = (tid & 15) * 8, vst0 = v_st(sr, sc), vst1 = v_st(32 + sr, sc);
    const int kr = tid >> 3, kc = (tid & 7) * 8, kst = KSWZ64(kr, kc * 2);
    const int vb0 = (int)(uintptr_t)V_lds + v_rd_base(lane);
    unsigned* stash = (unsigned*)(lds + MOFF_STASH) + wid * 2048;
    __syncthreads();
#pragma unroll 1
    for (int hv = 0; hv < 2; ++hv) {
    float m_reg = -1e30f, l_reg = 0.f; f32x16 o[4] = {};
#pragma unroll 1
    for (int t = 0; t < 4; ++t) {
        const int k0 = t * 64;
#pragma unroll
        for (int ds = 0; ds < 4; ++ds) { const u32x4 w = *(const u32x4*)(Kh + (size_t)(k0 + kr) * 2048 + ds * 64 + kc); const float* g = g_l + ds * 64 + kc;
            u32x4 o4; o4.x = cvt_pk_bf16(bflo(w.x) * g[0], bfhi(w.x) * g[1]); o4.y = cvt_pk_bf16(bflo(w.y) * g[2], bfhi(w.y) * g[3]);
            o4.z = cvt_pk_bf16(bflo(w.z) * g[4], bfhi(w.z) * g[5]); o4.w = cvt_pk_bf16(bflo(w.w) * g[6], bfhi(w.w) * g[7]);
            *(u32x4*)(K_lds + ds * 8192 + kst) = o4; asm volatile("" ::: "memory"); }
        *(u32x4*)(V_lds + vst0) = *(const u32x4*)(Vh + (size_t)(k0 + sr) * 2048 + hv * 128 + sc);
        *(u32x4*)(V_lds + vst1) = *(const u32x4*)(Vh + (size_t)(k0 + 32 + sr) * 2048 + hv * 128 + sc);
        __syncthreads();
        f32x16 p0 = {}, p1 = {};
#pragma unroll
        for (int ds = 0; ds < 4; ++ds) { bf16x8 qr[4];
#pragma unroll
            for (int d0 = 0; d0 < 4; ++d0) qr[d0] = *reinterpret_cast<const bf16x8*>(Qw + ds * 64 + d0 * 16);
            qkt64(p0, p1, K_lds + ds * 8192, qr, r32, hi); }
#pragma unroll
        for (int r = 0; r < 16; ++r) { p0[r] *= rk_l[k0 + crow(r, hi)] * rqC; p1[r] *= rk_l[k0 + 32 + crow(r, hi)] * rqC; }
        float pmax = p0[0];
#pragma unroll
        for (int r = 1; r < 16; ++r) pmax = fmaxf(pmax, p0[r]);
#pragma unroll
        for (int r = 0; r < 16; ++r) pmax = fmaxf(pmax, p1[r]);
        pmax = fmaxf(pmax, __shfl_xor(pmax, 32));
        const float mn = fmaxf(m_reg, pmax), alpha = __builtin_amdgcn_exp2f(m_reg - mn); m_reg = mn;
        float ps = 0.f;
#pragma unroll
        for (int r = 0; r < 16; ++r) { p0[r] = __builtin_amdgcn_exp2f(p0[r] - mn); p1[r] = __builtin_amdgcn_exp2f(p1[r] - mn); ps += p0[r] + p1[r]; }
        ps += __shfl_xor(ps, 32);
        l_reg = l_reg * alpha + ps;
        if (hi == 0) al_l[r32] = alpha; asm volatile("s_waitcnt lgkmcnt(0)" ::: "memory");
#pragma unroll
        for (int d = 0; d < 4; ++d)
#pragma unroll
            for (int r = 0; r < 16; ++r) o[d][r] *= al_l[crow(r, hi)];
        bf16x8 pa0, pa1, pa2, pa3;
#define PK4(P, BASE, OUT) do { unsigned a0 = cvt_pk_bf16(P[BASE + 0], P[BASE + 1]), a1 = cvt_pk_bf16(P[BASE + 2], P[BASE + 3]);   \
    unsigned b0 = cvt_pk_bf16(P[BASE + 4], P[BASE + 5]), b1 = cvt_pk_bf16(P[BASE + 6], P[BASE + 7]);                              \
    auto r0 = __builtin_amdgcn_permlane32_swap(a0, b0, false, false); auto r1 = __builtin_amdgcn_permlane32_swap(a1, b1, false, false); \
    u32x4 w = {r0[0], r1[0], r0[1], r1[1]}; OUT = *reinterpret_cast<bf16x8*>(&w); } while (0)
        PK4(p0, 0, pa0); PK4(p0, 8, pa1); PK4(p1, 0, pa2); PK4(p1, 8, pa3);
#undef PK4
        pv_d0(o, vb0, pa0, pa1, pa2, pa3);
        __syncthreads();
    }
    if (hi == 0) li_l[r32] = l_reg; asm volatile("s_waitcnt lgkmcnt(0)" ::: "memory");
    if (hv == 1) stash_store(stash, VM + qrow * 2048 + 1024 + mh * 256, 2048, lane);
#pragma unroll
    for (int d0 = 0; d0 < 4; ++d0)
#pragma unroll
        for (int r = 0; r < 16; r += 2) stash[(d0 * 8 + (r >> 1)) * 64 + lane] = cvt_pk_bf16(o[d0][r] * __builtin_amdgcn_rcpf(li_l[crow(r, hi)]), o[d0][r + 1] * __builtin_amdgcn_rcpf(li_l[crow(r + 1, hi)]));
    }
    stash_store(stash, VM + qrow * 2048 + 1024 + mh * 256 + 128, 2048, lane);
    __syncthreads();
}
#undef SBAR
}

namespace scan {
constexpr int TC = 32;
typedef _Float16 h2 __attribute__((ext_vector_type(2)));
typedef _Float16 h4 __attribute__((ext_vector_type(4)));
typedef _Float16 h8 __attribute__((ext_vector_type(8)));
constexpr int BUFB = 36864, O_R = 0, O_KD = 4096, O_KK = 8192, O_W = 12288, O_KA = 16384, O_V = 20480, O_Y = 28672;
constexpr int O_PRIV = 73728;
constexpr int O_TBL = 73728 + 32768;
__device__ __forceinline__ float dpp_red8(float x) {
    x += __uint_as_float(__builtin_amdgcn_update_dpp(0u, __float_as_uint(x), 0xB1, 0xf, 0xf, false));
    x += __uint_as_float(__builtin_amdgcn_update_dpp(0u, __float_as_uint(x), 0x4E, 0xf, 0xf, false));
    x += __uint_as_float(__builtin_amdgcn_update_dpp(0u, __float_as_uint(x), 0x141, 0xf, 0xf, false));
    return x;
}
template <int DIR> __device__ __forceinline__ void scan_chunk(const char* B_, h2 (&S)[2][4], int seg, int row0) {
    const char* base = B_ + seg * 16; const char* vbase = B_ + O_V + row0 * 4; char* ybase = (char*)B_ + O_Y + row0 * 4;
    u32x4 ck[2], cw[2], ca[2], cd[2], cr[2]; u32x2 cv[2];
#define LDSET(set, tl_) do { ck[set] = *(const u32x4*)(base + O_KK + (tl_) * 128); cw[set] = *(const u32x4*)(base + O_W + (tl_) * 128); ca[set] = *(const u32x4*)(base + O_KA + (tl_) * 128); \
    cd[set] = *(const u32x4*)(base + O_KD + (tl_) * 128); cr[set] = *(const u32x4*)(base + O_R + (tl_) * 128); cv[set] = *(const u32x2*)(vbase + (tl_) * 256); } while (0)
#define H2(u) __builtin_bit_cast(h2, (u))
    LDSET(0, DIR ? TC - 1 : 0);
#pragma unroll
    for (int st = 0; st < TC; ++st) {
        const int tl = DIR ? TC - 1 - st : st, cs = st & 1;
        if (st + 1 < TC) LDSET(cs ^ 1, DIR ? TC - 2 - st : st + 1);
#define SPLIT4(V, A0, A1, A2, A3) const h8 V##8 = __builtin_bit_cast(h8, V[cs]); const h2 A0 = __builtin_shufflevector(V##8, V##8, 0, 1), A1 = __builtin_shufflevector(V##8, V##8, 2, 3), \
    A2 = __builtin_shufflevector(V##8, V##8, 4, 5), A3 = __builtin_shufflevector(V##8, V##8, 6, 7)
        SPLIT4(ck, k0, k1, k2, k3); SPLIT4(cw, w0, w1, w2, w3); SPLIT4(ca, a0, a1, a2, a3); SPLIT4(cd, d0, d1, d2, d3); SPLIT4(cr, r0, r1, r2, r3);
#undef SPLIT4
        const h4 cv4 = __builtin_bit_cast(h4, cv[cs]);
        f32x2 yo;
#pragma unroll
        for (int h = 0; h < 2; ++h) {
            const h2 vv = h == 0 ? __builtin_shufflevector(cv4, cv4, 0, 1) : __builtin_shufflevector(cv4, cv4, 2, 3);
            float d = __builtin_amdgcn_fdot2(S[h][0], k0, 0.f, false); float e = __builtin_amdgcn_fdot2(S[h][2], k2, 0.f, false);
            d = __builtin_amdgcn_fdot2(S[h][1], k1, d, false); e = __builtin_amdgcn_fdot2(S[h][3], k3, e, false);
            d = dpp_red8(d + e);
            const h2 p0 = S[h][0] * w0 + vv * d0, p1 = S[h][1] * w1 + vv * d1, p2 = S[h][2] * w2 + vv * d2, p3 = S[h][3] * w3 + vv * d3;
            const _Float16 sh = (_Float16)(-d); const h2 sa = {sh, sh};
            S[h][0] = p0 + sa * a0; S[h][1] = p1 + sa * a1; S[h][2] = p2 + sa * a2; S[h][3] = p3 + sa * a3;
            float y = __builtin_amdgcn_fdot2(S[h][0], r0, 0.f, false); float z = __builtin_amdgcn_fdot2(S[h][2], r2, 0.f, false);
            y = __builtin_amdgcn_fdot2(S[h][1], r1, y, false); z = __builtin_amdgcn_fdot2(S[h][3], r3, z, false);
            yo[h] = dpp_red8(y + z);
        }
        if (seg == 0) *(f32x2*)(ybase + tl * 256) = yo;
    }
#undef LDSET
#undef H2
}
__device__ __forceinline__ unsigned pkh(float a, float b) { const h2 v = {(_Float16)a, (_Float16)b}; return __builtin_bit_cast(unsigned, v); }
struct P {
    const bf16_t* ZR; bf16_t* YB; float* BON;
    const float *mup, *mun, *w0, *w2, *a0, *a2, *kk_w, *ka_w, *rk_w;
};
__device__ __forceinline__ void job(int s, int dir, int head, const P& p, char* lds) {
    int tid = threadIdx.x; asm volatile("" : "+v"(tid));
    const int wid = __builtin_amdgcn_readfirstlane(tid >> 6), lane = tid & 63;
    const int tok0 = seq_start(s), T = seq_len(s), NCH = T / TC;
    float* TBL = (float*)(lds + O_TBL);
    float* MUP = TBL; float* MUN = TBL + 320; float* KKW = TBL + 640; float* KAW = TBL + 704; float* RKW = TBL + 768; float* BW = TBL + 832; float* BA = TBL + 896;
    __syncthreads();
    if (tid < 320) { const int which = tid >> 6, j = tid & 63; const int col = which < 3 ? which * 1024 + head * 64 + j : (which == 3 ? 3072 : 3200) + dir * 64 + j; MUP[tid] = p.mup[col]; MUN[tid] = p.mun[col]; }
    if (tid >= 320 && tid < 384) { const int j = tid - 320; KKW[j] = p.kk_w[head * 64 + j]; KAW[j] = p.ka_w[head * 64 + j]; RKW[j] = p.rk_w[head * 64 + j];
        BW[j] = p.w0[dir * 1024 + head * 64 + j]; BA[j] = p.a0[dir * 1024 + head * 64 + j]; }
    bf16_t* yb = p.YB + (size_t)dir * NT * 1024; float* bon = p.BON + (size_t)dir * NT * 16;
    if (wid >= 4) {
        const int pw = wid - 4;
        char* priv = lds + O_PRIV + pw * 8192;
        bf16_t* AWl = (bf16_t*)priv; bf16_t* AAl = AWl + 512; float* PK = (float*)(priv + 2048); float* PA = (float*)(priv + 4096); float* PR = (float*)(priv + 6144);
        bf16x8 Bf[2][4][2];
#pragma unroll
        for (int mat = 0; mat < 2; ++mat)
#pragma unroll
            for (int cbk = 0; cbk < 4; ++cbk)
#pragma unroll
                for (int ks = 0; ks < 2; ++ks) { const float* W2 = (mat == 0 ? p.w2 : p.a2) + (size_t)dir * 64 * 1024 + head * 64 + cbk * 16 + (lane & 15) + (size_t)(ks * 32 + (lane >> 4) * 8) * 1024;
                    float f[8];
#pragma unroll
                    for (int e = 0; e < 8; ++e) f[e] = W2[(size_t)e * 1024];
                    u32x4 w; w.x = cvt_pk_bf16(f[0], f[1]); w.y = cvt_pk_bf16(f[2], f[3]); w.z = cvt_pk_bf16(f[4], f[5]); w.w = cvt_pk_bf16(f[6], f[7]); Bf[mat][cbk][ks] = *reinterpret_cast<bf16x8*>(&w); }
        __syncthreads();
        const int pt = tid - 256;
        u32x4 zc[5], zm[5], zn[5];
#define PLOAD(cc) do { const int tf_ = dir ? T - TC * ((cc) + 1) : TC * (cc); \
    _Pragma("unroll") for (int k = 0; k < 5; ++k) { const int which = k, tl8 = lane >> 3, j0 = (lane & 7) * 8; \
        const int col = which < 3 ? which * 1024 + head * 64 + j0 : (which == 3 ? 3072 : 3200) + dir * 64 + j0; \
        const int t = tf_ + 8 * pw + tl8; const bf16_t* zp = p.ZR + (size_t)(tok0 + t) * ZRP + col; \
        zc[k] = *(const u32x4*)zp; zm[k] = (u32x4){0u, 0u, 0u, 0u}; zn[k] = (u32x4){0u, 0u, 0u, 0u}; \
        if (t > 0) zm[k] = *(const u32x4*)(zp - ZRP); \
        if (t < T - 1) zn[k] = *(const u32x4*)(zp + ZRP); } } while (0)
        PLOAD(0);
        for (int c = -1; c < NCH; ++c) {
            if (c >= 1) { const int cb_ = (c - 1) & 1, tf = dir ? T - TC * c : TC * (c - 1); const int tl = pt >> 3, c8 = (pt & 7) * 8;
                const float* yp = (const float*)(lds + cb_ * BUFB + O_Y) + tl * 64 + c8; const f32x4 y4 = *(const f32x4*)yp, y5 = *(const f32x4*)(yp + 4);
                u32x4 w; w.x = cvt_pk_bf16(y4[0], y4[1]); w.y = cvt_pk_bf16(y4[2], y4[3]); w.z = cvt_pk_bf16(y5[0], y5[1]); w.w = cvt_pk_bf16(y5[2], y5[3]);
                *(u32x4*)(yb + (size_t)(tok0 + tf + tl) * 1024 + head * 64 + c8) = w; }
            if (c + 1 < NCH) {
                const int nb = (c + 1) & 1, tfirst = dir ? T - TC * (c + 2) : TC * (c + 1);
                char* B_ = lds + nb * BUFB;
#pragma unroll
                for (int k = 0; k < 5; ++k) { const int which = k, tl8 = lane >> 3, j0 = (lane & 7) * 8, tl = 8 * pw + tl8;
                    const f32x4 mpa = *(const f32x4*)(MUP + which * 64 + j0), mpb = *(const f32x4*)(MUP + which * 64 + j0 + 4), mna = *(const f32x4*)(MUN + which * 64 + j0), mnb = *(const f32x4*)(MUN + which * 64 + j0 + 4);
                    const u32x4 z = zc[k], zmm = zm[k], znn = zn[k];
                    float v[8];
#define SH(i, zw, zmw, znw, lohi, mp_, mn_) { const float zz = lohi(zw), a_ = lohi(zmw), b_ = lohi(znw); v[i] = zz + mp_ * (a_ - zz) + mn_ * (b_ - zz); }
                    SH(0, z.x, zmm.x, znn.x, bflo, mpa[0], mna[0]) SH(1, z.x, zmm.x, znn.x, bfhi, mpa[1], mna[1]) SH(2, z.y, zmm.y, znn.y, bflo, mpa[2], mna[2]) SH(3, z.y, zmm.y, znn.y, bfhi, mpa[3], mna[3])
                    SH(4, z.z, zmm.z, znn.z, bflo, mpb[0], mnb[0]) SH(5, z.z, zmm.z, znn.z, bfhi, mpb[1], mnb[1]) SH(6, z.w, zmm.w, znn.w, bflo, mpb[2], mnb[2]) SH(7, z.w, zmm.w, znn.w, bfhi, mpb[3], mnb[3])
#undef SH
                    if (which < 2) { float* dst = (which == 0 ? PR : PK) + tl8 * 64 + j0;
                        *(f32x4*)dst = (f32x4){v[0], v[1], v[2], v[3]}; *(f32x4*)(dst + 4) = (f32x4){v[4], v[5], v[6], v[7]}; }
                    else if (which == 2) { unsigned* dst = (unsigned*)(B_ + O_V) + tl * 64 + j0;
                        *(u32x4*)dst = (u32x4){pkh(v[0], v[0]), pkh(v[1], v[1]), pkh(v[2], v[2]), pkh(v[3], v[3])}; *(u32x4*)(dst + 4) = (u32x4){pkh(v[4], v[4]), pkh(v[5], v[5]), pkh(v[6], v[6]), pkh(v[7], v[7])}; }
                    else { if (which == 3) {
#pragma unroll
                            for (int i = 0; i < 8; ++i) { const float e2 = __expf(2.f * v[i]); v[i] = 1.f - 2.f * __builtin_amdgcn_rcpf(e2 + 1.f); } }
                        u32x4 w; w.x = cvt_pk_bf16(v[0], v[1]); w.y = cvt_pk_bf16(v[2], v[3]); w.z = cvt_pk_bf16(v[4], v[5]); w.w = cvt_pk_bf16(v[6], v[7]);
                        *(u32x4*)((which == 3 ? AWl : AAl) + tl8 * 64 + j0) = w; }
                }
                if (c + 2 < NCH) PLOAD(c + 2);
                { const int tj = lane & 7, kq = lane >> 4;
#pragma unroll
                  for (int mat = 0; mat < 2; ++mat) { const bf16_t* Am = (mat == 0 ? AWl : AAl) + tj * 64 + kq * 8;
                      const bf16x8 y0 = *reinterpret_cast<const bf16x8*>(Am), y1 = *reinterpret_cast<const bf16x8*>(Am + 32);
#pragma unroll
                      for (int cbk = 0; cbk < 4; ++cbk) { f32x4 acc = {0.f, 0.f, 0.f, 0.f};
                          acc = __builtin_amdgcn_mfma_f32_16x16x32_bf16(Bf[mat][cbk][0], y0, acc, 0, 0, 0);
                          acc = __builtin_amdgcn_mfma_f32_16x16x32_bf16(Bf[mat][cbk][1], y1, acc, 0, 0, 0);
                          const int col = cbk * 16 + 4 * kq; const f32x4 bias = *(const f32x4*)((mat == 0 ? BW : BA) + col); f32x4 res;
#pragma unroll
                          for (int r = 0; r < 4; ++r) { const float u = acc[r] + bias[r];
                              const float sg = __builtin_amdgcn_rcpf(1.f + __expf(-u));
                              res[r] = mat == 0 ? __expf(-0.60653065971263342f * sg) : sg; }
                          if ((lane & 15) < 8) { if (mat == 0) *(u32x2*)((_Float16*)(B_ + O_W) + (8 * pw + tj) * 64 + col) = (u32x2){pkh(res[0], res[1]), pkh(res[2], res[3])};
                                                 else *(f32x4*)(PA + tj * 64 + col) = res; } } } }
                { const int t8 = lane >> 3, tl = 8 * pw + t8, c0 = (lane & 7) * 8; const int o = t8 * 64 + c0;
                  float bs = 0.f, ss = 0.f; f32x4 kr[2], k4[2], a4[2], r4[2];
#pragma unroll
                  for (int q = 0; q < 2; ++q) { k4[q] = *(const f32x4*)(PK + o + 4 * q); a4[q] = *(const f32x4*)(PA + o + 4 * q); r4[q] = *(const f32x4*)(PR + o + 4 * q);
                      kr[q] = k4[q] * *(const f32x4*)(KKW + c0 + 4 * q); ss += (kr[q][0] * kr[q][0] + kr[q][1] * kr[q][1]) + (kr[q][2] * kr[q][2] + kr[q][3] * kr[q][3]); }
                  ss = dpp_red8(ss);
                  const float inv = __builtin_amdgcn_rsqf(fmaxf(ss, 1e-24f));
                  f32x4 kk[2], kd[2], kka[2];
#pragma unroll
                  for (int q = 0; q < 2; ++q) { kk[q] = kr[q] * inv; kd[q] = k4[q] * (1.f + (a4[q] - 1.f) * *(const f32x4*)(KAW + c0 + 4 * q)); kka[q] = kk[q] * a4[q];
                      const f32x4 bb = r4[q] * kd[q] * *(const f32x4*)(RKW + c0 + 4 * q); bs += (bb[0] + bb[1]) + (bb[2] + bb[3]); }
                  const int oh = (tl * 64 + c0) * 2;
#define ST8(OFF, X) *(u32x4*)(B_ + (OFF) + oh) = (u32x4){pkh(X[0][0], X[0][1]), pkh(X[0][2], X[0][3]), pkh(X[1][0], X[1][1]), pkh(X[1][2], X[1][3])}
                  ST8(O_KK, kk); ST8(O_KD, kd); ST8(O_KA, kka); ST8(O_R, r4);
#undef ST8
                  bs = dpp_red8(bs);
                  if ((lane & 7) == 0) bon[(size_t)(tok0 + tfirst + tl) * 16 + head] = bs; }
            }
            asm volatile("s_waitcnt lgkmcnt(0)" ::: "memory"); __builtin_amdgcn_s_barrier(); asm volatile("" ::: "memory");
        }
#undef PLOAD
    } else {
        __syncthreads();
        const int row0 = wid * 16 + (lane >> 3) * 2, seg = lane & 7;
        h2 S[2][4];
#pragma unroll
        for (int h = 0; h < 2; ++h)
#pragma unroll
            for (int q = 0; q < 4; ++q) S[h][q] = (h2){(_Float16)0.f, (_Float16)0.f};
        asm volatile("s_waitcnt lgkmcnt(0)" ::: "memory"); __builtin_amdgcn_s_barrier(); asm volatile("" ::: "memory");
        for (int c = 0; c < NCH; ++c) {
            const char* B_ = lds + (c & 1) * BUFB;
            if (dir) scan_chunk<1>(B_, S, seg, row0); else scan_chunk<0>(B_, S, seg, row0);
            asm volatile("s_waitcnt lgkmcnt(0)" ::: "memory"); __builtin_amdgcn_s_barrier(); asm volatile("" ::: "memory");
        }
    }
    if (wid >= 4) {
        const int pt = tid - 256, c = NCH, cb_ = (c - 1) & 1, tf = dir ? T - TC * c : TC * (c - 1); const int tl = pt >> 3, c8 = (pt & 7) * 8;
        const float* yp = (const float*)(lds + cb_ * BUFB + O_Y) + tl * 64 + c8; const f32x4 y4 = *(const f32x4*)yp, y5 = *(const f32x4*)(yp + 4);
        u32x4 w; w.x = cvt_pk_bf16(y4[0], y4[1]); w.y = cvt_pk_bf16(y4[2], y4[3]); w.z = cvt_pk_bf16(y5[0], y5[1]); w.w = cvt_pk_bf16(y5[2], y5[3]);
        *(u32x4*)(yb + (size_t)(tok0 + tf + tl) * 1024 + head * 64 + c8) = w;
    }
    __syncthreads();
}
}

__device__ __forceinline__ void p4_post(const Args& a, char* lds, int vcu, int G) {
    const int tid = threadIdx.x, lane = tid & 63;
    unsigned char* ws = a.ws;
    const bf16_t* ZR = (const bf16_t*)a.out; bf16_t* QK = (bf16_t*)(ws + WS_QK);
    const bf16_t* Y0 = (const bf16_t*)(ws + WS_Y); const bf16_t* Y1 = Y0 + (size_t)NT * 1024;
    const float* BON = (const float*)(ws + WS_BON);
    const float* mup = a.in[13]; const float* mun = a.in[14]; const float* G2 = a.in[19]; const float* lnw = a.in[23]; const float* lnb = a.in[24]; const float* subg = a.in[12];
    float* SG = (float*)lds; float* BL = (float*)(lds + 20480);
    for (int tile = vcu; tile < NT / 32; tile += G) {
        const int tk0 = tile * 32;
        __syncthreads();
        for (int it = tid; it < 32 * 20; it += NTHR) {
            const int tl = it / 20, j0 = (it % 20) * 8, col = 3328 + j0, tok = tk0 + tl, t = tok_pos(tok), T = tok < TP ? TP : TS;
            const bf16_t* zp = ZR + (size_t)tok * ZRP + col; const u32x4 z = *(const u32x4*)zp; u32x4 zm = {0u, 0u, 0u, 0u}, zn = {0u, 0u, 0u, 0u};
            if (t > 0) zm = *(const u32x4*)(zp - ZRP);
            if (t < T - 1) zn = *(const u32x4*)(zp + ZRP);
            float v[8];
#define SH(i, zw, zmw, znw, lohi) { const float zz = lohi(zw), a_ = lohi(zmw), b_ = lohi(znw), mp_ = mup[col + i], mn_ = mun[col + i]; v[i] = sigmoidf_(zz + mp_ * (a_ - zz) + mn_ * (b_ - zz)); }
            SH(0, z.x, zm.x, zn.x, bflo) SH(1, z.x, zm.x, zn.x, bfhi) SH(2, z.y, zm.y, zn.y, bflo) SH(3, z.y, zm.y, zn.y, bfhi)
            SH(4, z.z, zm.z, zn.z, bflo) SH(5, z.z, zm.z, zn.z, bfhi) SH(6, z.w, zm.w, zn.w, bflo) SH(7, z.w, zm.w, zn.w, bfhi)
#undef SH
            *(f32x4*)(SG + tl * 160 + j0) = (f32x4){v[0], v[1], v[2], v[3]}; *(f32x4*)(SG + tl * 160 + j0 + 4) = (f32x4){v[4], v[5], v[6], v[7]};
        }
        { const int tl = tid >> 4, hd = tid & 15; BL[tid] = BON[(size_t)(tk0 + tl) * 16 + hd] + BON[(size_t)NT * 16 + (size_t)(tk0 + tl) * 16 + hd]; }
        { const int pr = tid >> 1, half = tid & 1, tl = pr >> 3, hd = pr & 7; bf16_t* op = QK + (size_t)(tk0 + tl) * 2048 + hd * 128 + half * 64;
          u32x4 w[8]; float ss = 0.f;
#pragma unroll
          for (int i = 0; i < 8; ++i) { w[i] = *(const u32x4*)(op + i * 8);
              ss += bflo(w[i].x) * bflo(w[i].x) + bfhi(w[i].x) * bfhi(w[i].x) + bflo(w[i].y) * bflo(w[i].y) + bfhi(w[i].y) * bfhi(w[i].y) + bflo(w[i].z) * bflo(w[i].z) + bfhi(w[i].z) * bfhi(w[i].z) + bflo(w[i].w) * bflo(w[i].w) + bfhi(w[i].w) * bfhi(w[i].w); }
          ss += __shfl_xor(ss, 1);
          const float rstd = rsqrtf(ss * (1.f / 128.f) + 1e-6f) * 0.8f; const float* sg = subg + half * 64;
#pragma unroll
          for (int i = 0; i < 8; ++i) { u32x4 o;
              o.x = cvt_pk_bf16(bflo(w[i].x) * rstd * sg[i * 8 + 0], bfhi(w[i].x) * rstd * sg[i * 8 + 1]); o.y = cvt_pk_bf16(bflo(w[i].y) * rstd * sg[i * 8 + 2], bfhi(w[i].y) * rstd * sg[i * 8 + 3]);
              o.z = cvt_pk_bf16(bflo(w[i].z) * rstd * sg[i * 8 + 4], bfhi(w[i].z) * rstd * sg[i * 8 + 5]); o.w = cvt_pk_bf16(bflo(w[i].w) * rstd * sg[i * 8 + 6], bfhi(w[i].w) * rstd * sg[i * 8 + 7]);
              *(u32x4*)(op + i * 8) = o; } }
        __syncthreads();
        const int c0 = tid * 2;
        float acc[32][2];
#pragma unroll
        for (int i = 0; i < 32; ++i) { acc[i][0] = 0.f; acc[i][1] = 0.f; }
#pragma unroll 1
        for (int k = 0; k < 160; k += 4) {
            const f32x2 g0 = *(const f32x2*)(G2 + (size_t)(k + 0) * 1024 + c0), g1 = *(const f32x2*)(G2 + (size_t)(k + 1) * 1024 + c0), g2 = *(const f32x2*)(G2 + (size_t)(k + 2) * 1024 + c0), g3 = *(const f32x2*)(G2 + (size_t)(k + 3) * 1024 + c0);
#pragma unroll
            for (int i = 0; i < 32; ++i) { const f32x4 s4 = *(const f32x4*)(SG + i * 160 + k);
                acc[i][0] += s4[0] * g0[0] + s4[1] * g1[0] + s4[2] * g2[0] + s4[3] * g3[0];
                acc[i][1] += s4[0] * g0[1] + s4[1] * g1[1] + s4[2] * g2[1] + s4[3] * g3[1]; }
        }
        const int hd = tid >> 5;
        const float lw0 = lnw[c0], lw1 = lnw[c0 + 1], lb0 = lnb[c0], lb1 = lnb[c0 + 1];
        const float mp0 = mup[2048 + c0], mp1 = mup[2048 + c0 + 1], mn0 = mun[2048 + c0], mn1 = mun[2048 + c0 + 1];
#pragma unroll
        for (int i = 0; i < 32; ++i) {
            const int tok = tk0 + i, t = tok_pos(tok), T = tok < TP ? TP : TS;
            const unsigned ya = *(const unsigned*)(Y0 + (size_t)tok * 1024 + c0), yb = *(const unsigned*)(Y1 + (size_t)tok * 1024 + c0);
            const float y0 = bflo(ya) + bflo(yb), y1 = bfhi(ya) + bfhi(yb);
            float s = y0 + y1, q = y0 * y0 + y1 * y1;
#pragma unroll
            for (int o = 1; o < 32; o <<= 1) { s += __shfl_xor(s, o); q += __shfl_xor(q, o); }
            const float mean = s * (1.f / 64.f), var = fmaxf(q * (1.f / 64.f) - mean * mean, 0.f), rstd = rsqrtf(var + 64e-5f);
            const bf16_t* zp = ZR + (size_t)tok * ZRP + 2048 + c0; const unsigned z = *(const unsigned*)zp;
            unsigned zm = 0u, zn = 0u;
            if (t > 0) zm = *(const unsigned*)(zp - ZRP);
            if (t < T - 1) zn = *(const unsigned*)(zp + ZRP);
            const float v0 = bflo(z) + mp0 * (bflo(zm) - bflo(z)) + mn0 * (bflo(zn) - bflo(z)), v1 = bfhi(z) + mp1 * (bfhi(zm) - bfhi(z)) + mn1 * (bfhi(zn) - bfhi(z));
            const float bo = BL[i * 16 + hd];
            const float o0 = ((y0 - mean) * rstd * lw0 + lb0 + bo * v0) * acc[i][0], o1 = ((y1 - mean) * rstd * lw1 + lb1 + bo * v1) * acc[i][1];
            *(unsigned*)(QK + (size_t)tok * 2048 + 1024 + c0) = cvt_pk_bf16(o0, o1);
        }
    }
    __syncthreads();
}

struct SchedMerge {
    int v, G; const char* H; const char* WG; const char* QK; const char* VM; const char* PAR; const char* PM2;
    __device__ __forceinline__ bool next(int i, Unit& u) const {
        const int ti = i / 6, kind = i - ti * 6; const long L = (long)ti * G + v; int pm, pn;
        if (!TileMap{192, 8}.get(L, pm, pn)) return false;
        u.pm = pm; u.pn = pn; u.kind = kind; u.t0 = 0; u.T = 0;
        const size_t bo = (size_t)pn * MiB;
        switch (kind) {
            case 0: u.A = H + (size_t)pm * MiB; u.B = WG + bo; u.nt = 32; break;
            case 1: u.A = QK + (size_t)pm * MiB; u.B = PAR + bo; u.nt = 16; break;
            case 2: u.A = H + (size_t)pm * MiB; u.B = WG + 8 * MiB + bo; u.nt = 32; break;
            case 3: u.A = QK + (size_t)pm * MiB + 2048; u.B = PAR + bo + 2048; u.nt = 16; break;
            case 4: u.A = H + (size_t)pm * MiB; u.B = WG + 16 * MiB + bo; u.nt = 32; break;
            default: u.A = VM + (size_t)pm * MiB + 2048; u.B = PM2 + bo; u.nt = 16; break;
        }
        return true;
    }
};
struct EpiMerge {
    u32x4* scrG; f32x4* scrP; bf16_t* MRG;
    __device__ __forceinline__ void operator()(const f32x4 (&acc)[2][2][4][2], const Unit& u, int wr, int wc, int fr, int fq) const {
        const int tid = threadIdx.x, kind = u.kind;
        u32x4* gp = scrG + tid; f32x4* pp = scrP + tid;
        if ((kind & 1) == 0) {
#pragma unroll
            for (int ai = 0; ai < 2; ++ai)
#pragma unroll
                for (int bj = 0; bj < 2; ++bj)
#pragma unroll
                    for (int m = 0; m < 4; ++m) { const f32x4 v0 = acc[ai][bj][m][0], v1 = acc[ai][bj][m][1]; u32x4 w;
                        w.x = cvt_pk_bf16(sigmoidf_(v0[0]), sigmoidf_(v0[1])); w.y = cvt_pk_bf16(sigmoidf_(v0[2]), sigmoidf_(v0[3]));
                        w.z = cvt_pk_bf16(sigmoidf_(v1[0]), sigmoidf_(v1[1])); w.w = cvt_pk_bf16(sigmoidf_(v1[2]), sigmoidf_(v1[3]));
                        *gp = w; gp += NTHR; asm volatile("" : "+v"(gp) :: "memory"); }
        } else {
            const int row0 = u.pm * 256 + wr * 64 + fr, col0 = u.pn * 256 + wc * 32 + 8 * fq;
#pragma unroll
            for (int ai = 0; ai < 2; ++ai)
#pragma unroll
                for (int bj = 0; bj < 2; ++bj) {
                    bf16_t* mp = MRG + (size_t)(row0 + ai * 128) * 2048 + col0 + bj * 128;
#pragma unroll
                    for (int m = 0; m < 4; ++m) { const u32x4 g = *gp;
                        f32x4 p0 = acc[ai][bj][m][0] * (f32x4){bflo(g.x), bfhi(g.x), bflo(g.y), bfhi(g.y)}, p1 = acc[ai][bj][m][1] * (f32x4){bflo(g.z), bfhi(g.z), bflo(g.w), bfhi(g.w)};
                        if (kind > 1) { p0 += pp[0]; p1 += pp[NTHR]; }
                        if (kind < 5) { pp[0] = p0; pp[NTHR] = p1; }
                        else { u32x4 w; w.x = cvt_pk_bf16(p0[0], p0[1]); w.y = cvt_pk_bf16(p0[2], p0[3]); w.z = cvt_pk_bf16(p1[0], p1[1]); w.w = cvt_pk_bf16(p1[2], p1[3]);
                            *(u32x4*)mp = w; }
                        gp += NTHR; pp += 2 * NTHR; mp += 16 * 2048; asm volatile("" : "+v"(gp), "+v"(pp), "+v"(mp) :: "memory"); } }
        }
    }
};

struct SchedSq {
    int v, G; const char* A; const char* B; size_t astep, bstep; int nt;
    __device__ __forceinline__ bool next(int i, Unit& u) const {
        const long L = (long)i * G + v; int pm, pn; if (!TileMap{192, 8}.get(L, pm, pn)) return false;
        u.A = A + (size_t)pm * astep; u.B = B + (size_t)pn * bstep; u.nt = nt; u.pm = pm; u.pn = pn; u.kind = 0; u.t0 = 0; u.T = 0; return true;
    }
};
struct EpiWo {
    const float* xp; const float* xs; float* out;
    __device__ __forceinline__ void operator()(const f32x4 (&acc)[2][2][4][2], const Unit& u, int wr, int wc, int fr, int fq) const {
        const int row0 = u.pm * 256 + wr * 64 + fr, col0 = u.pn * 256 + wc * 32 + 8 * fq;
#pragma unroll
        for (int ai = 0; ai < 2; ++ai)
#pragma unroll
            for (int m = 0; m < 4; ++m) { const int row = row0 + ai * 128 + m * 16;
                const float* xr = (row < TP ? xp + (size_t)row * DM : xs + (size_t)(row - TP) * DM) + col0; float* orow = out + (size_t)row * DM + col0;
#pragma unroll
                for (int bj = 0; bj < 2; ++bj) { const f32x4 x0 = *(const f32x4*)(xr + bj * 128), x1 = *(const f32x4*)(xr + bj * 128 + 4);
                    *(f32x4*)(orow + bj * 128) = x0 + acc[ai][bj][m][0]; *(f32x4*)(orow + bj * 128 + 4) = x1 + acc[ai][bj][m][1]; } }
    }
};
struct EpiDown {
    float* out;
    __device__ __forceinline__ void operator()(const f32x4 (&acc)[2][2][4][2], const Unit& u, int wr, int wc, int fr, int fq) const {
        const int row0 = u.pm * 256 + wr * 64 + fr, col0 = u.pn * 256 + wc * 32 + 8 * fq;
#pragma unroll
        for (int ai = 0; ai < 2; ++ai)
#pragma unroll
            for (int m = 0; m < 4; ++m) { float* orow = out + (size_t)(row0 + ai * 128 + m * 16) * DM + col0;
#pragma unroll
                for (int bj = 0; bj < 2; ++bj) { const f32x4 x0 = *(const f32x4*)(orow + bj * 128), x1 = *(const f32x4*)(orow + bj * 128 + 4);
                    *(f32x4*)(orow + bj * 128) = x0 + acc[ai][bj][m][0]; *(f32x4*)(orow + bj * 128 + 4) = x1 + acc[ai][bj][m][1]; } }
    }
};

struct SchedUp {
    int v, G; const char* HN; const char* WUP;
    __device__ __forceinline__ bool next(int i, Unit& u) const {
        const long L = (long)i * G + v; int pm, pn; if (!TileMap{197, 44}.get(L, pm, pn)) return false;
        int s, ti; if (pm < 65) { s = 0; ti = pm; } else { s = 1 + (pm - 65) / 33; ti = (pm - 65) % 33; }
        const int T = seq_len(s); int t0 = 254 * ti - 1; if (t0 > T - 255) t0 = T - 255;
        u.pm = seq_start(s); u.pn = pn; u.kind = 0; u.t0 = t0; u.T = T; u.nt = 32;
        u.A = HN + ((long)u.pm + t0) * 4096; u.B = WUP + (size_t)pn * MiB; return true;
    }
};
struct EpiUp {
    bf16_t* ACT; const float* cw; const float* cb; LAS float* xch;
    __device__ __forceinline__ void operator()(const f32x4 (&acc)[2][2][4][2], const Unit& u, int wr, int wc, int fr, int fq) const {
        const int lane = threadIdx.x & 63;
        const int cin = wc * 32 + 8 * fq;
#pragma unroll
        for (int ai = 0; ai < 2; ++ai) { const int rg = 2 * ai + wr;
#pragma unroll
            for (int bj = 0; bj < 2; ++bj)
#pragma unroll
                for (int n = 0; n < 2; ++n) {
                    if (fr == 0) *(LAS f32x4*)(xch + (rg * 2 + 0) * 256 + bj * 128 + cin + 4 * n) = acc[ai][bj][0][n];
                    if (fr == 15) *(LAS f32x4*)(xch + (rg * 2 + 1) * 256 + bj * 128 + cin + 4 * n) = acc[ai][bj][3][n]; } }
        asm volatile("s_waitcnt lgkmcnt(0)" ::: "memory"); __builtin_amdgcn_s_barrier(); asm volatile("" ::: "memory");
        const int gc = u.pn * 128 + cin;
#pragma unroll
        for (int n = 0; n < 2; ++n) {
            const int wcol = gc + 4 * n;
            const f32x4 g0 = *(const f32x4*)(cw + wcol), g1 = *(const f32x4*)(cw + 2 * DFF + wcol), g2 = *(const f32x4*)(cw + 4 * DFF + wcol), gb = *(const f32x4*)(cb + wcol);
            const f32x4 v0 = *(const f32x4*)(cw + DFF + wcol), v1 = *(const f32x4*)(cw + 3 * DFF + wcol), v2 = *(const f32x4*)(cw + 5 * DFF + wcol), vb = *(const f32x4*)(cb + DFF + wcol);
#pragma unroll
            for (int ai = 0; ai < 2; ++ai) { const int rg = 2 * ai + wr;
                bf16_t* ap = ACT + ((long)u.pm + u.t0 + 128 * ai + 64 * wr + fr) * DFF + gc + 4 * n;
#pragma unroll
                for (int m = 0; m < 4; ++m) {
                    const int j = 128 * ai + 64 * wr + 16 * m + fr, t = u.t0 + j;
                    f32x4 res;
#pragma unroll
                    for (int bj = 0; bj < 2; ++bj) {
                        const f32x4 cur = acc[ai][bj][m][n];
                        const f32x4 sp = (m > 0 && fr == 15) ? acc[ai][bj][m > 0 ? m - 1 : 0][n] : cur;
                        const f32x4 sn = (m < 3 && fr == 0) ? acc[ai][bj][m < 3 ? m + 1 : 3][n] : cur;
                        f32x4 pv, nv;
#pragma unroll
                        for (int i = 0; i < 4; ++i) { pv[i] = __uint_as_float(__builtin_amdgcn_update_dpp(0u, __float_as_uint(sp[i]), 0x121, 0xf, 0xf, false));
                                                       nv[i] = __uint_as_float(__builtin_amdgcn_update_dpp(0u, __float_as_uint(sn[i]), 0x12F, 0xf, 0xf, false)); }
                        if (m == 0) { const f32x4 xprev = rg > 0 ? *(const LAS f32x4*)(xch + ((rg - 1) * 2 + 1) * 256 + bj * 128 + cin + 4 * n) : (f32x4){0.f, 0.f, 0.f, 0.f}; if (fr == 0) pv = xprev; }
                        if (m == 3) { const f32x4 xnext = rg < 3 ? *(const LAS f32x4*)(xch + ((rg + 1) * 2 + 0) * 256 + bj * 128 + cin + 4 * n) : (f32x4){0.f, 0.f, 0.f, 0.f}; if (fr == 15) nv = xnext; }
                        if (t < 1) pv = (f32x4){0.f, 0.f, 0.f, 0.f};
                        if (t >= u.T - 1) nv = (f32x4){0.f, 0.f, 0.f, 0.f};
                        if (bj == 0) { const f32x4 cv = g0 * pv + g1 * cur + g2 * nv + gb; res = (f32x4){cv[0] * sigmoidf_(cv[0]), cv[1] * sigmoidf_(cv[1]), cv[2] * sigmoidf_(cv[2]), cv[3] * sigmoidf_(cv[3])}; }
                        else { const f32x4 cv = v0 * pv + v1 * cur + v2 * nv + vb; res = res * cv; }
                    }
                    if (j >= 1 && j <= 254) { u32x2 w; w.x = cvt_pk_bf16(res[0], res[1]); w.y = cvt_pk_bf16(res[2], res[3]); *(u32x2*)ap = w; }
                    ap += 16 * DFF; asm volatile("" : "+v"(ap) :: "memory");
                }
            }
        }
    }
};

__global__ void __launch_bounds__(NTHR, 2) enc_fwd(Args args) {
    extern __shared__ __attribute__((aligned(16))) unsigned char lds_raw[];
    cg::grid_group grid = cg::this_grid();
    LAS unsigned char* lds = (LAS unsigned char*)lds_raw;
    const int tid = threadIdx.x;
    const int G = gridDim.x, bx = blockIdx.x, vcu = (G % 8 == 0) ? (bx % 8) * (G / 8) + bx / 8 : bx;
    unsigned char* ws = args.ws;
    const int lo = args.ph_lo, hi = args.ph_hi;
#ifndef P2M
#define P2M 7
#endif
#ifndef PH_MASK
#define PH_MASK 0x1ff
#endif
#define IN(k) (((PH_MASK >> (k)) & 1) && lo <= (k) && (k) < hi)
#define SEAM(k) do { if (IN(k) && IN((k) + 1)) grid.sync(); } while (0)
#ifndef PROBE
#define PROBE 0
#endif
    unsigned long long tp0 = 0, tp1 = 0;
#define TSTAMP(v) do { if (PROBE) { v = __builtin_amdgcn_s_memrealtime(); } } while (0)

    if (IN(0)) p0_prologue(args, lds, vcu, G);
    SEAM(0);
    if (IN(1)) {
        SchedIn S{vcu, G, (const char*)(ws + WS_H), (const char*)(ws + WS_WIN), (const char*)(ws + WS_MEMN), (const char*)(ws + WS_WKV)};
        EpiIn E{(bf16_t*)(ws + WS_QK), (bf16_t*)(ws + WS_VM), (bf16_t*)args.out, (bf16_t*)(ws + WS_KVM), args.in[6], args.in[7], (const float*)(ws + WS_ROPE), (const float*)(ws + WS_ROPE) + TP * 32};
        pg8::gemm_phase<EpiIn, SchedIn, true>(lds, 2048, S, E);
    }
    SEAM(1);
    if (PROBE == 1 || PROBE == 2) TSTAMP(tp0);
    if (IN(2)) {
        unsigned* ctl = (unsigned*)(ws + WS_CTL);
        volatile LAS unsigned* jobw = (volatile LAS unsigned*)(lds + LDS_MISC);
        const float lam = ((const float*)ctl)[CW_LAM];
        scan::P sp{(const bf16_t*)args.out, (bf16_t*)(ws + WS_Y), (float*)(ws + WS_BON), args.in[13], args.in[14], args.in[15], args.in[16], args.in[17], args.in[18], args.in[20], args.in[21], args.in[22]};
        for (;;) {
            __syncthreads();
            if (tid == 0) jobw[0] = atomicAdd(ctl + CW_QUEUE, 1u);
            __syncthreads();
            const int jb = (int)jobw[0];
            if (jb >= 160 + 1536 + 768) break;
            if (((P2M) & 1) && jb < 160) {
                int s, r; if (jb < 32) { s = 0; r = jb; } else { s = 1 + (jb - 32) / 32; r = (jb - 32) % 32; }
                scan::job(s, r & 1, r >> 1, sp, (char*)lds_raw);
                if (PROBE == 2 && tid == 0) atomicMax((unsigned long long*)(ctl + 256), (unsigned long long)__builtin_amdgcn_s_memrealtime());
            } else if (((P2M) & 2) && jb < 160 + 1536) {
                const int a = jb - 160; int s, h, qb;
                if (a < 512) { s = 0; h = a / 64; qb = a % 64; } else { const int b = a - 512; s = 1 + b / 256; h = (b % 256) / 32; qb = b % 32; }
                att::diff_unit(s, h, qb, (bf16_t*)(ws + WS_QK), (const bf16_t*)(ws + WS_VM), lam, (char*)lds_raw);
            } else if ((P2M) & 4) {
                const int a = jb - 160 - 1536; int s, mh, qb;
                if (a < 256) { s = 0; mh = a / 64; qb = a % 64; } else { const int b = a - 256; s = 1 + b / 128; mh = (b % 128) / 32; qb = b % 32; }
                att::mem_unit(s, mh, qb, (bf16_t*)(ws + WS_VM), (const bf16_t*)(ws + WS_KVM), args.in[27], args.in[28], (char*)lds_raw);
            }
        }
    }
    SEAM(2);
    if (PROBE == 1) TSTAMP(tp1);
    if (IN(3)) p4_post(args, (char*)lds_raw, vcu, G);
    SEAM(3);
    if (IN(4)) {
        SchedMerge S{vcu, G, (const char*)(ws + WS_H), (const char*)(ws + WS_WG), (const char*)(ws + WS_QK), (const char*)(ws + WS_VM), (const char*)(ws + WS_PAR), (const char*)(ws + WS_PM2)};
        unsigned char* scr = (unsigned char*)args.out + (size_t)bx * (384 * 1024);
        EpiMerge E{(u32x4*)scr, (f32x4*)(scr + 128 * 1024), (bf16_t*)(ws + WS_MRG)};
        pg8::gemm_phase<EpiMerge, SchedMerge, true>(lds, 2048, S, E);
    }
    SEAM(4);
    if (IN(5)) {
        SchedSq S{vcu, G, (const char*)(ws + WS_MRG), (const char*)(ws + WS_WO), MiB, MiB, 32};
        EpiWo E{args.in[0], args.in[1], args.out};
        pg8::gemm_phase<EpiWo, SchedSq, true>(lds, 2048, S, E);
    }
    SEAM(5);
    if (IN(6)) {
        const int lane = tid & 63, gw = vcu * 8 + (tid >> 6), NGW = G * 8;
        for (int m = gw; m < NT; m += NGW) rms_row(args.out + (size_t)m * DM, args.in[33], (bf16_t*)(ws + WS_H) + (size_t)m * DM, lane);
    }
    SEAM(6);
    if (IN(7)) {
        SchedUp S{vcu, G, (const char*)(ws + WS_H), (const char*)(ws + WS_WUP)};
        EpiUp E{(bf16_t*)(ws + WS_ACT), args.in[35], args.in[36], (LAS float*)(lds + LDS_XCH)};
        pg8::gemm_phase<EpiUp, SchedUp, true>(lds, 2048, S, E);
    }
    SEAM(7);
    if (IN(8)) {
        SchedSq S{vcu, G, (const char*)(ws + WS_ACT), (const char*)(ws + WS_WDN), (size_t)256 * DFF * 2, (size_t)256 * DFF * 2, 88};
        EpiDown E{args.out};
        pg8::gemm_phase<EpiDown, SchedSq, true>(lds, DFF, S, E);
    }
    if (PROBE && bx == 0 && tid == 0) {
        if (PROBE == 2) tp1 = __hip_atomic_load((unsigned long long*)(ws + WS_CTL) + 128, __ATOMIC_RELAXED, __HIP_MEMORY_SCOPE_AGENT);
        const unsigned long long target = __builtin_amdgcn_s_memrealtime() + (tp1 > tp0 ? tp1 - tp0 : 0);
        while (__builtin_amdgcn_s_memrealtime() < target) __builtin_amdgcn_s_sleep(16);
    }
#undef IN
#undef SEAM
}

#ifndef MK_SPLIT
#define MK_SPLIT 0
#endif
extern "C" void kernel_launch(void* const* d_in, const int* in_sizes, int n_in, void* d_out, int out_size, void* d_ws, size_t ws_size, hipStream_t stream) {
    static int grid = 0;
    if (grid == 0) {
        if (n_in != 38 || out_size != NT * DM || ws_size < WS_END) { fprintf(stderr, "kernel_launch: unexpected shapes n_in %d out %d ws %zu\n", n_in, out_size, ws_size); grid = -1; return; }
        int dev = 0, cus = 0, per_cu = 0;
        hipGetDevice(&dev); hipDeviceGetAttribute(&cus, hipDeviceAttributeMultiprocessorCount, dev);
        if (hipFuncSetAttribute((const void*)enc_fwd, hipFuncAttributeMaxDynamicSharedMemorySize, LDS_BYTES) != hipSuccess) { fprintf(stderr, "kernel_launch: hipFuncSetAttribute failed\n"); grid = -1; return; }
        if (hipOccupancyMaxActiveBlocksPerMultiprocessor(&per_cu, (const void*)enc_fwd, NTHR, LDS_BYTES) != hipSuccess || per_cu < 1) { fprintf(stderr, "kernel_launch: occupancy query failed (%d)\n", per_cu); per_cu = 1; }
        (void)hipGetLastError();
        grid = cus * 1;
    }
    if (grid < 0) return;
    Args a{};
    for (int i = 0; i < 38; ++i) a.in[i] = (const float*)d_in[i];
    a.out = (float*)d_out; a.ws = (unsigned char*)d_ws;
    for (int d = 0; d < 32; ++d) a.inv_rev[d] = pow(10000.0, -(double)d / 32.0) / 6.283185307179586476925286766559;
#if MK_SPLIT
    for (int ph = 0; ph < 9; ++ph) { a.ph_lo = ph; a.ph_hi = ph + 1; void* kargs[] = {&a};
        hipError_t e = hipLaunchCooperativeKernel((const void*)enc_fwd, dim3(grid), dim3(NTHR), kargs, LDS_BYTES, stream);
        if (e != hipSuccess) { fprintf(stderr, "launch %d failed: %s\n", ph, hipGetErrorString(e)); break; } }
#else
    a.ph_lo = 0; a.ph_hi = 9;
    void* kargs[] = {&a};
    hipError_t e = hipLaunchCooperativeKernel((const void*)enc_fwd, dim3(grid), dim3(NTHR), kargs, LDS_BYTES, stream);
    if (e != hipSuccess) fprintf(stderr, "cooperative launch failed: %s (grid %d)\n", hipGetErrorString(e), grid);
#endif
}
```

```cpp
#include <hip/hip_runtime.h>
#include <hip/hip_cooperative_groups.h>
#include <cstdio>
#include <cstdint>
#include <cmath>
namespace cg = cooperative_groups;

#define LAS __attribute__((address_space(3)))
typedef unsigned short bf16_t;
typedef short bf16x8 __attribute__((ext_vector_type(8)));
typedef short s16x4 __attribute__((ext_vector_type(4)));
typedef float f32x2 __attribute__((ext_vector_type(2)));
typedef float f32x4 __attribute__((ext_vector_type(4)));
typedef float f32x16 __attribute__((ext_vector_type(16)));
typedef unsigned u32x2 __attribute__((ext_vector_type(2)));
typedef unsigned u32x4 __attribute__((ext_vector_type(4)));

constexpr int NT = 49152, DM = 2048, TP = 16384, TS = 8192, NSEQ = 5;
constexpr int ZRP = 3584;
constexpr int DFF = 5632;
constexpr int NTHR = 512;
constexpr size_t MiB = 1u << 20;
constexpr size_t WS_CTL = 0, WS_WIN = 1 * MiB, WS_WG = 31 * MiB, WS_WKV = 55 * MiB, WS_PAR = 63 * MiB, WS_PM2 = 71 * MiB, WS_WO = 79 * MiB,
                 WS_WUP = 87 * MiB, WS_WDN = 131 * MiB, WS_ROPE = 153 * MiB, WS_MEMN = 157 * MiB, WS_KVM = 162 * MiB, WS_BON = 167 * MiB,
                 WS_H = 176 * MiB, WS_QK = 370 * MiB, WS_VM = 562 * MiB, WS_Y = 754 * MiB, WS_ACT = 370 * MiB, WS_MRG = 754 * MiB, WS_END = 946 * MiB;
constexpr int CW_QUEUE = 64, CW_LAM = 128;
constexpr int LDS_XCH = 131072, LDS_MISC = 131072 + 8192, LDS_BYTES = 131072 + 8192 + 256;

__device__ __forceinline__ int seq_start(int s) { return s == 0 ? 0 : TP + (s - 1) * TS; }
__device__ __forceinline__ int seq_len(int s) { return s == 0 ? TP : TS; }
__device__ __forceinline__ int tok_pos(int tok) { return tok < TP ? tok : ((tok - TP) & (TS - 1)); }

__device__ __forceinline__ unsigned cvt_pk_bf16(float lo, float hi) { unsigned r; asm volatile("v_cvt_pk_bf16_f32 %0, %1, %2" : "=v"(r) : "v"(lo), "v"(hi)); return r; }
__device__ __forceinline__ float bflo(unsigned w) { return __uint_as_float(w << 16); }
__device__ __forceinline__ float bfhi(unsigned w) { return __uint_as_float(w & 0xffff0000u); }
__device__ __forceinline__ float bf1(bf16_t b) { return __uint_as_float((unsigned)b << 16); }
__device__ __forceinline__ float sigmoidf_(float x) { return 1.f / (1.f + __expf(-x)); }
__device__ __forceinline__ float wave_sum(float v) {
#pragma unroll
    for (int o = 1; o < 64; o <<= 1) v += __shfl_xor(v, o);
    return v;
}

namespace pg8 {
constexpr int BM = 256, BK = 64, HALF = 128, HTB = HALF * BK * 2, STAGE_BYTES = 8 * HTB;
__host__ __device__ __forceinline__ int lds_byte(int r, int c) { const int st = (r >> 4) * 2 + (c >> 5), rr = r & 15, cc = c & 31, ob = rr * 64 + cc * 2; return st * 1024 + (ob ^ (((ob >> 9) & 1) << 5)); }
__host__ __device__ __forceinline__ void stage_rc(int b, int& R, int& C) { const int st = b / 1024, sb = b % 1024, swz = sb ^ (((sb >> 9) & 1) << 5); R = (st >> 1) * 16 + swz / 64; C = (st & 1) * 32 + (swz % 64) / 2; }
__host__ __device__ __forceinline__ int perm32(int rho) { const int n = rho >> 4, i = rho & 15; return 8 * (i >> 2) + 4 * n + (i & 3); }

struct Unit { const char* A; const char* B; int nt, pm, pn, kind, t0, T; };

template <class Epi, class Sched, bool ALIGN_EPI>
__device__ __forceinline__ void gemm_phase(LAS unsigned char* lds, const int ld, const Sched& S, const Epi& E) {
    const int tid = threadIdx.x, wid = __builtin_amdgcn_readfirstlane(tid >> 6), lane = tid & 63, wr = wid >> 2, wc = wid & 3, fr = lane & 15, fq = lane >> 4;
    unsigned voffA[2], voffB[2];
#pragma unroll
    for (int i = 0; i < 2; ++i) { int R, C; stage_rc(tid * 16 + i * 8192, R, C); const int Rb = (R & ~31) + perm32(R & 31);
        voffA[i] = (unsigned)(R * ld + C) * 2u; voffB[i] = (unsigned)(Rb * ld + C) * 2u; }
    const size_t kstep = (size_t)(BK * 2);
    const size_t hstep = (size_t)HALF * ld * 2;
    const unsigned ldsw = (unsigned)wid * 1024u;
    const int aoff = lds_byte(wr * 64 + fr, fq * 8), boff = lds_byte(wc * 32 + fr, fq * 8);
#define PG8_SA(b, h) (((b) * 2 + (h)) * HTB)
#define PG8_SB(b, h) ((4 + (b) * 2 + (h)) * HTB)
#define PG8_STAGE(bufoff, gbase, voff) do { _Pragma("unroll") for (int _i = 0; _i < 2; ++_i) \
        __builtin_amdgcn_global_load_lds((const unsigned*)((const char*)(gbase) + (voff)[_i]), (LAS unsigned*)(lds + (bufoff) + ldsw + _i * 8192), 16, 0, 0); } while (0)
#define PG8_LDA(dst, b, h) do { _Pragma("unroll") for (int m = 0; m < 4; ++m) _Pragma("unroll") for (int k = 0; k < 2; ++k) dst[m][k] = *(const LAS bf16x8*)(lds + PG8_SA(b, h) + aoff + m * 2048 + k * 1024); } while (0)
#define PG8_LDB(dst, b, h) do { _Pragma("unroll") for (int n = 0; n < 2; ++n) _Pragma("unroll") for (int k = 0; k < 2; ++k) dst[n][k] = *(const LAS bf16x8*)(lds + PG8_SB(b, h) + boff + n * 2048 + k * 1024); } while (0)
#define PG8_MMA(ai, bj, At, Bt) do { __builtin_amdgcn_s_setprio(1); _Pragma("unroll") for (int m = 0; m < 4; ++m) _Pragma("unroll") for (int n = 0; n < 2; ++n) _Pragma("unroll") for (int k = 0; k < 2; ++k) \
        acc[ai][bj][m][n] = __builtin_amdgcn_mfma_f32_16x16x32_bf16(Bt[n][k], At[m][k], acc[ai][bj][m][n], 0, 0, 0); __builtin_amdgcn_s_setprio(0); } while (0)
#define PG8_WAIT_V(n) asm volatile("s_waitcnt vmcnt(" #n ")" ::: "memory")
#define PG8_WAIT_L(n) asm volatile("s_waitcnt lgkmcnt(" #n ")" ::: "memory")
#define PG8_BAR __builtin_amdgcn_s_barrier()
#define PG8_SCHED __builtin_amdgcn_sched_barrier(0)
    Unit cur, nxt; int ui = 0;
    if (!S.next(0, cur)) return;
    f32x4 acc[2][2][4][2];
#pragma unroll
    for (int a = 0; a < 2; ++a)
#pragma unroll
        for (int b = 0; b < 2; ++b)
#pragma unroll
            for (int m = 0; m < 4; ++m)
#pragma unroll
                for (int n = 0; n < 2; ++n) acc[a][b][m][n] = (f32x4){0.f, 0.f, 0.f, 0.f};
    bf16x8 At[4][2], B0[2][2], B1[2][2];
    const char* cA = cur.A; const char* cB = cur.B;
    PG8_STAGE(PG8_SB(0, 0), cB, voffB); PG8_STAGE(PG8_SB(0, 1), cB + hstep, voffB); PG8_STAGE(PG8_SA(0, 0), cA, voffA); PG8_STAGE(PG8_SA(0, 1), cA + hstep, voffA);
    if (wr == 1) PG8_BAR;
    PG8_WAIT_V(2); PG8_BAR;
    PG8_STAGE(PG8_SB(1, 0), cB + kstep, voffB); PG8_STAGE(PG8_SA(1, 0), cA + kstep, voffA); PG8_STAGE(PG8_SB(1, 1), cB + hstep + kstep, voffB);
    PG8_WAIT_V(6); PG8_BAR;
    for (;;) {
        const bool has_next = S.next(ui + 1, nxt);
        const char* nA = has_next ? nxt.A : cA; const char* nB = has_next ? nxt.B : cB;
        const int nt = cur.nt;
        for (int t = 0; t < nt; t += 2) {
            const bool last = (t == nt - 2);
            const char* a1 = cA + (size_t)(t + 1) * kstep;
            const char* a2 = last ? nA : cA + (size_t)(t + 2) * kstep; const char* b2 = last ? nB : cB + (size_t)(t + 2) * kstep;
            const char* a3 = a2 + kstep; const char* b3 = b2 + kstep;
            PG8_LDB(B0, 0, 0); PG8_LDB(B1, 0, 1); PG8_SCHED; PG8_LDA(At, 0, 0); PG8_STAGE(PG8_SA(1, 1), a1 + hstep, voffA);
            PG8_WAIT_V(8); PG8_WAIT_L(0); PG8_BAR; PG8_MMA(0, 0, At, B0); PG8_MMA(0, 1, At, B1); PG8_BAR; PG8_SCHED;
            PG8_LDA(At, 0, 1); PG8_STAGE(PG8_SB(0, 0), b2, voffB); PG8_STAGE(PG8_SB(0, 1), b2 + hstep, voffB); PG8_STAGE(PG8_SA(0, 0), a2, voffA);
            PG8_WAIT_V(8); PG8_WAIT_L(0); PG8_BAR; PG8_MMA(1, 0, At, B0); PG8_MMA(1, 1, At, B1); PG8_BAR; PG8_SCHED;
            PG8_LDB(B0, 1, 0); PG8_LDB(B1, 1, 1); PG8_SCHED; PG8_LDA(At, 1, 0); PG8_STAGE(PG8_SA(0, 1), a2 + hstep, voffA);
            PG8_WAIT_V(8); PG8_WAIT_L(0); PG8_BAR; PG8_MMA(0, 0, At, B0); PG8_MMA(0, 1, At, B1); PG8_BAR; PG8_SCHED;
            PG8_LDA(At, 1, 1); PG8_STAGE(PG8_SB(1, 0), b3, voffB); PG8_STAGE(PG8_SB(1, 1), b3 + hstep, voffB); PG8_STAGE(PG8_SA(1, 0), a3, voffA);
            PG8_WAIT_V(8); PG8_WAIT_L(0); PG8_BAR; PG8_MMA(1, 0, At, B0); PG8_MMA(1, 1, At, B1); PG8_BAR; PG8_SCHED;
        }
        if constexpr (ALIGN_EPI) { if (wr == 0) PG8_BAR; }
        E(acc, cur, wr, wc, fr, fq);
        if (!has_next) break;
#pragma unroll
        for (int a = 0; a < 2; ++a)
#pragma unroll
            for (int b = 0; b < 2; ++b)
#pragma unroll
                for (int m = 0; m < 4; ++m)
#pragma unroll
                    for (int n = 0; n < 2; ++n) acc[a][b][m][n] = (f32x4){0.f, 0.f, 0.f, 0.f};
        cur = nxt; cA = nA; cB = nB; ++ui;
        if constexpr (ALIGN_EPI) { if (wr == 1) PG8_BAR; }
    }
    PG8_WAIT_V(0);
    if constexpr (!ALIGN_EPI) { if (wr == 0) PG8_BAR; }
    PG8_BAR;
#undef PG8_SA
#undef PG8_SB
#undef PG8_STAGE
#undef PG8_LDA
#undef PG8_LDB
#undef PG8_MMA
#undef PG8_WAIT_V
#undef PG8_WAIT_L
#undef PG8_BAR
#undef PG8_SCHED
}
}
using pg8::Unit;

struct TileMap {
    int nM, nN;
    __device__ __forceinline__ bool get(long L, int& pm, int& pn) const {
        if (L >= (long)nM * nN) return false;
        const int nig = 8 * nN, gid = (int)(L / nig), fm = gid * 8, gsz = (nM - fm) < 8 ? (nM - fm) : 8, r = (int)(L % nig);
        pm = fm + r % gsz; pn = r / gsz; return true;
    }
};

struct Args {
    const float* in[38];
    float* out; unsigned char* ws;
    double inv_rev[32];
    int ph_lo, ph_hi;
};

__device__ __forceinline__ void tr_item(const float* W, int N, int src_n0, bf16_t* WT, size_t ldw, int koff, int r0, int k0, LAS float* scr, int lane) {
    if (src_n0 >= 0) {
#pragma unroll 8
        for (int i = 0; i < 32; ++i) { const int kk = 2 * i + (lane >> 5); scr[kk * 33 + (lane & 31)] = W[(size_t)(k0 + kk) * N + src_n0 + (lane & 31)]; }
    } else {
#pragma unroll 8
        for (int i = 0; i < 32; ++i) { const int kk = 2 * i + (lane >> 5); scr[kk * 33 + (lane & 31)] = 0.f; }
    }
    asm volatile("s_waitcnt lgkmcnt(0)" ::: "memory");
    const int c = lane & 7;
#pragma unroll
    for (int j = 0; j < 4; ++j) { const int n = (lane >> 3) + 8 * j; const LAS float* s = scr + (8 * c) * 33 + n;
        u32x4 o; o.x = cvt_pk_bf16(s[0 * 33], s[1 * 33]); o.y = cvt_pk_bf16(s[2 * 33], s[3 * 33]); o.z = cvt_pk_bf16(s[4 * 33], s[5 * 33]); o.w = cvt_pk_bf16(s[6 * 33], s[7 * 33]);
        *(u32x4*)(WT + (size_t)(r0 + n) * ldw + koff + k0 + 8 * c) = o; }
    asm volatile("s_waitcnt lgkmcnt(0)" ::: "memory");
}
__device__ __forceinline__ void rms_row(const float* xrow, const float* g, bf16_t* orow, int lane) {
    f32x4 v[8]; float s = 0.f;
#pragma unroll
    for (int j = 0; j < 8; ++j) { v[j] = ((const f32x4*)xrow)[64 * j + lane]; s += (v[j].x * v[j].x + v[j].y * v[j].y) + (v[j].z * v[j].z + v[j].w * v[j].w); }
    const float rstd = rsqrtf(wave_sum(s) * (1.f / DM) + 1e-6f);
#pragma unroll
    for (int j = 0; j < 8; ++j) { const f32x4 gg = ((const f32x4*)g)[64 * j + lane];
        u32x2 w; w.x = cvt_pk_bf16(v[j].x * rstd * gg.x, v[j].y * rstd * gg.y); w.y = cvt_pk_bf16(v[j].z * rstd * gg.z, v[j].w * rstd * gg.w);
        ((u32x2*)orow)[64 * j + lane] = w; }
}

__device__ __forceinline__ void p0_prologue(const Args& a, LAS unsigned char* lds, int vcu, int G) {
    const int tid = threadIdx.x, lane = tid & 63, wave = tid >> 6;
    unsigned char* ws = a.ws;
    LAS float* scr = (LAS float*)(lds + wave * 16384);
    const int gw = vcu * 8 + wave, NGW = G * 8;
    constexpr int I0 = 32 * 240, I1 = 32 * 192, I2 = 32 * 64, I3 = 16 * 64, I6 = 32 * 64, I7 = 32 * 352, I8 = 88 * 64;
    constexpr int NITEMS = I0 + I1 + I2 + 3 * I3 + I6 + I7 + I8;
    for (int it = gw; it < NITEMS; it += NGW) {
        int r = it;
        if (r < I0) { const int kb = r / 240, nb = r % 240, r0 = nb * 32; int src;
            if (r0 < 2048) { const int tile = r0 >> 8, cp = r0 & 255, h = cp >> 7, g = (cp & 127) >> 5; src = tile * 256 + 64 * g + 32 * h; }
            else if (r0 < 6560) src = r0;
            else if (r0 < 6656) src = -1;
            else src = 6560 + (r0 - 6656);
            tr_item(a.in[5], 13728, src, (bf16_t*)(ws + WS_WIN), 2048, 0, r0, kb * 64, scr, lane); continue; } r -= I0;
        if (r < I1) { const int kb = r / 192, nb = r % 192; tr_item(a.in[5], 13728, 7584 + nb * 32, (bf16_t*)(ws + WS_WG), 2048, 0, nb * 32, kb * 64, scr, lane); continue; } r -= I1;
        if (r < I2) { const int kb = r / 64, nb = r % 64; tr_item(a.in[26], 2048, nb * 32, (bf16_t*)(ws + WS_WKV), 2048, 0, nb * 32, kb * 64, scr, lane); continue; } r -= I2;
        if (r < I3) { const int kb = r / 64, nb = r % 64; tr_item(a.in[29], 2048, nb * 32, (bf16_t*)(ws + WS_PAR), 2048, 0, nb * 32, kb * 64, scr, lane); continue; } r -= I3;
        if (r < I3) { const int kb = r / 64, nb = r % 64; tr_item(a.in[30], 2048, nb * 32, (bf16_t*)(ws + WS_PAR), 2048, 1024, nb * 32, kb * 64, scr, lane); continue; } r -= I3;
        if (r < I3) { const int kb = r / 64, nb = r % 64; tr_item(a.in[31], 2048, nb * 32, (bf16_t*)(ws + WS_PM2), 2048, 0, nb * 32, kb * 64, scr, lane); continue; } r -= I3;
        if (r < I6) { const int kb = r / 64, nb = r % 64; tr_item(a.in[32], 2048, nb * 32, (bf16_t*)(ws + WS_WO), 2048, 0, nb * 32, kb * 64, scr, lane); continue; } r -= I6;
        if (r < I7) { const int kb = r / 352, nb = r % 352, r0 = nb * 32, tile = r0 >> 8, bj = (r0 & 255) >> 7, j = r0 & 127;
            tr_item(a.in[34], 2 * DFF, bj * DFF + 128 * tile + j, (bf16_t*)(ws + WS_WUP), 2048, 0, r0, kb * 64, scr, lane); continue; } r -= I7;
        { const int kb = r / 64, nb = r % 64; tr_item(a.in[37], 2048, nb * 32, (bf16_t*)(ws + WS_WDN), DFF, 0, nb * 32, kb * 64, scr, lane); }
    }
    for (int m = gw; m < NT + 1280; m += NGW) {
        if (m < NT) { const float* xr = m < TP ? a.in[0] + (size_t)m * DM : a.in[1] + (size_t)(m - TP) * DM; rms_row(xr, a.in[4], (bf16_t*)(ws + WS_H) + (size_t)m * DM, lane); }
        else { const int j = m - NT; const float* xr = j < 256 ? a.in[2] + (size_t)j * DM : a.in[3] + (size_t)(j - 256) * DM; rms_row(xr, a.in[25], (bf16_t*)(ws + WS_MEMN) + (size_t)j * DM, lane); }
    }
    { float* rc = (float*)(ws + WS_ROPE); float* rs = rc + TP * 32;
      for (int e = (vcu * NTHR + tid); e < TP * 32; e += G * NTHR) { const int t = e >> 5, d = e & 31; double rev = (double)t * a.inv_rev[d]; rev -= rint(rev); const float rf = (float)rev;
          rc[e] = __builtin_amdgcn_cosf(rf); rs[e] = __builtin_amdgcn_sinf(rf); } }
    if (blockIdx.x == 0) {
        unsigned* ctl = (unsigned*)(ws + WS_CTL);
        if (tid < 64) {
            if (tid == 0) { ctl[CW_QUEUE] = 0u; ctl[256] = 0u; ctl[257] = 0u; }
            const float s1 = wave_sum(a.in[8][tid] * a.in[9][tid]), s2 = wave_sum(a.in[10][tid] * a.in[11][tid]);
            if (tid == 0) ((float*)ctl)[CW_LAM] = __expf(s1) - __expf(s2) + 0.2f;
        }
    }
}

struct SchedIn {
    int v, G; const char* H; const char* WIN; const char* MEMN; const char* WKV;
    __device__ __forceinline__ bool next(int i, Unit& u) const {
        long L = (long)i * G + v; int pm, pn;
        if (L < 5760) { TileMap{192, 30}.get(L, pm, pn); u.A = H + (size_t)pm * MiB; u.B = WIN + (size_t)pn * MiB; u.nt = 32; u.pm = pm; u.pn = pn; u.kind = 0; u.t0 = 0; u.T = 0; return true; }
        L -= 5760; if (L < 40) { pm = (int)(L % 5); pn = (int)(L / 5); u.A = MEMN + (size_t)pm * MiB; u.B = WKV + (size_t)pn * MiB; u.nt = 32; u.pm = pm; u.pn = pn; u.kind = 1; u.t0 = 0; u.T = 0; return true; }
        return false;
    }
};
struct EpiIn {
    bf16_t* QK; bf16_t* VM; bf16_t* ZR; bf16_t* KVM; const float* qn; const float* kn; const float* rc; const float* rs;
    __device__ __forceinline__ void plain(const f32x4 (&acc)[2][2][4][2], bf16_t* base, size_t ldc, int row0, int col0) const {
#pragma unroll
        for (int ai = 0; ai < 2; ++ai)
#pragma unroll
            for (int m = 0; m < 4; ++m) { bf16_t* rowp = base + (size_t)(row0 + ai * 128 + m * 16) * ldc + col0;
#pragma unroll
                for (int bj = 0; bj < 2; ++bj) { const f32x4 v0 = acc[ai][bj][m][0], v1 = acc[ai][bj][m][1];
                    u32x4 w; w.x = cvt_pk_bf16(v0[0], v0[1]); w.y = cvt_pk_bf16(v0[2], v0[3]); w.z = cvt_pk_bf16(v1[0], v1[1]); w.w = cvt_pk_bf16(v1[2], v1[3]);
                    *(u32x4*)(rowp + bj * 128) = w; } }
    }
    __device__ __forceinline__ void operator()(const f32x4 (&acc)[2][2][4][2], const Unit& u, int wr, int wc, int fr, int fq) const {
        const int row0 = u.pm * 256 + wr * 64 + fr, cin = wc * 32 + 8 * fq;
        if (u.kind == 1) { plain(acc, KVM, 2048, row0, u.pn * 256 + cin); return; }
        const int pn = u.pn;
        if (pn < 8) {
            const bool isq = pn < 4; const float* nw = isq ? qn : kn;
            const int Gq = (pn & 3) * 4 + wc, d0 = 8 * fq;
            const float qs = isq ? 0.125f * 1.4426950408889634f : 1.f;
            const f32x4 w1a = *(const f32x4*)(nw + d0), w1b = *(const f32x4*)(nw + d0 + 4), w2a = *(const f32x4*)(nw + 32 + d0), w2b = *(const f32x4*)(nw + 36 + d0);
            bf16_t* dst = QK + (isq ? 0 : 1024) + Gq * 64 + d0;
#pragma unroll
            for (int ai = 0; ai < 2; ++ai)
#pragma unroll
                for (int m = 0; m < 4; ++m) {
                    const int row = row0 + ai * 128 + m * 16, t = tok_pos(row);
                    const f32x4 xa = acc[ai][0][m][0], xb = acc[ai][0][m][1], ya = acc[ai][1][m][0], yb = acc[ai][1][m][1];
                    float ss = (xa[0] * xa[0] + xa[1] * xa[1]) + (xa[2] * xa[2] + xa[3] * xa[3]) + (xb[0] * xb[0] + xb[1] * xb[1]) + (xb[2] * xb[2] + xb[3] * xb[3])
                             + (ya[0] * ya[0] + ya[1] * ya[1]) + (ya[2] * ya[2] + ya[3] * ya[3]) + (yb[0] * yb[0] + yb[1] * yb[1]) + (yb[2] * yb[2] + yb[3] * yb[3]);
                    ss += __shfl_xor(ss, 16); ss += __shfl_xor(ss, 32);
                    const float rstd = rsqrtf(ss * (1.f / 64.f) + 1e-6f);
                    const f32x4 ca = *(const f32x4*)(rc + t * 32 + d0), cb = *(const f32x4*)(rc + t * 32 + d0 + 4), sa = *(const f32x4*)(rs + t * 32 + d0), sb = *(const f32x4*)(rs + t * 32 + d0 + 4);
                    const f32x4 x1a = xa * rstd * w1a, x1b = xb * rstd * w1b, x2a = ya * rstd * w2a, x2b = yb * rstd * w2b;
                    const f32x4 o1a = (x1a * ca - x2a * sa) * qs, o1b = (x1b * cb - x2b * sb) * qs, o2a = (x2a * ca + x1a * sa) * qs, o2b = (x2b * cb + x1b * sb) * qs;
                    u32x4 w; w.x = cvt_pk_bf16(o1a[0], o1a[1]); w.y = cvt_pk_bf16(o1a[2], o1a[3]); w.z = cvt_pk_bf16(o1b[0], o1b[1]); w.w = cvt_pk_bf16(o1b[2], o1b[3]);
                    *(u32x4*)(dst + (size_t)row * 2048) = w;
                    w.x = cvt_pk_bf16(o2a[0], o2a[1]); w.y = cvt_pk_bf16(o2a[2], o2a[3]); w.z = cvt_pk_bf16(o2b[0], o2b[1]); w.w = cvt_pk_bf16(o2b[2], o2b[3]);
                    *(u32x4*)(dst + (size_t)row * 2048 + 32) = w;
                }
        } else if (pn < 12) plain(acc, VM, 2048, row0, (pn - 8) * 256 + cin);
        else if (pn < 26) plain(acc, ZR, ZRP, row0, (pn - 12) * 256 + cin);
        else plain(acc, VM, 2048, row0, 1024 + (pn - 26) * 256 + cin);
    }
};

namespace att {
constexpr int SHM_V = 16384, SHM_K = 8192;
constexpr int OFF_V = 0, OFF_K = 32768, OFF_WS = 49152, OFF_STASH = 51200;
#define KSWZ64(row, colB) ((row) * 128 + ((colB) ^ (((row) & 7) << 4)))
#define SBAR() __builtin_amdgcn_sched_barrier(0)
__device__ __forceinline__ int crow(int r, int hi) { return (r & 3) + 8 * (r >> 2) + 4 * hi; }
constexpr float THRL = 8.f;
__device__ __forceinline__ void partialSM(f32x16& p0, f32x16& p1, float& m_reg, float& alpha) {
    float pmax = fmaxf(fmaxf(p0[0], p0[1]), p0[2]);
#pragma unroll
    for (int r = 3; r < 15; r += 2) pmax = fmaxf(fmaxf(pmax, p0[r]), p0[r + 1]);
    pmax = fmaxf(fmaxf(pmax, p0[15]), p1[0]);
#pragma unroll
    for (int r = 1; r < 15; r += 2) pmax = fmaxf(fmaxf(pmax, p1[r]), p1[r + 1]);
    pmax = fmaxf(pmax, p1[15]);
    { auto rr = __builtin_amdgcn_permlane32_swap(__float_as_uint(pmax), __float_as_uint(pmax), false, false);
      pmax = fmaxf(__uint_as_float(rr[0]), __uint_as_float(rr[1])); }
    if (__builtin_expect(__all(pmax <= THRL), 1)) { alpha = 1.f; }
    else { const float dl = fmaxf(pmax, 0.f); alpha = __builtin_amdgcn_exp2f(-dl); m_reg += dl;
#pragma unroll
        for (int r = 0; r < 16; ++r) { p0[r] -= dl; p1[r] -= dl; } }
#pragma unroll
    for (int r = 0; r < 16; ++r) p0[r] = __builtin_amdgcn_exp2f(p0[r]);
}
__device__ __forceinline__ void finishSM(f32x16& p0, f32x16& p1, float alpha, float& l_reg, bf16x8& pa0, bf16x8& pa1, bf16x8& pa2, bf16x8& pa3) {
#pragma unroll
    for (int r = 0; r < 16; ++r) p1[r] = __builtin_amdgcn_exp2f(p1[r]);
    f32x2 s2 = (f32x2){p0[0], p0[1]} + (f32x2){p1[0], p1[1]};
#pragma unroll
    for (int r = 2; r < 16; r += 2) { s2 = s2 + (f32x2){p0[r], p0[r + 1]}; s2 = s2 + (f32x2){p1[r], p1[r + 1]}; }
    float ps = s2[0] + s2[1];
    { auto rr = __builtin_amdgcn_permlane32_swap(__float_as_uint(ps), __float_as_uint(ps), false, false);
      ps = __uint_as_float(rr[0]) + __uint_as_float(rr[1]); }
    l_reg = l_reg * alpha + ps;
#define PK4(P, BASE, OUT) do { unsigned a0 = cvt_pk_bf16(P[BASE + 0], P[BASE + 1]), a1 = cvt_pk_bf16(P[BASE + 2], P[BASE + 3]);   \
    unsigned b0 = cvt_pk_bf16(P[BASE + 4], P[BASE + 5]), b1 = cvt_pk_bf16(P[BASE + 6], P[BASE + 7]);                              \
    auto r0 = __builtin_amdgcn_permlane32_swap(a0, b0, false, false); auto r1 = __builtin_amdgcn_permlane32_swap(a1, b1, false, false); \
    u32x4 w = {r0[0], r1[0], r0[1], r1[1]}; OUT = *reinterpret_cast<bf16x8*>(&w); } while (0)
    PK4(p0, 0, pa0); PK4(p0, 8, pa1); PK4(p1, 0, pa2); PK4(p1, 8, pa3);
#undef PK4
}
__device__ __forceinline__ void qkt64(f32x16& p0, f32x16& p1, const char* Ks, const bf16x8* qr, int r32, int hi) {
#pragma unroll
    for (int d0 = 0; d0 < 4; ++d0) { const int cb = (d0 * 16 + hi * 8) * 2;
        const bf16x8 b0 = *reinterpret_cast<const bf16x8*>(Ks + KSWZ64(r32, cb));
        const bf16x8 b1 = *reinterpret_cast<const bf16x8*>(Ks + KSWZ64(32 + r32, cb));
        p0 = __builtin_amdgcn_mfma_f32_32x32x16_bf16(b0, qr[d0], p0, 0, 0, 0);
        p1 = __builtin_amdgcn_mfma_f32_32x32x16_bf16(b1, qr[d0], p1, 0, 0, 0); }
}
__device__ __forceinline__ int v_st(int k, int c) { const int kk = (k & ~0xC) | ((k & 4) << 1) | ((k & 8) >> 1); return ((kk >> 3) * 4 + (c >> 5)) * 512 + ((kk & 7) * 32 + (c & 31)) * 2; }
__device__ __forceinline__ int v_rd_base(int lane) { return ((lane & 3) << 3) | (((lane >> 2) & 3) << 6) | (((lane >> 4) & 1) << 5) | (((lane >> 5) & 1) << 8); }
constexpr int v_rd_off(int d0, int ks, int half) { return d0 * 512 + ks * 4096 + half * 2048; }
template <int OFF> __device__ __forceinline__ s16x4 tr_read(int vb) {
    s16x4 r; asm volatile("ds_read_b64_tr_b16 %0, %1 offset:%2" : "=&v"(r) : "v"(vb), "i"(OFF) : "memory"); return r;
}
template <int KS> __device__ __forceinline__ void pv_ks(f32x16* o, int vb, bf16x8 pa) {
    const s16x4 l0 = tr_read<v_rd_off(0, KS, 0)>(vb), h0 = tr_read<v_rd_off(0, KS, 1)>(vb), l1 = tr_read<v_rd_off(1, KS, 0)>(vb), h1 = tr_read<v_rd_off(1, KS, 1)>(vb);
    const s16x4 l2 = tr_read<v_rd_off(2, KS, 0)>(vb), h2 = tr_read<v_rd_off(2, KS, 1)>(vb), l3 = tr_read<v_rd_off(3, KS, 0)>(vb), h3 = tr_read<v_rd_off(3, KS, 1)>(vb);
    asm volatile("s_waitcnt lgkmcnt(0)" ::: "memory"); SBAR();
#define PK(L, H) (bf16x8){L[0], L[1], L[2], L[3], H[0], H[1], H[2], H[3]}
    o[0] = __builtin_amdgcn_mfma_f32_32x32x16_bf16(pa, PK(l0, h0), o[0], 0, 0, 0);
    o[1] = __builtin_amdgcn_mfma_f32_32x32x16_bf16(pa, PK(l1, h1), o[1], 0, 0, 0);
    o[2] = __builtin_amdgcn_mfma_f32_32x32x16_bf16(pa, PK(l2, h2), o[2], 0, 0, 0);
    o[3] = __builtin_amdgcn_mfma_f32_32x32x16_bf16(pa, PK(l3, h3), o[3], 0, 0, 0);
#undef PK
}
__device__ __forceinline__ void pv_d0(f32x16* o, int vb, bf16x8 pa0, bf16x8 pa1, bf16x8 pa2, bf16x8 pa3) {
    pv_ks<0>(o, vb, pa0); pv_ks<1>(o, vb, pa1); pv_ks<2>(o, vb, pa2); pv_ks<3>(o, vb, pa3);
}

__device__ __forceinline__ void stash_store(const unsigned* stash, bf16_t* Ow, int ldo, int lane) {
#pragma unroll
    for (int i = 0; i < 8; ++i) { const int q = i * 64 + lane, rl = q >> 4, c8 = (q & 15) * 8, hh = (rl >> 2) & 1, r = (rl & 3) + 4 * (rl >> 3), d0 = c8 >> 5, cc = c8 & 31;
        const unsigned* sp = stash + (d0 * 8 + (r >> 1)) * 64 + hh * 32 + cc; const u32x4 a = *(const u32x4*)sp, b = *(const u32x4*)(sp + 4);
        u32x4 w;
        if (r & 1) { w.x = (a.x >> 16) | (a.y & 0xffff0000u); w.y = (a.z >> 16) | (a.w & 0xffff0000u); w.z = (b.x >> 16) | (b.y & 0xffff0000u); w.w = (b.z >> 16) | (b.w & 0xffff0000u); }
        else { w.x = (a.x & 0xffffu) | (a.y << 16); w.y = (a.z & 0xffffu) | (a.w << 16); w.z = (b.x & 0xffffu) | (b.y << 16); w.w = (b.z & 0xffffu) | (b.w << 16); }
        *(u32x4*)(Ow + (size_t)rl * ldo + c8) = w; }
}

__device__ __forceinline__ void diff_unit(int s, int h, int qb, bf16_t* QK, const bf16_t* VM, float lam, char* lds) {
    constexpr int LDK = 2048;
    int tid = threadIdx.x; asm volatile("" : "+v"(tid));
    const int wid = __builtin_amdgcn_readfirstlane(tid >> 6), lane = tid & 63, r32 = lane & 31, hi = lane >> 5;
    const int tok0 = seq_start(s), T = seq_len(s), NTL = T / 64;
    char* V_lds = lds + OFF_V; char* K_lds = lds + OFF_K;
    float* wsf = (float*)(lds + OFF_WS) + wid * 64; float* li_l = wsf; float* al_l = wsf + 32;
    unsigned* stash = (unsigned*)(lds + OFF_STASH) + wid * 2048;
    const int sr = tid >> 4, sc = (tid & 15) * 8, vst0 = v_st(sr, sc), vst1 = v_st(32 + sr, sc);
    const int kr = tid >> 3, kc = (tid & 7) * 8, kst = KSWZ64(kr, kc * 2);
    const int vb0 = (int)(uintptr_t)V_lds + v_rd_base(lane);
    const bf16_t* Vh = VM + (size_t)tok0 * LDK + h * 128;
    const size_t qrow = (size_t)(tok0 + qb * 256 + wid * 32);
#pragma unroll 1
    for (int c = 0; c < 2; ++c) {
        const bf16_t* Kh = QK + (size_t)tok0 * LDK + 1024 + h * 128 + c * 64;
        const bf16_t* Qw = QK + (qrow + r32) * LDK + h * 128 + c * 64 + hi * 8;
        bf16x8 qr[4];
#pragma unroll
        for (int d0 = 0; d0 < 4; ++d0) qr[d0] = *reinterpret_cast<const bf16x8*>(Qw + d0 * 16);
        float m_reg = 0.f, l_reg = 0; f32x16 o[4] = {};
        struct { bf16x8 vs0, vs1, ks0; } sr_[2];
#define NEGM(P) do { const float nm_ = -m_reg; _Pragma("unroll") for (int r_ = 0; r_ < 16; ++r_) P[r_] = nm_; } while (0)
#define SLOAD(i, k0) do { sr_[i].vs0 = *reinterpret_cast<const bf16x8*>(&Vh[(size_t)((k0) + sr) * LDK + sc]); sr_[i].vs1 = *reinterpret_cast<const bf16x8*>(&Vh[(size_t)((k0) + 32 + sr) * LDK + sc]); \
    sr_[i].ks0 = *reinterpret_cast<const bf16x8*>(&Kh[(size_t)((k0) + kr) * LDK + kc]); } while (0)
#define SWRITE(b, i) do { *(bf16x8*)(V_lds + (b) * SHM_V + vst0) = sr_[i].vs0; *(bf16x8*)(V_lds + (b) * SHM_V + vst1) = sr_[i].vs1; *(bf16x8*)(K_lds + (b) * SHM_K + kst) = sr_[i].ks0; } while (0)
#define SWAIT() asm volatile("s_waitcnt vmcnt(3)" ::: "memory")
#define RESC(a) do { if (__any((a) < 1.f)) { if (hi == 0) al_l[r32] = (a); asm volatile("s_waitcnt lgkmcnt(0)" ::: "memory"); \
    _Pragma("unroll") for (int d = 0; d < 4; ++d) _Pragma("unroll") for (int r = 0; r < 16; ++r) o[d][r] *= al_l[crow(r, hi)]; } } while (0)
        f32x16 pA0, pA1, pB0, pB1; float alA, alB; bf16x8 pa0, pa1, pa2, pa3;
        SLOAD(0, 0); asm volatile("s_waitcnt vmcnt(0)" ::: "memory"); SWRITE(0, 0); __syncthreads();
        NEGM(pA0); NEGM(pA1); qkt64(pA0, pA1, K_lds, qr, r32, hi); partialSM(pA0, pA1, m_reg, alA);
        SLOAD(1, 64); if (2 < NTL) SLOAD(0, 128);
        SWAIT(); SWRITE(1, 1); __syncthreads();
        for (int j = 1; j + 1 < NTL; j += 2) {
            SBAR(); NEGM(pB0); NEGM(pB1); qkt64(pB0, pB1, K_lds + SHM_K, qr, r32, hi);
            finishSM(pA0, pA1, alA, l_reg, pa0, pa1, pa2, pa3); SBAR();
            SLOAD(1, (j + 2) * 64); SBAR();
            pv_d0(o, vb0, pa0, pa1, pa2, pa3); partialSM(pB0, pB1, m_reg, alB);
            __syncthreads(); SWAIT(); SWRITE(0, 0);
            RESC(alB); __syncthreads();
            SBAR(); NEGM(pA0); NEGM(pA1); qkt64(pA0, pA1, K_lds, qr, r32, hi);
            finishSM(pB0, pB1, alB, l_reg, pa0, pa1, pa2, pa3); SBAR();
            if (j + 3 < NTL) SLOAD(0, (j + 3) * 64); SBAR();
            pv_d0(o, vb0 + SHM_V, pa0, pa1, pa2, pa3); partialSM(pA0, pA1, m_reg, alA);
            __syncthreads(); SWAIT(); SWRITE(1, 1);
            RESC(alA); __syncthreads();
        }
        SBAR(); NEGM(pB0); NEGM(pB1); qkt64(pB0, pB1, K_lds + SHM_K, qr, r32, hi);
        finishSM(pA0, pA1, alA, l_reg, pa0, pa1, pa2, pa3); SBAR();
        pv_d0(o, vb0, pa0, pa1, pa2, pa3); partialSM(pB0, pB1, m_reg, alB);
        __syncthreads(); RESC(alB);
        finishSM(pB0, pB1, alB, l_reg, pa0, pa1, pa2, pa3); SBAR();
        pv_d0(o, vb0 + SHM_V, pa0, pa1, pa2, pa3);
#undef SLOAD
#undef SWRITE
#undef SWAIT
#undef RESC
#undef NEGM
        if (hi == 0) li_l[r32] = l_reg; asm volatile("s_waitcnt lgkmcnt(0)" ::: "memory");
        float rli[16];
#pragma unroll
        for (int r = 0; r < 16; ++r) rli[r] = __builtin_amdgcn_rcpf(li_l[crow(r, hi)]);
        { const float coef = c == 0 ? 1.f : -lam;
#pragma unroll
          for (int d0 = 0; d0 < 4; ++d0)
#pragma unroll
              for (int r = 0; r < 16; r += 2) { const int idx = (d0 * 8 + (r >> 1)) * 64 + lane; const unsigned w = c == 0 ? 0u : stash[idx];
                  stash[idx] = cvt_pk_bf16(bflo(w) + coef * o[d0][r] * rli[r], bfhi(w) + coef * o[d0][r + 1] * rli[r + 1]); } }
        __syncthreads();
    }
    stash_store(stash, QK + qrow * LDK + h * 128, LDK, lane);
    __syncthreads();
}

constexpr int MOFF_V = 0, MOFF_K = 32768, MOFF_WS = 65536, MOFF_RK = 67584, MOFF_G = 68608, MOFF_STASH = 69632;
__device__ __forceinline__ void mem_unit(int s, int mh, int qb, bf16_t* VM, const bf16_t* KVM, const float* mqn, const float* mkn, char* lds) {
    int tid = threadIdx.x; asm volatile("" : "+v"(tid));
    const int wid = __builtin_amdgcn_readfirstlane(tid >> 6), lane = tid & 63, r32 = lane & 31, hi = lane >> 5;
    const int tok0 = seq_start(s);
    char* V_lds = lds + MOFF_V; char* K_lds = lds + MOFF_K;
    float* wsf = (float*)(lds + MOFF_WS) + wid * 64; float* li_l = wsf; float* al_l = wsf + 32;
    float* rk_l = (float*)(lds + MOFF_RK); float* g_l = (float*)(lds + MOFF_G);
    const bf16_t* Kh = KVM + (size_t)(s * 256) * 2048 + mh * 256;
    const bf16_t* Vh = KVM + (size_t)(s * 256) * 2048 + 1024 + mh * 256;
    if (tid < 256) g_l[tid] = mqn[tid] * mkn[tid];
    {
        const bf16_t* kp = Kh + (size_t)(wid * 32 + r32) * 2048 + hi * 128; float ss = 0.f;
#pragma unroll
        for (int i = 0; i < 16; ++i) { const u32x4 w = *(const u32x4*)(kp + i * 8);
            ss += bflo(w.x) * bflo(w.x) + bfhi(w.x) * bfhi(w.x) + bflo(w.y) * bflo(w.y) + bfhi(w.y) * bfhi(w.y) + bflo(w.z) * bflo(w.z) + bfhi(w.z) * bfhi(w.z) + bflo(w.w) * bflo(w.w) + bfhi(w.w) * bfhi(w.w); }
        ss += __shfl_xor(ss, 32);
        if (hi == 0) rk_l[wid * 32 + r32] = rsqrtf(ss * (1.f / 256.f) + 1e-6f);
    }
    const size_t qrow = (size_t)(tok0 + qb * 256 + wid * 32);
    bf16_t* Qw = VM + (qrow + r32) * 2048 + 1024 + mh * 256 + hi * 8;
    float rqC;
    { float ss = 0.f;
#pragma unroll
      for (int i = 0; i < 16; ++i) { const u32x4 w = *(const u32x4*)(Qw + i * 16);
          ss += bflo(w.x) * bflo(w.x) + bfhi(w.x) * bfhi(w.x) + bflo(w.y) * bflo(w.y) + bfhi(w.y) * bfhi(w.y) + bflo(w.z) * bflo(w.z) + bfhi(w.z) * bfhi(w.z) + bflo(w.w) * bflo(w.w) + bfhi(w.w) * bfhi(w.w); }
      ss += __shfl_xor(ss, 32);
      rqC = rsqrtf(ss * (1.f / 256.f) + 1e-6f) * (0.0625f * 1.4426950408889634f); }
    const int sr = tid >> 4, sc = (tid & 15) * 8, vst0 = v_st(sr, sc), vst1 = v_st(32 + sr, sc);
    const int kr = tid >> 3, kc = (tid & 7) * 8, kst = KSWZ64(kr, kc * 2);
    const int vb0 = (int)(uintptr_t)V_lds + v_rd_base(lane);
    unsigned* stash = (unsigned*)(lds + MOFF_STASH) + wid * 2048;
    __syncthreads();
#pragma unroll 1
    for (int hv = 0; hv < 2; ++hv) {
    float m_reg = -1e30f, l_reg = 0.f; f32x16 o[4] = {};
#pragma unroll 1
    for (int t = 0; t < 4; ++t) {
        const int k0 = t * 64;
#pragma unroll
        for (int ds = 0; ds < 4; ++ds) { const u32x4 w = *(const u32x4*)(Kh + (size_t)(k0 + kr) * 2048 + ds * 64 + kc); const float* g = g_l + ds * 64 + kc;
            u32x4 o4; o4.x = cvt_pk_bf16(bflo(w.x) * g[0], bfhi(w.x) * g[1]); o4.y = cvt_pk_bf16(bflo(w.y) * g[2], bfhi(w.y) * g[3]);
            o4.z = cvt_pk_bf16(bflo(w.z) * g[4], bfhi(w.z) * g[5]); o4.w = cvt_pk_bf16(bflo(w.w) * g[6], bfhi(w.w) * g[7]);
            *(u32x4*)(K_lds + ds * 8192 + kst) = o4; asm volatile("" ::: "memory"); }
        *(u32x4*)(V_lds + vst0) = *(const u32x4*)(Vh + (size_t)(k0 + sr) * 2048 + hv * 128 + sc);
        *(u32x4*)(V_lds + vst1) = *(const u32x4*)(Vh + (size_t)(k0 + 32 + sr) * 2048 + hv * 128 + sc);
        __syncthreads();
        f32x16 p0 = {}, p1 = {};
#pragma unroll
        for (int ds = 0; ds < 4; ++ds) { bf16x8 qr[4];
#pragma unroll
            for (int d0 = 0; d0 < 4; ++d0) qr[d0] = *reinterpret_cast<const bf16x8*>(Qw + ds * 64 + d0 * 16);
            qkt64(p0, p1, K_lds + ds * 8192, qr, r32, hi); }
#pragma unroll
        for (int r = 0; r < 16; ++r) { p0[r] *= rk_l[k0 + crow(r, hi)] * rqC; p1[r] *= rk_l[k0 + 32 + crow(r, hi)] * rqC; }
        float pmax = p0[0];
#pragma unroll
        for (int r = 1; r < 16; ++r) pmax = fmaxf(pmax, p0[r]);
#pragma unroll
        for (int r = 0; r < 16; ++r) pmax = fmaxf(pmax, p1[r]);
        pmax = fmaxf(pmax, __shfl_xor(pmax, 32));
        const float mn = fmaxf(m_reg, pmax), alpha = __builtin_amdgcn_exp2f(m_reg - mn); m_reg = mn;
        float ps = 0.f;
#pragma unroll
        for (int r = 0; r < 16; ++r) { p0[r] = __builtin_amdgcn_exp2f(p0[r] - mn); p1[r] = __builtin_amdgcn_exp2f(p1[r] - mn); ps += p0[r] + p1[r]; }
        ps += __shfl_xor(ps, 32);
        l_reg = l_reg * alpha + ps;
        if (hi == 0) al_l[r32] = alpha; asm volatile("s_waitcnt lgkmcnt(0)" ::: "memory");
#pragma unroll
        for (int d = 0; d < 4; ++d)
#pragma unroll
            for (int r = 0; r < 16; ++r) o[d][r] *= al_l[crow(r, hi)];
        bf16x8 pa0, pa1, pa2, pa3;
#define PK4(P, BASE, OUT) do { unsigned a0 = cvt_pk_bf16(P[BASE + 0], P[BASE + 1]), a1 = cvt_pk_bf16(P[BASE + 2], P[BASE + 3]);   \
    unsigned b0 = cvt_pk_bf16(P[BASE + 4], P[BASE + 5]), b1 = cvt_pk_bf16(P[BASE + 6], P[BASE + 7]);                              \
    auto r0 = __builtin_amdgcn_permlane32_swap(a0, b0, false, false); auto r1 = __builtin_amdgcn_permlane32_swap(a1, b1, false, false); \
    u32x4 w = {r0[0], r1[0], r0[1], r1[1]}; OUT = *reinterpret_cast<bf16x8*>(&w); } while (0)
        PK4(p0, 0, pa0); PK4(p0, 8, pa1); PK4(p1, 0, pa2); PK4(p1, 8, pa3);
#undef PK4
        pv_d0(o, vb0, pa0, pa1, pa2, pa3);
        __syncthreads();
    }
    if (hi == 0) li_l[r32] = l_reg; asm volatile("s_waitcnt lgkmcnt(0)" ::: "memory");
    if (hv == 1) stash_store(stash, VM + qrow * 2048 + 1024 + mh * 256, 2048, lane);
#pragma unroll
    for (int d0 = 0; d0 < 4; ++d0)
#pragma unroll
        for (int r = 0; r < 16; r += 2) stash[(d0 * 8 + (r >> 1)) * 64 + lane] = cvt_pk_bf16(o[d0][r] * __builtin_amdgcn_rcpf(li_l[crow(r, hi)]), o[d0][r + 1] * __builtin_amdgcn_rcpf(li_l[crow(r + 1, hi)]));
    }
    stash_store(stash, VM + qrow * 2048 + 1024 + mh * 256 + 128, 2048, lane);
    __syncthreads();
}
#undef SBAR
}

namespace scan {
constexpr int TC = 32;
typedef _Float16 h2 __attribute__((ext_vector_type(2)));
typedef _Float16 h4 __attribute__((ext_vector_type(4)));
typedef _Float16 h8 __attribute__((ext_vector_type(8)));
constexpr int BUFB = 36864, O_R = 0, O_KD = 4096, O_KK = 8192, O_W = 12288, O_KA = 16384, O_V = 20480, O_Y = 28672;
constexpr int O_PRIV = 73728;
constexpr int O_TBL = 73728 + 32768;
__device__ __forceinline__ float dpp_red8(float x) {
    x += __uint_as_float(__builtin_amdgcn_update_dpp(0u, __float_as_uint(x), 0xB1, 0xf, 0xf, false));
    x += __uint_as_float(__builtin_amdgcn_update_dpp(0u, __float_as_uint(x), 0x4E, 0xf, 0xf, false));
    x += __uint_as_float(__builtin_amdgcn_update_dpp(0u, __float_as_uint(x), 0x141, 0xf, 0xf, false));
    return x;
}
template <int DIR> __device__ __forceinline__ void scan_chunk(const char* B_, h2 (&S)[2][4], int seg, int row0) {
    const char* base = B_ + seg * 16; const char* vbase = B_ + O_V + row0 * 4; char* ybase = (char*)B_ + O_Y + row0 * 4;
    u32x4 ck[2], cw[2], ca[2], cd[2], cr[2]; u32x2 cv[2];
#define LDSET(set, tl_) do { ck[set] = *(const u32x4*)(base + O_KK + (tl_) * 128); cw[set] = *(const u32x4*)(base + O_W + (tl_) * 128); ca[set] = *(const u32x4*)(base + O_KA + (tl_) * 128); \
    cd[set] = *(const u32x4*)(base + O_KD + (tl_) * 128); cr[set] = *(const u32x4*)(base + O_R + (tl_) * 128); cv[set] = *(const u32x2*)(vbase + (tl_) * 256); } while (0)
#define H2(u) __builtin_bit_cast(h2, (u))
    LDSET(0, DIR ? TC - 1 : 0);
#pragma unroll
    for (int st = 0; st < TC; ++st) {
        const int tl = DIR ? TC - 1 - st : st, cs = st & 1;
        if (st + 1 < TC) LDSET(cs ^ 1, DIR ? TC - 2 - st : st + 1);
#define SPLIT4(V, A0, A1, A2, A3) const h8 V##8 = __builtin_bit_cast(h8, V[cs]); const h2 A0 = __builtin_shufflevector(V##8, V##8, 0, 1), A1 = __builtin_shufflevector(V##8, V##8, 2, 3), \
    A2 = __builtin_shufflevector(V##8, V##8, 4, 5), A3 = __builtin_shufflevector(V##8, V##8, 6, 7)
        SPLIT4(ck, k0, k1, k2, k3); SPLIT4(cw, w0, w1, w2, w3); SPLIT4(ca, a0, a1, a2, a3); SPLIT4(cd, d0, d1, d2, d3); SPLIT4(cr, r0, r1, r2, r3);
#undef SPLIT4
        const h4 cv4 = __builtin_bit_cast(h4, cv[cs]);
        f32x2 yo;
#pragma unroll
        for (int h = 0; h < 2; ++h) {
            const h2 vv = h == 0 ? __builtin_shufflevector(cv4, cv4, 0, 1) : __builtin_shufflevector(cv4, cv4, 2, 3);
            float d = __builtin_amdgcn_fdot2(S[h][0], k0, 0.f, false); float e = __builtin_amdgcn_fdot2(S[h][2], k2, 0.f, false);
            d = __builtin_amdgcn_fdot2(S[h][1], k1, d, false); e = __builtin_amdgcn_fdot2(S[h][3], k3, e, false);
            d = dpp_red8(d + e);
            const h2 p0 = S[h][0] * w0 + vv * d0, p1 = S[h][1] * w1 + vv * d1, p2 = S[h][2] * w2 + vv * d2, p3 = S[h][3] * w3 + vv * d3;
            const _Float16 sh = (_Float16)(-d); const h2 sa = {sh, sh};
            S[h][0] = p0 + sa * a0; S[h][1] = p1 + sa * a1; S[h][2] = p2 + sa * a2; S[h][3] = p3 + sa * a3;
            float y = __builtin_amdgcn_fdot2(S[h][0], r0, 0.f, false); float z = __builtin_amdgcn_fdot2(S[h][2], r2, 0.f, false);
            y = __builtin_amdgcn_fdot2(S[h][1], r1, y, false); z = __builtin_amdgcn_fdot2(S[h][3], r3, z, false);
            yo[h] = dpp_red8(y + z);
        }
        if (seg == 0) *(f32x2*)(ybase + tl * 256) = yo;
    }
#undef LDSET
#undef H2
}
__device__ __forceinline__ unsigned pkh(float a, float b) { const h2 v = {(_Float16)a, (_Float16)b}; return __builtin_bit_cast(unsigned, v); }
struct P {
    const bf16_t* ZR; bf16_t* YB; float* BON;
    const float *mup, *mun, *w0, *w2, *a0, *a2, *kk_w, *ka_w, *rk_w;
};
__device__ __forceinline__ void job(int s, int dir, int head, const P& p, char* lds) {
    int tid = threadIdx.x; asm volatile("" : "+v"(tid));
    const int wid = __builtin_amdgcn_readfirstlane(tid >> 6), lane = tid & 63;
    const int tok0 = seq_start(s), T = seq_len(s), NCH = T / TC;
    float* TBL = (float*)(lds + O_TBL);
    float* MUP = TBL; float* MUN = TBL + 320; float* KKW = TBL + 640; float* KAW = TBL + 704; float* RKW = TBL + 768; float* BW = TBL + 832; float* BA = TBL + 896;
    __syncthreads();
    if (tid < 320) { const int which = tid >> 6, j = tid & 63; const int col = which < 3 ? which * 1024 + head * 64 + j : (which == 3 ? 3072 : 3200) + dir * 64 + j; MUP[tid] = p.mup[col]; MUN[tid] = p.mun[col]; }
    if (tid >= 320 && tid < 384) { const int j = tid - 320; KKW[j] = p.kk_w[head * 64 + j]; KAW[j] = p.ka_w[head * 64 + j]; RKW[j] = p.rk_w[head * 64 + j];
        BW[j] = p.w0[dir * 1024 + head * 64 + j]; BA[j] = p.a0[dir * 1024 + head * 64 + j]; }
    bf16_t* yb = p.YB + (size_t)dir * NT * 1024; float* bon = p.BON + (size_t)dir * NT * 16;
    if (wid >= 4) {
        const int pw = wid - 4;
        char* priv = lds + O_PRIV + pw * 8192;
        bf16_t* AWl = (bf16_t*)priv; bf16_t* AAl = AWl + 512; float* PK = (float*)(priv + 2048); float* PA = (float*)(priv + 4096); float* PR = (float*)(priv + 6144);
        bf16x8 Bf[2][4][2];
#pragma unroll
        for (int mat = 0; mat < 2; ++mat)
#pragma unroll
            for (int cbk = 0; cbk < 4; ++cbk)
#pragma unroll
                for (int ks = 0; ks < 2; ++ks) { const float* W2 = (mat == 0 ? p.w2 : p.a2) + (size_t)dir * 64 * 1024 + head * 64 + cbk * 16 + (lane & 15) + (size_t)(ks * 32 + (lane >> 4) * 8) * 1024;
                    float f[8];
#pragma unroll
                    for (int e = 0; e < 8; ++e) f[e] = W2[(size_t)e * 1024];
                    u32x4 w; w.x = cvt_pk_bf16(f[0], f[1]); w.y = cvt_pk_bf16(f[2], f[3]); w.z = cvt_pk_bf16(f[4], f[5]); w.w = cvt_pk_bf16(f[6], f[7]); Bf[mat][cbk][ks] = *reinterpret_cast<bf16x8*>(&w); }
        __syncthreads();
        const int pt = tid - 256;
        u32x4 zc[5], zm[5], zn[5];
#define PLOAD(cc) do { const int tf_ = dir ? T - TC * ((cc) + 1) : TC * (cc); \
    _Pragma("unroll") for (int k = 0; k < 5; ++k) { const int which = k, tl8 = lane >> 3, j0 = (lane & 7) * 8; \
        const int col = which < 3 ? which * 1024 + head * 64 + j0 : (which == 3 ? 3072 : 3200) + dir * 64 + j0; \
        const int t = tf_ + 8 * pw + tl8; const bf16_t* zp = p.ZR + (size_t)(tok0 + t) * ZRP + col; \
        zc[k] = *(const u32x4*)zp; zm[k] = (u32x4){0u, 0u, 0u, 0u}; zn[k] = (u32x4){0u, 0u, 0u, 0u}; \
        if (t > 0) zm[k] = *(const u32x4*)(zp - ZRP); \
        if (t < T - 1) zn[k] = *(const u32x4*)(zp + ZRP); } } while (0)
        PLOAD(0);
        for (int c = -1; c < NCH; ++c) {
            if (c >= 1) { const int cb_ = (c - 1) & 1, tf = dir ? T - TC * c : TC * (c - 1); const int tl = pt >> 3, c8 = (pt & 7) * 8;
                const float* yp = (const float*)(lds + cb_ * BUFB + O_Y) + tl * 64 + c8; const f32x4 y4 = *(const f32x4*)yp, y5 = *(const f32x4*)(yp + 4);
                u32x4 w; w.x = cvt_pk_bf16(y4[0], y4[1]); w.y = cvt_pk_bf16(y4[2], y4[3]); w.z = cvt_pk_bf16(y5[0], y5[1]); w.w = cvt_pk_bf16(y5[2], y5[3]);
                *(u32x4*)(yb + (size_t)(tok0 + tf + tl) * 1024 + head * 64 + c8) = w; }
            if (c + 1 < NCH) {
                const int nb = (c + 1) & 1, tfirst = dir ? T - TC * (c + 2) : TC * (c + 1);
                char* B_ = lds + nb * BUFB;
#pragma unroll
                for (int k = 0; k < 5; ++k) { const int which = k, tl8 = lane >> 3, j0 = (lane & 7) * 8, tl = 8 * pw + tl8;
                    const f32x4 mpa = *(const f32x4*)(MUP + which * 64 + j0), mpb = *(const f32x4*)(MUP + which * 64 + j0 + 4), mna = *(const f32x4*)(MUN + which * 64 + j0), mnb = *(const f32x4*)(MUN + which * 64 + j0 + 4);
                    const u32x4 z = zc[k], zmm = zm[k], znn = zn[k];
                    float v[8];
#define SH(i, zw, zmw, znw, lohi, mp_, mn_) { const float zz = lohi(zw), a_ = lohi(zmw), b_ = lohi(znw); v[i] = zz + mp_ * (a_ - zz) + mn_ * (b_ - zz); }
                    SH(0, z.x, zmm.x, znn.x, bflo, mpa[0], mna[0]) SH(1, z.x, zmm.x, znn.x, bfhi, mpa[1], mna[1]) SH(2, z.y, zmm.y, znn.y, bflo, mpa[2], mna[2]) SH(3, z.y, zmm.y, znn.y, bfhi, mpa[3], mna[3])
                    SH(4, z.z, zmm.z, znn.z, bflo, mpb[0], mnb[0]) SH(5, z.z, zmm.z, znn.z, bfhi, mpb[1], mnb[1]) SH(6, z.w, zmm.w, znn.w, bflo, mpb[2], mnb[2]) SH(7, z.w, zmm.w, znn.w, bfhi, mpb[3], mnb[3])
#undef SH
                    if (which < 2) { float* dst = (which == 0 ? PR : PK) + tl8 * 64 + j0;
                        *(f32x4*)dst = (f32x4){v[0], v[1], v[2], v[3]}; *(f32x4*)(dst + 4) = (f32x4){v[4], v[5], v[6], v[7]}; }
                    else if (which == 2) { unsigned* dst = (unsigned*)(B_ + O_V) + tl * 64 + j0;
                        *(u32x4*)dst = (u32x4){pkh(v[0], v[0]), pkh(v[1], v[1]), pkh(v[2], v[2]), pkh(v[3], v[3])}; *(u32x4*)(dst + 4) = (u32x4){pkh(v[4], v[4]), pkh(v[5], v[5]), pkh(v[6], v[6]), pkh(v[7], v[7])}; }
                    else { if (which == 3) {
#pragma unroll
                            for (int i = 0; i < 8; ++i) { const float e2 = __expf(2.f * v[i]); v[i] = 1.f - 2.f * __builtin_amdgcn_rcpf(e2 + 1.f); } }
                        u32x4 w; w.x = cvt_pk_bf16(v[0], v[1]); w.y = cvt_pk_bf16(v[2], v[3]); w.z = cvt_pk_bf16(v[4], v[5]); w.w = cvt_pk_bf16(v[6], v[7]);
                        *(u32x4*)((which == 3 ? AWl : AAl) + tl8 * 64 + j0) = w; }
                }
                if (c + 2 < NCH) PLOAD(c + 2);
                { const int tj = lane & 7, kq = lane >> 4;
#pragma unroll
                  for (int mat = 0; mat < 2; ++mat) { const bf16_t* Am = (mat == 0 ? AWl : AAl) + tj * 64 + kq * 8;
                      const bf16x8 y0 = *reinterpret_cast<const bf16x8*>(Am), y1 = *reinterpret_cast<const bf16x8*>(Am + 32);
#pragma unroll
                      for (int cbk = 0; cbk < 4; ++cbk) { f32x4 acc = {0.f, 0.f, 0.f, 0.f};
                          acc = __builtin_amdgcn_mfma_f32_16x16x32_bf16(Bf[mat][cbk][0], y0, acc, 0, 0, 0);
                          acc = __builtin_amdgcn_mfma_f32_16x16x32_bf16(Bf[mat][cbk][1], y1, acc, 0, 0, 0);
                          const int col = cbk * 16 + 4 * kq; const f32x4 bias = *(const f32x4*)((mat == 0 ? BW : BA) + col); f32x4 res;
#pragma unroll
                          for (int r = 0; r < 4; ++r) { const float u = acc[r] + bias[r];
                              const float sg = __builtin_amdgcn_rcpf(1.f + __expf(-u));
                              res[r] = mat == 0 ? __expf(-0.60653065971263342f * sg) : sg; }
                          if ((lane & 15) < 8) { if (mat == 0) *(u32x2*)((_Float16*)(B_ + O_W) + (8 * pw + tj) * 64 + col) = (u32x2){pkh(res[0], res[1]), pkh(res[2], res[3])};
                                                 else *(f32x4*)(PA + tj * 64 + col) = res; } } } }
                { const int t8 = lane >> 3, tl = 8 * pw + t8, c0 = (lane & 7) * 8; const int o = t8 * 64 + c0;
                  float bs = 0.f, ss = 0.f; f32x4 kr[2], k4[2], a4[2], r4[2];
#pragma unroll
                  for (int q = 0; q < 2; ++q) { k4[q] = *(const f32x4*)(PK + o + 4 * q); a4[q] = *(const f32x4*)(PA + o + 4 * q); r4[q] = *(const f32x4*)(PR + o + 4 * q);
                      kr[q] = k4[q] * *(const f32x4*)(KKW + c0 + 4 * q); ss += (kr[q][0] * kr[q][0] + kr[q][1] * kr[q][1]) + (kr[q][2] * kr[q][2] + kr[q][3] * kr[q][3]); }
                  ss = dpp_red8(ss);
                  const float inv = __builtin_amdgcn_rsqf(fmaxf(ss, 1e-24f));
                  f32x4 kk[2], kd[2], kka[2];
#pragma unroll
                  for (int q = 0; q < 2; ++q) { kk[q] = kr[q] * inv; kd[q] = k4[q] * (1.f + (a4[q] - 1.f) * *(const f32x4*)(KAW + c0 + 4 * q)); kka[q] = kk[q] * a4[q];
                      const f32x4 bb = r4[q] * kd[q] * *(const f32x4*)(RKW + c0 + 4 * q); bs += (bb[0] + bb[1]) + (bb[2] + bb[3]); }
                  const int oh = (tl * 64 + c0) * 2;
#define ST8(OFF, X) *(u32x4*)(B_ + (OFF) + oh) = (u32x4){pkh(X[0][0], X[0][1]), pkh(X[0][2], X[0][3]), pkh(X[1][0], X[1][1]), pkh(X[1][2], X[1][3])}
                  ST8(O_KK, kk); ST8(O_KD, kd); ST8(O_KA, kka); ST8(O_R, r4);
#undef ST8
                  bs = dpp_red8(bs);
                  if ((lane & 7) == 0) bon[(size_t)(tok0 + tfirst + tl) * 16 + head] = bs; }
            }
            asm volatile("s_waitcnt lgkmcnt(0)" ::: "memory"); __builtin_amdgcn_s_barrier(); asm volatile("" ::: "memory");
        }
#undef PLOAD
    } else {
        __syncthreads();
        const int row0 = wid * 16 + (lane >> 3) * 2, seg = lane & 7;
        h2 S[2][4];
#pragma unroll
        for (int h = 0; h < 2; ++h)
#pragma unroll
            for (int q = 0; q < 4; ++q) S[h][q] = (h2){(_Float16)0.f, (_Float16)0.f};
        asm volatile("s_waitcnt lgkmcnt(0)" ::: "memory"); __builtin_amdgcn_s_barrier(); asm volatile("" ::: "memory");
        for (int c = 0; c < NCH; ++c) {
            const char* B_ = lds + (c & 1) * BUFB;
            if (dir) scan_chunk<1>(B_, S, seg, row0); else scan_chunk<0>(B_, S, seg, row0);
            asm volatile("s_waitcnt lgkmcnt(0)" ::: "memory"); __builtin_amdgcn_s_barrier(); asm volatile("" ::: "memory");
        }
    }
    if (wid >= 4) {
        const int pt = tid - 256, c = NCH, cb_ = (c - 1) & 1, tf = dir ? T - TC * c : TC * (c - 1); const int tl = pt >> 3, c8 = (pt & 7) * 8;
        const float* yp = (const float*)(lds + cb_ * BUFB + O_Y) + tl * 64 + c8; const f32x4 y4 = *(const f32x4*)yp, y5 = *(const f32x4*)(yp + 4);
        u32x4 w; w.x = cvt_pk_bf16(y4[0], y4[1]); w.y = cvt_pk_bf16(y4[2], y4[3]); w.z = cvt_pk_bf16(y5[0], y5[1]); w.w = cvt_pk_bf16(y5[2], y5[3]);
        *(u32x4*)(yb + (size_t)(tok0 + tf + tl) * 1024 + head * 64 + c8) = w;
    }
    __syncthreads();
}
}

__device__ __forceinline__ void p4_post(const Args& a, char* lds, int vcu, int G) {
    const int tid = threadIdx.x, lane = tid & 63;
    unsigned char* ws = a.ws;
    const bf16_t* ZR = (const bf16_t*)a.out; bf16_t* QK = (bf16_t*)(ws + WS_QK);
    const bf16_t* Y0 = (const bf16_t*)(ws + WS_Y); const bf16_t* Y1 = Y0 + (size_t)NT * 1024;
    const float* BON = (const float*)(ws + WS_BON);
    const float* mup = a.in[13]; const float* mun = a.in[14]; const float* G2 = a.in[19]; const float* lnw = a.in[23]; const float* lnb = a.in[24]; const float* subg = a.in[12];
    float* SG = (float*)lds; float* BL = (float*)(lds + 20480);
    for (int tile = vcu; tile < NT / 32; tile += G) {
        const int tk0 = tile * 32;
        __syncthreads();
        for (int it = tid; it < 32 * 20; it += NTHR) {
            const int tl = it / 20, j0 = (it % 20) * 8, col = 3328 + j0, tok = tk0 + tl, t = tok_pos(tok), T = tok < TP ? TP : TS;
            const bf16_t* zp = ZR + (size_t)tok * ZRP + col; const u32x4 z = *(const u32x4*)zp; u32x4 zm = {0u, 0u, 0u, 0u}, zn = {0u, 0u, 0u, 0u};
            if (t > 0) zm = *(const u32x4*)(zp - ZRP);
            if (t < T - 1) zn = *(const u32x4*)(zp + ZRP);
            float v[8];
#define SH(i, zw, zmw, znw, lohi) { const float zz = lohi(zw), a_ = lohi(zmw), b_ = lohi(znw), mp_ = mup[col + i], mn_ = mun[col + i]; v[i] = sigmoidf_(zz + mp_ * (a_ - zz) + mn_ * (b_ - zz)); }
            SH(0, z.x, zm.x, zn.x, bflo) SH(1, z.x, zm.x, zn.x, bfhi) SH(2, z.y, zm.y, zn.y, bflo) SH(3, z.y, zm.y, zn.y, bfhi)
            SH(4, z.z, zm.z, zn.z, bflo) SH(5, z.z, zm.z, zn.z, bfhi) SH(6, z.w, zm.w, zn.w, bflo) SH(7, z.w, zm.w, zn.w, bfhi)
#undef SH
            *(f32x4*)(SG + tl * 160 + j0) = (f32x4){v[0], v[1], v[2], v[3]}; *(f32x4*)(SG + tl * 160 + j0 + 4) = (f32x4){v[4], v[5], v[6], v[7]};
        }
        { const int tl = tid >> 4, hd = tid & 15; BL[tid] = BON[(size_t)(tk0 + tl) * 16 + hd] + BON[(size_t)NT * 16 + (size_t)(tk0 + tl) * 16 + hd]; }
        { const int pr = tid >> 1, half = tid & 1, tl = pr >> 3, hd = pr & 7; bf16_t* op = QK + (size_t)(tk0 + tl) * 2048 + hd * 128 + half * 64;
          u32x4 w[8]; float ss = 0.f;
#pragma unroll
          for (int i = 0; i < 8; ++i) { w[i] = *(const u32x4*)(op + i * 8);
              ss += bflo(w[i].x) * bflo(w[i].x) + bfhi(w[i].x) * bfhi(w[i].x) + bflo(w[i].y) * bflo(w[i].y) + bfhi(w[i].y) * bfhi(w[i].y) + bflo(w[i].z) * bflo(w[i].z) + bfhi(w[i].z) * bfhi(w[i].z) + bflo(w[i].w) * bflo(w[i].w) + bfhi(w[i].w) * bfhi(w[i].w); }
          ss += __shfl_xor(ss, 1);
          const float rstd = rsqrtf(ss * (1.f / 128.f) + 1e-6f) * 0.8f; const float* sg = subg + half * 64;
#pragma unroll
          for (int i = 0; i < 8; ++i) { u32x4 o;
              o.x = cvt_pk_bf16(bflo(w[i].x) * rstd * sg[i * 8 + 0], bfhi(w[i].x) * rstd * sg[i * 8 + 1]); o.y = cvt_pk_bf16(bflo(w[i].y) * rstd * sg[i * 8 + 2], bfhi(w[i].y) * rstd * sg[i * 8 + 3]);
              o.z = cvt_pk_bf16(bflo(w[i].z) * rstd * sg[i * 8 + 4], bfhi(w[i].z) * rstd * sg[i * 8 + 5]); o.w = cvt_pk_bf16(bflo(w[i].w) * rstd * sg[i * 8 + 6], bfhi(w[i].w) * rstd * sg[i * 8 + 7]);
              *(u32x4*)(op + i * 8) = o; } }
        __syncthreads();
        const int c0 = tid * 2;
        float acc[32][2];
#pragma unroll
        for (int i = 0; i < 32; ++i) { acc[i][0] = 0.f; acc[i][1] = 0.f; }
#pragma unroll 1
        for (int k = 0; k < 160; k += 4) {
            const f32x2 g0 = *(const f32x2*)(G2 + (size_t)(k + 0) * 1024 + c0), g1 = *(const f32x2*)(G2 + (size_t)(k + 1) * 1024 + c0), g2 = *(const f32x2*)(G2 + (size_t)(k + 2) * 1024 + c0), g3 = *(const f32x2*)(G2 + (size_t)(k + 3) * 1024 + c0);
#pragma unroll
            for (int i = 0; i < 32; ++i) { const f32x4 s4 = *(const f32x4*)(SG + i * 160 + k);
                acc[i][0] += s4[0] * g0[0] + s4[1] * g1[0] + s4[2] * g2[0] + s4[3] * g3[0];
                acc[i][1] += s4[0] * g0[1] + s4[1] * g1[1] + s4[2] * g2[1] + s4[3] * g3[1]; }
        }
        const int hd = tid >> 5;
        const float lw0 = lnw[c0], lw1 = lnw[c0 + 1], lb0 = lnb[c0], lb1 = lnb[c0 + 1];
        const float mp0 = mup[2048 + c0], mp1 = mup[2048 + c0 + 1], mn0 = mun[2048 + c0], mn1 = mun[2048 + c0 + 1];
#pragma unroll
        for (int i = 0; i < 32; ++i) {
            const int tok = tk0 + i, t = tok_pos(tok), T = tok < TP ? TP : TS;
            const unsigned ya = *(const unsigned*)(Y0 + (size_t)tok * 1024 + c0), yb = *(const unsigned*)(Y1 + (size_t)tok * 1024 + c0);
            const float y0 = bflo(ya) + bflo(yb), y1 = bfhi(ya) + bfhi(yb);
            float s = y0 + y1, q = y0 * y0 + y1 * y1;
#pragma unroll
            for (int o = 1; o < 32; o <<= 1) { s += __shfl_xor(s, o); q += __shfl_xor(q, o); }
            const float mean = s * (1.f / 64.f), var = fmaxf(q * (1.f / 64.f) - mean * mean, 0.f), rstd = rsqrtf(var + 64e-5f);
            const bf16_t* zp = ZR + (size_t)tok * ZRP + 2048 + c0; const unsigned z = *(const unsigned*)zp;
            unsigned zm = 0u, zn = 0u;
            if (t > 0) zm = *(const unsigned*)(zp - ZRP);
            if (t < T - 1) zn = *(const unsigned*)(zp + ZRP);
            const float v0 = bflo(z) + mp0 * (bflo(zm) - bflo(z)) + mn0 * (bflo(zn) - bflo(z)), v1 = bfhi(z) + mp1 * (bfhi(zm) - bfhi(z)) + mn1 * (bfhi(zn) - bfhi(z));
            const float bo = BL[i * 16 + hd];
            const float o0 = ((y0 - mean) * rstd * lw0 + lb0 + bo * v0) * acc[i][0], o1 = ((y1 - mean) * rstd * lw1 + lb1 + bo * v1) * acc[i][1];
            *(unsigned*)(QK + (size_t)tok * 2048 + 1024 + c0) = cvt_pk_bf16(o0, o1);
        }
    }
    __syncthreads();
}

struct SchedMerge {
    int v, G; const char* H; const char* WG; const char* QK; const char* VM; const char* PAR; const char* PM2;
    __device__ __forceinline__ bool next(int i, Unit& u) const {
        const int ti = i / 6, kind = i - ti * 6; const long L = (long)ti * G + v; int pm, pn;
        if (!TileMap{192, 8}.get(L, pm, pn)) return false;
        u.pm = pm; u.pn = pn; u.kind = kind; u.t0 = 0; u.T = 0;
        const size_t bo = (size_t)pn * MiB;
        switch (kind) {
            case 0: u.A = H + (size_t)pm * MiB; u.B = WG + bo; u.nt = 32; break;
            case 1: u.A = QK + (size_t)pm * MiB; u.B = PAR + bo; u.nt = 16; break;
            case 2: u.A = H + (size_t)pm * MiB; u.B = WG + 8 * MiB + bo; u.nt = 32; break;
            case 3: u.A = QK + (size_t)pm * MiB + 2048; u.B = PAR + bo + 2048; u.nt = 16; break;
            case 4: u.A = H + (size_t)pm * MiB; u.B = WG + 16 * MiB + bo; u.nt = 32; break;
            default: u.A = VM + (size_t)pm * MiB + 2048; u.B = PM2 + bo; u.nt = 16; break;
        }
        return true;
    }
};
struct EpiMerge {
    u32x4* scrG; f32x4* scrP; bf16_t* MRG;
    __device__ __forceinline__ void operator()(const f32x4 (&acc)[2][2][4][2], const Unit& u, int wr, int wc, int fr, int fq) const {
        const int tid = threadIdx.x, kind = u.kind;
        u32x4* gp = scrG + tid; f32x4* pp = scrP + tid;
        if ((kind & 1) == 0) {
#pragma unroll
            for (int ai = 0; ai < 2; ++ai)
#pragma unroll
                for (int bj = 0; bj < 2; ++bj)
#pragma unroll
                    for (int m = 0; m < 4; ++m) { const f32x4 v0 = acc[ai][bj][m][0], v1 = acc[ai][bj][m][1]; u32x4 w;
                        w.x = cvt_pk_bf16(sigmoidf_(v0[0]), sigmoidf_(v0[1])); w.y = cvt_pk_bf16(sigmoidf_(v0[2]), sigmoidf_(v0[3]));
                        w.z = cvt_pk_bf16(sigmoidf_(v1[0]), sigmoidf_(v1[1])); w.w = cvt_pk_bf16(sigmoidf_(v1[2]), sigmoidf_(v1[3]));
                        *gp = w; gp += NTHR; asm volatile("" : "+v"(gp) :: "memory"); }
        } else {
            const int row0 = u.pm * 256 + wr * 64 + fr, col0 = u.pn * 256 + wc * 32 + 8 * fq;
#pragma unroll
            for (int ai = 0; ai < 2; ++ai)
#pragma unroll
                for (int bj = 0; bj < 2; ++bj) {
                    bf16_t* mp = MRG + (size_t)(row0 + ai * 128) * 2048 + col0 + bj * 128;
#pragma unroll
                    for (int m = 0; m < 4; ++m) { const u32x4 g = *gp;
                        f32x4 p0 = acc[ai][bj][m][0] * (f32x4){bflo(g.x), bfhi(g.x), bflo(g.y), bfhi(g.y)}, p1 = acc[ai][bj][m][1] * (f32x4){bflo(g.z), bfhi(g.z), bflo(g.w), bfhi(g.w)};
                        if (kind > 1) { p0 += pp[0]; p1 += pp[NTHR]; }
                        if (kind < 5) { pp[0] = p0; pp[NTHR] = p1; }
                        else { u32x4 w; w.x = cvt_pk_bf16(p0[0], p0[1]); w.y = cvt_pk_bf16(p0[2], p0[3]); w.z = cvt_pk_bf16(p1[0], p1[1]); w.w = cvt_pk_bf16(p1[2], p1[3]);
                            *(u32x4*)mp = w; }
                        gp += NTHR; pp += 2 * NTHR; mp += 16 * 2048; asm volatile("" : "+v"(gp), "+v"(pp), "+v"(mp) :: "memory"); } }
        }
    }
};

struct SchedSq {
    int v, G; const char* A; const char* B; size_t astep, bstep; int nt;
    __device__ __forceinline__ bool next(int i, Unit& u) const {
        const long L = (long)i * G + v; int pm, pn; if (!TileMap{192, 8}.get(L, pm, pn)) return false;
        u.A = A + (size_t)pm * astep; u.B = B + (size_t)pn * bstep; u.nt = nt; u.pm = pm; u.pn = pn; u.kind = 0; u.t0 = 0; u.T = 0; return true;
    }
};
struct EpiWo {
    const float* xp; const float* xs; float* out;
    __device__ __forceinline__ void operator()(const f32x4 (&acc)[2][2][4][2], const Unit& u, int wr, int wc, int fr, int fq) const {
        const int row0 = u.pm * 256 + wr * 64 + fr, col0 = u.pn * 256 + wc * 32 + 8 * fq;
#pragma unroll
        for (int ai = 0; ai < 2; ++ai)
#pragma unroll
            for (int m = 0; m < 4; ++m) { const int row = row0 + ai * 128 + m * 16;
                const float* xr = (row < TP ? xp + (size_t)row * DM : xs + (size_t)(row - TP) * DM) + col0; float* orow = out + (size_t)row * DM + col0;
#pragma unroll
                for (int bj = 0; bj < 2; ++bj) { const f32x4 x0 = *(const f32x4*)(xr + bj * 128), x1 = *(const f32x4*)(xr + bj * 128 + 4);
                    *(f32x4*)(orow + bj * 128) = x0 + acc[ai][bj][m][0]; *(f32x4*)(orow + bj * 128 + 4) = x1 + acc[ai][bj][m][1]; } }
    }
};
struct EpiDown {
    float* out;
    __device__ __forceinline__ void operator()(const f32x4 (&acc)[2][2][4][2], const Unit& u, int wr, int wc, int fr, int fq) const {
        const int row0 = u.pm * 256 + wr * 64 + fr, col0 = u.pn * 256 + wc * 32 + 8 * fq;
#pragma unroll
        for (int ai = 0; ai < 2; ++ai)
#pragma unroll
            for (int m = 0; m < 4; ++m) { float* orow = out + (size_t)(row0 + ai * 128 + m * 16) * DM + col0;
#pragma unroll
                for (int bj = 0; bj < 2; ++bj) { const f32x4 x0 = *(const f32x4*)(orow + bj * 128), x1 = *(const f32x4*)(orow + bj * 128 + 4);
                    *(f32x4*)(orow + bj * 128) = x0 + acc[ai][bj][m][0]; *(f32x4*)(orow + bj * 128 + 4) = x1 + acc[ai][bj][m][1]; } }
    }
};

struct SchedUp {
    int v, G; const char* HN; const char* WUP;
    __device__ __forceinline__ bool next(int i, Unit& u) const {
        const long L = (long)i * G + v; int pm, pn; if (!TileMap{197, 44}.get(L, pm, pn)) return false;
        int s, ti; if (pm < 65) { s = 0; ti = pm; } else { s = 1 + (pm - 65) / 33; ti = (pm - 65) % 33; }
        const int T = seq_len(s); int t0 = 254 * ti - 1; if (t0 > T - 255) t0 = T - 255;
        u.pm = seq_start(s); u.pn = pn; u.kind = 0; u.t0 = t0; u.T = T; u.nt = 32;
        u.A = HN + ((long)u.pm + t0) * 4096; u.B = WUP + (size_t)pn * MiB; return true;
    }
};
struct EpiUp {
    bf16_t* ACT; const float* cw; const float* cb; LAS float* xch;
    __device__ __forceinline__ void operator()(const f32x4 (&acc)[2][2][4][2], const Unit& u, int wr, int wc, int fr, int fq) const {
        const int lane = threadIdx.x & 63;
        const int cin = wc * 32 + 8 * fq;
#pragma unroll
        for (int ai = 0; ai < 2; ++ai) { const int rg = 2 * ai + wr;
#pragma unroll
            for (int bj = 0; bj < 2; ++bj)
#pragma unroll
                for (int n = 0; n < 2; ++n) {
                    if (fr == 0) *(LAS f32x4*)(xch + (rg * 2 + 0) * 256 + bj * 128 + cin + 4 * n) = acc[ai][bj][0][n];
                    if (fr == 15) *(LAS f32x4*)(xch + (rg * 2 + 1) * 256 + bj * 128 + cin + 4 * n) = acc[ai][bj][3][n]; } }
        asm volatile("s_waitcnt lgkmcnt(0)" ::: "memory"); __builtin_amdgcn_s_barrier(); asm volatile("" ::: "memory");
        const int gc = u.pn * 128 + cin;
#pragma unroll
        for (int n = 0; n < 2; ++n) {
            const int wcol = gc + 4 * n;
            const f32x4 g0 = *(const f32x4*)(cw + wcol), g1 = *(const f32x4*)(cw + 2 * DFF + wcol), g2 = *(const f32x4*)(cw + 4 * DFF + wcol), gb = *(const f32x4*)(cb + wcol);
            const f32x4 v0 = *(const f32x4*)(cw + DFF + wcol), v1 = *(const f32x4*)(cw + 3 * DFF + wcol), v2 = *(const f32x4*)(cw + 5 * DFF + wcol), vb = *(const f32x4*)(cb + DFF + wcol);
#pragma unroll
            for (int ai = 0; ai < 2; ++ai) { const int rg = 2 * ai + wr;
                bf16_t* ap = ACT + ((long)u.pm + u.t0 + 128 * ai + 64 * wr + fr) * DFF + gc + 4 * n;
#pragma unroll
                for (int m = 0; m < 4; ++m) {
                    const int j = 128 * ai + 64 * wr + 16 * m + fr, t = u.t0 + j;
                    f32x4 res;
#pragma unroll
                    for (int bj = 0; bj < 2; ++bj) {
                        const f32x4 cur = acc[ai][bj][m][n];
                        const f32x4 sp = (m > 0 && fr == 15) ? acc[ai][bj][m > 0 ? m - 1 : 0][n] : cur;
                        const f32x4 sn = (m < 3 && fr == 0) ? acc[ai][bj][m < 3 ? m + 1 : 3][n] : cur;
                        f32x4 pv, nv;
#pragma unroll
                        for (int i = 0; i < 4; ++i) { pv[i] = __uint_as_float(__builtin_amdgcn_update_dpp(0u, __float_as_uint(sp[i]), 0x121, 0xf, 0xf, false));
                                                       nv[i] = __uint_as_float(__builtin_amdgcn_update_dpp(0u, __float_as_uint(sn[i]), 0x12F, 0xf, 0xf, false)); }
                        if (m == 0) { const f32x4 xprev = rg > 0 ? *(const LAS f32x4*)(xch + ((rg - 1) * 2 + 1) * 256 + bj * 128 + cin + 4 * n) : (f32x4){0.f, 0.f, 0.f, 0.f}; if (fr == 0) pv = xprev; }
                        if (m == 3) { const f32x4 xnext = rg < 3 ? *(const LAS f32x4*)(xch + ((rg + 1) * 2 + 0) * 256 + bj * 128 + cin + 4 * n) : (f32x4){0.f, 0.f, 0.f, 0.f}; if (fr == 15) nv = xnext; }
                        if (t < 1) pv = (f32x4){0.f, 0.f, 0.f, 0.f};
                        if (t >= u.T - 1) nv = (f32x4){0.f, 0.f, 0.f, 0.f};
                        if (bj == 0) { const f32x4 cv = g0 * pv + g1 * cur + g2 * nv + gb; res = (f32x4){cv[0] * sigmoidf_(cv[0]), cv[1] * sigmoidf_(cv[1]), cv[2] * sigmoidf_(cv[2]), cv[3] * sigmoidf_(cv[3])}; }
                        else { const f32x4 cv = v0 * pv + v1 * cur + v2 * nv + vb; res = res * cv; }
                    }
                    if (j >= 1 && j <= 254) { u32x2 w; w.x = cvt_pk_bf16(res[0], res[1]); w.y = cvt_pk_bf16(res[2], res[3]); *(u32x2*)ap = w; }
                    ap += 16 * DFF; asm volatile("" : "+v"(ap) :: "memory");
                }
            }
        }
    }
};

__global__ void __launch_bounds__(NTHR, 2) enc_fwd(Args args) {
    extern __shared__ __attribute__((aligned(16))) unsigned char lds_raw[];
    cg::grid_group grid = cg::this_grid();
    LAS unsigned char* lds = (LAS unsigned char*)lds_raw;
    const int tid = threadIdx.x;
    const int G = gridDim.x, bx = blockIdx.x, vcu = (G % 8 == 0) ? (bx % 8) * (G / 8) + bx / 8 : bx;
    unsigned char* ws = args.ws;
    const int lo = args.ph_lo, hi = args.ph_hi;
#ifndef P2M
#define P2M 7
#endif
#ifndef PH_MASK
#define PH_MASK 0x1ff
#endif
#define IN(k) (((PH_MASK >> (k)) & 1) && lo <= (k) && (k) < hi)
#define SEAM(k) do { if (IN(k) && IN((k) + 1)) grid.sync(); } while (0)
#ifndef PROBE
#define PROBE 0
#endif
    unsigned long long tp0 = 0, tp1 = 0;
#define TSTAMP(v) do { if (PROBE) { v = __builtin_amdgcn_s_memrealtime(); } } while (0)

    if (IN(0)) p0_prologue(args, lds, vcu, G);
    SEAM(0);
    if (IN(1)) {
        SchedIn S{vcu, G, (const char*)(ws + WS_H), (const char*)(ws + WS_WIN), (const char*)(ws + WS_MEMN), (const char*)(ws + WS_WKV)};
        EpiIn E{(bf16_t*)(ws + WS_QK), (bf16_t*)(ws + WS_VM), (bf16_t*)args.out, (bf16_t*)(ws + WS_KVM), args.in[6], args.in[7], (const float*)(ws + WS_ROPE), (const float*)(ws + WS_ROPE) + TP * 32};
        pg8::gemm_phase<EpiIn, SchedIn, true>(lds, 2048, S, E);
    }
    SEAM(1);
    if (PROBE == 1 || PROBE == 2) TSTAMP(tp0);
    if (IN(2)) {
        unsigned* ctl = (unsigned*)(ws + WS_CTL);
        volatile LAS unsigned* jobw = (volatile LAS unsigned*)(lds + LDS_MISC);
        const float lam = ((const float*)ctl)[CW_LAM];
        scan::P sp{(const bf16_t*)args.out, (bf16_t*)(ws + WS_Y), (float*)(ws + WS_BON), args.in[13], args.in[14], args.in[15], args.in[16], args.in[17], args.in[18], args.in[20], args.in[21], args.in[22]};
        for (;;) {
            __syncthreads();
            if (tid == 0) jobw[0] = atomicAdd(ctl + CW_QUEUE, 1u);
            __syncthreads();
            const int jb = (int)jobw[0];
            if (jb >= 160 + 1536 + 768) break;
            if (((P2M) & 1) && jb < 160) {
                int s, r; if (jb < 32) { s = 0; r = jb; } else { s = 1 + (jb - 32) / 32; r = (jb - 32) % 32; }
                scan::job(s, r & 1, r >> 1, sp, (char*)lds_raw);
                if (PROBE == 2 && tid == 0) atomicMax((unsigned long long*)(ctl + 256), (unsigned long long)__builtin_amdgcn_s_memrealtime());
            } else if (((P2M) & 2) && jb < 160 + 1536) {
                const int a = jb - 160; int s, h, qb;
                if (a < 512) { s = 0; h = a / 64; qb = a % 64; } else { const int b = a - 512; s = 1 + b / 256; h = (b % 256) / 32; qb = b % 32; }
                att::diff_unit(s, h, qb, (bf16_t*)(ws + WS_QK), (const bf16_t*)(ws + WS_VM), lam, (char*)lds_raw);
            } else if ((P2M) & 4) {
                const int a = jb - 160 - 1536; int s, mh, qb;
                if (a < 256) { s = 0; mh = a / 64; qb = a % 64; } else { const int b = a - 256; s = 1 + b / 128; mh = (b % 128) / 32; qb = b % 32; }
                att::mem_unit(s, mh, qb, (bf16_t*)(ws + WS_VM), (const bf16_t*)(ws + WS_KVM), args.in[27], args.in[28], (char*)lds_raw);
            }
        }
    }
    SEAM(2);
    if (PROBE == 1) TSTAMP(tp1);
    if (IN(3)) p4_post(args, (char*)lds_raw, vcu, G);
    SEAM(3);
    if (IN(4)) {
        SchedMerge S{vcu, G, (const char*)(ws + WS_H), (const char*)(ws + WS_WG), (const char*)(ws + WS_QK), (const char*)(ws + WS_VM), (const char*)(ws + WS_PAR), (const char*)(ws + WS_PM2)};
        unsigned char* scr = (unsigned char*)args.out + (size_t)bx * (384 * 1024);
        EpiMerge E{(u32x4*)scr, (f32x4*)(scr + 128 * 1024), (bf16_t*)(ws + WS_MRG)};
        pg8::gemm_phase<EpiMerge, SchedMerge, true>(lds, 2048, S, E);
    }
    SEAM(4);
    if (IN(5)) {
        SchedSq S{vcu, G, (const char*)(ws + WS_MRG), (const char*)(ws + WS_WO), MiB, MiB, 32};
        EpiWo E{args.in[0], args.in[1], args.out};
        pg8::gemm_phase<EpiWo, SchedSq, true>(lds, 2048, S, E);
    }
    SEAM(5);
    if (IN(6)) {
        const int lane = tid & 63, gw = vcu * 8 + (tid >> 6), NGW = G * 8;
        for (int m = gw; m < NT; m += NGW) rms_row(args.out + (size_t)m * DM, args.in[33], (bf16_t*)(ws + WS_H) + (size_t)m * DM, lane);
    }
    SEAM(6);
    if (IN(7)) {
        SchedUp S{vcu, G, (const char*)(ws + WS_H), (const char*)(ws + WS_WUP)};
        EpiUp E{(bf16_t*)(ws + WS_ACT), args.in[35], args.in[36], (LAS float*)(lds + LDS_XCH)};
        pg8::gemm_phase<EpiUp, SchedUp, true>(lds, 2048, S, E);
    }
    SEAM(7);
    if (IN(8)) {
        SchedSq S{vcu, G, (const char*)(ws + WS_ACT), (const char*)(ws + WS_WDN), (size_t)256 * DFF * 2, (size_t)256 * DFF * 2, 88};
        EpiDown E{args.out};
        pg8::gemm_phase<EpiDown, SchedSq, true>(lds, DFF, S, E);
    }
    if (PROBE && bx == 0 && tid == 0) {
        if (PROBE == 2) tp1 = __hip_atomic_load((unsigned long long*)(ws + WS_CTL) + 128, __ATOMIC_RELAXED, __HIP_MEMORY_SCOPE_AGENT);
        const unsigned long long target = __builtin_amdgcn_s_memrealtime() + (tp1 > tp0 ? tp1 - tp0 : 0);
        while (__builtin_amdgcn_s_memrealtime() < target) __builtin_amdgcn_s_sleep(16);
    }
#undef IN
#undef SEAM
}

#ifndef MK_SPLIT
#define MK_SPLIT 0
#endif
extern "C" void kernel_launch(void* const* d_in, const int* in_sizes, int n_in, void* d_out, int out_size, void* d_ws, size_t ws_size, hipStream_t stream) {
    static int grid = 0;
    if (grid == 0) {
        if (n_in != 38 || out_size != NT * DM || ws_size < WS_END) { fprintf(stderr, "kernel_launch: unexpected shapes n_in %d out %d ws %zu\n", n_in, out_size, ws_size); grid = -1; return; }
        int dev = 0, cus = 0, per_cu = 0;
        hipGetDevice(&dev); hipDeviceGetAttribute(&cus, hipDeviceAttributeMultiprocessorCount, dev);
        if (hipFuncSetAttribute((const void*)enc_fwd, hipFuncAttributeMaxDynamicSharedMemorySize, LDS_BYTES) != hipSuccess) { fprintf(stderr, "kernel_launch: hipFuncSetAttribute failed\n"); grid = -1; return; }
        if (hipOccupancyMaxActiveBlocksPerMultiprocessor(&per_cu, (const void*)enc_fwd, NTHR, LDS_BYTES) != hipSuccess || per_cu < 1) { fprintf(stderr, "kernel_launch: occupancy query failed (%d)\n", per_cu); per_cu = 1; }
        (void)hipGetLastError();
        grid = cus * 1;
    }
    if (grid < 0) return;
    Args a{};
    for (int i = 0; i < 38; ++i) a.in[i] = (const float*)d_in[i];
    a.out = (float*)d_out; a.ws = (unsigned char*)d_ws;
    for (int d = 0; d < 32; ++d) a.inv_rev[d] = pow(10000.0, -(double)d / 32.0) / 6.283185307179586476925286766559;
#if MK_SPLIT
    for (int ph = 0; ph < 9; ++ph) { a.ph_lo = ph; a.ph_hi = ph + 1; void* kargs[] = {&a};
        hipError_t e = hipLaunchCooperativeKernel((const void*)enc_fwd, dim3(grid), dim3(NTHR), kargs, LDS_BYTES, stream);
        if (e != hipSuccess) { fprintf(stderr, "launch %d failed: %s\n", ph, hipGetErrorString(e)); break; } }
#else
    a.ph_lo = 0; a.ph_hi = 9;
    void* kargs[] = {&a};
    hipError_t e = hipLaunchCooperativeKernel((const void*)enc_fwd, dim3(grid), dim3(NTHR), kargs, LDS_BYTES, stream);
    if (e != hipSuccess) fprintf(stderr, "cooperative launch failed: %s (grid %d)\n", hipGetErrorString(e), grid);
#endif
}
```

```cpp
#include <hip/hip_runtime.h>
#include <hip/hip_cooperative_groups.h>
#include <cstdio>
#include <cstdint>
#include <cmath>
namespace cg = cooperative_groups;

#define LAS __attribute__((address_space(3)))
typedef unsigned short bf16_t;
typedef short bf16x8 __attribute__((ext_vector_type(8)));
typedef short s16x4 __attribute__((ext_vector_type(4)));
typedef float f32x2 __attribute__((ext_vector_type(2)));
typedef float f32x4 __attribute__((ext_vector_type(4)));
typedef float f32x16 __attribute__((ext_vector_type(16)));
typedef unsigned u32x2 __attribute__((ext_vector_type(2)));
typedef unsigned u32x4 __attribute__((ext_vector_type(4)));

constexpr int NT = 49152, DM = 2048, TP = 16384, TS = 8192, NSEQ = 5;
constexpr int ZRP = 3584;
constexpr int DFF = 5632;
constexpr int NTHR = 512;
constexpr size_t MiB = 1u << 20;
constexpr size_t WS_CTL = 0, WS_WIN = 1 * MiB, WS_WG = 31 * MiB, WS_WKV = 55 * MiB, WS_PAR = 63 * MiB, WS_PM2 = 71 * MiB, WS_WO = 79 * MiB,
                 WS_WUP = 87 * MiB, WS_WDN = 131 * MiB, WS_ROPE = 153 * MiB, WS_MEMN = 157 * MiB, WS_KVM = 162 * MiB, WS_BON = 167 * MiB,
                 WS_H = 176 * MiB, WS_QK = 370 * MiB, WS_VM = 562 * MiB, WS_Y = 754 * MiB, WS_ACT = 370 * MiB, WS_MRG = 754 * MiB, WS_END = 946 * MiB;
constexpr int CW_QUEUE = 64, CW_LAM = 128, CW_SMAX = 129;
constexpr int LDS_XCH = 131072, LDS_MISC = 131072 + 8192, LDS_BYTES = 131072 + 8192 + 256;

__device__ __forceinline__ int seq_start(int s) { return s == 0 ? 0 : TP + (s - 1) * TS; }
__device__ __forceinline__ int seq_len(int s) { return s == 0 ? TP : TS; }
__device__ __forceinline__ int tok_pos(int tok) { return tok < TP ? tok : ((tok - TP) & (TS - 1)); }

__device__ __forceinline__ unsigned cvt_pk_bf16(float lo, float hi) { unsigned r; asm volatile("v_cvt_pk_bf16_f32 %0, %1, %2" : "=v"(r) : "v"(lo), "v"(hi)); return r; }
__device__ __forceinline__ float bflo(unsigned w) { return __uint_as_float(w << 16); }
__device__ __forceinline__ float bfhi(unsigned w) { return __uint_as_float(w & 0xffff0000u); }
__device__ __forceinline__ float bf1(bf16_t b) { return __uint_as_float((unsigned)b << 16); }
__device__ __forceinline__ float sigmoidf_(float x) { return 1.f / (1.f + __expf(-x)); }
__device__ __forceinline__ float wave_sum(float v) {
#pragma unroll
    for (int o = 1; o < 64; o <<= 1) v += __shfl_xor(v, o);
    return v;
}

namespace pg8 {
constexpr int BM = 256, BK = 64, HALF = 128, HTB = HALF * BK * 2, STAGE_BYTES = 8 * HTB;
__host__ __device__ __forceinline__ int lds_byte(int r, int c) { const int st = (r >> 4) * 2 + (c >> 5), rr = r & 15, cc = c & 31, ob = rr * 64 + cc * 2; return st * 1024 + (ob ^ (((ob >> 9) & 1) << 5)); }
__host__ __device__ __forceinline__ void stage_rc(int b, int& R, int& C) { const int st = b / 1024, sb = b % 1024, swz = sb ^ (((sb >> 9) & 1) << 5); R = (st >> 1) * 16 + swz / 64; C = (st & 1) * 32 + (swz % 64) / 2; }
__host__ __device__ __forceinline__ int perm32(int rho) { const int n = rho >> 4, i = rho & 15; return 8 * (i >> 2) + 4 * n + (i & 3); }

struct Unit { const char* A; const char* B; int nt, pm, pn, kind, t0, T; };

template <class Epi, class Sched, bool ALIGN_EPI>
__device__ __forceinline__ void gemm_phase(LAS unsigned char* lds, const int ld, const Sched& S, const Epi& E) {
    const int tid = threadIdx.x, wid = __builtin_amdgcn_readfirstlane(tid >> 6), lane = tid & 63, wr = wid >> 2, wc = wid & 3, fr = lane & 15, fq = lane >> 4;
    unsigned voffA[2], voffB[2];
#pragma unroll
    for (int i = 0; i < 2; ++i) { int R, C; stage_rc(tid * 16 + i * 8192, R, C); const int Rb = (R & ~31) + perm32(R & 31);
        voffA[i] = (unsigned)(R * ld + C) * 2u; voffB[i] = (unsigned)(Rb * ld + C) * 2u; }
    const size_t kstep = (size_t)(BK * 2);
    const size_t hstep = (size_t)HALF * ld * 2;
    const unsigned ldsw = (unsigned)wid * 1024u;
    const int aoff = lds_byte(wr * 64 + fr, fq * 8), boff = lds_byte(wc * 32 + fr, fq * 8);
#define PG8_SA(b, h) (((b) * 2 + (h)) * HTB)
#define PG8_SB(b, h) ((4 + (b) * 2 + (h)) * HTB)
#define PG8_STAGE(bufoff, gbase, voff) do { _Pragma("unroll") for (int _i = 0; _i < 2; ++_i) \
        __builtin_amdgcn_global_load_lds((const unsigned*)((const char*)(gbase) + (voff)[_i]), (LAS unsigned*)(lds + (bufoff) + ldsw + _i * 8192), 16, 0, 0); } while (0)
#define PG8_LDA(dst, b, h) do { _Pragma("unroll") for (int m = 0; m < 4; ++m) _Pragma("unroll") for (int k = 0; k < 2; ++k) dst[m][k] = *(const LAS bf16x8*)(lds + PG8_SA(b, h) + aoff + m * 2048 + k * 1024); } while (0)
#define PG8_LDB(dst, b, h) do { _Pragma("unroll") for (int n = 0; n < 2; ++n) _Pragma("unroll") for (int k = 0; k < 2; ++k) dst[n][k] = *(const LAS bf16x8*)(lds + PG8_SB(b, h) + boff + n * 2048 + k * 1024); } while (0)
#define PG8_MMA(ai, bj, At, Bt) do { __builtin_amdgcn_s_setprio(1); _Pragma("unroll") for (int m = 0; m < 4; ++m) _Pragma("unroll") for (int n = 0; n < 2; ++n) _Pragma("unroll") for (int k = 0; k < 2; ++k) \
        acc[ai][bj][m][n] = __builtin_amdgcn_mfma_f32_16x16x32_bf16(Bt[n][k], At[m][k], acc[ai][bj][m][n], 0, 0, 0); __builtin_amdgcn_s_setprio(0); } while (0)
#define PG8_WAIT_V(n) asm volatile("s_waitcnt vmcnt(" #n ")" ::: "memory")
#define PG8_WAIT_L(n) asm volatile("s_waitcnt lgkmcnt(" #n ")" ::: "memory")
#define PG8_BAR __builtin_amdgcn_s_barrier()
#define PG8_SCHED __builtin_amdgcn_sched_barrier(0)
    Unit cur, nxt; int ui = 0;
    if (!S.next(0, cur)) return;
    f32x4 acc[2][2][4][2];
#pragma unroll
    for (int a = 0; a < 2; ++a)
#pragma unroll
        for (int b = 0; b < 2; ++b)
#pragma unroll
            for (int m = 0; m < 4; ++m)
#pragma unroll
                for (int n = 0; n < 2; ++n) acc[a][b][m][n] = (f32x4){0.f, 0.f, 0.f, 0.f};
    bf16x8 At[4][2], B0[2][2], B1[2][2];
    const char* cA = cur.A; const char* cB = cur.B;
    PG8_STAGE(PG8_SB(0, 0), cB, voffB); PG8_STAGE(PG8_SB(0, 1), cB + hstep, voffB); PG8_STAGE(PG8_SA(0, 0), cA, voffA); PG8_STAGE(PG8_SA(0, 1), cA + hstep, voffA);
    if (wr == 1) PG8_BAR;
    PG8_WAIT_V(2); PG8_BAR;
    PG8_STAGE(PG8_SB(1, 0), cB + kstep, voffB); PG8_STAGE(PG8_SA(1, 0), cA + kstep, voffA); PG8_STAGE(PG8_SB(1, 1), cB + hstep + kstep, voffB);
    PG8_WAIT_V(6); PG8_BAR;
    for (;;) {
        const bool has_next = S.next(ui + 1, nxt);
        const char* nA = has_next ? nxt.A : cA; const char* nB = has_next ? nxt.B : cB;
        const int nt = cur.nt;
        for (int t = 0; t < nt; t += 2) {
            const bool last = (t == nt - 2);
            const char* a1 = cA + (size_t)(t + 1) * kstep;
            const char* a2 = last ? nA : cA + (size_t)(t + 2) * kstep; const char* b2 = last ? nB : cB + (size_t)(t + 2) * kstep;
            const char* a3 = a2 + kstep; const char* b3 = b2 + kstep;
            PG8_LDB(B0, 0, 0); PG8_LDB(B1, 0, 1); PG8_SCHED; PG8_LDA(At, 0, 0); PG8_STAGE(PG8_SA(1, 1), a1 + hstep, voffA);
            PG8_WAIT_V(8); PG8_WAIT_L(0); PG8_BAR; PG8_MMA(0, 0, At, B0); PG8_MMA(0, 1, At, B1); PG8_BAR; PG8_SCHED;
            PG8_LDA(At, 0, 1); PG8_STAGE(PG8_SB(0, 0), b2, voffB); PG8_STAGE(PG8_SB(0, 1), b2 + hstep, voffB); PG8_STAGE(PG8_SA(0, 0), a2, voffA);
            PG8_WAIT_V(8); PG8_WAIT_L(0); PG8_BAR; PG8_MMA(1, 0, At, B0); PG8_MMA(1, 1, At, B1); PG8_BAR; PG8_SCHED;
            PG8_LDB(B0, 1, 0); PG8_LDB(B1, 1, 1); PG8_SCHED; PG8_LDA(At, 1, 0); PG8_STAGE(PG8_SA(0, 1), a2 + hstep, voffA);
            PG8_WAIT_V(8); PG8_WAIT_L(0); PG8_BAR; PG8_MMA(0, 0, At, B0); PG8_MMA(0, 1, At, B1); PG8_BAR; PG8_SCHED;
            PG8_LDA(At, 1, 1); PG8_STAGE(PG8_SB(1, 0), b3, voffB); PG8_STAGE(PG8_SB(1, 1), b3 + hstep, voffB); PG8_STAGE(PG8_SA(1, 0), a3, voffA);
            PG8_WAIT_V(8); PG8_WAIT_L(0); PG8_BAR; PG8_MMA(1, 0, At, B0); PG8_MMA(1, 1, At, B1); PG8_BAR; PG8_SCHED;
        }
        if constexpr (ALIGN_EPI) { if (wr == 0) PG8_BAR; }
        E(acc, cur, wr, wc, fr, fq);
        if (!has_next) break;
#pragma unroll
        for (int a = 0; a < 2; ++a)
#pragma unroll
            for (int b = 0; b < 2; ++b)
#pragma unroll
                for (int m = 0; m < 4; ++m)
#pragma unroll
                    for (int n = 0; n < 2; ++n) acc[a][b][m][n] = (f32x4){0.f, 0.f, 0.f, 0.f};
        cur = nxt; cA = nA; cB = nB; ++ui;
        if constexpr (ALIGN_EPI) { if (wr == 1) PG8_BAR; }
    }
    PG8_WAIT_V(0);
    if constexpr (!ALIGN_EPI) { if (wr == 0) PG8_BAR; }
    PG8_BAR;
#undef PG8_SA
#undef PG8_SB
#undef PG8_STAGE
#undef PG8_LDA
#undef PG8_LDB
#undef PG8_MMA
#undef PG8_WAIT_V
#undef PG8_WAIT_L
#undef PG8_BAR
#undef PG8_SCHED
}
}
using pg8::Unit;

struct TileMap {
    int nM, nN;
    __device__ __forceinline__ bool get(long L, int& pm, int& pn) const {
        if (L >= (long)nM * nN) return false;
        const int nig = 8 * nN, gid = (int)(L / nig), fm = gid * 8, gsz = (nM - fm) < 8 ? (nM - fm) : 8, r = (int)(L % nig);
        pm = fm + r % gsz; pn = r / gsz; return true;
    }
};

struct Args {
    const float* in[38];
    float* out; unsigned char* ws;
    double inv_rev[32];
    int ph_lo, ph_hi;
};

__device__ __forceinline__ void tr_item(const float* W, int N, int src_n0, bf16_t* WT, size_t ldw, int koff, int r0, int k0, LAS float* scr, int lane) {
    if (src_n0 >= 0) {
#pragma unroll 8
        for (int i = 0; i < 32; ++i) { const int kk = 2 * i + (lane >> 5); scr[kk * 33 + (lane & 31)] = W[(size_t)(k0 + kk) * N + src_n0 + (lane & 31)]; }
    } else {
#pragma unroll 8
        for (int i = 0; i < 32; ++i) { const int kk = 2 * i + (lane >> 5); scr[kk * 33 + (lane & 31)] = 0.f; }
    }
    asm volatile("s_waitcnt lgkmcnt(0)" ::: "memory");
    const int c = lane & 7;
#pragma unroll
    for (int j = 0; j < 4; ++j) { const int n = (lane >> 3) + 8 * j; const LAS float* s = scr + (8 * c) * 33 + n;
        u32x4 o; o.x = cvt_pk_bf16(s[0 * 33], s[1 * 33]); o.y = cvt_pk_bf16(s[2 * 33], s[3 * 33]); o.z = cvt_pk_bf16(s[4 * 33], s[5 * 33]); o.w = cvt_pk_bf16(s[6 * 33], s[7 * 33]);
        *(u32x4*)(WT + (size_t)(r0 + n) * ldw + koff + k0 + 8 * c) = o; }
    asm volatile("s_waitcnt lgkmcnt(0)" ::: "memory");
}
__device__ __forceinline__ void rms_row(const float* xrow, const float* g, bf16_t* orow, int lane) {
    f32x4 v[8]; float s = 0.f;
#pragma unroll
    for (int j = 0; j < 8; ++j) { v[j] = ((const f32x4*)xrow)[64 * j + lane]; s += (v[j].x * v[j].x + v[j].y * v[j].y) + (v[j].z * v[j].z + v[j].w * v[j].w); }
    const float rstd = rsqrtf(wave_sum(s) * (1.f / DM) + 1e-6f);
#pragma unroll
    for (int j = 0; j < 8; ++j) { const f32x4 gg = ((const f32x4*)g)[64 * j + lane];
        u32x2 w; w.x = cvt_pk_bf16(v[j].x * rstd * gg.x, v[j].y * rstd * gg.y); w.y = cvt_pk_bf16(v[j].z * rstd * gg.z, v[j].w * rstd * gg.w);
        ((u32x2*)orow)[64 * j + lane] = w; }
}

__device__ __forceinline__ void p0_prologue(const Args& a, LAS unsigned char* lds, int vcu, int G) {
    const int tid = threadIdx.x, lane = tid & 63, wave = tid >> 6;
    unsigned char* ws = a.ws;
    LAS float* scr = (LAS float*)(lds + wave * 16384);
    const int gw = vcu * 8 + wave, NGW = G * 8;
    constexpr int I0 = 32 * 240, I1 = 32 * 192, I2 = 32 * 64, I3 = 16 * 64, I6 = 32 * 64, I7 = 32 * 352, I8 = 88 * 64;
    constexpr int NITEMS = I0 + I1 + I2 + 3 * I3 + I6 + I7 + I8;
    for (int it = gw; it < NITEMS; it += NGW) {
        int r = it;
        if (r < I0) { const int kb = r / 240, nb = r % 240, r0 = nb * 32; int src;
            if (r0 < 2048) { const int tile = r0 >> 8, cp = r0 & 255, h = cp >> 7, g = (cp & 127) >> 5; src = tile * 256 + 64 * g + 32 * h; }
            else if (r0 < 6560) src = r0;
            else if (r0 < 6656) src = -1;
            else src = 6560 + (r0 - 6656);
            tr_item(a.in[5], 13728, src, (bf16_t*)(ws + WS_WIN), 2048, 0, r0, kb * 64, scr, lane); continue; } r -= I0;
        if (r < I1) { const int kb = r / 192, nb = r % 192; tr_item(a.in[5], 13728, 7584 + nb * 32, (bf16_t*)(ws + WS_WG), 2048, 0, nb * 32, kb * 64, scr, lane); continue; } r -= I1;
        if (r < I2) { const int kb = r / 64, nb = r % 64; tr_item(a.in[26], 2048, nb * 32, (bf16_t*)(ws + WS_WKV), 2048, 0, nb * 32, kb * 64, scr, lane); continue; } r -= I2;
        if (r < I3) { const int kb = r / 64, nb = r % 64; tr_item(a.in[29], 2048, nb * 32, (bf16_t*)(ws + WS_PAR), 2048, 0, nb * 32, kb * 64, scr, lane); continue; } r -= I3;
        if (r < I3) { const int kb = r / 64, nb = r % 64; tr_item(a.in[30], 2048, nb * 32, (bf16_t*)(ws + WS_PAR), 2048, 1024, nb * 32, kb * 64, scr, lane); continue; } r -= I3;
        if (r < I3) { const int kb = r / 64, nb = r % 64; tr_item(a.in[31], 2048, nb * 32, (bf16_t*)(ws + WS_PM2), 2048, 0, nb * 32, kb * 64, scr, lane); continue; } r -= I3;
        if (r < I6) { const int kb = r / 64, nb = r % 64; tr_item(a.in[32], 2048, nb * 32, (bf16_t*)(ws + WS_WO), 2048, 0, nb * 32, kb * 64, scr, lane); continue; } r -= I6;
        if (r < I7) { const int kb = r / 352, nb = r % 352, r0 = nb * 32, tile = r0 >> 8, bj = (r0 & 255) >> 7, j = r0 & 127;
            tr_item(a.in[34], 2 * DFF, bj * DFF + 128 * tile + j, (bf16_t*)(ws + WS_WUP), 2048, 0, r0, kb * 64, scr, lane); continue; } r -= I7;
        { const int kb = r / 64, nb = r % 64; tr_item(a.in[37], 2048, nb * 32, (bf16_t*)(ws + WS_WDN), DFF, 0, nb * 32, kb * 64, scr, lane); }
    }
    for (int m = gw; m < NT + 1280; m += NGW) {
        if (m < NT) { const float* xr = m < TP ? a.in[0] + (size_t)m * DM : a.in[1] + (size_t)(m - TP) * DM; rms_row(xr, a.in[4], (bf16_t*)(ws + WS_H) + (size_t)m * DM, lane); }
        else { const int j = m - NT; const float* xr = j < 256 ? a.in[2] + (size_t)j * DM : a.in[3] + (size_t)(j - 256) * DM; rms_row(xr, a.in[25], (bf16_t*)(ws + WS_MEMN) + (size_t)j * DM, lane); }
    }
    { float* rc = (float*)(ws + WS_ROPE); float* rs = rc + TP * 32;
      for (int e = (vcu * NTHR + tid); e < TP * 32; e += G * NTHR) { const int t = e >> 5, d = e & 31; double rev = (double)t * a.inv_rev[d]; rev -= rint(rev); const float rf = (float)rev;
          rc[e] = __builtin_amdgcn_cosf(rf); rs[e] = __builtin_amdgcn_sinf(rf); } }
    if (blockIdx.x == 0) {
        unsigned* ctl = (unsigned*)(ws + WS_CTL);
        if (tid < 64) {
            if (tid == 0) { ctl[CW_QUEUE] = 0u; ctl[256] = 0u; ctl[257] = 0u; }
            const float s1 = wave_sum(a.in[8][tid] * a.in[9][tid]), s2 = wave_sum(a.in[10][tid] * a.in[11][tid]);
            if (tid == 0) ((float*)ctl)[CW_LAM] = __expf(s1) - __expf(s2) + 0.2f;
            float gq = fabsf(a.in[6][tid]), gk = fabsf(a.in[7][tid]);
#pragma unroll
            for (int o = 1; o < 64; o <<= 1) { gq = fmaxf(gq, __shfl_xor(gq, o)); gk = fmaxf(gk, __shfl_xor(gk, o)); }
            if (tid == 0) ((float*)ctl)[CW_SMAX] = 64.f * 0.125f * 1.4426950408889634f * gq * gk;
        }
    }
}

struct SchedIn {
    int v, G; const char* H; const char* WIN; const char* MEMN; const char* WKV;
    __device__ __forceinline__ bool next(int i, Unit& u) const {
        long L = (long)i * G + v; int pm, pn;
        if (L < 5760) { TileMap{192, 30}.get(L, pm, pn); u.A = H + (size_t)pm * MiB; u.B = WIN + (size_t)pn * MiB; u.nt = 32; u.pm = pm; u.pn = pn; u.kind = 0; u.t0 = 0; u.T = 0; return true; }
        L -= 5760; if (L < 40) { pm = (int)(L % 5); pn = (int)(L / 5); u.A = MEMN + (size_t)pm * MiB; u.B = WKV + (size_t)pn * MiB; u.nt = 32; u.pm = pm; u.pn = pn; u.kind = 1; u.t0 = 0; u.T = 0; return true; }
        return false;
    }
};
struct EpiIn {
    bf16_t* QK; bf16_t* VM; bf16_t* ZR; bf16_t* KVM; const float* qn; const float* kn; const float* rc; const float* rs;
    __device__ __forceinline__ void plain(const f32x4 (&acc)[2][2][4][2], bf16_t* base, size_t ldc, int row0, int col0) const {
#pragma unroll
        for (int ai = 0; ai < 2; ++ai)
#pragma unroll
            for (int m = 0; m < 4; ++m) { bf16_t* rowp = base + (size_t)(row0 + ai * 128 + m * 16) * ldc + col0;
#pragma unroll
                for (int bj = 0; bj < 2; ++bj) { const f32x4 v0 = acc[ai][bj][m][0], v1 = acc[ai][bj][m][1];
                    u32x4 w; w.x = cvt_pk_bf16(v0[0], v0[1]); w.y = cvt_pk_bf16(v0[2], v0[3]); w.z = cvt_pk_bf16(v1[0], v1[1]); w.w = cvt_pk_bf16(v1[2], v1[3]);
                    *(u32x4*)(rowp + bj * 128) = w; } }
    }
    __device__ __forceinline__ void operator()(const f32x4 (&acc)[2][2][4][2], const Unit& u, int wr, int wc, int fr, int fq) const {
        const int row0 = u.pm * 256 + wr * 64 + fr, cin = wc * 32 + 8 * fq;
        if (u.kind == 1) { plain(acc, KVM, 2048, row0, u.pn * 256 + cin); return; }
        const int pn = u.pn;
        if (pn < 8) {
            const bool isq = pn < 4; const float* nw = isq ? qn : kn;
            const int Gq = (pn & 3) * 4 + wc, d0 = 8 * fq;
            const float qs = isq ? 0.125f * 1.4426950408889634f : 1.f;
            const f32x4 w1a = *(const f32x4*)(nw + d0), w1b = *(const f32x4*)(nw + d0 + 4), w2a = *(const f32x4*)(nw + 32 + d0), w2b = *(const f32x4*)(nw + 36 + d0);
            bf16_t* dst = QK + (isq ? 0 : 1024) + Gq * 64 + d0;
#pragma unroll
            for (int ai = 0; ai < 2; ++ai)
#pragma unroll
                for (int m = 0; m < 4; ++m) {
                    const int row = row0 + ai * 128 + m * 16, t = tok_pos(row);
                    const f32x4 xa = acc[ai][0][m][0], xb = acc[ai][0][m][1], ya = acc[ai][1][m][0], yb = acc[ai][1][m][1];
                    float ss = (xa[0] * xa[0] + xa[1] * xa[1]) + (xa[2] * xa[2] + xa[3] * xa[3]) + (xb[0] * xb[0] + xb[1] * xb[1]) + (xb[2] * xb[2] + xb[3] * xb[3])
                             + (ya[0] * ya[0] + ya[1] * ya[1]) + (ya[2] * ya[2] + ya[3] * ya[3]) + (yb[0] * yb[0] + yb[1] * yb[1]) + (yb[2] * yb[2] + yb[3] * yb[3]);
                    ss += __shfl_xor(ss, 16); ss += __shfl_xor(ss, 32);
                    const float rstd = rsqrtf(ss * (1.f / 64.f) + 1e-6f);
                    const f32x4 ca = *(const f32x4*)(rc + t * 32 + d0), cb = *(const f32x4*)(rc + t * 32 + d0 + 4), sa = *(const f32x4*)(rs + t * 32 + d0), sb = *(const f32x4*)(rs + t * 32 + d0 + 4);
                    const f32x4 x1a = xa * rstd * w1a, x1b = xb * rstd * w1b, x2a = ya * rstd * w2a, x2b = yb * rstd * w2b;
                    const f32x4 o1a = (x1a * ca - x2a * sa) * qs, o1b = (x1b * cb - x2b * sb) * qs, o2a = (x2a * ca + x1a * sa) * qs, o2b = (x2b * cb + x1b * sb) * qs;
                    u32x4 w; w.x = cvt_pk_bf16(o1a[0], o1a[1]); w.y = cvt_pk_bf16(o1a[2], o1a[3]); w.z = cvt_pk_bf16(o1b[0], o1b[1]); w.w = cvt_pk_bf16(o1b[2], o1b[3]);
                    *(u32x4*)(dst + (size_t)row * 2048) = w;
                    w.x = cvt_pk_bf16(o2a[0], o2a[1]); w.y = cvt_pk_bf16(o2a[2], o2a[3]); w.z = cvt_pk_bf16(o2b[0], o2b[1]); w.w = cvt_pk_bf16(o2b[2], o2b[3]);
                    *(u32x4*)(dst + (size_t)row * 2048 + 32) = w;
                }
        } else if (pn < 12) plain(acc, VM, 2048, row0, (pn - 8) * 256 + cin);
        else if (pn < 26) plain(acc, ZR, ZRP, row0, (pn - 12) * 256 + cin);
        else plain(acc, VM, 2048, row0, 1024 + (pn - 26) * 256 + cin);
    }
};

namespace att {
constexpr int SHM_V = 16384, SHM_K = 8192;
constexpr int OFF_V = 0, OFF_K = 32768, OFF_WS = 49152, OFF_STASH = 51200;
#define KSWZ64(row, colB) ((row) * 128 + ((colB) ^ (((row) & 7) << 4)))
#define SBAR() __builtin_amdgcn_sched_barrier(0)
__device__ __forceinline__ int crow(int r, int hi) { return (r & 3) + 8 * (r >> 2) + 4 * hi; }
constexpr float THRL = 8.f;
__device__ __forceinline__ void partialSM(f32x16& p0, f32x16& p1, float& m_reg, float& alpha) {
    float pmax = fmaxf(fmaxf(p0[0], p0[1]), p0[2]);
#pragma unroll
    for (int r = 3; r < 15; r += 2) pmax = fmaxf(fmaxf(pmax, p0[r]), p0[r + 1]);
    pmax = fmaxf(fmaxf(pmax, p0[15]), p1[0]);
#pragma unroll
    for (int r = 1; r < 15; r += 2) pmax = fmaxf(fmaxf(pmax, p1[r]), p1[r + 1]);
    pmax = fmaxf(pmax, p1[15]);
    { auto rr = __builtin_amdgcn_permlane32_swap(__float_as_uint(pmax), __float_as_uint(pmax), false, false);
      pmax = fmaxf(__uint_as_float(rr[0]), __uint_as_float(rr[1])); }
    if (__builtin_expect(__all(pmax <= THRL), 1)) { alpha = 1.f; }
    else { const float dl = fmaxf(pmax, 0.f); alpha = __builtin_amdgcn_exp2f(-dl); m_reg += dl;
#pragma unroll
        for (int r = 0; r < 16; ++r) { p0[r] -= dl; p1[r] -= dl; } }
#pragma unroll
    for (int r = 0; r < 16; ++r) p0[r] = __builtin_amdgcn_exp2f(p0[r]);
}
__device__ __forceinline__ void finishSM(f32x16& p0, f32x16& p1, float alpha, float& l_reg, bf16x8& pa0, bf16x8& pa1, bf16x8& pa2, bf16x8& pa3) {
#pragma unroll
    for (int r = 0; r < 16; ++r) p1[r] = __builtin_amdgcn_exp2f(p1[r]);
    f32x2 s2 = (f32x2){p0[0], p0[1]} + (f32x2){p1[0], p1[1]};
#pragma unroll
    for (int r = 2; r < 16; r += 2) { s2 = s2 + (f32x2){p0[r], p0[r + 1]}; s2 = s2 + (f32x2){p1[r], p1[r + 1]}; }
    float ps = s2[0] + s2[1];
    { auto rr = __builtin_amdgcn_permlane32_swap(__float_as_uint(ps), __float_as_uint(ps), false, false);
      ps = __uint_as_float(rr[0]) + __uint_as_float(rr[1]); }
    l_reg = l_reg * alpha + ps;
#define PK4(P, BASE, OUT) do { unsigned a0 = cvt_pk_bf16(P[BASE + 0], P[BASE + 1]), a1 = cvt_pk_bf16(P[BASE + 2], P[BASE + 3]);   \
    unsigned b0 = cvt_pk_bf16(P[BASE + 4], P[BASE + 5]), b1 = cvt_pk_bf16(P[BASE + 6], P[BASE + 7]);                              \
    auto r0 = __builtin_amdgcn_permlane32_swap(a0, b0, false, false); auto r1 = __builtin_amdgcn_permlane32_swap(a1, b1, false, false); \
    u32x4 w = {r0[0], r1[0], r0[1], r1[1]}; OUT = *reinterpret_cast<bf16x8*>(&w); } while (0)
    PK4(p0, 0, pa0); PK4(p0, 8, pa1); PK4(p1, 0, pa2); PK4(p1, 8, pa3);
#undef PK4
}
__device__ __forceinline__ void qkt64(f32x16& p0, f32x16& p1, const char* Ks, const bf16x8* qr, int r32, int hi) {
#pragma unroll
    for (int d0 = 0; d0 < 4; ++d0) { const int cb = (d0 * 16 + hi * 8) * 2;
        const bf16x8 b0 = *reinterpret_cast<const bf16x8*>(Ks + KSWZ64(r32, cb));
        const bf16x8 b1 = *reinterpret_cast<const bf16x8*>(Ks + KSWZ64(32 + r32, cb));
        p0 = __builtin_amdgcn_mfma_f32_32x32x16_bf16(b0, qr[d0], p0, 0, 0, 0);
        p1 = __builtin_amdgcn_mfma_f32_32x32x16_bf16(b1, qr[d0], p1, 0, 0, 0); }
}
__device__ __forceinline__ int v_st(int k, int c) { const int kk = (k & ~0xC) | ((k & 4) << 1) | ((k & 8) >> 1); return ((kk >> 3) * 4 + (c >> 5)) * 512 + ((kk & 7) * 32 + (c & 31)) * 2; }
__device__ __forceinline__ int v_rd_base(int lane) { return ((lane & 3) << 3) | (((lane >> 2) & 3) << 6) | (((lane >> 4) & 1) << 5) | (((lane >> 5) & 1) << 8); }
constexpr int v_rd_off(int d0, int ks, int half) { return d0 * 512 + ks * 4096 + half * 2048; }
template <int OFF> __device__ __forceinline__ s16x4 tr_read(int vb) {
    s16x4 r; asm volatile("ds_read_b64_tr_b16 %0, %1 offset:%2" : "=&v"(r) : "v"(vb), "i"(OFF) : "memory"); return r;
}
template <int KS> __device__ __forceinline__ void pv_ks(f32x16* o, int vb, bf16x8 pa) {
    const s16x4 l0 = tr_read<v_rd_off(0, KS, 0)>(vb), h0 = tr_read<v_rd_off(0, KS, 1)>(vb), l1 = tr_read<v_rd_off(1, KS, 0)>(vb), h1 = tr_read<v_rd_off(1, KS, 1)>(vb);
    const s16x4 l2 = tr_read<v_rd_off(2, KS, 0)>(vb), h2 = tr_read<v_rd_off(2, KS, 1)>(vb), l3 = tr_read<v_rd_off(3, KS, 0)>(vb), h3 = tr_read<v_rd_off(3, KS, 1)>(vb);
    asm volatile("s_waitcnt lgkmcnt(0)" ::: "memory"); SBAR();
#define PK(L, H) (bf16x8){L[0], L[1], L[2], L[3], H[0], H[1], H[2], H[3]}
    o[0] = __builtin_amdgcn_mfma_f32_32x32x16_bf16(pa, PK(l0, h0), o[0], 0, 0, 0);
    o[1] = __builtin_amdgcn_mfma_f32_32x32x16_bf16(pa, PK(l1, h1), o[1], 0, 0, 0);
    o[2] = __builtin_amdgcn_mfma_f32_32x32x16_bf16(pa, PK(l2, h2), o[2], 0, 0, 0);
    o[3] = __builtin_amdgcn_mfma_f32_32x32x16_bf16(pa, PK(l3, h3), o[3], 0, 0, 0);
#undef PK
}
__device__ __forceinline__ void pv_d0(f32x16* o, int vb, bf16x8 pa0, bf16x8 pa1, bf16x8 pa2, bf16x8 pa3) {
    pv_ks<0>(o, vb, pa0); pv_ks<1>(o, vb, pa1); pv_ks<2>(o, vb, pa2); pv_ks<3>(o, vb, pa3);
}

__device__ __forceinline__ void stash_store(const unsigned* stash, bf16_t* Ow, int ldo, int lane) {
#pragma unroll
    for (int i = 0; i < 8; ++i) { const int q = i * 64 + lane, rl = q >> 4, c8 = (q & 15) * 8, hh = (rl >> 2) & 1, r = (rl & 3) + 4 * (rl >> 3), d0 = c8 >> 5, cc = c8 & 31;
        const unsigned* sp = stash + (d0 * 8 + (r >> 1)) * 64 + hh * 32 + cc; const u32x4 a = *(const u32x4*)sp, b = *(const u32x4*)(sp + 4);
        u32x4 w;
        if (r & 1) { w.x = (a.x >> 16) | (a.y & 0xffff0000u); w.y = (a.z >> 16) | (a.w & 0xffff0000u); w.z = (b.x >> 16) | (b.y & 0xffff0000u); w.w = (b.z >> 16) | (b.w & 0xffff0000u); }
        else { w.x = (a.x & 0xffffu) | (a.y << 16); w.y = (a.z & 0xffffu) | (a.w << 16); w.z = (b.x & 0xffffu) | (b.y << 16); w.w = (b.z & 0xffffu) | (b.w << 16); }
        *(u32x4*)(Ow + (size_t)rl * ldo + c8) = w; }
}

template <bool FX> __device__ __forceinline__ void diff_unit(int s, int h, int qb, bf16_t* QK, const bf16_t* VM, float lam, char* lds) {
    constexpr int LDK = 2048;
    int tid = threadIdx.x; asm volatile("" : "+v"(tid));
    const int wid = __builtin_amdgcn_readfirstlane(tid >> 6), lane = tid & 63, r32 = lane & 31, hi = lane >> 5;
    const int tok0 = seq_start(s), T = seq_len(s), NTL = T / 64;
    char* V_lds = lds + OFF_V; char* K_lds = lds + OFF_K;
    float* wsf = (float*)(lds + OFF_WS) + wid * 64; float* li_l = wsf; float* al_l = wsf + 32;
    unsigned* stash = (unsigned*)(lds + OFF_STASH) + wid * 2048;
    const int sr = tid >> 4, sc = (tid & 15) * 8, vst0 = v_st(sr, sc), vst1 = v_st(32 + sr, sc);
    const int kr = tid >> 3, kc = (tid & 7) * 8, kst = KSWZ64(kr, kc * 2);
    const int vb0 = (int)(uintptr_t)V_lds + v_rd_base(lane);
    const bf16_t* Vh = VM + (size_t)tok0 * LDK + h * 128;
    const size_t qrow = (size_t)(tok0 + qb * 256 + wid * 32);
#pragma unroll 1
    for (int c = 0; c < 2; ++c) {
        const bf16_t* Kh = QK + (size_t)tok0 * LDK + 1024 + h * 128 + c * 64;
        const bf16_t* Qw = QK + (qrow + r32) * LDK + h * 128 + c * 64 + hi * 8;
        bf16x8 qr[4];
#pragma unroll
        for (int d0 = 0; d0 < 4; ++d0) qr[d0] = *reinterpret_cast<const bf16x8*>(Qw + d0 * 16);
        float m_reg = 0.f, l_reg = 0; f32x16 o[4] = {};
        struct { bf16x8 vs0, vs1, ks0; } sr_[2];
#define NEGM(P) do { const float nm_ = FX ? 0.f : -m_reg; _Pragma("unroll") for (int r_ = 0; r_ < 16; ++r_) P[r_] = nm_; } while (0)
#define PSM(P0, P1, AL) do { if constexpr (FX) { AL = 1.f; _Pragma("unroll") for (int r_ = 0; r_ < 16; ++r_) P0[r_] = __builtin_amdgcn_exp2f(P0[r_]); } else partialSM(P0, P1, m_reg, AL); } while (0)
#define SLOAD(i, k0) do { sr_[i].vs0 = *reinterpret_cast<const bf16x8*>(&Vh[(size_t)((k0) + sr) * LDK + sc]); sr_[i].vs1 = *reinterpret_cast<const bf16x8*>(&Vh[(size_t)((k0) + 32 + sr) * LDK + sc]); \
    sr_[i].ks0 = *reinterpret_cast<const bf16x8*>(&Kh[(size_t)((k0) + kr) * LDK + kc]); } while (0)
#define SWRITE(b, i) do { *(bf16x8*)(V_lds + (b) * SHM_V + vst0) = sr_[i].vs0; *(bf16x8*)(V_lds + (b) * SHM_V + vst1) = sr_[i].vs1; *(bf16x8*)(K_lds + (b) * SHM_K + kst) = sr_[i].ks0; } while (0)
#define SWAIT() asm volatile("s_waitcnt vmcnt(3)" ::: "memory")
#define RESC(a) do { if (!FX && __any((a) < 1.f)) { if (hi == 0) al_l[r32] = (a); asm volatile("s_waitcnt lgkmcnt(0)" ::: "memory"); \
    _Pragma("unroll") for (int d = 0; d < 4; ++d) _Pragma("unroll") for (int r = 0; r < 16; ++r) o[d][r] *= al_l[crow(r, hi)]; } } while (0)
        f32x16 pA0, pA1, pB0, pB1; float alA, alB; bf16x8 pa0, pa1, pa2, pa3;
        SLOAD(0, 0); asm volatile("s_waitcnt vmcnt(0)" ::: "memory"); SWRITE(0, 0); __syncthreads();
        NEGM(pA0); NEGM(pA1); qkt64(pA0, pA1, K_lds, qr, r32, hi); PSM(pA0, pA1, alA);
        SLOAD(1, 64); if (2 < NTL) SLOAD(0, 128);
        SWAIT(); SWRITE(1, 1); __syncthreads();
        for (int j = 1; j + 1 < NTL; j += 2) {
            SBAR(); NEGM(pB0); NEGM(pB1); qkt64(pB0, pB1, K_lds + SHM_K, qr, r32, hi);
            finishSM(pA0, pA1, alA, l_reg, pa0, pa1, pa2, pa3); SBAR();
            SLOAD(1, (j + 2) * 64); SBAR();
            pv_d0(o, vb0, pa0, pa1, pa2, pa3); PSM(pB0, pB1, alB);
            __syncthreads(); SWAIT(); SWRITE(0, 0);
            RESC(alB); __syncthreads();
            SBAR(); NEGM(pA0); NEGM(pA1); qkt64(pA0, pA1, K_lds, qr, r32, hi);
            finishSM(pB0, pB1, alB, l_reg, pa0, pa1, pa2, pa3); SBAR();
            if (j + 3 < NTL) SLOAD(0, (j + 3) * 64); SBAR();
            pv_d0(o, vb0 + SHM_V, pa0, pa1, pa2, pa3); PSM(pA0, pA1, alA);
            __syncthreads(); SWAIT(); SWRITE(1, 1);
            RESC(alA); __syncthreads();
        }
        SBAR(); NEGM(pB0); NEGM(pB1); qkt64(pB0, pB1, K_lds + SHM_K, qr, r32, hi);
        finishSM(pA0, pA1, alA, l_reg, pa0, pa1, pa2, pa3); SBAR();
        pv_d0(o, vb0, pa0, pa1, pa2, pa3); PSM(pB0, pB1, alB);
        __syncthreads(); RESC(alB);
        finishSM(pB0, pB1, alB, l_reg, pa0, pa1, pa2, pa3); SBAR();
        pv_d0(o, vb0 + SHM_V, pa0, pa1, pa2, pa3);
#undef SLOAD
#undef SWRITE
#undef SWAIT
#undef RESC
#undef NEGM
#undef PSM
        if (hi == 0) li_l[r32] = l_reg; asm volatile("s_waitcnt lgkmcnt(0)" ::: "memory");
        float rli[16];
#pragma unroll
        for (int r = 0; r < 16; ++r) rli[r] = __builtin_amdgcn_rcpf(li_l[crow(r, hi)]);
        { const float coef = c == 0 ? 1.f : -lam;
#pragma unroll
          for (int d0 = 0; d0 < 4; ++d0)
#pragma unroll
              for (int r = 0; r < 16; r += 2) { const int idx = (d0 * 8 + (r >> 1)) * 64 + lane; const unsigned w = c == 0 ? 0u : stash[idx];
                  stash[idx] = cvt_pk_bf16(bflo(w) + coef * o[d0][r] * rli[r], bfhi(w) + coef * o[d0][r + 1] * rli[r + 1]); } }
        __syncthreads();
    }
    stash_store(stash, QK + qrow * LDK + h * 128, LDK, lane);
    __syncthreads();
}

constexpr int MOFF_V = 0, MOFF_K = 32768, MOFF_WS = 65536, MOFF_RK = 67584, MOFF_G = 68608, MOFF_STASH = 69632;
__device__ __forceinline__ void mem_unit(int s, int mh, int qb, bf16_t* VM, const bf16_t* KVM, const float* mqn, const float* mkn, char* lds) {
    int tid = threadIdx.x; asm volatile("" : "+v"(tid));
    const int wid = __builtin_amdgcn_readfirstlane(tid >> 6), lane = tid & 63, r32 = lane & 31, hi = lane >> 5;
    const int tok0 = seq_start(s);
    char* V_lds = lds + MOFF_V; char* K_lds = lds + MOFF_K;
    float* wsf = (float*)(lds + MOFF_WS) + wid * 64; float* li_l = wsf; float* al_l = wsf + 32;
    float* rk_l = (float*)(lds + MOFF_RK); float* g_l = (float*)(lds + MOFF_G);
    const bf16_t* Kh = KVM + (size_t)(s * 256) * 2048 + mh * 256;
    const bf16_t* Vh = KVM + (size_t)(s * 256) * 2048 + 1024 + mh * 256;
    if (tid < 256) g_l[tid] = mqn[tid] * mkn[tid];
    {
        const bf16_t* kp = Kh + (size_t)(wid * 32 + r32) * 2048 + hi * 128; float ss = 0.f;
#pragma unroll
        for (int i = 0; i < 16; ++i) { const u32x4 w = *(const u32x4*)(kp + i * 8);
            ss += bflo(w.x) * bflo(w.x) + bfhi(w.x) * bfhi(w.x) + bflo(w.y) * bflo(w.y) + bfhi(w.y) * bfhi(w.y) + bflo(w.z) * bflo(w.z) + bfhi(w.z) * bfhi(w.z) + bflo(w.w) * bflo(w.w) + bfhi(w.w) * bfhi(w.w); }
        ss += __shfl_xor(ss, 32);
        if (hi == 0) rk_l[wid * 32 + r32] = rsqrtf(ss * (1.f / 256.f) + 1e-6f);
    }
    const size_t qrow = (size_t)(tok0 + qb * 256 + wid * 32);
    bf16_t* Qw = VM + (qrow + r32) * 2048 + 1024 + mh * 256 + hi * 8;
    float rqC;
    { float ss = 0.f;
#pragma unroll
      for (int i = 0; i < 16; ++i) { const u32x4 w = *(const u32x4*)(Qw + i * 16);
          ss += bflo(w.x) * bflo(w.x) + bfhi(w.x) * bfhi(w.x) + bflo(w.y) * bflo(w.y) + bfhi(w.y) * bfhi(w.y) + bflo(w.z) * bflo(w.z) + bfhi(w.z) * bfhi(w.z) + bflo(w.w) * bflo(w.w) + bfhi(w.w) * bfhi(w.w); }
      ss += __shfl_xor(ss, 32);
      rqC = rsqrtf(ss * (1.f / 256.f) + 1e-6f) * (0.0625f * 1.4426950408889634f); }
    const int sr = tid >> 4, sc = (tid & 15) * 8, vst0 = v_st(sr, sc), vst1 = v_st(32 + sr, sc);
    const int kr = tid >> 3, kc = (tid & 7) * 8, kst = KSWZ64(kr, kc * 2);
    const int vb0 = (int)(uintptr_t)V_lds + v_rd_base(lane);
    unsigned* stash = (unsigned*)(lds + MOFF_STASH) + wid * 2048;
    __syncthreads();
#pragma unroll 1
    for (int hv = 0; hv < 2; ++hv) {
    float m_reg = -1e30f, l_reg = 0.f; f32x16 o[4] = {};
#pragma unroll 1
    for (int t = 0; t < 4; ++t) {
        const int k0 = t * 64;
#pragma unroll
        for (int ds = 0; ds < 4; ++ds) { const u32x4 w = *(const u32x4*)(Kh + (size_t)(k0 + kr) * 2048 + ds * 64 + kc); const float* g = g_l + ds * 64 + kc;
            u32x4 o4; o4.x = cvt_pk_bf16(bflo(w.x) * g[0], bfhi(w.x) * g[1]); o4.y = cvt_pk_bf16(bflo(w.y) * g[2], bfhi(w.y) * g[3]);
            o4.z = cvt_pk_bf16(bflo(w.z) * g[4], bfhi(w.z) * g[5]); o4.w = cvt_pk_bf16(bflo(w.w) * g[6], bfhi(w.w) * g[7]);
            *(u32x4*)(K_lds + ds * 8192 + kst) = o4; asm volatile("" ::: "memory"); }
        *(u32x4*)(V_lds + vst0) = *(const u32x4*)(Vh + (size_t)(k0 + sr) * 2048 + hv * 128 + sc);
        *(u32x4*)(V_lds + vst1) = *(const u32x4*)(Vh + (size_t)(k0 + 32 + sr) * 2048 + hv * 128 + sc);
        __syncthreads();
        f32x16 p0 = {}, p1 = {};
#pragma unroll
        for (int ds = 0; ds < 4; ++ds) { bf16x8 qr[4];
#pragma unroll
            for (int d0 = 0; d0 < 4; ++d0) qr[d0] = *reinterpret_cast<const bf16x8*>(Qw + ds * 64 + d0 * 16);
            qkt64(p0, p1, K_lds + ds * 8192, qr, r32, hi); }
#pragma unroll
        for (int r = 0; r < 16; ++r) { p0[r] *= rk_l[k0 + crow(r, hi)] * rqC; p1[r] *= rk_l[k0 + 32 + crow(r, hi)] * rqC; }
        float pmax = p0[0];
#pragma unroll
        for (int r = 1; r < 16; ++r) pmax = fmaxf(pmax, p0[r]);
#pragma unroll
        for (int r = 0; r < 16; ++r) pmax = fmaxf(pmax, p1[r]);
        pmax = fmaxf(pmax, __shfl_xor(pmax, 32));
        const float mn = fmaxf(m_reg, pmax), alpha = __builtin_amdgcn_exp2f(m_reg - mn); m_reg = mn;
        float ps = 0.f;
#pragma unroll
        for (int r = 0; r < 16; ++r) { p0[r] = __builtin_amdgcn_exp2f(p0[r] - mn); p1[r] = __builtin_amdgcn_exp2f(p1[r] - mn); ps += p0[r] + p1[r]; }
        ps += __shfl_xor(ps, 32);
        l_reg = l_reg * alpha + ps;
        if (hi == 0) al_l[r32] = alpha; asm volatile("s_waitcnt lgkmcnt(0)" ::: "memory");
#pragma unroll
        for (int d = 0; d < 4; ++d)
#pragma unroll
            for (int r = 0; r < 16; ++r) o[d][r] *= al_l[crow(r, hi)];
        bf16x8 pa0, pa1, pa2, pa3;
#define PK4(P, BASE, OUT) do { unsigned a0 = cvt_pk_bf16(P[BASE + 0], P[BASE + 1]), a1 = cvt_pk_bf16(P[BASE + 2], P[BASE + 3]);   \
    unsigned b0 = cvt_pk_bf16(P[BASE + 4], P[BASE + 5]), b1 = cvt_pk_bf16(P[BASE + 6], P[BASE + 7]);                              \
    auto r0 = __builtin_amdgcn_permlane32_swap(a0, b0, false, false); auto r1 = __builtin_amdgcn_permlane32_swap(a1, b1, false, false); \
    u32x4 w = {r0[0], r1[0], r0[1], r1[1]}; OUT = *reinterpret_cast<bf16x8*>(&w); } while (0)
        PK4(p0, 0, pa0); PK4(p0, 8, pa1); PK4(p1, 0, pa2); PK4(p1, 8, pa3);
#undef PK4
        pv_d0(o, vb0, pa0, pa1, pa2, pa3);
        __syncthreads();
    }
    if (hi == 0) li_l[r32] = l_reg; asm volatile("s_waitcnt lgkmcnt(0)" ::: "memory");
    if (hv == 1) stash_store(stash, VM + qrow * 2048 + 1024 + mh * 256, 2048, lane);
#pragma unroll
    for (int d0 = 0; d0 < 4; ++d0)
#pragma unroll
        for (int r = 0; r < 16; r += 2) stash[(d0 * 8 + (r >> 1)) * 64 + lane] = cvt_pk_bf16(o[d0][r] * __builtin_amdgcn_rcpf(li_l[crow(r, hi)]), o[d0][r + 1] * __builtin_amdgcn_rcpf(li_l[crow(r + 1, hi)]));
    }
    stash_store(stash, VM + qrow * 2048 + 1024 + mh * 256 + 128, 2048, lane);
    __syncthreads();
}
#undef SBAR
}

namespace scan {
constexpr int TC = 32;
typedef _Float16 h2 __attribute__((ext_vector_type(2)));
typedef _Float16 h4 __attribute__((ext_vector_type(4)));
typedef _Float16 h8 __attribute__((ext_vector_type(8)));
constexpr int BUFB = 36864, O_R = 0, O_KD = 4096, O_KK = 8192, O_W = 12288, O_KA = 16384, O_V = 20480, O_Y = 28672;
constexpr int O_PRIV = 73728;
constexpr int O_TBL = 73728 + 32768;
__device__ __forceinline__ float dpp_red8(float x) {
    x += __uint_as_float(__builtin_amdgcn_update_dpp(0u, __float_as_uint(x), 0xB1, 0xf, 0xf, false));
    x += __uint_as_float(__builtin_amdgcn_update_dpp(0u, __float_as_uint(x), 0x4E, 0xf, 0xf, false));
    x += __uint_as_float(__builtin_amdgcn_update_dpp(0u, __float_as_uint(x), 0x141, 0xf, 0xf, false));
    return x;
}
template <int DIR> __device__ __forceinline__ void scan_chunk(const char* B_, h2 (&S)[2][4], int seg, int row0) {
    const char* base = B_ + seg * 16; const char* vbase = B_ + O_V + row0 * 4; char* ybase = (char*)B_ + O_Y + row0 * 4;
    u32x4 ck[2], cw[2], ca[2], cd[2], cr[2]; u32x2 cv[2];
#define LDSET(set, tl_) do { ck[set] = *(const u32x4*)(base + O_KK + (tl_) * 128); cw[set] = *(const u32x4*)(base + O_W + (tl_) * 128); ca[set] = *(const u32x4*)(base + O_KA + (tl_) * 128); \
    cd[set] = *(const u32x4*)(base + O_KD + (tl_) * 128); cr[set] = *(const u32x4*)(base + O_R + (tl_) * 128); cv[set] = *(const u32x2*)(vbase + (tl_) * 256); } while (0)
#define H2(u) __builtin_bit_cast(h2, (u))
    LDSET(0, DIR ? TC - 1 : 0);
#pragma unroll
    for (int st = 0; st < TC; ++st) {
        const int tl = DIR ? TC - 1 - st : st, cs = st & 1;
        if (st + 1 < TC) LDSET(cs ^ 1, DIR ? TC - 2 - st : st + 1);
#define SPLIT4(V, A0, A1, A2, A3) const h8 V##8 = __builtin_bit_cast(h8, V[cs]); const h2 A0 = __builtin_shufflevector(V##8, V##8, 0, 1), A1 = __builtin_shufflevector(V##8, V##8, 2, 3), \
    A2 = __builtin_shufflevector(V##8, V##8, 4, 5), A3 = __builtin_shufflevector(V##8, V##8, 6, 7)
        SPLIT4(ck, k0, k1, k2, k3); SPLIT4(cw, w0, w1, w2, w3); SPLIT4(ca, a0, a1, a2, a3); SPLIT4(cd, d0, d1, d2, d3); SPLIT4(cr, r0, r1, r2, r3);
#undef SPLIT4
        const h4 cv4 = __builtin_bit_cast(h4, cv[cs]);
        f32x2 yo;
#pragma unroll
        for (int h = 0; h < 2; ++h) {
            const h2 vv = h == 0 ? __builtin_shufflevector(cv4, cv4, 0, 1) : __builtin_shufflevector(cv4, cv4, 2, 3);
            float d = __builtin_amdgcn_fdot2(S[h][0], k0, 0.f, false); float e = __builtin_amdgcn_fdot2(S[h][2], k2, 0.f, false);
            d = __builtin_amdgcn_fdot2(S[h][1], k1, d, false); e = __builtin_amdgcn_fdot2(S[h][3], k3, e, false);
            d = dpp_red8(d + e);
            const h2 p0 = S[h][0] * w0 + vv * d0, p1 = S[h][1] * w1 + vv * d1, p2 = S[h][2] * w2 + vv * d2, p3 = S[h][3] * w3 + vv * d3;
            const _Float16 sh = (_Float16)(-d); const h2 sa = {sh, sh};
            S[h][0] = p0 + sa * a0; S[h][1] = p1 + sa * a1; S[h][2] = p2 + sa * a2; S[h][3] = p3 + sa * a3;
            float y = __builtin_amdgcn_fdot2(S[h][0], r0, 0.f, false); float z = __builtin_amdgcn_fdot2(S[h][2], r2, 0.f, false);
            y = __builtin_amdgcn_fdot2(S[h][1], r1, y, false); z = __builtin_amdgcn_fdot2(S[h][3], r3, z, false);
            yo[h] = dpp_red8(y + z);
        }
        if (seg == 0) *(f32x2*)(ybase + tl * 256) = yo;
    }
#undef LDSET
#undef H2
}
__device__ __forceinline__ unsigned pkh(float a, float b) { const h2 v = {(_Float16)a, (_Float16)b}; return __builtin_bit_cast(unsigned, v); }
struct P {
    const bf16_t* ZR; bf16_t* YB; float* BON;
    const float *mup, *mun, *w0, *w2, *a0, *a2, *kk_w, *ka_w, *rk_w;
};
__device__ __forceinline__ void job(int s, int dir, int head, const P& p, char* lds) {
    int tid = threadIdx.x; asm volatile("" : "+v"(tid));
    const int wid = __builtin_amdgcn_readfirstlane(tid >> 6), lane = tid & 63;
    const int tok0 = seq_start(s), T = seq_len(s), NCH = T / TC;
    float* TBL = (float*)(lds + O_TBL);
    float* MUP = TBL; float* MUN = TBL + 320; float* KKW = TBL + 640; float* KAW = TBL + 704; float* RKW = TBL + 768; float* BW = TBL + 832; float* BA = TBL + 896;
    __syncthreads();
    if (tid < 320) { const int which = tid >> 6, j = tid & 63; const int col = which < 3 ? which * 1024 + head * 64 + j : (which == 3 ? 3072 : 3200) + dir * 64 + j; MUP[tid] = p.mup[col]; MUN[tid] = p.mun[col]; }
    if (tid >= 320 && tid < 384) { const int j = tid - 320; KKW[j] = p.kk_w[head * 64 + j]; KAW[j] = p.ka_w[head * 64 + j]; RKW[j] = p.rk_w[head * 64 + j];
        BW[j] = p.w0[dir * 1024 + head * 64 + j]; BA[j] = p.a0[dir * 1024 + head * 64 + j]; }
    bf16_t* yb = p.YB + (size_t)dir * NT * 1024; float* bon = p.BON + (size_t)dir * NT * 16;
    if (wid >= 4) {
        const int pw = wid - 4;
        char* priv = lds + O_PRIV + pw * 8192;
        bf16_t* AWl = (bf16_t*)priv; bf16_t* AAl = AWl + 512; float* PK = (float*)(priv + 2048); float* PA = (float*)(priv + 4096); float* PR = (float*)(priv + 6144);
        bf16x8 Bf[2][4][2];
#pragma unroll
        for (int mat = 0; mat < 2; ++mat)
#pragma unroll
            for (int cbk = 0; cbk < 4; ++cbk)
#pragma unroll
                for (int ks = 0; ks < 2; ++ks) { const float* W2 = (mat == 0 ? p.w2 : p.a2) + (size_t)dir * 64 * 1024 + head * 64 + cbk * 16 + (lane & 15) + (size_t)(ks * 32 + (lane >> 4) * 8) * 1024;
                    float f[8];
#pragma unroll
                    for (int e = 0; e < 8; ++e) f[e] = W2[(size_t)e * 1024];
                    u32x4 w; w.x = cvt_pk_bf16(f[0], f[1]); w.y = cvt_pk_bf16(f[2], f[3]); w.z = cvt_pk_bf16(f[4], f[5]); w.w = cvt_pk_bf16(f[6], f[7]); Bf[mat][cbk][ks] = *reinterpret_cast<bf16x8*>(&w); }
        __syncthreads();
        const int pt = tid - 256;
        u32x4 zc[5], zm[5], zn[5];
#define PLOAD(cc) do { const int tf_ = dir ? T - TC * ((cc) + 1) : TC * (cc); \
    _Pragma("unroll") for (int k = 0; k < 5; ++k) { const int which = k, tl8 = lane >> 3, j0 = (lane & 7) * 8; \
        const int col = which < 3 ? which * 1024 + head * 64 + j0 : (which == 3 ? 3072 : 3200) + dir * 64 + j0; \
        const int t = tf_ + 8 * pw + tl8; const bf16_t* zp = p.ZR + (size_t)(tok0 + t) * ZRP + col; \
        zc[k] = *(const u32x4*)zp; zm[k] = (u32x4){0u, 0u, 0u, 0u}; zn[k] = (u32x4){0u, 0u, 0u, 0u}; \
        if (t > 0) zm[k] = *(const u32x4*)(zp - ZRP); \
        if (t < T - 1) zn[k] = *(const u32x4*)(zp + ZRP); } } while (0)
        PLOAD(0);
        for (int c = -1; c < NCH; ++c) {
            if (c >= 1) { const int cb_ = (c - 1) & 1, tf = dir ? T - TC * c : TC * (c - 1); const int tl = pt >> 3, c8 = (pt & 7) * 8;
                const float* yp = (const float*)(lds + cb_ * BUFB + O_Y) + tl * 64 + c8; const f32x4 y4 = *(const f32x4*)yp, y5 = *(const f32x4*)(yp + 4);
                u32x4 w; w.x = cvt_pk_bf16(y4[0], y4[1]); w.y = cvt_pk_bf16(y4[2], y4[3]); w.z = cvt_pk_bf16(y5[0], y5[1]); w.w = cvt_pk_bf16(y5[2], y5[3]);
                *(u32x4*)(yb + (size_t)(tok0 + tf + tl) * 1024 + head * 64 + c8) = w; }
            if (c + 1 < NCH) {
                const int nb = (c + 1) & 1, tfirst = dir ? T - TC * (c + 2) : TC * (c + 1);
                char* B_ = lds + nb * BUFB;
#pragma unroll
                for (int k = 0; k < 5; ++k) { const int which = k, tl8 = lane >> 3, j0 = (lane & 7) * 8, tl = 8 * pw + tl8;
                    const f32x4 mpa = *(const f32x4*)(MUP + which * 64 + j0), mpb = *(const f32x4*)(MUP + which * 64 + j0 + 4), mna = *(const f32x4*)(MUN + which * 64 + j0), mnb = *(const f32x4*)(MUN + which * 64 + j0 + 4);
                    const u32x4 z = zc[k], zmm = zm[k], znn = zn[k];
                    float v[8];
#define SH(i, zw, zmw, znw, lohi, mp_, mn_) { const float zz = lohi(zw), a_ = lohi(zmw), b_ = lohi(znw); v[i] = zz + mp_ * (a_ - zz) + mn_ * (b_ - zz); }
                    SH(0, z.x, zmm.x, znn.x, bflo, mpa[0], mna[0]) SH(1, z.x, zmm.x, znn.x, bfhi, mpa[1], mna[1]) SH(2, z.y, zmm.y, znn.y, bflo, mpa[2], mna[2]) SH(3, z.y, zmm.y, znn.y, bfhi, mpa[3], mna[3])
                    SH(4, z.z, zmm.z, znn.z, bflo, mpb[0], mnb[0]) SH(5, z.z, zmm.z, znn.z, bfhi, mpb[1], mnb[1]) SH(6, z.w, zmm.w, znn.w, bflo, mpb[2], mnb[2]) SH(7, z.w, zmm.w, znn.w, bfhi, mpb[3], mnb[3])
#undef SH
                    if (which < 2) { float* dst = (which == 0 ? PR : PK) + tl8 * 64 + j0;
                        *(f32x4*)dst = (f32x4){v[0], v[1], v[2], v[3]}; *(f32x4*)(dst + 4) = (f32x4){v[4], v[5], v[6], v[7]}; }
                    else if (which == 2) { unsigned* dst = (unsigned*)(B_ + O_V) + tl * 64 + j0;
                        *(u32x4*)dst = (u32x4){pkh(v[0], v[0]), pkh(v[1], v[1]), pkh(v[2], v[2]), pkh(v[3], v[3])}; *(u32x4*)(dst + 4) = (u32x4){pkh(v[4], v[4]), pkh(v[5], v[5]), pkh(v[6], v[6]), pkh(v[7], v[7])}; }
                    else { if (which == 3) {
#pragma unroll
                            for (int i = 0; i < 8; ++i) { const float e2 = __expf(2.f * v[i]); v[i] = 1.f - 2.f * __builtin_amdgcn_rcpf(e2 + 1.f); } }
                        u32x4 w; w.x = cvt_pk_bf16(v[0], v[1]); w.y = cvt_pk_bf16(v[2], v[3]); w.z = cvt_pk_bf16(v[4], v[5]); w.w = cvt_pk_bf16(v[6], v[7]);
                        *(u32x4*)((which == 3 ? AWl : AAl) + tl8 * 64 + j0) = w; }
                }
                if (c + 2 < NCH) PLOAD(c + 2);
                { const int tj = lane & 7, kq = lane >> 4;
#pragma unroll
                  for (int mat = 0; mat < 2; ++mat) { const bf16_t* Am = (mat == 0 ? AWl : AAl) + tj * 64 + kq * 8;
                      const bf16x8 y0 = *reinterpret_cast<const bf16x8*>(Am), y1 = *reinterpret_cast<const bf16x8*>(Am + 32);
#pragma unroll
                      for (int cbk = 0; cbk < 4; ++cbk) { f32x4 acc = {0.f, 0.f, 0.f, 0.f};
                          acc = __builtin_amdgcn_mfma_f32_16x16x32_bf16(Bf[mat][cbk][0], y0, acc, 0, 0, 0);
                          acc = __builtin_amdgcn_mfma_f32_16x16x32_bf16(Bf[mat][cbk][1], y1, acc, 0, 0, 0);
                          const int col = cbk * 16 + 4 * kq; const f32x4 bias = *(const f32x4*)((mat == 0 ? BW : BA) + col); f32x4 res;
#pragma unroll
                          for (int r = 0; r < 4; ++r) { const float u = acc[r] + bias[r];
                              const float sg = __builtin_amdgcn_rcpf(1.f + __expf(-u));
                              res[r] = mat == 0 ? __expf(-0.60653065971263342f * sg) : sg; }
                          if ((lane & 15) < 8) { if (mat == 0) *(u32x2*)((_Float16*)(B_ + O_W) + (8 * pw + tj) * 64 + col) = (u32x2){pkh(res[0], res[1]), pkh(res[2], res[3])};
                                                 else *(f32x4*)(PA + tj * 64 + col) = res; } } } }
                { const int t8 = lane >> 3, tl = 8 * pw + t8, c0 = (lane & 7) * 8; const int o = t8 * 64 + c0;
                  float bs = 0.f, ss = 0.f; f32x4 kr[2], k4[2], a4[2], r4[2];
#pragma unroll
                  for (int q = 0; q < 2; ++q) { k4[q] = *(const f32x4*)(PK + o + 4 * q); a4[q] = *(const f32x4*)(PA + o + 4 * q); r4[q] = *(const f32x4*)(PR + o + 4 * q);
                      kr[q] = k4[q] * *(const f32x4*)(KKW + c0 + 4 * q); ss += (kr[q][0] * kr[q][0] + kr[q][1] * kr[q][1]) + (kr[q][2] * kr[q][2] + kr[q][3] * kr[q][3]); }
                  ss = dpp_red8(ss);
                  const float inv = __builtin_amdgcn_rsqf(fmaxf(ss, 1e-24f));
                  f32x4 kk[2], kd[2], kka[2];
#pragma unroll
                  for (int q = 0; q < 2; ++q) { kk[q] = kr[q] * inv; kd[q] = k4[q] * (1.f + (a4[q] - 1.f) * *(const f32x4*)(KAW + c0 + 4 * q)); kka[q] = kk[q] * a4[q];
                      const f32x4 bb = r4[q] * kd[q] * *(const f32x4*)(RKW + c0 + 4 * q); bs += (bb[0] + bb[1]) + (bb[2] + bb[3]); }
                  const int oh = (tl * 64 + c0) * 2;
#define ST8(OFF, X) *(u32x4*)(B_ + (OFF) + oh) = (u32x4){pkh(X[0][0], X[0][1]), pkh(X[0][2], X[0][3]), pkh(X[1][0], X[1][1]), pkh(X[1][2], X[1][3])}
                  ST8(O_KK, kk); ST8(O_KD, kd); ST8(O_KA, kka); ST8(O_R, r4);
#undef ST8
                  bs = dpp_red8(bs);
                  if ((lane & 7) == 0) bon[(size_t)(tok0 + tfirst + tl) * 16 + head] = bs; }
            }
            asm volatile("s_waitcnt lgkmcnt(0)" ::: "memory"); __builtin_amdgcn_s_barrier(); asm volatile("" ::: "memory");
        }
#undef PLOAD
    } else {
        __syncthreads();
        const int row0 = wid * 16 + (lane >> 3) * 2, seg = lane & 7;
        h2 S[2][4];
#pragma unroll
        for (int h = 0; h < 2; ++h)
#pragma unroll
            for (int q = 0; q < 4; ++q) S[h][q] = (h2){(_Float16)0.f, (_Float16)0.f};
        asm volatile("s_waitcnt lgkmcnt(0)" ::: "memory"); __builtin_amdgcn_s_barrier(); asm volatile("" ::: "memory");
        for (int c = 0; c < NCH; ++c) {
            const char* B_ = lds + (c & 1) * BUFB;
            if (dir) scan_chunk<1>(B_, S, seg, row0); else scan_chunk<0>(B_, S, seg, row0);
            asm volatile("s_waitcnt lgkmcnt(0)" ::: "memory"); __builtin_amdgcn_s_barrier(); asm volatile("" ::: "memory");
        }
    }
    if (wid >= 4) {
        const int pt = tid - 256, c = NCH, cb_ = (c - 1) & 1, tf = dir ? T - TC * c : TC * (c - 1); const int tl = pt >> 3, c8 = (pt & 7) * 8;
        const float* yp = (const float*)(lds + cb_ * BUFB + O_Y) + tl * 64 + c8; const f32x4 y4 = *(const f32x4*)yp, y5 = *(const f32x4*)(yp + 4);
        u32x4 w; w.x = cvt_pk_bf16(y4[0], y4[1]); w.y = cvt_pk_bf16(y4[2], y4[3]); w.z = cvt_pk_bf16(y5[0], y5[1]); w.w = cvt_pk_bf16(y5[2], y5[3]);
        *(u32x4*)(yb + (size_t)(tok0 + tf + tl) * 1024 + head * 64 + c8) = w;
    }
    __syncthreads();
}
}

__device__ __forceinline__ void p4_post(const Args& a, char* lds, int vcu, int G) {
    const int tid = threadIdx.x, lane = tid & 63;
    unsigned char* ws = a.ws;
    const bf16_t* ZR = (const bf16_t*)a.out; bf16_t* QK = (bf16_t*)(ws + WS_QK);
    const bf16_t* Y0 = (const bf16_t*)(ws + WS_Y); const bf16_t* Y1 = Y0 + (size_t)NT * 1024;
    const float* BON = (const float*)(ws + WS_BON);
    const float* mup = a.in[13]; const float* mun = a.in[14]; const float* G2 = a.in[19]; const float* lnw = a.in[23]; const float* lnb = a.in[24]; const float* subg = a.in[12];
    float* SG = (float*)lds; float* BL = (float*)(lds + 20480);
    for (int tile = vcu; tile < NT / 32; tile += G) {
        const int tk0 = tile * 32;
        __syncthreads();
        for (int it = tid; it < 32 * 20; it += NTHR) {
            const int tl = it / 20, j0 = (it % 20) * 8, col = 3328 + j0, tok = tk0 + tl, t = tok_pos(tok), T = tok < TP ? TP : TS;
            const bf16_t* zp = ZR + (size_t)tok * ZRP + col; const u32x4 z = *(const u32x4*)zp; u32x4 zm = {0u, 0u, 0u, 0u}, zn = {0u, 0u, 0u, 0u};
            if (t > 0) zm = *(const u32x4*)(zp - ZRP);
            if (t < T - 1) zn = *(const u32x4*)(zp + ZRP);
            float v[8];
#define SH(i, zw, zmw, znw, lohi) { const float zz = lohi(zw), a_ = lohi(zmw), b_ = lohi(znw), mp_ = mup[col + i], mn_ = mun[col + i]; v[i] = sigmoidf_(zz + mp_ * (a_ - zz) + mn_ * (b_ - zz)); }
            SH(0, z.x, zm.x, zn.x, bflo) SH(1, z.x, zm.x, zn.x, bfhi) SH(2, z.y, zm.y, zn.y, bflo) SH(3, z.y, zm.y, zn.y, bfhi)
            SH(4, z.z, zm.z, zn.z, bflo) SH(5, z.z, zm.z, zn.z, bfhi) SH(6, z.w, zm.w, zn.w, bflo) SH(7, z.w, zm.w, zn.w, bfhi)
#undef SH
            *(f32x4*)(SG + tl * 160 + j0) = (f32x4){v[0], v[1], v[2], v[3]}; *(f32x4*)(SG + tl * 160 + j0 + 4) = (f32x4){v[4], v[5], v[6], v[7]};
        }
        { const int tl = tid >> 4, hd = tid & 15; BL[tid] = BON[(size_t)(tk0 + tl) * 16 + hd] + BON[(size_t)NT * 16 + (size_t)(tk0 + tl) * 16 + hd]; }
        { const int pr = tid >> 1, half = tid & 1, tl = pr >> 3, hd = pr & 7; bf16_t* op = QK + (size_t)(tk0 + tl) * 2048 + hd * 128 + half * 64;
          u32x4 w[8]; float ss = 0.f;
#pragma unroll
          for (int i = 0; i < 8; ++i) { w[i] = *(const u32x4*)(op + i * 8);
              ss += bflo(w[i].x) * bflo(w[i].x) + bfhi(w[i].x) * bfhi(w[i].x) + bflo(w[i].y) * bflo(w[i].y) + bfhi(w[i].y) * bfhi(w[i].y) + bflo(w[i].z) * bflo(w[i].z) + bfhi(w[i].z) * bfhi(w[i].z) + bflo(w[i].w) * bflo(w[i].w) + bfhi(w[i].w) * bfhi(w[i].w); }
          ss += __shfl_xor(ss, 1);
          const float rstd = rsqrtf(ss * (1.f / 128.f) + 1e-6f) * 0.8f; const float* sg = subg + half * 64;
#pragma unroll
          for (int i = 0; i < 8; ++i) { u32x4 o;
              o.x = cvt_pk_bf16(bflo(w[i].x) * rstd * sg[i * 8 + 0], bfhi(w[i].x) * rstd * sg[i * 8 + 1]); o.y = cvt_pk_bf16(bflo(w[i].y) * rstd * sg[i * 8 + 2], bfhi(w[i].y) * rstd * sg[i * 8 + 3]);
              o.z = cvt_pk_bf16(bflo(w[i].z) * rstd * sg[i * 8 + 4], bfhi(w[i].z) * rstd * sg[i * 8 + 5]); o.w = cvt_pk_bf16(bflo(w[i].w) * rstd * sg[i * 8 + 6], bfhi(w[i].w) * rstd * sg[i * 8 + 7]);
              *(u32x4*)(op + i * 8) = o; } }
        __syncthreads();
        const int c0 = tid * 2;
        float acc[32][2];
#pragma unroll
        for (int i = 0; i < 32; ++i) { acc[i][0] = 0.f; acc[i][1] = 0.f; }
#pragma unroll 1
        for (int k = 0; k < 160; k += 4) {
            const f32x2 g0 = *(const f32x2*)(G2 + (size_t)(k + 0) * 1024 + c0), g1 = *(const f32x2*)(G2 + (size_t)(k + 1) * 1024 + c0), g2 = *(const f32x2*)(G2 + (size_t)(k + 2) * 1024 + c0), g3 = *(const f32x2*)(G2 + (size_t)(k + 3) * 1024 + c0);
#pragma unroll
            for (int i = 0; i < 32; ++i) { const f32x4 s4 = *(const f32x4*)(SG + i * 160 + k);
                acc[i][0] += s4[0] * g0[0] + s4[1] * g1[0] + s4[2] * g2[0] + s4[3] * g3[0];
                acc[i][1] += s4[0] * g0[1] + s4[1] * g1[1] + s4[2] * g2[1] + s4[3] * g3[1]; }
        }
        const int hd = tid >> 5;
        const float lw0 = lnw[c0], lw1 = lnw[c0 + 1], lb0 = lnb[c0], lb1 = lnb[c0 + 1];
        const float mp0 = mup[2048 + c0], mp1 = mup[2048 + c0 + 1], mn0 = mun[2048 + c0], mn1 = mun[2048 + c0 + 1];
#pragma unroll
        for (int i = 0; i < 32; ++i) {
            const int tok = tk0 + i, t = tok_pos(tok), T = tok < TP ? TP : TS;
            const unsigned ya = *(const unsigned*)(Y0 + (size_t)tok * 1024 + c0), yb = *(const unsigned*)(Y1 + (size_t)tok * 1024 + c0);
            const float y0 = bflo(ya) + bflo(yb), y1 = bfhi(ya) + bfhi(yb);
            float s = y0 + y1, q = y0 * y0 + y1 * y1;
#pragma unroll
            for (int o = 1; o < 32; o <<= 1) { s += __shfl_xor(s, o); q += __shfl_xor(q, o); }
            const float mean = s * (1.f / 64.f), var = fmaxf(q * (1.f / 64.f) - mean * mean, 0.f), rstd = rsqrtf(var + 64e-5f);
            const bf16_t* zp = ZR + (size_t)tok * ZRP + 2048 + c0; const unsigned z = *(const unsigned*)zp;
            unsigned zm = 0u, zn = 0u;
            if (t > 0) zm = *(const unsigned*)(zp - ZRP);
            if (t < T - 1) zn = *(const unsigned*)(zp + ZRP);
            const float v0 = bflo(z) + mp0 * (bflo(zm) - bflo(z)) + mn0 * (bflo(zn) - bflo(z)), v1 = bfhi(z) + mp1 * (bfhi(zm) - bfhi(z)) + mn1 * (bfhi(zn) - bfhi(z));
            const float bo = BL[i * 16 + hd];
            const float o0 = ((y0 - mean) * rstd * lw0 + lb0 + bo * v0) * acc[i][0], o1 = ((y1 - mean) * rstd * lw1 + lb1 + bo * v1) * acc[i][1];
            *(unsigned*)(QK + (size_t)tok * 2048 + 1024 + c0) = cvt_pk_bf16(o0, o1);
        }
    }
    __syncthreads();
}

struct SchedMerge {
    int v, G; const char* H; const char* WG; const char* QK; const char* VM; const char* PAR; const char* PM2;
    __device__ __forceinline__ bool next(int i, Unit& u) const {
        const int ti = i / 6, kind = i - ti * 6; const long L = (long)ti * G + v; int pm, pn;
        if (!TileMap{192, 8}.get(L, pm, pn)) return false;
        u.pm = pm; u.pn = pn; u.kind = kind; u.t0 = 0; u.T = 0;
        const size_t bo = (size_t)pn * MiB;
        switch (kind) {
            case 0: u.A = H + (size_t)pm * MiB; u.B = WG + bo; u.nt = 32; break;
            case 1: u.A = QK + (size_t)pm * MiB; u.B = PAR + bo; u.nt = 16; break;
            case 2: u.A = H + (size_t)pm * MiB; u.B = WG + 8 * MiB + bo; u.nt = 32; break;
            case 3: u.A = QK + (size_t)pm * MiB + 2048; u.B = PAR + bo + 2048; u.nt = 16; break;
            case 4: u.A = H + (size_t)pm * MiB; u.B = WG + 16 * MiB + bo; u.nt = 32; break;
            default: u.A = VM + (size_t)pm * MiB + 2048; u.B = PM2 + bo; u.nt = 16; break;
        }
        return true;
    }
};
struct EpiMerge {
    u32x4* scrG; f32x4* scrP; bf16_t* MRG;
    __device__ __forceinline__ void operator()(const f32x4 (&acc)[2][2][4][2], const Unit& u, int wr, int wc, int fr, int fq) const {
        const int tid = threadIdx.x, kind = u.kind;
        u32x4* gp = scrG + tid; f32x4* pp = scrP + tid;
        if ((kind & 1) == 0) {
#pragma unroll
            for (int ai = 0; ai < 2; ++ai)
#pragma unroll
                for (int bj = 0; bj < 2; ++bj)
#pragma unroll
                    for (int m = 0; m < 4; ++m) { const f32x4 v0 = acc[ai][bj][m][0], v1 = acc[ai][bj][m][1]; u32x4 w;
                        w.x = cvt_pk_bf16(sigmoidf_(v0[0]), sigmoidf_(v0[1])); w.y = cvt_pk_bf16(sigmoidf_(v0[2]), sigmoidf_(v0[3]));
                        w.z = cvt_pk_bf16(sigmoidf_(v1[0]), sigmoidf_(v1[1])); w.w = cvt_pk_bf16(sigmoidf_(v1[2]), sigmoidf_(v1[3]));
                        *gp = w; gp += NTHR; asm volatile("" : "+v"(gp) :: "memory"); }
        } else {
            const int row0 = u.pm * 256 + wr * 64 + fr, col0 = u.pn * 256 + wc * 32 + 8 * fq;
#pragma unroll
            for (int ai = 0; ai < 2; ++ai)
#pragma unroll
                for (int bj = 0; bj < 2; ++bj) {
                    bf16_t* mp = MRG + (size_t)(row0 + ai * 128) * 2048 + col0 + bj * 128;
#pragma unroll
                    for (int m = 0; m < 4; ++m) { const u32x4 g = *gp;
                        f32x4 p0 = acc[ai][bj][m][0] * (f32x4){bflo(g.x), bfhi(g.x), bflo(g.y), bfhi(g.y)}, p1 = acc[ai][bj][m][1] * (f32x4){bflo(g.z), bfhi(g.z), bflo(g.w), bfhi(g.w)};
                        if (kind > 1) { p0 += pp[0]; p1 += pp[NTHR]; }
                        if (kind < 5) { pp[0] = p0; pp[NTHR] = p1; }
                        else { u32x4 w; w.x = cvt_pk_bf16(p0[0], p0[1]); w.y = cvt_pk_bf16(p0[2], p0[3]); w.z = cvt_pk_bf16(p1[0], p1[1]); w.w = cvt_pk_bf16(p1[2], p1[3]);
                            *(u32x4*)mp = w; }
                        gp += NTHR; pp += 2 * NTHR; mp += 16 * 2048; asm volatile("" : "+v"(gp), "+v"(pp), "+v"(mp) :: "memory"); } }
        }
    }
};

struct SchedSq {
    int v, G; const char* A; const char* B; size_t astep, bstep; int nt;
    __device__ __forceinline__ bool next(int i, Unit& u) const {
        const long L = (long)i * G + v; int pm, pn; if (!TileMap{192, 8}.get(L, pm, pn)) return false;
        u.A = A + (size_t)pm * astep; u.B = B + (size_t)pn * bstep; u.nt = nt; u.pm = pm; u.pn = pn; u.kind = 0; u.t0 = 0; u.T = 0; return true;
    }
};
struct EpiWo {
    const float* xp; const float* xs; float* out;
    __device__ __forceinline__ void operator()(const f32x4 (&acc)[2][2][4][2], const Unit& u, int wr, int wc, int fr, int fq) const {
        const int row0 = u.pm * 256 + wr * 64 + fr, col0 = u.pn * 256 + wc * 32 + 8 * fq;
#pragma unroll
        for (int ai = 0; ai < 2; ++ai)
#pragma unroll
            for (int m = 0; m < 4; ++m) { const int row = row0 + ai * 128 + m * 16;
                const float* xr = (row < TP ? xp + (size_t)row * DM : xs + (size_t)(row - TP) * DM) + col0; float* orow = out + (size_t)row * DM + col0;
#pragma unroll
                for (int bj = 0; bj < 2; ++bj) { const f32x4 x0 = *(const f32x4*)(xr + bj * 128), x1 = *(const f32x4*)(xr + bj * 128 + 4);
                    *(f32x4*)(orow + bj * 128) = x0 + acc[ai][bj][m][0]; *(f32x4*)(orow + bj * 128 + 4) = x1 + acc[ai][bj][m][1]; } }
    }
};
struct EpiDown {
    float* out;
    __device__ __forceinline__ void operator()(const f32x4 (&acc)[2][2][4][2], const Unit& u, int wr, int wc, int fr, int fq) const {
        const int row0 = u.pm * 256 + wr * 64 + fr, col0 = u.pn * 256 + wc * 32 + 8 * fq;
#pragma unroll
        for (int ai = 0; ai < 2; ++ai)
#pragma unroll
            for (int m = 0; m < 4; ++m) { float* orow = out + (size_t)(row0 + ai * 128 + m * 16) * DM + col0;
#pragma unroll
                for (int bj = 0; bj < 2; ++bj) { const f32x4 x0 = *(const f32x4*)(orow + bj * 128), x1 = *(const f32x4*)(orow + bj * 128 + 4);
                    *(f32x4*)(orow + bj * 128) = x0 + acc[ai][bj][m][0]; *(f32x4*)(orow + bj * 128 + 4) = x1 + acc[ai][bj][m][1]; } }
    }
};

struct SchedUp {
    int v, G; const char* HN; const char* WUP;
    __device__ __forceinline__ bool next(int i, Unit& u) const {
        const long L = (long)i * G + v; int pm, pn; if (!TileMap{197, 44}.get(L, pm, pn)) return false;
        int s, ti; if (pm < 65) { s = 0; ti = pm; } else { s = 1 + (pm - 65) / 33; ti = (pm - 65) % 33; }
        const int T = seq_len(s); int t0 = 254 * ti - 1; if (t0 > T - 255) t0 = T - 255;
        u.pm = seq_start(s); u.pn = pn; u.kind = 0; u.t0 = t0; u.T = T; u.nt = 32;
        u.A = HN + ((long)u.pm + t0) * 4096; u.B = WUP + (size_t)pn * MiB; return true;
    }
};
struct EpiUp {
    bf16_t* ACT; const float* cw; const float* cb; LAS float* xch;
    __device__ __forceinline__ void operator()(const f32x4 (&acc)[2][2][4][2], const Unit& u, int wr, int wc, int fr, int fq) const {
        const int lane = threadIdx.x & 63;
        const int cin = wc * 32 + 8 * fq;
#pragma unroll
        for (int ai = 0; ai < 2; ++ai) { const int rg = 2 * ai + wr;
#pragma unroll
            for (int bj = 0; bj < 2; ++bj)
#pragma unroll
                for (int n = 0; n < 2; ++n) {
                    if (fr == 0) *(LAS f32x4*)(xch + (rg * 2 + 0) * 256 + bj * 128 + cin + 4 * n) = acc[ai][bj][0][n];
                    if (fr == 15) *(LAS f32x4*)(xch + (rg * 2 + 1) * 256 + bj * 128 + cin + 4 * n) = acc[ai][bj][3][n]; } }
        asm volatile("s_waitcnt lgkmcnt(0)" ::: "memory"); __builtin_amdgcn_s_barrier(); asm volatile("" ::: "memory");
        const int gc = u.pn * 128 + cin;
#pragma unroll
        for (int n = 0; n < 2; ++n) {
            const int wcol = gc + 4 * n;
            const f32x4 g0 = *(const f32x4*)(cw + wcol), g1 = *(const f32x4*)(cw + 2 * DFF + wcol), g2 = *(const f32x4*)(cw + 4 * DFF + wcol), gb = *(const f32x4*)(cb + wcol);
            const f32x4 v0 = *(const f32x4*)(cw + DFF + wcol), v1 = *(const f32x4*)(cw + 3 * DFF + wcol), v2 = *(const f32x4*)(cw + 5 * DFF + wcol), vb = *(const f32x4*)(cb + DFF + wcol);
#pragma unroll
            for (int ai = 0; ai < 2; ++ai) { const int rg = 2 * ai + wr;
                bf16_t* ap = ACT + ((long)u.pm + u.t0 + 128 * ai + 64 * wr + fr) * DFF + gc + 4 * n;
#pragma unroll
                for (int m = 0; m < 4; ++m) {
                    const int j = 128 * ai + 64 * wr + 16 * m + fr, t = u.t0 + j;
                    f32x4 res;
#pragma unroll
                    for (int bj = 0; bj < 2; ++bj) {
                        const f32x4 cur = acc[ai][bj][m][n];
                        const f32x4 sp = (m > 0 && fr == 15) ? acc[ai][bj][m > 0 ? m - 1 : 0][n] : cur;
                        const f32x4 sn = (m < 3 && fr == 0) ? acc[ai][bj][m < 3 ? m + 1 : 3][n] : cur;
                        f32x4 pv, nv;
#pragma unroll
                        for (int i = 0; i < 4; ++i) { pv[i] = __uint_as_float(__builtin_amdgcn_update_dpp(0u, __float_as_uint(sp[i]), 0x121, 0xf, 0xf, false));
                                                       nv[i] = __uint_as_float(__builtin_amdgcn_update_dpp(0u, __float_as_uint(sn[i]), 0x12F, 0xf, 0xf, false)); }
                        if (m == 0) { const f32x4 xprev = rg > 0 ? *(const LAS f32x4*)(xch + ((rg - 1) * 2 + 1) * 256 + bj * 128 + cin + 4 * n) : (f32x4){0.f, 0.f, 0.f, 0.f}; if (fr == 0) pv = xprev; }
                        if (m == 3) { const f32x4 xnext = rg < 3 ? *(const LAS f32x4*)(xch + ((rg + 1) * 2 + 0) * 256 + bj * 128 + cin + 4 * n) : (f32x4){0.f, 0.f, 0.f, 0.f}; if (fr == 15) nv = xnext; }
                        if (t < 1) pv = (f32x4){0.f, 0.f, 0.f, 0.f};
                        if (t >= u.T - 1) nv = (f32x4){0.f, 0.f, 0.f, 0.f};
                        if (bj == 0) { const f32x4 cv = g0 * pv + g1 * cur + g2 * nv + gb; res = (f32x4){cv[0] * sigmoidf_(cv[0]), cv[1] * sigmoidf_(cv[1]), cv[2] * sigmoidf_(cv[2]), cv[3] * sigmoidf_(cv[3])}; }
                        else { const f32x4 cv = v0 * pv + v1 * cur + v2 * nv + vb; res = res * cv; }
                    }
                    if (j >= 1 && j <= 254) { u32x2 w; w.x = cvt_pk_bf16(res[0], res[1]); w.y = cvt_pk_bf16(res[2], res[3]); *(u32x2*)ap = w; }
                    ap += 16 * DFF; asm volatile("" : "+v"(ap) :: "memory");
                }
            }
        }
    }
};

__global__ void __launch_bounds__(NTHR, 2) enc_fwd(Args args) {
    extern __shared__ __attribute__((aligned(16))) unsigned char lds_raw[];
    cg::grid_group grid = cg::this_grid();
    LAS unsigned char* lds = (LAS unsigned char*)lds_raw;
    const int tid = threadIdx.x;
    const int G = gridDim.x, bx = blockIdx.x, vcu = (G % 8 == 0) ? (bx % 8) * (G / 8) + bx / 8 : bx;
    unsigned char* ws = args.ws;
    const int lo = args.ph_lo, hi = args.ph_hi;
#ifndef P2M
#define P2M 7
#endif
#ifndef PH_MASK
#define PH_MASK 0x1ff
#endif
#define IN(k) (((PH_MASK >> (k)) & 1) && lo <= (k) && (k) < hi)
#define SEAM(k) do { if (IN(k) && IN((k) + 1)) grid.sync(); } while (0)
#ifndef PROBE
#define PROBE 0
#endif
    unsigned long long tp0 = 0, tp1 = 0;
#define TSTAMP(v) do { if (PROBE) { v = __builtin_amdgcn_s_memrealtime(); } } while (0)

    if (IN(0)) p0_prologue(args, lds, vcu, G);
    SEAM(0);
    if (IN(1)) {
        SchedIn S{vcu, G, (const char*)(ws + WS_H), (const char*)(ws + WS_WIN), (const char*)(ws + WS_MEMN), (const char*)(ws + WS_WKV)};
        EpiIn E{(bf16_t*)(ws + WS_QK), (bf16_t*)(ws + WS_VM), (bf16_t*)args.out, (bf16_t*)(ws + WS_KVM), args.in[6], args.in[7], (const float*)(ws + WS_ROPE), (const float*)(ws + WS_ROPE) + TP * 32};
        pg8::gemm_phase<EpiIn, SchedIn, true>(lds, 2048, S, E);
    }
    SEAM(1);
    if (PROBE == 1 || PROBE == 2) TSTAMP(tp0);
    if (IN(2)) {
        unsigned* ctl = (unsigned*)(ws + WS_CTL);
        volatile LAS unsigned* jobw = (volatile LAS unsigned*)(lds + LDS_MISC);
        const float lam = ((const float*)ctl)[CW_LAM];
        const bool fixref = ((const float*)ctl)[CW_SMAX] <= 30.f;
        scan::P sp{(const bf16_t*)args.out, (bf16_t*)(ws + WS_Y), (float*)(ws + WS_BON), args.in[13], args.in[14], args.in[15], args.in[16], args.in[17], args.in[18], args.in[20], args.in[21], args.in[22]};
        for (;;) {
            __syncthreads();
            if (tid == 0) jobw[0] = atomicAdd(ctl + CW_QUEUE, 1u);
            __syncthreads();
            const int jb = (int)jobw[0];
            if (jb >= 160 + 1536 + 768) break;
            if (((P2M) & 1) && jb < 160) {
                int s, r; if (jb < 32) { s = 0; r = jb; } else { s = 1 + (jb - 32) / 32; r = (jb - 32) % 32; }
                scan::job(s, r & 1, r >> 1, sp, (char*)lds_raw);
                if (PROBE == 2 && tid == 0) atomicMax((unsigned long long*)(ctl + 256), (unsigned long long)__builtin_amdgcn_s_memrealtime());
            } else if (((P2M) & 2) && jb < 160 + 1536) {
                const int a = jb - 160; int s, h, qb;
                if (a < 512) { s = 0; h = a / 64; qb = a % 64; } else { const int b = a - 512; s = 1 + b / 256; h = (b % 256) / 32; qb = b % 32; }
                if (fixref) att::diff_unit<true>(s, h, qb, (bf16_t*)(ws + WS_QK), (const bf16_t*)(ws + WS_VM), lam, (char*)lds_raw);
                else att::diff_unit<false>(s, h, qb, (bf16_t*)(ws + WS_QK), (const bf16_t*)(ws + WS_VM), lam, (char*)lds_raw);
            } else if ((P2M) & 4) {
                const int a = jb - 160 - 1536; int s, mh, qb;
                if (a < 256) { s = 0; mh = a / 64; qb = a % 64; } else { const int b = a - 256; s = 1 + b / 128; mh = (b % 128) / 32; qb = b % 32; }
                att::mem_unit(s, mh, qb, (bf16_t*)(ws + WS_VM), (const bf16_t*)(ws + WS_KVM), args.in[27], args.in[28], (char*)lds_raw);
            }
        }
    }
    SEAM(2);
    if (PROBE == 1) TSTAMP(tp1);
    if (IN(3)) p4_post(args, (char*)lds_raw, vcu, G);
    SEAM(3);
    if (IN(4)) {
        SchedMerge S{vcu, G, (const char*)(ws + WS_H), (const char*)(ws + WS_WG), (const char*)(ws + WS_QK), (const char*)(ws + WS_VM), (const char*)(ws + WS_PAR), (const char*)(ws + WS_PM2)};
        unsigned char* scr = (unsigned char*)args.out + (size_t)bx * (384 * 1024);
        EpiMerge E{(u32x4*)scr, (f32x4*)(scr + 128 * 1024), (bf16_t*)(ws + WS_MRG)};
        pg8::gemm_phase<EpiMerge, SchedMerge, true>(lds, 2048, S, E);
    }
    SEAM(4);
    if (IN(5)) {
        SchedSq S{vcu, G, (const char*)(ws + WS_MRG), (const char*)(ws + WS_WO), MiB, MiB, 32};
        EpiWo E{args.in[0], args.in[1], args.out};
        pg8::gemm_phase<EpiWo, SchedSq, true>(lds, 2048, S, E);
    }
    SEAM(5);
    if (IN(6)) {
        const int lane = tid & 63, gw = vcu * 8 + (tid >> 6), NGW = G * 8;
        for (int m = gw; m < NT; m += NGW) rms_row(args.out + (size_t)m * DM, args.in[33], (bf16_t*)(ws + WS_H) + (size_t)m * DM, lane);
    }
    SEAM(6);
    if (IN(7)) {
        SchedUp S{vcu, G, (const char*)(ws + WS_H), (const char*)(ws + WS_WUP)};
        EpiUp E{(bf16_t*)(ws + WS_ACT), args.in[35], args.in[36], (LAS float*)(lds + LDS_XCH)};
        pg8::gemm_phase<EpiUp, SchedUp, true>(lds, 2048, S, E);
    }
    SEAM(7);
    if (IN(8)) {
        SchedSq S{vcu, G, (const char*)(ws + WS_ACT), (const char*)(ws + WS_WDN), (size_t)256 * DFF * 2, (size_t)256 * DFF * 2, 88};
        EpiDown E{args.out};
        pg8::gemm_phase<EpiDown, SchedSq, true>(lds, DFF, S, E);
    }
    if (PROBE && bx == 0 && tid == 0) {
        if (PROBE == 2) tp1 = __hip_atomic_load((unsigned long long*)(ws + WS_CTL) + 128, __ATOMIC_RELAXED, __HIP_MEMORY_SCOPE_AGENT);
        const unsigned long long target = __builtin_amdgcn_s_memrealtime() + (tp1 > tp0 ? tp1 - tp0 : 0);
        while (__builtin_amdgcn_s_memrealtime() < target) __builtin_amdgcn_s_sleep(16);
    }
#undef IN
#undef SEAM
}

#ifndef MK_SPLIT
#define MK_SPLIT 0
#endif
extern "C" void kernel_launch(void* const* d_in, const int* in_sizes, int n_in, void* d_out, int out_size, void* d_ws, size_t ws_size, hipStream_t stream) {
    static int grid = 0;
    if (grid == 0) {
        if (n_in != 38 || out_size != NT * DM || ws_size < WS_END) { fprintf(stderr, "kernel_launch: unexpected shapes n_in %d out %d ws %zu\n", n_in, out_size, ws_size); grid = -1; return; }
        int dev = 0, cus = 0, per_cu = 0;
        hipGetDevice(&dev); hipDeviceGetAttribute(&cus, hipDeviceAttributeMultiprocessorCount, dev);
        if (hipFuncSetAttribute((const void*)enc_fwd, hipFuncAttributeMaxDynamicSharedMemorySize, LDS_BYTES) != hipSuccess) { fprintf(stderr, "kernel_launch: hipFuncSetAttribute failed\n"); grid = -1; return; }
        if (hipOccupancyMaxActiveBlocksPerMultiprocessor(&per_cu, (const void*)enc_fwd, NTHR, LDS_BYTES) != hipSuccess || per_cu < 1) { fprintf(stderr, "kernel_launch: occupancy query failed (%d)\n", per_cu); per_cu = 1; }
        (void)hipGetLastError();
        grid = cus * 1;
    }
    if (grid < 0) return;
    Args a{};
    for (int i = 0; i < 38; ++i) a.in[i] = (const float*)d_in[i];
    a.out = (float*)d_out; a.ws = (unsigned char*)d_ws;
    for (int d = 0; d < 32; ++d) a.inv_rev[d] = pow(10000.0, -(double)d / 32.0) / 6.283185307179586476925286766559;
#if MK_SPLIT
    for (int ph = 0; ph < 9; ++ph) { a.ph_lo = ph; a.ph_hi = ph + 1; void* kargs[] = {&a};
        hipError_t e = hipLaunchCooperativeKernel((const void*)enc_fwd, dim3(grid), dim3(NTHR), kargs, LDS_BYTES, stream);
        if (e != hipSuccess) { fprintf(stderr, "launch %d failed: %s\n", ph, hipGetErrorString(e)); break; } }
#else
    a.ph_lo = 0; a.ph_hi = 9;
    void* kargs[] = {&a};
    hipError_t e = hipLaunchCooperativeKernel((const void*)enc_fwd, dim3(grid), dim3(NTHR), kargs, LDS_BYTES, stream);
    if (e != hipSuccess) fprintf(stderr, "cooperative launch failed: %s (grid %d)\n", hipGetErrorString(e), grid);
#endif
}
```

```cpp
#include <hip/hip_runtime.h>
#include <hip/hip_cooperative_groups.h>
#include <cstdio>
#include <cstdint>
#include <cmath>
namespace cg = cooperative_groups;

#define LAS __attribute__((address_space(3)))
typedef unsigned short bf16_t;
typedef short bf16x8 __attribute__((ext_vector_type(8)));
typedef short s16x4 __attribute__((ext_vector_type(4)));
typedef float f32x2 __attribute__((ext_vector_type(2)));
typedef float f32x4 __attribute__((ext_vector_type(4)));
typedef float f32x16 __attribute__((ext_vector_type(16)));
typedef unsigned u32x2 __attribute__((ext_vector_type(2)));
typedef unsigned u32x4 __attribute__((ext_vector_type(4)));

constexpr int NT = 49152, DM = 2048, TP = 16384, TS = 8192, NSEQ = 5;
constexpr int ZRP = 3584;
constexpr int DFF = 5632;
constexpr int NTHR = 512;
constexpr size_t MiB = 1u << 20;
constexpr size_t WS_CTL = 0, WS_WIN = 1 * MiB, WS_WG = 31 * MiB, WS_WKV = 55 * MiB, WS_PAR = 63 * MiB, WS_PM2 = 71 * MiB, WS_WO = 79 * MiB,
                 WS_WUP = 87 * MiB, WS_WDN = 131 * MiB, WS_ROPE = 153 * MiB, WS_MEMN = 157 * MiB, WS_KVM = 162 * MiB, WS_BON = 167 * MiB,
                 WS_H = 176 * MiB, WS_QK = 370 * MiB, WS_VM = 562 * MiB, WS_Y = 754 * MiB, WS_ACT = 370 * MiB, WS_MRG = 754 * MiB, WS_END = 946 * MiB;
constexpr int CW_QUEUE = 64, CW_LAM = 128, CW_SMAX = 129;
constexpr size_t WS_G2T = 173 * MiB;
constexpr int LDS_XCH = 131072, LDS_MISC = 131072 + 8192, LDS_BYTES = 131072 + 8192 + 256;

__device__ __forceinline__ int seq_start(int s) { return s == 0 ? 0 : TP + (s - 1) * TS; }
__device__ __forceinline__ int seq_len(int s) { return s == 0 ? TP : TS; }
__device__ __forceinline__ int tok_pos(int tok) { return tok < TP ? tok : ((tok - TP) & (TS - 1)); }

__device__ __forceinline__ unsigned cvt_pk_bf16(float lo, float hi) { unsigned r; asm volatile("v_cvt_pk_bf16_f32 %0, %1, %2" : "=v"(r) : "v"(lo), "v"(hi)); return r; }
__device__ __forceinline__ float bflo(unsigned w) { return __uint_as_float(w << 16); }
__device__ __forceinline__ float bfhi(unsigned w) { return __uint_as_float(w & 0xffff0000u); }
__device__ __forceinline__ float bf1(bf16_t b) { return __uint_as_float((unsigned)b << 16); }
__device__ __forceinline__ float sigmoidf_(float x) { return 1.f / (1.f + __expf(-x)); }
__device__ __forceinline__ float wave_sum(float v) {
#pragma unroll
    for (int o = 1; o < 64; o <<= 1) v += __shfl_xor(v, o);
    return v;
}

namespace pg8 {
constexpr int BM = 256, BK = 64, HALF = 128, HTB = HALF * BK * 2, STAGE_BYTES = 8 * HTB;
__host__ __device__ __forceinline__ int lds_byte(int r, int c) { const int st = (r >> 4) * 2 + (c >> 5), rr = r & 15, cc = c & 31, ob = rr * 64 + cc * 2; return st * 1024 + (ob ^ (((ob >> 9) & 1) << 5)); }
__host__ __device__ __forceinline__ void stage_rc(int b, int& R, int& C) { const int st = b / 1024, sb = b % 1024, swz = sb ^ (((sb >> 9) & 1) << 5); R = (st >> 1) * 16 + swz / 64; C = (st & 1) * 32 + (swz % 64) / 2; }
__host__ __device__ __forceinline__ int perm32(int rho) { const int n = rho >> 4, i = rho & 15; return 8 * (i >> 2) + 4 * n + (i & 3); }

struct Unit { const char* A; const char* B; int nt, pm, pn, kind, t0, T; };

template <class Epi, class Sched, bool ALIGN_EPI>
__device__ __forceinline__ void gemm_phase(LAS unsigned char* lds, const int ld, const Sched& S, const Epi& E) {
    const int tid = threadIdx.x, wid = __builtin_amdgcn_readfirstlane(tid >> 6), lane = tid & 63, wr = wid >> 2, wc = wid & 3, fr = lane & 15, fq = lane >> 4;
    unsigned voffA[2], voffB[2];
#pragma unroll
    for (int i = 0; i < 2; ++i) { int R, C; stage_rc(tid * 16 + i * 8192, R, C); const int Rb = (R & ~31) + perm32(R & 31);
        voffA[i] = (unsigned)(R * ld + C) * 2u; voffB[i] = (unsigned)(Rb * ld + C) * 2u; }
    const size_t kstep = (size_t)(BK * 2);
    const size_t hstep = (size_t)HALF * ld * 2;
    const unsigned ldsw = (unsigned)wid * 1024u;
    const int aoff = lds_byte(wr * 64 + fr, fq * 8), boff = lds_byte(wc * 32 + fr, fq * 8);
#define PG8_SA(b, h) (((b) * 2 + (h)) * HTB)
#define PG8_SB(b, h) ((4 + (b) * 2 + (h)) * HTB)
#define PG8_STAGE(bufoff, gbase, voff) do { _Pragma("unroll") for (int _i = 0; _i < 2; ++_i) \
        __builtin_amdgcn_global_load_lds((const unsigned*)((const char*)(gbase) + (voff)[_i]), (LAS unsigned*)(lds + (bufoff) + ldsw + _i * 8192), 16, 0, 0); } while (0)
#define PG8_LDA(dst, b, h) do { _Pragma("unroll") for (int m = 0; m < 4; ++m) _Pragma("unroll") for (int k = 0; k < 2; ++k) dst[m][k] = *(const LAS bf16x8*)(lds + PG8_SA(b, h) + aoff + m * 2048 + k * 1024); } while (0)
#define PG8_LDB(dst, b, h) do { _Pragma("unroll") for (int n = 0; n < 2; ++n) _Pragma("unroll") for (int k = 0; k < 2; ++k) dst[n][k] = *(const LAS bf16x8*)(lds + PG8_SB(b, h) + boff + n * 2048 + k * 1024); } while (0)
#define PG8_MMA(ai, bj, At, Bt) do { __builtin_amdgcn_s_setprio(1); _Pragma("unroll") for (int m = 0; m < 4; ++m) _Pragma("unroll") for (int n = 0; n < 2; ++n) _Pragma("unroll") for (int k = 0; k < 2; ++k) \
        acc[ai][bj][m][n] = __builtin_amdgcn_mfma_f32_16x16x32_bf16(Bt[n][k], At[m][k], acc[ai][bj][m][n], 0, 0, 0); __builtin_amdgcn_s_setprio(0); } while (0)
#define PG8_WAIT_V(n) asm volatile("s_waitcnt vmcnt(" #n ")" ::: "memory")
#define PG8_WAIT_L(n) asm volatile("s_waitcnt lgkmcnt(" #n ")" ::: "memory")
#define PG8_BAR __builtin_amdgcn_s_barrier()
#define PG8_SCHED __builtin_amdgcn_sched_barrier(0)
    Unit cur, nxt; int ui = 0;
    if (!S.next(0, cur)) return;
    f32x4 acc[2][2][4][2];
#pragma unroll
    for (int a = 0; a < 2; ++a)
#pragma unroll
        for (int b = 0; b < 2; ++b)
#pragma unroll
            for (int m = 0; m < 4; ++m)
#pragma unroll
                for (int n = 0; n < 2; ++n) acc[a][b][m][n] = (f32x4){0.f, 0.f, 0.f, 0.f};
    bf16x8 At[4][2], B0[2][2], B1[2][2];
    const char* cA = cur.A; const char* cB = cur.B;
    PG8_STAGE(PG8_SB(0, 0), cB, voffB); PG8_STAGE(PG8_SB(0, 1), cB + hstep, voffB); PG8_STAGE(PG8_SA(0, 0), cA, voffA); PG8_STAGE(PG8_SA(0, 1), cA + hstep, voffA);
    if (wr == 1) PG8_BAR;
    PG8_WAIT_V(2); PG8_BAR;
    PG8_STAGE(PG8_SB(1, 0), cB + kstep, voffB); PG8_STAGE(PG8_SA(1, 0), cA + kstep, voffA); PG8_STAGE(PG8_SB(1, 1), cB + hstep + kstep, voffB);
    PG8_WAIT_V(6); PG8_BAR;
    for (;;) {
        const bool has_next = S.next(ui + 1, nxt);
        const char* nA = has_next ? nxt.A : cA; const char* nB = has_next ? nxt.B : cB;
        const int nt = cur.nt;
        for (int t = 0; t < nt; t += 2) {
            const bool last = (t == nt - 2);
            const char* a1 = cA + (size_t)(t + 1) * kstep;
            const char* a2 = last ? nA : cA + (size_t)(t + 2) * kstep; const char* b2 = last ? nB : cB + (size_t)(t + 2) * kstep;
            const char* a3 = a2 + kstep; const char* b3 = b2 + kstep;
            PG8_LDB(B0, 0, 0); PG8_LDB(B1, 0, 1); PG8_SCHED; PG8_LDA(At, 0, 0); PG8_STAGE(PG8_SA(1, 1), a1 + hstep, voffA);
            PG8_WAIT_V(8); PG8_WAIT_L(0); PG8_BAR; PG8_MMA(0, 0, At, B0); PG8_MMA(0, 1, At, B1); PG8_BAR; PG8_SCHED;
            PG8_LDA(At, 0, 1); PG8_STAGE(PG8_SB(0, 0), b2, voffB); PG8_STAGE(PG8_SB(0, 1), b2 + hstep, voffB); PG8_STAGE(PG8_SA(0, 0), a2, voffA);
            PG8_WAIT_V(8); PG8_WAIT_L(0); PG8_BAR; PG8_MMA(1, 0, At, B0); PG8_MMA(1, 1, At, B1); PG8_BAR; PG8_SCHED;
            PG8_LDB(B0, 1, 0); PG8_LDB(B1, 1, 1); PG8_SCHED; PG8_LDA(At, 1, 0); PG8_STAGE(PG8_SA(0, 1), a2 + hstep, voffA);
            PG8_WAIT_V(8); PG8_WAIT_L(0); PG8_BAR; PG8_MMA(0, 0, At, B0); PG8_MMA(0, 1, At, B1); PG8_BAR; PG8_SCHED;
            PG8_LDA(At, 1, 1); PG8_STAGE(PG8_SB(1, 0), b3, voffB); PG8_STAGE(PG8_SB(1, 1), b3 + hstep, voffB); PG8_STAGE(PG8_SA(1, 0), a3, voffA);
            PG8_WAIT_V(8); PG8_WAIT_L(0); PG8_BAR; PG8_MMA(1, 0, At, B0); PG8_MMA(1, 1, At, B1); PG8_BAR; PG8_SCHED;
        }
        if constexpr (ALIGN_EPI) { if (wr == 0) PG8_BAR; }
        E(acc, cur, wr, wc, fr, fq);
        if (!has_next) break;
#pragma unroll
        for (int a = 0; a < 2; ++a)
#pragma unroll
            for (int b = 0; b < 2; ++b)
#pragma unroll
                for (int m = 0; m < 4; ++m)
#pragma unroll
                    for (int n = 0; n < 2; ++n) acc[a][b][m][n] = (f32x4){0.f, 0.f, 0.f, 0.f};
        cur = nxt; cA = nA; cB = nB; ++ui;
        if constexpr (ALIGN_EPI) { if (wr == 1) PG8_BAR; }
    }
    PG8_WAIT_V(0);
    if constexpr (!ALIGN_EPI) { if (wr == 0) PG8_BAR; }
    PG8_BAR;
#undef PG8_SA
#undef PG8_SB
#undef PG8_STAGE
#undef PG8_LDA
#undef PG8_LDB
#undef PG8_MMA
#undef PG8_WAIT_V
#undef PG8_WAIT_L
#undef PG8_BAR
#undef PG8_SCHED
}
}
using pg8::Unit;

struct TileMap {
    int nM, nN;
    __device__ __forceinline__ bool get(long L, int& pm, int& pn) const {
        if (L >= (long)nM * nN) return false;
        const int nig = 8 * nN, gid = (int)(L / nig), fm = gid * 8, gsz = (nM - fm) < 8 ? (nM - fm) : 8, r = (int)(L % nig);
        pm = fm + r % gsz; pn = r / gsz; return true;
    }
};

struct Args {
    const float* in[38];
    float* out; unsigned char* ws;
    double inv_rev[32];
    int ph_lo, ph_hi;
};

__device__ __forceinline__ void tr_item(const float* W, int N, int src_n0, bf16_t* WT, size_t ldw, int koff, int r0, int k0, LAS float* scr, int lane) {
    if (src_n0 >= 0) {
#pragma unroll 8
        for (int i = 0; i < 32; ++i) { const int kk = 2 * i + (lane >> 5); scr[kk * 33 + (lane & 31)] = W[(size_t)(k0 + kk) * N + src_n0 + (lane & 31)]; }
    } else {
#pragma unroll 8
        for (int i = 0; i < 32; ++i) { const int kk = 2 * i + (lane >> 5); scr[kk * 33 + (lane & 31)] = 0.f; }
    }
    asm volatile("s_waitcnt lgkmcnt(0)" ::: "memory");
    const int c = lane & 7;
#pragma unroll
    for (int j = 0; j < 4; ++j) { const int n = (lane >> 3) + 8 * j; const LAS float* s = scr + (8 * c) * 33 + n;
        u32x4 o; o.x = cvt_pk_bf16(s[0 * 33], s[1 * 33]); o.y = cvt_pk_bf16(s[2 * 33], s[3 * 33]); o.z = cvt_pk_bf16(s[4 * 33], s[5 * 33]); o.w = cvt_pk_bf16(s[6 * 33], s[7 * 33]);
        *(u32x4*)(WT + (size_t)(r0 + n) * ldw + koff + k0 + 8 * c) = o; }
    asm volatile("s_waitcnt lgkmcnt(0)" ::: "memory");
}
__device__ __forceinline__ void rms_row(const float* xrow, const float* g, bf16_t* orow, int lane) {
    f32x4 v[8]; float s = 0.f;
#pragma unroll
    for (int j = 0; j < 8; ++j) { v[j] = ((const f32x4*)xrow)[64 * j + lane]; s += (v[j].x * v[j].x + v[j].y * v[j].y) + (v[j].z * v[j].z + v[j].w * v[j].w); }
    const float rstd = rsqrtf(wave_sum(s) * (1.f / DM) + 1e-6f);
#pragma unroll
    for (int j = 0; j < 8; ++j) { const f32x4 gg = ((const f32x4*)g)[64 * j + lane];
        u32x2 w; w.x = cvt_pk_bf16(v[j].x * rstd * gg.x, v[j].y * rstd * gg.y); w.y = cvt_pk_bf16(v[j].z * rstd * gg.z, v[j].w * rstd * gg.w);
        ((u32x2*)orow)[64 * j + lane] = w; }
}

__device__ __forceinline__ void p0_prologue(const Args& a, LAS unsigned char* lds, int vcu, int G) {
    const int tid = threadIdx.x, lane = tid & 63, wave = tid >> 6;
    unsigned char* ws = a.ws;
    LAS float* scr = (LAS float*)(lds + wave * 16384);
    const int gw = vcu * 8 + wave, NGW = G * 8;
    constexpr int I0 = 32 * 240, I1 = 32 * 192, I2 = 32 * 64, I3 = 16 * 64, I6 = 32 * 64, I7 = 32 * 352, I8 = 88 * 64;
    constexpr int NITEMS = I0 + I1 + I2 + 3 * I3 + I6 + I7 + I8;
    for (int it = gw; it < NITEMS; it += NGW) {
        int r = it;
        if (r < I0) { const int kb = r / 240, nb = r % 240, r0 = nb * 32; int src;
            if (r0 < 2048) { const int tile = r0 >> 8, cp = r0 & 255, h = cp >> 7, g = (cp & 127) >> 5; src = tile * 256 + 64 * g + 32 * h; }
            else if (r0 < 6560) src = r0;
            else if (r0 < 6656) src = -1;
            else src = 6560 + (r0 - 6656);
            tr_item(a.in[5], 13728, src, (bf16_t*)(ws + WS_WIN), 2048, 0, r0, kb * 64, scr, lane); continue; } r -= I0;
        if (r < I1) { const int kb = r / 192, nb = r % 192; tr_item(a.in[5], 13728, 7584 + nb * 32, (bf16_t*)(ws + WS_WG), 2048, 0, nb * 32, kb * 64, scr, lane); continue; } r -= I1;
        if (r < I2) { const int kb = r / 64, nb = r % 64; tr_item(a.in[26], 2048, nb * 32, (bf16_t*)(ws + WS_WKV), 2048, 0, nb * 32, kb * 64, scr, lane); continue; } r -= I2;
        if (r < I3) { const int kb = r / 64, nb = r % 64; tr_item(a.in[29], 2048, nb * 32, (bf16_t*)(ws + WS_PAR), 2048, 0, nb * 32, kb * 64, scr, lane); continue; } r -= I3;
        if (r < I3) { const int kb = r / 64, nb = r % 64; tr_item(a.in[30], 2048, nb * 32, (bf16_t*)(ws + WS_PAR), 2048, 1024, nb * 32, kb * 64, scr, lane); continue; } r -= I3;
        if (r < I3) { const int kb = r / 64, nb = r % 64; tr_item(a.in[31], 2048, nb * 32, (bf16_t*)(ws + WS_PM2), 2048, 0, nb * 32, kb * 64, scr, lane); continue; } r -= I3;
        if (r < I6) { const int kb = r / 64, nb = r % 64; tr_item(a.in[32], 2048, nb * 32, (bf16_t*)(ws + WS_WO), 2048, 0, nb * 32, kb * 64, scr, lane); continue; } r -= I6;
        if (r < I7) { const int kb = r / 352, nb = r % 352, r0 = nb * 32, tile = r0 >> 8, bj = (r0 & 255) >> 7, j = r0 & 127;
            tr_item(a.in[34], 2 * DFF, bj * DFF + 128 * tile + j, (bf16_t*)(ws + WS_WUP), 2048, 0, r0, kb * 64, scr, lane); continue; } r -= I7;
        { const int kb = r / 64, nb = r % 64; tr_item(a.in[37], 2048, nb * 32, (bf16_t*)(ws + WS_WDN), DFF, 0, nb * 32, kb * 64, scr, lane); }
    }
    for (int m = gw; m < NT + 1280; m += NGW) {
        if (m < NT) { const float* xr = m < TP ? a.in[0] + (size_t)m * DM : a.in[1] + (size_t)(m - TP) * DM; rms_row(xr, a.in[4], (bf16_t*)(ws + WS_H) + (size_t)m * DM, lane); }
        else { const int j = m - NT; const float* xr = j < 256 ? a.in[2] + (size_t)j * DM : a.in[3] + (size_t)(j - 256) * DM; rms_row(xr, a.in[25], (bf16_t*)(ws + WS_MEMN) + (size_t)j * DM, lane); }
    }
    { float* rc = (float*)(ws + WS_ROPE); float* rs = rc + TP * 32;
      for (int e = (vcu * NTHR + tid); e < TP * 32; e += G * NTHR) { const int t = e >> 5, d = e & 31; double rev = (double)t * a.inv_rev[d]; rev -= rint(rev); const float rf = (float)rev;
          rc[e] = __builtin_amdgcn_cosf(rf); rs[e] = __builtin_amdgcn_sinf(rf); } }
    { bf16_t* g2t = (bf16_t*)(ws + WS_G2T); const float* G2 = a.in[19];
      for (int e = vcu * NTHR + tid; e < 1024 * 20; e += G * NTHR) { const int col = e / 20, kc = e - col * 20; float f[8];
#pragma unroll
          for (int i = 0; i < 8; ++i) f[i] = G2[(size_t)(kc * 8 + i) * 1024 + col];
          u32x4 w; w.x = cvt_pk_bf16(f[0], f[1]); w.y = cvt_pk_bf16(f[2], f[3]); w.z = cvt_pk_bf16(f[4], f[5]); w.w = cvt_pk_bf16(f[6], f[7]);
          *(u32x4*)(g2t + (size_t)col * 160 + kc * 8) = w; } }
    if (blockIdx.x == 0) {
        unsigned* ctl = (unsigned*)(ws + WS_CTL);
        if (tid < 64) {
            if (tid == 0) { ctl[CW_QUEUE] = 0u; ctl[256] = 0u; ctl[257] = 0u; }
            const float s1 = wave_sum(a.in[8][tid] * a.in[9][tid]), s2 = wave_sum(a.in[10][tid] * a.in[11][tid]);
            if (tid == 0) ((float*)ctl)[CW_LAM] = __expf(s1) - __expf(s2) + 0.2f;
            float gq = fabsf(a.in[6][tid]), gk = fabsf(a.in[7][tid]);
#pragma unroll
            for (int o = 1; o < 64; o <<= 1) { gq = fmaxf(gq, __shfl_xor(gq, o)); gk = fmaxf(gk, __shfl_xor(gk, o)); }
            if (tid == 0) ((float*)ctl)[CW_SMAX] = 64.f * 0.125f * 1.4426950408889634f * gq * gk;
        }
    }
}

struct SchedIn {
    int v, G; const char* H; const char* WIN; const char* MEMN; const char* WKV;
    __device__ __forceinline__ bool next(int i, Unit& u) const {
        long L = (long)i * G + v; int pm, pn;
        if (L < 5760) { TileMap{192, 30}.get(L, pm, pn); u.A = H + (size_t)pm * MiB; u.B = WIN + (size_t)pn * MiB; u.nt = 32; u.pm = pm; u.pn = pn; u.kind = 0; u.t0 = 0; u.T = 0; return true; }
        L -= 5760; if (L < 40) { pm = (int)(L % 5); pn = (int)(L / 5); u.A = MEMN + (size_t)pm * MiB; u.B = WKV + (size_t)pn * MiB; u.nt = 32; u.pm = pm; u.pn = pn; u.kind = 1; u.t0 = 0; u.T = 0; return true; }
        return false;
    }
};
struct EpiIn {
    bf16_t* QK; bf16_t* VM; bf16_t* ZR; bf16_t* KVM; const float* qn; const float* kn; const float* rc; const float* rs;
    __device__ __forceinline__ void plain(const f32x4 (&acc)[2][2][4][2], bf16_t* base, size_t ldc, int row0, int col0) const {
#pragma unroll
        for (int ai = 0; ai < 2; ++ai)
#pragma unroll
            for (int m = 0; m < 4; ++m) { bf16_t* rowp = base + (size_t)(row0 + ai * 128 + m * 16) * ldc + col0;
#pragma unroll
                for (int bj = 0; bj < 2; ++bj) { const f32x4 v0 = acc[ai][bj][m][0], v1 = acc[ai][bj][m][1];
                    u32x4 w; w.x = cvt_pk_bf16(v0[0], v0[1]); w.y = cvt_pk_bf16(v0[2], v0[3]); w.z = cvt_pk_bf16(v1[0], v1[1]); w.w = cvt_pk_bf16(v1[2], v1[3]);
                    *(u32x4*)(rowp + bj * 128) = w; } }
    }
    __device__ __forceinline__ void operator()(const f32x4 (&acc)[2][2][4][2], const Unit& u, int wr, int wc, int fr, int fq) const {
        const int row0 = u.pm * 256 + wr * 64 + fr, cin = wc * 32 + 8 * fq;
        if (u.kind == 1) { plain(acc, KVM, 2048, row0, u.pn * 256 + cin); return; }
        const int pn = u.pn;
        if (pn < 8) {
            const bool isq = pn < 4; const float* nw = isq ? qn : kn;
            const int Gq = (pn & 3) * 4 + wc, d0 = 8 * fq;
            const float qs = isq ? 0.125f * 1.4426950408889634f : 1.f;
            const f32x4 w1a = *(const f32x4*)(nw + d0), w1b = *(const f32x4*)(nw + d0 + 4), w2a = *(const f32x4*)(nw + 32 + d0), w2b = *(const f32x4*)(nw + 36 + d0);
            bf16_t* dst = QK + (isq ? 0 : 1024) + Gq * 64 + d0;
#pragma unroll
            for (int ai = 0; ai < 2; ++ai)
#pragma unroll
                for (int m = 0; m < 4; ++m) {
                    const int row = row0 + ai * 128 + m * 16, t = tok_pos(row);
                    const f32x4 xa = acc[ai][0][m][0], xb = acc[ai][0][m][1], ya = acc[ai][1][m][0], yb = acc[ai][1][m][1];
                    float ss = (xa[0] * xa[0] + xa[1] * xa[1]) + (xa[2] * xa[2] + xa[3] * xa[3]) + (xb[0] * xb[0] + xb[1] * xb[1]) + (xb[2] * xb[2] + xb[3] * xb[3])
                             + (ya[0] * ya[0] + ya[1] * ya[1]) + (ya[2] * ya[2] + ya[3] * ya[3]) + (yb[0] * yb[0] + yb[1] * yb[1]) + (yb[2] * yb[2] + yb[3] * yb[3]);
                    ss += __shfl_xor(ss, 16); ss += __shfl_xor(ss, 32);
                    const float rstd = rsqrtf(ss * (1.f / 64.f) + 1e-6f);
                    const f32x4 ca = *(const f32x4*)(rc + t * 32 + d0), cb = *(const f32x4*)(rc + t * 32 + d0 + 4), sa = *(const f32x4*)(rs + t * 32 + d0), sb = *(const f32x4*)(rs + t * 32 + d0 + 4);
                    const f32x4 x1a = xa * rstd * w1a, x1b = xb * rstd * w1b, x2a = ya * rstd * w2a, x2b = yb * rstd * w2b;
                    const f32x4 o1a = (x1a * ca - x2a * sa) * qs, o1b = (x1b * cb - x2b * sb) * qs, o2a = (x2a * ca + x1a * sa) * qs, o2b = (x2b * cb + x1b * sb) * qs;
                    u32x4 w; w.x = cvt_pk_bf16(o1a[0], o1a[1]); w.y = cvt_pk_bf16(o1a[2], o1a[3]); w.z = cvt_pk_bf16(o1b[0], o1b[1]); w.w = cvt_pk_bf16(o1b[2], o1b[3]);
                    *(u32x4*)(dst + (size_t)row * 2048) = w;
                    w.x = cvt_pk_bf16(o2a[0], o2a[1]); w.y = cvt_pk_bf16(o2a[2], o2a[3]); w.z = cvt_pk_bf16(o2b[0], o2b[1]); w.w = cvt_pk_bf16(o2b[2], o2b[3]);
                    *(u32x4*)(dst + (size_t)row * 2048 + 32) = w;
                }
        } else if (pn < 12) plain(acc, VM, 2048, row0, (pn - 8) * 256 + cin);
        else if (pn < 26) plain(acc, ZR, ZRP, row0, (pn - 12) * 256 + cin);
        else plain(acc, VM, 2048, row0, 1024 + (pn - 26) * 256 + cin);
    }
};

namespace att {
constexpr int SHM_V = 16384, SHM_K = 8192;
constexpr int OFF_V = 0, OFF_K = 32768, OFF_WS = 49152, OFF_STASH = 51200;
#define KSWZ64(row, colB) ((row) * 128 + ((colB) ^ (((row) & 7) << 4)))
#define SBAR() __builtin_amdgcn_sched_barrier(0)
__device__ __forceinline__ int crow(int r, int hi) { return (r & 3) + 8 * (r >> 2) + 4 * hi; }
constexpr float THRL = 8.f;
__device__ __forceinline__ void partialSM(f32x16& p0, f32x16& p1, float& m_reg, float& alpha) {
    float pmax = fmaxf(fmaxf(p0[0], p0[1]), p0[2]);
#pragma unroll
    for (int r = 3; r < 15; r += 2) pmax = fmaxf(fmaxf(pmax, p0[r]), p0[r + 1]);
    pmax = fmaxf(fmaxf(pmax, p0[15]), p1[0]);
#pragma unroll
    for (int r = 1; r < 15; r += 2) pmax = fmaxf(fmaxf(pmax, p1[r]), p1[r + 1]);
    pmax = fmaxf(pmax, p1[15]);
    { auto rr = __builtin_amdgcn_permlane32_swap(__float_as_uint(pmax), __float_as_uint(pmax), false, false);
      pmax = fmaxf(__uint_as_float(rr[0]), __uint_as_float(rr[1])); }
    if (__builtin_expect(__all(pmax <= THRL), 1)) { alpha = 1.f; }
    else { const float dl = fmaxf(pmax, 0.f); alpha = __builtin_amdgcn_exp2f(-dl); m_reg += dl;
#pragma unroll
        for (int r = 0; r < 16; ++r) { p0[r] -= dl; p1[r] -= dl; } }
#pragma unroll
    for (int r = 0; r < 16; ++r) p0[r] = __builtin_amdgcn_exp2f(p0[r]);
}
__device__ __forceinline__ void finishSM(f32x16& p0, f32x16& p1, float alpha, float& l_reg, bf16x8& pa0, bf16x8& pa1, bf16x8& pa2, bf16x8& pa3) {
#pragma unroll
    for (int r = 0; r < 16; ++r) p1[r] = __builtin_amdgcn_exp2f(p1[r]);
    f32x2 s2 = (f32x2){p0[0], p0[1]} + (f32x2){p1[0], p1[1]};
#pragma unroll
    for (int r = 2; r < 16; r += 2) { s2 = s2 + (f32x2){p0[r], p0[r + 1]}; s2 = s2 + (f32x2){p1[r], p1[r + 1]}; }
    float ps = s2[0] + s2[1];
    { auto rr = __builtin_amdgcn_permlane32_swap(__float_as_uint(ps), __float_as_uint(ps), false, false);
      ps = __uint_as_float(rr[0]) + __uint_as_float(rr[1]); }
    l_reg = l_reg * alpha + ps;
#define PK4(P, BASE, OUT) do { unsigned a0 = cvt_pk_bf16(P[BASE + 0], P[BASE + 1]), a1 = cvt_pk_bf16(P[BASE + 2], P[BASE + 3]);   \
    unsigned b0 = cvt_pk_bf16(P[BASE + 4], P[BASE + 5]), b1 = cvt_pk_bf16(P[BASE + 6], P[BASE + 7]);                              \
    auto r0 = __builtin_amdgcn_permlane32_swap(a0, b0, false, false); auto r1 = __builtin_amdgcn_permlane32_swap(a1, b1, false, false); \
    u32x4 w = {r0[0], r1[0], r0[1], r1[1]}; OUT = *reinterpret_cast<bf16x8*>(&w); } while (0)
    PK4(p0, 0, pa0); PK4(p0, 8, pa1); PK4(p1, 0, pa2); PK4(p1, 8, pa3);
#undef PK4
}
__device__ __forceinline__ void qkt64(f32x16& p0, f32x16& p1, const char* Ks, const bf16x8* qr, int r32, int hi) {
#pragma unroll
    for (int d0 = 0; d0 < 4; ++d0) { const int cb = (d0 * 16 + hi * 8) * 2;
        const bf16x8 b0 = *reinterpret_cast<const bf16x8*>(Ks + KSWZ64(r32, cb));
        const bf16x8 b1 = *reinterpret_cast<const bf16x8*>(Ks + KSWZ64(32 + r32, cb));
        p0 = __builtin_amdgcn_mfma_f32_32x32x16_bf16(b0, qr[d0], p0, 0, 0, 0);
        p1 = __builtin_amdgcn_mfma_f32_32x32x16_bf16(b1, qr[d0], p1, 0, 0, 0); }
}
__device__ __forceinline__ int v_st(int k, int c) { const int kk = (k & ~0xC) | ((k & 4) << 1) | ((k & 8) >> 1); return ((kk >> 3) * 4 + (c >> 5)) * 512 + ((kk & 7) * 32 + (c & 31)) * 2; }
__device__ __forceinline__ int v_rd_base(int lane) { return ((lane & 3) << 3) | (((lane >> 2) & 3) << 6) | (((lane >> 4) & 1) << 5) | (((lane >> 5) & 1) << 8); }
constexpr int v_rd_off(int d0, int ks, int half) { return d0 * 512 + ks * 4096 + half * 2048; }
template <int OFF> __device__ __forceinline__ s16x4 tr_read(int vb) {
    s16x4 r; asm volatile("ds_read_b64_tr_b16 %0, %1 offset:%2" : "=&v"(r) : "v"(vb), "i"(OFF) : "memory"); return r;
}
template <int KS> __device__ __forceinline__ void pv_ks(f32x16* o, int vb, bf16x8 pa) {
    const s16x4 l0 = tr_read<v_rd_off(0, KS, 0)>(vb), h0 = tr_read<v_rd_off(0, KS, 1)>(vb), l1 = tr_read<v_rd_off(1, KS, 0)>(vb), h1 = tr_read<v_rd_off(1, KS, 1)>(vb);
    const s16x4 l2 = tr_read<v_rd_off(2, KS, 0)>(vb), h2 = tr_read<v_rd_off(2, KS, 1)>(vb), l3 = tr_read<v_rd_off(3, KS, 0)>(vb), h3 = tr_read<v_rd_off(3, KS, 1)>(vb);
    asm volatile("s_waitcnt lgkmcnt(0)" ::: "memory"); SBAR();
#define PK(L, H) (bf16x8){L[0], L[1], L[2], L[3], H[0], H[1], H[2], H[3]}
    o[0] = __builtin_amdgcn_mfma_f32_32x32x16_bf16(pa, PK(l0, h0), o[0], 0, 0, 0);
    o[1] = __builtin_amdgcn_mfma_f32_32x32x16_bf16(pa, PK(l1, h1), o[1], 0, 0, 0);
    o[2] = __builtin_amdgcn_mfma_f32_32x32x16_bf16(pa, PK(l2, h2), o[2], 0, 0, 0);
    o[3] = __builtin_amdgcn_mfma_f32_32x32x16_bf16(pa, PK(l3, h3), o[3], 0, 0, 0);
#undef PK
}
__device__ __forceinline__ void pv_d0(f32x16* o, int vb, bf16x8 pa0, bf16x8 pa1, bf16x8 pa2, bf16x8 pa3) {
    pv_ks<0>(o, vb, pa0); pv_ks<1>(o, vb, pa1); pv_ks<2>(o, vb, pa2); pv_ks<3>(o, vb, pa3);
}

__device__ __forceinline__ void stash_store(const unsigned* stash, bf16_t* Ow, int ldo, int lane) {
#pragma unroll
    for (int i = 0; i < 8; ++i) { const int q = i * 64 + lane, rl = q >> 4, c8 = (q & 15) * 8, hh = (rl >> 2) & 1, r = (rl & 3) + 4 * (rl >> 3), d0 = c8 >> 5, cc = c8 & 31;
        const unsigned* sp = stash + (d0 * 8 + (r >> 1)) * 64 + hh * 32 + cc; const u32x4 a = *(const u32x4*)sp, b = *(const u32x4*)(sp + 4);
        u32x4 w;
        if (r & 1) { w.x = (a.x >> 16) | (a.y & 0xffff0000u); w.y = (a.z >> 16) | (a.w & 0xffff0000u); w.z = (b.x >> 16) | (b.y & 0xffff0000u); w.w = (b.z >> 16) | (b.w & 0xffff0000u); }
        else { w.x = (a.x & 0xffffu) | (a.y << 16); w.y = (a.z & 0xffffu) | (a.w << 16); w.z = (b.x & 0xffffu) | (b.y << 16); w.w = (b.z & 0xffffu) | (b.w << 16); }
        *(u32x4*)(Ow + (size_t)rl * ldo + c8) = w; }
}

template <bool FX> __device__ __forceinline__ void diff_unit(int s, int h, int qb, bf16_t* QK, const bf16_t* VM, float lam, char* lds) {
    constexpr int LDK = 2048;
    int tid = threadIdx.x; asm volatile("" : "+v"(tid));
    const int wid = __builtin_amdgcn_readfirstlane(tid >> 6), lane = tid & 63, r32 = lane & 31, hi = lane >> 5;
    const int tok0 = seq_start(s), T = seq_len(s), NTL = T / 64;
    char* V_lds = lds + OFF_V; char* K_lds = lds + OFF_K;
    float* wsf = (float*)(lds + OFF_WS) + wid * 64; float* li_l = wsf; float* al_l = wsf + 32;
    unsigned* stash = (unsigned*)(lds + OFF_STASH) + wid * 2048;
    const int sr = tid >> 4, sc = (tid & 15) * 8, vst0 = v_st(sr, sc), vst1 = v_st(32 + sr, sc);
    const int kr = tid >> 3, kc = (tid & 7) * 8, kst = KSWZ64(kr, kc * 2);
    const int vb0 = (int)(uintptr_t)V_lds + v_rd_base(lane);
    const bf16_t* Vh = VM + (size_t)tok0 * LDK + h * 128;
    const size_t qrow = (size_t)(tok0 + qb * 256 + wid * 32);
#pragma unroll 1
    for (int c = 0; c < 2; ++c) {
        const bf16_t* Kh = QK + (size_t)tok0 * LDK + 1024 + h * 128 + c * 64;
        const bf16_t* Qw = QK + (qrow + r32) * LDK + h * 128 + c * 64 + hi * 8;
        bf16x8 qr[4];
#pragma unroll
        for (int d0 = 0; d0 < 4; ++d0) qr[d0] = *reinterpret_cast<const bf16x8*>(Qw + d0 * 16);
        float m_reg = 0.f, l_reg = 0; f32x16 o[4] = {};
        struct { bf16x8 vs0, vs1, ks0; } sr_[2];
#define NEGM(P) do { const float nm_ = FX ? 0.f : -m_reg; _Pragma("unroll") for (int r_ = 0; r_ < 16; ++r_) P[r_] = nm_; } while (0)
#define PSM(P0, P1, AL) do { if constexpr (FX) { AL = 1.f; _Pragma("unroll") for (int r_ = 0; r_ < 16; ++r_) P0[r_] = __builtin_amdgcn_exp2f(P0[r_]); } else partialSM(P0, P1, m_reg, AL); } while (0)
#define SLOAD(i, k0) do { sr_[i].vs0 = *reinterpret_cast<const bf16x8*>(&Vh[(size_t)((k0) + sr) * LDK + sc]); sr_[i].vs1 = *reinterpret_cast<const bf16x8*>(&Vh[(size_t)((k0) + 32 + sr) * LDK + sc]); \
    sr_[i].ks0 = *reinterpret_cast<const bf16x8*>(&Kh[(size_t)((k0) + kr) * LDK + kc]); } while (0)
#define SWRITE(b, i) do { *(bf16x8*)(V_lds + (b) * SHM_V + vst0) = sr_[i].vs0; *(bf16x8*)(V_lds + (b) * SHM_V + vst1) = sr_[i].vs1; *(bf16x8*)(K_lds + (b) * SHM_K + kst) = sr_[i].ks0; } while (0)
#define SWAIT() asm volatile("s_waitcnt vmcnt(3)" ::: "memory")
#define RESC(a) do { if (!FX && __any((a) < 1.f)) { if (hi == 0) al_l[r32] = (a); asm volatile("s_waitcnt lgkmcnt(0)" ::: "memory"); \
    _Pragma("unroll") for (int d = 0; d < 4; ++d) _Pragma("unroll") for (int r = 0; r < 16; ++r) o[d][r] *= al_l[crow(r, hi)]; } } while (0)
        f32x16 pA0, pA1, pB0, pB1; float alA, alB; bf16x8 pa0, pa1, pa2, pa3;
        SLOAD(0, 0); asm volatile("s_waitcnt vmcnt(0)" ::: "memory"); SWRITE(0, 0); __syncthreads();
        NEGM(pA0); NEGM(pA1); qkt64(pA0, pA1, K_lds, qr, r32, hi); PSM(pA0, pA1, alA);
        SLOAD(1, 64); if (2 < NTL) SLOAD(0, 128);
        SWAIT(); SWRITE(1, 1); __syncthreads();
        for (int j = 1; j + 1 < NTL; j += 2) {
            SBAR(); NEGM(pB0); NEGM(pB1); qkt64(pB0, pB1, K_lds + SHM_K, qr, r32, hi);
            finishSM(pA0, pA1, alA, l_reg, pa0, pa1, pa2, pa3); SBAR();
            SLOAD(1, (j + 2) * 64); SBAR();
            pv_d0(o, vb0, pa0, pa1, pa2, pa3); PSM(pB0, pB1, alB);
            __syncthreads(); SWAIT(); SWRITE(0, 0);
            RESC(alB); __syncthreads();
            SBAR(); NEGM(pA0); NEGM(pA1); qkt64(pA0, pA1, K_lds, qr, r32, hi);
            finishSM(pB0, pB1, alB, l_reg, pa0, pa1, pa2, pa3); SBAR();
            if (j + 3 < NTL) SLOAD(0, (j + 3) * 64); SBAR();
            pv_d0(o, vb0 + SHM_V, pa0, pa1, pa2, pa3); PSM(pA0, pA1, alA);
            __syncthreads(); SWAIT(); SWRITE(1, 1);
            RESC(alA); __syncthreads();
        }
        SBAR(); NEGM(pB0); NEGM(pB1); qkt64(pB0, pB1, K_lds + SHM_K, qr, r32, hi);
        finishSM(pA0, pA1, alA, l_reg, pa0, pa1, pa2, pa3); SBAR();
        pv_d0(o, vb0, pa0, pa1, pa2, pa3); PSM(pB0, pB1, alB);
        __syncthreads(); RESC(alB);
        finishSM(pB0, pB1, alB, l_reg, pa0, pa1, pa2, pa3); SBAR();
        pv_d0(o, vb0 + SHM_V, pa0, pa1, pa2, pa3);
#undef SLOAD
#undef SWRITE
#undef SWAIT
#undef RESC
#undef NEGM
#undef PSM
        if (hi == 0) li_l[r32] = l_reg; asm volatile("s_waitcnt lgkmcnt(0)" ::: "memory");
        float rli[16];
#pragma unroll
        for (int r = 0; r < 16; ++r) rli[r] = __builtin_amdgcn_rcpf(li_l[crow(r, hi)]);
        { const float coef = c == 0 ? 1.f : -lam;
#pragma unroll
          for (int d0 = 0; d0 < 4; ++d0)
#pragma unroll
              for (int r = 0; r < 16; r += 2) { const int idx = (d0 * 8 + (r >> 1)) * 64 + lane; const unsigned w = c == 0 ? 0u : stash[idx];
                  stash[idx] = cvt_pk_bf16(bflo(w) + coef * o[d0][r] * rli[r], bfhi(w) + coef * o[d0][r + 1] * rli[r + 1]); } }
        __syncthreads();
    }
    stash_store(stash, QK + qrow * LDK + h * 128, LDK, lane);
    __syncthreads();
}

constexpr int MOFF_V = 0, MOFF_K = 32768, MOFF_WS = 65536, MOFF_RK = 67584, MOFF_G = 68608, MOFF_STASH = 69632;
__device__ __forceinline__ void mem_unit(int s, int mh, int qb, bf16_t* VM, const bf16_t* KVM, const float* mqn, const float* mkn, char* lds) {
    int tid = threadIdx.x; asm volatile("" : "+v"(tid));
    const int wid = __builtin_amdgcn_readfirstlane(tid >> 6), lane = tid & 63, r32 = lane & 31, hi = lane >> 5;
    const int tok0 = seq_start(s);
    char* V_lds = lds + MOFF_V; char* K_lds = lds + MOFF_K;
    float* wsf = (float*)(lds + MOFF_WS) + wid * 64; float* li_l = wsf; float* al_l = wsf + 32;
    float* rk_l = (float*)(lds + MOFF_RK); float* g_l = (float*)(lds + MOFF_G);
    const bf16_t* Kh = KVM + (size_t)(s * 256) * 2048 + mh * 256;
    const bf16_t* Vh = KVM + (size_t)(s * 256) * 2048 + 1024 + mh * 256;
    if (tid < 256) g_l[tid] = mqn[tid] * mkn[tid];
    {
        const bf16_t* kp = Kh + (size_t)(wid * 32 + r32) * 2048 + hi * 128; float ss = 0.f;
#pragma unroll
        for (int i = 0; i < 16; ++i) { const u32x4 w = *(const u32x4*)(kp + i * 8);
            ss += bflo(w.x) * bflo(w.x) + bfhi(w.x) * bfhi(w.x) + bflo(w.y) * bflo(w.y) + bfhi(w.y) * bfhi(w.y) + bflo(w.z) * bflo(w.z) + bfhi(w.z) * bfhi(w.z) + bflo(w.w) * bflo(w.w) + bfhi(w.w) * bfhi(w.w); }
        ss += __shfl_xor(ss, 32);
        if (hi == 0) rk_l[wid * 32 + r32] = rsqrtf(ss * (1.f / 256.f) + 1e-6f);
    }
    const size_t qrow = (size_t)(tok0 + qb * 256 + wid * 32);
    bf16_t* Qw = VM + (qrow + r32) * 2048 + 1024 + mh * 256 + hi * 8;
    float rqC;
    { float ss = 0.f;
#pragma unroll
      for (int i = 0; i < 16; ++i) { const u32x4 w = *(const u32x4*)(Qw + i * 16);
          ss += bflo(w.x) * bflo(w.x) + bfhi(w.x) * bfhi(w.x) + bflo(w.y) * bflo(w.y) + bfhi(w.y) * bfhi(w.y) + bflo(w.z) * bflo(w.z) + bfhi(w.z) * bfhi(w.z) + bflo(w.w) * bflo(w.w) + bfhi(w.w) * bfhi(w.w); }
      ss += __shfl_xor(ss, 32);
      rqC = rsqrtf(ss * (1.f / 256.f) + 1e-6f) * (0.0625f * 1.4426950408889634f); }
    const int sr = tid >> 4, sc = (tid & 15) * 8, vst0 = v_st(sr, sc), vst1 = v_st(32 + sr, sc);
    const int kr = tid >> 3, kc = (tid & 7) * 8, kst = KSWZ64(kr, kc * 2);
    const int vb0 = (int)(uintptr_t)V_lds + v_rd_base(lane);
    unsigned* stash = (unsigned*)(lds + MOFF_STASH) + wid * 2048;
    __syncthreads();
#pragma unroll 1
    for (int hv = 0; hv < 2; ++hv) {
    float m_reg = -1e30f, l_reg = 0.f; f32x16 o[4] = {};
#pragma unroll 1
    for (int t = 0; t < 4; ++t) {
        const int k0 = t * 64;
#pragma unroll
        for (int ds = 0; ds < 4; ++ds) { const u32x4 w = *(const u32x4*)(Kh + (size_t)(k0 + kr) * 2048 + ds * 64 + kc); const float* g = g_l + ds * 64 + kc;
            u32x4 o4; o4.x = cvt_pk_bf16(bflo(w.x) * g[0], bfhi(w.x) * g[1]); o4.y = cvt_pk_bf16(bflo(w.y) * g[2], bfhi(w.y) * g[3]);
            o4.z = cvt_pk_bf16(bflo(w.z) * g[4], bfhi(w.z) * g[5]); o4.w = cvt_pk_bf16(bflo(w.w) * g[6], bfhi(w.w) * g[7]);
            *(u32x4*)(K_lds + ds * 8192 + kst) = o4; asm volatile("" ::: "memory"); }
        *(u32x4*)(V_lds + vst0) = *(const u32x4*)(Vh + (size_t)(k0 + sr) * 2048 + hv * 128 + sc);
        *(u32x4*)(V_lds + vst1) = *(const u32x4*)(Vh + (size_t)(k0 + 32 + sr) * 2048 + hv * 128 + sc);
        __syncthreads();
        f32x16 p0 = {}, p1 = {};
#pragma unroll
        for (int ds = 0; ds < 4; ++ds) { bf16x8 qr[4];
#pragma unroll
            for (int d0 = 0; d0 < 4; ++d0) qr[d0] = *reinterpret_cast<const bf16x8*>(Qw + ds * 64 + d0 * 16);
            qkt64(p0, p1, K_lds + ds * 8192, qr, r32, hi); }
#pragma unroll
        for (int r = 0; r < 16; ++r) { p0[r] *= rk_l[k0 + crow(r, hi)] * rqC; p1[r] *= rk_l[k0 + 32 + crow(r, hi)] * rqC; }
        float pmax = p0[0];
#pragma unroll
        for (int r = 1; r < 16; ++r) pmax = fmaxf(pmax, p0[r]);
#pragma unroll
        for (int r = 0; r < 16; ++r) pmax = fmaxf(pmax, p1[r]);
        pmax = fmaxf(pmax, __shfl_xor(pmax, 32));
        const float mn = fmaxf(m_reg, pmax), alpha = __builtin_amdgcn_exp2f(m_reg - mn); m_reg = mn;
        float ps = 0.f;
#pragma unroll
        for (int r = 0; r < 16; ++r) { p0[r] = __builtin_amdgcn_exp2f(p0[r] - mn); p1[r] = __builtin_amdgcn_exp2f(p1[r] - mn); ps += p0[r] + p1[r]; }
        ps += __shfl_xor(ps, 32);
        l_reg = l_reg * alpha + ps;
        if (hi == 0) al_l[r32] = alpha; asm volatile("s_waitcnt lgkmcnt(0)" ::: "memory");
#pragma unroll
        for (int d = 0; d < 4; ++d)
#pragma unroll
            for (int r = 0; r < 16; ++r) o[d][r] *= al_l[crow(r, hi)];
        bf16x8 pa0, pa1, pa2, pa3;
#define PK4(P, BASE, OUT) do { unsigned a0 = cvt_pk_bf16(P[BASE + 0], P[BASE + 1]), a1 = cvt_pk_bf16(P[BASE + 2], P[BASE + 3]);   \
    unsigned b0 = cvt_pk_bf16(P[BASE + 4], P[BASE + 5]), b1 = cvt_pk_bf16(P[BASE + 6], P[BASE + 7]);                              \
    auto r0 = __builtin_amdgcn_permlane32_swap(a0, b0, false, false); auto r1 = __builtin_amdgcn_permlane32_swap(a1, b1, false, false); \
    u32x4 w = {r0[0], r1[0], r0[1], r1[1]}; OUT = *reinterpret_cast<bf16x8*>(&w); } while (0)
        PK4(p0, 0, pa0); PK4(p0, 8, pa1); PK4(p1, 0, pa2); PK4(p1, 8, pa3);
#undef PK4
        pv_d0(o, vb0, pa0, pa1, pa2, pa3);
        __syncthreads();
    }
    if (hi == 0) li_l[r32] = l_reg; asm volatile("s_waitcnt lgkmcnt(0)" ::: "memory");
    if (hv == 1) stash_store(stash, VM + qrow * 2048 + 1024 + mh * 256, 2048, lane);
#pragma unroll
    for (int d0 = 0; d0 < 4; ++d0)
#pragma unroll
        for (int r = 0; r < 16; r += 2) stash[(d0 * 8 + (r >> 1)) * 64 + lane] = cvt_pk_bf16(o[d0][r] * __builtin_amdgcn_rcpf(li_l[crow(r, hi)]), o[d0][r + 1] * __builtin_amdgcn_rcpf(li_l[crow(r + 1, hi)]));
    }
    stash_store(stash, VM + qrow * 2048 + 1024 + mh * 256 + 128, 2048, lane);
    __syncthreads();
}
#undef SBAR
}

namespace scan {
constexpr int TC = 32;
typedef _Float16 h2 __attribute__((ext_vector_type(2)));
typedef _Float16 h4 __attribute__((ext_vector_type(4)));
typedef _Float16 h8 __attribute__((ext_vector_type(8)));
constexpr int BUFB = 36864, O_R = 0, O_KD = 4096, O_KK = 8192, O_W = 12288, O_KA = 16384, O_V = 20480, O_Y = 28672;
constexpr int O_PRIV = 73728;
constexpr int O_TBL = 73728 + 32768;
__device__ __forceinline__ float dpp_red8(float x) {
    x += __uint_as_float(__builtin_amdgcn_update_dpp(0u, __float_as_uint(x), 0xB1, 0xf, 0xf, false));
    x += __uint_as_float(__builtin_amdgcn_update_dpp(0u, __float_as_uint(x), 0x4E, 0xf, 0xf, false));
    x += __uint_as_float(__builtin_amdgcn_update_dpp(0u, __float_as_uint(x), 0x141, 0xf, 0xf, false));
    return x;
}
template <int DIR> __device__ __forceinline__ void scan_chunk(const char* B_, h2 (&S)[2][4], int seg, int row0) {
    const char* base = B_ + seg * 16; const char* vbase = B_ + O_V + row0 * 4; char* ybase = (char*)B_ + O_Y + row0 * 4;
    u32x4 ck[2], cw[2], ca[2], cd[2], cr[2]; u32x2 cv[2];
#define LDSET(set, tl_) do { ck[set] = *(const u32x4*)(base + O_KK + (tl_) * 128); cw[set] = *(const u32x4*)(base + O_W + (tl_) * 128); ca[set] = *(const u32x4*)(base + O_KA + (tl_) * 128); \
    cd[set] = *(const u32x4*)(base + O_KD + (tl_) * 128); cr[set] = *(const u32x4*)(base + O_R + (tl_) * 128); cv[set] = *(const u32x2*)(vbase + (tl_) * 256); } while (0)
#define H2(u) __builtin_bit_cast(h2, (u))
    LDSET(0, DIR ? TC - 1 : 0);
#pragma unroll
    for (int st = 0; st < TC; ++st) {
        const int tl = DIR ? TC - 1 - st : st, cs = st & 1;
        if (st + 1 < TC) LDSET(cs ^ 1, DIR ? TC - 2 - st : st + 1);
#define SPLIT4(V, A0, A1, A2, A3) const h8 V##8 = __builtin_bit_cast(h8, V[cs]); const h2 A0 = __builtin_shufflevector(V##8, V##8, 0, 1), A1 = __builtin_shufflevector(V##8, V##8, 2, 3), \
    A2 = __builtin_shufflevector(V##8, V##8, 4, 5), A3 = __builtin_shufflevector(V##8, V##8, 6, 7)
        SPLIT4(ck, k0, k1, k2, k3); SPLIT4(cw, w0, w1, w2, w3); SPLIT4(ca, a0, a1, a2, a3); SPLIT4(cd, d0, d1, d2, d3); SPLIT4(cr, r0, r1, r2, r3);
#undef SPLIT4
        const h4 cv4 = __builtin_bit_cast(h4, cv[cs]);
        f32x2 yo;
#pragma unroll
        for (int h = 0; h < 2; ++h) {
            const h2 vv = h == 0 ? __builtin_shufflevector(cv4, cv4, 0, 1) : __builtin_shufflevector(cv4, cv4, 2, 3);
            float d = __builtin_amdgcn_fdot2(S[h][0], k0, 0.f, false); float e = __builtin_amdgcn_fdot2(S[h][2], k2, 0.f, false);
            d = __builtin_amdgcn_fdot2(S[h][1], k1, d, false); e = __builtin_amdgcn_fdot2(S[h][3], k3, e, false);
            d = dpp_red8(d + e);
            const h2 p0 = S[h][0] * w0 + vv * d0, p1 = S[h][1] * w1 + vv * d1, p2 = S[h][2] * w2 + vv * d2, p3 = S[h][3] * w3 + vv * d3;
            const _Float16 sh = (_Float16)(-d); const h2 sa = {sh, sh};
            S[h][0] = p0 + sa * a0; S[h][1] = p1 + sa * a1; S[h][2] = p2 + sa * a2; S[h][3] = p3 + sa * a3;
            float y = __builtin_amdgcn_fdot2(S[h][0], r0, 0.f, false); float z = __builtin_amdgcn_fdot2(S[h][2], r2, 0.f, false);
            y = __builtin_amdgcn_fdot2(S[h][1], r1, y, false); z = __builtin_amdgcn_fdot2(S[h][3], r3, z, false);
            yo[h] = dpp_red8(y + z);
        }
        if (seg == 0) *(f32x2*)(ybase + tl * 256) = yo;
    }
#undef LDSET
#undef H2
}
__device__ __forceinline__ unsigned pkh(float a, float b) { const h2 v = {(_Float16)a, (_Float16)b}; return __builtin_bit_cast(unsigned, v); }
struct P {
    const bf16_t* ZR; bf16_t* YB; float* BON;
    const float *mup, *mun, *w0, *w2, *a0, *a2, *kk_w, *ka_w, *rk_w;
};
__device__ __forceinline__ void job(int s, int dir, int head, const P& p, char* lds) {
    int tid = threadIdx.x; asm volatile("" : "+v"(tid));
    const int wid = __builtin_amdgcn_readfirstlane(tid >> 6), lane = tid & 63;
    const int tok0 = seq_start(s), T = seq_len(s), NCH = T / TC;
    float* TBL = (float*)(lds + O_TBL);
    float* MUP = TBL; float* MUN = TBL + 320; float* KKW = TBL + 640; float* KAW = TBL + 704; float* RKW = TBL + 768; float* BW = TBL + 832; float* BA = TBL + 896;
    __syncthreads();
    if (tid < 320) { const int which = tid >> 6, j = tid & 63; const int col = which < 3 ? which * 1024 + head * 64 + j : (which == 3 ? 3072 : 3200) + dir * 64 + j; MUP[tid] = p.mup[col]; MUN[tid] = p.mun[col]; }
    if (tid >= 320 && tid < 384) { const int j = tid - 320; KKW[j] = p.kk_w[head * 64 + j]; KAW[j] = p.ka_w[head * 64 + j]; RKW[j] = p.rk_w[head * 64 + j];
        BW[j] = p.w0[dir * 1024 + head * 64 + j]; BA[j] = p.a0[dir * 1024 + head * 64 + j]; }
    bf16_t* yb = p.YB + (size_t)dir * NT * 1024; float* bon = p.BON + (size_t)dir * NT * 16;
    if (wid >= 4) {
        const int pw = wid - 4;
        char* priv = lds + O_PRIV + pw * 8192;
        bf16_t* AWl = (bf16_t*)priv; bf16_t* AAl = AWl + 512; float* PK = (float*)(priv + 2048); float* PA = (float*)(priv + 4096); float* PR = (float*)(priv + 6144);
        bf16x8 Bf[2][4][2];
#pragma unroll
        for (int mat = 0; mat < 2; ++mat)
#pragma unroll
            for (int cbk = 0; cbk < 4; ++cbk)
#pragma unroll
                for (int ks = 0; ks < 2; ++ks) { const float* W2 = (mat == 0 ? p.w2 : p.a2) + (size_t)dir * 64 * 1024 + head * 64 + cbk * 16 + (lane & 15) + (size_t)(ks * 32 + (lane >> 4) * 8) * 1024;
                    float f[8];
#pragma unroll
                    for (int e = 0; e < 8; ++e) f[e] = W2[(size_t)e * 1024];
                    u32x4 w; w.x = cvt_pk_bf16(f[0], f[1]); w.y = cvt_pk_bf16(f[2], f[3]); w.z = cvt_pk_bf16(f[4], f[5]); w.w = cvt_pk_bf16(f[6], f[7]); Bf[mat][cbk][ks] = *reinterpret_cast<bf16x8*>(&w); }
        __syncthreads();
        const int pt = tid - 256;
        u32x4 zc[5], zm[5], zn[5];
#define PLOAD(cc) do { const int tf_ = dir ? T - TC * ((cc) + 1) : TC * (cc); \
    _Pragma("unroll") for (int k = 0; k < 5; ++k) { const int which = k, tl8 = lane >> 3, j0 = (lane & 7) * 8; \
        const int col = which < 3 ? which * 1024 + head * 64 + j0 : (which == 3 ? 3072 : 3200) + dir * 64 + j0; \
        const int t = tf_ + 8 * pw + tl8; const bf16_t* zp = p.ZR + (size_t)(tok0 + t) * ZRP + col; \
        zc[k] = *(const u32x4*)zp; zm[k] = (u32x4){0u, 0u, 0u, 0u}; zn[k] = (u32x4){0u, 0u, 0u, 0u}; \
        if (t > 0) zm[k] = *(const u32x4*)(zp - ZRP); \
        if (t < T - 1) zn[k] = *(const u32x4*)(zp + ZRP); } } while (0)
        PLOAD(0);
        for (int c = -1; c < NCH; ++c) {
            if (c >= 1) { const int cb_ = (c - 1) & 1, tf = dir ? T - TC * c : TC * (c - 1); const int tl = pt >> 3, c8 = (pt & 7) * 8;
                const float* yp = (const float*)(lds + cb_ * BUFB + O_Y) + tl * 64 + c8; const f32x4 y4 = *(const f32x4*)yp, y5 = *(const f32x4*)(yp + 4);
                u32x4 w; w.x = cvt_pk_bf16(y4[0], y4[1]); w.y = cvt_pk_bf16(y4[2], y4[3]); w.z = cvt_pk_bf16(y5[0], y5[1]); w.w = cvt_pk_bf16(y5[2], y5[3]);
                *(u32x4*)(yb + (size_t)(tok0 + tf + tl) * 1024 + head * 64 + c8) = w; }
            if (c + 1 < NCH) {
                const int nb = (c + 1) & 1, tfirst = dir ? T - TC * (c + 2) : TC * (c + 1);
                char* B_ = lds + nb * BUFB;
#pragma unroll
                for (int k = 0; k < 5; ++k) { const int which = k, tl8 = lane >> 3, j0 = (lane & 7) * 8, tl = 8 * pw + tl8;
                    const f32x4 mpa = *(const f32x4*)(MUP + which * 64 + j0), mpb = *(const f32x4*)(MUP + which * 64 + j0 + 4), mna = *(const f32x4*)(MUN + which * 64 + j0), mnb = *(const f32x4*)(MUN + which * 64 + j0 + 4);
                    const u32x4 z = zc[k], zmm = zm[k], znn = zn[k];
                    float v[8];
#define SH(i, zw, zmw, znw, lohi, mp_, mn_) { const float zz = lohi(zw), a_ = lohi(zmw), b_ = lohi(znw); v[i] = zz + mp_ * (a_ - zz) + mn_ * (b_ - zz); }
                    SH(0, z.x, zmm.x, znn.x, bflo, mpa[0], mna[0]) SH(1, z.x, zmm.x, znn.x, bfhi, mpa[1], mna[1]) SH(2, z.y, zmm.y, znn.y, bflo, mpa[2], mna[2]) SH(3, z.y, zmm.y, znn.y, bfhi, mpa[3], mna[3])
                    SH(4, z.z, zmm.z, znn.z, bflo, mpb[0], mnb[0]) SH(5, z.z, zmm.z, znn.z, bfhi, mpb[1], mnb[1]) SH(6, z.w, zmm.w, znn.w, bflo, mpb[2], mnb[2]) SH(7, z.w, zmm.w, znn.w, bfhi, mpb[3], mnb[3])
#undef SH
                    if (which < 2) { float* dst = (which == 0 ? PR : PK) + tl8 * 64 + j0;
                        *(f32x4*)dst = (f32x4){v[0], v[1], v[2], v[3]}; *(f32x4*)(dst + 4) = (f32x4){v[4], v[5], v[6], v[7]}; }
                    else if (which == 2) { unsigned* dst = (unsigned*)(B_ + O_V) + tl * 64 + j0;
                        *(u32x4*)dst = (u32x4){pkh(v[0], v[0]), pkh(v[1], v[1]), pkh(v[2], v[2]), pkh(v[3], v[3])}; *(u32x4*)(dst + 4) = (u32x4){pkh(v[4], v[4]), pkh(v[5], v[5]), pkh(v[6], v[6]), pkh(v[7], v[7])}; }
                    else { if (which == 3) {
#pragma unroll
                            for (int i = 0; i < 8; ++i) { const float e2 = __expf(2.f * v[i]); v[i] = 1.f - 2.f * __builtin_amdgcn_rcpf(e2 + 1.f); } }
                        u32x4 w; w.x = cvt_pk_bf16(v[0], v[1]); w.y = cvt_pk_bf16(v[2], v[3]); w.z = cvt_pk_bf16(v[4], v[5]); w.w = cvt_pk_bf16(v[6], v[7]);
                        *(u32x4*)((which == 3 ? AWl : AAl) + tl8 * 64 + j0) = w; }
                }
                if (c + 2 < NCH) PLOAD(c + 2);
                { const int tj = lane & 7, kq = lane >> 4;
#pragma unroll
                  for (int mat = 0; mat < 2; ++mat) { const bf16_t* Am = (mat == 0 ? AWl : AAl) + tj * 64 + kq * 8;
                      const bf16x8 y0 = *reinterpret_cast<const bf16x8*>(Am), y1 = *reinterpret_cast<const bf16x8*>(Am + 32);
#pragma unroll
                      for (int cbk = 0; cbk < 4; ++cbk) { f32x4 acc = {0.f, 0.f, 0.f, 0.f};
                          acc = __builtin_amdgcn_mfma_f32_16x16x32_bf16(Bf[mat][cbk][0], y0, acc, 0, 0, 0);
                          acc = __builtin_amdgcn_mfma_f32_16x16x32_bf16(Bf[mat][cbk][1], y1, acc, 0, 0, 0);
                          const int col = cbk * 16 + 4 * kq; const f32x4 bias = *(const f32x4*)((mat == 0 ? BW : BA) + col); f32x4 res;
#pragma unroll
                          for (int r = 0; r < 4; ++r) { const float u = acc[r] + bias[r];
                              const float sg = __builtin_amdgcn_rcpf(1.f + __expf(-u));
                              res[r] = mat == 0 ? __expf(-0.60653065971263342f * sg) : sg; }
                          if ((lane & 15) < 8) { if (mat == 0) *(u32x2*)((_Float16*)(B_ + O_W) + (8 * pw + tj) * 64 + col) = (u32x2){pkh(res[0], res[1]), pkh(res[2], res[3])};
                                                 else *(f32x4*)(PA + tj * 64 + col) = res; } } } }
                { const int t8 = lane >> 3, tl = 8 * pw + t8, c0 = (lane & 7) * 8; const int o = t8 * 64 + c0;
                  float bs = 0.f, ss = 0.f; f32x4 kr[2], k4[2], a4[2], r4[2];
#pragma unroll
                  for (int q = 0; q < 2; ++q) { k4[q] = *(const f32x4*)(PK + o + 4 * q); a4[q] = *(const f32x4*)(PA + o + 4 * q); r4[q] = *(const f32x4*)(PR + o + 4 * q);
                      kr[q] = k4[q] * *(const f32x4*)(KKW + c0 + 4 * q); ss += (kr[q][0] * kr[q][0] + kr[q][1] * kr[q][1]) + (kr[q][2] * kr[q][2] + kr[q][3] * kr[q][3]); }
                  ss = dpp_red8(ss);
                  const float inv = __builtin_amdgcn_rsqf(fmaxf(ss, 1e-24f));
                  f32x4 kk[2], kd[2], kka[2];
#pragma unroll
                  for (int q = 0; q < 2; ++q) { kk[q] = kr[q] * inv; kd[q] = k4[q] * (1.f + (a4[q] - 1.f) * *(const f32x4*)(KAW + c0 + 4 * q)); kka[q] = kk[q] * a4[q];
                      const f32x4 bb = r4[q] * kd[q] * *(const f32x4*)(RKW + c0 + 4 * q); bs += (bb[0] + bb[1]) + (bb[2] + bb[3]); }
                  const int oh = (tl * 64 + c0) * 2;
#define ST8(OFF, X) *(u32x4*)(B_ + (OFF) + oh) = (u32x4){pkh(X[0][0], X[0][1]), pkh(X[0][2], X[0][3]), pkh(X[1][0], X[1][1]), pkh(X[1][2], X[1][3])}
                  ST8(O_KK, kk); ST8(O_KD, kd); ST8(O_KA, kka); ST8(O_R, r4);
#undef ST8
                  bs = dpp_red8(bs);
                  if ((lane & 7) == 0) bon[(size_t)(tok0 + tfirst + tl) * 16 + head] = bs; }
            }
            asm volatile("s_waitcnt lgkmcnt(0)" ::: "memory"); __builtin_amdgcn_s_barrier(); asm volatile("" ::: "memory");
        }
#undef PLOAD
    } else {
        __syncthreads();
        const int row0 = wid * 16 + (lane >> 3) * 2, seg = lane & 7;
        h2 S[2][4];
#pragma unroll
        for (int h = 0; h < 2; ++h)
#pragma unroll
            for (int q = 0; q < 4; ++q) S[h][q] = (h2){(_Float16)0.f, (_Float16)0.f};
        asm volatile("s_waitcnt lgkmcnt(0)" ::: "memory"); __builtin_amdgcn_s_barrier(); asm volatile("" ::: "memory");
        for (int c = 0; c < NCH; ++c) {
            const char* B_ = lds + (c & 1) * BUFB;
            if (dir) scan_chunk<1>(B_, S, seg, row0); else scan_chunk<0>(B_, S, seg, row0);
            asm volatile("s_waitcnt lgkmcnt(0)" ::: "memory"); __builtin_amdgcn_s_barrier(); asm volatile("" ::: "memory");
        }
    }
    if (wid >= 4) {
        const int pt = tid - 256, c = NCH, cb_ = (c - 1) & 1, tf = dir ? T - TC * c : TC * (c - 1); const int tl = pt >> 3, c8 = (pt & 7) * 8;
        const float* yp = (const float*)(lds + cb_ * BUFB + O_Y) + tl * 64 + c8; const f32x4 y4 = *(const f32x4*)yp, y5 = *(const f32x4*)(yp + 4);
        u32x4 w; w.x = cvt_pk_bf16(y4[0], y4[1]); w.y = cvt_pk_bf16(y4[2], y4[3]); w.z = cvt_pk_bf16(y5[0], y5[1]); w.w = cvt_pk_bf16(y5[2], y5[3]);
        *(u32x4*)(yb + (size_t)(tok0 + tf + tl) * 1024 + head * 64 + c8) = w;
    }
    __syncthreads();
}
}

__device__ __forceinline__ void p4_post(const Args& a, char* lds, int vcu, int G) {
    const int tid = threadIdx.x, lane = tid & 63;
    unsigned char* ws = a.ws;
    const bf16_t* ZR = (const bf16_t*)a.out; bf16_t* QK = (bf16_t*)(ws + WS_QK);
    const bf16_t* Y0 = (const bf16_t*)(ws + WS_Y); const bf16_t* Y1 = Y0 + (size_t)NT * 1024;
    const float* BON = (const float*)(ws + WS_BON);
    const float* mup = a.in[13]; const float* mun = a.in[14]; const float* G2 = a.in[19]; const float* lnw = a.in[23]; const float* lnb = a.in[24]; const float* subg = a.in[12];
    bf16_t* SGh = (bf16_t*)lds; float* BL = (float*)(lds + 20480); bf16_t* GL = (bf16_t*)(lds + 24576);
    const bf16_t* G2T = (const bf16_t*)(ws + WS_G2T);
    const int wid = tid >> 6, r32 = lane & 31, hi = lane >> 5;
    for (int tile = vcu; tile < NT / 32; tile += G) {
        const int tk0 = tile * 32;
        __syncthreads();
        for (int it = tid; it < 32 * 20; it += NTHR) {
            const int tl = it / 20, j0 = (it % 20) * 8, col = 3328 + j0, tok = tk0 + tl, t = tok_pos(tok), T = tok < TP ? TP : TS;
            const bf16_t* zp = ZR + (size_t)tok * ZRP + col; const u32x4 z = *(const u32x4*)zp; u32x4 zm = {0u, 0u, 0u, 0u}, zn = {0u, 0u, 0u, 0u};
            if (t > 0) zm = *(const u32x4*)(zp - ZRP);
            if (t < T - 1) zn = *(const u32x4*)(zp + ZRP);
            float v[8];
#define SH(i, zw, zmw, znw, lohi) { const float zz = lohi(zw), a_ = lohi(zmw), b_ = lohi(znw), mp_ = mup[col + i], mn_ = mun[col + i]; v[i] = sigmoidf_(zz + mp_ * (a_ - zz) + mn_ * (b_ - zz)); }
            SH(0, z.x, zm.x, zn.x, bflo) SH(1, z.x, zm.x, zn.x, bfhi) SH(2, z.y, zm.y, zn.y, bflo) SH(3, z.y, zm.y, zn.y, bfhi)
            SH(4, z.z, zm.z, zn.z, bflo) SH(5, z.z, zm.z, zn.z, bfhi) SH(6, z.w, zm.w, zn.w, bflo) SH(7, z.w, zm.w, zn.w, bfhi)
#undef SH
            { u32x4 w; w.x = cvt_pk_bf16(v[0], v[1]); w.y = cvt_pk_bf16(v[2], v[3]); w.z = cvt_pk_bf16(v[4], v[5]); w.w = cvt_pk_bf16(v[6], v[7]); *(u32x4*)(SGh + tl * 160 + j0) = w; }
        }
        { const int tl = tid >> 4, hd = tid & 15; BL[tid] = BON[(size_t)(tk0 + tl) * 16 + hd] + BON[(size_t)NT * 16 + (size_t)(tk0 + tl) * 16 + hd]; }
        { const int pr = tid >> 1, half = tid & 1, tl = pr >> 3, hd = pr & 7; bf16_t* op = QK + (size_t)(tk0 + tl) * 2048 + hd * 128 + half * 64;
          u32x4 w[8]; float ss = 0.f;
#pragma unroll
          for (int i = 0; i < 8; ++i) { w[i] = *(const u32x4*)(op + i * 8);
              ss += bflo(w[i].x) * bflo(w[i].x) + bfhi(w[i].x) * bfhi(w[i].x) + bflo(w[i].y) * bflo(w[i].y) + bfhi(w[i].y) * bfhi(w[i].y) + bflo(w[i].z) * bflo(w[i].z) + bfhi(w[i].z) * bfhi(w[i].z) + bflo(w[i].w) * bflo(w[i].w) + bfhi(w[i].w) * bfhi(w[i].w); }
          ss += __shfl_xor(ss, 1);
          const float rstd = rsqrtf(ss * (1.f / 128.f) + 1e-6f) * 0.8f; const float* sg = subg + half * 64;
#pragma unroll
          for (int i = 0; i < 8; ++i) { u32x4 o;
              o.x = cvt_pk_bf16(bflo(w[i].x) * rstd * sg[i * 8 + 0], bfhi(w[i].x) * rstd * sg[i * 8 + 1]); o.y = cvt_pk_bf16(bflo(w[i].y) * rstd * sg[i * 8 + 2], bfhi(w[i].y) * rstd * sg[i * 8 + 3]);
              o.z = cvt_pk_bf16(bflo(w[i].z) * rstd * sg[i * 8 + 4], bfhi(w[i].z) * rstd * sg[i * 8 + 5]); o.w = cvt_pk_bf16(bflo(w[i].w) * rstd * sg[i * 8 + 6], bfhi(w[i].w) * rstd * sg[i * 8 + 7]);
              *(u32x4*)(op + i * 8) = o; } }
        __syncthreads();
        { f32x16 gacc[4] = {};
#pragma unroll
          for (int ks = 0; ks < 10; ++ks) { const bf16x8 af = *reinterpret_cast<const bf16x8*>(SGh + r32 * 160 + ks * 16 + hi * 8);
#pragma unroll
              for (int cb = 0; cb < 4; ++cb) { const bf16x8 bfr = *reinterpret_cast<const bf16x8*>(G2T + (size_t)(wid * 128 + cb * 32 + r32) * 160 + ks * 16 + hi * 8);
                  gacc[cb] = __builtin_amdgcn_mfma_f32_32x32x16_bf16(af, bfr, gacc[cb], 0, 0, 0); } }
#pragma unroll
          for (int cb = 0; cb < 4; ++cb)
#pragma unroll
              for (int r = 0; r < 16; ++r) GL[(att::crow(r, hi)) * 1024 + wid * 128 + cb * 32 + r32] = (bf16_t)(cvt_pk_bf16(gacc[cb][r], gacc[cb][r]) & 0xffffu); }
        __syncthreads();
        const int c0 = tid * 2;
        const int hd = tid >> 5;
        const float lw0 = lnw[c0], lw1 = lnw[c0 + 1], lb0 = lnb[c0], lb1 = lnb[c0 + 1];
        const float mp0 = mup[2048 + c0], mp1 = mup[2048 + c0 + 1], mn0 = mun[2048 + c0], mn1 = mun[2048 + c0 + 1];
#pragma unroll
        for (int i = 0; i < 32; ++i) {
            const int tok = tk0 + i, t = tok_pos(tok), T = tok < TP ? TP : TS;
            const unsigned ya = *(const unsigned*)(Y0 + (size_t)tok * 1024 + c0), yb = *(const unsigned*)(Y1 + (size_t)tok * 1024 + c0);
            const float y0 = bflo(ya) + bflo(yb), y1 = bfhi(ya) + bfhi(yb);
            float s = y0 + y1, q = y0 * y0 + y1 * y1;
#pragma unroll
            for (int o = 1; o < 32; o <<= 1) { s += __shfl_xor(s, o); q += __shfl_xor(q, o); }
            const float mean = s * (1.f / 64.f), var = fmaxf(q * (1.f / 64.f) - mean * mean, 0.f), rstd = rsqrtf(var + 64e-5f);
            const bf16_t* zp = ZR + (size_t)tok * ZRP + 2048 + c0; const unsigned z = *(const unsigned*)zp;
            unsigned zm = 0u, zn = 0u;
            if (t > 0) zm = *(const unsigned*)(zp - ZRP);
            if (t < T - 1) zn = *(const unsigned*)(zp + ZRP);
            const float v0 = bflo(z) + mp0 * (bflo(zm) - bflo(z)) + mn0 * (bflo(zn) - bflo(z)), v1 = bfhi(z) + mp1 * (bfhi(zm) - bfhi(z)) + mn1 * (bfhi(zn) - bfhi(z));
            const float bo = BL[i * 16 + hd];
            const unsigned gg = *(const unsigned*)(GL + i * 1024 + c0);
            const float o0 = ((y0 - mean) * rstd * lw0 + lb0 + bo * v0) * bflo(gg), o1 = ((y1 - mean) * rstd * lw1 + lb1 + bo * v1) * bfhi(gg);
            *(unsigned*)(QK + (size_t)tok * 2048 + 1024 + c0) = cvt_pk_bf16(o0, o1);
        }
    }
    __syncthreads();
}

struct SchedMerge {
    int v, G; const char* H; const char* WG; const char* QK; const char* VM; const char* PAR; const char* PM2;
    __device__ __forceinline__ bool next(int i, Unit& u) const {
        const int ti = i / 6, kind = i - ti * 6; const long L = (long)ti * G + v; int pm, pn;
        if (!TileMap{192, 8}.get(L, pm, pn)) return false;
        u.pm = pm; u.pn = pn; u.kind = kind; u.t0 = 0; u.T = 0;
        const size_t bo = (size_t)pn * MiB;
        switch (kind) {
            case 0: u.A = H + (size_t)pm * MiB; u.B = WG + bo; u.nt = 32; break;
            case 1: u.A = QK + (size_t)pm * MiB; u.B = PAR + bo; u.nt = 16; break;
            case 2: u.A = H + (size_t)pm * MiB; u.B = WG + 8 * MiB + bo; u.nt = 32; break;
            case 3: u.A = QK + (size_t)pm * MiB + 2048; u.B = PAR + bo + 2048; u.nt = 16; break;
            case 4: u.A = H + (size_t)pm * MiB; u.B = WG + 16 * MiB + bo; u.nt = 32; break;
            default: u.A = VM + (size_t)pm * MiB + 2048; u.B = PM2 + bo; u.nt = 16; break;
        }
        return true;
    }
};
struct EpiMerge {
    u32x4* scrG; f32x4* scrP; bf16_t* MRG;
    __device__ __forceinline__ void operator()(const f32x4 (&acc)[2][2][4][2], const Unit& u, int wr, int wc, int fr, int fq) const {
        const int tid = threadIdx.x, kind = u.kind;
        u32x4* gp = scrG + tid; f32x4* pp = scrP + tid;
        if ((kind & 1) == 0) {
#pragma unroll
            for (int ai = 0; ai < 2; ++ai)
#pragma unroll
                for (int bj = 0; bj < 2; ++bj)
#pragma unroll
                    for (int m = 0; m < 4; ++m) { const f32x4 v0 = acc[ai][bj][m][0], v1 = acc[ai][bj][m][1]; u32x4 w;
                        w.x = cvt_pk_bf16(sigmoidf_(v0[0]), sigmoidf_(v0[1])); w.y = cvt_pk_bf16(sigmoidf_(v0[2]), sigmoidf_(v0[3]));
                        w.z = cvt_pk_bf16(sigmoidf_(v1[0]), sigmoidf_(v1[1])); w.w = cvt_pk_bf16(sigmoidf_(v1[2]), sigmoidf_(v1[3]));
                        *gp = w; gp += NTHR; asm volatile("" : "+v"(gp) :: "memory"); }
        } else {
            const int row0 = u.pm * 256 + wr * 64 + fr, col0 = u.pn * 256 + wc * 32 + 8 * fq;
#pragma unroll
            for (int ai = 0; ai < 2; ++ai)
#pragma unroll
                for (int bj = 0; bj < 2; ++bj) {
                    bf16_t* mp = MRG + (size_t)(row0 + ai * 128) * 2048 + col0 + bj * 128;
#pragma unroll
                    for (int m = 0; m < 4; ++m) { const u32x4 g = *gp;
                        f32x4 p0 = acc[ai][bj][m][0] * (f32x4){bflo(g.x), bfhi(g.x), bflo(g.y), bfhi(g.y)}, p1 = acc[ai][bj][m][1] * (f32x4){bflo(g.z), bfhi(g.z), bflo(g.w), bfhi(g.w)};
                        if (kind > 1) { p0 += pp[0]; p1 += pp[NTHR]; }
                        if (kind < 5) { pp[0] = p0; pp[NTHR] = p1; }
                        else { u32x4 w; w.x = cvt_pk_bf16(p0[0], p0[1]); w.y = cvt_pk_bf16(p0[2], p0[3]); w.z = cvt_pk_bf16(p1[0], p1[1]); w.w = cvt_pk_bf16(p1[2], p1[3]);
                            *(u32x4*)mp = w; }
                        gp += NTHR; pp += 2 * NTHR; mp += 16 * 2048; asm volatile("" : "+v"(gp), "+v"(pp), "+v"(mp) :: "memory"); } }
        }
    }
};

struct SchedSq {
    int v, G; const char* A; const char* B; size_t astep, bstep; int nt;
    __device__ __forceinline__ bool next(int i, Unit& u) const {
        const long L = (long)i * G + v; int pm, pn; if (!TileMap{192, 8}.get(L, pm, pn)) return false;
        u.A = A + (size_t)pm * astep; u.B = B + (size_t)pn * bstep; u.nt = nt; u.pm = pm; u.pn = pn; u.kind = 0; u.t0 = 0; u.T = 0; return true;
    }
};
struct EpiWo {
    const float* xp; const float* xs; float* out;
    __device__ __forceinline__ void operator()(const f32x4 (&acc)[2][2][4][2], const Unit& u, int wr, int wc, int fr, int fq) const {
        const int row0 = u.pm * 256 + wr * 64 + fr, col0 = u.pn * 256 + wc * 32 + 8 * fq;
#pragma unroll
        for (int ai = 0; ai < 2; ++ai)
#pragma unroll
            for (int m = 0; m < 4; ++m) { const int row = row0 + ai * 128 + m * 16;
                const float* xr = (row < TP ? xp + (size_t)row * DM : xs + (size_t)(row - TP) * DM) + col0; float* orow = out + (size_t)row * DM + col0;
#pragma unroll
                for (int bj = 0; bj < 2; ++bj) { const f32x4 x0 = *(const f32x4*)(xr + bj * 128), x1 = *(const f32x4*)(xr + bj * 128 + 4);
                    *(f32x4*)(orow + bj * 128) = x0 + acc[ai][bj][m][0]; *(f32x4*)(orow + bj * 128 + 4) = x1 + acc[ai][bj][m][1]; } }
    }
};
struct EpiDown {
    float* out;
    __device__ __forceinline__ void operator()(const f32x4 (&acc)[2][2][4][2], const Unit& u, int wr, int wc, int fr, int fq) const {
        const int row0 = u.pm * 256 + wr * 64 + fr, col0 = u.pn * 256 + wc * 32 + 8 * fq;
#pragma unroll
        for (int ai = 0; ai < 2; ++ai)
#pragma unroll
            for (int m = 0; m < 4; ++m) { float* orow = out + (size_t)(row0 + ai * 128 + m * 16) * DM + col0;
#pragma unroll
                for (int bj = 0; bj < 2; ++bj) { const f32x4 x0 = *(const f32x4*)(orow + bj * 128), x1 = *(const f32x4*)(orow + bj * 128 + 4);
                    *(f32x4*)(orow + bj * 128) = x0 + acc[ai][bj][m][0]; *(f32x4*)(orow + bj * 128 + 4) = x1 + acc[ai][bj][m][1]; } }
    }
};

struct SchedUp {
    int v, G; const char* HN; const char* WUP;
    __device__ __forceinline__ bool next(int i, Unit& u) const {
        const long L = (long)i * G + v; int pm, pn; if (!TileMap{197, 44}.get(L, pm, pn)) return false;
        int s, ti; if (pm < 65) { s = 0; ti = pm; } else { s = 1 + (pm - 65) / 33; ti = (pm - 65) % 33; }
        const int T = seq_len(s); int t0 = 254 * ti - 1; if (t0 > T - 255) t0 = T - 255;
        u.pm = seq_start(s); u.pn = pn; u.kind = 0; u.t0 = t0; u.T = T; u.nt = 32;
        u.A = HN + ((long)u.pm + t0) * 4096; u.B = WUP + (size_t)pn * MiB; return true;
    }
};
struct EpiUp {
    bf16_t* ACT; const float* cw; const float* cb; LAS float* xch;
    __device__ __forceinline__ void operator()(const f32x4 (&acc)[2][2][4][2], const Unit& u, int wr, int wc, int fr, int fq) const {
        const int lane = threadIdx.x & 63;
        const int cin = wc * 32 + 8 * fq;
#pragma unroll
        for (int ai = 0; ai < 2; ++ai) { const int rg = 2 * ai + wr;
#pragma unroll
            for (int bj = 0; bj < 2; ++bj)
#pragma unroll
                for (int n = 0; n < 2; ++n) {
                    if (fr == 0) *(LAS f32x4*)(xch + (rg * 2 + 0) * 256 + bj * 128 + cin + 4 * n) = acc[ai][bj][0][n];
                    if (fr == 15) *(LAS f32x4*)(xch + (rg * 2 + 1) * 256 + bj * 128 + cin + 4 * n) = acc[ai][bj][3][n]; } }
        asm volatile("s_waitcnt lgkmcnt(0)" ::: "memory"); __builtin_amdgcn_s_barrier(); asm volatile("" ::: "memory");
        const int gc = u.pn * 128 + cin;
#pragma unroll
        for (int n = 0; n < 2; ++n) {
            const int wcol = gc + 4 * n;
            const f32x4 g0 = *(const f32x4*)(cw + wcol), g1 = *(const f32x4*)(cw + 2 * DFF + wcol), g2 = *(const f32x4*)(cw + 4 * DFF + wcol), gb = *(const f32x4*)(cb + wcol);
            const f32x4 v0 = *(const f32x4*)(cw + DFF + wcol), v1 = *(const f32x4*)(cw + 3 * DFF + wcol), v2 = *(const f32x4*)(cw + 5 * DFF + wcol), vb = *(const f32x4*)(cb + DFF + wcol);
#pragma unroll
            for (int ai = 0; ai < 2; ++ai) { const int rg = 2 * ai + wr;
                bf16_t* ap = ACT + ((long)u.pm + u.t0 + 128 * ai + 64 * wr + fr) * DFF + gc + 4 * n;
#pragma unroll
                for (int m = 0; m < 4; ++m) {
                    const int j = 128 * ai + 64 * wr + 16 * m + fr, t = u.t0 + j;
                    f32x4 res;
#pragma unroll
                    for (int bj = 0; bj < 2; ++bj) {
                        const f32x4 cur = acc[ai][bj][m][n];
                        const f32x4 sp = (m > 0 && fr == 15) ? acc[ai][bj][m > 0 ? m - 1 : 0][n] : cur;
                        const f32x4 sn = (m < 3 && fr == 0) ? acc[ai][bj][m < 3 ? m + 1 : 3][n] : cur;
                        f32x4 pv, nv;
#pragma unroll
                        for (int i = 0; i < 4; ++i) { pv[i] = __uint_as_float(__builtin_amdgcn_update_dpp(0u, __float_as_uint(sp[i]), 0x121, 0xf, 0xf, false));
                                                       nv[i] = __uint_as_float(__builtin_amdgcn_update_dpp(0u, __float_as_uint(sn[i]), 0x12F, 0xf, 0xf, false)); }
                        if (m == 0) { const f32x4 xprev = rg > 0 ? *(const LAS f32x4*)(xch + ((rg - 1) * 2 + 1) * 256 + bj * 128 + cin + 4 * n) : (f32x4){0.f, 0.f, 0.f, 0.f}; if (fr == 0) pv = xprev; }
                        if (m == 3) { const f32x4 xnext = rg < 3 ? *(const LAS f32x4*)(xch + ((rg + 1) * 2 + 0) * 256 + bj * 128 + cin + 4 * n) : (f32x4){0.f, 0.f, 0.f, 0.f}; if (fr == 15) nv = xnext; }
                        if (t < 1) pv = (f32x4){0.f, 0.f, 0.f, 0.f};
                        if (t >= u.T - 1) nv = (f32x4){0.f, 0.f, 0.f, 0.f};
                        if (bj == 0) { const f32x4 cv = g0 * pv + g1 * cur + g2 * nv + gb; res = (f32x4){cv[0] * sigmoidf_(cv[0]), cv[1] * sigmoidf_(cv[1]), cv[2] * sigmoidf_(cv[2]), cv[3] * sigmoidf_(cv[3])}; }
                        else { const f32x4 cv = v0 * pv + v1 * cur + v2 * nv + vb; res = res * cv; }
                    }
                    if (j >= 1 && j <= 254) { u32x2 w; w.x = cvt_pk_bf16(res[0], res[1]); w.y = cvt_pk_bf16(res[2], res[3]); *(u32x2*)ap = w; }
                    ap += 16 * DFF; asm volatile("" : "+v"(ap) :: "memory");
                }
            }
        }
    }
};

__global__ void __launch_bounds__(NTHR, 2) enc_fwd(Args args) {
    extern __shared__ __attribute__((aligned(16))) unsigned char lds_raw[];
    cg::grid_group grid = cg::this_grid();
    LAS unsigned char* lds = (LAS unsigned char*)lds_raw;
    const int tid = threadIdx.x;
    const int G = gridDim.x, bx = blockIdx.x, vcu = (G % 8 == 0) ? (bx % 8) * (G / 8) + bx / 8 : bx;
    unsigned char* ws = args.ws;
    const int lo = args.ph_lo, hi = args.ph_hi;
#ifndef P2M
#define P2M 7
#endif
#ifndef PH_MASK
#define PH_MASK 0x1ff
#endif
#define IN(k) (((PH_MASK >> (k)) & 1) && lo <= (k) && (k) < hi)
#define SEAM(k) do { if (IN(k) && IN((k) + 1)) grid.sync(); } while (0)
#ifndef PROBE
#define PROBE 0
#endif
    unsigned long long tp0 = 0, tp1 = 0;
#define TSTAMP(v) do { if (PROBE) { v = __builtin_amdgcn_s_memrealtime(); } } while (0)

    if (IN(0)) p0_prologue(args, lds, vcu, G);
    SEAM(0);
    if (IN(1)) {
        SchedIn S{vcu, G, (const char*)(ws + WS_H), (const char*)(ws + WS_WIN), (const char*)(ws + WS_MEMN), (const char*)(ws + WS_WKV)};
        EpiIn E{(bf16_t*)(ws + WS_QK), (bf16_t*)(ws + WS_VM), (bf16_t*)args.out, (bf16_t*)(ws + WS_KVM), args.in[6], args.in[7], (const float*)(ws + WS_ROPE), (const float*)(ws + WS_ROPE) + TP * 32};
        pg8::gemm_phase<EpiIn, SchedIn, true>(lds, 2048, S, E);
    }
    SEAM(1);
    if (PROBE == 1 || PROBE == 2) TSTAMP(tp0);
    if (IN(2)) {
        unsigned* ctl = (unsigned*)(ws + WS_CTL);
        volatile LAS unsigned* jobw = (volatile LAS unsigned*)(lds + LDS_MISC);
        const float lam = ((const float*)ctl)[CW_LAM];
        const bool fixref = ((const float*)ctl)[CW_SMAX] <= 30.f;
        scan::P sp{(const bf16_t*)args.out, (bf16_t*)(ws + WS_Y), (float*)(ws + WS_BON), args.in[13], args.in[14], args.in[15], args.in[16], args.in[17], args.in[18], args.in[20], args.in[21], args.in[22]};
        for (;;) {
            __syncthreads();
            if (tid == 0) jobw[0] = atomicAdd(ctl + CW_QUEUE, 1u);
            __syncthreads();
            const int jb = (int)jobw[0];
            if (jb >= 160 + 1536 + 768) break;
            if (((P2M) & 1) && jb < 160) {
                int s, r; if (jb < 32) { s = 0; r = jb; } else { s = 1 + (jb - 32) / 32; r = (jb - 32) % 32; }
                scan::job(s, r & 1, r >> 1, sp, (char*)lds_raw);
                if (PROBE == 2 && tid == 0) atomicMax((unsigned long long*)(ctl + 256), (unsigned long long)__builtin_amdgcn_s_memrealtime());
            } else if (((P2M) & 2) && jb < 160 + 1536) {
                const int a = jb - 160; int s, h, qb;
                if (a < 512) { s = 0; h = a / 64; qb = a % 64; } else { const int b = a - 512; s = 1 + b / 256; h = (b % 256) / 32; qb = b % 32; }
                if (fixref) att::diff_unit<true>(s, h, qb, (bf16_t*)(ws + WS_QK), (const bf16_t*)(ws + WS_VM), lam, (char*)lds_raw);
                else att::diff_unit<false>(s, h, qb, (bf16_t*)(ws + WS_QK), (const bf16_t*)(ws + WS_VM), lam, (char*)lds_raw);
            } else if ((P2M) & 4) {
                const int a = jb - 160 - 1536; int s, mh, qb;
                if (a < 256) { s = 0; mh = a / 64; qb = a % 64; } else { const int b = a - 256; s = 1 + b / 128; mh = (b % 128) / 32; qb = b % 32; }
                att::mem_unit(s, mh, qb, (bf16_t*)(ws + WS_VM), (const bf16_t*)(ws + WS_KVM), args.in[27], args.in[28], (char*)lds_raw);
            }
        }
    }
    SEAM(2);
    if (PROBE == 1) TSTAMP(tp1);
    if (IN(3)) p4_post(args, (char*)lds_raw, vcu, G);
    SEAM(3);
    if (IN(4)) {
        SchedMerge S{vcu, G, (const char*)(ws + WS_H), (const char*)(ws + WS_WG), (const char*)(ws + WS_QK), (const char*)(ws + WS_VM), (const char*)(ws + WS_PAR), (const char*)(ws + WS_PM2)};
        unsigned char* scr = (unsigned char*)args.out + (size_t)bx * (384 * 1024);
        EpiMerge E{(u32x4*)scr, (f32x4*)(scr + 128 * 1024), (bf16_t*)(ws + WS_MRG)};
        pg8::gemm_phase<EpiMerge, SchedMerge, true>(lds, 2048, S, E);
    }
    SEAM(4);
    if (IN(5)) {
        SchedSq S{vcu, G, (const char*)(ws + WS_MRG), (const char*)(ws + WS_WO), MiB, MiB, 32};
        EpiWo E{args.in[0], args.in[1], args.out};
        pg8::gemm_phase<EpiWo, SchedSq, true>(lds, 2048, S, E);
    }
    SEAM(5);
    if (IN(6)) {
        const int lane = tid & 63, gw = vcu * 8 + (tid >> 6), NGW = G * 8;
        for (int m = gw; m < NT; m += NGW) rms_row(args.out + (size_t)m * DM, args.in[33], (bf16_t*)(ws + WS_H) + (size_t)m * DM, lane);
    }
    SEAM(6);
    if (IN(7)) {
        SchedUp S{vcu, G, (const char*)(ws + WS_H), (const char*)(ws + WS_WUP)};
        EpiUp E{(bf16_t*)(ws + WS_ACT), args.in[35], args.in[36], (LAS float*)(lds + LDS_XCH)};
        pg8::gemm_phase<EpiUp, SchedUp, true>(lds, 2048, S, E);
    }
    SEAM(7);
    if (IN(8)) {
        SchedSq S{vcu, G, (const char*)(ws + WS_ACT), (const char*)(ws + WS_WDN), (size_t)256 * DFF * 2, (size_t)256 * DFF * 2, 88};
        EpiDown E{args.out};
        pg8::gemm_phase<EpiDown, SchedSq, true>(lds, DFF, S, E);
    }
    if (PROBE && bx == 0 && tid == 0) {
        if (PROBE == 2) tp1 = __hip_atomic_load((unsigned long long*)(ws + WS_CTL) + 128, __ATOMIC_RELAXED, __HIP_MEMORY_SCOPE_AGENT);
        const unsigned long long target = __builtin_amdgcn_s_memrealtime() + (tp1 > tp0 ? tp1 - tp0 : 0);
        while (__builtin_amdgcn_s_memrealtime() < target) __builtin_amdgcn_s_sleep(16);
    }
#undef IN
#undef SEAM
}

#ifndef MK_SPLIT
#define MK_SPLIT 0
#endif
extern "C" void kernel_launch(void* const* d_in, const int* in_sizes, int n_in, void* d_out, int out_size, void* d_ws, size_t ws_size, hipStream_t stream) {
    static int grid = 0;
    if (grid == 0) {
        if (n_in != 38 || out_size != NT * DM || ws_size < WS_END) { fprintf(stderr, "kernel_launch: unexpected shapes n_in %d out %d ws %zu\n", n_in, out_size, ws_size); grid = -1; return; }
        int dev = 0, cus = 0, per_cu = 0;
        hipGetDevice(&dev); hipDeviceGetAttribute(&cus, hipDeviceAttributeMultiprocessorCount, dev);
        if (hipFuncSetAttribute((const void*)enc_fwd, hipFuncAttributeMaxDynamicSharedMemorySize, LDS_BYTES) != hipSuccess) { fprintf(stderr, "kernel_launch: hipFuncSetAttribute failed\n"); grid = -1; return; }
        if (hipOccupancyMaxActiveBlocksPerMultiprocessor(&per_cu, (const void*)enc_fwd, NTHR, LDS_BYTES) != hipSuccess || per_cu < 1) { fprintf(stderr, "kernel_launch: occupancy query failed (%d)\n", per_cu); per_cu = 1; }
        (void)hipGetLastError();
        grid = cus * 1;
    }
    if (grid < 0) return;
    Args a{};
    for (int i = 0; i < 38; ++i) a.in[i] = (const float*)d_in[i];
    a.out = (float*)d_out; a.ws = (unsigned char*)d_ws;
    for (int d = 0; d < 32; ++d) a.inv_rev[d] = pow(10000.0, -(double)d / 32.0) / 6.283185307179586476925286766559;
#if MK_SPLIT
    for (int ph = 0; ph < 9; ++ph) { a.ph_lo = ph; a.ph_hi = ph + 1; void* kargs[] = {&a};
        hipError_t e = hipLaunchCooperativeKernel((const void*)enc_fwd, dim3(grid), dim3(NTHR), kargs, LDS_BYTES, stream);
        if (e != hipSuccess) { fprintf(stderr, "launch %d failed: %s\n", ph, hipGetErrorString(e)); break; } }
#else
    a.ph_lo = 0; a.ph_hi = 9;
    void* kargs[] = {&a};
    hipError_t e = hipLaunchCooperativeKernel((const void*)enc_fwd, dim3(grid), dim3(NTHR), kargs, LDS_BYTES, stream);
    if (e != hipSuccess) fprintf(stderr, "cooperative launch failed: %s (grid %d)\n", hipGetErrorString(e), grid);
#endif
}
```

```cpp
#include <hip/hip_runtime.h>
#include <hip/hip_cooperative_groups.h>
#include <cstdio>
#include <cstdint>
#include <cmath>
namespace cg = cooperative_groups;

#define LAS __attribute__((address_space(3)))
typedef unsigned short bf16_t;
typedef short bf16x8 __attribute__((ext_vector_type(8)));
typedef short s16x4 __attribute__((ext_vector_type(4)));
typedef float f32x2 __attribute__((ext_vector_type(2)));
typedef float f32x4 __attribute__((ext_vector_type(4)));
typedef float f32x16 __attribute__((ext_vector_type(16)));
typedef unsigned u32x2 __attribute__((ext_vector_type(2)));
typedef unsigned u32x4 __attribute__((ext_vector_type(4)));

constexpr int NT = 49152, DM = 2048, TP = 16384, TS = 8192, NSEQ = 5;
constexpr int ZRP = 3584;
constexpr int DFF = 5632;
constexpr int NTHR = 512;
constexpr size_t MiB = 1u << 20;
constexpr size_t WS_CTL = 0, WS_WIN = 1 * MiB, WS_WG = 31 * MiB, WS_WKV = 55 * MiB, WS_PAR = 63 * MiB, WS_PM2 = 71 * MiB, WS_WO = 79 * MiB,
                 WS_WUP = 87 * MiB, WS_WDN = 131 * MiB, WS_ROPE = 153 * MiB, WS_MEMN = 157 * MiB, WS_KVM = 162 * MiB, WS_BON = 167 * MiB,
                 WS_H = 176 * MiB, WS_QK = 370 * MiB, WS_VM = 562 * MiB, WS_Y = 754 * MiB, WS_ACT = 370 * MiB, WS_MRG = 754 * MiB, WS_END = 946 * MiB;
constexpr int CW_QUEUE = 64, CW_LAM = 128, CW_SMAX = 129;
constexpr size_t WS_G2T = 173 * MiB;
constexpr int LDS_XCH = 131072, LDS_MISC = 131072 + 8192, LDS_BYTES = 131072 + 8192 + 256;

__device__ __forceinline__ int seq_start(int s) { return s == 0 ? 0 : TP + (s - 1) * TS; }
__device__ __forceinline__ int seq_len(int s) { return s == 0 ? TP : TS; }
__device__ __forceinline__ int tok_pos(int tok) { return tok < TP ? tok : ((tok - TP) & (TS - 1)); }

__device__ __forceinline__ unsigned cvt_pk_bf16(float lo, float hi) { unsigned r; asm volatile("v_cvt_pk_bf16_f32 %0, %1, %2" : "=v"(r) : "v"(lo), "v"(hi)); return r; }
__device__ __forceinline__ float bflo(unsigned w) { return __uint_as_float(w << 16); }
__device__ __forceinline__ float bfhi(unsigned w) { return __uint_as_float(w & 0xffff0000u); }
__device__ __forceinline__ float bf1(bf16_t b) { return __uint_as_float((unsigned)b << 16); }
__device__ __forceinline__ float sigmoidf_(float x) { return 1.f / (1.f + __expf(-x)); }
__device__ __forceinline__ float wave_sum(float v) {
#pragma unroll
    for (int o = 1; o < 64; o <<= 1) v += __shfl_xor(v, o);
    return v;
}

namespace pg8 {
constexpr int BM = 256, BK = 64, HALF = 128, HTB = HALF * BK * 2, STAGE_BYTES = 8 * HTB;
__host__ __device__ __forceinline__ int lds_byte(int r, int c) { const int st = (r >> 4) * 2 + (c >> 5), rr = r & 15, cc = c & 31, ob = rr * 64 + cc * 2; return st * 1024 + (ob ^ (((ob >> 9) & 1) << 5)); }
__host__ __device__ __forceinline__ void stage_rc(int b, int& R, int& C) { const int st = b / 1024, sb = b % 1024, swz = sb ^ (((sb >> 9) & 1) << 5); R = (st >> 1) * 16 + swz / 64; C = (st & 1) * 32 + (swz % 64) / 2; }
__host__ __device__ __forceinline__ int perm32(int rho) { const int n = rho >> 4, i = rho & 15; return 8 * (i >> 2) + 4 * n + (i & 3); }

struct Unit { const char* A; const char* B; int nt, pm, pn, kind, t0, T; };

template <class Epi, class Sched, bool ALIGN_EPI>
__device__ __forceinline__ void gemm_phase(LAS unsigned char* lds, const int ld, const Sched& S, const Epi& E) {
    const int tid = threadIdx.x, wid = __builtin_amdgcn_readfirstlane(tid >> 6), lane = tid & 63, wr = wid >> 2, wc = wid & 3, fr = lane & 15, fq = lane >> 4;
    unsigned voffA[2], voffB[2];
#pragma unroll
    for (int i = 0; i < 2; ++i) { int R, C; stage_rc(tid * 16 + i * 8192, R, C); const int Rb = (R & ~31) + perm32(R & 31);
        voffA[i] = (unsigned)(R * ld + C) * 2u; voffB[i] = (unsigned)(Rb * ld + C) * 2u; }
    const size_t kstep = (size_t)(BK * 2);
    const size_t hstep = (size_t)HALF * ld * 2;
    const unsigned ldsw = (unsigned)wid * 1024u;
    const int aoff = lds_byte(wr * 64 + fr, fq * 8), boff = lds_byte(wc * 32 + fr, fq * 8);
#define PG8_SA(b, h) (((b) * 2 + (h)) * HTB)
#define PG8_SB(b, h) ((4 + (b) * 2 + (h)) * HTB)
#define PG8_STAGE(bufoff, gbase, voff) do { _Pragma("unroll") for (int _i = 0; _i < 2; ++_i) \
        __builtin_amdgcn_global_load_lds((const unsigned*)((const char*)(gbase) + (voff)[_i]), (LAS unsigned*)(lds + (bufoff) + ldsw + _i * 8192), 16, 0, 0); } while (0)
#define PG8_LDA(dst, b, h) do { _Pragma("unroll") for (int m = 0; m < 4; ++m) _Pragma("unroll") for (int k = 0; k < 2; ++k) dst[m][k] = *(const LAS bf16x8*)(lds + PG8_SA(b, h) + aoff + m * 2048 + k * 1024); } while (0)
#define PG8_LDB(dst, b, h) do { _Pragma("unroll") for (int n = 0; n < 2; ++n) _Pragma("unroll") for (int k = 0; k < 2; ++k) dst[n][k] = *(const LAS bf16x8*)(lds + PG8_SB(b, h) + boff + n * 2048 + k * 1024); } while (0)
#define PG8_MMA(ai, bj, At, Bt) do { __builtin_amdgcn_s_setprio(1); _Pragma("unroll") for (int m = 0; m < 4; ++m) _Pragma("unroll") for (int n = 0; n < 2; ++n) _Pragma("unroll") for (int k = 0; k < 2; ++k) \
        acc[ai][bj][m][n] = __builtin_amdgcn_mfma_f32_16x16x32_bf16(Bt[n][k], At[m][k], acc[ai][bj][m][n], 0, 0, 0); __builtin_amdgcn_s_setprio(0); } while (0)
#define PG8_WAIT_V(n) asm volatile("s_waitcnt vmcnt(" #n ")" ::: "memory")
#define PG8_WAIT_L(n) asm volatile("s_waitcnt lgkmcnt(" #n ")" ::: "memory")
#define PG8_BAR __builtin_amdgcn_s_barrier()
#define PG8_SCHED __builtin_amdgcn_sched_barrier(0)
    Unit cur, nxt; int ui = 0;
    if (!S.next(0, cur)) return;
    f32x4 acc[2][2][4][2];
#pragma unroll
    for (int a = 0; a < 2; ++a)
#pragma unroll
        for (int b = 0; b < 2; ++b)
#pragma unroll
            for (int m = 0; m < 4; ++m)
#pragma unroll
                for (int n = 0; n < 2; ++n) acc[a][b][m][n] = (f32x4){0.f, 0.f, 0.f, 0.f};
    bf16x8 At[4][2], B0[2][2], B1[2][2];
    const char* cA = cur.A; const char* cB = cur.B;
    PG8_STAGE(PG8_SB(0, 0), cB, voffB); PG8_STAGE(PG8_SB(0, 1), cB + hstep, voffB); PG8_STAGE(PG8_SA(0, 0), cA, voffA); PG8_STAGE(PG8_SA(0, 1), cA + hstep, voffA);
    if (wr == 1) PG8_BAR;
    PG8_WAIT_V(2); PG8_BAR;
    PG8_STAGE(PG8_SB(1, 0), cB + kstep, voffB); PG8_STAGE(PG8_SA(1, 0), cA + kstep, voffA); PG8_STAGE(PG8_SB(1, 1), cB + hstep + kstep, voffB);
    PG8_WAIT_V(6); PG8_BAR;
    for (;;) {
        const bool has_next = S.next(ui + 1, nxt);
        const char* nA = has_next ? nxt.A : cA; const char* nB = has_next ? nxt.B : cB;
        const int nt = cur.nt;
        for (int t = 0; t < nt; t += 2) {
            const bool last = (t == nt - 2);
            const char* a1 = cA + (size_t)(t + 1) * kstep;
            const char* a2 = last ? nA : cA + (size_t)(t + 2) * kstep; const char* b2 = last ? nB : cB + (size_t)(t + 2) * kstep;
            const char* a3 = a2 + kstep; const char* b3 = b2 + kstep;
            PG8_LDB(B0, 0, 0); PG8_LDB(B1, 0, 1); PG8_SCHED; PG8_LDA(At, 0, 0); PG8_STAGE(PG8_SA(1, 1), a1 + hstep, voffA);
            PG8_WAIT_V(8); PG8_WAIT_L(0); PG8_BAR; PG8_MMA(0, 0, At, B0); PG8_MMA(0, 1, At, B1); PG8_BAR; PG8_SCHED;
            PG8_LDA(At, 0, 1); PG8_STAGE(PG8_SB(0, 0), b2, voffB); PG8_STAGE(PG8_SB(0, 1), b2 + hstep, voffB); PG8_STAGE(PG8_SA(0, 0), a2, voffA);
            PG8_WAIT_V(8); PG8_WAIT_L(0); PG8_BAR; PG8_MMA(1, 0, At, B0); PG8_MMA(1, 1, At, B1); PG8_BAR; PG8_SCHED;
            PG8_LDB(B0, 1, 0); PG8_LDB(B1, 1, 1); PG8_SCHED; PG8_LDA(At, 1, 0); PG8_STAGE(PG8_SA(0, 1), a2 + hstep, voffA);
            PG8_WAIT_V(8); PG8_WAIT_L(0); PG8_BAR; PG8_MMA(0, 0, At, B0); PG8_MMA(0, 1, At, B1); PG8_BAR; PG8_SCHED;
            PG8_LDA(At, 1, 1); PG8_STAGE(PG8_SB(1, 0), b3, voffB); PG8_STAGE(PG8_SB(1, 1), b3 + hstep, voffB); PG8_STAGE(PG8_SA(1, 0), a3, voffA);
            PG8_WAIT_V(8); PG8_WAIT_L(0); PG8_BAR; PG8_MMA(1, 0, At, B0); PG8_MMA(1, 1, At, B1); PG8_BAR; PG8_SCHED;
        }
        if constexpr (ALIGN_EPI) { if (wr == 0) PG8_BAR; }
        E(acc, cur, wr, wc, fr, fq);
        if (!has_next) break;
#pragma unroll
        for (int a = 0; a < 2; ++a)
#pragma unroll
            for (int b = 0; b < 2; ++b)
#pragma unroll
                for (int m = 0; m < 4; ++m)
#pragma unroll
                    for (int n = 0; n < 2; ++n) acc[a][b][m][n] = (f32x4){0.f, 0.f, 0.f, 0.f};
        cur = nxt; cA = nA; cB = nB; ++ui;
        if constexpr (ALIGN_EPI) { if (wr == 1) PG8_BAR; }
    }
    PG8_WAIT_V(0);
    if constexpr (!ALIGN_EPI) { if (wr == 0) PG8_BAR; }
    PG8_BAR;
#undef PG8_SA
#undef PG8_SB
#undef PG8_STAGE
#undef PG8_LDA
#undef PG8_LDB
#undef PG8_MMA
#undef PG8_WAIT_V
#undef PG8_WAIT_L
#undef PG8_BAR
#undef PG8_SCHED
}
}
using pg8::Unit;

struct TileMap {
    int nM, nN;
    __device__ __forceinline__ bool get(long L, int& pm, int& pn) const {
        if (L >= (long)nM * nN) return false;
        const int nig = 8 * nN, gid = (int)(L / nig), fm = gid * 8, gsz = (nM - fm) < 8 ? (nM - fm) : 8, r = (int)(L % nig);
        pm = fm + r % gsz; pn = r / gsz; return true;
    }
};

struct Args {
    const float* in[38];
    float* out; unsigned char* ws;
    double inv_rev[32];
    int ph_lo, ph_hi;
};

__device__ __forceinline__ void tr_item(const float* W, int N, int src_n0, bf16_t* WT, size_t ldw, int koff, int r0, int k0, LAS float* scr, int lane) {
    if (src_n0 >= 0) {
#pragma unroll 8
        for (int i = 0; i < 32; ++i) { const int kk = 2 * i + (lane >> 5); scr[kk * 33 + (lane & 31)] = W[(size_t)(k0 + kk) * N + src_n0 + (lane & 31)]; }
    } else {
#pragma unroll 8
        for (int i = 0; i < 32; ++i) { const int kk = 2 * i + (lane >> 5); scr[kk * 33 + (lane & 31)] = 0.f; }
    }
    asm volatile("s_waitcnt lgkmcnt(0)" ::: "memory");
    const int c = lane & 7;
#pragma unroll
    for (int j = 0; j < 4; ++j) { const int n = (lane >> 3) + 8 * j; const LAS float* s = scr + (8 * c) * 33 + n;
        u32x4 o; o.x = cvt_pk_bf16(s[0 * 33], s[1 * 33]); o.y = cvt_pk_bf16(s[2 * 33], s[3 * 33]); o.z = cvt_pk_bf16(s[4 * 33], s[5 * 33]); o.w = cvt_pk_bf16(s[6 * 33], s[7 * 33]);
        *(u32x4*)(WT + (size_t)(r0 + n) * ldw + koff + k0 + 8 * c) = o; }
    asm volatile("s_waitcnt lgkmcnt(0)" ::: "memory");
}
__device__ __forceinline__ void rms_row(const float* xrow, const float* g, bf16_t* orow, int lane) {
    f32x4 v[8]; float s = 0.f;
#pragma unroll
    for (int j = 0; j < 8; ++j) { v[j] = ((const f32x4*)xrow)[64 * j + lane]; s += (v[j].x * v[j].x + v[j].y * v[j].y) + (v[j].z * v[j].z + v[j].w * v[j].w); }
    const float rstd = rsqrtf(wave_sum(s) * (1.f / DM) + 1e-6f);
#pragma unroll
    for (int j = 0; j < 8; ++j) { const f32x4 gg = ((const f32x4*)g)[64 * j + lane];
        u32x2 w; w.x = cvt_pk_bf16(v[j].x * rstd * gg.x, v[j].y * rstd * gg.y); w.y = cvt_pk_bf16(v[j].z * rstd * gg.z, v[j].w * rstd * gg.w);
        ((u32x2*)orow)[64 * j + lane] = w; }
}

__device__ __forceinline__ void p0_prologue(const Args& a, LAS unsigned char* lds, int vcu, int G) {
    const int tid = threadIdx.x, lane = tid & 63, wave = tid >> 6;
    unsigned char* ws = a.ws;
    LAS float* scr = (LAS float*)(lds + wave * 16384);
    const int gw = vcu * 8 + wave, NGW = G * 8;
    constexpr int I0 = 32 * 240, I1 = 32 * 192, I2 = 32 * 64, I3 = 16 * 64, I6 = 32 * 64, I7 = 32 * 352, I8 = 88 * 64;
    constexpr int NITEMS = I0 + I1 + I2 + 3 * I3 + I6 + I7 + I8;
    for (int it = gw; it < NITEMS; it += NGW) {
        int r = it;
        if (r < I0) { const int kb = r / 240, nb = r % 240, r0 = nb * 32; int src;
            if (r0 < 2048) { const int tile = r0 >> 8, cp = r0 & 255, h = cp >> 7, g = (cp & 127) >> 5; src = tile * 256 + 64 * g + 32 * h; }
            else if (r0 < 6560) src = r0;
            else if (r0 < 6656) src = -1;
            else src = 6560 + (r0 - 6656);
            tr_item(a.in[5], 13728, src, (bf16_t*)(ws + WS_WIN), 2048, 0, r0, kb * 64, scr, lane); continue; } r -= I0;
        if (r < I1) { const int kb = r / 192, nb = r % 192; tr_item(a.in[5], 13728, 7584 + nb * 32, (bf16_t*)(ws + WS_WG), 2048, 0, nb * 32, kb * 64, scr, lane); continue; } r -= I1;
        if (r < I2) { const int kb = r / 64, nb = r % 64; tr_item(a.in[26], 2048, nb * 32, (bf16_t*)(ws + WS_WKV), 2048, 0, nb * 32, kb * 64, scr, lane); continue; } r -= I2;
        if (r < I3) { const int kb = r / 64, nb = r % 64; tr_item(a.in[29], 2048, nb * 32, (bf16_t*)(ws + WS_PAR), 2048, 0, nb * 32, kb * 64, scr, lane); continue; } r -= I3;
        if (r < I3) { const int kb = r / 64, nb = r % 64; tr_item(a.in[30], 2048, nb * 32, (bf16_t*)(ws + WS_PAR), 2048, 1024, nb * 32, kb * 64, scr, lane); continue; } r -= I3;
        if (r < I3) { const int kb = r / 64, nb = r % 64; tr_item(a.in[31], 2048, nb * 32, (bf16_t*)(ws + WS_PM2), 2048, 0, nb * 32, kb * 64, scr, lane); continue; } r -= I3;
        if (r < I6) { const int kb = r / 64, nb = r % 64; tr_item(a.in[32], 2048, nb * 32, (bf16_t*)(ws + WS_WO), 2048, 0, nb * 32, kb * 64, scr, lane); continue; } r -= I6;
        if (r < I7) { const int kb = r / 352, nb = r % 352, r0 = nb * 32, tile = r0 >> 8, bj = (r0 & 255) >> 7, j = r0 & 127;
            tr_item(a.in[34], 2 * DFF, bj * DFF + 128 * tile + j, (bf16_t*)(ws + WS_WUP), 2048, 0, r0, kb * 64, scr, lane); continue; } r -= I7;
        { const int kb = r / 64, nb = r % 64; tr_item(a.in[37], 2048, nb * 32, (bf16_t*)(ws + WS_WDN), DFF, 0, nb * 32, kb * 64, scr, lane); }
    }
    for (int m = gw; m < NT + 1280; m += NGW) {
        if (m < NT) { const float* xr = m < TP ? a.in[0] + (size_t)m * DM : a.in[1] + (size_t)(m - TP) * DM; rms_row(xr, a.in[4], (bf16_t*)(ws + WS_H) + (size_t)m * DM, lane); }
        else { const int j = m - NT; const float* xr = j < 256 ? a.in[2] + (size_t)j * DM : a.in[3] + (size_t)(j - 256) * DM; rms_row(xr, a.in[25], (bf16_t*)(ws + WS_MEMN) + (size_t)j * DM, lane); }
    }
    { float* rc = (float*)(ws + WS_ROPE); float* rs = rc + TP * 32;
      for (int e = (vcu * NTHR + tid); e < TP * 32; e += G * NTHR) { const int t = e >> 5, d = e & 31; double rev = (double)t * a.inv_rev[d]; rev -= rint(rev); const float rf = (float)rev;
          rc[e] = __builtin_amdgcn_cosf(rf); rs[e] = __builtin_amdgcn_sinf(rf); } }
    { bf16_t* g2t = (bf16_t*)(ws + WS_G2T); const float* G2 = a.in[19];
      for (int e = vcu * NTHR + tid; e < 1024 * 20; e += G * NTHR) { const int col = e / 20, kc = e - col * 20; float f[8];
#pragma unroll
          for (int i = 0; i < 8; ++i) f[i] = G2[(size_t)(kc * 8 + i) * 1024 + col];
          u32x4 w; w.x = cvt_pk_bf16(f[0], f[1]); w.y = cvt_pk_bf16(f[2], f[3]); w.z = cvt_pk_bf16(f[4], f[5]); w.w = cvt_pk_bf16(f[6], f[7]);
          *(u32x4*)(g2t + (size_t)col * 160 + kc * 8) = w; } }
    if (blockIdx.x == 0) {
        unsigned* ctl = (unsigned*)(ws + WS_CTL);
        if (tid < 64) {
            if (tid == 0) { ctl[CW_QUEUE] = 0u; ctl[256] = 0u; ctl[257] = 0u; }
            const float s1 = wave_sum(a.in[8][tid] * a.in[9][tid]), s2 = wave_sum(a.in[10][tid] * a.in[11][tid]);
            if (tid == 0) ((float*)ctl)[CW_LAM] = __expf(s1) - __expf(s2) + 0.2f;
            float gq = fabsf(a.in[6][tid]), gk = fabsf(a.in[7][tid]);
#pragma unroll
            for (int o = 1; o < 64; o <<= 1) { gq = fmaxf(gq, __shfl_xor(gq, o)); gk = fmaxf(gk, __shfl_xor(gk, o)); }
            if (tid == 0) ((float*)ctl)[CW_SMAX] = 64.f * 0.125f * 1.4426950408889634f * gq * gk;
        }
    }
}

struct SchedIn {
    int v, G; const char* H; const char* WIN; const char* MEMN; const char* WKV;
    __device__ __forceinline__ bool next(int i, Unit& u) const {
        long L = (long)i * G + v; int pm, pn;
        if (L < 5760) { TileMap{192, 30}.get(L, pm, pn); u.A = H + (size_t)pm * MiB; u.B = WIN + (size_t)pn * MiB; u.nt = 32; u.pm = pm; u.pn = pn; u.kind = 0; u.t0 = 0; u.T = 0; return true; }
        L -= 5760; if (L < 40) { pm = (int)(L % 5); pn = (int)(L / 5); u.A = MEMN + (size_t)pm * MiB; u.B = WKV + (size_t)pn * MiB; u.nt = 32; u.pm = pm; u.pn = pn; u.kind = 1; u.t0 = 0; u.T = 0; return true; }
        return false;
    }
};
struct EpiIn {
    bf16_t* QK; bf16_t* VM; bf16_t* ZR; bf16_t* KVM; const float* qn; const float* kn; const float* rc; const float* rs;
    __device__ __forceinline__ void plain(const f32x4 (&acc)[2][2][4][2], bf16_t* base, size_t ldc, int row0, int col0) const {
#pragma unroll
        for (int ai = 0; ai < 2; ++ai)
#pragma unroll
            for (int m = 0; m < 4; ++m) { bf16_t* rowp = base + (size_t)(row0 + ai * 128 + m * 16) * ldc + col0;
#pragma unroll
                for (int bj = 0; bj < 2; ++bj) { const f32x4 v0 = acc[ai][bj][m][0], v1 = acc[ai][bj][m][1];
                    u32x4 w; w.x = cvt_pk_bf16(v0[0], v0[1]); w.y = cvt_pk_bf16(v0[2], v0[3]); w.z = cvt_pk_bf16(v1[0], v1[1]); w.w = cvt_pk_bf16(v1[2], v1[3]);
                    *(u32x4*)(rowp + bj * 128) = w; } }
    }
    __device__ __forceinline__ void operator()(const f32x4 (&acc)[2][2][4][2], const Unit& u, int wr, int wc, int fr, int fq) const {
        const int row0 = u.pm * 256 + wr * 64 + fr, cin = wc * 32 + 8 * fq;
        if (u.kind == 1) { plain(acc, KVM, 2048, row0, u.pn * 256 + cin); return; }
        const int pn = u.pn;
        if (pn < 8) {
            const bool isq = pn < 4; const float* nw = isq ? qn : kn;
            const int Gq = (pn & 3) * 4 + wc, d0 = 8 * fq;
            const float qs = isq ? 0.125f * 1.4426950408889634f : 1.f;
            const f32x4 w1a = *(const f32x4*)(nw + d0), w1b = *(const f32x4*)(nw + d0 + 4), w2a = *(const f32x4*)(nw + 32 + d0), w2b = *(const f32x4*)(nw + 36 + d0);
            bf16_t* dst = QK + (isq ? 0 : 1024) + Gq * 64 + d0;
#pragma unroll
            for (int ai = 0; ai < 2; ++ai)
#pragma unroll
                for (int m = 0; m < 4; ++m) {
                    const int row = row0 + ai * 128 + m * 16, t = tok_pos(row);
                    const f32x4 xa = acc[ai][0][m][0], xb = acc[ai][0][m][1], ya = acc[ai][1][m][0], yb = acc[ai][1][m][1];
                    float ss = (xa[0] * xa[0] + xa[1] * xa[1]) + (xa[2] * xa[2] + xa[3] * xa[3]) + (xb[0] * xb[0] + xb[1] * xb[1]) + (xb[2] * xb[2] + xb[3] * xb[3])
                             + (ya[0] * ya[0] + ya[1] * ya[1]) + (ya[2] * ya[2] + ya[3] * ya[3]) + (yb[0] * yb[0] + yb[1] * yb[1]) + (yb[2] * yb[2] + yb[3] * yb[3]);
                    ss += __shfl_xor(ss, 16); ss += __shfl_xor(ss, 32);
                    const float rstd = rsqrtf(ss * (1.f / 64.f) + 1e-6f);
                    const f32x4 ca = *(const f32x4*)(rc + t * 32 + d0), cb = *(const f32x4*)(rc + t * 32 + d0 + 4), sa = *(const f32x4*)(rs + t * 32 + d0), sb = *(const f32x4*)(rs + t * 32 + d0 + 4);
                    const f32x4 x1a = xa * rstd * w1a, x1b = xb * rstd * w1b, x2a = ya * rstd * w2a, x2b = yb * rstd * w2b;
                    const f32x4 o1a = (x1a * ca - x2a * sa) * qs, o1b = (x1b * cb - x2b * sb) * qs, o2a = (x2a * ca + x1a * sa) * qs, o2b = (x2b * cb + x1b * sb) * qs;
                    u32x4 w; w.x = cvt_pk_bf16(o1a[0], o1a[1]); w.y = cvt_pk_bf16(o1a[2], o1a[3]); w.z = cvt_pk_bf16(o1b[0], o1b[1]); w.w = cvt_pk_bf16(o1b[2], o1b[3]);
                    *(u32x4*)(dst + (size_t)row * 2048) = w;
                    w.x = cvt_pk_bf16(o2a[0], o2a[1]); w.y = cvt_pk_bf16(o2a[2], o2a[3]); w.z = cvt_pk_bf16(o2b[0], o2b[1]); w.w = cvt_pk_bf16(o2b[2], o2b[3]);
                    *(u32x4*)(dst + (size_t)row * 2048 + 32) = w;
                }
        } else if (pn < 12) plain(acc, VM, 2048, row0, (pn - 8) * 256 + cin);
        else if (pn < 26) plain(acc, ZR, ZRP, row0, (pn - 12) * 256 + cin);
        else plain(acc, VM, 2048, row0, 1024 + (pn - 26) * 256 + cin);
    }
};

namespace att {
constexpr int SHM_V = 16384, SHM_K = 8192;
constexpr int OFF_V = 0, OFF_K = 32768, OFF_WS = 49152, OFF_STASH = 51200;
#define KSWZ64(row, colB) ((row) * 128 + ((colB) ^ (((row) & 7) << 4)))
#define SBAR() __builtin_amdgcn_sched_barrier(0)
__device__ __forceinline__ int crow(int r, int hi) { return (r & 3) + 8 * (r >> 2) + 4 * hi; }
constexpr float THRL = 8.f;
__device__ __forceinline__ void partialSM(f32x16& p0, f32x16& p1, float& m_reg, float& alpha) {
    float pmax = fmaxf(fmaxf(p0[0], p0[1]), p0[2]);
#pragma unroll
    for (int r = 3; r < 15; r += 2) pmax = fmaxf(fmaxf(pmax, p0[r]), p0[r + 1]);
    pmax = fmaxf(fmaxf(pmax, p0[15]), p1[0]);
#pragma unroll
    for (int r = 1; r < 15; r += 2) pmax = fmaxf(fmaxf(pmax, p1[r]), p1[r + 1]);
    pmax = fmaxf(pmax, p1[15]);
    { auto rr = __builtin_amdgcn_permlane32_swap(__float_as_uint(pmax), __float_as_uint(pmax), false, false);
      pmax = fmaxf(__uint_as_float(rr[0]), __uint_as_float(rr[1])); }
    if (__builtin_expect(__all(pmax <= THRL), 1)) { alpha = 1.f; }
    else { const float dl = fmaxf(pmax, 0.f); alpha = __builtin_amdgcn_exp2f(-dl); m_reg += dl;
#pragma unroll
        for (int r = 0; r < 16; ++r) { p0[r] -= dl; p1[r] -= dl; } }
#pragma unroll
    for (int r = 0; r < 16; ++r) p0[r] = __builtin_amdgcn_exp2f(p0[r]);
}
__device__ __forceinline__ void finishSM(f32x16& p0, f32x16& p1, float alpha, float& l_reg, bf16x8& pa0, bf16x8& pa1, bf16x8& pa2, bf16x8& pa3) {
#pragma unroll
    for (int r = 0; r < 16; ++r) p1[r] = __builtin_amdgcn_exp2f(p1[r]);
    f32x2 s2 = (f32x2){p0[0], p0[1]} + (f32x2){p1[0], p1[1]};
#pragma unroll
    for (int r = 2; r < 16; r += 2) { s2 = s2 + (f32x2){p0[r], p0[r + 1]}; s2 = s2 + (f32x2){p1[r], p1[r + 1]}; }
    float ps = s2[0] + s2[1];
    { auto rr = __builtin_amdgcn_permlane32_swap(__float_as_uint(ps), __float_as_uint(ps), false, false);
      ps = __uint_as_float(rr[0]) + __uint_as_float(rr[1]); }
    l_reg = l_reg * alpha + ps;
#define PK4(P, BASE, OUT) do { unsigned a0 = cvt_pk_bf16(P[BASE + 0], P[BASE + 1]), a1 = cvt_pk_bf16(P[BASE + 2], P[BASE + 3]);   \
    unsigned b0 = cvt_pk_bf16(P[BASE + 4], P[BASE + 5]), b1 = cvt_pk_bf16(P[BASE + 6], P[BASE + 7]);                              \
    auto r0 = __builtin_amdgcn_permlane32_swap(a0, b0, false, false); auto r1 = __builtin_amdgcn_permlane32_swap(a1, b1, false, false); \
    u32x4 w = {r0[0], r1[0], r0[1], r1[1]}; OUT = *reinterpret_cast<bf16x8*>(&w); } while (0)
    PK4(p0, 0, pa0); PK4(p0, 8, pa1); PK4(p1, 0, pa2); PK4(p1, 8, pa3);
#undef PK4
}
__device__ __forceinline__ void qkt64(f32x16& p0, f32x16& p1, const char* Ks, const bf16x8* qr, int r32, int hi) {
#pragma unroll
    for (int d0 = 0; d0 < 4; ++d0) { const int cb = (d0 * 16 + hi * 8) * 2;
        const bf16x8 b0 = *reinterpret_cast<const bf16x8*>(Ks + KSWZ64(r32, cb));
        const bf16x8 b1 = *reinterpret_cast<const bf16x8*>(Ks + KSWZ64(32 + r32, cb));
        p0 = __builtin_amdgcn_mfma_f32_32x32x16_bf16(b0, qr[d0], p0, 0, 0, 0);
        p1 = __builtin_amdgcn_mfma_f32_32x32x16_bf16(b1, qr[d0], p1, 0, 0, 0); }
}
__device__ __forceinline__ int v_st(int k, int c) { const int kk = (k & ~0xC) | ((k & 4) << 1) | ((k & 8) >> 1); return ((kk >> 3) * 4 + (c >> 5)) * 512 + ((kk & 7) * 32 + (c & 31)) * 2; }
__device__ __forceinline__ int v_rd_base(int lane) { return ((lane & 3) << 3) | (((lane >> 2) & 3) << 6) | (((lane >> 4) & 1) << 5) | (((lane >> 5) & 1) << 8); }
constexpr int v_rd_off(int d0, int ks, int half) { return d0 * 512 + ks * 4096 + half * 2048; }
template <int OFF> __device__ __forceinline__ s16x4 tr_read(int vb) {
    s16x4 r; asm volatile("ds_read_b64_tr_b16 %0, %1 offset:%2" : "=&v"(r) : "v"(vb), "i"(OFF) : "memory"); return r;
}
template <int KS> __device__ __forceinline__ void pv_ks(f32x16* o, int vb, bf16x8 pa) {
    const s16x4 l0 = tr_read<v_rd_off(0, KS, 0)>(vb), h0 = tr_read<v_rd_off(0, KS, 1)>(vb), l1 = tr_read<v_rd_off(1, KS, 0)>(vb), h1 = tr_read<v_rd_off(1, KS, 1)>(vb);
    const s16x4 l2 = tr_read<v_rd_off(2, KS, 0)>(vb), h2 = tr_read<v_rd_off(2, KS, 1)>(vb), l3 = tr_read<v_rd_off(3, KS, 0)>(vb), h3 = tr_read<v_rd_off(3, KS, 1)>(vb);
    asm volatile("s_waitcnt lgkmcnt(0)" ::: "memory"); SBAR();
#define PK(L, H) (bf16x8){L[0], L[1], L[2], L[3], H[0], H[1], H[2], H[3]}
    o[0] = __builtin_amdgcn_mfma_f32_32x32x16_bf16(pa, PK(l0, h0), o[0], 0, 0, 0);
    o[1] = __builtin_amdgcn_mfma_f32_32x32x16_bf16(pa, PK(l1, h1), o[1], 0, 0, 0);
    o[2] = __builtin_amdgcn_mfma_f32_32x32x16_bf16(pa, PK(l2, h2), o[2], 0, 0, 0);
    o[3] = __builtin_amdgcn_mfma_f32_32x32x16_bf16(pa, PK(l3, h3), o[3], 0, 0, 0);
#undef PK
}
__device__ __forceinline__ void pv_d0(f32x16* o, int vb, bf16x8 pa0, bf16x8 pa1, bf16x8 pa2, bf16x8 pa3) {
    pv_ks<0>(o, vb, pa0); pv_ks<1>(o, vb, pa1); pv_ks<2>(o, vb, pa2); pv_ks<3>(o, vb, pa3);
}

__device__ __forceinline__ void stash_store(const unsigned* stash, bf16_t* Ow, int ldo, int lane) {
#pragma unroll
    for (int i = 0; i < 8; ++i) { const int q = i * 64 + lane, rl = q >> 4, c8 = (q & 15) * 8, hh = (rl >> 2) & 1, r = (rl & 3) + 4 * (rl >> 3), d0 = c8 >> 5, cc = c8 & 31;
        const unsigned* sp = stash + (d0 * 8 + (r >> 1)) * 64 + hh * 32 + cc; const u32x4 a = *(const u32x4*)sp, b = *(const u32x4*)(sp + 4);
        u32x4 w;
        if (r & 1) { w.x = (a.x >> 16) | (a.y & 0xffff0000u); w.y = (a.z >> 16) | (a.w & 0xffff0000u); w.z = (b.x >> 16) | (b.y & 0xffff0000u); w.w = (b.z >> 16) | (b.w & 0xffff0000u); }
        else { w.x = (a.x & 0xffffu) | (a.y << 16); w.y = (a.z & 0xffffu) | (a.w << 16); w.z = (b.x & 0xffffu) | (b.y << 16); w.w = (b.z & 0xffffu) | (b.w << 16); }
        *(u32x4*)(Ow + (size_t)rl * ldo + c8) = w; }
}

template <bool FX> __device__ __forceinline__ void diff_unit(int s, int h, int qb, bf16_t* QK, const bf16_t* VM, float lam, char* lds) {
    constexpr int LDK = 2048;
    int tid = threadIdx.x; asm volatile("" : "+v"(tid));
    const int wid = __builtin_amdgcn_readfirstlane(tid >> 6), lane = tid & 63, r32 = lane & 31, hi = lane >> 5;
    const int tok0 = seq_start(s), T = seq_len(s), NTL = T / 64;
    char* V_lds = lds + OFF_V; char* K_lds = lds + OFF_K;
    float* wsf = (float*)(lds + OFF_WS) + wid * 64; float* li_l = wsf; float* al_l = wsf + 32;
    unsigned* stash = (unsigned*)(lds + OFF_STASH) + wid * 2048;
    const int sr = tid >> 4, sc = (tid & 15) * 8, vst0 = v_st(sr, sc), vst1 = v_st(32 + sr, sc);
    const int kr = tid >> 3, kc = (tid & 7) * 8, kst = KSWZ64(kr, kc * 2);
    const int vb0 = (int)(uintptr_t)V_lds + v_rd_base(lane);
    const bf16_t* Vh = VM + (size_t)tok0 * LDK + h * 128;
    const size_t qrow = (size_t)(tok0 + qb * 256 + wid * 32);
#pragma unroll 1
    for (int c = 0; c < 2; ++c) {
        const bf16_t* Kh = QK + (size_t)tok0 * LDK + 1024 + h * 128 + c * 64;
        const bf16_t* Qw = QK + (qrow + r32) * LDK + h * 128 + c * 64 + hi * 8;
        bf16x8 qr[4];
#pragma unroll
        for (int d0 = 0; d0 < 4; ++d0) qr[d0] = *reinterpret_cast<const bf16x8*>(Qw + d0 * 16);
        float m_reg = 0.f, l_reg = 0; f32x16 o[4] = {};
        struct { bf16x8 vs0, vs1, ks0; } sr_[2];
#define NEGM(P) do { const float nm_ = FX ? 0.f : -m_reg; _Pragma("unroll") for (int r_ = 0; r_ < 16; ++r_) P[r_] = nm_; } while (0)
#define PSM(P0, P1, AL) do { if constexpr (FX) { AL = 1.f; _Pragma("unroll") for (int r_ = 0; r_ < 16; ++r_) P0[r_] = __builtin_amdgcn_exp2f(P0[r_]); } else partialSM(P0, P1, m_reg, AL); } while (0)
#define SLOAD(i, k0) do { sr_[i].vs0 = *reinterpret_cast<const bf16x8*>(&Vh[(size_t)((k0) + sr) * LDK + sc]); sr_[i].vs1 = *reinterpret_cast<const bf16x8*>(&Vh[(size_t)((k0) + 32 + sr) * LDK + sc]); \
    sr_[i].ks0 = *reinterpret_cast<const bf16x8*>(&Kh[(size_t)((k0) + kr) * LDK + kc]); } while (0)
#define SWRITE(b, i) do { *(bf16x8*)(V_lds + (b) * SHM_V + vst0) = sr_[i].vs0; *(bf16x8*)(V_lds + (b) * SHM_V + vst1) = sr_[i].vs1; *(bf16x8*)(K_lds + (b) * SHM_K + kst) = sr_[i].ks0; } while (0)
#define SWAIT() asm volatile("s_waitcnt vmcnt(3)" ::: "memory")
#define RESC(a) do { if (!FX && __any((a) < 1.f)) { if (hi == 0) al_l[r32] = (a); asm volatile("s_waitcnt lgkmcnt(0)" ::: "memory"); \
    _Pragma("unroll") for (int d = 0; d < 4; ++d) _Pragma("unroll") for (int r = 0; r < 16; ++r) o[d][r] *= al_l[crow(r, hi)]; } } while (0)
        f32x16 pA0, pA1, pB0, pB1; float alA, alB; bf16x8 pa0, pa1, pa2, pa3;
        SLOAD(0, 0); asm volatile("s_waitcnt vmcnt(0)" ::: "memory"); SWRITE(0, 0); __syncthreads();
        NEGM(pA0); NEGM(pA1); qkt64(pA0, pA1, K_lds, qr, r32, hi); PSM(pA0, pA1, alA);
        SLOAD(1, 64); if (2 < NTL) SLOAD(0, 128);
        SWAIT(); SWRITE(1, 1); __syncthreads();
        for (int j = 1; j + 1 < NTL; j += 2) {
            SBAR(); NEGM(pB0); NEGM(pB1); qkt64(pB0, pB1, K_lds + SHM_K, qr, r32, hi);
            finishSM(pA0, pA1, alA, l_reg, pa0, pa1, pa2, pa3); SBAR();
            SLOAD(1, (j + 2) * 64); SBAR();
            pv_d0(o, vb0, pa0, pa1, pa2, pa3); PSM(pB0, pB1, alB);
            __syncthreads(); SWAIT(); SWRITE(0, 0);
            RESC(alB); __syncthreads();
            SBAR(); NEGM(pA0); NEGM(pA1); qkt64(pA0, pA1, K_lds, qr, r32, hi);
            finishSM(pB0, pB1, alB, l_reg, pa0, pa1, pa2, pa3); SBAR();
            if (j + 3 < NTL) SLOAD(0, (j + 3) * 64); SBAR();
            pv_d0(o, vb0 + SHM_V, pa0, pa1, pa2, pa3); PSM(pA0, pA1, alA);
            __syncthreads(); SWAIT(); SWRITE(1, 1);
            RESC(alA); __syncthreads();
        }
        SBAR(); NEGM(pB0); NEGM(pB1); qkt64(pB0, pB1, K_lds + SHM_K, qr, r32, hi);
        finishSM(pA0, pA1, alA, l_reg, pa0, pa1, pa2, pa3); SBAR();
        pv_d0(o, vb0, pa0, pa1, pa2, pa3); PSM(pB0, pB1, alB);
        __syncthreads(); RESC(alB);
        finishSM(pB0, pB1, alB, l_reg, pa0, pa1, pa2, pa3); SBAR();
        pv_d0(o, vb0 + SHM_V, pa0, pa1, pa2, pa3);
#undef SLOAD
#undef SWRITE
#undef SWAIT
#undef RESC
#undef NEGM
#undef PSM
        if (hi == 0) li_l[r32] = l_reg; asm volatile("s_waitcnt lgkmcnt(0)" ::: "memory");
        float rli[16];
#pragma unroll
        for (int r = 0; r < 16; ++r) rli[r] = __builtin_amdgcn_rcpf(li_l[crow(r, hi)]);
        { const float coef = c == 0 ? 1.f : -lam;
#pragma unroll
          for (int d0 = 0; d0 < 4; ++d0)
#pragma unroll
              for (int r = 0; r < 16; r += 2) { const int idx = (d0 * 8 + (r >> 1)) * 64 + lane; const unsigned w = c == 0 ? 0u : stash[idx];
                  stash[idx] = cvt_pk_bf16(bflo(w) + coef * o[d0][r] * rli[r], bfhi(w) + coef * o[d0][r + 1] * rli[r + 1]); } }
        __syncthreads();
    }
    stash_store(stash, QK + qrow * LDK + h * 128, LDK, lane);
    __syncthreads();
}

constexpr int MOFF_V = 0, MOFF_K = 32768, MOFF_WS = 65536, MOFF_RK = 67584, MOFF_G = 68608, MOFF_STASH = 69632;
__device__ __forceinline__ void mem_unit(int s, int mh, int qb, bf16_t* VM, const bf16_t* KVM, const float* mqn, const float* mkn, char* lds) {
    int tid = threadIdx.x; asm volatile("" : "+v"(tid));
    const int wid = __builtin_amdgcn_readfirstlane(tid >> 6), lane = tid & 63, r32 = lane & 31, hi = lane >> 5;
    const int tok0 = seq_start(s);
    char* V_lds = lds + MOFF_V; char* K_lds = lds + MOFF_K;
    float* wsf = (float*)(lds + MOFF_WS) + wid * 64; float* li_l = wsf; float* al_l = wsf + 32;
    float* rk_l = (float*)(lds + MOFF_RK); float* g_l = (float*)(lds + MOFF_G);
    const bf16_t* Kh = KVM + (size_t)(s * 256) * 2048 + mh * 256;
    const bf16_t* Vh = KVM + (size_t)(s * 256) * 2048 + 1024 + mh * 256;
    if (tid < 256) g_l[tid] = mqn[tid] * mkn[tid];
    {
        const bf16_t* kp = Kh + (size_t)(wid * 32 + r32) * 2048 + hi * 128; float ss = 0.f;
#pragma unroll
        for (int i = 0; i < 16; ++i) { const u32x4 w = *(const u32x4*)(kp + i * 8);
            ss += bflo(w.x) * bflo(w.x) + bfhi(w.x) * bfhi(w.x) + bflo(w.y) * bflo(w.y) + bfhi(w.y) * bfhi(w.y) + bflo(w.z) * bflo(w.z) + bfhi(w.z) * bfhi(w.z) + bflo(w.w) * bflo(w.w) + bfhi(w.w) * bfhi(w.w); }
        ss += __shfl_xor(ss, 32);
        if (hi == 0) rk_l[wid * 32 + r32] = rsqrtf(ss * (1.f / 256.f) + 1e-6f);
    }
    const size_t qrow = (size_t)(tok0 + qb * 256 + wid * 32);
    bf16_t* Qw = VM + (qrow + r32) * 2048 + 1024 + mh * 256 + hi * 8;
    float rqC;
    { float ss = 0.f;
#pragma unroll
      for (int i = 0; i < 16; ++i) { const u32x4 w = *(const u32x4*)(Qw + i * 16);
          ss += bflo(w.x) * bflo(w.x) + bfhi(w.x) * bfhi(w.x) + bflo(w.y) * bflo(w.y) + bfhi(w.y) * bfhi(w.y) + bflo(w.z) * bflo(w.z) + bfhi(w.z) * bfhi(w.z) + bflo(w.w) * bflo(w.w) + bfhi(w.w) * bfhi(w.w); }
      ss += __shfl_xor(ss, 32);
      rqC = rsqrtf(ss * (1.f / 256.f) + 1e-6f) * (0.0625f * 1.4426950408889634f); }
    const int sr = tid >> 4, sc = (tid & 15) * 8, vst0 = v_st(sr, sc), vst1 = v_st(32 + sr, sc);
    const int kr = tid >> 3, kc = (tid & 7) * 8, kst = KSWZ64(kr, kc * 2);
    const int vb0 = (int)(uintptr_t)V_lds + v_rd_base(lane);
    unsigned* stash = (unsigned*)(lds + MOFF_STASH) + wid * 2048;
    __syncthreads();
#pragma unroll 1
    for (int hv = 0; hv < 2; ++hv) {
    float m_reg = -1e30f, l_reg = 0.f; f32x16 o[4] = {};
#pragma unroll 1
    for (int t = 0; t < 4; ++t) {
        const int k0 = t * 64;
#pragma unroll
        for (int ds = 0; ds < 4; ++ds) { const u32x4 w = *(const u32x4*)(Kh + (size_t)(k0 + kr) * 2048 + ds * 64 + kc); const float* g = g_l + ds * 64 + kc;
            u32x4 o4; o4.x = cvt_pk_bf16(bflo(w.x) * g[0], bfhi(w.x) * g[1]); o4.y = cvt_pk_bf16(bflo(w.y) * g[2], bfhi(w.y) * g[3]);
            o4.z = cvt_pk_bf16(bflo(w.z) * g[4], bfhi(w.z) * g[5]); o4.w = cvt_pk_bf16(bflo(w.w) * g[6], bfhi(w.w) * g[7]);
            *(u32x4*)(K_lds + ds * 8192 + kst) = o4; asm volatile("" ::: "memory"); }
        *(u32x4*)(V_lds + vst0) = *(const u32x4*)(Vh + (size_t)(k0 + sr) * 2048 + hv * 128 + sc);
        *(u32x4*)(V_lds + vst1) = *(const u32x4*)(Vh + (size_t)(k0 + 32 + sr) * 2048 + hv * 128 + sc);
        __syncthreads();
        f32x16 p0 = {}, p1 = {};
#pragma unroll
        for (int ds = 0; ds < 4; ++ds) { bf16x8 qr[4];
#pragma unroll
            for (int d0 = 0; d0 < 4; ++d0) qr[d0] = *reinterpret_cast<const bf16x8*>(Qw + ds * 64 + d0 * 16);
            qkt64(p0, p1, K_lds + ds * 8192, qr, r32, hi); }
#pragma unroll
        for (int r = 0; r < 16; ++r) { p0[r] *= rk_l[k0 + crow(r, hi)] * rqC; p1[r] *= rk_l[k0 + 32 + crow(r, hi)] * rqC; }
        float pmax = p0[0];
#pragma unroll
        for (int r = 1; r < 16; ++r) pmax = fmaxf(pmax, p0[r]);
#pragma unroll
        for (int r = 0; r < 16; ++r) pmax = fmaxf(pmax, p1[r]);
        pmax = fmaxf(pmax, __shfl_xor(pmax, 32));
        const float mn = fmaxf(m_reg, pmax), alpha = __builtin_amdgcn_exp2f(m_reg - mn); m_reg = mn;
        float ps = 0.f;
#pragma unroll
        for (int r = 0; r < 16; ++r) { p0[r] = __builtin_amdgcn_exp2f(p0[r] - mn); p1[r] = __builtin_amdgcn_exp2f(p1[r] - mn); ps += p0[r] + p1[r]; }
        ps += __shfl_xor(ps, 32);
        l_reg = l_reg * alpha + ps;
        if (hi == 0) al_l[r32] = alpha; asm volatile("s_waitcnt lgkmcnt(0)" ::: "memory");
#pragma unroll
        for (int d = 0; d < 4; ++d)
#pragma unroll
            for (int r = 0; r < 16; ++r) o[d][r] *= al_l[crow(r, hi)];
        bf16x8 pa0, pa1, pa2, pa3;
#define PK4(P, BASE, OUT) do { unsigned a0 = cvt_pk_bf16(P[BASE + 0], P[BASE + 1]), a1 = cvt_pk_bf16(P[BASE + 2], P[BASE + 3]);   \
    unsigned b0 = cvt_pk_bf16(P[BASE + 4], P[BASE + 5]), b1 = cvt_pk_bf16(P[BASE + 6], P[BASE + 7]);                              \
    auto r0 = __builtin_amdgcn_permlane32_swap(a0, b0, false, false); auto r1 = __builtin_amdgcn_permlane32_swap(a1, b1, false, false); \
    u32x4 w = {r0[0], r1[0], r0[1], r1[1]}; OUT = *reinterpret_cast<bf16x8*>(&w); } while (0)
        PK4(p0, 0, pa0); PK4(p0, 8, pa1); PK4(p1, 0, pa2); PK4(p1, 8, pa3);
#undef PK4
        pv_d0(o, vb0, pa0, pa1, pa2, pa3);
        __syncthreads();
    }
    if (hi == 0) li_l[r32] = l_reg; asm volatile("s_waitcnt lgkmcnt(0)" ::: "memory");
    if (hv == 1) stash_store(stash, VM + qrow * 2048 + 1024 + mh * 256, 2048, lane);
#pragma unroll
    for (int d0 = 0; d0 < 4; ++d0)
#pragma unroll
        for (int r = 0; r < 16; r += 2) stash[(d0 * 8 + (r >> 1)) * 64 + lane] = cvt_pk_bf16(o[d0][r] * __builtin_amdgcn_rcpf(li_l[crow(r, hi)]), o[d0][r + 1] * __builtin_amdgcn_rcpf(li_l[crow(r + 1, hi)]));
    }
    stash_store(stash, VM + qrow * 2048 + 1024 + mh * 256 + 128, 2048, lane);
    __syncthreads();
}
#undef SBAR
}

namespace scan {
constexpr int TC = 32;
typedef _Float16 h2 __attribute__((ext_vector_type(2)));
typedef _Float16 h4 __attribute__((ext_vector_type(4)));
typedef _Float16 h8 __attribute__((ext_vector_type(8)));
constexpr int BUFB = 36864, O_R = 0, O_KD = 4096, O_KK = 8192, O_W = 12288, O_KA = 16384, O_V = 20480, O_Y = 28672;
constexpr int O_PRIV = 73728;
constexpr int O_TBL = 73728 + 32768;
__device__ __forceinline__ float dpp_red8(float x) {
    x += __uint_as_float(__builtin_amdgcn_update_dpp(0u, __float_as_uint(x), 0xB1, 0xf, 0xf, false));
    x += __uint_as_float(__builtin_amdgcn_update_dpp(0u, __float_as_uint(x), 0x4E, 0xf, 0xf, false));
    x += __uint_as_float(__builtin_amdgcn_update_dpp(0u, __float_as_uint(x), 0x141, 0xf, 0xf, false));
    return x;
}
template <int DIR> __device__ __forceinline__ void scan_chunk(const char* B_, h2 (&S)[2][4], int seg, int row0) {
    const char* base = B_ + seg * 16; const char* vbase = B_ + O_V + row0 * 4; char* ybase = (char*)B_ + O_Y + row0 * 4;
    u32x4 ck[2], cw[2], ca[2], cd[2], cr[2]; u32x2 cv[2];
#define LDSET(set, tl_) do { ck[set] = *(const u32x4*)(base + O_KK + (tl_) * 128); cw[set] = *(const u32x4*)(base + O_W + (tl_) * 128); ca[set] = *(const u32x4*)(base + O_KA + (tl_) * 128); \
    cd[set] = *(const u32x4*)(base + O_KD + (tl_) * 128); cr[set] = *(const u32x4*)(base + O_R + (tl_) * 128); cv[set] = *(const u32x2*)(vbase + (tl_) * 256); } while (0)
#define H2(u) __builtin_bit_cast(h2, (u))
    LDSET(0, DIR ? TC - 1 : 0);
#pragma unroll
    for (int st = 0; st < TC; ++st) {
        const int tl = DIR ? TC - 1 - st : st, cs = st & 1;
        if (st + 1 < TC) LDSET(cs ^ 1, DIR ? TC - 2 - st : st + 1);
#define SPLIT4(V, A0, A1, A2, A3) const h8 V##8 = __builtin_bit_cast(h8, V[cs]); const h2 A0 = __builtin_shufflevector(V##8, V##8, 0, 1), A1 = __builtin_shufflevector(V##8, V##8, 2, 3), \
    A2 = __builtin_shufflevector(V##8, V##8, 4, 5), A3 = __builtin_shufflevector(V##8, V##8, 6, 7)
        SPLIT4(ck, k0, k1, k2, k3); SPLIT4(cw, w0, w1, w2, w3); SPLIT4(ca, a0, a1, a2, a3); SPLIT4(cd, d0, d1, d2, d3); SPLIT4(cr, r0, r1, r2, r3);
#undef SPLIT4
        const h4 cv4 = __builtin_bit_cast(h4, cv[cs]);
        f32x2 yo;
#pragma unroll
        for (int h = 0; h < 2; ++h) {
            const h2 vv = h == 0 ? __builtin_shufflevector(cv4, cv4, 0, 1) : __builtin_shufflevector(cv4, cv4, 2, 3);
            float d = __builtin_amdgcn_fdot2(S[h][0], k0, 0.f, false); float e = __builtin_amdgcn_fdot2(S[h][2], k2, 0.f, false);
            d = __builtin_amdgcn_fdot2(S[h][1], k1, d, false); e = __builtin_amdgcn_fdot2(S[h][3], k3, e, false);
            d = dpp_red8(d + e);
            const h2 p0 = S[h][0] * w0 + vv * d0, p1 = S[h][1] * w1 + vv * d1, p2 = S[h][2] * w2 + vv * d2, p3 = S[h][3] * w3 + vv * d3;
            const _Float16 sh = (_Float16)(-d); const h2 sa = {sh, sh};
            S[h][0] = p0 + sa * a0; S[h][1] = p1 + sa * a1; S[h][2] = p2 + sa * a2; S[h][3] = p3 + sa * a3;
            float y = __builtin_amdgcn_fdot2(S[h][0], r0, 0.f, false); float z = __builtin_amdgcn_fdot2(S[h][2], r2, 0.f, false);
            y = __builtin_amdgcn_fdot2(S[h][1], r1, y, false); z = __builtin_amdgcn_fdot2(S[h][3], r3, z, false);
            yo[h] = dpp_red8(y + z);
        }
        if (seg == 0) *(f32x2*)(ybase + tl * 256) = yo;
    }
#undef LDSET
#undef H2
}
__device__ __forceinline__ unsigned pkh(float a, float b) { const h2 v = {(_Float16)a, (_Float16)b}; return __builtin_bit_cast(unsigned, v); }
struct P {
    const bf16_t* ZR; bf16_t* YB; float* BON;
    const float *mup, *mun, *w0, *w2, *a0, *a2, *kk_w, *ka_w, *rk_w;
};
__device__ __forceinline__ void job(int s, int dir, int head, const P& p, char* lds) {
    int tid = threadIdx.x; asm volatile("" : "+v"(tid));
    const int wid = __builtin_amdgcn_readfirstlane(tid >> 6), lane = tid & 63;
    const int tok0 = seq_start(s), T = seq_len(s), NCH = T / TC;
    float* TBL = (float*)(lds + O_TBL);
    float* MUP = TBL; float* MUN = TBL + 320; float* KKW = TBL + 640; float* KAW = TBL + 704; float* RKW = TBL + 768; float* BW = TBL + 832; float* BA = TBL + 896;
    __syncthreads();
    if (tid < 320) { const int which = tid >> 6, j = tid & 63; const int col = which < 3 ? which * 1024 + head * 64 + j : (which == 3 ? 3072 : 3200) + dir * 64 + j; MUP[tid] = p.mup[col]; MUN[tid] = p.mun[col]; }
    if (tid >= 320 && tid < 384) { const int j = tid - 320; KKW[j] = p.kk_w[head * 64 + j]; KAW[j] = p.ka_w[head * 64 + j]; RKW[j] = p.rk_w[head * 64 + j];
        BW[j] = p.w0[dir * 1024 + head * 64 + j]; BA[j] = p.a0[dir * 1024 + head * 64 + j]; }
    bf16_t* yb = p.YB + (size_t)dir * NT * 1024; float* bon = p.BON + (size_t)dir * NT * 16;
    if (wid >= 4) {
        const int pw = wid - 4;
        char* priv = lds + O_PRIV + pw * 8192;
        bf16_t* AWl = (bf16_t*)priv; bf16_t* AAl = AWl + 512; float* PK = (float*)(priv + 2048); float* PA = (float*)(priv + 4096); float* PR = (float*)(priv + 6144);
        bf16x8 Bf[2][4][2];
#pragma unroll
        for (int mat = 0; mat < 2; ++mat)
#pragma unroll
            for (int cbk = 0; cbk < 4; ++cbk)
#pragma unroll
                for (int ks = 0; ks < 2; ++ks) { const float* W2 = (mat == 0 ? p.w2 : p.a2) + (size_t)dir * 64 * 1024 + head * 64 + cbk * 16 + (lane & 15) + (size_t)(ks * 32 + (lane >> 4) * 8) * 1024;
                    float f[8];
#pragma unroll
                    for (int e = 0; e < 8; ++e) f[e] = W2[(size_t)e * 1024];
                    u32x4 w; w.x = cvt_pk_bf16(f[0], f[1]); w.y = cvt_pk_bf16(f[2], f[3]); w.z = cvt_pk_bf16(f[4], f[5]); w.w = cvt_pk_bf16(f[6], f[7]); Bf[mat][cbk][ks] = *reinterpret_cast<bf16x8*>(&w); }
        __syncthreads();
        const int pt = tid - 256;
        u32x4 zc[5], zm[5], zn[5];
#define PLOAD(cc) do { const int tf_ = dir ? T - TC * ((cc) + 1) : TC * (cc); \
    _Pragma("unroll") for (int k = 0; k < 5; ++k) { const int which = k, tl8 = lane >> 3, j0 = (lane & 7) * 8; \
        const int col = which < 3 ? which * 1024 + head * 64 + j0 : (which == 3 ? 3072 : 3200) + dir * 64 + j0; \
        const int t = tf_ + 8 * pw + tl8; const bf16_t* zp = p.ZR + (size_t)(tok0 + t) * ZRP + col; \
        zc[k] = *(const u32x4*)zp; zm[k] = (u32x4){0u, 0u, 0u, 0u}; zn[k] = (u32x4){0u, 0u, 0u, 0u}; \
        if (t > 0) zm[k] = *(const u32x4*)(zp - ZRP); \
        if (t < T - 1) zn[k] = *(const u32x4*)(zp + ZRP); } } while (0)
        PLOAD(0);
        for (int c = -1; c < NCH; ++c) {
            if (c >= 1) { const int cb_ = (c - 1) & 1, tf = dir ? T - TC * c : TC * (c - 1); const int tl = pt >> 3, c8 = (pt & 7) * 8;
                const float* yp = (const float*)(lds + cb_ * BUFB + O_Y) + tl * 64 + c8; const f32x4 y4 = *(const f32x4*)yp, y5 = *(const f32x4*)(yp + 4);
                u32x4 w; w.x = cvt_pk_bf16(y4[0], y4[1]); w.y = cvt_pk_bf16(y4[2], y4[3]); w.z = cvt_pk_bf16(y5[0], y5[1]); w.w = cvt_pk_bf16(y5[2], y5[3]);
                *(u32x4*)(yb + (size_t)(tok0 + tf + tl) * 1024 + head * 64 + c8) = w; }
            if (c + 1 < NCH) {
                const int nb = (c + 1) & 1, tfirst = dir ? T - TC * (c + 2) : TC * (c + 1);
                char* B_ = lds + nb * BUFB;
#pragma unroll
                for (int k = 0; k < 5; ++k) { const int which = k, tl8 = lane >> 3, j0 = (lane & 7) * 8, tl = 8 * pw + tl8;
                    const f32x4 mpa = *(const f32x4*)(MUP + which * 64 + j0), mpb = *(const f32x4*)(MUP + which * 64 + j0 + 4), mna = *(const f32x4*)(MUN + which * 64 + j0), mnb = *(const f32x4*)(MUN + which * 64 + j0 + 4);
                    const u32x4 z = zc[k], zmm = zm[k], znn = zn[k];
                    float v[8];
#define SH(i, zw, zmw, znw, lohi, mp_, mn_) { const float zz = lohi(zw), a_ = lohi(zmw), b_ = lohi(znw); v[i] = zz + mp_ * (a_ - zz) + mn_ * (b_ - zz); }
                    SH(0, z.x, zmm.x, znn.x, bflo, mpa[0], mna[0]) SH(1, z.x, zmm.x, znn.x, bfhi, mpa[1], mna[1]) SH(2, z.y, zmm.y, znn.y, bflo, mpa[2], mna[2]) SH(3, z.y, zmm.y, znn.y, bfhi, mpa[3], mna[3])
                    SH(4, z.z, zmm.z, znn.z, bflo, mpb[0], mnb[0]) SH(5, z.z, zmm.z, znn.z, bfhi, mpb[1], mnb[1]) SH(6, z.w, zmm.w, znn.w, bflo, mpb[2], mnb[2]) SH(7, z.w, zmm.w, znn.w, bfhi, mpb[3], mnb[3])
#undef SH
                    if (which < 2) { float* dst = (which == 0 ? PR : PK) + tl8 * 64 + j0;
                        *(f32x4*)dst = (f32x4){v[0], v[1], v[2], v[3]}; *(f32x4*)(dst + 4) = (f32x4){v[4], v[5], v[6], v[7]}; }
                    else if (which == 2) { unsigned* dst = (unsigned*)(B_ + O_V) + tl * 64 + j0;
                        *(u32x4*)dst = (u32x4){pkh(v[0], v[0]), pkh(v[1], v[1]), pkh(v[2], v[2]), pkh(v[3], v[3])}; *(u32x4*)(dst + 4) = (u32x4){pkh(v[4], v[4]), pkh(v[5], v[5]), pkh(v[6], v[6]), pkh(v[7], v[7])}; }
                    else { if (which == 3) {
#pragma unroll
                            for (int i = 0; i < 8; ++i) { const float e2 = __expf(2.f * v[i]); v[i] = 1.f - 2.f * __builtin_amdgcn_rcpf(e2 + 1.f); } }
                        u32x4 w; w.x = cvt_pk_bf16(v[0], v[1]); w.y = cvt_pk_bf16(v[2], v[3]); w.z = cvt_pk_bf16(v[4], v[5]); w.w = cvt_pk_bf16(v[6], v[7]);
                        *(u32x4*)((which == 3 ? AWl : AAl) + tl8 * 64 + j0) = w; }
                }
                if (c + 2 < NCH) PLOAD(c + 2);
                { const int tj = lane & 7, kq = lane >> 4;
#pragma unroll
                  for (int mat = 0; mat < 2; ++mat) { const bf16_t* Am = (mat == 0 ? AWl : AAl) + tj * 64 + kq * 8;
                      const bf16x8 y0 = *reinterpret_cast<const bf16x8*>(Am), y1 = *reinterpret_cast<const bf16x8*>(Am + 32);
#pragma unroll
                      for (int cbk = 0; cbk < 4; ++cbk) { f32x4 acc = {0.f, 0.f, 0.f, 0.f};
                          acc = __builtin_amdgcn_mfma_f32_16x16x32_bf16(Bf[mat][cbk][0], y0, acc, 0, 0, 0);
                          acc = __builtin_amdgcn_mfma_f32_16x16x32_bf16(Bf[mat][cbk][1], y1, acc, 0, 0, 0);
                          const int col = cbk * 16 + 4 * kq; const f32x4 bias = *(const f32x4*)((mat == 0 ? BW : BA) + col); f32x4 res;
#pragma unroll
                          for (int r = 0; r < 4; ++r) { const float u = acc[r] + bias[r];
                              const float sg = __builtin_amdgcn_rcpf(1.f + __expf(-u));
                              res[r] = mat == 0 ? __expf(-0.60653065971263342f * sg) : sg; }
                          if ((lane & 15) < 8) { if (mat == 0) *(u32x2*)((_Float16*)(B_ + O_W) + (8 * pw + tj) * 64 + col) = (u32x2){pkh(res[0], res[1]), pkh(res[2], res[3])};
                                                 else *(f32x4*)(PA + tj * 64 + col) = res; } } } }
                { const int t8 = lane >> 3, tl = 8 * pw + t8, c0 = (lane & 7) * 8; const int o = t8 * 64 + c0;
                  float bs = 0.f, ss = 0.f; f32x4 kr[2], k4[2], a4[2], r4[2];
#pragma unroll
                  for (int q = 0; q < 2; ++q) { k4[q] = *(const f32x4*)(PK + o + 4 * q); a4[q] = *(const f32x4*)(PA + o + 4 * q); r4[q] = *(const f32x4*)(PR + o + 4 * q);
                      kr[q] = k4[q] * *(const f32x4*)(KKW + c0 + 4 * q); ss += (kr[q][0] * kr[q][0] + kr[q][1] * kr[q][1]) + (kr[q][2] * kr[q][2] + kr[q][3] * kr[q][3]); }
                  ss = dpp_red8(ss);
                  const float inv = __builtin_amdgcn_rsqf(fmaxf(ss, 1e-24f));
                  f32x4 kk[2], kd[2], kka[2];
#pragma unroll
                  for (int q = 0; q < 2; ++q) { kk[q] = kr[q] * inv; kd[q] = k4[q] * (1.f + (a4[q] - 1.f) * *(const f32x4*)(KAW + c0 + 4 * q)); kka[q] = kk[q] * a4[q];
                      const f32x4 bb = r4[q] * kd[q] * *(const f32x4*)(RKW + c0 + 4 * q); bs += (bb[0] + bb[1]) + (bb[2] + bb[3]); }
                  const int oh = (tl * 64 + c0) * 2;
#define ST8(OFF, X) *(u32x4*)(B_ + (OFF) + oh) = (u32x4){pkh(X[0][0], X[0][1]), pkh(X[0][2], X[0][3]), pkh(X[1][0], X[1][1]), pkh(X[1][2], X[1][3])}
                  ST8(O_KK, kk); ST8(O_KD, kd); ST8(O_KA, kka); ST8(O_R, r4);
#undef ST8
                  bs = dpp_red8(bs);
                  if ((lane & 7) == 0) bon[(size_t)(tok0 + tfirst + tl) * 16 + head] = bs; }
            }
            asm volatile("s_waitcnt lgkmcnt(0)" ::: "memory"); __builtin_amdgcn_s_barrier(); asm volatile("" ::: "memory");
        }
#undef PLOAD
    } else {
        __syncthreads();
        const int row0 = wid * 16 + (lane >> 3) * 2, seg = lane & 7;
        h2 S[2][4];
#pragma unroll
        for (int h = 0; h < 2; ++h)
#pragma unroll
            for (int q = 0; q < 4; ++q) S[h][q] = (h2){(_Float16)0.f, (_Float16)0.f};
        asm volatile("s_waitcnt lgkmcnt(0)" ::: "memory"); __builtin_amdgcn_s_barrier(); asm volatile("" ::: "memory");
        for (int c = 0; c < NCH; ++c) {
            const char* B_ = lds + (c & 1) * BUFB;
            if (dir) scan_chunk<1>(B_, S, seg, row0); else scan_chunk<0>(B_, S, seg, row0);
            asm volatile("s_waitcnt lgkmcnt(0)" ::: "memory"); __builtin_amdgcn_s_barrier(); asm volatile("" ::: "memory");
        }
    }
    if (wid >= 4) {
        const int pt = tid - 256, c = NCH, cb_ = (c - 1) & 1, tf = dir ? T - TC * c : TC * (c - 1); const int tl = pt >> 3, c8 = (pt & 7) * 8;
        const float* yp = (const float*)(lds + cb_ * BUFB + O_Y) + tl * 64 + c8; const f32x4 y4 = *(const f32x4*)yp, y5 = *(const f32x4*)(yp + 4);
        u32x4 w; w.x = cvt_pk_bf16(y4[0], y4[1]); w.y = cvt_pk_bf16(y4[2], y4[3]); w.z = cvt_pk_bf16(y5[0], y5[1]); w.w = cvt_pk_bf16(y5[2], y5[3]);
        *(u32x4*)(yb + (size_t)(tok0 + tf + tl) * 1024 + head * 64 + c8) = w;
    }
    __syncthreads();
}
}

__device__ __forceinline__ void p4_post(const Args& a, char* lds, int vcu, int G) {
    const int tid = threadIdx.x, lane = tid & 63;
    unsigned char* ws = a.ws;
    const bf16_t* ZR = (const bf16_t*)a.out; bf16_t* QK = (bf16_t*)(ws + WS_QK);
    const bf16_t* Y0 = (const bf16_t*)(ws + WS_Y); const bf16_t* Y1 = Y0 + (size_t)NT * 1024;
    const float* BON = (const float*)(ws + WS_BON);
    const float* mup = a.in[13]; const float* mun = a.in[14]; const float* G2 = a.in[19]; const float* lnw = a.in[23]; const float* lnb = a.in[24]; const float* subg = a.in[12];
    bf16_t* SGh = (bf16_t*)lds; float* BL = (float*)(lds + 20480); bf16_t* GL = (bf16_t*)(lds + 24576);
    const bf16_t* G2T = (const bf16_t*)(ws + WS_G2T);
    const int wid = tid >> 6, r32 = lane & 31, hi = lane >> 5;
    for (int tile = vcu; tile < NT / 32; tile += G) {
        const int tk0 = tile * 32;
        __syncthreads();
        for (int it = tid; it < 32 * 20; it += NTHR) {
            const int tl = it / 20, j0 = (it % 20) * 8, col = 3328 + j0, tok = tk0 + tl, t = tok_pos(tok), T = tok < TP ? TP : TS;
            const bf16_t* zp = ZR + (size_t)tok * ZRP + col; const u32x4 z = *(const u32x4*)zp; u32x4 zm = {0u, 0u, 0u, 0u}, zn = {0u, 0u, 0u, 0u};
            if (t > 0) zm = *(const u32x4*)(zp - ZRP);
            if (t < T - 1) zn = *(const u32x4*)(zp + ZRP);
            float v[8];
            const f32x4 mpa = *(const f32x4*)(mup + col), mpb = *(const f32x4*)(mup + col + 4), mna = *(const f32x4*)(mun + col), mnb = *(const f32x4*)(mun + col + 4);
#define SH(i, zw, zmw, znw, lohi) { const float zz = lohi(zw), a_ = lohi(zmw), b_ = lohi(znw), mp_ = (i < 4 ? mpa[i & 3] : mpb[i & 3]), mn_ = (i < 4 ? mna[i & 3] : mnb[i & 3]); v[i] = sigmoidf_(zz + mp_ * (a_ - zz) + mn_ * (b_ - zz)); }
            SH(0, z.x, zm.x, zn.x, bflo) SH(1, z.x, zm.x, zn.x, bfhi) SH(2, z.y, zm.y, zn.y, bflo) SH(3, z.y, zm.y, zn.y, bfhi)
            SH(4, z.z, zm.z, zn.z, bflo) SH(5, z.z, zm.z, zn.z, bfhi) SH(6, z.w, zm.w, zn.w, bflo) SH(7, z.w, zm.w, zn.w, bfhi)
#undef SH
            { u32x4 w; w.x = cvt_pk_bf16(v[0], v[1]); w.y = cvt_pk_bf16(v[2], v[3]); w.z = cvt_pk_bf16(v[4], v[5]); w.w = cvt_pk_bf16(v[6], v[7]); *(u32x4*)(SGh + tl * 160 + j0) = w; }
        }
        { const int tl = tid >> 4, hd = tid & 15; BL[tid] = BON[(size_t)(tk0 + tl) * 16 + hd] + BON[(size_t)NT * 16 + (size_t)(tk0 + tl) * 16 + hd]; }
        { const int pr = tid >> 1, half = tid & 1, tl = pr >> 3, hd = pr & 7; bf16_t* op = QK + (size_t)(tk0 + tl) * 2048 + hd * 128 + half * 64;
          u32x4 w[8]; float ss = 0.f;
#pragma unroll
          for (int i = 0; i < 8; ++i) { w[i] = *(const u32x4*)(op + i * 8);
              ss += bflo(w[i].x) * bflo(w[i].x) + bfhi(w[i].x) * bfhi(w[i].x) + bflo(w[i].y) * bflo(w[i].y) + bfhi(w[i].y) * bfhi(w[i].y) + bflo(w[i].z) * bflo(w[i].z) + bfhi(w[i].z) * bfhi(w[i].z) + bflo(w[i].w) * bflo(w[i].w) + bfhi(w[i].w) * bfhi(w[i].w); }
          ss += __shfl_xor(ss, 1);
          const float rstd = rsqrtf(ss * (1.f / 128.f) + 1e-6f) * 0.8f; const float* sg = subg + half * 64;
#pragma unroll
          for (int i = 0; i < 8; ++i) { u32x4 o;
              o.x = cvt_pk_bf16(bflo(w[i].x) * rstd * sg[i * 8 + 0], bfhi(w[i].x) * rstd * sg[i * 8 + 1]); o.y = cvt_pk_bf16(bflo(w[i].y) * rstd * sg[i * 8 + 2], bfhi(w[i].y) * rstd * sg[i * 8 + 3]);
              o.z = cvt_pk_bf16(bflo(w[i].z) * rstd * sg[i * 8 + 4], bfhi(w[i].z) * rstd * sg[i * 8 + 5]); o.w = cvt_pk_bf16(bflo(w[i].w) * rstd * sg[i * 8 + 6], bfhi(w[i].w) * rstd * sg[i * 8 + 7]);
              *(u32x4*)(op + i * 8) = o; } }
        __syncthreads();
        { f32x16 gacc[4] = {};
#pragma unroll
          for (int ks = 0; ks < 10; ++ks) { const bf16x8 af = *reinterpret_cast<const bf16x8*>(SGh + r32 * 160 + ks * 16 + hi * 8);
#pragma unroll
              for (int cb = 0; cb < 4; ++cb) { const bf16x8 bfr = *reinterpret_cast<const bf16x8*>(G2T + (size_t)(wid * 128 + cb * 32 + r32) * 160 + ks * 16 + hi * 8);
                  gacc[cb] = __builtin_amdgcn_mfma_f32_32x32x16_bf16(af, bfr, gacc[cb], 0, 0, 0); } }
#pragma unroll
          for (int cb = 0; cb < 4; ++cb)
#pragma unroll
              for (int r = 0; r < 16; ++r) GL[(att::crow(r, hi)) * 1024 + wid * 128 + cb * 32 + r32] = (bf16_t)(cvt_pk_bf16(gacc[cb][r], gacc[cb][r]) & 0xffffu); }
        __syncthreads();
        const int c0 = tid * 2;
        const int hd = tid >> 5;
        const float lw0 = lnw[c0], lw1 = lnw[c0 + 1], lb0 = lnb[c0], lb1 = lnb[c0 + 1];
        const float mp0 = mup[2048 + c0], mp1 = mup[2048 + c0 + 1], mn0 = mun[2048 + c0], mn1 = mun[2048 + c0 + 1];
#pragma unroll
        for (int i = 0; i < 32; ++i) {
            const int tok = tk0 + i, t = tok_pos(tok), T = tok < TP ? TP : TS;
            const unsigned ya = *(const unsigned*)(Y0 + (size_t)tok * 1024 + c0), yb = *(const unsigned*)(Y1 + (size_t)tok * 1024 + c0);
            const float y0 = bflo(ya) + bflo(yb), y1 = bfhi(ya) + bfhi(yb);
            float s = y0 + y1, q = y0 * y0 + y1 * y1;
#pragma unroll
            for (int o = 16; o < 32; o <<= 1) { s += __shfl_xor(s, o); q += __shfl_xor(q, o); }
#define DPPADD(x, ctrl) x += __uint_as_float(__builtin_amdgcn_update_dpp(0u, __float_as_uint(x), ctrl, 0xf, 0xf, false))
            DPPADD(s, 0xB1); DPPADD(q, 0xB1); DPPADD(s, 0x4E); DPPADD(q, 0x4E); DPPADD(s, 0x141); DPPADD(q, 0x141); DPPADD(s, 0x140); DPPADD(q, 0x140);
#undef DPPADD
            const float mean = s * (1.f / 64.f), var = fmaxf(q * (1.f / 64.f) - mean * mean, 0.f), rstd = rsqrtf(var + 64e-5f);
            const bf16_t* zp = ZR + (size_t)tok * ZRP + 2048 + c0; const unsigned z = *(const unsigned*)zp;
            unsigned zm = 0u, zn = 0u;
            if (t > 0) zm = *(const unsigned*)(zp - ZRP);
            if (t < T - 1) zn = *(const unsigned*)(zp + ZRP);
            const float v0 = bflo(z) + mp0 * (bflo(zm) - bflo(z)) + mn0 * (bflo(zn) - bflo(z)), v1 = bfhi(z) + mp1 * (bfhi(zm) - bfhi(z)) + mn1 * (bfhi(zn) - bfhi(z));
            const float bo = BL[i * 16 + hd];
            const unsigned gg = *(const unsigned*)(GL + i * 1024 + c0);
            const float o0 = ((y0 - mean) * rstd * lw0 + lb0 + bo * v0) * bflo(gg), o1 = ((y1 - mean) * rstd * lw1 + lb1 + bo * v1) * bfhi(gg);
            *(unsigned*)(QK + (size_t)tok * 2048 + 1024 + c0) = cvt_pk_bf16(o0, o1);
        }
    }
    __syncthreads();
}

struct SchedMerge {
    int v, G; const char* H; const char* WG; const char* QK; const char* VM; const char* PAR; const char* PM2;
    __device__ __forceinline__ bool next(int i, Unit& u) const {
        const int ti = i / 6, kind = i - ti * 6; const long L = (long)ti * G + v; int pm, pn;
        if (!TileMap{192, 8}.get(L, pm, pn)) return false;
        u.pm = pm; u.pn = pn; u.kind = kind; u.t0 = 0; u.T = 0;
        const size_t bo = (size_t)pn * MiB;
        switch (kind) {
            case 0: u.A = H + (size_t)pm * MiB; u.B = WG + bo; u.nt = 32; break;
            case 1: u.A = QK + (size_t)pm * MiB; u.B = PAR + bo; u.nt = 16; break;
            case 2: u.A = H + (size_t)pm * MiB; u.B = WG + 8 * MiB + bo; u.nt = 32; break;
            case 3: u.A = QK + (size_t)pm * MiB + 2048; u.B = PAR + bo + 2048; u.nt = 16; break;
            case 4: u.A = H + (size_t)pm * MiB; u.B = WG + 16 * MiB + bo; u.nt = 32; break;
            default: u.A = VM + (size_t)pm * MiB + 2048; u.B = PM2 + bo; u.nt = 16; break;
        }
        return true;
    }
};
struct EpiMerge {
    u32x4* scrG; f32x4* scrP; bf16_t* MRG;
    __device__ __forceinline__ void operator()(const f32x4 (&acc)[2][2][4][2], const Unit& u, int wr, int wc, int fr, int fq) const {
        const int tid = threadIdx.x, kind = u.kind;
        u32x4* gp = scrG + tid; f32x4* pp = scrP + tid;
        if ((kind & 1) == 0) {
#pragma unroll
            for (int ai = 0; ai < 2; ++ai)
#pragma unroll
                for (int bj = 0; bj < 2; ++bj)
#pragma unroll
                    for (int m = 0; m < 4; ++m) { const f32x4 v0 = acc[ai][bj][m][0], v1 = acc[ai][bj][m][1]; u32x4 w;
                        w.x = cvt_pk_bf16(sigmoidf_(v0[0]), sigmoidf_(v0[1])); w.y = cvt_pk_bf16(sigmoidf_(v0[2]), sigmoidf_(v0[3]));
                        w.z = cvt_pk_bf16(sigmoidf_(v1[0]), sigmoidf_(v1[1])); w.w = cvt_pk_bf16(sigmoidf_(v1[2]), sigmoidf_(v1[3]));
                        *gp = w; gp += NTHR; asm volatile("" : "+v"(gp) :: "memory"); }
        } else {
            const int row0 = u.pm * 256 + wr * 64 + fr, col0 = u.pn * 256 + wc * 32 + 8 * fq;
#pragma unroll
            for (int ai = 0; ai < 2; ++ai)
#pragma unroll
                for (int bj = 0; bj < 2; ++bj) {
                    bf16_t* mp = MRG + (size_t)(row0 + ai * 128) * 2048 + col0 + bj * 128;
#pragma unroll
                    for (int m = 0; m < 4; ++m) { const u32x4 g = *gp;
                        f32x4 p0 = acc[ai][bj][m][0] * (f32x4){bflo(g.x), bfhi(g.x), bflo(g.y), bfhi(g.y)}, p1 = acc[ai][bj][m][1] * (f32x4){bflo(g.z), bfhi(g.z), bflo(g.w), bfhi(g.w)};
                        if (kind > 1) { p0 += pp[0]; p1 += pp[NTHR]; }
                        if (kind < 5) { pp[0] = p0; pp[NTHR] = p1; }
                        else { u32x4 w; w.x = cvt_pk_bf16(p0[0], p0[1]); w.y = cvt_pk_bf16(p0[2], p0[3]); w.z = cvt_pk_bf16(p1[0], p1[1]); w.w = cvt_pk_bf16(p1[2], p1[3]);
                            *(u32x4*)mp = w; }
                        gp += NTHR; pp += 2 * NTHR; mp += 16 * 2048; asm volatile("" : "+v"(gp), "+v"(pp), "+v"(mp) :: "memory"); } }
        }
    }
};

struct SchedSq {
    int v, G; const char* A; const char* B; size_t astep, bstep; int nt;
    __device__ __forceinline__ bool next(int i, Unit& u) const {
        const long L = (long)i * G + v; int pm, pn; if (!TileMap{192, 8}.get(L, pm, pn)) return false;
        u.A = A + (size_t)pm * astep; u.B = B + (size_t)pn * bstep; u.nt = nt; u.pm = pm; u.pn = pn; u.kind = 0; u.t0 = 0; u.T = 0; return true;
    }
};
struct EpiWo {
    const float* xp; const float* xs; float* out;
    __device__ __forceinline__ void operator()(const f32x4 (&acc)[2][2][4][2], const Unit& u, int wr, int wc, int fr, int fq) const {
        const int row0 = u.pm * 256 + wr * 64 + fr, col0 = u.pn * 256 + wc * 32 + 8 * fq;
#pragma unroll
        for (int ai = 0; ai < 2; ++ai)
#pragma unroll
            for (int m = 0; m < 4; ++m) { const int row = row0 + ai * 128 + m * 16;
                const float* xr = (row < TP ? xp + (size_t)row * DM : xs + (size_t)(row - TP) * DM) + col0; float* orow = out + (size_t)row * DM + col0;
#pragma unroll
                for (int bj = 0; bj < 2; ++bj) { const f32x4 x0 = *(const f32x4*)(xr + bj * 128), x1 = *(const f32x4*)(xr + bj * 128 + 4);
                    *(f32x4*)(orow + bj * 128) = x0 + acc[ai][bj][m][0]; *(f32x4*)(orow + bj * 128 + 4) = x1 + acc[ai][bj][m][1]; } }
    }
};
struct EpiDown {
    float* out;
    __device__ __forceinline__ void operator()(const f32x4 (&acc)[2][2][4][2], const Unit& u, int wr, int wc, int fr, int fq) const {
        const int row0 = u.pm * 256 + wr * 64 + fr, col0 = u.pn * 256 + wc * 32 + 8 * fq;
#pragma unroll
        for (int ai = 0; ai < 2; ++ai)
#pragma unroll
            for (int m = 0; m < 4; ++m) { float* orow = out + (size_t)(row0 + ai * 128 + m * 16) * DM + col0;
#pragma unroll
                for (int bj = 0; bj < 2; ++bj) { const f32x4 x0 = *(const f32x4*)(orow + bj * 128), x1 = *(const f32x4*)(orow + bj * 128 + 4);
                    *(f32x4*)(orow + bj * 128) = x0 + acc[ai][bj][m][0]; *(f32x4*)(orow + bj * 128 + 4) = x1 + acc[ai][bj][m][1]; } }
    }
};

struct SchedUp {
    int v, G; const char* HN; const char* WUP;
    __device__ __forceinline__ bool next(int i, Unit& u) const {
        const long L = (long)i * G + v; int pm, pn; if (!TileMap{197, 44}.get(L, pm, pn)) return false;
        int s, ti; if (pm < 65) { s = 0; ti = pm; } else { s = 1 + (pm - 65) / 33; ti = (pm - 65) % 33; }
        const int T = seq_len(s); int t0 = 254 * ti - 1; if (t0 > T - 255) t0 = T - 255;
        u.pm = seq_start(s); u.pn = pn; u.kind = 0; u.t0 = t0; u.T = T; u.nt = 32;
        u.A = HN + ((long)u.pm + t0) * 4096; u.B = WUP + (size_t)pn * MiB; return true;
    }
};
struct EpiUp {
    bf16_t* ACT; const float* cw; const float* cb; LAS float* xch;
    __device__ __forceinline__ void operator()(const f32x4 (&acc)[2][2][4][2], const Unit& u, int wr, int wc, int fr, int fq) const {
        const int lane = threadIdx.x & 63;
        const int cin = wc * 32 + 8 * fq;
#pragma unroll
        for (int ai = 0; ai < 2; ++ai) { const int rg = 2 * ai + wr;
#pragma unroll
            for (int bj = 0; bj < 2; ++bj)
#pragma unroll
                for (int n = 0; n < 2; ++n) {
                    if (fr == 0) *(LAS f32x4*)(xch + (rg * 2 + 0) * 256 + bj * 128 + cin + 4 * n) = acc[ai][bj][0][n];
                    if (fr == 15) *(LAS f32x4*)(xch + (rg * 2 + 1) * 256 + bj * 128 + cin + 4 * n) = acc[ai][bj][3][n]; } }
        asm volatile("s_waitcnt lgkmcnt(0)" ::: "memory"); __builtin_amdgcn_s_barrier(); asm volatile("" ::: "memory");
        const int gc = u.pn * 128 + cin;
#pragma unroll
        for (int n = 0; n < 2; ++n) {
            const int wcol = gc + 4 * n;
            const f32x4 g0 = *(const f32x4*)(cw + wcol), g1 = *(const f32x4*)(cw + 2 * DFF + wcol), g2 = *(const f32x4*)(cw + 4 * DFF + wcol), gb = *(const f32x4*)(cb + wcol);
            const f32x4 v0 = *(const f32x4*)(cw + DFF + wcol), v1 = *(const f32x4*)(cw + 3 * DFF + wcol), v2 = *(const f32x4*)(cw + 5 * DFF + wcol), vb = *(const f32x4*)(cb + DFF + wcol);
#pragma unroll
            for (int ai = 0; ai < 2; ++ai) { const int rg = 2 * ai + wr;
                bf16_t* ap = ACT + ((long)u.pm + u.t0 + 128 * ai + 64 * wr + fr) * DFF + gc + 4 * n;
#pragma unroll
                for (int m = 0; m < 4; ++m) {
                    const int j = 128 * ai + 64 * wr + 16 * m + fr, t = u.t0 + j;
                    f32x4 res;
#pragma unroll
                    for (int bj = 0; bj < 2; ++bj) {
                        const f32x4 cur = acc[ai][bj][m][n];
                        const f32x4 sp = (m > 0 && fr == 15) ? acc[ai][bj][m > 0 ? m - 1 : 0][n] : cur;
                        const f32x4 sn = (m < 3 && fr == 0) ? acc[ai][bj][m < 3 ? m + 1 : 3][n] : cur;
                        f32x4 pv, nv;
#pragma unroll
                        for (int i = 0; i < 4; ++i) { pv[i] = __uint_as_float(__builtin_amdgcn_update_dpp(0u, __float_as_uint(sp[i]), 0x121, 0xf, 0xf, false));
                                                       nv[i] = __uint_as_float(__builtin_amdgcn_update_dpp(0u, __float_as_uint(sn[i]), 0x12F, 0xf, 0xf, false)); }
                        if (m == 0) { const f32x4 xprev = rg > 0 ? *(const LAS f32x4*)(xch + ((rg - 1) * 2 + 1) * 256 + bj * 128 + cin + 4 * n) : (f32x4){0.f, 0.f, 0.f, 0.f}; if (fr == 0) pv = xprev; }
                        if (m == 3) { const f32x4 xnext = rg < 3 ? *(const LAS f32x4*)(xch + ((rg + 1) * 2 + 0) * 256 + bj * 128 + cin + 4 * n) : (f32x4){0.f, 0.f, 0.f, 0.f}; if (fr == 15) nv = xnext; }
                        if (t < 1) pv = (f32x4){0.f, 0.f, 0.f, 0.f};
                        if (t >= u.T - 1) nv = (f32x4){0.f, 0.f, 0.f, 0.f};
                        if (bj == 0) { const f32x4 cv = g0 * pv + g1 * cur + g2 * nv + gb; res = (f32x4){cv[0] * sigmoidf_(cv[0]), cv[1] * sigmoidf_(cv[1]), cv[2] * sigmoidf_(cv[2]), cv[3] * sigmoidf_(cv[3])}; }
                        else { const f32x4 cv = v0 * pv + v1 * cur + v2 * nv + vb; res = res * cv; }
                    }
                    if (j >= 1 && j <= 254) { u32x2 w; w.x = cvt_pk_bf16(res[0], res[1]); w.y = cvt_pk_bf16(res[2], res[3]); *(u32x2*)ap = w; }
                    ap += 16 * DFF; asm volatile("" : "+v"(ap) :: "memory");
                }
            }
        }
    }
};

__global__ void __launch_bounds__(NTHR, 2) enc_fwd(Args args) {
    extern __shared__ __attribute__((aligned(16))) unsigned char lds_raw[];
    cg::grid_group grid = cg::this_grid();
    LAS unsigned char* lds = (LAS unsigned char*)lds_raw;
    const int tid = threadIdx.x;
    const int G = gridDim.x, bx = blockIdx.x, vcu = (G % 8 == 0) ? (bx % 8) * (G / 8) + bx / 8 : bx;
    unsigned char* ws = args.ws;
    const int lo = args.ph_lo, hi = args.ph_hi;
#ifndef P2M
#define P2M 7
#endif
#ifndef PH_MASK
#define PH_MASK 0x1ff
#endif
#define IN(k) (((PH_MASK >> (k)) & 1) && lo <= (k) && (k) < hi)
#define SEAM(k) do { if (IN(k) && IN((k) + 1)) grid.sync(); } while (0)
#ifndef PROBE
#define PROBE 0
#endif
    unsigned long long tp0 = 0, tp1 = 0;
#define TSTAMP(v) do { if (PROBE) { v = __builtin_amdgcn_s_memrealtime(); } } while (0)

    if (IN(0)) p0_prologue(args, lds, vcu, G);
    SEAM(0);
    if (IN(1)) {
        SchedIn S{vcu, G, (const char*)(ws + WS_H), (const char*)(ws + WS_WIN), (const char*)(ws + WS_MEMN), (const char*)(ws + WS_WKV)};
        EpiIn E{(bf16_t*)(ws + WS_QK), (bf16_t*)(ws + WS_VM), (bf16_t*)args.out, (bf16_t*)(ws + WS_KVM), args.in[6], args.in[7], (const float*)(ws + WS_ROPE), (const float*)(ws + WS_ROPE) + TP * 32};
        pg8::gemm_phase<EpiIn, SchedIn, true>(lds, 2048, S, E);
    }
    SEAM(1);
    if (PROBE == 1 || PROBE == 2) TSTAMP(tp0);
    if (IN(2)) {
        unsigned* ctl = (unsigned*)(ws + WS_CTL);
        volatile LAS unsigned* jobw = (volatile LAS unsigned*)(lds + LDS_MISC);
        const float lam = ((const float*)ctl)[CW_LAM];
        const bool fixref = ((const float*)ctl)[CW_SMAX] <= 30.f;
        scan::P sp{(const bf16_t*)args.out, (bf16_t*)(ws + WS_Y), (float*)(ws + WS_BON), args.in[13], args.in[14], args.in[15], args.in[16], args.in[17], args.in[18], args.in[20], args.in[21], args.in[22]};
        for (;;) {
            __syncthreads();
            if (tid == 0) jobw[0] = atomicAdd(ctl + CW_QUEUE, 1u);
            __syncthreads();
            const int jb = (int)jobw[0];
            if (jb >= 160 + 1536 + 768) break;
            if (((P2M) & 1) && jb < 160) {
                int s, r; if (jb < 32) { s = 0; r = jb; } else { s = 1 + (jb - 32) / 32; r = (jb - 32) % 32; }
                scan::job(s, r & 1, r >> 1, sp, (char*)lds_raw);
                if (PROBE == 2 && tid == 0) atomicMax((unsigned long long*)(ctl + 256), (unsigned long long)__builtin_amdgcn_s_memrealtime());
            } else if (((P2M) & 2) && jb < 160 + 1536) {
                const int a = jb - 160; int s, h, qb;
                if (a < 512) { s = 0; h = a / 64; qb = a % 64; } else { const int b = a - 512; s = 1 + b / 256; h = (b % 256) / 32; qb = b % 32; }
                if (fixref) att::diff_unit<true>(s, h, qb, (bf16_t*)(ws + WS_QK), (const bf16_t*)(ws + WS_VM), lam, (char*)lds_raw);
                else att::diff_unit<false>(s, h, qb, (bf16_t*)(ws + WS_QK), (const bf16_t*)(ws + WS_VM), lam, (char*)lds_raw);
            } else if ((P2M) & 4) {
                const int a = jb - 160 - 1536; int s, mh, qb;
                if (a < 256) { s = 0; mh = a / 64; qb = a % 64; } else { const int b = a - 256; s = 1 + b / 128; mh = (b % 128) / 32; qb = b % 32; }
                att::mem_unit(s, mh, qb, (bf16_t*)(ws + WS_VM), (const bf16_t*)(ws + WS_KVM), args.in[27], args.in[28], (char*)lds_raw);
            }
        }
    }
    SEAM(2);
    if (PROBE == 1) TSTAMP(tp1);
    if (IN(3)) p4_post(args, (char*)lds_raw, vcu, G);
    SEAM(3);
    if (IN(4)) {
        SchedMerge S{vcu, G, (const char*)(ws + WS_H), (const char*)(ws + WS_WG), (const char*)(ws + WS_QK), (const char*)(ws + WS_VM), (const char*)(ws + WS_PAR), (const char*)(ws + WS_PM2)};
        unsigned char* scr = (unsigned char*)args.out + (size_t)bx * (384 * 1024);
        EpiMerge E{(u32x4*)scr, (f32x4*)(scr + 128 * 1024), (bf16_t*)(ws + WS_MRG)};
        pg8::gemm_phase<EpiMerge, SchedMerge, true>(lds, 2048, S, E);
    }
    SEAM(4);
    if (IN(5)) {
        SchedSq S{vcu, G, (const char*)(ws + WS_MRG), (const char*)(ws + WS_WO), MiB, MiB, 32};
        EpiWo E{args.in[0], args.in[1], args.out};
        pg8::gemm_phase<EpiWo, SchedSq, true>(lds, 2048, S, E);
    }
    SEAM(5);
    if (IN(6)) {
        const int lane = tid & 63, gw = vcu * 8 + (tid >> 6), NGW = G * 8;
        for (int m = gw; m < NT; m += NGW) rms_row(args.out + (size_t)m * DM, args.in[33], (bf16_t*)(ws + WS_H) + (size_t)m * DM, lane);
    }
    SEAM(6);
    if (IN(7)) {
        SchedUp S{vcu, G, (const char*)(ws + WS_H), (const char*)(ws + WS_WUP)};
        EpiUp E{(bf16_t*)(ws + WS_ACT), args.in[35], args.in[36], (LAS float*)(lds + LDS_XCH)};
        pg8::gemm_phase<EpiUp, SchedUp, true>(lds, 2048, S, E);
    }
    SEAM(7);
    if (IN(8)) {
        SchedSq S{vcu, G, (const char*)(ws + WS_ACT), (const char*)(ws + WS_WDN), (size_t)256 * DFF * 2, (size_t)256 * DFF * 2, 88};
        EpiDown E{args.out};
        pg8::gemm_phase<EpiDown, SchedSq, true>(lds, DFF, S, E);
    }
    if (PROBE && bx == 0 && tid == 0) {
        if (PROBE == 2) tp1 = __hip_atomic_load((unsigned long long*)(ws + WS_CTL) + 128, __ATOMIC_RELAXED, __HIP_MEMORY_SCOPE_AGENT);
        const unsigned long long target = __builtin_amdgcn_s_memrealtime() + (tp1 > tp0 ? tp1 - tp0 : 0);
        while (__builtin_amdgcn_s_memrealtime() < target) __builtin_amdgcn_s_sleep(16);
    }
#undef IN
#undef SEAM
}

#ifndef MK_SPLIT
#define MK_SPLIT 0
#endif
extern "C" void kernel_launch(void* const* d_in, const int* in_sizes, int n_in, void* d_out, int out_size, void* d_ws, size_t ws_size, hipStream_t stream) {
    static int grid = 0;
    if (grid == 0) {
        if (n_in != 38 || out_size != NT * DM || ws_size < WS_END) { fprintf(stderr, "kernel_launch: unexpected shapes n_in %d out %d ws %zu\n", n_in, out_size, ws_size); grid = -1; return; }
        int dev = 0, cus = 0, per_cu = 0;
        hipGetDevice(&dev); hipDeviceGetAttribute(&cus, hipDeviceAttributeMultiprocessorCount, dev);
        if (hipFuncSetAttribute((const void*)enc_fwd, hipFuncAttributeMaxDynamicSharedMemorySize, LDS_BYTES) != hipSuccess) { fprintf(stderr, "kernel_launch: hipFuncSetAttribute failed\n"); grid = -1; return; }
        if (hipOccupancyMaxActiveBlocksPerMultiprocessor(&per_cu, (const void*)enc_fwd, NTHR, LDS_BYTES) != hipSuccess || per_cu < 1) { fprintf(stderr, "kernel_launch: occupancy query failed (%d)\n", per_cu); per_cu = 1; }
        (void)hipGetLastError();
        grid = cus * 1;
    }
    if (grid < 0) return;
    Args a{};
    for (int i = 0; i < 38; ++i) a.in[i] = (const float*)d_in[i];
    a.out = (float*)d_out; a.ws = (unsigned char*)d_ws;
    for (int d = 0; d < 32; ++d) a.inv_rev[d] = pow(10000.0, -(double)d / 32.0) / 6.283185307179586476925286766559;
#if MK_SPLIT
    for (int ph = 0; ph < 9; ++ph) { a.ph_lo = ph; a.ph_hi = ph + 1; void* kargs[] = {&a};
        hipError_t e = hipLaunchCooperativeKernel((const void*)enc_fwd, dim3(grid), dim3(NTHR), kargs, LDS_BYTES, stream);
        if (e != hipSuccess) { fprintf(stderr, "launch %d failed: %s\n", ph, hipGetErrorString(e)); break; } }
#else
    a.ph_lo = 0; a.ph_hi = 9;
    void* kargs[] = {&a};
    hipError_t e = hipLaunchCooperativeKernel((const void*)enc_fwd, dim3(grid), dim3(NTHR), kargs, LDS_BYTES, stream);
    if (e != hipSuccess) fprintf(stderr, "cooperative launch failed: %s (grid %d)\n", hipGetErrorString(e), grid);
#endif
}
```

```cpp
#include <hip/hip_runtime.h>
#include <hip/hip_cooperative_groups.h>
#include <cstdio>
#include <cstdint>
#include <cmath>
namespace cg = cooperative_groups;

#define LAS __attribute__((address_space(3)))
typedef unsigned short bf16_t;
typedef short bf16x8 __attribute__((ext_vector_type(8)));
typedef short s16x4 __attribute__((ext_vector_type(4)));
typedef float f32x2 __attribute__((ext_vector_type(2)));
typedef float f32x4 __attribute__((ext_vector_type(4)));
typedef float f32x16 __attribute__((ext_vector_type(16)));
typedef unsigned u32x2 __attribute__((ext_vector_type(2)));
typedef unsigned u32x4 __attribute__((ext_vector_type(4)));

constexpr int NT = 49152, DM = 2048, TP = 16384, TS = 8192, NSEQ = 5;
constexpr int ZRP = 3584;
constexpr int DFF = 5632;
constexpr int NTHR = 512;
constexpr size_t MiB = 1u << 20;
constexpr size_t WS_CTL = 0, WS_WIN = 1 * MiB, WS_WG = 31 * MiB, WS_WKV = 55 * MiB, WS_PAR = 63 * MiB, WS_PM2 = 71 * MiB, WS_WO = 79 * MiB,
                 WS_WUP = 87 * MiB, WS_WDN = 131 * MiB, WS_ROPE = 153 * MiB, WS_MEMN = 157 * MiB, WS_KVM = 162 * MiB, WS_BON = 167 * MiB,
                 WS_H = 176 * MiB, WS_QK = 370 * MiB, WS_VM = 562 * MiB, WS_Y = 754 * MiB, WS_ACT = 370 * MiB, WS_MRG = 754 * MiB, WS_END = 946 * MiB;
constexpr int CW_QUEUE = 64, CW_LAM = 128, CW_SMAX = 129;
constexpr size_t WS_G2T = 173 * MiB;
constexpr int LDS_XCH = 131072, LDS_MISC = 141312, LDS_BYTES = 141312 + 256;

__device__ __forceinline__ int seq_start(int s) { return s == 0 ? 0 : TP + (s - 1) * TS; }
__device__ __forceinline__ int seq_len(int s) { return s == 0 ? TP : TS; }
__device__ __forceinline__ int tok_pos(int tok) { return tok < TP ? tok : ((tok - TP) & (TS - 1)); }

__device__ __forceinline__ unsigned cvt_pk_bf16(float lo, float hi) { unsigned r; asm volatile("v_cvt_pk_bf16_f32 %0, %1, %2" : "=v"(r) : "v"(lo), "v"(hi)); return r; }
__device__ __forceinline__ float bflo(unsigned w) { return __uint_as_float(w << 16); }
__device__ __forceinline__ float bfhi(unsigned w) { return __uint_as_float(w & 0xffff0000u); }
__device__ __forceinline__ float bf1(bf16_t b) { return __uint_as_float((unsigned)b << 16); }
__device__ __forceinline__ float sigmoidf_(float x) { return 1.f / (1.f + __expf(-x)); }
__device__ __forceinline__ float wave_sum(float v) {
#pragma unroll
    for (int o = 1; o < 64; o <<= 1) v += __shfl_xor(v, o);
    return v;
}

namespace pg8 {
constexpr int BM = 256, BK = 64, HALF = 128, HTB = HALF * BK * 2, STAGE_BYTES = 8 * HTB;
__host__ __device__ __forceinline__ int lds_byte(int r, int c) { const int st = (r >> 4) * 2 + (c >> 5), rr = r & 15, cc = c & 31, ob = rr * 64 + cc * 2; return st * 1024 + (ob ^ (((ob >> 9) & 1) << 5)); }
__host__ __device__ __forceinline__ void stage_rc(int b, int& R, int& C) { const int st = b / 1024, sb = b % 1024, swz = sb ^ (((sb >> 9) & 1) << 5); R = (st >> 1) * 16 + swz / 64; C = (st & 1) * 32 + (swz % 64) / 2; }
__host__ __device__ __forceinline__ int perm32(int rho) { const int n = rho >> 4, i = rho & 15; return 8 * (i >> 2) + 4 * n + (i & 3); }

struct Unit { const char* A; const char* B; int nt, pm, pn, kind, t0, T; };

template <class Epi, class Sched, bool ALIGN_EPI>
__device__ __forceinline__ void gemm_phase(LAS unsigned char* lds, const int ld, const Sched& S, const Epi& E) {
    const int tid = threadIdx.x, wid = __builtin_amdgcn_readfirstlane(tid >> 6), lane = tid & 63, wr = wid >> 2, wc = wid & 3, fr = lane & 15, fq = lane >> 4;
    unsigned voffA[2], voffB[2];
#pragma unroll
    for (int i = 0; i < 2; ++i) { int R, C; stage_rc(tid * 16 + i * 8192, R, C); const int Rb = (R & ~31) + perm32(R & 31);
        voffA[i] = (unsigned)(R * ld + C) * 2u; voffB[i] = (unsigned)(Rb * ld + C) * 2u; }
    const size_t kstep = (size_t)(BK * 2);
    const size_t hstep = (size_t)HALF * ld * 2;
    const unsigned ldsw = (unsigned)wid * 1024u;
    const int aoff = lds_byte(wr * 64 + fr, fq * 8), boff = lds_byte(wc * 32 + fr, fq * 8);
#define PG8_SA(b, h) (((b) * 2 + (h)) * HTB)
#define PG8_SB(b, h) ((4 + (b) * 2 + (h)) * HTB)
#define PG8_STAGE(bufoff, gbase, voff) do { _Pragma("unroll") for (int _i = 0; _i < 2; ++_i) \
        __builtin_amdgcn_global_load_lds((const unsigned*)((const char*)(gbase) + (voff)[_i]), (LAS unsigned*)(lds + (bufoff) + ldsw + _i * 8192), 16, 0, 0); } while (0)
#define PG8_LDA(dst, b, h) do { _Pragma("unroll") for (int m = 0; m < 4; ++m) _Pragma("unroll") for (int k = 0; k < 2; ++k) dst[m][k] = *(const LAS bf16x8*)(lds + PG8_SA(b, h) + aoff + m * 2048 + k * 1024); } while (0)
#define PG8_LDB(dst, b, h) do { _Pragma("unroll") for (int n = 0; n < 2; ++n) _Pragma("unroll") for (int k = 0; k < 2; ++k) dst[n][k] = *(const LAS bf16x8*)(lds + PG8_SB(b, h) + boff + n * 2048 + k * 1024); } while (0)
#define PG8_MMA(ai, bj, At, Bt) do { __builtin_amdgcn_s_setprio(1); _Pragma("unroll") for (int m = 0; m < 4; ++m) _Pragma("unroll") for (int n = 0; n < 2; ++n) _Pragma("unroll") for (int k = 0; k < 2; ++k) \
        acc[ai][bj][m][n] = __builtin_amdgcn_mfma_f32_16x16x32_bf16(Bt[n][k], At[m][k], acc[ai][bj][m][n], 0, 0, 0); __builtin_amdgcn_s_setprio(0); } while (0)
#define PG8_WAIT_V(n) asm volatile("s_waitcnt vmcnt(" #n ")" ::: "memory")
#define PG8_WAIT_L(n) asm volatile("s_waitcnt lgkmcnt(" #n ")" ::: "memory")
#define PG8_BAR __builtin_amdgcn_s_barrier()
#define PG8_SCHED __builtin_amdgcn_sched_barrier(0)
    Unit cur, nxt; int ui = 0;
    if (!S.next(0, cur)) return;
    f32x4 acc[2][2][4][2];
#pragma unroll
    for (int a = 0; a < 2; ++a)
#pragma unroll
        for (int b = 0; b < 2; ++b)
#pragma unroll
            for (int m = 0; m < 4; ++m)
#pragma unroll
                for (int n = 0; n < 2; ++n) acc[a][b][m][n] = (f32x4){0.f, 0.f, 0.f, 0.f};
    bf16x8 At[4][2], B0[2][2], B1[2][2];
    const char* cA = cur.A; const char* cB = cur.B;
    PG8_STAGE(PG8_SB(0, 0), cB, voffB); PG8_STAGE(PG8_SB(0, 1), cB + hstep, voffB); PG8_STAGE(PG8_SA(0, 0), cA, voffA); PG8_STAGE(PG8_SA(0, 1), cA + hstep, voffA);
    if (wr == 1) PG8_BAR;
    PG8_WAIT_V(2); PG8_BAR;
    PG8_STAGE(PG8_SB(1, 0), cB + kstep, voffB); PG8_STAGE(PG8_SA(1, 0), cA + kstep, voffA); PG8_STAGE(PG8_SB(1, 1), cB + hstep + kstep, voffB);
    PG8_WAIT_V(6); PG8_BAR;
    for (;;) {
        const bool has_next = S.next(ui + 1, nxt);
        const char* nA = has_next ? nxt.A : cA; const char* nB = has_next ? nxt.B : cB;
        const int nt = cur.nt;
        for (int t = 0; t < nt; t += 2) {
            const bool last = (t == nt - 2);
            const char* a1 = cA + (size_t)(t + 1) * kstep;
            const char* a2 = last ? nA : cA + (size_t)(t + 2) * kstep; const char* b2 = last ? nB : cB + (size_t)(t + 2) * kstep;
            const char* a3 = a2 + kstep; const char* b3 = b2 + kstep;
            PG8_LDB(B0, 0, 0); PG8_LDB(B1, 0, 1); PG8_SCHED; PG8_LDA(At, 0, 0); PG8_STAGE(PG8_SA(1, 1), a1 + hstep, voffA);
            PG8_WAIT_V(8); PG8_WAIT_L(0); PG8_BAR; PG8_MMA(0, 0, At, B0); PG8_MMA(0, 1, At, B1); PG8_BAR; PG8_SCHED;
            PG8_LDA(At, 0, 1); PG8_STAGE(PG8_SB(0, 0), b2, voffB); PG8_STAGE(PG8_SB(0, 1), b2 + hstep, voffB); PG8_STAGE(PG8_SA(0, 0), a2, voffA);
            PG8_WAIT_V(8); PG8_WAIT_L(0); PG8_BAR; PG8_MMA(1, 0, At, B0); PG8_MMA(1, 1, At, B1); PG8_BAR; PG8_SCHED;
            PG8_LDB(B0, 1, 0); PG8_LDB(B1, 1, 1); PG8_SCHED; PG8_LDA(At, 1, 0); PG8_STAGE(PG8_SA(0, 1), a2 + hstep, voffA);
            PG8_WAIT_V(8); PG8_WAIT_L(0); PG8_BAR; PG8_MMA(0, 0, At, B0); PG8_MMA(0, 1, At, B1); PG8_BAR; PG8_SCHED;
            PG8_LDA(At, 1, 1); PG8_STAGE(PG8_SB(1, 0), b3, voffB); PG8_STAGE(PG8_SB(1, 1), b3 + hstep, voffB); PG8_STAGE(PG8_SA(1, 0), a3, voffA);
            PG8_WAIT_V(8); PG8_WAIT_L(0); PG8_BAR; PG8_MMA(1, 0, At, B0); PG8_MMA(1, 1, At, B1); PG8_BAR; PG8_SCHED;
        }
        if constexpr (ALIGN_EPI) { if (wr == 0) PG8_BAR; }
        E(acc, cur, wr, wc, fr, fq);
        if (!has_next) break;
#pragma unroll
        for (int a = 0; a < 2; ++a)
#pragma unroll
            for (int b = 0; b < 2; ++b)
#pragma unroll
                for (int m = 0; m < 4; ++m)
#pragma unroll
                    for (int n = 0; n < 2; ++n) acc[a][b][m][n] = (f32x4){0.f, 0.f, 0.f, 0.f};
        cur = nxt; cA = nA; cB = nB; ++ui;
        if constexpr (ALIGN_EPI) { if (wr == 1) PG8_BAR; }
    }
    PG8_WAIT_V(0);
    if constexpr (!ALIGN_EPI) { if (wr == 0) PG8_BAR; }
    PG8_BAR;
#undef PG8_SA
#undef PG8_SB
#undef PG8_STAGE
#undef PG8_LDA
#undef PG8_LDB
#undef PG8_MMA
#undef PG8_WAIT_V
#undef PG8_WAIT_L
#undef PG8_BAR
#undef PG8_SCHED
}
}
using pg8::Unit;

struct TileMap {
    int nM, nN;
    __device__ __forceinline__ bool get(long L, int& pm, int& pn) const {
        if (L >= (long)nM * nN) return false;
        const int nig = 8 * nN, gid = (int)(L / nig), fm = gid * 8, gsz = (nM - fm) < 8 ? (nM - fm) : 8, r = (int)(L % nig);
        pm = fm + r % gsz; pn = r / gsz; return true;
    }
};

struct Args {
    const float* in[38];
    float* out; unsigned char* ws;
    double inv_rev[32];
    int ph_lo, ph_hi;
};

__device__ __forceinline__ void tr_item(const float* W, int N, int src_n0, bf16_t* WT, size_t ldw, int koff, int r0, int k0, LAS float* scr, int lane) {
    if (src_n0 >= 0) {
#pragma unroll 8
        for (int i = 0; i < 32; ++i) { const int kk = 2 * i + (lane >> 5); scr[kk * 33 + (lane & 31)] = W[(size_t)(k0 + kk) * N + src_n0 + (lane & 31)]; }
    } else {
#pragma unroll 8
        for (int i = 0; i < 32; ++i) { const int kk = 2 * i + (lane >> 5); scr[kk * 33 + (lane & 31)] = 0.f; }
    }
    asm volatile("s_waitcnt lgkmcnt(0)" ::: "memory");
    const int c = lane & 7;
#pragma unroll
    for (int j = 0; j < 4; ++j) { const int n = (lane >> 3) + 8 * j; const LAS float* s = scr + (8 * c) * 33 + n;
        u32x4 o; o.x = cvt_pk_bf16(s[0 * 33], s[1 * 33]); o.y = cvt_pk_bf16(s[2 * 33], s[3 * 33]); o.z = cvt_pk_bf16(s[4 * 33], s[5 * 33]); o.w = cvt_pk_bf16(s[6 * 33], s[7 * 33]);
        *(u32x4*)(WT + (size_t)(r0 + n) * ldw + koff + k0 + 8 * c) = o; }
    asm volatile("s_waitcnt lgkmcnt(0)" ::: "memory");
}
__device__ __forceinline__ void rms_row(const float* xrow, const float* g, bf16_t* orow, int lane) {
    f32x4 v[8]; float s = 0.f;
#pragma unroll
    for (int j = 0; j < 8; ++j) { v[j] = ((const f32x4*)xrow)[64 * j + lane]; s += (v[j].x * v[j].x + v[j].y * v[j].y) + (v[j].z * v[j].z + v[j].w * v[j].w); }
    const float rstd = rsqrtf(wave_sum(s) * (1.f / DM) + 1e-6f);
#pragma unroll
    for (int j = 0; j < 8; ++j) { const f32x4 gg = ((const f32x4*)g)[64 * j + lane];
        u32x2 w; w.x = cvt_pk_bf16(v[j].x * rstd * gg.x, v[j].y * rstd * gg.y); w.y = cvt_pk_bf16(v[j].z * rstd * gg.z, v[j].w * rstd * gg.w);
        ((u32x2*)orow)[64 * j + lane] = w; }
}

__device__ __forceinline__ void p0_prologue(const Args& a, LAS unsigned char* lds, int vcu, int G) {
    const int tid = threadIdx.x, lane = tid & 63, wave = tid >> 6;
    unsigned char* ws = a.ws;
    LAS float* scr = (LAS float*)(lds + wave * 16384);
    const int gw = vcu * 8 + wave, NGW = G * 8;
    constexpr int I0 = 32 * 240, I1 = 32 * 192, I2 = 32 * 64, I3 = 16 * 64, I6 = 32 * 64, I7 = 32 * 352, I8 = 88 * 64;
    constexpr int NITEMS = I0 + I1 + I2 + 3 * I3 + I6 + I7 + I8;
    for (int it = gw; it < NITEMS; it += NGW) {
        int r = it;
        if (r < I0) { const int kb = r / 240, nb = r % 240, r0 = nb * 32; int src;
            if (r0 < 2048) { const int tile = r0 >> 8, cp = r0 & 255, h = cp >> 7, g = (cp & 127) >> 5; src = tile * 256 + 64 * g + 32 * h; }
            else if (r0 < 6560) src = r0;
            else if (r0 < 6656) src = -1;
            else src = 6560 + (r0 - 6656);
            tr_item(a.in[5], 13728, src, (bf16_t*)(ws + WS_WIN), 2048, 0, r0, kb * 64, scr, lane); continue; } r -= I0;
        if (r < I1) { const int kb = r / 192, nb = r % 192; tr_item(a.in[5], 13728, 7584 + nb * 32, (bf16_t*)(ws + WS_WG), 2048, 0, nb * 32, kb * 64, scr, lane); continue; } r -= I1;
        if (r < I2) { const int kb = r / 64, nb = r % 64; tr_item(a.in[26], 2048, nb * 32, (bf16_t*)(ws + WS_WKV), 2048, 0, nb * 32, kb * 64, scr, lane); continue; } r -= I2;
        if (r < I3) { const int kb = r / 64, nb = r % 64; tr_item(a.in[29], 2048, nb * 32, (bf16_t*)(ws + WS_PAR), 2048, 0, nb * 32, kb * 64, scr, lane); continue; } r -= I3;
        if (r < I3) { const int kb = r / 64, nb = r % 64; tr_item(a.in[30], 2048, nb * 32, (bf16_t*)(ws + WS_PAR), 2048, 1024, nb * 32, kb * 64, scr, lane); continue; } r -= I3;
        if (r < I3) { const int kb = r / 64, nb = r % 64; tr_item(a.in[31], 2048, nb * 32, (bf16_t*)(ws + WS_PM2), 2048, 0, nb * 32, kb * 64, scr, lane); continue; } r -= I3;
        if (r < I6) { const int kb = r / 64, nb = r % 64; tr_item(a.in[32], 2048, nb * 32, (bf16_t*)(ws + WS_WO), 2048, 0, nb * 32, kb * 64, scr, lane); continue; } r -= I6;
        if (r < I7) { const int kb = r / 352, nb = r % 352, r0 = nb * 32, tile = r0 >> 8, bj = (r0 & 255) >> 7, j = r0 & 127;
            tr_item(a.in[34], 2 * DFF, bj * DFF + 128 * tile + j, (bf16_t*)(ws + WS_WUP), 2048, 0, r0, kb * 64, scr, lane); continue; } r -= I7;
        { const int kb = r / 64, nb = r % 64; tr_item(a.in[37], 2048, nb * 32, (bf16_t*)(ws + WS_WDN), DFF, 0, nb * 32, kb * 64, scr, lane); }
    }
    for (int m = gw; m < NT + 1280; m += NGW) {
        if (m < NT) { const float* xr = m < TP ? a.in[0] + (size_t)m * DM : a.in[1] + (size_t)(m - TP) * DM; rms_row(xr, a.in[4], (bf16_t*)(ws + WS_H) + (size_t)m * DM, lane); }
        else { const int j = m - NT; const float* xr = j < 256 ? a.in[2] + (size_t)j * DM : a.in[3] + (size_t)(j - 256) * DM; rms_row(xr, a.in[25], (bf16_t*)(ws + WS_MEMN) + (size_t)j * DM, lane); }
    }
    { float* rc = (float*)(ws + WS_ROPE); float* rs = rc + TP * 32;
      for (int e = (vcu * NTHR + tid); e < TP * 32; e += G * NTHR) { const int t = e >> 5, d = e & 31; double rev = (double)t * a.inv_rev[d]; rev -= rint(rev); const float rf = (float)rev;
          rc[e] = __builtin_amdgcn_cosf(rf); rs[e] = __builtin_amdgcn_sinf(rf); } }
    { bf16_t* g2t = (bf16_t*)(ws + WS_G2T); const float* G2 = a.in[19];
      for (int e = vcu * NTHR + tid; e < 1024 * 20; e += G * NTHR) { const int col = e / 20, kc = e - col * 20; float f[8];
#pragma unroll
          for (int i = 0; i < 8; ++i) f[i] = G2[(size_t)(kc * 8 + i) * 1024 + col];
          u32x4 w; w.x = cvt_pk_bf16(f[0], f[1]); w.y = cvt_pk_bf16(f[2], f[3]); w.z = cvt_pk_bf16(f[4], f[5]); w.w = cvt_pk_bf16(f[6], f[7]);
          *(u32x4*)(g2t + (size_t)col * 160 + kc * 8) = w; } }
    if (blockIdx.x == 0) {
        unsigned* ctl = (unsigned*)(ws + WS_CTL);
        if (tid < 64) {
            if (tid == 0) { ctl[CW_QUEUE] = 0u; ctl[256] = 0u; ctl[257] = 0u; }
            const float s1 = wave_sum(a.in[8][tid] * a.in[9][tid]), s2 = wave_sum(a.in[10][tid] * a.in[11][tid]);
            if (tid == 0) ((float*)ctl)[CW_LAM] = __expf(s1) - __expf(s2) + 0.2f;
            float gq = fabsf(a.in[6][tid]), gk = fabsf(a.in[7][tid]);
#pragma unroll
            for (int o = 1; o < 64; o <<= 1) { gq = fmaxf(gq, __shfl_xor(gq, o)); gk = fmaxf(gk, __shfl_xor(gk, o)); }
            if (tid == 0) ((float*)ctl)[CW_SMAX] = 64.f * 0.125f * 1.4426950408889634f * gq * gk;
        }
    }
}

struct SchedIn {
    int v, G; const char* H; const char* WIN; const char* MEMN; const char* WKV;
    __device__ __forceinline__ bool next(int i, Unit& u) const {
        long L = (long)i * G + v; int pm, pn;
        if (L < 5760) { TileMap{192, 30}.get(L, pm, pn); u.A = H + (size_t)pm * MiB; u.B = WIN + (size_t)pn * MiB; u.nt = 32; u.pm = pm; u.pn = pn; u.kind = 0; u.t0 = 0; u.T = 0; return true; }
        L -= 5760; if (L < 40) { pm = (int)(L % 5); pn = (int)(L / 5); u.A = MEMN + (size_t)pm * MiB; u.B = WKV + (size_t)pn * MiB; u.nt = 32; u.pm = pm; u.pn = pn; u.kind = 1; u.t0 = 0; u.T = 0; return true; }
        return false;
    }
};
struct EpiIn {
    bf16_t* QK; bf16_t* VM; bf16_t* ZR; bf16_t* KVM; const float* qn; const float* kn; const float* rc; const float* rs;
    __device__ __forceinline__ void plain(const f32x4 (&acc)[2][2][4][2], bf16_t* base, size_t ldc, int row0, int col0) const {
#pragma unroll
        for (int ai = 0; ai < 2; ++ai)
#pragma unroll
            for (int m = 0; m < 4; ++m) { bf16_t* rowp = base + (size_t)(row0 + ai * 128 + m * 16) * ldc + col0;
#pragma unroll
                for (int bj = 0; bj < 2; ++bj) { const f32x4 v0 = acc[ai][bj][m][0], v1 = acc[ai][bj][m][1];
                    u32x4 w; w.x = cvt_pk_bf16(v0[0], v0[1]); w.y = cvt_pk_bf16(v0[2], v0[3]); w.z = cvt_pk_bf16(v1[0], v1[1]); w.w = cvt_pk_bf16(v1[2], v1[3]);
                    *(u32x4*)(rowp + bj * 128) = w; } }
    }
    __device__ __forceinline__ void operator()(const f32x4 (&acc)[2][2][4][2], const Unit& u, int wr, int wc, int fr, int fq) const {
        const int row0 = u.pm * 256 + wr * 64 + fr, cin = wc * 32 + 8 * fq;
        if (u.kind == 1) { plain(acc, KVM, 2048, row0, u.pn * 256 + cin); return; }
        const int pn = u.pn;
        if (pn < 8) {
            const bool isq = pn < 4; const float* nw = isq ? qn : kn;
            const int Gq = (pn & 3) * 4 + wc, d0 = 8 * fq;
            const float qs = isq ? 0.125f * 1.4426950408889634f : 1.f;
            const f32x4 w1a = *(const f32x4*)(nw + d0), w1b = *(const f32x4*)(nw + d0 + 4), w2a = *(const f32x4*)(nw + 32 + d0), w2b = *(const f32x4*)(nw + 36 + d0);
            bf16_t* dst = QK + (isq ? 0 : 1024) + Gq * 64 + d0;
#pragma unroll
            for (int ai = 0; ai < 2; ++ai)
#pragma unroll
                for (int m = 0; m < 4; ++m) {
                    const int row = row0 + ai * 128 + m * 16, t = tok_pos(row);
                    const f32x4 xa = acc[ai][0][m][0], xb = acc[ai][0][m][1], ya = acc[ai][1][m][0], yb = acc[ai][1][m][1];
                    float ss = (xa[0] * xa[0] + xa[1] * xa[1]) + (xa[2] * xa[2] + xa[3] * xa[3]) + (xb[0] * xb[0] + xb[1] * xb[1]) + (xb[2] * xb[2] + xb[3] * xb[3])
                             + (ya[0] * ya[0] + ya[1] * ya[1]) + (ya[2] * ya[2] + ya[3] * ya[3]) + (yb[0] * yb[0] + yb[1] * yb[1]) + (yb[2] * yb[2] + yb[3] * yb[3]);
                    ss += __shfl_xor(ss, 16); ss += __shfl_xor(ss, 32);
                    const float rstd = rsqrtf(ss * (1.f / 64.f) + 1e-6f);
                    const f32x4 ca = *(const f32x4*)(rc + t * 32 + d0), cb = *(const f32x4*)(rc + t * 32 + d0 + 4), sa = *(const f32x4*)(rs + t * 32 + d0), sb = *(const f32x4*)(rs + t * 32 + d0 + 4);
                    const f32x4 x1a = xa * rstd * w1a, x1b = xb * rstd * w1b, x2a = ya * rstd * w2a, x2b = yb * rstd * w2b;
                    const f32x4 o1a = (x1a * ca - x2a * sa) * qs, o1b = (x1b * cb - x2b * sb) * qs, o2a = (x2a * ca + x1a * sa) * qs, o2b = (x2b * cb + x1b * sb) * qs;
                    u32x4 w; w.x = cvt_pk_bf16(o1a[0], o1a[1]); w.y = cvt_pk_bf16(o1a[2], o1a[3]); w.z = cvt_pk_bf16(o1b[0], o1b[1]); w.w = cvt_pk_bf16(o1b[2], o1b[3]);
                    *(u32x4*)(dst + (size_t)row * 2048) = w;
                    w.x = cvt_pk_bf16(o2a[0], o2a[1]); w.y = cvt_pk_bf16(o2a[2], o2a[3]); w.z = cvt_pk_bf16(o2b[0], o2b[1]); w.w = cvt_pk_bf16(o2b[2], o2b[3]);
                    *(u32x4*)(dst + (size_t)row * 2048 + 32) = w;
                }
        } else if (pn < 12) plain(acc, VM, 2048, row0, (pn - 8) * 256 + cin);
        else if (pn < 26) plain(acc, ZR, ZRP, row0, (pn - 12) * 256 + cin);
        else plain(acc, VM, 2048, row0, 1024 + (pn - 26) * 256 + cin);
    }
};

namespace att {
constexpr int SHM_V = 16384, SHM_K = 8192;
constexpr int OFF_K = 0, OFF_V = 24576, OFF_WS = 73728, OFF_STASH = 75776;
#define KSWZ64(row, colB) ((row) * 128 + ((colB) ^ (((row) & 7) << 4)))
#define SBAR() __builtin_amdgcn_sched_barrier(0)
__device__ __forceinline__ int crow(int r, int hi) { return (r & 3) + 8 * (r >> 2) + 4 * hi; }
constexpr float THRL = 8.f;
__device__ __forceinline__ void partialSM(f32x16& p0, f32x16& p1, float& m_reg, float& alpha) {
    float pmax = fmaxf(fmaxf(p0[0], p0[1]), p0[2]);
#pragma unroll
    for (int r = 3; r < 15; r += 2) pmax = fmaxf(fmaxf(pmax, p0[r]), p0[r + 1]);
    pmax = fmaxf(fmaxf(pmax, p0[15]), p1[0]);
#pragma unroll
    for (int r = 1; r < 15; r += 2) pmax = fmaxf(fmaxf(pmax, p1[r]), p1[r + 1]);
    pmax = fmaxf(pmax, p1[15]);
    { auto rr = __builtin_amdgcn_permlane32_swap(__float_as_uint(pmax), __float_as_uint(pmax), false, false);
      pmax = fmaxf(__uint_as_float(rr[0]), __uint_as_float(rr[1])); }
    if (__builtin_expect(__all(pmax <= THRL), 1)) { alpha = 1.f; }
    else { const float dl = fmaxf(pmax, 0.f); alpha = __builtin_amdgcn_exp2f(-dl); m_reg += dl;
#pragma unroll
        for (int r = 0; r < 16; ++r) { p0[r] -= dl; p1[r] -= dl; } }
#pragma unroll
    for (int r = 0; r < 16; ++r) p0[r] = __builtin_amdgcn_exp2f(p0[r]);
}
__device__ __forceinline__ void finishSM(f32x16& p0, f32x16& p1, float alpha, float& l_reg, bf16x8& pa0, bf16x8& pa1, bf16x8& pa2, bf16x8& pa3) {
#pragma unroll
    for (int r = 0; r < 16; ++r) p1[r] = __builtin_amdgcn_exp2f(p1[r]);
    f32x2 s2 = (f32x2){p0[0], p0[1]} + (f32x2){p1[0], p1[1]};
#pragma unroll
    for (int r = 2; r < 16; r += 2) { s2 = s2 + (f32x2){p0[r], p0[r + 1]}; s2 = s2 + (f32x2){p1[r], p1[r + 1]}; }
    float ps = s2[0] + s2[1];
    { auto rr = __builtin_amdgcn_permlane32_swap(__float_as_uint(ps), __float_as_uint(ps), false, false);
      ps = __uint_as_float(rr[0]) + __uint_as_float(rr[1]); }
    l_reg = l_reg * alpha + ps;
#define PK4(P, BASE, OUT) do { unsigned a0 = cvt_pk_bf16(P[BASE + 0], P[BASE + 1]), a1 = cvt_pk_bf16(P[BASE + 2], P[BASE + 3]);   \
    unsigned b0 = cvt_pk_bf16(P[BASE + 4], P[BASE + 5]), b1 = cvt_pk_bf16(P[BASE + 6], P[BASE + 7]);                              \
    auto r0 = __builtin_amdgcn_permlane32_swap(a0, b0, false, false); auto r1 = __builtin_amdgcn_permlane32_swap(a1, b1, false, false); \
    u32x4 w = {r0[0], r1[0], r0[1], r1[1]}; OUT = *reinterpret_cast<bf16x8*>(&w); } while (0)
    PK4(p0, 0, pa0); PK4(p0, 8, pa1); PK4(p1, 0, pa2); PK4(p1, 8, pa3);
#undef PK4
}
__device__ __forceinline__ void qkt64(f32x16& p0, f32x16& p1, const char* Ks, const bf16x8* qr, int r32, int hi) {
#pragma unroll
    for (int d0 = 0; d0 < 4; ++d0) { const int cb = (d0 * 16 + hi * 8) * 2;
        const bf16x8 b0 = *reinterpret_cast<const bf16x8*>(Ks + KSWZ64(r32, cb));
        const bf16x8 b1 = *reinterpret_cast<const bf16x8*>(Ks + KSWZ64(32 + r32, cb));
        p0 = __builtin_amdgcn_mfma_f32_32x32x16_bf16(b0, qr[d0], p0, 0, 0, 0);
        p1 = __builtin_amdgcn_mfma_f32_32x32x16_bf16(b1, qr[d0], p1, 0, 0, 0); }
}
__device__ __forceinline__ int v_st(int k, int c) { const int kk = (k & ~0xC) | ((k & 4) << 1) | ((k & 8) >> 1); return ((kk >> 3) * 4 + (c >> 5)) * 512 + ((kk & 7) * 32 + (c & 31)) * 2; }
__device__ __forceinline__ int v_rd_base(int lane) { return ((lane & 3) << 3) | (((lane >> 2) & 3) << 6) | (((lane >> 4) & 1) << 5) | (((lane >> 5) & 1) << 8); }
constexpr int v_rd_off(int d0, int ks, int half) { return d0 * 512 + ks * 4096 + half * 2048; }
template <int OFF> __device__ __forceinline__ s16x4 tr_read(int vb) {
    s16x4 r; asm volatile("ds_read_b64_tr_b16 %0, %1 offset:%2" : "=&v"(r) : "v"(vb), "i"(OFF) : "memory"); return r;
}
template <int KS> __device__ __forceinline__ void pv_ks(f32x16* o, int vb, bf16x8 pa) {
    const s16x4 l0 = tr_read<v_rd_off(0, KS, 0)>(vb), h0 = tr_read<v_rd_off(0, KS, 1)>(vb), l1 = tr_read<v_rd_off(1, KS, 0)>(vb), h1 = tr_read<v_rd_off(1, KS, 1)>(vb);
    const s16x4 l2 = tr_read<v_rd_off(2, KS, 0)>(vb), h2 = tr_read<v_rd_off(2, KS, 1)>(vb), l3 = tr_read<v_rd_off(3, KS, 0)>(vb), h3 = tr_read<v_rd_off(3, KS, 1)>(vb);
    asm volatile("s_waitcnt lgkmcnt(0)" ::: "memory"); SBAR();
#define PK(L, H) (bf16x8){L[0], L[1], L[2], L[3], H[0], H[1], H[2], H[3]}
    o[0] = __builtin_amdgcn_mfma_f32_32x32x16_bf16(pa, PK(l0, h0), o[0], 0, 0, 0);
    o[1] = __builtin_amdgcn_mfma_f32_32x32x16_bf16(pa, PK(l1, h1), o[1], 0, 0, 0);
    o[2] = __builtin_amdgcn_mfma_f32_32x32x16_bf16(pa, PK(l2, h2), o[2], 0, 0, 0);
    o[3] = __builtin_amdgcn_mfma_f32_32x32x16_bf16(pa, PK(l3, h3), o[3], 0, 0, 0);
#undef PK
}
__device__ __forceinline__ void pv_d0(f32x16* o, int vb, bf16x8 pa0, bf16x8 pa1, bf16x8 pa2, bf16x8 pa3) {
    pv_ks<0>(o, vb, pa0); pv_ks<1>(o, vb, pa1); pv_ks<2>(o, vb, pa2); pv_ks<3>(o, vb, pa3);
}

__device__ __forceinline__ void stash_store(const unsigned* stash, bf16_t* Ow, int ldo, int lane) {
#pragma unroll
    for (int i = 0; i < 8; ++i) { const int q = i * 64 + lane, rl = q >> 4, c8 = (q & 15) * 8, hh = (rl >> 2) & 1, r = (rl & 3) + 4 * (rl >> 3), d0 = c8 >> 5, cc = c8 & 31;
        const unsigned* sp = stash + (d0 * 8 + (r >> 1)) * 64 + hh * 32 + cc; const u32x4 a = *(const u32x4*)sp, b = *(const u32x4*)(sp + 4);
        u32x4 w;
        if (r & 1) { w.x = (a.x >> 16) | (a.y & 0xffff0000u); w.y = (a.z >> 16) | (a.w & 0xffff0000u); w.z = (b.x >> 16) | (b.y & 0xffff0000u); w.w = (b.z >> 16) | (b.w & 0xffff0000u); }
        else { w.x = (a.x & 0xffffu) | (a.y << 16); w.y = (a.z & 0xffffu) | (a.w << 16); w.z = (b.x & 0xffffu) | (b.y << 16); w.w = (b.z & 0xffffu) | (b.w << 16); }
        *(u32x4*)(Ow + (size_t)rl * ldo + c8) = w; }
}

template <bool FX> __device__ __forceinline__ void diff_unit(int s, int h, int qb, bf16_t* QK, const bf16_t* VM, float lam, char* lds, LAS unsigned char* ldsl) {
    constexpr int LDK = 2048;
    int tid = threadIdx.x; asm volatile("" : "+v"(tid));
    const int wid = __builtin_amdgcn_readfirstlane(tid >> 6), lane = tid & 63, r32 = lane & 31, hi = lane >> 5;
    const int tok0 = seq_start(s), T = seq_len(s), NTL = T / 64;
    char* V_lds = lds + OFF_V; char* K_lds = lds + OFF_K;
    float* wsf = (float*)(lds + OFF_WS) + wid * 64; float* li_l = wsf; float* al_l = wsf + 32;
    unsigned* stash = (unsigned*)(lds + OFF_STASH) + wid * 2048;
    const int vb0 = (int)(uintptr_t)V_lds + v_rd_base(lane);
    const bf16_t* Vh = VM + (size_t)tok0 * LDK + h * 128;
    const size_t qrow = (size_t)(tok0 + qb * 256 + wid * 32);
    const unsigned ksrc = (unsigned)((wid * 8 + (lane >> 3)) * LDK + (((lane & 7) ^ (lane >> 3)) << 3)) * 2u;
    unsigned vsrc[2];
#pragma unroll
    for (int i = 0; i < 2; ++i) { const int st = 2 * (2 * wid + i) + (lane >> 5), kk = (st >> 2) * 8 + ((lane & 31) >> 2), k = (kk & ~0xC) | ((kk & 4) << 1) | ((kk & 8) >> 1), cc = (st & 3) * 32 + (lane & 3) * 8;
        vsrc[i] = (unsigned)(k * LDK + cc) * 2u; }
#pragma unroll 1
    for (int c = 0; c < 2; ++c) {
        const bf16_t* Kh = QK + (size_t)tok0 * LDK + 1024 + h * 128 + c * 64;
        const bf16_t* Qw = QK + (qrow + r32) * LDK + h * 128 + c * 64 + hi * 8;
        bf16x8 qr[4];
#pragma unroll
        for (int d0 = 0; d0 < 4; ++d0) qr[d0] = *reinterpret_cast<const bf16x8*>(Qw + d0 * 16);
        float m_reg = 0.f, l_reg = 0; f32x16 o[4] = {};
#define NEGM(P) do { const float nm_ = FX ? 0.f : -m_reg; _Pragma("unroll") for (int r_ = 0; r_ < 16; ++r_) P[r_] = nm_; } while (0)
#define PSM(P0, P1, AL) do { if constexpr (FX) { AL = 1.f; _Pragma("unroll") for (int r_ = 0; r_ < 16; ++r_) P0[r_] = __builtin_amdgcn_exp2f(P0[r_]); } else partialSM(P0, P1, m_reg, AL); } while (0)
#define DMA_K(t, slotB) __builtin_amdgcn_global_load_lds((const unsigned*)((const char*)(Kh + (size_t)(t) * 64 * LDK) + ksrc), (LAS unsigned*)(ldsl + OFF_K + (slotB) * SHM_K + wid * 1024), 16, 0, 0)
#define DMA_V(t, slotB) do { __builtin_amdgcn_global_load_lds((const unsigned*)((const char*)(Vh + (size_t)(t) * 64 * LDK) + vsrc[0]), (LAS unsigned*)(ldsl + OFF_V + (slotB) * SHM_V + (2 * wid) * 1024), 16, 0, 0); \
    __builtin_amdgcn_global_load_lds((const unsigned*)((const char*)(Vh + (size_t)(t) * 64 * LDK) + vsrc[1]), (LAS unsigned*)(ldsl + OFF_V + (slotB) * SHM_V + (2 * wid + 1) * 1024), 16, 0, 0); } while (0)
#define WAITB(n) asm volatile("s_waitcnt vmcnt(" #n ") lgkmcnt(0)\n\ts_barrier" ::: "memory")
#define RESC(a) do { if (!FX && __any((a) < 1.f)) { if (hi == 0) al_l[r32] = (a); asm volatile("s_waitcnt lgkmcnt(0)" ::: "memory"); \
    _Pragma("unroll") for (int d = 0; d < 4; ++d) _Pragma("unroll") for (int r = 0; r < 16; ++r) o[d][r] *= al_l[crow(r, hi)]; } } while (0)
#define SEG(X0, X1, ALX, Y0, Y1, ALY, sg) do { \
        SBAR(); NEGM(X0); NEGM(X1); qkt64(X0, X1, K_lds + sl_c * SHM_K, qr, r32, hi); \
        finishSM(Y0, Y1, ALY, l_reg, pa0, pa1, pa2, pa3); SBAR(); \
        if ((sg) + 2 < NTL) DMA_K((sg) + 2, sl_p); if ((sg) + 1 < NTL) DMA_V((sg) + 1, sl_n); SBAR(); \
        pv_d0(o, vb0 + sl_p * SHM_V, pa0, pa1, pa2, pa3); PSM(X0, X1, ALX); \
        RESC(ALX); \
        if ((sg) + 2 < NTL) WAITB(3); else if ((sg) + 1 < NTL) WAITB(2); else WAITB(0); \
        { const int t_ = sl_p; sl_p = sl_c; sl_c = sl_n; sl_n = t_; } } while (0)
        f32x16 pA0, pA1, pB0, pB1; float alA, alB; bf16x8 pa0, pa1, pa2, pa3;
        int sl_p = 2, sl_c = 0, sl_n = 1;
        DMA_K(0, 0); DMA_V(0, 0); DMA_K(1, 1);
        WAITB(1);
        DMA_K(2, 2); DMA_V(1, 1);
        NEGM(pA0); NEGM(pA1); qkt64(pA0, pA1, K_lds, qr, r32, hi); PSM(pA0, pA1, alA);
        WAITB(3);
        { sl_p = 0; sl_c = 1; sl_n = 2; }
        for (int j = 1; j + 1 < NTL; j += 2) {
            SEG(pB0, pB1, alB, pA0, pA1, alA, j);
            SEG(pA0, pA1, alA, pB0, pB1, alB, j + 1);
        }
        SEG(pB0, pB1, alB, pA0, pA1, alA, NTL - 1);
        finishSM(pB0, pB1, alB, l_reg, pa0, pa1, pa2, pa3); SBAR();
        pv_d0(o, vb0 + sl_p * SHM_V, pa0, pa1, pa2, pa3);
#undef SEG
#undef DMA_K
#undef DMA_V
#undef WAITB
#undef RESC
#undef NEGM
#undef PSM
        if (hi == 0) li_l[r32] = l_reg; asm volatile("s_waitcnt lgkmcnt(0)" ::: "memory");
        float rli[16];
#pragma unroll
        for (int r = 0; r < 16; ++r) rli[r] = __builtin_amdgcn_rcpf(li_l[crow(r, hi)]);
        { const float coef = c == 0 ? 1.f : -lam;
#pragma unroll
          for (int d0 = 0; d0 < 4; ++d0)
#pragma unroll
              for (int r = 0; r < 16; r += 2) { const int idx = (d0 * 8 + (r >> 1)) * 64 + lane; const unsigned w = c == 0 ? 0u : stash[idx];
                  stash[idx] = cvt_pk_bf16(bflo(w) + coef * o[d0][r] * rli[r], bfhi(w) + coef * o[d0][r + 1] * rli[r + 1]); } }
        __syncthreads();
    }
    stash_store(stash, QK + qrow * LDK + h * 128, LDK, lane);
    __syncthreads();
}

constexpr int MOFF_V = 0, MOFF_K = 32768, MOFF_WS = 65536, MOFF_RK = 67584, MOFF_G = 68608, MOFF_STASH = 69632;
__device__ __forceinline__ void mem_unit(int s, int mh, int qb, bf16_t* VM, const bf16_t* KVM, const float* mqn, const float* mkn, char* lds) {
    int tid = threadIdx.x; asm volatile("" : "+v"(tid));
    const int wid = __builtin_amdgcn_readfirstlane(tid >> 6), lane = tid & 63, r32 = lane & 31, hi = lane >> 5;
    const int tok0 = seq_start(s);
    char* V_lds = lds + MOFF_V; char* K_lds = lds + MOFF_K;
    float* wsf = (float*)(lds + MOFF_WS) + wid * 64; float* li_l = wsf; float* al_l = wsf + 32;
    float* rk_l = (float*)(lds + MOFF_RK); float* g_l = (float*)(lds + MOFF_G);
    const bf16_t* Kh = KVM + (size_t)(s * 256) * 2048 + mh * 256;
    const bf16_t* Vh = KVM + (size_t)(s * 256) * 2048 + 1024 + mh * 256;
    if (tid < 256) g_l[tid] = mqn[tid] * mkn[tid];
    {
        const bf16_t* kp = Kh + (size_t)(wid * 32 + r32) * 2048 + hi * 128; float ss = 0.f;
#pragma unroll
        for (int i = 0; i < 16; ++i) { const u32x4 w = *(const u32x4*)(kp + i * 8);
            ss += bflo(w.x) * bflo(w.x) + bfhi(w.x) * bfhi(w.x) + bflo(w.y) * bflo(w.y) + bfhi(w.y) * bfhi(w.y) + bflo(w.z) * bflo(w.z) + bfhi(w.z) * bfhi(w.z) + bflo(w.w) * bflo(w.w) + bfhi(w.w) * bfhi(w.w); }
        ss += __shfl_xor(ss, 32);
        if (hi == 0) rk_l[wid * 32 + r32] = rsqrtf(ss * (1.f / 256.f) + 1e-6f);
    }
    const size_t qrow = (size_t)(tok0 + qb * 256 + wid * 32);
    bf16_t* Qw = VM + (qrow + r32) * 2048 + 1024 + mh * 256 + hi * 8;
    float rqC;
    { float ss = 0.f;
#pragma unroll
      for (int i = 0; i < 16; ++i) { const u32x4 w = *(const u32x4*)(Qw + i * 16);
          ss += bflo(w.x) * bflo(w.x) + bfhi(w.x) * bfhi(w.x) + bflo(w.y) * bflo(w.y) + bfhi(w.y) * bfhi(w.y) + bflo(w.z) * bflo(w.z) + bfhi(w.z) * bfhi(w.z) + bflo(w.w) * bflo(w.w) + bfhi(w.w) * bfhi(w.w); }
      ss += __shfl_xor(ss, 32);
      rqC = rsqrtf(ss * (1.f / 256.f) + 1e-6f) * (0.0625f * 1.4426950408889634f); }
    const int sr = tid >> 4, sc = (tid & 15) * 8, vst0 = v_st(sr, sc), vst1 = v_st(32 + sr, sc);
    const int kr = tid >> 3, kc = (tid & 7) * 8, kst = KSWZ64(kr, kc * 2);
    const int vb0 = (int)(uintptr_t)V_lds + v_rd_base(lane);
    unsigned* stash = (unsigned*)(lds + MOFF_STASH) + wid * 2048;
    __syncthreads();
#pragma unroll 1
    for (int hv = 0; hv < 2; ++hv) {
    float m_reg = -1e30f, l_reg = 0.f; f32x16 o[4] = {};
#pragma unroll 1
    for (int t = 0; t < 4; ++t) {
        const int k0 = t * 64;
#pragma unroll
        for (int ds = 0; ds < 4; ++ds) { const u32x4 w = *(const u32x4*)(Kh + (size_t)(k0 + kr) * 2048 + ds * 64 + kc); const float* g = g_l + ds * 64 + kc;
            u32x4 o4; o4.x = cvt_pk_bf16(bflo(w.x) * g[0], bfhi(w.x) * g[1]); o4.y = cvt_pk_bf16(bflo(w.y) * g[2], bfhi(w.y) * g[3]);
            o4.z = cvt_pk_bf16(bflo(w.z) * g[4], bfhi(w.z) * g[5]); o4.w = cvt_pk_bf16(bflo(w.w) * g[6], bfhi(w.w) * g[7]);
            *(u32x4*)(K_lds + ds * 8192 + kst) = o4; asm volatile("" ::: "memory"); }
        *(u32x4*)(V_lds + vst0) = *(const u32x4*)(Vh + (size_t)(k0 + sr) * 2048 + hv * 128 + sc);
        *(u32x4*)(V_lds + vst1) = *(const u32x4*)(Vh + (size_t)(k0 + 32 + sr) * 2048 + hv * 128 + sc);
        __syncthreads();
        f32x16 p0 = {}, p1 = {};
#pragma unroll
        for (int ds = 0; ds < 4; ++ds) { bf16x8 qr[4];
#pragma unroll
            for (int d0 = 0; d0 < 4; ++d0) qr[d0] = *reinterpret_cast<const bf16x8*>(Qw + ds * 64 + d0 * 16);
            qkt64(p0, p1, K_lds + ds * 8192, qr, r32, hi); }
#pragma unroll
        for (int r = 0; r < 16; ++r) { p0[r] *= rk_l[k0 + crow(r, hi)] * rqC; p1[r] *= rk_l[k0 + 32 + crow(r, hi)] * rqC; }
        float pmax = p0[0];
#pragma unroll
        for (int r = 1; r < 16; ++r) pmax = fmaxf(pmax, p0[r]);
#pragma unroll
        for (int r = 0; r < 16; ++r) pmax = fmaxf(pmax, p1[r]);
        pmax = fmaxf(pmax, __shfl_xor(pmax, 32));
        const float mn = fmaxf(m_reg, pmax), alpha = __builtin_amdgcn_exp2f(m_reg - mn); m_reg = mn;
        float ps = 0.f;
#pragma unroll
        for (int r = 0; r < 16; ++r) { p0[r] = __builtin_amdgcn_exp2f(p0[r] - mn); p1[r] = __builtin_amdgcn_exp2f(p1[r] - mn); ps += p0[r] + p1[r]; }
        ps += __shfl_xor(ps, 32);
        l_reg = l_reg * alpha + ps;
        if (hi == 0) al_l[r32] = alpha; asm volatile("s_waitcnt lgkmcnt(0)" ::: "memory");
#pragma unroll
        for (int d = 0; d < 4; ++d)
#pragma unroll
            for (int r = 0; r < 16; ++r) o[d][r] *= al_l[crow(r, hi)];
        bf16x8 pa0, pa1, pa2, pa3;
#define PK4(P, BASE, OUT) do { unsigned a0 = cvt_pk_bf16(P[BASE + 0], P[BASE + 1]), a1 = cvt_pk_bf16(P[BASE + 2], P[BASE + 3]);   \
    unsigned b0 = cvt_pk_bf16(P[BASE + 4], P[BASE + 5]), b1 = cvt_pk_bf16(P[BASE + 6], P[BASE + 7]);                              \
    auto r0 = __builtin_amdgcn_permlane32_swap(a0, b0, false, false); auto r1 = __builtin_amdgcn_permlane32_swap(a1, b1, false, false); \
    u32x4 w = {r0[0], r1[0], r0[1], r1[1]}; OUT = *reinterpret_cast<bf16x8*>(&w); } while (0)
        PK4(p0, 0, pa0); PK4(p0, 8, pa1); PK4(p1, 0, pa2); PK4(p1, 8, pa3);
#undef PK4
        pv_d0(o, vb0, pa0, pa1, pa2, pa3);
        __syncthreads();
    }
    if (hi == 0) li_l[r32] = l_reg; asm volatile("s_waitcnt lgkmcnt(0)" ::: "memory");
    if (hv == 1) stash_store(stash, VM + qrow * 2048 + 1024 + mh * 256, 2048, lane);
#pragma unroll
    for (int d0 = 0; d0 < 4; ++d0)
#pragma unroll
        for (int r = 0; r < 16; r += 2) stash[(d0 * 8 + (r >> 1)) * 64 + lane] = cvt_pk_bf16(o[d0][r] * __builtin_amdgcn_rcpf(li_l[crow(r, hi)]), o[d0][r + 1] * __builtin_amdgcn_rcpf(li_l[crow(r + 1, hi)]));
    }
    stash_store(stash, VM + qrow * 2048 + 1024 + mh * 256 + 128, 2048, lane);
    __syncthreads();
}
#undef SBAR
}

namespace scan {
constexpr int TC = 32;
typedef _Float16 h2 __attribute__((ext_vector_type(2)));
typedef _Float16 h4 __attribute__((ext_vector_type(4)));
typedef _Float16 h8 __attribute__((ext_vector_type(8)));
constexpr int BUFB = 36864, O_R = 0, O_KD = 4096, O_KK = 8192, O_W = 12288, O_KA = 16384, O_V = 20480, O_Y = 28672;
constexpr int O_PRIV = 73728;
constexpr int O_TBL = 73728 + 32768;
__device__ __forceinline__ float dpp_red8(float x) {
    x += __uint_as_float(__builtin_amdgcn_update_dpp(0u, __float_as_uint(x), 0xB1, 0xf, 0xf, false));
    x += __uint_as_float(__builtin_amdgcn_update_dpp(0u, __float_as_uint(x), 0x4E, 0xf, 0xf, false));
    x += __uint_as_float(__builtin_amdgcn_update_dpp(0u, __float_as_uint(x), 0x141, 0xf, 0xf, false));
    return x;
}
template <int DIR> __device__ __forceinline__ void scan_chunk(const char* B_, h2 (&S)[2][4], int seg, int row0) {
    const char* base = B_ + seg * 16; const char* vbase = B_ + O_V + row0 * 4; char* ybase = (char*)B_ + O_Y + row0 * 4;
    u32x4 ck[2], cw[2], ca[2], cd[2], cr[2]; u32x2 cv[2];
#define LDSET(set, tl_) do { ck[set] = *(const u32x4*)(base + O_KK + (tl_) * 128); cw[set] = *(const u32x4*)(base + O_W + (tl_) * 128); ca[set] = *(const u32x4*)(base + O_KA + (tl_) * 128); \
    cd[set] = *(const u32x4*)(base + O_KD + (tl_) * 128); cr[set] = *(const u32x4*)(base + O_R + (tl_) * 128); cv[set] = *(const u32x2*)(vbase + (tl_) * 256); } while (0)
#define H2(u) __builtin_bit_cast(h2, (u))
    LDSET(0, DIR ? TC - 1 : 0);
#pragma unroll
    for (int st = 0; st < TC; ++st) {
        const int tl = DIR ? TC - 1 - st : st, cs = st & 1;
        if (st + 1 < TC) LDSET(cs ^ 1, DIR ? TC - 2 - st : st + 1);
#define SPLIT4(V, A0, A1, A2, A3) const h8 V##8 = __builtin_bit_cast(h8, V[cs]); const h2 A0 = __builtin_shufflevector(V##8, V##8, 0, 1), A1 = __builtin_shufflevector(V##8, V##8, 2, 3), \
    A2 = __builtin_shufflevector(V##8, V##8, 4, 5), A3 = __builtin_shufflevector(V##8, V##8, 6, 7)
        SPLIT4(ck, k0, k1, k2, k3); SPLIT4(cw, w0, w1, w2, w3); SPLIT4(ca, a0, a1, a2, a3); SPLIT4(cd, d0, d1, d2, d3); SPLIT4(cr, r0, r1, r2, r3);
#undef SPLIT4
        const h4 cv4 = __builtin_bit_cast(h4, cv[cs]);
        f32x2 yo;
#pragma unroll
        for (int h = 0; h < 2; ++h) {
            const h2 vv = h == 0 ? __builtin_shufflevector(cv4, cv4, 0, 1) : __builtin_shufflevector(cv4, cv4, 2, 3);
            float d = __builtin_amdgcn_fdot2(S[h][0], k0, 0.f, false); float e = __builtin_amdgcn_fdot2(S[h][2], k2, 0.f, false);
            d = __builtin_amdgcn_fdot2(S[h][1], k1, d, false); e = __builtin_amdgcn_fdot2(S[h][3], k3, e, false);
            d = dpp_red8(d + e);
            const h2 p0 = S[h][0] * w0 + vv * d0, p1 = S[h][1] * w1 + vv * d1, p2 = S[h][2] * w2 + vv * d2, p3 = S[h][3] * w3 + vv * d3;
            const _Float16 sh = (_Float16)(-d); const h2 sa = {sh, sh};
            S[h][0] = p0 + sa * a0; S[h][1] = p1 + sa * a1; S[h][2] = p2 + sa * a2; S[h][3] = p3 + sa * a3;
            float y = __builtin_amdgcn_fdot2(S[h][0], r0, 0.f, false); float z = __builtin_amdgcn_fdot2(S[h][2], r2, 0.f, false);
            y = __builtin_amdgcn_fdot2(S[h][1], r1, y, false); z = __builtin_amdgcn_fdot2(S[h][3], r3, z, false);
            yo[h] = dpp_red8(y + z);
        }
        if (seg == 0) *(f32x2*)(ybase + tl * 256) = yo;
    }
#undef LDSET
#undef H2
}
__device__ __forceinline__ unsigned pkh(float a, float b) { const h2 v = {(_Float16)a, (_Float16)b}; return __builtin_bit_cast(unsigned, v); }
struct P {
    const bf16_t* ZR; bf16_t* YB; float* BON;
    const float *mup, *mun, *w0, *w2, *a0, *a2, *kk_w, *ka_w, *rk_w;
};
__device__ __forceinline__ void job(int s, int dir, int head, const P& p, char* lds) {
    int tid = threadIdx.x; asm volatile("" : "+v"(tid));
    const int wid = __builtin_amdgcn_readfirstlane(tid >> 6), lane = tid & 63;
    const int tok0 = seq_start(s), T = seq_len(s), NCH = T / TC;
    float* TBL = (float*)(lds + O_TBL);
    float* MUP = TBL; float* MUN = TBL + 320; float* KKW = TBL + 640; float* KAW = TBL + 704; float* RKW = TBL + 768; float* BW = TBL + 832; float* BA = TBL + 896;
    __syncthreads();
    if (tid < 320) { const int which = tid >> 6, j = tid & 63; const int col = which < 3 ? which * 1024 + head * 64 + j : (which == 3 ? 3072 : 3200) + dir * 64 + j; MUP[tid] = p.mup[col]; MUN[tid] = p.mun[col]; }
    if (tid >= 320 && tid < 384) { const int j = tid - 320; KKW[j] = p.kk_w[head * 64 + j]; KAW[j] = p.ka_w[head * 64 + j]; RKW[j] = p.rk_w[head * 64 + j];
        BW[j] = p.w0[dir * 1024 + head * 64 + j]; BA[j] = p.a0[dir * 1024 + head * 64 + j]; }
    bf16_t* yb = p.YB + (size_t)dir * NT * 1024; float* bon = p.BON + (size_t)dir * NT * 16;
    if (wid >= 4) {
        const int pw = wid - 4;
        char* priv = lds + O_PRIV + pw * 8192;
        bf16_t* AWl = (bf16_t*)priv; bf16_t* AAl = AWl + 512; float* PK = (float*)(priv + 2048); float* PA = (float*)(priv + 4096); float* PR = (float*)(priv + 6144);
        bf16x8 Bf[2][4][2];
#pragma unroll
        for (int mat = 0; mat < 2; ++mat)
#pragma unroll
            for (int cbk = 0; cbk < 4; ++cbk)
#pragma unroll
                for (int ks = 0; ks < 2; ++ks) { const float* W2 = (mat == 0 ? p.w2 : p.a2) + (size_t)dir * 64 * 1024 + head * 64 + cbk * 16 + (lane & 15) + (size_t)(ks * 32 + (lane >> 4) * 8) * 1024;
                    float f[8];
#pragma unroll
                    for (int e = 0; e < 8; ++e) f[e] = W2[(size_t)e * 1024];
                    u32x4 w; w.x = cvt_pk_bf16(f[0], f[1]); w.y = cvt_pk_bf16(f[2], f[3]); w.z = cvt_pk_bf16(f[4], f[5]); w.w = cvt_pk_bf16(f[6], f[7]); Bf[mat][cbk][ks] = *reinterpret_cast<bf16x8*>(&w); }
        __syncthreads();
        const int pt = tid - 256;
        u32x4 zc[5], zm[5], zn[5];
#define PLOAD(cc) do { const int tf_ = dir ? T - TC * ((cc) + 1) : TC * (cc); \
    _Pragma("unroll") for (int k = 0; k < 5; ++k) { const int which = k, tl8 = lane >> 3, j0 = (lane & 7) * 8; \
        const int col = which < 3 ? which * 1024 + head * 64 + j0 : (which == 3 ? 3072 : 3200) + dir * 64 + j0; \
        const int t = tf_ + 8 * pw + tl8; const bf16_t* zp = p.ZR + (size_t)(tok0 + t) * ZRP + col; \
        zc[k] = *(const u32x4*)zp; zm[k] = (u32x4){0u, 0u, 0u, 0u}; zn[k] = (u32x4){0u, 0u, 0u, 0u}; \
        if (t > 0) zm[k] = *(const u32x4*)(zp - ZRP); \
        if (t < T - 1) zn[k] = *(const u32x4*)(zp + ZRP); } } while (0)
        PLOAD(0);
        for (int c = -1; c < NCH; ++c) {
            if (c >= 1) { const int cb_ = (c - 1) & 1, tf = dir ? T - TC * c : TC * (c - 1); const int tl = pt >> 3, c8 = (pt & 7) * 8;
                const float* yp = (const float*)(lds + cb_ * BUFB + O_Y) + tl * 64 + c8; const f32x4 y4 = *(const f32x4*)yp, y5 = *(const f32x4*)(yp + 4);
                u32x4 w; w.x = cvt_pk_bf16(y4[0], y4[1]); w.y = cvt_pk_bf16(y4[2], y4[3]); w.z = cvt_pk_bf16(y5[0], y5[1]); w.w = cvt_pk_bf16(y5[2], y5[3]);
                *(u32x4*)(yb + (size_t)(tok0 + tf + tl) * 1024 + head * 64 + c8) = w; }
            if (c + 1 < NCH) {
                const int nb = (c + 1) & 1, tfirst = dir ? T - TC * (c + 2) : TC * (c + 1);
                char* B_ = lds + nb * BUFB;
#pragma unroll
                for (int k = 0; k < 5; ++k) { const int which = k, tl8 = lane >> 3, j0 = (lane & 7) * 8, tl = 8 * pw + tl8;
                    const f32x4 mpa = *(const f32x4*)(MUP + which * 64 + j0), mpb = *(const f32x4*)(MUP + which * 64 + j0 + 4), mna = *(const f32x4*)(MUN + which * 64 + j0), mnb = *(const f32x4*)(MUN + which * 64 + j0 + 4);
                    const u32x4 z = zc[k], zmm = zm[k], znn = zn[k];
                    float v[8];
#define SH(i, zw, zmw, znw, lohi, mp_, mn_) { const float zz = lohi(zw), a_ = lohi(zmw), b_ = lohi(znw); v[i] = zz + mp_ * (a_ - zz) + mn_ * (b_ - zz); }
                    SH(0, z.x, zmm.x, znn.x, bflo, mpa[0], mna[0]) SH(1, z.x, zmm.x, znn.x, bfhi, mpa[1], mna[1]) SH(2, z.y, zmm.y, znn.y, bflo, mpa[2], mna[2]) SH(3, z.y, zmm.y, znn.y, bfhi, mpa[3], mna[3])
                    SH(4, z.z, zmm.z, znn.z, bflo, mpb[0], mnb[0]) SH(5, z.z, zmm.z, znn.z, bfhi, mpb[1], mnb[1]) SH(6, z.w, zmm.w, znn.w, bflo, mpb[2], mnb[2]) SH(7, z.w, zmm.w, znn.w, bfhi, mpb[3], mnb[3])
#undef SH
                    if (which < 2) { float* dst = (which == 0 ? PR : PK) + tl8 * 64 + j0;
                        *(f32x4*)dst = (f32x4){v[0], v[1], v[2], v[3]}; *(f32x4*)(dst + 4) = (f32x4){v[4], v[5], v[6], v[7]}; }
                    else if (which == 2) { unsigned* dst = (unsigned*)(B_ + O_V) + tl * 64 + j0;
                        *(u32x4*)dst = (u32x4){pkh(v[0], v[0]), pkh(v[1], v[1]), pkh(v[2], v[2]), pkh(v[3], v[3])}; *(u32x4*)(dst + 4) = (u32x4){pkh(v[4], v[4]), pkh(v[5], v[5]), pkh(v[6], v[6]), pkh(v[7], v[7])}; }
                    else { if (which == 3) {
#pragma unroll
                            for (int i = 0; i < 8; ++i) { const float e2 = __expf(2.f * v[i]); v[i] = 1.f - 2.f * __builtin_amdgcn_rcpf(e2 + 1.f); } }
                        u32x4 w; w.x = cvt_pk_bf16(v[0], v[1]); w.y = cvt_pk_bf16(v[2], v[3]); w.z = cvt_pk_bf16(v[4], v[5]); w.w = cvt_pk_bf16(v[6], v[7]);
                        *(u32x4*)((which == 3 ? AWl : AAl) + tl8 * 64 + j0) = w; }
                }
                if (c + 2 < NCH) PLOAD(c + 2);
                { const int tj = lane & 7, kq = lane >> 4;
#pragma unroll
                  for (int mat = 0; mat < 2; ++mat) { const bf16_t* Am = (mat == 0 ? AWl : AAl) + tj * 64 + kq * 8;
                      const bf16x8 y0 = *reinterpret_cast<const bf16x8*>(Am), y1 = *reinterpret_cast<const bf16x8*>(Am + 32);
#pragma unroll
                      for (int cbk = 0; cbk < 4; ++cbk) { f32x4 acc = {0.f, 0.f, 0.f, 0.f};
                          acc = __builtin_amdgcn_mfma_f32_16x16x32_bf16(Bf[mat][cbk][0], y0, acc, 0, 0, 0);
                          acc = __builtin_amdgcn_mfma_f32_16x16x32_bf16(Bf[mat][cbk][1], y1, acc, 0, 0, 0);
                          const int col = cbk * 16 + 4 * kq; const f32x4 bias = *(const f32x4*)((mat == 0 ? BW : BA) + col); f32x4 res;
#pragma unroll
                          for (int r = 0; r < 4; ++r) { const float u = acc[r] + bias[r];
                              const float sg = __builtin_amdgcn_rcpf(1.f + __expf(-u));
                              res[r] = mat == 0 ? __expf(-0.60653065971263342f * sg) : sg; }
                          if ((lane & 15) < 8) { if (mat == 0) *(u32x2*)((_Float16*)(B_ + O_W) + (8 * pw + tj) * 64 + col) = (u32x2){pkh(res[0], res[1]), pkh(res[2], res[3])};
                                                 else *(f32x4*)(PA + tj * 64 + col) = res; } } } }
                { const int t8 = lane >> 3, tl = 8 * pw + t8, c0 = (lane & 7) * 8; const int o = t8 * 64 + c0;
                  float bs = 0.f, ss = 0.f; f32x4 kr[2], k4[2], a4[2], r4[2];
#pragma unroll
                  for (int q = 0; q < 2; ++q) { k4[q] = *(const f32x4*)(PK + o + 4 * q); a4[q] = *(const f32x4*)(PA + o + 4 * q); r4[q] = *(const f32x4*)(PR + o + 4 * q);
                      kr[q] = k4[q] * *(const f32x4*)(KKW + c0 + 4 * q); ss += (kr[q][0] * kr[q][0] + kr[q][1] * kr[q][1]) + (kr[q][2] * kr[q][2] + kr[q][3] * kr[q][3]); }
                  ss = dpp_red8(ss);
                  const float inv = __builtin_amdgcn_rsqf(fmaxf(ss, 1e-24f));
                  f32x4 kk[2], kd[2], kka[2];
#pragma unroll
                  for (int q = 0; q < 2; ++q) { kk[q] = kr[q] * inv; kd[q] = k4[q] * (1.f + (a4[q] - 1.f) * *(const f32x4*)(KAW + c0 + 4 * q)); kka[q] = kk[q] * a4[q];
                      const f32x4 bb = r4[q] * kd[q] * *(const f32x4*)(RKW + c0 + 4 * q); bs += (bb[0] + bb[1]) + (bb[2] + bb[3]); }
                  const int oh = (tl * 64 + c0) * 2;
#define ST8(OFF, X) *(u32x4*)(B_ + (OFF) + oh) = (u32x4){pkh(X[0][0], X[0][1]), pkh(X[0][2], X[0][3]), pkh(X[1][0], X[1][1]), pkh(X[1][2], X[1][3])}
                  ST8(O_KK, kk); ST8(O_KD, kd); ST8(O_KA, kka); ST8(O_R, r4);
#undef ST8
                  bs = dpp_red8(bs);
                  if ((lane & 7) == 0) bon[(size_t)(tok0 + tfirst + tl) * 16 + head] = bs; }
            }
            asm volatile("s_waitcnt lgkmcnt(0)" ::: "memory"); __builtin_amdgcn_s_barrier(); asm volatile("" ::: "memory");
        }
#undef PLOAD
    } else {
        __syncthreads();
        const int row0 = wid * 16 + (lane >> 3) * 2, seg = lane & 7;
        h2 S[2][4];
#pragma unroll
        for (int h = 0; h < 2; ++h)
#pragma unroll
            for (int q = 0; q < 4; ++q) S[h][q] = (h2){(_Float16)0.f, (_Float16)0.f};
        asm volatile("s_waitcnt lgkmcnt(0)" ::: "memory"); __builtin_amdgcn_s_barrier(); asm volatile("" ::: "memory");
        for (int c = 0; c < NCH; ++c) {
            const char* B_ = lds + (c & 1) * BUFB;
            if (dir) scan_chunk<1>(B_, S, seg, row0); else scan_chunk<0>(B_, S, seg, row0);
            asm volatile("s_waitcnt lgkmcnt(0)" ::: "memory"); __builtin_amdgcn_s_barrier(); asm volatile("" ::: "memory");
        }
    }
    if (wid >= 4) {
        const int pt = tid - 256, c = NCH, cb_ = (c - 1) & 1, tf = dir ? T - TC * c : TC * (c - 1); const int tl = pt >> 3, c8 = (pt & 7) * 8;
        const float* yp = (const float*)(lds + cb_ * BUFB + O_Y) + tl * 64 + c8; const f32x4 y4 = *(const f32x4*)yp, y5 = *(const f32x4*)(yp + 4);
        u32x4 w; w.x = cvt_pk_bf16(y4[0], y4[1]); w.y = cvt_pk_bf16(y4[2], y4[3]); w.z = cvt_pk_bf16(y5[0], y5[1]); w.w = cvt_pk_bf16(y5[2], y5[3]);
        *(u32x4*)(yb + (size_t)(tok0 + tf + tl) * 1024 + head * 64 + c8) = w;
    }
    __syncthreads();
}
}

__device__ __forceinline__ void p4_post(const Args& a, char* lds, int vcu, int G) {
    const int tid = threadIdx.x, lane = tid & 63;
    unsigned char* ws = a.ws;
    const bf16_t* ZR = (const bf16_t*)a.out; bf16_t* QK = (bf16_t*)(ws + WS_QK);
    const bf16_t* Y0 = (const bf16_t*)(ws + WS_Y); const bf16_t* Y1 = Y0 + (size_t)NT * 1024;
    const float* BON = (const float*)(ws + WS_BON);
    const float* mup = a.in[13]; const float* mun = a.in[14]; const float* G2 = a.in[19]; const float* lnw = a.in[23]; const float* lnb = a.in[24]; const float* subg = a.in[12];
    bf16_t* SGh = (bf16_t*)lds; float* BL = (float*)(lds + 20480); bf16_t* GL = (bf16_t*)(lds + 24576);
    const bf16_t* G2T = (const bf16_t*)(ws + WS_G2T);
    const int wid = tid >> 6, r32 = lane & 31, hi = lane >> 5;
    for (int tile = vcu; tile < NT / 32; tile += G) {
        const int tk0 = tile * 32;
        __syncthreads();
        for (int it = tid; it < 32 * 20; it += NTHR) {
            const int tl = it / 20, j0 = (it % 20) * 8, col = 3328 + j0, tok = tk0 + tl, t = tok_pos(tok), T = tok < TP ? TP : TS;
            const bf16_t* zp = ZR + (size_t)tok * ZRP + col; const u32x4 z = *(const u32x4*)zp; u32x4 zm = {0u, 0u, 0u, 0u}, zn = {0u, 0u, 0u, 0u};
            if (t > 0) zm = *(const u32x4*)(zp - ZRP);
            if (t < T - 1) zn = *(const u32x4*)(zp + ZRP);
            float v[8];
            const f32x4 mpa = *(const f32x4*)(mup + col), mpb = *(const f32x4*)(mup + col + 4), mna = *(const f32x4*)(mun + col), mnb = *(const f32x4*)(mun + col + 4);
#define SH(i, zw, zmw, znw, lohi) { const float zz = lohi(zw), a_ = lohi(zmw), b_ = lohi(znw), mp_ = (i < 4 ? mpa[i & 3] : mpb[i & 3]), mn_ = (i < 4 ? mna[i & 3] : mnb[i & 3]); v[i] = sigmoidf_(zz + mp_ * (a_ - zz) + mn_ * (b_ - zz)); }
            SH(0, z.x, zm.x, zn.x, bflo) SH(1, z.x, zm.x, zn.x, bfhi) SH(2, z.y, zm.y, zn.y, bflo) SH(3, z.y, zm.y, zn.y, bfhi)
            SH(4, z.z, zm.z, zn.z, bflo) SH(5, z.z, zm.z, zn.z, bfhi) SH(6, z.w, zm.w, zn.w, bflo) SH(7, z.w, zm.w, zn.w, bfhi)
#undef SH
            { u32x4 w; w.x = cvt_pk_bf16(v[0], v[1]); w.y = cvt_pk_bf16(v[2], v[3]); w.z = cvt_pk_bf16(v[4], v[5]); w.w = cvt_pk_bf16(v[6], v[7]); *(u32x4*)(SGh + tl * 160 + j0) = w; }
        }
        { const int tl = tid >> 4, hd = tid & 15; BL[tid] = BON[(size_t)(tk0 + tl) * 16 + hd] + BON[(size_t)NT * 16 + (size_t)(tk0 + tl) * 16 + hd]; }
        { const int pr = tid >> 1, half = tid & 1, tl = pr >> 3, hd = pr & 7; bf16_t* op = QK + (size_t)(tk0 + tl) * 2048 + hd * 128 + half * 64;
          u32x4 w[8]; float ss = 0.f;
#pragma unroll
          for (int i = 0; i < 8; ++i) { w[i] = *(const u32x4*)(op + i * 8);
              ss += bflo(w[i].x) * bflo(w[i].x) + bfhi(w[i].x) * bfhi(w[i].x) + bflo(w[i].y) * bflo(w[i].y) + bfhi(w[i].y) * bfhi(w[i].y) + bflo(w[i].z) * bflo(w[i].z) + bfhi(w[i].z) * bfhi(w[i].z) + bflo(w[i].w) * bflo(w[i].w) + bfhi(w[i].w) * bfhi(w[i].w); }
          ss += __shfl_xor(ss, 1);
          const float rstd = rsqrtf(ss * (1.f / 128.f) + 1e-6f) * 0.8f; const float* sg = subg + half * 64;
#pragma unroll
          for (int i = 0; i < 8; ++i) { u32x4 o;
              o.x = cvt_pk_bf16(bflo(w[i].x) * rstd * sg[i * 8 + 0], bfhi(w[i].x) * rstd * sg[i * 8 + 1]); o.y = cvt_pk_bf16(bflo(w[i].y) * rstd * sg[i * 8 + 2], bfhi(w[i].y) * rstd * sg[i * 8 + 3]);
              o.z = cvt_pk_bf16(bflo(w[i].z) * rstd * sg[i * 8 + 4], bfhi(w[i].z) * rstd * sg[i * 8 + 5]); o.w = cvt_pk_bf16(bflo(w[i].w) * rstd * sg[i * 8 + 6], bfhi(w[i].w) * rstd * sg[i * 8 + 7]);
              *(u32x4*)(op + i * 8) = o; } }
        __syncthreads();
        { f32x16 gacc[4] = {};
#pragma unroll
          for (int ks = 0; ks < 10; ++ks) { const bf16x8 af = *reinterpret_cast<const bf16x8*>(SGh + r32 * 160 + ks * 16 + hi * 8);
#pragma unroll
              for (int cb = 0; cb < 4; ++cb) { const bf16x8 bfr = *reinterpret_cast<const bf16x8*>(G2T + (size_t)(wid * 128 + cb * 32 + r32) * 160 + ks * 16 + hi * 8);
                  gacc[cb] = __builtin_amdgcn_mfma_f32_32x32x16_bf16(af, bfr, gacc[cb], 0, 0, 0); } }
#pragma unroll
          for (int cb = 0; cb < 4; ++cb)
#pragma unroll
              for (int r = 0; r < 16; ++r) GL[(att::crow(r, hi)) * 1024 + wid * 128 + cb * 32 + r32] = (bf16_t)(cvt_pk_bf16(gacc[cb][r], gacc[cb][r]) & 0xffffu); }
        __syncthreads();
        const int c0 = tid * 2;
        const int hd = tid >> 5;
        const float lw0 = lnw[c0], lw1 = lnw[c0 + 1], lb0 = lnb[c0], lb1 = lnb[c0 + 1];
        const float mp0 = mup[2048 + c0], mp1 = mup[2048 + c0 + 1], mn0 = mun[2048 + c0], mn1 = mun[2048 + c0 + 1];
#pragma unroll
        for (int i = 0; i < 32; ++i) {
            const int tok = tk0 + i, t = tok_pos(tok), T = tok < TP ? TP : TS;
            const unsigned ya = *(const unsigned*)(Y0 + (size_t)tok * 1024 + c0), yb = *(const unsigned*)(Y1 + (size_t)tok * 1024 + c0);
            const float y0 = bflo(ya) + bflo(yb), y1 = bfhi(ya) + bfhi(yb);
            float s = y0 + y1, q = y0 * y0 + y1 * y1;
#pragma unroll
            for (int o = 16; o < 32; o <<= 1) { s += __shfl_xor(s, o); q += __shfl_xor(q, o); }
#define DPPADD(x, ctrl) x += __uint_as_float(__builtin_amdgcn_update_dpp(0u, __float_as_uint(x), ctrl, 0xf, 0xf, false))
            DPPADD(s, 0xB1); DPPADD(q, 0xB1); DPPADD(s, 0x4E); DPPADD(q, 0x4E); DPPADD(s, 0x141); DPPADD(q, 0x141); DPPADD(s, 0x140); DPPADD(q, 0x140);
#undef DPPADD
            const float mean = s * (1.f / 64.f), var = fmaxf(q * (1.f / 64.f) - mean * mean, 0.f), rstd = rsqrtf(var + 64e-5f);
            const bf16_t* zp = ZR + (size_t)tok * ZRP + 2048 + c0; const unsigned z = *(const unsigned*)zp;
            unsigned zm = 0u, zn = 0u;
            if (t > 0) zm = *(const unsigned*)(zp - ZRP);
            if (t < T - 1) zn = *(const unsigned*)(zp + ZRP);
            const float v0 = bflo(z) + mp0 * (bflo(zm) - bflo(z)) + mn0 * (bflo(zn) - bflo(z)), v1 = bfhi(z) + mp1 * (bfhi(zm) - bfhi(z)) + mn1 * (bfhi(zn) - bfhi(z));
            const float bo = BL[i * 16 + hd];
            const unsigned gg = *(const unsigned*)(GL + i * 1024 + c0);
            const float o0 = ((y0 - mean) * rstd * lw0 + lb0 + bo * v0) * bflo(gg), o1 = ((y1 - mean) * rstd * lw1 + lb1 + bo * v1) * bfhi(gg);
            *(unsigned*)(QK + (size_t)tok * 2048 + 1024 + c0) = cvt_pk_bf16(o0, o1);
        }
    }
    __syncthreads();
}

struct SchedMerge {
    int v, G; const char* H; const char* WG; const char* QK; const char* VM; const char* PAR; const char* PM2;
    __device__ __forceinline__ bool next(int i, Unit& u) const {
        const int ti = i / 6, kind = i - ti * 6; const long L = (long)ti * G + v; int pm, pn;
        if (!TileMap{192, 8}.get(L, pm, pn)) return false;
        u.pm = pm; u.pn = pn; u.kind = kind; u.t0 = 0; u.T = 0;
        const size_t bo = (size_t)pn * MiB;
        switch (kind) {
            case 0: u.A = H + (size_t)pm * MiB; u.B = WG + bo; u.nt = 32; break;
            case 1: u.A = QK + (size_t)pm * MiB; u.B = PAR + bo; u.nt = 16; break;
            case 2: u.A = H + (size_t)pm * MiB; u.B = WG + 8 * MiB + bo; u.nt = 32; break;
            case 3: u.A = QK + (size_t)pm * MiB + 2048; u.B = PAR + bo + 2048; u.nt = 16; break;
            case 4: u.A = H + (size_t)pm * MiB; u.B = WG + 16 * MiB + bo; u.nt = 32; break;
            default: u.A = VM + (size_t)pm * MiB + 2048; u.B = PM2 + bo; u.nt = 16; break;
        }
        return true;
    }
};
struct EpiMerge {
    u32x4* scrG; f32x4* scrP; bf16_t* MRG;
    __device__ __forceinline__ void operator()(const f32x4 (&acc)[2][2][4][2], const Unit& u, int wr, int wc, int fr, int fq) const {
        const int tid = threadIdx.x, kind = u.kind;
        u32x4* gp = scrG + tid; f32x4* pp = scrP + tid;
        if ((kind & 1) == 0) {
#pragma unroll
            for (int ai = 0; ai < 2; ++ai)
#pragma unroll
                for (int bj = 0; bj < 2; ++bj)
#pragma unroll
                    for (int m = 0; m < 4; ++m) { const f32x4 v0 = acc[ai][bj][m][0], v1 = acc[ai][bj][m][1]; u32x4 w;
                        w.x = cvt_pk_bf16(sigmoidf_(v0[0]), sigmoidf_(v0[1])); w.y = cvt_pk_bf16(sigmoidf_(v0[2]), sigmoidf_(v0[3]));
                        w.z = cvt_pk_bf16(sigmoidf_(v1[0]), sigmoidf_(v1[1])); w.w = cvt_pk_bf16(sigmoidf_(v1[2]), sigmoidf_(v1[3]));
                        *gp = w; gp += NTHR; asm volatile("" : "+v"(gp) :: "memory"); }
        } else {
            const int row0 = u.pm * 256 + wr * 64 + fr, col0 = u.pn * 256 + wc * 32 + 8 * fq;
#pragma unroll
            for (int ai = 0; ai < 2; ++ai)
#pragma unroll
                for (int bj = 0; bj < 2; ++bj) {
                    bf16_t* mp = MRG + (size_t)(row0 + ai * 128) * 2048 + col0 + bj * 128;
#pragma unroll
                    for (int m = 0; m < 4; ++m) { const u32x4 g = *gp;
                        f32x4 p0 = acc[ai][bj][m][0] * (f32x4){bflo(g.x), bfhi(g.x), bflo(g.y), bfhi(g.y)}, p1 = acc[ai][bj][m][1] * (f32x4){bflo(g.z), bfhi(g.z), bflo(g.w), bfhi(g.w)};
                        if (kind > 1) { p0 += pp[0]; p1 += pp[NTHR]; }
                        if (kind < 5) { pp[0] = p0; pp[NTHR] = p1; }
                        else { u32x4 w; w.x = cvt_pk_bf16(p0[0], p0[1]); w.y = cvt_pk_bf16(p0[2], p0[3]); w.z = cvt_pk_bf16(p1[0], p1[1]); w.w = cvt_pk_bf16(p1[2], p1[3]);
                            *(u32x4*)mp = w; }
                        gp += NTHR; pp += 2 * NTHR; mp += 16 * 2048; asm volatile("" : "+v"(gp), "+v"(pp), "+v"(mp) :: "memory"); } }
        }
    }
};

struct SchedSq {
    int v, G; const char* A; const char* B; size_t astep, bstep; int nt;
    __device__ __forceinline__ bool next(int i, Unit& u) const {
        const long L = (long)i * G + v; int pm, pn; if (!TileMap{192, 8}.get(L, pm, pn)) return false;
        u.A = A + (size_t)pm * astep; u.B = B + (size_t)pn * bstep; u.nt = nt; u.pm = pm; u.pn = pn; u.kind = 0; u.t0 = 0; u.T = 0; return true;
    }
};
struct EpiWo {
    const float* xp; const float* xs; float* out;
    __device__ __forceinline__ void operator()(const f32x4 (&acc)[2][2][4][2], const Unit& u, int wr, int wc, int fr, int fq) const {
        const int row0 = u.pm * 256 + wr * 64 + fr, col0 = u.pn * 256 + wc * 32 + 8 * fq;
#pragma unroll
        for (int ai = 0; ai < 2; ++ai)
#pragma unroll
            for (int m = 0; m < 4; ++m) { const int row = row0 + ai * 128 + m * 16;
                const float* xr = (row < TP ? xp + (size_t)row * DM : xs + (size_t)(row - TP) * DM) + col0; float* orow = out + (size_t)row * DM + col0;
#pragma unroll
                for (int bj = 0; bj < 2; ++bj) { const f32x4 x0 = *(const f32x4*)(xr + bj * 128), x1 = *(const f32x4*)(xr + bj * 128 + 4);
                    *(f32x4*)(orow + bj * 128) = x0 + acc[ai][bj][m][0]; *(f32x4*)(orow + bj * 128 + 4) = x1 + acc[ai][bj][m][1]; } }
    }
};
struct EpiDown {
    float* out;
    __device__ __forceinline__ void operator()(const f32x4 (&acc)[2][2][4][2], const Unit& u, int wr, int wc, int fr, int fq) const {
        const int row0 = u.pm * 256 + wr * 64 + fr, col0 = u.pn * 256 + wc * 32 + 8 * fq;
#pragma unroll
        for (int ai = 0; ai < 2; ++ai)
#pragma unroll
            for (int m = 0; m < 4; ++m) { float* orow = out + (size_t)(row0 + ai * 128 + m * 16) * DM + col0;
#pragma unroll
                for (int bj = 0; bj < 2; ++bj) { const f32x4 x0 = *(const f32x4*)(orow + bj * 128), x1 = *(const f32x4*)(orow + bj * 128 + 4);
                    *(f32x4*)(orow + bj * 128) = x0 + acc[ai][bj][m][0]; *(f32x4*)(orow + bj * 128 + 4) = x1 + acc[ai][bj][m][1]; } }
    }
};

struct SchedUp {
    int v, G; const char* HN; const char* WUP;
    __device__ __forceinline__ bool next(int i, Unit& u) const {
        const long L = (long)i * G + v; int pm, pn; if (!TileMap{197, 44}.get(L, pm, pn)) return false;
        int s, ti; if (pm < 65) { s = 0; ti = pm; } else { s = 1 + (pm - 65) / 33; ti = (pm - 65) % 33; }
        const int T = seq_len(s); int t0 = 254 * ti - 1; if (t0 > T - 255) t0 = T - 255;
        u.pm = seq_start(s); u.pn = pn; u.kind = 0; u.t0 = t0; u.T = T; u.nt = 32;
        u.A = HN + ((long)u.pm + t0) * 4096; u.B = WUP + (size_t)pn * MiB; return true;
    }
};
struct EpiUp {
    bf16_t* ACT; const float* cw; const float* cb; LAS float* xch;
    __device__ __forceinline__ void operator()(const f32x4 (&acc)[2][2][4][2], const Unit& u, int wr, int wc, int fr, int fq) const {
        const int lane = threadIdx.x & 63;
        const int cin = wc * 32 + 8 * fq;
#pragma unroll
        for (int ai = 0; ai < 2; ++ai) { const int rg = 2 * ai + wr;
#pragma unroll
            for (int bj = 0; bj < 2; ++bj)
#pragma unroll
                for (int n = 0; n < 2; ++n) {
                    if (fr == 0) *(LAS f32x4*)(xch + (rg * 2 + 0) * 256 + bj * 128 + cin + 4 * n) = acc[ai][bj][0][n];
                    if (fr == 15) *(LAS f32x4*)(xch + (rg * 2 + 1) * 256 + bj * 128 + cin + 4 * n) = acc[ai][bj][3][n]; } }
        asm volatile("s_waitcnt lgkmcnt(0)" ::: "memory"); __builtin_amdgcn_s_barrier(); asm volatile("" ::: "memory");
        const int gc = u.pn * 128 + cin;
#pragma unroll
        for (int n = 0; n < 2; ++n) {
            const int wcol = gc + 4 * n;
            const f32x4 g0 = *(const f32x4*)(cw + wcol), g1 = *(const f32x4*)(cw + 2 * DFF + wcol), g2 = *(const f32x4*)(cw + 4 * DFF + wcol), gb = *(const f32x4*)(cb + wcol);
            const f32x4 v0 = *(const f32x4*)(cw + DFF + wcol), v1 = *(const f32x4*)(cw + 3 * DFF + wcol), v2 = *(const f32x4*)(cw + 5 * DFF + wcol), vb = *(const f32x4*)(cb + DFF + wcol);
#pragma unroll
            for (int ai = 0; ai < 2; ++ai) { const int rg = 2 * ai + wr;
                bf16_t* ap = ACT + ((long)u.pm + u.t0 + 128 * ai + 64 * wr + fr) * DFF + gc + 4 * n;
#pragma unroll
                for (int m = 0; m < 4; ++m) {
                    const int j = 128 * ai + 64 * wr + 16 * m + fr, t = u.t0 + j;
                    f32x4 res;
#pragma unroll
                    for (int bj = 0; bj < 2; ++bj) {
                        const f32x4 cur = acc[ai][bj][m][n];
                        const f32x4 sp = (m > 0 && fr == 15) ? acc[ai][bj][m > 0 ? m - 1 : 0][n] : cur;
                        const f32x4 sn = (m < 3 && fr == 0) ? acc[ai][bj][m < 3 ? m + 1 : 3][n] : cur;
                        f32x4 pv, nv;
#pragma unroll
                        for (int i = 0; i < 4; ++i) { pv[i] = __uint_as_float(__builtin_amdgcn_update_dpp(0u, __float_as_uint(sp[i]), 0x121, 0xf, 0xf, false));
                                                       nv[i] = __uint_as_float(__builtin_amdgcn_update_dpp(0u, __float_as_uint(sn[i]), 0x12F, 0xf, 0xf, false)); }
                        if (m == 0) { const f32x4 xprev = rg > 0 ? *(const LAS f32x4*)(xch + ((rg - 1) * 2 + 1) * 256 + bj * 128 + cin + 4 * n) : (f32x4){0.f, 0.f, 0.f, 0.f}; if (fr == 0) pv = xprev; }
                        if (m == 3) { const f32x4 xnext = rg < 3 ? *(const LAS f32x4*)(xch + ((rg + 1) * 2 + 0) * 256 + bj * 128 + cin + 4 * n) : (f32x4){0.f, 0.f, 0.f, 0.f}; if (fr == 15) nv = xnext; }
                        if (t < 1) pv = (f32x4){0.f, 0.f, 0.f, 0.f};
                        if (t >= u.T - 1) nv = (f32x4){0.f, 0.f, 0.f, 0.f};
                        if (bj == 0) { const f32x4 cv = g0 * pv + g1 * cur + g2 * nv + gb; res = (f32x4){cv[0] * sigmoidf_(cv[0]), cv[1] * sigmoidf_(cv[1]), cv[2] * sigmoidf_(cv[2]), cv[3] * sigmoidf_(cv[3])}; }
                        else { const f32x4 cv = v0 * pv + v1 * cur + v2 * nv + vb; res = res * cv; }
                    }
                    if (j >= 1 && j <= 254) { u32x2 w; w.x = cvt_pk_bf16(res[0], res[1]); w.y = cvt_pk_bf16(res[2], res[3]); *(u32x2*)ap = w; }
                    ap += 16 * DFF; asm volatile("" : "+v"(ap) :: "memory");
                }
            }
        }
    }
};

__global__ void __launch_bounds__(NTHR, 2) enc_fwd(Args args) {
    extern __shared__ __attribute__((aligned(16))) unsigned char lds_raw[];
    cg::grid_group grid = cg::this_grid();
    LAS unsigned char* lds = (LAS unsigned char*)lds_raw;
    const int tid = threadIdx.x;
    const int G = gridDim.x, bx = blockIdx.x, vcu = (G % 8 == 0) ? (bx % 8) * (G / 8) + bx / 8 : bx;
    unsigned char* ws = args.ws;
    const int lo = args.ph_lo, hi = args.ph_hi;
#ifndef P2M
#define P2M 7
#endif
#ifndef PH_MASK
#define PH_MASK 0x1ff
#endif
#define IN(k) (((PH_MASK >> (k)) & 1) && lo <= (k) && (k) < hi)
#define SEAM(k) do { if (IN(k) && IN((k) + 1)) grid.sync(); } while (0)
#ifndef PROBE
#define PROBE 0
#endif
    unsigned long long tp0 = 0, tp1 = 0;
#define TSTAMP(v) do { if (PROBE) { v = __builtin_amdgcn_s_memrealtime(); } } while (0)

    if (IN(0)) p0_prologue(args, lds, vcu, G);
    SEAM(0);
    if (IN(1)) {
        SchedIn S{vcu, G, (const char*)(ws + WS_H), (const char*)(ws + WS_WIN), (const char*)(ws + WS_MEMN), (const char*)(ws + WS_WKV)};
        EpiIn E{(bf16_t*)(ws + WS_QK), (bf16_t*)(ws + WS_VM), (bf16_t*)args.out, (bf16_t*)(ws + WS_KVM), args.in[6], args.in[7], (const float*)(ws + WS_ROPE), (const float*)(ws + WS_ROPE) + TP * 32};
        pg8::gemm_phase<EpiIn, SchedIn, true>(lds, 2048, S, E);
    }
    SEAM(1);
    if (PROBE == 1 || PROBE == 2) TSTAMP(tp0);
    if (IN(2)) {
        unsigned* ctl = (unsigned*)(ws + WS_CTL);
        volatile LAS unsigned* jobw = (volatile LAS unsigned*)(lds + LDS_MISC);
        const float lam = ((const float*)ctl)[CW_LAM];
        const bool fixref = ((const float*)ctl)[CW_SMAX] <= 30.f;
        scan::P sp{(const bf16_t*)args.out, (bf16_t*)(ws + WS_Y), (float*)(ws + WS_BON), args.in[13], args.in[14], args.in[15], args.in[16], args.in[17], args.in[18], args.in[20], args.in[21], args.in[22]};
        for (;;) {
            __syncthreads();
            if (tid == 0) jobw[0] = atomicAdd(ctl + CW_QUEUE, 1u);
            __syncthreads();
            const int jb = (int)jobw[0];
            if (jb >= 160 + 1536 + 768) break;
            if (((P2M) & 1) && jb < 160) {
                int s, r; if (jb < 32) { s = 0; r = jb; } else { s = 1 + (jb - 32) / 32; r = (jb - 32) % 32; }
                scan::job(s, r & 1, r >> 1, sp, (char*)lds_raw);
                if (PROBE == 2 && tid == 0) atomicMax((unsigned long long*)(ctl + 256), (unsigned long long)__builtin_amdgcn_s_memrealtime());
            } else if (((P2M) & 2) && jb < 160 + 1536) {
                const int a = jb - 160; int s, h, qb;
                if (a < 512) { s = 0; h = a / 64; qb = a % 64; } else { const int b = a - 512; s = 1 + b / 256; h = (b % 256) / 32; qb = b % 32; }
                if (fixref) att::diff_unit<true>(s, h, qb, (bf16_t*)(ws + WS_QK), (const bf16_t*)(ws + WS_VM), lam, (char*)lds_raw, lds);
                else att::diff_unit<false>(s, h, qb, (bf16_t*)(ws + WS_QK), (const bf16_t*)(ws + WS_VM), lam, (char*)lds_raw, lds);
            } else if ((P2M) & 4) {
                const int a = jb - 160 - 1536; int s, mh, qb;
                if (a < 256) { s = 0; mh = a / 64; qb = a % 64; } else { const int b = a - 256; s = 1 + b / 128; mh = (b % 128) / 32; qb = b % 32; }
                att::mem_unit(s, mh, qb, (bf16_t*)(ws + WS_VM), (const bf16_t*)(ws + WS_KVM), args.in[27], args.in[28], (char*)lds_raw);
            }
        }
    }
    SEAM(2);
    if (PROBE == 1) TSTAMP(tp1);
    if (IN(3)) p4_post(args, (char*)lds_raw, vcu, G);
    SEAM(3);
    if (IN(4)) {
        SchedMerge S{vcu, G, (const char*)(ws + WS_H), (const char*)(ws + WS_WG), (const char*)(ws + WS_QK), (const char*)(ws + WS_VM), (const char*)(ws + WS_PAR), (const char*)(ws + WS_PM2)};
        unsigned char* scr = (unsigned char*)args.out + (size_t)bx * (384 * 1024);
        EpiMerge E{(u32x4*)scr, (f32x4*)(scr + 128 * 1024), (bf16_t*)(ws + WS_MRG)};
        pg8::gemm_phase<EpiMerge, SchedMerge, true>(lds, 2048, S, E);
    }
    SEAM(4);
    if (IN(5)) {
        SchedSq S{vcu, G, (const char*)(ws + WS_MRG), (const char*)(ws + WS_WO), MiB, MiB, 32};
        EpiWo E{args.in[0], args.in[1], args.out};
        pg8::gemm_phase<EpiWo, SchedSq, true>(lds, 2048, S, E);
    }
    SEAM(5);
    if (IN(6)) {
        const int lane = tid & 63, gw = vcu * 8 + (tid >> 6), NGW = G * 8;
        for (int m = gw; m < NT; m += NGW) rms_row(args.out + (size_t)m * DM, args.in[33], (bf16_t*)(ws + WS_H) + (size_t)m * DM, lane);
    }
    SEAM(6);
    if (IN(7)) {
        SchedUp S{vcu, G, (const char*)(ws + WS_H), (const char*)(ws + WS_WUP)};
        EpiUp E{(bf16_t*)(ws + WS_ACT), args.in[35], args.in[36], (LAS float*)(lds + LDS_XCH)};
        pg8::gemm_phase<EpiUp, SchedUp, true>(lds, 2048, S, E);
    }
    SEAM(7);
    if (IN(8)) {
        SchedSq S{vcu, G, (const char*)(ws + WS_ACT), (const char*)(ws + WS_WDN), (size_t)256 * DFF * 2, (size_t)256 * DFF * 2, 88};
        EpiDown E{args.out};
        pg8::gemm_phase<EpiDown, SchedSq, true>(lds, DFF, S, E);
    }
    if (PROBE && bx == 0 && tid == 0) {
        if (PROBE == 2) tp1 = __hip_atomic_load((unsigned long long*)(ws + WS_CTL) + 128, __ATOMIC_RELAXED, __HIP_MEMORY_SCOPE_AGENT);
        const unsigned long long target = __builtin_amdgcn_s_memrealtime() + (tp1 > tp0 ? tp1 - tp0 : 0);
        while (__builtin_amdgcn_s_memrealtime() < target) __builtin_amdgcn_s_sleep(16);
    }
#undef IN
#undef SEAM
}

#ifndef MK_SPLIT
#define MK_SPLIT 0
#endif
extern "C" void kernel_launch(void* const* d_in, const int* in_sizes, int n_in, void* d_out, int out_size, void* d_ws, size_t ws_size, hipStream_t stream) {
    static int grid = 0;
    if (grid == 0) {
        if (n_in != 38 || out_size != NT * DM || ws_size < WS_END) { fprintf(stderr, "kernel_launch: unexpected shapes n_in %d out %d ws %zu\n", n_in, out_size, ws_size); grid = -1; return; }
        int dev = 0, cus = 0, per_cu = 0;
        hipGetDevice(&dev); hipDeviceGetAttribute(&cus, hipDeviceAttributeMultiprocessorCount, dev);
        if (hipFuncSetAttribute((const void*)enc_fwd, hipFuncAttributeMaxDynamicSharedMemorySize, LDS_BYTES) != hipSuccess) { fprintf(stderr, "kernel_launch: hipFuncSetAttribute failed\n"); grid = -1; return; }
        if (hipOccupancyMaxActiveBlocksPerMultiprocessor(&per_cu, (const void*)enc_fwd, NTHR, LDS_BYTES) != hipSuccess || per_cu < 1) { fprintf(stderr, "kernel_launch: occupancy query failed (%d)\n", per_cu); per_cu = 1; }
        (void)hipGetLastError();
        grid = cus * 1;
    }
    if (grid < 0) return;
    Args a{};
    for (int i = 0; i < 38; ++i) a.in[i] = (const float*)d_in[i];
    a.out = (float*)d_out; a.ws = (unsigned char*)d_ws;
    for (int d = 0; d < 32; ++d) a.inv_rev[d] = pow(10000.0, -(double)d / 32.0) / 6.283185307179586476925286766559;
#if MK_SPLIT
    for (int ph = 0; ph < 9; ++ph) { a.ph_lo = ph; a.ph_hi = ph + 1; void* kargs[] = {&a};
        hipError_t e = hipLaunchCooperativeKernel((const void*)enc_fwd, dim3(grid), dim3(NTHR), kargs, LDS_BYTES, stream);
        if (e != hipSuccess) { fprintf(stderr, "launch %d failed: %s\n", ph, hipGetErrorString(e)); break; } }
#else
    a.ph_lo = 0; a.ph_hi = 9;
    void* kargs[] = {&a};
    hipError_t e = hipLaunchCooperativeKernel((const void*)enc_fwd, dim3(grid), dim3(NTHR), kargs, LDS_BYTES, stream);
    if (e != hipSuccess) fprintf(stderr, "cooperative launch failed: %s (grid %d)\n", hipGetErrorString(e), grid);
#endif
}
```

```cpp
#include <hip/hip_runtime.h>
#include <hip/hip_cooperative_groups.h>
#include <cstdio>
#include <cstdint>
#include <cmath>
namespace cg = cooperative_groups;

#define LAS __attribute__((address_space(3)))
typedef unsigned short bf16_t;
typedef short bf16x8 __attribute__((ext_vector_type(8)));
typedef short s16x4 __attribute__((ext_vector_type(4)));
typedef float f32x2 __attribute__((ext_vector_type(2)));
typedef float f32x4 __attribute__((ext_vector_type(4)));
typedef float f32x16 __attribute__((ext_vector_type(16)));
typedef unsigned u32x2 __attribute__((ext_vector_type(2)));
typedef unsigned u32x4 __attribute__((ext_vector_type(4)));

constexpr int NT = 49152, DM = 2048, TP = 16384, TS = 8192, NSEQ = 5;
constexpr int ZRP = 3584;
constexpr int DFF = 5632;
constexpr int NTHR = 512;
constexpr size_t MiB = 1u << 20;
constexpr size_t WS_CTL = 0, WS_WIN = 1 * MiB, WS_WG = 31 * MiB, WS_WKV = 55 * MiB, WS_PAR = 63 * MiB, WS_PM2 = 71 * MiB, WS_WO = 79 * MiB,
                 WS_WUP = 87 * MiB, WS_WDN = 131 * MiB, WS_ROPE = 153 * MiB, WS_MEMN = 157 * MiB, WS_KVM = 162 * MiB, WS_BON = 167 * MiB,
                 WS_H = 176 * MiB, WS_QK = 370 * MiB, WS_VM = 562 * MiB, WS_Y = 754 * MiB, WS_ACT = 370 * MiB, WS_MRG = 754 * MiB, WS_END = 946 * MiB;
constexpr int CW_QUEUE = 64, CW_LAM = 128, CW_SMAX = 129;
constexpr size_t WS_G2T = 173 * MiB;
constexpr int LDS_XCH = 131072, LDS_MISC = 141312, LDS_BYTES = 141312 + 256;

__device__ __forceinline__ int seq_start(int s) { return s == 0 ? 0 : TP + (s - 1) * TS; }
__device__ __forceinline__ int seq_len(int s) { return s == 0 ? TP : TS; }
__device__ __forceinline__ int tok_pos(int tok) { return tok < TP ? tok : ((tok - TP) & (TS - 1)); }

__device__ __forceinline__ unsigned cvt_pk_bf16(float lo, float hi) { unsigned r; asm volatile("v_cvt_pk_bf16_f32 %0, %1, %2" : "=v"(r) : "v"(lo), "v"(hi)); return r; }
__device__ __forceinline__ float bflo(unsigned w) { return __uint_as_float(w << 16); }
__device__ __forceinline__ float bfhi(unsigned w) { return __uint_as_float(w & 0xffff0000u); }
__device__ __forceinline__ float bf1(bf16_t b) { return __uint_as_float((unsigned)b << 16); }
__device__ __forceinline__ float sigmoidf_(float x) { return 1.f / (1.f + __expf(-x)); }
__device__ __forceinline__ float wave_sum(float v) {
#pragma unroll
    for (int o = 1; o < 64; o <<= 1) v += __shfl_xor(v, o);
    return v;
}

namespace pg8 {
constexpr int BM = 256, BK = 64, HALF = 128, HTB = HALF * BK * 2, STAGE_BYTES = 8 * HTB;
__host__ __device__ __forceinline__ int lds_byte(int r, int c) { const int st = (r >> 4) * 2 + (c >> 5), rr = r & 15, cc = c & 31, ob = rr * 64 + cc * 2; return st * 1024 + (ob ^ (((ob >> 9) & 1) << 5)); }
__host__ __device__ __forceinline__ void stage_rc(int b, int& R, int& C) { const int st = b / 1024, sb = b % 1024, swz = sb ^ (((sb >> 9) & 1) << 5); R = (st >> 1) * 16 + swz / 64; C = (st & 1) * 32 + (swz % 64) / 2; }
__host__ __device__ __forceinline__ int perm32(int rho) { const int n = rho >> 4, i = rho & 15; return 8 * (i >> 2) + 4 * n + (i & 3); }

struct Unit { const char* A; const char* B; int nt, pm, pn, kind, t0, T; };

template <class Epi, class Sched, bool ALIGN_EPI>
__device__ __forceinline__ void gemm_phase(LAS unsigned char* lds, const int ld, const Sched& S, const Epi& E) {
    const int tid = threadIdx.x, wid = __builtin_amdgcn_readfirstlane(tid >> 6), lane = tid & 63, wr = wid >> 2, wc = wid & 3, fr = lane & 15, fq = lane >> 4;
    unsigned voffA[2], voffB[2];
#pragma unroll
    for (int i = 0; i < 2; ++i) { int R, C; stage_rc(tid * 16 + i * 8192, R, C); const int Rb = (R & ~31) + perm32(R & 31);
        voffA[i] = (unsigned)(R * ld + C) * 2u; voffB[i] = (unsigned)(Rb * ld + C) * 2u; }
    const size_t kstep = (size_t)(BK * 2);
    const size_t hstep = (size_t)HALF * ld * 2;
    const unsigned ldsw = (unsigned)wid * 1024u;
    const int aoff = lds_byte(wr * 64 + fr, fq * 8), boff = lds_byte(wc * 32 + fr, fq * 8);
#define PG8_SA(b, h) (((b) * 2 + (h)) * HTB)
#define PG8_SB(b, h) ((4 + (b) * 2 + (h)) * HTB)
#define PG8_STAGE(bufoff, gbase, voff) do { _Pragma("unroll") for (int _i = 0; _i < 2; ++_i) \
        __builtin_amdgcn_global_load_lds((const unsigned*)((const char*)(gbase) + (voff)[_i]), (LAS unsigned*)(lds + (bufoff) + ldsw + _i * 8192), 16, 0, 0); } while (0)
#define PG8_LDA(dst, b, h) do { _Pragma("unroll") for (int m = 0; m < 4; ++m) _Pragma("unroll") for (int k = 0; k < 2; ++k) dst[m][k] = *(const LAS bf16x8*)(lds + PG8_SA(b, h) + aoff + m * 2048 + k * 1024); } while (0)
#define PG8_LDB(dst, b, h) do { _Pragma("unroll") for (int n = 0; n < 2; ++n) _Pragma("unroll") for (int k = 0; k < 2; ++k) dst[n][k] = *(const LAS bf16x8*)(lds + PG8_SB(b, h) + boff + n * 2048 + k * 1024); } while (0)
#define PG8_MMA(ai, bj, At, Bt) do { __builtin_amdgcn_s_setprio(1); _Pragma("unroll") for (int m = 0; m < 4; ++m) _Pragma("unroll") for (int n = 0; n < 2; ++n) _Pragma("unroll") for (int k = 0; k < 2; ++k) \
        acc[ai][bj][m][n] = __builtin_amdgcn_mfma_f32_16x16x32_bf16(Bt[n][k], At[m][k], acc[ai][bj][m][n], 0, 0, 0); __builtin_amdgcn_s_setprio(0); } while (0)
#define PG8_WAIT_V(n) asm volatile("s_waitcnt vmcnt(" #n ")" ::: "memory")
#define PG8_WAIT_L(n) asm volatile("s_waitcnt lgkmcnt(" #n ")" ::: "memory")
#define PG8_BAR __builtin_amdgcn_s_barrier()
#define PG8_SCHED __builtin_amdgcn_sched_barrier(0)
    Unit cur, nxt; int ui = 0;
    if (!S.next(0, cur)) return;
    f32x4 acc[2][2][4][2];
#pragma unroll
    for (int a = 0; a < 2; ++a)
#pragma unroll
        for (int b = 0; b < 2; ++b)
#pragma unroll
            for (int m = 0; m < 4; ++m)
#pragma unroll
                for (int n = 0; n < 2; ++n) acc[a][b][m][n] = (f32x4){0.f, 0.f, 0.f, 0.f};
    bf16x8 At[4][2], B0[2][2], B1[2][2];
    const char* cA = cur.A; const char* cB = cur.B;
    PG8_STAGE(PG8_SB(0, 0), cB, voffB); PG8_STAGE(PG8_SB(0, 1), cB + hstep, voffB); PG8_STAGE(PG8_SA(0, 0), cA, voffA); PG8_STAGE(PG8_SA(0, 1), cA + hstep, voffA);
    if (wr == 1) PG8_BAR;
    PG8_WAIT_V(2); PG8_BAR;
    PG8_STAGE(PG8_SB(1, 0), cB + kstep, voffB); PG8_STAGE(PG8_SA(1, 0), cA + kstep, voffA); PG8_STAGE(PG8_SB(1, 1), cB + hstep + kstep, voffB);
    PG8_WAIT_V(6); PG8_BAR;
    for (;;) {
        const bool has_next = S.next(ui + 1, nxt);
        const char* nA = has_next ? nxt.A : cA; const char* nB = has_next ? nxt.B : cB;
        const int nt = cur.nt;
        for (int t = 0; t < nt; t += 2) {
            const bool last = (t == nt - 2);
            const char* a1 = cA + (size_t)(t + 1) * kstep;
            const char* a2 = last ? nA : cA + (size_t)(t + 2) * kstep; const char* b2 = last ? nB : cB + (size_t)(t + 2) * kstep;
            const char* a3 = a2 + kstep; const char* b3 = b2 + kstep;
            PG8_LDB(B0, 0, 0); PG8_LDB(B1, 0, 1); PG8_SCHED; PG8_LDA(At, 0, 0); PG8_STAGE(PG8_SA(1, 1), a1 + hstep, voffA);
            PG8_WAIT_V(8); PG8_WAIT_L(0); PG8_BAR; PG8_MMA(0, 0, At, B0); PG8_MMA(0, 1, At, B1); PG8_BAR; PG8_SCHED;
            PG8_LDA(At, 0, 1); PG8_STAGE(PG8_SB(0, 0), b2, voffB); PG8_STAGE(PG8_SB(0, 1), b2 + hstep, voffB); PG8_STAGE(PG8_SA(0, 0), a2, voffA);
            PG8_WAIT_V(8); PG8_WAIT_L(0); PG8_BAR; PG8_MMA(1, 0, At, B0); PG8_MMA(1, 1, At, B1); PG8_BAR; PG8_SCHED;
            PG8_LDB(B0, 1, 0); PG8_LDB(B1, 1, 1); PG8_SCHED; PG8_LDA(At, 1, 0); PG8_STAGE(PG8_SA(0, 1), a2 + hstep, voffA);
            PG8_WAIT_V(8); PG8_WAIT_L(0); PG8_BAR; PG8_MMA(0, 0, At, B0); PG8_MMA(0, 1, At, B1); PG8_BAR; PG8_SCHED;
            PG8_LDA(At, 1, 1); PG8_STAGE(PG8_SB(1, 0), b3, voffB); PG8_STAGE(PG8_SB(1, 1), b3 + hstep, voffB); PG8_STAGE(PG8_SA(1, 0), a3, voffA);
            PG8_WAIT_V(8); PG8_WAIT_L(0); PG8_BAR; PG8_MMA(1, 0, At, B0); PG8_MMA(1, 1, At, B1); PG8_BAR; PG8_SCHED;
        }
        if constexpr (ALIGN_EPI) { if (wr == 0) PG8_BAR; }
        E(acc, cur, wr, wc, fr, fq);
        if (!has_next) break;
#pragma unroll
        for (int a = 0; a < 2; ++a)
#pragma unroll
            for (int b = 0; b < 2; ++b)
#pragma unroll
                for (int m = 0; m < 4; ++m)
#pragma unroll
                    for (int n = 0; n < 2; ++n) acc[a][b][m][n] = (f32x4){0.f, 0.f, 0.f, 0.f};
        cur = nxt; cA = nA; cB = nB; ++ui;
        if constexpr (ALIGN_EPI) { if (wr == 1) PG8_BAR; }
    }
    PG8_WAIT_V(0);
    if constexpr (!ALIGN_EPI) { if (wr == 0) PG8_BAR; }
    PG8_BAR;
#undef PG8_SA
#undef PG8_SB
#undef PG8_STAGE
#undef PG8_LDA
#undef PG8_LDB
#undef PG8_MMA
#undef PG8_WAIT_V
#undef PG8_WAIT_L
#undef PG8_BAR
#undef PG8_SCHED
}
}
using pg8::Unit;

struct TileMap {
    int nM, nN;
    __device__ __forceinline__ bool get(long L, int& pm, int& pn) const {
        if (L >= (long)nM * nN) return false;
        const int nig = 8 * nN, gid = (int)(L / nig), fm = gid * 8, gsz = (nM - fm) < 8 ? (nM - fm) : 8, r = (int)(L % nig);
        pm = fm + r % gsz; pn = r / gsz; return true;
    }
};

struct Args {
    const float* in[38];
    float* out; unsigned char* ws;
    double inv_rev[32];
    int ph_lo, ph_hi;
};

__device__ __forceinline__ void tr_item(const float* W, int N, int src_n0, bf16_t* WT, size_t ldw, int koff, int r0, int k0, LAS float* scr, int lane) {
    if (src_n0 >= 0) {
#pragma unroll 8
        for (int i = 0; i < 32; ++i) { const int kk = 2 * i + (lane >> 5); scr[kk * 33 + (lane & 31)] = W[(size_t)(k0 + kk) * N + src_n0 + (lane & 31)]; }
    } else {
#pragma unroll 8
        for (int i = 0; i < 32; ++i) { const int kk = 2 * i + (lane >> 5); scr[kk * 33 + (lane & 31)] = 0.f; }
    }
    asm volatile("s_waitcnt lgkmcnt(0)" ::: "memory");
    const int c = lane & 7;
#pragma unroll
    for (int j = 0; j < 4; ++j) { const int n = (lane >> 3) + 8 * j; const LAS float* s = scr + (8 * c) * 33 + n;
        u32x4 o; o.x = cvt_pk_bf16(s[0 * 33], s[1 * 33]); o.y = cvt_pk_bf16(s[2 * 33], s[3 * 33]); o.z = cvt_pk_bf16(s[4 * 33], s[5 * 33]); o.w = cvt_pk_bf16(s[6 * 33], s[7 * 33]);
        *(u32x4*)(WT + (size_t)(r0 + n) * ldw + koff + k0 + 8 * c) = o; }
    asm volatile("s_waitcnt lgkmcnt(0)" ::: "memory");
}
__device__ __forceinline__ void rms_row(const float* xrow, const float* g, bf16_t* orow, int lane) {
    f32x4 v[8]; float s = 0.f;
#pragma unroll
    for (int j = 0; j < 8; ++j) { v[j] = ((const f32x4*)xrow)[64 * j + lane]; s += (v[j].x * v[j].x + v[j].y * v[j].y) + (v[j].z * v[j].z + v[j].w * v[j].w); }
    const float rstd = rsqrtf(wave_sum(s) * (1.f / DM) + 1e-6f);
#pragma unroll
    for (int j = 0; j < 8; ++j) { const f32x4 gg = ((const f32x4*)g)[64 * j + lane];
        u32x2 w; w.x = cvt_pk_bf16(v[j].x * rstd * gg.x, v[j].y * rstd * gg.y); w.y = cvt_pk_bf16(v[j].z * rstd * gg.z, v[j].w * rstd * gg.w);
        ((u32x2*)orow)[64 * j + lane] = w; }
}

__device__ __forceinline__ void p0_prologue(const Args& a, LAS unsigned char* lds, int vcu, int G) {
    const int tid = threadIdx.x, lane = tid & 63, wave = tid >> 6;
    unsigned char* ws = a.ws;
    LAS float* scr = (LAS float*)(lds + wave * 16384);
    const int gw = vcu * 8 + wave, NGW = G * 8;
    constexpr int I0 = 32 * 240, I1 = 32 * 192, I2 = 32 * 64, I3 = 16 * 64, I6 = 32 * 64, I7 = 32 * 352, I8 = 88 * 64;
    constexpr int NITEMS = I0 + I1 + I2 + 3 * I3 + I6 + I7 + I8;
    for (int it = gw; it < NITEMS; it += NGW) {
        int r = it;
        if (r < I0) { const int kb = r / 240, nb = r % 240, r0 = nb * 32; int src;
            if (r0 < 2048) { const int tile = r0 >> 8, cp = r0 & 255, h = cp >> 7, g = (cp & 127) >> 5; src = tile * 256 + 64 * g + 32 * h; }
            else if (r0 < 6560) src = r0;
            else if (r0 < 6656) src = -1;
            else src = 6560 + (r0 - 6656);
            tr_item(a.in[5], 13728, src, (bf16_t*)(ws + WS_WIN), 2048, 0, r0, kb * 64, scr, lane); continue; } r -= I0;
        if (r < I1) { const int kb = r / 192, nb = r % 192; tr_item(a.in[5], 13728, 7584 + nb * 32, (bf16_t*)(ws + WS_WG), 2048, 0, nb * 32, kb * 64, scr, lane); continue; } r -= I1;
        if (r < I2) { const int kb = r / 64, nb = r % 64; tr_item(a.in[26], 2048, nb * 32, (bf16_t*)(ws + WS_WKV), 2048, 0, nb * 32, kb * 64, scr, lane); continue; } r -= I2;
        if (r < I3) { const int kb = r / 64, nb = r % 64; tr_item(a.in[29], 2048, nb * 32, (bf16_t*)(ws + WS_PAR), 2048, 0, nb * 32, kb * 64, scr, lane); continue; } r -= I3;
        if (r < I3) { const int kb = r / 64, nb = r % 64; tr_item(a.in[30], 2048, nb * 32, (bf16_t*)(ws + WS_PAR), 2048, 1024, nb * 32, kb * 64, scr, lane); continue; } r -= I3;
        if (r < I3) { const int kb = r / 64, nb = r % 64; tr_item(a.in[31], 2048, nb * 32, (bf16_t*)(ws + WS_PM2), 2048, 0, nb * 32, kb * 64, scr, lane); continue; } r -= I3;
        if (r < I6) { const int kb = r / 64, nb = r % 64; tr_item(a.in[32], 2048, nb * 32, (bf16_t*)(ws + WS_WO), 2048, 0, nb * 32, kb * 64, scr, lane); continue; } r -= I6;
        if (r < I7) { const int kb = r / 352, nb = r % 352, r0 = nb * 32, tile = r0 >> 8, bj = (r0 & 255) >> 7, j = r0 & 127;
            tr_item(a.in[34], 2 * DFF, bj * DFF + 128 * tile + j, (bf16_t*)(ws + WS_WUP), 2048, 0, r0, kb * 64, scr, lane); continue; } r -= I7;
        { const int kb = r / 64, nb = r % 64; tr_item(a.in[37], 2048, nb * 32, (bf16_t*)(ws + WS_WDN), DFF, 0, nb * 32, kb * 64, scr, lane); }
    }
    for (int m = gw; m < NT + 1280; m += NGW) {
        if (m < NT) { const float* xr = m < TP ? a.in[0] + (size_t)m * DM : a.in[1] + (size_t)(m - TP) * DM; rms_row(xr, a.in[4], (bf16_t*)(ws + WS_H) + (size_t)m * DM, lane); }
        else { const int j = m - NT; const float* xr = j < 256 ? a.in[2] + (size_t)j * DM : a.in[3] + (size_t)(j - 256) * DM; rms_row(xr, a.in[25], (bf16_t*)(ws + WS_MEMN) + (size_t)j * DM, lane); }
    }
    { float* rc = (float*)(ws + WS_ROPE); float* rs = rc + TP * 32;
      for (int e = (vcu * NTHR + tid); e < TP * 32; e += G * NTHR) { const int t = e >> 5, d = e & 31; double rev = (double)t * a.inv_rev[d]; rev -= rint(rev); const float rf = (float)rev;
          rc[e] = __builtin_amdgcn_cosf(rf); rs[e] = __builtin_amdgcn_sinf(rf); } }
    { bf16_t* g2t = (bf16_t*)(ws + WS_G2T); const float* G2 = a.in[19];
      for (int e = vcu * NTHR + tid; e < 1024 * 20; e += G * NTHR) { const int col = e / 20, kc = e - col * 20; float f[8];
#pragma unroll
          for (int i = 0; i < 8; ++i) f[i] = G2[(size_t)(kc * 8 + i) * 1024 + col];
          u32x4 w; w.x = cvt_pk_bf16(f[0], f[1]); w.y = cvt_pk_bf16(f[2], f[3]); w.z = cvt_pk_bf16(f[4], f[5]); w.w = cvt_pk_bf16(f[6], f[7]);
          *(u32x4*)(g2t + (size_t)col * 160 + kc * 8) = w; } }
    if (blockIdx.x == 0) {
        unsigned* ctl = (unsigned*)(ws + WS_CTL);
        if (tid < 64) {
            if (tid == 0) { ctl[CW_QUEUE] = 0u; ctl[256] = 0u; ctl[257] = 0u; }
            const float s1 = wave_sum(a.in[8][tid] * a.in[9][tid]), s2 = wave_sum(a.in[10][tid] * a.in[11][tid]);
            if (tid == 0) ((float*)ctl)[CW_LAM] = __expf(s1) - __expf(s2) + 0.2f;
            float gq = fabsf(a.in[6][tid]), gk = fabsf(a.in[7][tid]);
#pragma unroll
            for (int o = 1; o < 64; o <<= 1) { gq = fmaxf(gq, __shfl_xor(gq, o)); gk = fmaxf(gk, __shfl_xor(gk, o)); }
            if (tid == 0) ((float*)ctl)[CW_SMAX] = 64.f * 0.125f * 1.4426950408889634f * gq * gk;
        }
    }
}

struct SchedIn {
    int v, G; const char* H; const char* WIN; const char* MEMN; const char* WKV;
    __device__ __forceinline__ bool next(int i, Unit& u) const {
        long L = (long)i * G + v; int pm, pn;
        if (L < 5760) { TileMap{192, 30}.get(L, pm, pn); u.A = H + (size_t)pm * MiB; u.B = WIN + (size_t)pn * MiB; u.nt = 32; u.pm = pm; u.pn = pn; u.kind = 0; u.t0 = 0; u.T = 0; return true; }
        L -= 5760; if (L < 40) { pm = (int)(L % 5); pn = (int)(L / 5); u.A = MEMN + (size_t)pm * MiB; u.B = WKV + (size_t)pn * MiB; u.nt = 32; u.pm = pm; u.pn = pn; u.kind = 1; u.t0 = 0; u.T = 0; return true; }
        return false;
    }
};
struct EpiIn {
    bf16_t* QK; bf16_t* VM; bf16_t* ZR; bf16_t* KVM; const float* qn; const float* kn; const float* rc; const float* rs;
    __device__ __forceinline__ void plain(const f32x4 (&acc)[2][2][4][2], bf16_t* base, size_t ldc, int row0, int col0) const {
#pragma unroll
        for (int ai = 0; ai < 2; ++ai)
#pragma unroll
            for (int m = 0; m < 4; ++m) { bf16_t* rowp = base + (size_t)(row0 + ai * 128 + m * 16) * ldc + col0;
#pragma unroll
                for (int bj = 0; bj < 2; ++bj) { const f32x4 v0 = acc[ai][bj][m][0], v1 = acc[ai][bj][m][1];
                    u32x4 w; w.x = cvt_pk_bf16(v0[0], v0[1]); w.y = cvt_pk_bf16(v0[2], v0[3]); w.z = cvt_pk_bf16(v1[0], v1[1]); w.w = cvt_pk_bf16(v1[2], v1[3]);
                    *(u32x4*)(rowp + bj * 128) = w; } }
    }
    __device__ __forceinline__ void operator()(const f32x4 (&acc)[2][2][4][2], const Unit& u, int wr, int wc, int fr, int fq) const {
        const int row0 = u.pm * 256 + wr * 64 + fr, cin = wc * 32 + 8 * fq;
        if (u.kind == 1) { plain(acc, KVM, 2048, row0, u.pn * 256 + cin); return; }
        const int pn = u.pn;
        if (pn < 8) {
            const bool isq = pn < 4; const float* nw = isq ? qn : kn;
            const int Gq = (pn & 3) * 4 + wc, d0 = 8 * fq;
            const float qs = isq ? 0.125f * 1.4426950408889634f : 1.f;
            const f32x4 w1a = *(const f32x4*)(nw + d0), w1b = *(const f32x4*)(nw + d0 + 4), w2a = *(const f32x4*)(nw + 32 + d0), w2b = *(const f32x4*)(nw + 36 + d0);
            bf16_t* dst = QK + (isq ? 0 : 1024) + Gq * 64 + d0;
#pragma unroll
            for (int ai = 0; ai < 2; ++ai)
#pragma unroll
                for (int m = 0; m < 4; ++m) {
                    const int row = row0 + ai * 128 + m * 16, t = tok_pos(row);
                    const f32x4 xa = acc[ai][0][m][0], xb = acc[ai][0][m][1], ya = acc[ai][1][m][0], yb = acc[ai][1][m][1];
                    float ss = (xa[0] * xa[0] + xa[1] * xa[1]) + (xa[2] * xa[2] + xa[3] * xa[3]) + (xb[0] * xb[0] + xb[1] * xb[1]) + (xb[2] * xb[2] + xb[3] * xb[3])
                             + (ya[0] * ya[0] + ya[1] * ya[1]) + (ya[2] * ya[2] + ya[3] * ya[3]) + (yb[0] * yb[0] + yb[1] * yb[1]) + (yb[2] * yb[2] + yb[3] * yb[3]);
                    ss += __shfl_xor(ss, 16); ss += __shfl_xor(ss, 32);
                    const float rstd = rsqrtf(ss * (1.f / 64.f) + 1e-6f);
                    const f32x4 ca = *(const f32x4*)(rc + t * 32 + d0), cb = *(const f32x4*)(rc + t * 32 + d0 + 4), sa = *(const f32x4*)(rs + t * 32 + d0), sb = *(const f32x4*)(rs + t * 32 + d0 + 4);
                    const f32x4 x1a = xa * rstd * w1a, x1b = xb * rstd * w1b, x2a = ya * rstd * w2a, x2b = yb * rstd * w2b;
                    const f32x4 o1a = (x1a * ca - x2a * sa) * qs, o1b = (x1b * cb - x2b * sb) * qs, o2a = (x2a * ca + x1a * sa) * qs, o2b = (x2b * cb + x1b * sb) * qs;
                    u32x4 w; w.x = cvt_pk_bf16(o1a[0], o1a[1]); w.y = cvt_pk_bf16(o1a[2], o1a[3]); w.z = cvt_pk_bf16(o1b[0], o1b[1]); w.w = cvt_pk_bf16(o1b[2], o1b[3]);
                    *(u32x4*)(dst + (size_t)row * 2048) = w;
                    w.x = cvt_pk_bf16(o2a[0], o2a[1]); w.y = cvt_pk_bf16(o2a[2], o2a[3]); w.z = cvt_pk_bf16(o2b[0], o2b[1]); w.w = cvt_pk_bf16(o2b[2], o2b[3]);
                    *(u32x4*)(dst + (size_t)row * 2048 + 32) = w;
                }
        } else if (pn < 12) plain(acc, VM, 2048, row0, (pn - 8) * 256 + cin);
        else if (pn < 26) plain(acc, ZR, ZRP, row0, (pn - 12) * 256 + cin);
        else plain(acc, VM, 2048, row0, 1024 + (pn - 26) * 256 + cin);
    }
};

namespace att {
constexpr int SHM_V = 16384, SHM_K = 8192;
constexpr int OFF_K = 0, OFF_V = 24576, OFF_WS = 73728, OFF_STASH = 75776;
#define KSWZ64(row, colB) ((row) * 128 + ((colB) ^ (((row) & 7) << 4)))
#define SBAR() __builtin_amdgcn_sched_barrier(0)
__device__ __forceinline__ int crow(int r, int hi) { return (r & 3) + 8 * (r >> 2) + 4 * hi; }
constexpr float THRL = 8.f;
__device__ __forceinline__ void partialSM(f32x16& p0, f32x16& p1, float& m_reg, float& alpha) {
    float pmax = fmaxf(fmaxf(p0[0], p0[1]), p0[2]);
#pragma unroll
    for (int r = 3; r < 15; r += 2) pmax = fmaxf(fmaxf(pmax, p0[r]), p0[r + 1]);
    pmax = fmaxf(fmaxf(pmax, p0[15]), p1[0]);
#pragma unroll
    for (int r = 1; r < 15; r += 2) pmax = fmaxf(fmaxf(pmax, p1[r]), p1[r + 1]);
    pmax = fmaxf(pmax, p1[15]);
    { auto rr = __builtin_amdgcn_permlane32_swap(__float_as_uint(pmax), __float_as_uint(pmax), false, false);
      pmax = fmaxf(__uint_as_float(rr[0]), __uint_as_float(rr[1])); }
    if (__builtin_expect(__all(pmax <= THRL), 1)) { alpha = 1.f; }
    else { const float dl = fmaxf(pmax, 0.f); alpha = __builtin_amdgcn_exp2f(-dl); m_reg += dl;
#pragma unroll
        for (int r = 0; r < 16; ++r) { p0[r] -= dl; p1[r] -= dl; } }
#pragma unroll
    for (int r = 0; r < 16; ++r) p0[r] = __builtin_amdgcn_exp2f(p0[r]);
}
__device__ __forceinline__ void finishSM(f32x16& p0, f32x16& p1, float alpha, float& l_reg, bf16x8& pa0, bf16x8& pa1, bf16x8& pa2, bf16x8& pa3) {
#pragma unroll
    for (int r = 0; r < 16; ++r) p1[r] = __builtin_amdgcn_exp2f(p1[r]);
    f32x2 s2 = (f32x2){p0[0], p0[1]} + (f32x2){p1[0], p1[1]};
#pragma unroll
    for (int r = 2; r < 16; r += 2) { s2 = s2 + (f32x2){p0[r], p0[r + 1]}; s2 = s2 + (f32x2){p1[r], p1[r + 1]}; }
    float ps = s2[0] + s2[1];
    { auto rr = __builtin_amdgcn_permlane32_swap(__float_as_uint(ps), __float_as_uint(ps), false, false);
      ps = __uint_as_float(rr[0]) + __uint_as_float(rr[1]); }
    l_reg = l_reg * alpha + ps;
#define PK4(P, BASE, OUT) do { unsigned a0 = cvt_pk_bf16(P[BASE + 0], P[BASE + 1]), a1 = cvt_pk_bf16(P[BASE + 2], P[BASE + 3]);   \
    unsigned b0 = cvt_pk_bf16(P[BASE + 4], P[BASE + 5]), b1 = cvt_pk_bf16(P[BASE + 6], P[BASE + 7]);                              \
    auto r0 = __builtin_amdgcn_permlane32_swap(a0, b0, false, false); auto r1 = __builtin_amdgcn_permlane32_swap(a1, b1, false, false); \
    u32x4 w = {r0[0], r1[0], r0[1], r1[1]}; OUT = *reinterpret_cast<bf16x8*>(&w); } while (0)
    PK4(p0, 0, pa0); PK4(p0, 8, pa1); PK4(p1, 0, pa2); PK4(p1, 8, pa3);
#undef PK4
}
__device__ __forceinline__ void qkt64(f32x16& p0, f32x16& p1, const char* Ks, const bf16x8* qr, int r32, int hi) {
#pragma unroll
    for (int d0 = 0; d0 < 4; ++d0) { const int cb = (d0 * 16 + hi * 8) * 2;
        const bf16x8 b0 = *reinterpret_cast<const bf16x8*>(Ks + KSWZ64(r32, cb));
        const bf16x8 b1 = *reinterpret_cast<const bf16x8*>(Ks + KSWZ64(32 + r32, cb));
        p0 = __builtin_amdgcn_mfma_f32_32x32x16_bf16(b0, qr[d0], p0, 0, 0, 0);
        p1 = __builtin_amdgcn_mfma_f32_32x32x16_bf16(b1, qr[d0], p1, 0, 0, 0); }
}
__device__ __forceinline__ int v_st(int k, int c) { const int kk = (k & ~0xC) | ((k & 4) << 1) | ((k & 8) >> 1); return ((kk >> 3) * 4 + (c >> 5)) * 512 + ((kk & 7) * 32 + (c & 31)) * 2; }
__device__ __forceinline__ int v_rd_base(int lane) { return ((lane & 3) << 3) | (((lane >> 2) & 3) << 6) | (((lane >> 4) & 1) << 5) | (((lane >> 5) & 1) << 8); }
constexpr int v_rd_off(int d0, int ks, int half) { return d0 * 512 + ks * 4096 + half * 2048; }
template <int OFF> __device__ __forceinline__ s16x4 tr_read(int vb) {
    s16x4 r; asm volatile("ds_read_b64_tr_b16 %0, %1 offset:%2" : "=&v"(r) : "v"(vb), "i"(OFF) : "memory"); return r;
}
struct VFrag { s16x4 l0, h0, l1, h1, l2, h2, l3, h3; };
template <int KS> __device__ __forceinline__ void pv_read(VFrag& f, int vb) {
    f.l0 = tr_read<v_rd_off(0, KS, 0)>(vb); f.h0 = tr_read<v_rd_off(0, KS, 1)>(vb); f.l1 = tr_read<v_rd_off(1, KS, 0)>(vb); f.h1 = tr_read<v_rd_off(1, KS, 1)>(vb);
    f.l2 = tr_read<v_rd_off(2, KS, 0)>(vb); f.h2 = tr_read<v_rd_off(2, KS, 1)>(vb); f.l3 = tr_read<v_rd_off(3, KS, 0)>(vb); f.h3 = tr_read<v_rd_off(3, KS, 1)>(vb);
}
__device__ __forceinline__ void pv_mma(f32x16* o, const VFrag& f, bf16x8 pa) {
#define PK(L, H) (bf16x8){L[0], L[1], L[2], L[3], H[0], H[1], H[2], H[3]}
    o[0] = __builtin_amdgcn_mfma_f32_32x32x16_bf16(pa, PK(f.l0, f.h0), o[0], 0, 0, 0);
    o[1] = __builtin_amdgcn_mfma_f32_32x32x16_bf16(pa, PK(f.l1, f.h1), o[1], 0, 0, 0);
    o[2] = __builtin_amdgcn_mfma_f32_32x32x16_bf16(pa, PK(f.l2, f.h2), o[2], 0, 0, 0);
    o[3] = __builtin_amdgcn_mfma_f32_32x32x16_bf16(pa, PK(f.l3, f.h3), o[3], 0, 0, 0);
#undef PK
}
__device__ __forceinline__ void pv_d0(f32x16* o, int vb, bf16x8 pa0, bf16x8 pa1, bf16x8 pa2, bf16x8 pa3) {
    VFrag fa, fb;
    pv_read<0>(fa, vb);
    pv_read<1>(fb, vb); asm volatile("s_waitcnt lgkmcnt(8)" ::: "memory"); SBAR(); pv_mma(o, fa, pa0); SBAR();
    pv_read<2>(fa, vb); asm volatile("s_waitcnt lgkmcnt(8)" ::: "memory"); SBAR(); pv_mma(o, fb, pa1); SBAR();
    pv_read<3>(fb, vb); asm volatile("s_waitcnt lgkmcnt(8)" ::: "memory"); SBAR(); pv_mma(o, fa, pa2); SBAR();
    asm volatile("s_waitcnt lgkmcnt(0)" ::: "memory"); SBAR(); pv_mma(o, fb, pa3);
}

__device__ __forceinline__ void stash_store(const unsigned* stash, bf16_t* Ow, int ldo, int lane) {
#pragma unroll
    for (int i = 0; i < 8; ++i) { const int q = i * 64 + lane, rl = q >> 4, c8 = (q & 15) * 8, hh = (rl >> 2) & 1, r = (rl & 3) + 4 * (rl >> 3), d0 = c8 >> 5, cc = c8 & 31;
        const unsigned* sp = stash + (d0 * 8 + (r >> 1)) * 64 + hh * 32 + cc; const u32x4 a = *(const u32x4*)sp, b = *(const u32x4*)(sp + 4);
        u32x4 w;
        if (r & 1) { w.x = (a.x >> 16) | (a.y & 0xffff0000u); w.y = (a.z >> 16) | (a.w & 0xffff0000u); w.z = (b.x >> 16) | (b.y & 0xffff0000u); w.w = (b.z >> 16) | (b.w & 0xffff0000u); }
        else { w.x = (a.x & 0xffffu) | (a.y << 16); w.y = (a.z & 0xffffu) | (a.w << 16); w.z = (b.x & 0xffffu) | (b.y << 16); w.w = (b.z & 0xffffu) | (b.w << 16); }
        *(u32x4*)(Ow + (size_t)rl * ldo + c8) = w; }
}

template <bool FX> __device__ __forceinline__ void diff_unit(int s, int h, int qb, bf16_t* QK, const bf16_t* VM, float lam, char* lds, LAS unsigned char* ldsl) {
    constexpr int LDK = 2048;
    int tid = threadIdx.x; asm volatile("" : "+v"(tid));
    const int wid = __builtin_amdgcn_readfirstlane(tid >> 6), lane = tid & 63, r32 = lane & 31, hi = lane >> 5;
    const int tok0 = seq_start(s), T = seq_len(s), NTL = T / 64;
    char* V_lds = lds + OFF_V; char* K_lds = lds + OFF_K;
    float* wsf = (float*)(lds + OFF_WS) + wid * 64; float* li_l = wsf; float* al_l = wsf + 32;
    unsigned* stash = (unsigned*)(lds + OFF_STASH) + wid * 2048;
    const int vb0 = (int)(uintptr_t)V_lds + v_rd_base(lane);
    const bf16_t* Vh = VM + (size_t)tok0 * LDK + h * 128;
    const size_t qrow = (size_t)(tok0 + qb * 256 + wid * 32);
    const unsigned ksrc = (unsigned)((wid * 8 + (lane >> 3)) * LDK + (((lane & 7) ^ (lane >> 3)) << 3)) * 2u;
    unsigned vsrc[2];
#pragma unroll
    for (int i = 0; i < 2; ++i) { const int st = 2 * (2 * wid + i) + (lane >> 5), kk = (st >> 2) * 8 + ((lane & 31) >> 2), k = (kk & ~0xC) | ((kk & 4) << 1) | ((kk & 8) >> 1), cc = (st & 3) * 32 + (lane & 3) * 8;
        vsrc[i] = (unsigned)(k * LDK + cc) * 2u; }
#pragma unroll 1
    for (int c = 0; c < 2; ++c) {
        const bf16_t* Kh = QK + (size_t)tok0 * LDK + 1024 + h * 128 + c * 64;
        const bf16_t* Qw = QK + (qrow + r32) * LDK + h * 128 + c * 64 + hi * 8;
        bf16x8 qr[4];
#pragma unroll
        for (int d0 = 0; d0 < 4; ++d0) qr[d0] = *reinterpret_cast<const bf16x8*>(Qw + d0 * 16);
        float m_reg = 0.f, l_reg = 0; f32x16 o[4] = {};
#define NEGM(P) do { const float nm_ = FX ? 0.f : -m_reg; _Pragma("unroll") for (int r_ = 0; r_ < 16; ++r_) P[r_] = nm_; } while (0)
#define PSM(P0, P1, AL) do { if constexpr (FX) { AL = 1.f; _Pragma("unroll") for (int r_ = 0; r_ < 16; ++r_) P0[r_] = __builtin_amdgcn_exp2f(P0[r_]); } else partialSM(P0, P1, m_reg, AL); } while (0)
#define DMA_K(t, slotB) __builtin_amdgcn_global_load_lds((const unsigned*)((const char*)(Kh + (size_t)(t) * 64 * LDK) + ksrc), (LAS unsigned*)(ldsl + OFF_K + (slotB) * SHM_K + wid * 1024), 16, 0, 0)
#define DMA_V(t, slotB) do { __builtin_amdgcn_global_load_lds((const unsigned*)((const char*)(Vh + (size_t)(t) * 64 * LDK) + vsrc[0]), (LAS unsigned*)(ldsl + OFF_V + (slotB) * SHM_V + (2 * wid) * 1024), 16, 0, 0); \
    __builtin_amdgcn_global_load_lds((const unsigned*)((const char*)(Vh + (size_t)(t) * 64 * LDK) + vsrc[1]), (LAS unsigned*)(ldsl + OFF_V + (slotB) * SHM_V + (2 * wid + 1) * 1024), 16, 0, 0); } while (0)
#define WAITB(n) asm volatile("s_waitcnt vmcnt(" #n ") lgkmcnt(0)\n\ts_barrier" ::: "memory")
#define RESC(a) do { if (!FX && __any((a) < 1.f)) { if (hi == 0) al_l[r32] = (a); asm volatile("s_waitcnt lgkmcnt(0)" ::: "memory"); \
    _Pragma("unroll") for (int d = 0; d < 4; ++d) _Pragma("unroll") for (int r = 0; r < 16; ++r) o[d][r] *= al_l[crow(r, hi)]; } } while (0)
#define SEG(X0, X1, ALX, Y0, Y1, ALY, sg) do { \
        SBAR(); NEGM(X0); NEGM(X1); qkt64(X0, X1, K_lds + sl_c * SHM_K, qr, r32, hi); \
        finishSM(Y0, Y1, ALY, l_reg, pa0, pa1, pa2, pa3); SBAR(); \
        if ((sg) + 2 < NTL) DMA_K((sg) + 2, sl_p); if ((sg) + 1 < NTL) DMA_V((sg) + 1, sl_n); SBAR(); \
        pv_d0(o, vb0 + sl_p * SHM_V, pa0, pa1, pa2, pa3); PSM(X0, X1, ALX); \
        RESC(ALX); \
        if ((sg) + 2 < NTL) WAITB(3); else if ((sg) + 1 < NTL) WAITB(2); else WAITB(0); \
        { const int t_ = sl_p; sl_p = sl_c; sl_c = sl_n; sl_n = t_; } } while (0)
        f32x16 pA0, pA1, pB0, pB1; float alA, alB; bf16x8 pa0, pa1, pa2, pa3;
        int sl_p = 2, sl_c = 0, sl_n = 1;
        DMA_K(0, 0); DMA_V(0, 0); DMA_K(1, 1);
        WAITB(1);
        DMA_K(2, 2); DMA_V(1, 1);
        NEGM(pA0); NEGM(pA1); qkt64(pA0, pA1, K_lds, qr, r32, hi); PSM(pA0, pA1, alA);
        WAITB(3);
        { sl_p = 0; sl_c = 1; sl_n = 2; }
        for (int j = 1; j + 1 < NTL; j += 2) {
            SEG(pB0, pB1, alB, pA0, pA1, alA, j);
            SEG(pA0, pA1, alA, pB0, pB1, alB, j + 1);
        }
        SEG(pB0, pB1, alB, pA0, pA1, alA, NTL - 1);
        finishSM(pB0, pB1, alB, l_reg, pa0, pa1, pa2, pa3); SBAR();
        pv_d0(o, vb0 + sl_p * SHM_V, pa0, pa1, pa2, pa3);
#undef SEG
#undef DMA_K
#undef DMA_V
#undef WAITB
#undef RESC
#undef NEGM
#undef PSM
        if (hi == 0) li_l[r32] = l_reg; asm volatile("s_waitcnt lgkmcnt(0)" ::: "memory");
        float rli[16];
#pragma unroll
        for (int r = 0; r < 16; ++r) rli[r] = __builtin_amdgcn_rcpf(li_l[crow(r, hi)]);
        { const float coef = c == 0 ? 1.f : -lam;
#pragma unroll
          for (int d0 = 0; d0 < 4; ++d0)
#pragma unroll
              for (int r = 0; r < 16; r += 2) { const int idx = (d0 * 8 + (r >> 1)) * 64 + lane; const unsigned w = c == 0 ? 0u : stash[idx];
                  stash[idx] = cvt_pk_bf16(bflo(w) + coef * o[d0][r] * rli[r], bfhi(w) + coef * o[d0][r + 1] * rli[r + 1]); } }
        __syncthreads();
    }
    stash_store(stash, QK + qrow * LDK + h * 128, LDK, lane);
    __syncthreads();
}

constexpr int MOFF_V = 0, MOFF_K = 32768, MOFF_WS = 65536, MOFF_RK = 67584, MOFF_G = 68608, MOFF_STASH = 69632;
__device__ __forceinline__ void mem_unit(int s, int mh, int qb, bf16_t* VM, const bf16_t* KVM, const float* mqn, const float* mkn, char* lds) {
    int tid = threadIdx.x; asm volatile("" : "+v"(tid));
    const int wid = __builtin_amdgcn_readfirstlane(tid >> 6), lane = tid & 63, r32 = lane & 31, hi = lane >> 5;
    const int tok0 = seq_start(s);
    char* V_lds = lds + MOFF_V; char* K_lds = lds + MOFF_K;
    float* wsf = (float*)(lds + MOFF_WS) + wid * 64; float* li_l = wsf; float* al_l = wsf + 32;
    float* rk_l = (float*)(lds + MOFF_RK); float* g_l = (float*)(lds + MOFF_G);
    const bf16_t* Kh = KVM + (size_t)(s * 256) * 2048 + mh * 256;
    const bf16_t* Vh = KVM + (size_t)(s * 256) * 2048 + 1024 + mh * 256;
    if (tid < 256) g_l[tid] = mqn[tid] * mkn[tid];
    {
        const bf16_t* kp = Kh + (size_t)(wid * 32 + r32) * 2048 + hi * 128; float ss = 0.f;
#pragma unroll
        for (int i = 0; i < 16; ++i) { const u32x4 w = *(const u32x4*)(kp + i * 8);
            ss += bflo(w.x) * bflo(w.x) + bfhi(w.x) * bfhi(w.x) + bflo(w.y) * bflo(w.y) + bfhi(w.y) * bfhi(w.y) + bflo(w.z) * bflo(w.z) + bfhi(w.z) * bfhi(w.z) + bflo(w.w) * bflo(w.w) + bfhi(w.w) * bfhi(w.w); }
        ss += __shfl_xor(ss, 32);
        if (hi == 0) rk_l[wid * 32 + r32] = rsqrtf(ss * (1.f / 256.f) + 1e-6f);
    }
    const size_t qrow = (size_t)(tok0 + qb * 256 + wid * 32);
    bf16_t* Qw = VM + (qrow + r32) * 2048 + 1024 + mh * 256 + hi * 8;
    float rqC;
    { float ss = 0.f;
#pragma unroll
      for (int i = 0; i < 16; ++i) { const u32x4 w = *(const u32x4*)(Qw + i * 16);
          ss += bflo(w.x) * bflo(w.x) + bfhi(w.x) * bfhi(w.x) + bflo(w.y) * bflo(w.y) + bfhi(w.y) * bfhi(w.y) + bflo(w.z) * bflo(w.z) + bfhi(w.z) * bfhi(w.z) + bflo(w.w) * bflo(w.w) + bfhi(w.w) * bfhi(w.w); }
      ss += __shfl_xor(ss, 32);
      rqC = rsqrtf(ss * (1.f / 256.f) + 1e-6f) * (0.0625f * 1.4426950408889634f); }
    const int sr = tid >> 4, sc = (tid & 15) * 8, vst0 = v_st(sr, sc), vst1 = v_st(32 + sr, sc);
    const int kr = tid >> 3, kc = (tid & 7) * 8, kst = KSWZ64(kr, kc * 2);
    const int vb0 = (int)(uintptr_t)V_lds + v_rd_base(lane);
    unsigned* stash = (unsigned*)(lds + MOFF_STASH) + wid * 2048;
    __syncthreads();
#pragma unroll 1
    for (int hv = 0; hv < 2; ++hv) {
    float m_reg = -1e30f, l_reg = 0.f; f32x16 o[4] = {};
#pragma unroll 1
    for (int t = 0; t < 4; ++t) {
        const int k0 = t * 64;
#pragma unroll
        for (int ds = 0; ds < 4; ++ds) { const u32x4 w = *(const u32x4*)(Kh + (size_t)(k0 + kr) * 2048 + ds * 64 + kc); const float* g = g_l + ds * 64 + kc;
            u32x4 o4; o4.x = cvt_pk_bf16(bflo(w.x) * g[0], bfhi(w.x) * g[1]); o4.y = cvt_pk_bf16(bflo(w.y) * g[2], bfhi(w.y) * g[3]);
            o4.z = cvt_pk_bf16(bflo(w.z) * g[4], bfhi(w.z) * g[5]); o4.w = cvt_pk_bf16(bflo(w.w) * g[6], bfhi(w.w) * g[7]);
            *(u32x4*)(K_lds + ds * 8192 + kst) = o4; asm volatile("" ::: "memory"); }
        *(u32x4*)(V_lds + vst0) = *(const u32x4*)(Vh + (size_t)(k0 + sr) * 2048 + hv * 128 + sc);
        *(u32x4*)(V_lds + vst1) = *(const u32x4*)(Vh + (size_t)(k0 + 32 + sr) * 2048 + hv * 128 + sc);
        __syncthreads();
        f32x16 p0 = {}, p1 = {};
#pragma unroll
        for (int ds = 0; ds < 4; ++ds) { bf16x8 qr[4];
#pragma unroll
            for (int d0 = 0; d0 < 4; ++d0) qr[d0] = *reinterpret_cast<const bf16x8*>(Qw + ds * 64 + d0 * 16);
            qkt64(p0, p1, K_lds + ds * 8192, qr, r32, hi); }
#pragma unroll
        for (int r = 0; r < 16; ++r) { p0[r] *= rk_l[k0 + crow(r, hi)] * rqC; p1[r] *= rk_l[k0 + 32 + crow(r, hi)] * rqC; }
        float pmax = p0[0];
#pragma unroll
        for (int r = 1; r < 16; ++r) pmax = fmaxf(pmax, p0[r]);
#pragma unroll
        for (int r = 0; r < 16; ++r) pmax = fmaxf(pmax, p1[r]);
        pmax = fmaxf(pmax, __shfl_xor(pmax, 32));
        const float mn = fmaxf(m_reg, pmax), alpha = __builtin_amdgcn_exp2f(m_reg - mn); m_reg = mn;
        float ps = 0.f;
#pragma unroll
        for (int r = 0; r < 16; ++r) { p0[r] = __builtin_amdgcn_exp2f(p0[r] - mn); p1[r] = __builtin_amdgcn_exp2f(p1[r] - mn); ps += p0[r] + p1[r]; }
        ps += __shfl_xor(ps, 32);
        l_reg = l_reg * alpha + ps;
        if (hi == 0) al_l[r32] = alpha; asm volatile("s_waitcnt lgkmcnt(0)" ::: "memory");
#pragma unroll
        for (int d = 0; d < 4; ++d)
#pragma unroll
            for (int r = 0; r < 16; ++r) o[d][r] *= al_l[crow(r, hi)];
        bf16x8 pa0, pa1, pa2, pa3;
#define PK4(P, BASE, OUT) do { unsigned a0 = cvt_pk_bf16(P[BASE + 0], P[BASE + 1]), a1 = cvt_pk_bf16(P[BASE + 2], P[BASE + 3]);   \
    unsigned b0 = cvt_pk_bf16(P[BASE + 4], P[BASE + 5]), b1 = cvt_pk_bf16(P[BASE + 6], P[BASE + 7]);                              \
    auto r0 = __builtin_amdgcn_permlane32_swap(a0, b0, false, false); auto r1 = __builtin_amdgcn_permlane32_swap(a1, b1, false, false); \
    u32x4 w = {r0[0], r1[0], r0[1], r1[1]}; OUT = *reinterpret_cast<bf16x8*>(&w); } while (0)
        PK4(p0, 0, pa0); PK4(p0, 8, pa1); PK4(p1, 0, pa2); PK4(p1, 8, pa3);
#undef PK4
        pv_d0(o, vb0, pa0, pa1, pa2, pa3);
        __syncthreads();
    }
    if (hi == 0) li_l[r32] = l_reg; asm volatile("s_waitcnt lgkmcnt(0)" ::: "memory");
    if (hv == 1) stash_store(stash, VM + qrow * 2048 + 1024 + mh * 256, 2048, lane);
#pragma unroll
    for (int d0 = 0; d0 < 4; ++d0)
#pragma unroll
        for (int r = 0; r < 16; r += 2) stash[(d0 * 8 + (r >> 1)) * 64 + lane] = cvt_pk_bf16(o[d0][r] * __builtin_amdgcn_rcpf(li_l[crow(r, hi)]), o[d0][r + 1] * __builtin_amdgcn_rcpf(li_l[crow(r + 1, hi)]));
    }
    stash_store(stash, VM + qrow * 2048 + 1024 + mh * 256 + 128, 2048, lane);
    __syncthreads();
}
#undef SBAR
}

namespace scan {
constexpr int TC = 32;
typedef _Float16 h2 __attribute__((ext_vector_type(2)));
typedef _Float16 h4 __attribute__((ext_vector_type(4)));
typedef _Float16 h8 __attribute__((ext_vector_type(8)));
constexpr int BUFB = 36864, O_R = 0, O_KD = 4096, O_KK = 8192, O_W = 12288, O_KA = 16384, O_V = 20480, O_Y = 28672;
constexpr int O_PRIV = 73728;
constexpr int O_TBL = 73728 + 32768;
__device__ __forceinline__ float dpp_red8(float x) {
    x += __uint_as_float(__builtin_amdgcn_update_dpp(0u, __float_as_uint(x), 0xB1, 0xf, 0xf, false));
    x += __uint_as_float(__builtin_amdgcn_update_dpp(0u, __float_as_uint(x), 0x4E, 0xf, 0xf, false));
    x += __uint_as_float(__builtin_amdgcn_update_dpp(0u, __float_as_uint(x), 0x141, 0xf, 0xf, false));
    return x;
}
template <int DIR> __device__ __forceinline__ void scan_chunk(const char* B_, h2 (&S)[2][4], int seg, int row0) {
    const char* base = B_ + seg * 16; const char* vbase = B_ + O_V + row0 * 4; char* ybase = (char*)B_ + O_Y + row0 * 4;
    u32x4 ck[2], cw[2], ca[2], cd[2], cr[2]; u32x2 cv[2];
#define LDSET(set, tl_) do { ck[set] = *(const u32x4*)(base + O_KK + (tl_) * 128); cw[set] = *(const u32x4*)(base + O_W + (tl_) * 128); ca[set] = *(const u32x4*)(base + O_KA + (tl_) * 128); \
    cd[set] = *(const u32x4*)(base + O_KD + (tl_) * 128); cr[set] = *(const u32x4*)(base + O_R + (tl_) * 128); cv[set] = *(const u32x2*)(vbase + (tl_) * 256); } while (0)
#define H2(u) __builtin_bit_cast(h2, (u))
    LDSET(0, DIR ? TC - 1 : 0);
#pragma unroll
    for (int st = 0; st < TC; ++st) {
        const int tl = DIR ? TC - 1 - st : st, cs = st & 1;
        if (st + 1 < TC) LDSET(cs ^ 1, DIR ? TC - 2 - st : st + 1);
#define SPLIT4(V, A0, A1, A2, A3) const h8 V##8 = __builtin_bit_cast(h8, V[cs]); const h2 A0 = __builtin_shufflevector(V##8, V##8, 0, 1), A1 = __builtin_shufflevector(V##8, V##8, 2, 3), \
    A2 = __builtin_shufflevector(V##8, V##8, 4, 5), A3 = __builtin_shufflevector(V##8, V##8, 6, 7)
        SPLIT4(ck, k0, k1, k2, k3); SPLIT4(cw, w0, w1, w2, w3); SPLIT4(ca, a0, a1, a2, a3); SPLIT4(cd, d0, d1, d2, d3); SPLIT4(cr, r0, r1, r2, r3);
#undef SPLIT4
        const h4 cv4 = __builtin_bit_cast(h4, cv[cs]);
        f32x2 yo;
#pragma unroll
        for (int h = 0; h < 2; ++h) {
            const h2 vv = h == 0 ? __builtin_shufflevector(cv4, cv4, 0, 1) : __builtin_shufflevector(cv4, cv4, 2, 3);
            float d = __builtin_amdgcn_fdot2(S[h][0], k0, 0.f, false); float e = __builtin_amdgcn_fdot2(S[h][2], k2, 0.f, false);
            d = __builtin_amdgcn_fdot2(S[h][1], k1, d, false); e = __builtin_amdgcn_fdot2(S[h][3], k3, e, false);
            d = dpp_red8(d + e);
            const h2 p0 = S[h][0] * w0 + vv * d0, p1 = S[h][1] * w1 + vv * d1, p2 = S[h][2] * w2 + vv * d2, p3 = S[h][3] * w3 + vv * d3;
            const _Float16 sh = (_Float16)(-d); const h2 sa = {sh, sh};
            S[h][0] = p0 + sa * a0; S[h][1] = p1 + sa * a1; S[h][2] = p2 + sa * a2; S[h][3] = p3 + sa * a3;
            float y = __builtin_amdgcn_fdot2(S[h][0], r0, 0.f, false); float z = __builtin_amdgcn_fdot2(S[h][2], r2, 0.f, false);
            y = __builtin_amdgcn_fdot2(S[h][1], r1, y, false); z = __builtin_amdgcn_fdot2(S[h][3], r3, z, false);
            yo[h] = dpp_red8(y + z);
        }
        if (seg == 0) *(f32x2*)(ybase + tl * 256) = yo;
    }
#undef LDSET
#undef H2
}
__device__ __forceinline__ unsigned pkh(float a, float b) { const h2 v = {(_Float16)a, (_Float16)b}; return __builtin_bit_cast(unsigned, v); }
struct P {
    const bf16_t* ZR; bf16_t* YB; float* BON;
    const float *mup, *mun, *w0, *w2, *a0, *a2, *kk_w, *ka_w, *rk_w;
};
__device__ __forceinline__ void job(int s, int dir, int head, const P& p, char* lds) {
    int tid = threadIdx.x; asm volatile("" : "+v"(tid));
    const int wid = __builtin_amdgcn_readfirstlane(tid >> 6), lane = tid & 63;
    const int tok0 = seq_start(s), T = seq_len(s), NCH = T / TC;
    float* TBL = (float*)(lds + O_TBL);
    float* MUP = TBL; float* MUN = TBL + 320; float* KKW = TBL + 640; float* KAW = TBL + 704; float* RKW = TBL + 768; float* BW = TBL + 832; float* BA = TBL + 896;
    __syncthreads();
    if (tid < 320) { const int which = tid >> 6, j = tid & 63; const int col = which < 3 ? which * 1024 + head * 64 + j : (which == 3 ? 3072 : 3200) + dir * 64 + j; MUP[tid] = p.mup[col]; MUN[tid] = p.mun[col]; }
    if (tid >= 320 && tid < 384) { const int j = tid - 320; KKW[j] = p.kk_w[head * 64 + j]; KAW[j] = p.ka_w[head * 64 + j]; RKW[j] = p.rk_w[head * 64 + j];
        BW[j] = p.w0[dir * 1024 + head * 64 + j]; BA[j] = p.a0[dir * 1024 + head * 64 + j]; }
    bf16_t* yb = p.YB + (size_t)dir * NT * 1024; float* bon = p.BON + (size_t)dir * NT * 16;
    if (wid >= 4) {
        const int pw = wid - 4;
        char* priv = lds + O_PRIV + pw * 8192;
        bf16_t* AWl = (bf16_t*)priv; bf16_t* AAl = AWl + 512; float* PK = (float*)(priv + 2048); float* PA = (float*)(priv + 4096); float* PR = (float*)(priv + 6144);
        bf16x8 Bf[2][4][2];
#pragma unroll
        for (int mat = 0; mat < 2; ++mat)
#pragma unroll
            for (int cbk = 0; cbk < 4; ++cbk)
#pragma unroll
                for (int ks = 0; ks < 2; ++ks) { const float* W2 = (mat == 0 ? p.w2 : p.a2) + (size_t)dir * 64 * 1024 + head * 64 + cbk * 16 + (lane & 15) + (size_t)(ks * 32 + (lane >> 4) * 8) * 1024;
                    float f[8];
#pragma unroll
                    for (int e = 0; e < 8; ++e) f[e] = W2[(size_t)e * 1024];
                    u32x4 w; w.x = cvt_pk_bf16(f[0], f[1]); w.y = cvt_pk_bf16(f[2], f[3]); w.z = cvt_pk_bf16(f[4], f[5]); w.w = cvt_pk_bf16(f[6], f[7]); Bf[mat][cbk][ks] = *reinterpret_cast<bf16x8*>(&w); }
        __syncthreads();
        const int pt = tid - 256;
        u32x4 zc[5], zm[5], zn[5];
#define PLOAD(cc) do { const int tf_ = dir ? T - TC * ((cc) + 1) : TC * (cc); \
    _Pragma("unroll") for (int k = 0; k < 5; ++k) { const int which = k, tl8 = lane >> 3, j0 = (lane & 7) * 8; \
        const int col = which < 3 ? which * 1024 + head * 64 + j0 : (which == 3 ? 3072 : 3200) + dir * 64 + j0; \
        const int t = tf_ + 8 * pw + tl8; const bf16_t* zp = p.ZR + (size_t)(tok0 + t) * ZRP + col; \
        zc[k] = *(const u32x4*)zp; zm[k] = (u32x4){0u, 0u, 0u, 0u}; zn[k] = (u32x4){0u, 0u, 0u, 0u}; \
        if (t > 0) zm[k] = *(const u32x4*)(zp - ZRP); \
        if (t < T - 1) zn[k] = *(const u32x4*)(zp + ZRP); } } while (0)
        PLOAD(0);
        for (int c = -1; c < NCH; ++c) {
            if (c >= 1) { const int cb_ = (c - 1) & 1, tf = dir ? T - TC * c : TC * (c - 1); const int tl = pt >> 3, c8 = (pt & 7) * 8;
                const float* yp = (const float*)(lds + cb_ * BUFB + O_Y) + tl * 64 + c8; const f32x4 y4 = *(const f32x4*)yp, y5 = *(const f32x4*)(yp + 4);
                u32x4 w; w.x = cvt_pk_bf16(y4[0], y4[1]); w.y = cvt_pk_bf16(y4[2], y4[3]); w.z = cvt_pk_bf16(y5[0], y5[1]); w.w = cvt_pk_bf16(y5[2], y5[3]);
                *(u32x4*)(yb + (size_t)(tok0 + tf + tl) * 1024 + head * 64 + c8) = w; }
            if (c + 1 < NCH) {
                const int nb = (c + 1) & 1, tfirst = dir ? T - TC * (c + 2) : TC * (c + 1);
                char* B_ = lds + nb * BUFB;
#pragma unroll
                for (int k = 0; k < 5; ++k) { const int which = k, tl8 = lane >> 3, j0 = (lane & 7) * 8, tl = 8 * pw + tl8;
                    const f32x4 mpa = *(const f32x4*)(MUP + which * 64 + j0), mpb = *(const f32x4*)(MUP + which * 64 + j0 + 4), mna = *(const f32x4*)(MUN + which * 64 + j0), mnb = *(const f32x4*)(MUN + which * 64 + j0 + 4);
                    const u32x4 z = zc[k], zmm = zm[k], znn = zn[k];
                    float v[8];
#define SH(i, zw, zmw, znw, lohi, mp_, mn_) { const float zz = lohi(zw), a_ = lohi(zmw), b_ = lohi(znw); v[i] = zz + mp_ * (a_ - zz) + mn_ * (b_ - zz); }
                    SH(0, z.x, zmm.x, znn.x, bflo, mpa[0], mna[0]) SH(1, z.x, zmm.x, znn.x, bfhi, mpa[1], mna[1]) SH(2, z.y, zmm.y, znn.y, bflo, mpa[2], mna[2]) SH(3, z.y, zmm.y, znn.y, bfhi, mpa[3], mna[3])
                    SH(4, z.z, zmm.z, znn.z, bflo, mpb[0], mnb[0]) SH(5, z.z, zmm.z, znn.z, bfhi, mpb[1], mnb[1]) SH(6, z.w, zmm.w, znn.w, bflo, mpb[2], mnb[2]) SH(7, z.w, zmm.w, znn.w, bfhi, mpb[3], mnb[3])
#undef SH
                    if (which < 2) { float* dst = (which == 0 ? PR : PK) + tl8 * 64 + j0;
                        *(f32x4*)dst = (f32x4){v[0], v[1], v[2], v[3]}; *(f32x4*)(dst + 4) = (f32x4){v[4], v[5], v[6], v[7]}; }
                    else if (which == 2) { unsigned* dst = (unsigned*)(B_ + O_V) + tl * 64 + j0;
                        *(u32x4*)dst = (u32x4){pkh(v[0], v[0]), pkh(v[1], v[1]), pkh(v[2], v[2]), pkh(v[3], v[3])}; *(u32x4*)(dst + 4) = (u32x4){pkh(v[4], v[4]), pkh(v[5], v[5]), pkh(v[6], v[6]), pkh(v[7], v[7])}; }
                    else { if (which == 3) {
#pragma unroll
                            for (int i = 0; i < 8; ++i) { const float e2 = __expf(2.f * v[i]); v[i] = 1.f - 2.f * __builtin_amdgcn_rcpf(e2 + 1.f); } }
                        u32x4 w; w.x = cvt_pk_bf16(v[0], v[1]); w.y = cvt_pk_bf16(v[2], v[3]); w.z = cvt_pk_bf16(v[4], v[5]); w.w = cvt_pk_bf16(v[6], v[7]);
                        *(u32x4*)((which == 3 ? AWl : AAl) + tl8 * 64 + j0) = w; }
                }
                if (c + 2 < NCH) PLOAD(c + 2);
                { const int tj = lane & 7, kq = lane >> 4;
#pragma unroll
                  for (int mat = 0; mat < 2; ++mat) { const bf16_t* Am = (mat == 0 ? AWl : AAl) + tj * 64 + kq * 8;
                      const bf16x8 y0 = *reinterpret_cast<const bf16x8*>(Am), y1 = *reinterpret_cast<const bf16x8*>(Am + 32);
#pragma unroll
                      for (int cbk = 0; cbk < 4; ++cbk) { f32x4 acc = {0.f, 0.f, 0.f, 0.f};
                          acc = __builtin_amdgcn_mfma_f32_16x16x32_bf16(Bf[mat][cbk][0], y0, acc, 0, 0, 0);
                          acc = __builtin_amdgcn_mfma_f32_16x16x32_bf16(Bf[mat][cbk][1], y1, acc, 0, 0, 0);
                          const int col = cbk * 16 + 4 * kq; const f32x4 bias = *(const f32x4*)((mat == 0 ? BW : BA) + col); f32x4 res;
#pragma unroll
                          for (int r = 0; r < 4; ++r) { const float u = acc[r] + bias[r];
                              const float sg = __builtin_amdgcn_rcpf(1.f + __expf(-u));
                              res[r] = mat == 0 ? __expf(-0.60653065971263342f * sg) : sg; }
                          if ((lane & 15) < 8) { if (mat == 0) *(u32x2*)((_Float16*)(B_ + O_W) + (8 * pw + tj) * 64 + col) = (u32x2){pkh(res[0], res[1]), pkh(res[2], res[3])};
                                                 else *(f32x4*)(PA + tj * 64 + col) = res; } } } }
                { const int t8 = lane >> 3, tl = 8 * pw + t8, c0 = (lane & 7) * 8; const int o = t8 * 64 + c0;
                  float bs = 0.f, ss = 0.f; f32x4 kr[2], k4[2], a4[2], r4[2];
#pragma unroll
                  for (int q = 0; q < 2; ++q) { k4[q] = *(const f32x4*)(PK + o + 4 * q); a4[q] = *(const f32x4*)(PA + o + 4 * q); r4[q] = *(const f32x4*)(PR + o + 4 * q);
                      kr[q] = k4[q] * *(const f32x4*)(KKW + c0 + 4 * q); ss += (kr[q][0] * kr[q][0] + kr[q][1] * kr[q][1]) + (kr[q][2] * kr[q][2] + kr[q][3] * kr[q][3]); }
                  ss = dpp_red8(ss);
                  const float inv = __builtin_amdgcn_rsqf(fmaxf(ss, 1e-24f));
                  f32x4 kk[2], kd[2], kka[2];
#pragma unroll
                  for (int q = 0; q < 2; ++q) { kk[q] = kr[q] * inv; kd[q] = k4[q] * (1.f + (a4[q] - 1.f) * *(const f32x4*)(KAW + c0 + 4 * q)); kka[q] = kk[q] * a4[q];
                      const f32x4 bb = r4[q] * kd[q] * *(const f32x4*)(RKW + c0 + 4 * q); bs += (bb[0] + bb[1]) + (bb[2] + bb[3]); }
                  const int oh = (tl * 64 + c0) * 2;
#define ST8(OFF, X) *(u32x4*)(B_ + (OFF) + oh) = (u32x4){pkh(X[0][0], X[0][1]), pkh(X[0][2], X[0][3]), pkh(X[1][0], X[1][1]), pkh(X[1][2], X[1][3])}
                  ST8(O_KK, kk); ST8(O_KD, kd); ST8(O_KA, kka); ST8(O_R, r4);
#undef ST8
                  bs = dpp_red8(bs);
                  if ((lane & 7) == 0) bon[(size_t)(tok0 + tfirst + tl) * 16 + head] = bs; }
            }
            asm volatile("s_waitcnt lgkmcnt(0)" ::: "memory"); __builtin_amdgcn_s_barrier(); asm volatile("" ::: "memory");
        }
#undef PLOAD
    } else {
        __syncthreads();
        const int row0 = wid * 16 + (lane >> 3) * 2, seg = lane & 7;
        h2 S[2][4];
#pragma unroll
        for (int h = 0; h < 2; ++h)
#pragma unroll
            for (int q = 0; q < 4; ++q) S[h][q] = (h2){(_Float16)0.f, (_Float16)0.f};
        asm volatile("s_waitcnt lgkmcnt(0)" ::: "memory"); __builtin_amdgcn_s_barrier(); asm volatile("" ::: "memory");
        for (int c = 0; c < NCH; ++c) {
            const char* B_ = lds + (c & 1) * BUFB;
            if (dir) scan_chunk<1>(B_, S, seg, row0); else scan_chunk<0>(B_, S, seg, row0);
            asm volatile("s_waitcnt lgkmcnt(0)" ::: "memory"); __builtin_amdgcn_s_barrier(); asm volatile("" ::: "memory");
        }
    }
    if (wid >= 4) {
        const int pt = tid - 256, c = NCH, cb_ = (c - 1) & 1, tf = dir ? T - TC * c : TC * (c - 1); const int tl = pt >> 3, c8 = (pt & 7) * 8;
        const float* yp = (const float*)(lds + cb_ * BUFB + O_Y) + tl * 64 + c8; const f32x4 y4 = *(const f32x4*)yp, y5 = *(const f32x4*)(yp + 4);
        u32x4 w; w.x = cvt_pk_bf16(y4[0], y4[1]); w.y = cvt_pk_bf16(y4[2], y4[3]); w.z = cvt_pk_bf16(y5[0], y5[1]); w.w = cvt_pk_bf16(y5[2], y5[3]);
        *(u32x4*)(yb + (size_t)(tok0 + tf + tl) * 1024 + head * 64 + c8) = w;
    }
    __syncthreads();
}
}

__device__ __forceinline__ void p4_post(const Args& a, char* lds, int vcu, int G) {
    const int tid = threadIdx.x, lane = tid & 63;
    unsigned char* ws = a.ws;
    const bf16_t* ZR = (const bf16_t*)a.out; bf16_t* QK = (bf16_t*)(ws + WS_QK);
    const bf16_t* Y0 = (const bf16_t*)(ws + WS_Y); const bf16_t* Y1 = Y0 + (size_t)NT * 1024;
    const float* BON = (const float*)(ws + WS_BON);
    const float* mup = a.in[13]; const float* mun = a.in[14]; const float* G2 = a.in[19]; const float* lnw = a.in[23]; const float* lnb = a.in[24]; const float* subg = a.in[12];
    bf16_t* SGh = (bf16_t*)lds; float* BL = (float*)(lds + 20480); bf16_t* GL = (bf16_t*)(lds + 24576);
    const bf16_t* G2T = (const bf16_t*)(ws + WS_G2T);
    const int wid = tid >> 6, r32 = lane & 31, hi = lane >> 5;
    for (int tile = vcu; tile < NT / 32; tile += G) {
        const int tk0 = tile * 32;
        __syncthreads();
        for (int it = tid; it < 32 * 20; it += NTHR) {
            const int tl = it / 20, j0 = (it % 20) * 8, col = 3328 + j0, tok = tk0 + tl, t = tok_pos(tok), T = tok < TP ? TP : TS;
            const bf16_t* zp = ZR + (size_t)tok * ZRP + col; const u32x4 z = *(const u32x4*)zp; u32x4 zm = {0u, 0u, 0u, 0u}, zn = {0u, 0u, 0u, 0u};
            if (t > 0) zm = *(const u32x4*)(zp - ZRP);
            if (t < T - 1) zn = *(const u32x4*)(zp + ZRP);
            float v[8];
            const f32x4 mpa = *(const f32x4*)(mup + col), mpb = *(const f32x4*)(mup + col + 4), mna = *(const f32x4*)(mun + col), mnb = *(const f32x4*)(mun + col + 4);
#define SH(i, zw, zmw, znw, lohi) { const float zz = lohi(zw), a_ = lohi(zmw), b_ = lohi(znw), mp_ = (i < 4 ? mpa[i & 3] : mpb[i & 3]), mn_ = (i < 4 ? mna[i & 3] : mnb[i & 3]); v[i] = sigmoidf_(zz + mp_ * (a_ - zz) + mn_ * (b_ - zz)); }
            SH(0, z.x, zm.x, zn.x, bflo) SH(1, z.x, zm.x, zn.x, bfhi) SH(2, z.y, zm.y, zn.y, bflo) SH(3, z.y, zm.y, zn.y, bfhi)
            SH(4, z.z, zm.z, zn.z, bflo) SH(5, z.z, zm.z, zn.z, bfhi) SH(6, z.w, zm.w, zn.w, bflo) SH(7, z.w, zm.w, zn.w, bfhi)
#undef SH
            { u32x4 w; w.x = cvt_pk_bf16(v[0], v[1]); w.y = cvt_pk_bf16(v[2], v[3]); w.z = cvt_pk_bf16(v[4], v[5]); w.w = cvt_pk_bf16(v[6], v[7]); *(u32x4*)(SGh + tl * 160 + j0) = w; }
        }
        { const int tl = tid >> 4, hd = tid & 15; BL[tid] = BON[(size_t)(tk0 + tl) * 16 + hd] + BON[(size_t)NT * 16 + (size_t)(tk0 + tl) * 16 + hd]; }
        { const int pr = tid >> 1, half = tid & 1, tl = pr >> 3, hd = pr & 7; bf16_t* op = QK + (size_t)(tk0 + tl) * 2048 + hd * 128 + half * 64;
          u32x4 w[8]; float ss = 0.f;
#pragma unroll
          for (int i = 0; i < 8; ++i) { w[i] = *(const u32x4*)(op + i * 8);
              ss += bflo(w[i].x) * bflo(w[i].x) + bfhi(w[i].x) * bfhi(w[i].x) + bflo(w[i].y) * bflo(w[i].y) + bfhi(w[i].y) * bfhi(w[i].y) + bflo(w[i].z) * bflo(w[i].z) + bfhi(w[i].z) * bfhi(w[i].z) + bflo(w[i].w) * bflo(w[i].w) + bfhi(w[i].w) * bfhi(w[i].w); }
          ss += __shfl_xor(ss, 1);
          const float rstd = rsqrtf(ss * (1.f / 128.f) + 1e-6f) * 0.8f; const float* sg = subg + half * 64;
#pragma unroll
          for (int i = 0; i < 8; ++i) { u32x4 o;
              o.x = cvt_pk_bf16(bflo(w[i].x) * rstd * sg[i * 8 + 0], bfhi(w[i].x) * rstd * sg[i * 8 + 1]); o.y = cvt_pk_bf16(bflo(w[i].y) * rstd * sg[i * 8 + 2], bfhi(w[i].y) * rstd * sg[i * 8 + 3]);
              o.z = cvt_pk_bf16(bflo(w[i].z) * rstd * sg[i * 8 + 4], bfhi(w[i].z) * rstd * sg[i * 8 + 5]); o.w = cvt_pk_bf16(bflo(w[i].w) * rstd * sg[i * 8 + 6], bfhi(w[i].w) * rstd * sg[i * 8 + 7]);
              *(u32x4*)(op + i * 8) = o; } }
        __syncthreads();
        { f32x16 gacc[4] = {};
#pragma unroll
          for (int ks = 0; ks < 10; ++ks) { const bf16x8 af = *reinterpret_cast<const bf16x8*>(SGh + r32 * 160 + ks * 16 + hi * 8);
#pragma unroll
              for (int cb = 0; cb < 4; ++cb) { const bf16x8 bfr = *reinterpret_cast<const bf16x8*>(G2T + (size_t)(wid * 128 + cb * 32 + r32) * 160 + ks * 16 + hi * 8);
                  gacc[cb] = __builtin_amdgcn_mfma_f32_32x32x16_bf16(af, bfr, gacc[cb], 0, 0, 0); } }
#pragma unroll
          for (int cb = 0; cb < 4; ++cb)
#pragma unroll
              for (int r = 0; r < 16; ++r) GL[(att::crow(r, hi)) * 1024 + wid * 128 + cb * 32 + r32] = (bf16_t)(cvt_pk_bf16(gacc[cb][r], gacc[cb][r]) & 0xffffu); }
        __syncthreads();
        const int c0 = tid * 2;
        const int hd = tid >> 5;
        const float lw0 = lnw[c0], lw1 = lnw[c0 + 1], lb0 = lnb[c0], lb1 = lnb[c0 + 1];
        const float mp0 = mup[2048 + c0], mp1 = mup[2048 + c0 + 1], mn0 = mun[2048 + c0], mn1 = mun[2048 + c0 + 1];
#pragma unroll
        for (int i = 0; i < 32; ++i) {
            const int tok = tk0 + i, t = tok_pos(tok), T = tok < TP ? TP : TS;
            const unsigned ya = *(const unsigned*)(Y0 + (size_t)tok * 1024 + c0), yb = *(const unsigned*)(Y1 + (size_t)tok * 1024 + c0);
            const float y0 = bflo(ya) + bflo(yb), y1 = bfhi(ya) + bfhi(yb);
            float s = y0 + y1, q = y0 * y0 + y1 * y1;
#pragma unroll
            for (int o = 16; o < 32; o <<= 1) { s += __shfl_xor(s, o); q += __shfl_xor(q, o); }
#define DPPADD(x, ctrl) x += __uint_as_float(__builtin_amdgcn_update_dpp(0u, __float_as_uint(x), ctrl, 0xf, 0xf, false))
            DPPADD(s, 0xB1); DPPADD(q, 0xB1); DPPADD(s, 0x4E); DPPADD(q, 0x4E); DPPADD(s, 0x141); DPPADD(q, 0x141); DPPADD(s, 0x140); DPPADD(q, 0x140);
#undef DPPADD
            const float mean = s * (1.f / 64.f), var = fmaxf(q * (1.f / 64.f) - mean * mean, 0.f), rstd = rsqrtf(var + 64e-5f);
            const bf16_t* zp = ZR + (size_t)tok * ZRP + 2048 + c0; const unsigned z = *(const unsigned*)zp;
            unsigned zm = 0u, zn = 0u;
            if (t > 0) zm = *(const unsigned*)(zp - ZRP);
            if (t < T - 1) zn = *(const unsigned*)(zp + ZRP);
            const float v0 = bflo(z) + mp0 * (bflo(zm) - bflo(z)) + mn0 * (bflo(zn) - bflo(z)), v1 = bfhi(z) + mp1 * (bfhi(zm) - bfhi(z)) + mn1 * (bfhi(zn) - bfhi(z));
            const float bo = BL[i * 16 + hd];
            const unsigned gg = *(const unsigned*)(GL + i * 1024 + c0);
            const float o0 = ((y0 - mean) * rstd * lw0 + lb0 + bo * v0) * bflo(gg), o1 = ((y1 - mean) * rstd * lw1 + lb1 + bo * v1) * bfhi(gg);
            *(unsigned*)(QK + (size_t)tok * 2048 + 1024 + c0) = cvt_pk_bf16(o0, o1);
        }
    }
    __syncthreads();
}

struct SchedMerge {
    int v, G; const char* H; const char* WG; const char* QK; const char* VM; const char* PAR; const char* PM2;
    __device__ __forceinline__ bool next(int i, Unit& u) const {
        const int ti = i / 6, kind = i - ti * 6; const long L = (long)ti * G + v; int pm, pn;
        if (!TileMap{192, 8}.get(L, pm, pn)) return false;
        u.pm = pm; u.pn = pn; u.kind = kind; u.t0 = 0; u.T = 0;
        const size_t bo = (size_t)pn * MiB;
        switch (kind) {
            case 0: u.A = H + (size_t)pm * MiB; u.B = WG + bo; u.nt = 32; break;
            case 1: u.A = QK + (size_t)pm * MiB; u.B = PAR + bo; u.nt = 16; break;
            case 2: u.A = H + (size_t)pm * MiB; u.B = WG + 8 * MiB + bo; u.nt = 32; break;
            case 3: u.A = QK + (size_t)pm * MiB + 2048; u.B = PAR + bo + 2048; u.nt = 16; break;
            case 4: u.A = H + (size_t)pm * MiB; u.B = WG + 16 * MiB + bo; u.nt = 32; break;
            default: u.A = VM + (size_t)pm * MiB + 2048; u.B = PM2 + bo; u.nt = 16; break;
        }
        return true;
    }
};
struct EpiMerge {
    u32x4* scrG; f32x4* scrP; bf16_t* MRG;
    __device__ __forceinline__ void operator()(const f32x4 (&acc)[2][2][4][2], const Unit& u, int wr, int wc, int fr, int fq) const {
        const int tid = threadIdx.x, kind = u.kind;
        u32x4* gp = scrG + tid; f32x4* pp = scrP + tid;
        if ((kind & 1) == 0) {
#pragma unroll
            for (int ai = 0; ai < 2; ++ai)
#pragma unroll
                for (int bj = 0; bj < 2; ++bj)
#pragma unroll
                    for (int m = 0; m < 4; ++m) { const f32x4 v0 = acc[ai][bj][m][0], v1 = acc[ai][bj][m][1]; u32x4 w;
                        w.x = cvt_pk_bf16(sigmoidf_(v0[0]), sigmoidf_(v0[1])); w.y = cvt_pk_bf16(sigmoidf_(v0[2]), sigmoidf_(v0[3]));
                        w.z = cvt_pk_bf16(sigmoidf_(v1[0]), sigmoidf_(v1[1])); w.w = cvt_pk_bf16(sigmoidf_(v1[2]), sigmoidf_(v1[3]));
                        *gp = w; gp += NTHR; asm volatile("" : "+v"(gp) :: "memory"); }
        } else {
            const int row0 = u.pm * 256 + wr * 64 + fr, col0 = u.pn * 256 + wc * 32 + 8 * fq;
#pragma unroll
            for (int ai = 0; ai < 2; ++ai)
#pragma unroll
                for (int bj = 0; bj < 2; ++bj) {
                    bf16_t* mp = MRG + (size_t)(row0 + ai * 128) * 2048 + col0 + bj * 128;
#pragma unroll
                    for (int m = 0; m < 4; ++m) { const u32x4 g = *gp;
                        f32x4 p0 = acc[ai][bj][m][0] * (f32x4){bflo(g.x), bfhi(g.x), bflo(g.y), bfhi(g.y)}, p1 = acc[ai][bj][m][1] * (f32x4){bflo(g.z), bfhi(g.z), bflo(g.w), bfhi(g.w)};
                        if (kind > 1) { p0 += pp[0]; p1 += pp[NTHR]; }
                        if (kind < 5) { pp[0] = p0; pp[NTHR] = p1; }
                        else { u32x4 w; w.x = cvt_pk_bf16(p0[0], p0[1]); w.y = cvt_pk_bf16(p0[2], p0[3]); w.z = cvt_pk_bf16(p1[0], p1[1]); w.w = cvt_pk_bf16(p1[2], p1[3]);
                            *(u32x4*)mp = w; }
                        gp += NTHR; pp += 2 * NTHR; mp += 16 * 2048; asm volatile("" : "+v"(gp), "+v"(pp), "+v"(mp) :: "memory"); } }
        }
    }
};

struct SchedSq {
    int v, G; const char* A; const char* B; size_t astep, bstep; int nt;
    __device__ __forceinline__ bool next(int i, Unit& u) const {
        const long L = (long)i * G + v; int pm, pn; if (!TileMap{192, 8}.get(L, pm, pn)) return false;
        u.A = A + (size_t)pm * astep; u.B = B + (size_t)pn * bstep; u.nt = nt; u.pm = pm; u.pn = pn; u.kind = 0; u.t0 = 0; u.T = 0; return true;
    }
};
struct EpiWo {
    const float* xp; const float* xs; float* out;
    __device__ __forceinline__ void operator()(const f32x4 (&acc)[2][2][4][2], const Unit& u, int wr, int wc, int fr, int fq) const {
        const int row0 = u.pm * 256 + wr * 64 + fr, col0 = u.pn * 256 + wc * 32 + 8 * fq;
#pragma unroll
        for (int ai = 0; ai < 2; ++ai)
#pragma unroll
            for (int m = 0; m < 4; ++m) { const int row = row0 + ai * 128 + m * 16;
                const float* xr = (row < TP ? xp + (size_t)row * DM : xs + (size_t)(row - TP) * DM) + col0; float* orow = out + (size_t)row * DM + col0;
#pragma unroll
                for (int bj = 0; bj < 2; ++bj) { const f32x4 x0 = *(const f32x4*)(xr + bj * 128), x1 = *(const f32x4*)(xr + bj * 128 + 4);
                    *(f32x4*)(orow + bj * 128) = x0 + acc[ai][bj][m][0]; *(f32x4*)(orow + bj * 128 + 4) = x1 + acc[ai][bj][m][1]; } }
    }
};
struct EpiDown {
    float* out;
    __device__ __forceinline__ void operator()(const f32x4 (&acc)[2][2][4][2], const Unit& u, int wr, int wc, int fr, int fq) const {
        const int row0 = u.pm * 256 + wr * 64 + fr, col0 = u.pn * 256 + wc * 32 + 8 * fq;
#pragma unroll
        for (int ai = 0; ai < 2; ++ai)
#pragma unroll
            for (int m = 0; m < 4; ++m) { float* orow = out + (size_t)(row0 + ai * 128 + m * 16) * DM + col0;
#pragma unroll
                for (int bj = 0; bj < 2; ++bj) { const f32x4 x0 = *(const f32x4*)(orow + bj * 128), x1 = *(const f32x4*)(orow + bj * 128 + 4);
                    *(f32x4*)(orow + bj * 128) = x0 + acc[ai][bj][m][0]; *(f32x4*)(orow + bj * 128 + 4) = x1 + acc[ai][bj][m][1]; } }
    }
};

struct SchedUp {
    int v, G; const char* HN; const char* WUP;
    __device__ __forceinline__ bool next(int i, Unit& u) const {
        const long L = (long)i * G + v; int pm, pn; if (!TileMap{197, 44}.get(L, pm, pn)) return false;
        int s, ti; if (pm < 65) { s = 0; ti = pm; } else { s = 1 + (pm - 65) / 33; ti = (pm - 65) % 33; }
        const int T = seq_len(s); int t0 = 254 * ti - 1; if (t0 > T - 255) t0 = T - 255;
        u.pm = seq_start(s); u.pn = pn; u.kind = 0; u.t0 = t0; u.T = T; u.nt = 32;
        u.A = HN + ((long)u.pm + t0) * 4096; u.B = WUP + (size_t)pn * MiB; return true;
    }
};
struct EpiUp {
    bf16_t* ACT; const float* cw; const float* cb; LAS float* xch;
    __device__ __forceinline__ void operator()(const f32x4 (&acc)[2][2][4][2], const Unit& u, int wr, int wc, int fr, int fq) const {
        const int lane = threadIdx.x & 63;
        const int cin = wc * 32 + 8 * fq;
#pragma unroll
        for (int ai = 0; ai < 2; ++ai) { const int rg = 2 * ai + wr;
#pragma unroll
            for (int bj = 0; bj < 2; ++bj)
#pragma unroll
                for (int n = 0; n < 2; ++n) {
                    if (fr == 0) *(LAS f32x4*)(xch + (rg * 2 + 0) * 256 + bj * 128 + cin + 4 * n) = acc[ai][bj][0][n];
                    if (fr == 15) *(LAS f32x4*)(xch + (rg * 2 + 1) * 256 + bj * 128 + cin + 4 * n) = acc[ai][bj][3][n]; } }
        asm volatile("s_waitcnt lgkmcnt(0)" ::: "memory"); __builtin_amdgcn_s_barrier(); asm volatile("" ::: "memory");
        const int gc = u.pn * 128 + cin;
#pragma unroll
        for (int n = 0; n < 2; ++n) {
            const int wcol = gc + 4 * n;
            const f32x4 g0 = *(const f32x4*)(cw + wcol), g1 = *(const f32x4*)(cw + 2 * DFF + wcol), g2 = *(const f32x4*)(cw + 4 * DFF + wcol), gb = *(const f32x4*)(cb + wcol);
            const f32x4 v0 = *(const f32x4*)(cw + DFF + wcol), v1 = *(const f32x4*)(cw + 3 * DFF + wcol), v2 = *(const f32x4*)(cw + 5 * DFF + wcol), vb = *(const f32x4*)(cb + DFF + wcol);
#pragma unroll
            for (int ai = 0; ai < 2; ++ai) { const int rg = 2 * ai + wr;
                bf16_t* ap = ACT + ((long)u.pm + u.t0 + 128 * ai + 64 * wr + fr) * DFF + gc + 4 * n;
#pragma unroll
                for (int m = 0; m < 4; ++m) {
                    const int j = 128 * ai + 64 * wr + 16 * m + fr, t = u.t0 + j;
                    f32x4 res;
#pragma unroll
                    for (int bj = 0; bj < 2; ++bj) {
                        const f32x4 cur = acc[ai][bj][m][n];
                        const f32x4 sp = (m > 0 && fr == 15) ? acc[ai][bj][m > 0 ? m - 1 : 0][n] : cur;
                        const f32x4 sn = (m < 3 && fr == 0) ? acc[ai][bj][m < 3 ? m + 1 : 3][n] : cur;
                        f32x4 pv, nv;
#pragma unroll
                        for (int i = 0; i < 4; ++i) { pv[i] = __uint_as_float(__builtin_amdgcn_update_dpp(0u, __float_as_uint(sp[i]), 0x121, 0xf, 0xf, false));
                                                       nv[i] = __uint_as_float(__builtin_amdgcn_update_dpp(0u, __float_as_uint(sn[i]), 0x12F, 0xf, 0xf, false)); }
                        if (m == 0) { const f32x4 xprev = rg > 0 ? *(const LAS f32x4*)(xch + ((rg - 1) * 2 + 1) * 256 + bj * 128 + cin + 4 * n) : (f32x4){0.f, 0.f, 0.f, 0.f}; if (fr == 0) pv = xprev; }
                        if (m == 3) { const f32x4 xnext = rg < 3 ? *(const LAS f32x4*)(xch + ((rg + 1) * 2 + 0) * 256 + bj * 128 + cin + 4 * n) : (f32x4){0.f, 0.f, 0.f, 0.f}; if (fr == 15) nv = xnext; }
                        if (t < 1) pv = (f32x4){0.f, 0.f, 0.f, 0.f};
                        if (t >= u.T - 1) nv = (f32x4){0.f, 0.f, 0.f, 0.f};
                        if (bj == 0) { const f32x4 cv = g0 * pv + g1 * cur + g2 * nv + gb; res = (f32x4){cv[0] * sigmoidf_(cv[0]), cv[1] * sigmoidf_(cv[1]), cv[2] * sigmoidf_(cv[2]), cv[3] * sigmoidf_(cv[3])}; }
                        else { const f32x4 cv = v0 * pv + v1 * cur + v2 * nv + vb; res = res * cv; }
                    }
                    if (j >= 1 && j <= 254) { u32x2 w; w.x = cvt_pk_bf16(res[0], res[1]); w.y = cvt_pk_bf16(res[2], res[3]); *(u32x2*)ap = w; }
                    ap += 16 * DFF; asm volatile("" : "+v"(ap) :: "memory");
                }
            }
        }
    }
};

__global__ void __launch_bounds__(NTHR, 2) enc_fwd(Args args) {
    extern __shared__ __attribute__((aligned(16))) unsigned char lds_raw[];
    cg::grid_group grid = cg::this_grid();
    LAS unsigned char* lds = (LAS unsigned char*)lds_raw;
    const int tid = threadIdx.x;
    const int G = gridDim.x, bx = blockIdx.x, vcu = (G % 8 == 0) ? (bx % 8) * (G / 8) + bx / 8 : bx;
    unsigned char* ws = args.ws;
    const int lo = args.ph_lo, hi = args.ph_hi;
#ifndef P2M
#define P2M 7
#endif
#ifndef PH_MASK
#define PH_MASK 0x1ff
#endif
#define IN(k) (((PH_MASK >> (k)) & 1) && lo <= (k) && (k) < hi)
#define SEAM(k) do { if (IN(k) && IN((k) + 1)) grid.sync(); } while (0)
#ifndef PROBE
#define PROBE 0
#endif
    unsigned long long tp0 = 0, tp1 = 0;
#define TSTAMP(v) do { if (PROBE) { v = __builtin_amdgcn_s_memrealtime(); } } while (0)

    if (IN(0)) p0_prologue(args, lds, vcu, G);
    SEAM(0);
    if (IN(1)) {
        SchedIn S{vcu, G, (const char*)(ws + WS_H), (const char*)(ws + WS_WIN), (const char*)(ws + WS_MEMN), (const char*)(ws + WS_WKV)};
        EpiIn E{(bf16_t*)(ws + WS_QK), (bf16_t*)(ws + WS_VM), (bf16_t*)args.out, (bf16_t*)(ws + WS_KVM), args.in[6], args.in[7], (const float*)(ws + WS_ROPE), (const float*)(ws + WS_ROPE) + TP * 32};
        pg8::gemm_phase<EpiIn, SchedIn, true>(lds, 2048, S, E);
    }
    SEAM(1);
    if (PROBE == 1 || PROBE == 2) TSTAMP(tp0);
    if (IN(2)) {
        unsigned* ctl = (unsigned*)(ws + WS_CTL);
        volatile LAS unsigned* jobw = (volatile LAS unsigned*)(lds + LDS_MISC);
        const float lam = ((const float*)ctl)[CW_LAM];
        const bool fixref = ((const float*)ctl)[CW_SMAX] <= 30.f;
        scan::P sp{(const bf16_t*)args.out, (bf16_t*)(ws + WS_Y), (float*)(ws + WS_BON), args.in[13], args.in[14], args.in[15], args.in[16], args.in[17], args.in[18], args.in[20], args.in[21], args.in[22]};
        for (;;) {
            __syncthreads();
            if (tid == 0) jobw[0] = atomicAdd(ctl + CW_QUEUE, 1u);
            __syncthreads();
            const int jb = (int)jobw[0];
            if (jb >= 160 + 1536 + 768) break;
            if (((P2M) & 1) && jb < 160) {
                int s, r; if (jb < 32) { s = 0; r = jb; } else { s = 1 + (jb - 32) / 32; r = (jb - 32) % 32; }
                scan::job(s, r & 1, r >> 1, sp, (char*)lds_raw);
                if (PROBE == 2 && tid == 0) atomicMax((unsigned long long*)(ctl + 256), (unsigned long long)__builtin_amdgcn_s_memrealtime());
            } else if (((P2M) & 2) && jb < 160 + 1536) {
                const int a = jb - 160; int s, h, qb;
                if (a < 512) { s = 0; h = a / 64; qb = a % 64; } else { const int b = a - 512; s = 1 + b / 256; h = (b % 256) / 32; qb = b % 32; }
                if (fixref) att::diff_unit<true>(s, h, qb, (bf16_t*)(ws + WS_QK), (const bf16_t*)(ws + WS_VM), lam, (char*)lds_raw, lds);
                else att::diff_unit<false>(s, h, qb, (bf16_t*)(ws + WS_QK), (const bf16_t*)(ws + WS_VM), lam, (char*)lds_raw, lds);
            } else if ((P2M) & 4) {
                const int a = jb - 160 - 1536; int s, mh, qb;
                if (a < 256) { s = 0; mh = a / 64; qb = a % 64; } else { const int b = a - 256; s = 1 + b / 128; mh = (b % 128) / 32; qb = b % 32; }
                att::mem_unit(s, mh, qb, (bf16_t*)(ws + WS_VM), (const bf16_t*)(ws + WS_KVM), args.in[27], args.in[28], (char*)lds_raw);
            }
        }
    }
    SEAM(2);
    if (PROBE == 1) TSTAMP(tp1);
    if (IN(3)) p4_post(args, (char*)lds_raw, vcu, G);
    SEAM(3);
    if (IN(4)) {
        SchedMerge S{vcu, G, (const char*)(ws + WS_H), (const char*)(ws + WS_WG), (const char*)(ws + WS_QK), (const char*)(ws + WS_VM), (const char*)(ws + WS_PAR), (const char*)(ws + WS_PM2)};
        unsigned char* scr = (unsigned char*)args.out + (size_t)bx * (384 * 1024);
        EpiMerge E{(u32x4*)scr, (f32x4*)(scr + 128 * 1024), (bf16_t*)(ws + WS_MRG)};
        pg8::gemm_phase<EpiMerge, SchedMerge, true>(lds, 2048, S, E);
    }
    SEAM(4);
    if (IN(5)) {
        SchedSq S{vcu, G, (const char*)(ws + WS_MRG), (const char*)(ws + WS_WO), MiB, MiB, 32};
        EpiWo E{args.in[0], args.in[1], args.out};
        pg8::gemm_phase<EpiWo, SchedSq, true>(lds, 2048, S, E);
    }
    SEAM(5);
    if (IN(6)) {
        const int lane = tid & 63, gw = vcu * 8 + (tid >> 6), NGW = G * 8;
        for (int m = gw; m < NT; m += NGW) rms_row(args.out + (size_t)m * DM, args.in[33], (bf16_t*)(ws + WS_H) + (size_t)m * DM, lane);
    }
    SEAM(6);
    if (IN(7)) {
        SchedUp S{vcu, G, (const char*)(ws + WS_H), (const char*)(ws + WS_WUP)};
        EpiUp E{(bf16_t*)(ws + WS_ACT), args.in[35], args.in[36], (LAS float*)(lds + LDS_XCH)};
        pg8::gemm_phase<EpiUp, SchedUp, true>(lds, 2048, S, E);
    }
    SEAM(7);
    if (IN(8)) {
        SchedSq S{vcu, G, (const char*)(ws + WS_ACT), (const char*)(ws + WS_WDN), (size_t)256 * DFF * 2, (size_t)256 * DFF * 2, 88};
        EpiDown E{args.out};
        pg8::gemm_phase<EpiDown, SchedSq, true>(lds, DFF, S, E);
    }
    if (PROBE && bx == 0 && tid == 0) {
        if (PROBE == 2) tp1 = __hip_atomic_load((unsigned long long*)(ws + WS_CTL) + 128, __ATOMIC_RELAXED, __HIP_MEMORY_SCOPE_AGENT);
        const unsigned long long target = __builtin_amdgcn_s_memrealtime() + (tp1 > tp0 ? tp1 - tp0 : 0);
        while (__builtin_amdgcn_s_memrealtime() < target) __builtin_amdgcn_s_sleep(16);
    }
#undef IN
#undef SEAM
}

#ifndef MK_SPLIT
#define MK_SPLIT 0
#endif
extern "C" void kernel_launch(void* const* d_in, const int* in_sizes, int n_in, void* d_out, int out_size, void* d_ws, size_t ws_size, hipStream_t stream) {
    static int grid = 0;
    if (grid == 0) {
        if (n_in != 38 || out_size != NT * DM || ws_size < WS_END) { fprintf(stderr, "kernel_launch: unexpected shapes n_in %d out %d ws %zu\n", n_in, out_size, ws_size); grid = -1; return; }
        int dev = 0, cus = 0, per_cu = 0;
        hipGetDevice(&dev); hipDeviceGetAttribute(&cus, hipDeviceAttributeMultiprocessorCount, dev);
        if (hipFuncSetAttribute((const void*)enc_fwd, hipFuncAttributeMaxDynamicSharedMemorySize, LDS_BYTES) != hipSuccess) { fprintf(stderr, "kernel_launch: hipFuncSetAttribute failed\n"); grid = -1; return; }
        if (hipOccupancyMaxActiveBlocksPerMultiprocessor(&per_cu, (const void*)enc_fwd, NTHR, LDS_BYTES) != hipSuccess || per_cu < 1) { fprintf(stderr, "kernel_launch: occupancy query failed (%d)\n", per_cu); per_cu = 1; }
        (void)hipGetLastError();
        grid = cus * 1;
    }
    if (grid < 0) return;
    Args a{};
    for (int i = 0; i < 38; ++i) a.in[i] = (const float*)d_in[i];
    a.out = (float*)d_out; a.ws = (unsigned char*)d_ws;
    for (int d = 0; d < 32; ++d) a.inv_rev[d] = pow(10000.0, -(double)d / 32.0) / 6.283185307179586476925286766559;
#if MK_SPLIT
    for (int ph = 0; ph < 9; ++ph) { a.ph_lo = ph; a.ph_hi = ph + 1; void* kargs[] = {&a};
        hipError_t e = hipLaunchCooperativeKernel((const void*)enc_fwd, dim3(grid), dim3(NTHR), kargs, LDS_BYTES, stream);
        if (e != hipSuccess) { fprintf(stderr, "launch %d failed: %s\n", ph, hipGetErrorString(e)); break; } }
#else
    a.ph_lo = 0; a.ph_hi = 9;
    void* kargs[] = {&a};
    hipError_t e = hipLaunchCooperativeKernel((const void*)enc_fwd, dim3(grid), dim3(NTHR), kargs, LDS_BYTES, stream);
    if (e != hipSuccess) fprintf(stderr, "cooperative launch failed: %s (grid %d)\n", hipGetErrorString(e), grid);
#endif
}
```

```cpp
#include <hip/hip_runtime.h>
#include <hip/hip_cooperative_groups.h>
#include <cstdio>
#include <cstdint>
#include <cmath>
namespace cg = cooperative_groups;

#define LAS __attribute__((address_space(3)))
typedef unsigned short bf16_t;
typedef short bf16x8 __attribute__((ext_vector_type(8)));
typedef short s16x4 __attribute__((ext_vector_type(4)));
typedef float f32x2 __attribute__((ext_vector_type(2)));
typedef float f32x4 __attribute__((ext_vector_type(4)));
typedef float f32x16 __attribute__((ext_vector_type(16)));
typedef unsigned u32x2 __attribute__((ext_vector_type(2)));
typedef unsigned u32x4 __attribute__((ext_vector_type(4)));

constexpr int NT = 49152, DM = 2048, TP = 16384, TS = 8192, NSEQ = 5;
constexpr int ZRP = 3584;
constexpr int DFF = 5632;
constexpr int NTHR = 512;
constexpr size_t MiB = 1u << 20;
constexpr size_t WS_CTL = 0, WS_WIN = 1 * MiB, WS_WG = 31 * MiB, WS_WKV = 55 * MiB, WS_PAR = 63 * MiB, WS_PM2 = 71 * MiB, WS_WO = 79 * MiB,
                 WS_WUP = 87 * MiB, WS_WDN = 131 * MiB, WS_ROPE = 153 * MiB, WS_MEMN = 157 * MiB, WS_KVM = 162 * MiB, WS_BON = 167 * MiB,
                 WS_H = 176 * MiB, WS_QK = 370 * MiB, WS_VM = 562 * MiB, WS_Y = 754 * MiB, WS_ACT = 370 * MiB, WS_MRG = 754 * MiB, WS_END = 946 * MiB;
constexpr int CW_QUEUE = 64, CW_LAM = 128, CW_SMAX = 129;
constexpr size_t WS_G2T = 173 * MiB;
constexpr int LDS_XCH = 131072, LDS_MISC = 141312, LDS_BYTES = 141312 + 256;

__device__ __forceinline__ int seq_start(int s) { return s == 0 ? 0 : TP + (s - 1) * TS; }
__device__ __forceinline__ int seq_len(int s) { return s == 0 ? TP : TS; }
__device__ __forceinline__ int tok_pos(int tok) { return tok < TP ? tok : ((tok - TP) & (TS - 1)); }

__device__ __forceinline__ unsigned cvt_pk_bf16(float lo, float hi) { unsigned r; asm volatile("v_cvt_pk_bf16_f32 %0, %1, %2" : "=v"(r) : "v"(lo), "v"(hi)); return r; }
__device__ __forceinline__ float bflo(unsigned w) { return __uint_as_float(w << 16); }
__device__ __forceinline__ float bfhi(unsigned w) { return __uint_as_float(w & 0xffff0000u); }
__device__ __forceinline__ float bf1(bf16_t b) { return __uint_as_float((unsigned)b << 16); }
__device__ __forceinline__ float sigmoidf_(float x) { return 1.f / (1.f + __expf(-x)); }
__device__ __forceinline__ float wave_sum(float v) {
#pragma unroll
    for (int o = 1; o < 64; o <<= 1) v += __shfl_xor(v, o);
    return v;
}

namespace pg8 {
constexpr int BM = 256, BK = 64, HALF = 128, HTB = HALF * BK * 2, STAGE_BYTES = 8 * HTB;
__host__ __device__ __forceinline__ int lds_byte(int r, int c) { const int st = (r >> 4) * 2 + (c >> 5), rr = r & 15, cc = c & 31, ob = rr * 64 + cc * 2; return st * 1024 + (ob ^ (((ob >> 9) & 1) << 5)); }
__host__ __device__ __forceinline__ void stage_rc(int b, int& R, int& C) { const int st = b / 1024, sb = b % 1024, swz = sb ^ (((sb >> 9) & 1) << 5); R = (st >> 1) * 16 + swz / 64; C = (st & 1) * 32 + (swz % 64) / 2; }
__host__ __device__ __forceinline__ int perm32(int rho) { const int n = rho >> 4, i = rho & 15; return 8 * (i >> 2) + 4 * n + (i & 3); }

struct Unit { const char* A; const char* B; int nt, pm, pn, kind, t0, T; };

template <class Epi, class Sched, bool ALIGN_EPI>
__device__ __forceinline__ void gemm_phase(LAS unsigned char* lds, const int ld, const Sched& S, const Epi& E) {
    const int tid = threadIdx.x, wid = __builtin_amdgcn_readfirstlane(tid >> 6), lane = tid & 63, wr = wid >> 2, wc = wid & 3, fr = lane & 15, fq = lane >> 4;
    unsigned voffA[2], voffB[2];
#pragma unroll
    for (int i = 0; i < 2; ++i) { int R, C; stage_rc(tid * 16 + i * 8192, R, C); const int Rb = (R & ~31) + perm32(R & 31);
        voffA[i] = (unsigned)(R * ld + C) * 2u; voffB[i] = (unsigned)(Rb * ld + C) * 2u; }
    const size_t kstep = (size_t)(BK * 2);
    const size_t hstep = (size_t)HALF * ld * 2;
    const unsigned ldsw = (unsigned)wid * 1024u;
    const int aoff = lds_byte(wr * 64 + fr, fq * 8), boff = lds_byte(wc * 32 + fr, fq * 8);
#define PG8_SA(b, h) (((b) * 2 + (h)) * HTB)
#define PG8_SB(b, h) ((4 + (b) * 2 + (h)) * HTB)
#define PG8_STAGE(bufoff, gbase, voff) do { _Pragma("unroll") for (int _i = 0; _i < 2; ++_i) \
        __builtin_amdgcn_global_load_lds((const unsigned*)((const char*)(gbase) + (voff)[_i]), (LAS unsigned*)(lds + (bufoff) + ldsw + _i * 8192), 16, 0, 0); } while (0)
#define PG8_LDA(dst, b, h) do { _Pragma("unroll") for (int m = 0; m < 4; ++m) _Pragma("unroll") for (int k = 0; k < 2; ++k) dst[m][k] = *(const LAS bf16x8*)(lds + PG8_SA(b, h) + aoff + m * 2048 + k * 1024); } while (0)
#define PG8_LDB(dst, b, h) do { _Pragma("unroll") for (int n = 0; n < 2; ++n) _Pragma("unroll") for (int k = 0; k < 2; ++k) dst[n][k] = *(const LAS bf16x8*)(lds + PG8_SB(b, h) + boff + n * 2048 + k * 1024); } while (0)
#define PG8_MMA(ai, bj, At, Bt) do { __builtin_amdgcn_s_setprio(1); _Pragma("unroll") for (int m = 0; m < 4; ++m) _Pragma("unroll") for (int n = 0; n < 2; ++n) _Pragma("unroll") for (int k = 0; k < 2; ++k) \
        acc[ai][bj][m][n] = __builtin_amdgcn_mfma_f32_16x16x32_bf16(Bt[n][k], At[m][k], acc[ai][bj][m][n], 0, 0, 0); __builtin_amdgcn_s_setprio(0); } while (0)
#define PG8_WAIT_V(n) asm volatile("s_waitcnt vmcnt(" #n ")" ::: "memory")
#define PG8_WAIT_L(n) asm volatile("s_waitcnt lgkmcnt(" #n ")" ::: "memory")
#define PG8_BAR __builtin_amdgcn_s_barrier()
#define PG8_SCHED __builtin_amdgcn_sched_barrier(0)
    Unit cur, nxt; int ui = 0;
    if (!S.next(0, cur)) return;
    f32x4 acc[2][2][4][2];
#pragma unroll
    for (int a = 0; a < 2; ++a)
#pragma unroll
        for (int b = 0; b < 2; ++b)
#pragma unroll
            for (int m = 0; m < 4; ++m)
#pragma unroll
                for (int n = 0; n < 2; ++n) acc[a][b][m][n] = (f32x4){0.f, 0.f, 0.f, 0.f};
    bf16x8 At[4][2], B0[2][2], B1[2][2];
    const char* cA = cur.A; const char* cB = cur.B;
    PG8_STAGE(PG8_SB(0, 0), cB, voffB); PG8_STAGE(PG8_SB(0, 1), cB + hstep, voffB); PG8_STAGE(PG8_SA(0, 0), cA, voffA); PG8_STAGE(PG8_SA(0, 1), cA + hstep, voffA);
    if (wr == 1) PG8_BAR;
    PG8_WAIT_V(2); PG8_BAR;
    PG8_STAGE(PG8_SB(1, 0), cB + kstep, voffB); PG8_STAGE(PG8_SA(1, 0), cA + kstep, voffA); PG8_STAGE(PG8_SB(1, 1), cB + hstep + kstep, voffB);
    PG8_WAIT_V(6); PG8_BAR;
    for (;;) {
        const bool has_next = S.next(ui + 1, nxt);
        const char* nA = has_next ? nxt.A : cA; const char* nB = has_next ? nxt.B : cB;
        const int nt = cur.nt;
        for (int t = 0; t < nt; t += 2) {
            const bool last = (t == nt - 2);
            const char* a1 = cA + (size_t)(t + 1) * kstep;
            const char* a2 = last ? nA : cA + (size_t)(t + 2) * kstep; const char* b2 = last ? nB : cB + (size_t)(t + 2) * kstep;
            const char* a3 = a2 + kstep; const char* b3 = b2 + kstep;
            PG8_LDB(B0, 0, 0); PG8_LDB(B1, 0, 1); PG8_SCHED; PG8_LDA(At, 0, 0); PG8_STAGE(PG8_SA(1, 1), a1 + hstep, voffA);
            PG8_WAIT_V(8); PG8_WAIT_L(0); PG8_BAR; PG8_MMA(0, 0, At, B0); PG8_MMA(0, 1, At, B1); PG8_BAR; PG8_SCHED;
            PG8_LDA(At, 0, 1); PG8_STAGE(PG8_SB(0, 0), b2, voffB); PG8_STAGE(PG8_SB(0, 1), b2 + hstep, voffB); PG8_STAGE(PG8_SA(0, 0), a2, voffA);
            PG8_WAIT_V(8); PG8_WAIT_L(0); PG8_BAR; PG8_MMA(1, 0, At, B0); PG8_MMA(1, 1, At, B1); PG8_BAR; PG8_SCHED;
            PG8_LDB(B0, 1, 0); PG8_LDB(B1, 1, 1); PG8_SCHED; PG8_LDA(At, 1, 0); PG8_STAGE(PG8_SA(0, 1), a2 + hstep, voffA);
            PG8_WAIT_V(8); PG8_WAIT_L(0); PG8_BAR; PG8_MMA(0, 0, At, B0); PG8_MMA(0, 1, At, B1); PG8_BAR; PG8_SCHED;
            PG8_LDA(At, 1, 1); PG8_STAGE(PG8_SB(1, 0), b3, voffB); PG8_STAGE(PG8_SB(1, 1), b3 + hstep, voffB); PG8_STAGE(PG8_SA(1, 0), a3, voffA);
            PG8_WAIT_V(8); PG8_WAIT_L(0); PG8_BAR; PG8_MMA(1, 0, At, B0); PG8_MMA(1, 1, At, B1); PG8_BAR; PG8_SCHED;
        }
        if constexpr (ALIGN_EPI) { if (wr == 0) PG8_BAR; }
        E(acc, cur, wr, wc, fr, fq);
        if (!has_next) break;
#pragma unroll
        for (int a = 0; a < 2; ++a)
#pragma unroll
            for (int b = 0; b < 2; ++b)
#pragma unroll
                for (int m = 0; m < 4; ++m)
#pragma unroll
                    for (int n = 0; n < 2; ++n) acc[a][b][m][n] = (f32x4){0.f, 0.f, 0.f, 0.f};
        cur = nxt; cA = nA; cB = nB; ++ui;
        if constexpr (ALIGN_EPI) { if (wr == 1) PG8_BAR; }
    }
    PG8_WAIT_V(0);
    if constexpr (!ALIGN_EPI) { if (wr == 0) PG8_BAR; }
    PG8_BAR;
#undef PG8_SA
#undef PG8_SB
#undef PG8_STAGE
#undef PG8_LDA
#undef PG8_LDB
#undef PG8_MMA
#undef PG8_WAIT_V
#undef PG8_WAIT_L
#undef PG8_BAR
#undef PG8_SCHED
}
}
using pg8::Unit;

struct TileMap {
    int nM, nN;
    __device__ __forceinline__ bool get(long L, int& pm, int& pn) const {
        if (L >= (long)nM * nN) return false;
        const int nig = 8 * nN, gid = (int)(L / nig), fm = gid * 8, gsz = (nM - fm) < 8 ? (nM - fm) : 8, r = (int)(L % nig);
        pm = fm + r % gsz; pn = r / gsz; return true;
    }
};

struct Args {
    const float* in[38];
    float* out; unsigned char* ws;
    double inv_rev[32];
    int ph_lo, ph_hi;
};

__device__ __forceinline__ void tr_item(const float* W, int N, int src_n0, bf16_t* WT, size_t ldw, int koff, int r0, int k0, LAS float* scr, int lane) {
    if (src_n0 >= 0) {
#pragma unroll 8
        for (int i = 0; i < 32; ++i) { const int kk = 2 * i + (lane >> 5); scr[kk * 33 + (lane & 31)] = W[(size_t)(k0 + kk) * N + src_n0 + (lane & 31)]; }
    } else {
#pragma unroll 8
        for (int i = 0; i < 32; ++i) { const int kk = 2 * i + (lane >> 5); scr[kk * 33 + (lane & 31)] = 0.f; }
    }
    asm volatile("s_waitcnt lgkmcnt(0)" ::: "memory");
    const int c = lane & 7;
#pragma unroll
    for (int j = 0; j < 4; ++j) { const int n = (lane >> 3) + 8 * j; const LAS float* s = scr + (8 * c) * 33 + n;
        u32x4 o; o.x = cvt_pk_bf16(s[0 * 33], s[1 * 33]); o.y = cvt_pk_bf16(s[2 * 33], s[3 * 33]); o.z = cvt_pk_bf16(s[4 * 33], s[5 * 33]); o.w = cvt_pk_bf16(s[6 * 33], s[7 * 33]);
        *(u32x4*)(WT + (size_t)(r0 + n) * ldw + koff + k0 + 8 * c) = o; }
    asm volatile("s_waitcnt lgkmcnt(0)" ::: "memory");
}
__device__ __forceinline__ void rms_row(const float* xrow, const float* g, bf16_t* orow, int lane) {
    f32x4 v[8]; float s = 0.f;
#pragma unroll
    for (int j = 0; j < 8; ++j) { v[j] = ((const f32x4*)xrow)[64 * j + lane]; s += (v[j].x * v[j].x + v[j].y * v[j].y) + (v[j].z * v[j].z + v[j].w * v[j].w); }
    const float rstd = rsqrtf(wave_sum(s) * (1.f / DM) + 1e-6f);
#pragma unroll
    for (int j = 0; j < 8; ++j) { const f32x4 gg = ((const f32x4*)g)[64 * j + lane];
        u32x2 w; w.x = cvt_pk_bf16(v[j].x * rstd * gg.x, v[j].y * rstd * gg.y); w.y = cvt_pk_bf16(v[j].z * rstd * gg.z, v[j].w * rstd * gg.w);
        ((u32x2*)orow)[64 * j + lane] = w; }
}

__device__ __forceinline__ void p0_prologue(const Args& a, LAS unsigned char* lds, int vcu, int G) {
    const int tid = threadIdx.x, lane = tid & 63, wave = tid >> 6;
    unsigned char* ws = a.ws;
    LAS float* scr = (LAS float*)(lds + wave * 16384);
    const int gw = vcu * 8 + wave, NGW = G * 8;
    constexpr int I0 = 32 * 240, I1 = 32 * 192, I2 = 32 * 64, I3 = 16 * 64, I6 = 32 * 64, I7 = 32 * 352, I8 = 88 * 64;
    constexpr int NITEMS = I0 + I1 + I2 + 3 * I3 + I6 + I7 + I8;
    for (int it = gw; it < NITEMS; it += NGW) {
        int r = it;
        if (r < I0) { const int kb = r / 240, nb = r % 240, r0 = nb * 32; int src;
            if (r0 < 2048) { const int tile = r0 >> 8, cp = r0 & 255, h = cp >> 7, g = (cp & 127) >> 5; src = tile * 256 + 64 * g + 32 * h; }
            else if (r0 < 6560) src = r0;
            else if (r0 < 6656) src = -1;
            else src = 6560 + (r0 - 6656);
            tr_item(a.in[5], 13728, src, (bf16_t*)(ws + WS_WIN), 2048, 0, r0, kb * 64, scr, lane); continue; } r -= I0;
        if (r < I1) { const int kb = r / 192, nb = r % 192; tr_item(a.in[5], 13728, 7584 + nb * 32, (bf16_t*)(ws + WS_WG), 2048, 0, nb * 32, kb * 64, scr, lane); continue; } r -= I1;
        if (r < I2) { const int kb = r / 64, nb = r % 64; tr_item(a.in[26], 2048, nb * 32, (bf16_t*)(ws + WS_WKV), 2048, 0, nb * 32, kb * 64, scr, lane); continue; } r -= I2;
        if (r < I3) { const int kb = r / 64, nb = r % 64; tr_item(a.in[29], 2048, nb * 32, (bf16_t*)(ws + WS_PAR), 2048, 0, nb * 32, kb * 64, scr, lane); continue; } r -= I3;
        if (r < I3) { const int kb = r / 64, nb = r % 64; tr_item(a.in[30], 2048, nb * 32, (bf16_t*)(ws + WS_PAR), 2048, 1024, nb * 32, kb * 64, scr, lane); continue; } r -= I3;
        if (r < I3) { const int kb = r / 64, nb = r % 64; tr_item(a.in[31], 2048, nb * 32, (bf16_t*)(ws + WS_PM2), 2048, 0, nb * 32, kb * 64, scr, lane); continue; } r -= I3;
        if (r < I6) { const int kb = r / 64, nb = r % 64; tr_item(a.in[32], 2048, nb * 32, (bf16_t*)(ws + WS_WO), 2048, 0, nb * 32, kb * 64, scr, lane); continue; } r -= I6;
        if (r < I7) { const int kb = r / 352, nb = r % 352, r0 = nb * 32, tile = r0 >> 8, bj = (r0 & 255) >> 7, j = r0 & 127;
            tr_item(a.in[34], 2 * DFF, bj * DFF + 128 * tile + j, (bf16_t*)(ws + WS_WUP), 2048, 0, r0, kb * 64, scr, lane); continue; } r -= I7;
        { const int kb = r / 64, nb = r % 64; tr_item(a.in[37], 2048, nb * 32, (bf16_t*)(ws + WS_WDN), DFF, 0, nb * 32, kb * 64, scr, lane); }
    }
    for (int m = gw; m < NT + 1280; m += NGW) {
        if (m < NT) { const float* xr = m < TP ? a.in[0] + (size_t)m * DM : a.in[1] + (size_t)(m - TP) * DM; rms_row(xr, a.in[4], (bf16_t*)(ws + WS_H) + (size_t)m * DM, lane); }
        else { const int j = m - NT; const float* xr = j < 256 ? a.in[2] + (size_t)j * DM : a.in[3] + (size_t)(j - 256) * DM; rms_row(xr, a.in[25], (bf16_t*)(ws + WS_MEMN) + (size_t)j * DM, lane); }
    }
    { float* rc = (float*)(ws + WS_ROPE); float* rs = rc + TP * 32;
      for (int e = (vcu * NTHR + tid); e < TP * 32; e += G * NTHR) { const int t = e >> 5, d = e & 31; double rev = (double)t * a.inv_rev[d]; rev -= rint(rev); const float rf = (float)rev;
          rc[e] = __builtin_amdgcn_cosf(rf); rs[e] = __builtin_amdgcn_sinf(rf); } }
    { bf16_t* g2t = (bf16_t*)(ws + WS_G2T); const float* G2 = a.in[19];
      for (int e = vcu * NTHR + tid; e < 1024 * 20; e += G * NTHR) { const int col = e / 20, kc = e - col * 20; float f[8];
#pragma unroll
          for (int i = 0; i < 8; ++i) f[i] = G2[(size_t)(kc * 8 + i) * 1024 + col];
          u32x4 w; w.x = cvt_pk_bf16(f[0], f[1]); w.y = cvt_pk_bf16(f[2], f[3]); w.z = cvt_pk_bf16(f[4], f[5]); w.w = cvt_pk_bf16(f[6], f[7]);
          *(u32x4*)(g2t + (size_t)col * 160 + kc * 8) = w; } }
    if (blockIdx.x == 0) {
        unsigned* ctl = (unsigned*)(ws + WS_CTL);
        if (tid < 64) {
            if (tid == 0) { ctl[CW_QUEUE] = 0u; ctl[256] = 0u; ctl[257] = 0u; }
            const float s1 = wave_sum(a.in[8][tid] * a.in[9][tid]), s2 = wave_sum(a.in[10][tid] * a.in[11][tid]);
            if (tid == 0) ((float*)ctl)[CW_LAM] = __expf(s1) - __expf(s2) + 0.2f;
            float gq = fabsf(a.in[6][tid]), gk = fabsf(a.in[7][tid]);
#pragma unroll
            for (int o = 1; o < 64; o <<= 1) { gq = fmaxf(gq, __shfl_xor(gq, o)); gk = fmaxf(gk, __shfl_xor(gk, o)); }
            if (tid == 0) ((float*)ctl)[CW_SMAX] = 64.f * 0.125f * 1.4426950408889634f * gq * gk;
        }
    }
}

struct SchedIn {
    int v, G; const char* H; const char* WIN; const char* MEMN; const char* WKV;
    __device__ __forceinline__ bool next(int i, Unit& u) const {
        long L = (long)i * G + v; int pm, pn;
        if (L < 5760) { TileMap{192, 30}.get(L, pm, pn); u.A = H + (size_t)pm * MiB; u.B = WIN + (size_t)pn * MiB; u.nt = 32; u.pm = pm; u.pn = pn; u.kind = 0; u.t0 = 0; u.T = 0; return true; }
        L -= 5760; if (L < 40) { pm = (int)(L % 5); pn = (int)(L / 5); u.A = MEMN + (size_t)pm * MiB; u.B = WKV + (size_t)pn * MiB; u.nt = 32; u.pm = pm; u.pn = pn; u.kind = 1; u.t0 = 0; u.T = 0; return true; }
        return false;
    }
};
struct EpiIn {
    bf16_t* QK; bf16_t* VM; bf16_t* ZR; bf16_t* KVM; const float* qn; const float* kn; const float* rc; const float* rs;
    __device__ __forceinline__ void plain(const f32x4 (&acc)[2][2][4][2], bf16_t* base, size_t ldc, int row0, int col0) const {
#pragma unroll
        for (int ai = 0; ai < 2; ++ai)
#pragma unroll
            for (int m = 0; m < 4; ++m) { bf16_t* rowp = base + (size_t)(row0 + ai * 128 + m * 16) * ldc + col0;
#pragma unroll
                for (int bj = 0; bj < 2; ++bj) { const f32x4 v0 = acc[ai][bj][m][0], v1 = acc[ai][bj][m][1];
                    u32x4 w; w.x = cvt_pk_bf16(v0[0], v0[1]); w.y = cvt_pk_bf16(v0[2], v0[3]); w.z = cvt_pk_bf16(v1[0], v1[1]); w.w = cvt_pk_bf16(v1[2], v1[3]);
                    *(u32x4*)(rowp + bj * 128) = w; } }
    }
    __device__ __forceinline__ void operator()(const f32x4 (&acc)[2][2][4][2], const Unit& u, int wr, int wc, int fr, int fq) const {
        const int row0 = u.pm * 256 + wr * 64 + fr, cin = wc * 32 + 8 * fq;
        if (u.kind == 1) { plain(acc, KVM, 2048, row0, u.pn * 256 + cin); return; }
        const int pn = u.pn;
        if (pn < 8) {
            const bool isq = pn < 4; const float* nw = isq ? qn : kn;
            const int Gq = (pn & 3) * 4 + wc, d0 = 8 * fq;
            const float qs = isq ? 0.125f * 1.4426950408889634f : 1.f;
            const f32x4 w1a = *(const f32x4*)(nw + d0), w1b = *(const f32x4*)(nw + d0 + 4), w2a = *(const f32x4*)(nw + 32 + d0), w2b = *(const f32x4*)(nw + 36 + d0);
            bf16_t* dst = QK + (isq ? 0 : 1024) + Gq * 64 + d0;
#pragma unroll
            for (int ai = 0; ai < 2; ++ai)
#pragma unroll
                for (int m = 0; m < 4; ++m) {
                    const int row = row0 + ai * 128 + m * 16, t = tok_pos(row);
                    const f32x4 xa = acc[ai][0][m][0], xb = acc[ai][0][m][1], ya = acc[ai][1][m][0], yb = acc[ai][1][m][1];
                    float ss = (xa[0] * xa[0] + xa[1] * xa[1]) + (xa[2] * xa[2] + xa[3] * xa[3]) + (xb[0] * xb[0] + xb[1] * xb[1]) + (xb[2] * xb[2] + xb[3] * xb[3])
                             + (ya[0] * ya[0] + ya[1] * ya[1]) + (ya[2] * ya[2] + ya[3] * ya[3]) + (yb[0] * yb[0] + yb[1] * yb[1]) + (yb[2] * yb[2] + yb[3] * yb[3]);
                    ss += __shfl_xor(ss, 16); ss += __shfl_xor(ss, 32);
                    const float rstd = rsqrtf(ss * (1.f / 64.f) + 1e-6f);
                    const f32x4 ca = *(const f32x4*)(rc + t * 32 + d0), cb = *(const f32x4*)(rc + t * 32 + d0 + 4), sa = *(const f32x4*)(rs + t * 32 + d0), sb = *(const f32x4*)(rs + t * 32 + d0 + 4);
                    const f32x4 x1a = xa * rstd * w1a, x1b = xb * rstd * w1b, x2a = ya * rstd * w2a, x2b = yb * rstd * w2b;
                    const f32x4 o1a = (x1a * ca - x2a * sa) * qs, o1b = (x1b * cb - x2b * sb) * qs, o2a = (x2a * ca + x1a * sa) * qs, o2b = (x2b * cb + x1b * sb) * qs;
                    u32x4 w; w.x = cvt_pk_bf16(o1a[0], o1a[1]); w.y = cvt_pk_bf16(o1a[2], o1a[3]); w.z = cvt_pk_bf16(o1b[0], o1b[1]); w.w = cvt_pk_bf16(o1b[2], o1b[3]);
                    *(u32x4*)(dst + (size_t)row * 2048) = w;
                    w.x = cvt_pk_bf16(o2a[0], o2a[1]); w.y = cvt_pk_bf16(o2a[2], o2a[3]); w.z = cvt_pk_bf16(o2b[0], o2b[1]); w.w = cvt_pk_bf16(o2b[2], o2b[3]);
                    *(u32x4*)(dst + (size_t)row * 2048 + 32) = w;
                }
        } else if (pn < 12) plain(acc, VM, 2048, row0, (pn - 8) * 256 + cin);
        else if (pn < 26) plain(acc, ZR, ZRP, row0, (pn - 12) * 256 + cin);
        else plain(acc, VM, 2048, row0, 1024 + (pn - 26) * 256 + cin);
    }
};

namespace att {
constexpr int SHM_V = 16384, SHM_K = 8192;
constexpr int OFF_K = 0, OFF_V = 24576, OFF_WS = 73728, OFF_STASH = 75776;
#define KSWZ64(row, colB) ((row) * 128 + ((colB) ^ (((row) & 7) << 4)))
#define SBAR() __builtin_amdgcn_sched_barrier(0)
__device__ __forceinline__ int crow(int r, int hi) { return (r & 3) + 8 * (r >> 2) + 4 * hi; }
constexpr float THRL = 8.f;
__device__ __forceinline__ void partialSM(f32x16& p0, f32x16& p1, float& m_reg, float& alpha) {
    float pmax = fmaxf(fmaxf(p0[0], p0[1]), p0[2]);
#pragma unroll
    for (int r = 3; r < 15; r += 2) pmax = fmaxf(fmaxf(pmax, p0[r]), p0[r + 1]);
    pmax = fmaxf(fmaxf(pmax, p0[15]), p1[0]);
#pragma unroll
    for (int r = 1; r < 15; r += 2) pmax = fmaxf(fmaxf(pmax, p1[r]), p1[r + 1]);
    pmax = fmaxf(pmax, p1[15]);
    { auto rr = __builtin_amdgcn_permlane32_swap(__float_as_uint(pmax), __float_as_uint(pmax), false, false);
      pmax = fmaxf(__uint_as_float(rr[0]), __uint_as_float(rr[1])); }
    if (__builtin_expect(__all(pmax <= THRL), 1)) { alpha = 1.f; }
    else { const float dl = fmaxf(pmax, 0.f); alpha = __builtin_amdgcn_exp2f(-dl); m_reg += dl;
#pragma unroll
        for (int r = 0; r < 16; ++r) { p0[r] -= dl; p1[r] -= dl; } }
#pragma unroll
    for (int r = 0; r < 16; ++r) p0[r] = __builtin_amdgcn_exp2f(p0[r]);
}
__device__ __forceinline__ void finishSM(f32x16& p0, f32x16& p1, float alpha, float& l_reg, bf16x8& pa0, bf16x8& pa1, bf16x8& pa2, bf16x8& pa3) {
#pragma unroll
    for (int r = 0; r < 16; ++r) p1[r] = __builtin_amdgcn_exp2f(p1[r]);
    f32x2 s2 = (f32x2){p0[0], p0[1]} + (f32x2){p1[0], p1[1]};
#pragma unroll
    for (int r = 2; r < 16; r += 2) { s2 = s2 + (f32x2){p0[r], p0[r + 1]}; s2 = s2 + (f32x2){p1[r], p1[r + 1]}; }
    float ps = s2[0] + s2[1];
    { auto rr = __builtin_amdgcn_permlane32_swap(__float_as_uint(ps), __float_as_uint(ps), false, false);
      ps = __uint_as_float(rr[0]) + __uint_as_float(rr[1]); }
    l_reg = l_reg * alpha + ps;
#define PK4(P, BASE, OUT) do { unsigned a0 = cvt_pk_bf16(P[BASE + 0], P[BASE + 1]), a1 = cvt_pk_bf16(P[BASE + 2], P[BASE + 3]);   \
    unsigned b0 = cvt_pk_bf16(P[BASE + 4], P[BASE + 5]), b1 = cvt_pk_bf16(P[BASE + 6], P[BASE + 7]);                              \
    auto r0 = __builtin_amdgcn_permlane32_swap(a0, b0, false, false); auto r1 = __builtin_amdgcn_permlane32_swap(a1, b1, false, false); \
    u32x4 w = {r0[0], r1[0], r0[1], r1[1]}; OUT = *reinterpret_cast<bf16x8*>(&w); } while (0)
    PK4(p0, 0, pa0); PK4(p0, 8, pa1); PK4(p1, 0, pa2); PK4(p1, 8, pa3);
#undef PK4
}
__device__ __forceinline__ void qkt64(f32x16& p0, f32x16& p1, const char* Ks, const bf16x8* qr, int r32, int hi) {
#pragma unroll
    for (int d0 = 0; d0 < 4; ++d0) { const int cb = (d0 * 16 + hi * 8) * 2;
        const bf16x8 b0 = *reinterpret_cast<const bf16x8*>(Ks + KSWZ64(r32, cb));
        const bf16x8 b1 = *reinterpret_cast<const bf16x8*>(Ks + KSWZ64(32 + r32, cb));
        p0 = __builtin_amdgcn_mfma_f32_32x32x16_bf16(b0, qr[d0], p0, 0, 0, 0);
        p1 = __builtin_amdgcn_mfma_f32_32x32x16_bf16(b1, qr[d0], p1, 0, 0, 0); }
}
__device__ __forceinline__ int v_st(int k, int c) { const int kk = (k & ~0xC) | ((k & 4) << 1) | ((k & 8) >> 1); return ((kk >> 3) * 4 + (c >> 5)) * 512 + ((kk & 7) * 32 + (c & 31)) * 2; }
__device__ __forceinline__ int v_rd_base(int lane) { return ((lane & 3) << 3) | (((lane >> 2) & 3) << 6) | (((lane >> 4) & 1) << 5) | (((lane >> 5) & 1) << 8); }
constexpr int v_rd_off(int d0, int ks, int half) { return d0 * 512 + ks * 4096 + half * 2048; }
template <int OFF> __device__ __forceinline__ s16x4 tr_read(int vb) {
    s16x4 r; asm volatile("ds_read_b64_tr_b16 %0, %1 offset:%2" : "=&v"(r) : "v"(vb), "i"(OFF) : "memory"); return r;
}
struct VFrag { s16x4 l0, h0, l1, h1, l2, h2, l3, h3; };
template <int KS> __device__ __forceinline__ void pv_read(VFrag& f, int vb) {
    f.l0 = tr_read<v_rd_off(0, KS, 0)>(vb); f.h0 = tr_read<v_rd_off(0, KS, 1)>(vb); f.l1 = tr_read<v_rd_off(1, KS, 0)>(vb); f.h1 = tr_read<v_rd_off(1, KS, 1)>(vb);
    f.l2 = tr_read<v_rd_off(2, KS, 0)>(vb); f.h2 = tr_read<v_rd_off(2, KS, 1)>(vb); f.l3 = tr_read<v_rd_off(3, KS, 0)>(vb); f.h3 = tr_read<v_rd_off(3, KS, 1)>(vb);
}
__device__ __forceinline__ void pv_mma(f32x16* o, const VFrag& f, bf16x8 pa) {
#define PK(L, H) (bf16x8){L[0], L[1], L[2], L[3], H[0], H[1], H[2], H[3]}
    o[0] = __builtin_amdgcn_mfma_f32_32x32x16_bf16(pa, PK(f.l0, f.h0), o[0], 0, 0, 0);
    o[1] = __builtin_amdgcn_mfma_f32_32x32x16_bf16(pa, PK(f.l1, f.h1), o[1], 0, 0, 0);
    o[2] = __builtin_amdgcn_mfma_f32_32x32x16_bf16(pa, PK(f.l2, f.h2), o[2], 0, 0, 0);
    o[3] = __builtin_amdgcn_mfma_f32_32x32x16_bf16(pa, PK(f.l3, f.h3), o[3], 0, 0, 0);
#undef PK
}
__device__ __forceinline__ void pv_d0(f32x16* o, int vb, bf16x8 pa0, bf16x8 pa1, bf16x8 pa2, bf16x8 pa3) {
    VFrag fa, fb;
    pv_read<0>(fa, vb);
    pv_read<1>(fb, vb); asm volatile("s_waitcnt lgkmcnt(8)" ::: "memory"); SBAR(); pv_mma(o, fa, pa0); SBAR();
    pv_read<2>(fa, vb); asm volatile("s_waitcnt lgkmcnt(8)" ::: "memory"); SBAR(); pv_mma(o, fb, pa1); SBAR();
    pv_read<3>(fb, vb); asm volatile("s_waitcnt lgkmcnt(8)" ::: "memory"); SBAR(); pv_mma(o, fa, pa2); SBAR();
    asm volatile("s_waitcnt lgkmcnt(0)" ::: "memory"); SBAR(); pv_mma(o, fb, pa3);
}

__device__ __forceinline__ void stash_store(const unsigned* stash, bf16_t* Ow, int ldo, int lane) {
#pragma unroll
    for (int i = 0; i < 8; ++i) { const int q = i * 64 + lane, rl = q >> 4, c8 = (q & 15) * 8, hh = (rl >> 2) & 1, r = (rl & 3) + 4 * (rl >> 3), d0 = c8 >> 5, cc = c8 & 31;
        const unsigned* sp = stash + (d0 * 8 + (r >> 1)) * 64 + hh * 32 + cc; const u32x4 a = *(const u32x4*)sp, b = *(const u32x4*)(sp + 4);
        u32x4 w;
        if (r & 1) { w.x = (a.x >> 16) | (a.y & 0xffff0000u); w.y = (a.z >> 16) | (a.w & 0xffff0000u); w.z = (b.x >> 16) | (b.y & 0xffff0000u); w.w = (b.z >> 16) | (b.w & 0xffff0000u); }
        else { w.x = (a.x & 0xffffu) | (a.y << 16); w.y = (a.z & 0xffffu) | (a.w << 16); w.z = (b.x & 0xffffu) | (b.y << 16); w.w = (b.z & 0xffffu) | (b.w << 16); }
        *(u32x4*)(Ow + (size_t)rl * ldo + c8) = w; }
}

template <bool FX> __device__ __forceinline__ void diff_unit(int s, int h, int qb, bf16_t* QK, const bf16_t* VM, float lam, char* lds, LAS unsigned char* ldsl) {
    constexpr int LDK = 2048;
    int tid = threadIdx.x; asm volatile("" : "+v"(tid));
    const int wid = __builtin_amdgcn_readfirstlane(tid >> 6), lane = tid & 63, r32 = lane & 31, hi = lane >> 5;
    const int tok0 = seq_start(s), T = seq_len(s), NTL = T / 64;
    char* V_lds = lds + OFF_V; char* K_lds = lds + OFF_K;
    float* wsf = (float*)(lds + OFF_WS) + wid * 64; float* li_l = wsf; float* al_l = wsf + 32;
    unsigned* stash = (unsigned*)(lds + OFF_STASH) + wid * 2048;
    const int vb0 = (int)(uintptr_t)V_lds + v_rd_base(lane);
    const bf16_t* Vh = VM + (size_t)tok0 * LDK + h * 128;
    const size_t qrow = (size_t)(tok0 + qb * 256 + wid * 32);
    const unsigned ksrc = (unsigned)((wid * 8 + (lane >> 3)) * LDK + (((lane & 7) ^ (lane >> 3)) << 3)) * 2u;
    unsigned vsrc[2];
#pragma unroll
    for (int i = 0; i < 2; ++i) { const int st = 2 * (2 * wid + i) + (lane >> 5), kk = (st >> 2) * 8 + ((lane & 31) >> 2), k = (kk & ~0xC) | ((kk & 4) << 1) | ((kk & 8) >> 1), cc = (st & 3) * 32 + (lane & 3) * 8;
        vsrc[i] = (unsigned)(k * LDK + cc) * 2u; }
#pragma unroll 1
    for (int c = 0; c < 2; ++c) {
        const bf16_t* Kh = QK + (size_t)tok0 * LDK + 1024 + h * 128 + c * 64;
        const bf16_t* Qw = QK + (qrow + r32) * LDK + h * 128 + c * 64 + hi * 8;
        bf16x8 qr[4];
#pragma unroll
        for (int d0 = 0; d0 < 4; ++d0) qr[d0] = *reinterpret_cast<const bf16x8*>(Qw + d0 * 16);
        float m_reg = 0.f, l_reg = 0; f32x16 o[4] = {};
#define NEGM(P) do { const float nm_ = FX ? 0.f : -m_reg; _Pragma("unroll") for (int r_ = 0; r_ < 16; ++r_) P[r_] = nm_; } while (0)
#define PSM(P0, P1, AL) do { if constexpr (FX) { AL = 1.f; _Pragma("unroll") for (int r_ = 0; r_ < 16; ++r_) P0[r_] = __builtin_amdgcn_exp2f(P0[r_]); } else partialSM(P0, P1, m_reg, AL); } while (0)
#define DMA_K(t, slotB) __builtin_amdgcn_global_load_lds((const unsigned*)((const char*)(Kh + (size_t)(t) * 64 * LDK) + ksrc), (LAS unsigned*)(ldsl + OFF_K + (slotB) * SHM_K + wid * 1024), 16, 0, 0)
#define DMA_V(t, slotB) do { __builtin_amdgcn_global_load_lds((const unsigned*)((const char*)(Vh + (size_t)(t) * 64 * LDK) + vsrc[0]), (LAS unsigned*)(ldsl + OFF_V + (slotB) * SHM_V + (2 * wid) * 1024), 16, 0, 0); \
    __builtin_amdgcn_global_load_lds((const unsigned*)((const char*)(Vh + (size_t)(t) * 64 * LDK) + vsrc[1]), (LAS unsigned*)(ldsl + OFF_V + (slotB) * SHM_V + (2 * wid + 1) * 1024), 16, 0, 0); } while (0)
#define WAITB(n) asm volatile("s_waitcnt vmcnt(" #n ") lgkmcnt(0)\n\ts_barrier" ::: "memory")
#define RESC(a) do { if (!FX && __any((a) < 1.f)) { if (hi == 0) al_l[r32] = (a); asm volatile("s_waitcnt lgkmcnt(0)" ::: "memory"); \
    _Pragma("unroll") for (int d = 0; d < 4; ++d) _Pragma("unroll") for (int r = 0; r < 16; ++r) o[d][r] *= al_l[crow(r, hi)]; } } while (0)
#define SEG(X0, X1, ALX, Y0, Y1, ALY, sg) do { \
        SBAR(); NEGM(X0); NEGM(X1); qkt64(X0, X1, K_lds + sl_c * SHM_K, qr, r32, hi); \
        finishSM(Y0, Y1, ALY, l_reg, pa0, pa1, pa2, pa3); SBAR(); \
        if ((sg) + 2 < NTL) DMA_K((sg) + 2, sl_p); if ((sg) + 1 < NTL) DMA_V((sg) + 1, sl_n); SBAR(); \
        pv_d0(o, vb0 + sl_p * SHM_V, pa0, pa1, pa2, pa3); PSM(X0, X1, ALX); \
        RESC(ALX); \
        if ((sg) + 2 < NTL) WAITB(3); else if ((sg) + 1 < NTL) WAITB(2); else WAITB(0); \
        { const int t_ = sl_p; sl_p = sl_c; sl_c = sl_n; sl_n = t_; } } while (0)
        f32x16 pA0, pA1, pB0, pB1; float alA, alB; bf16x8 pa0, pa1, pa2, pa3;
        int sl_p = 2, sl_c = 0, sl_n = 1;
        DMA_K(0, 0); DMA_V(0, 0); DMA_K(1, 1);
        WAITB(1);
        DMA_K(2, 2); DMA_V(1, 1);
        NEGM(pA0); NEGM(pA1); qkt64(pA0, pA1, K_lds, qr, r32, hi); PSM(pA0, pA1, alA);
        WAITB(3);
        { sl_p = 0; sl_c = 1; sl_n = 2; }
        for (int j = 1; j + 1 < NTL; j += 2) {
            SEG(pB0, pB1, alB, pA0, pA1, alA, j);
            SEG(pA0, pA1, alA, pB0, pB1, alB, j + 1);
        }
        SEG(pB0, pB1, alB, pA0, pA1, alA, NTL - 1);
        finishSM(pB0, pB1, alB, l_reg, pa0, pa1, pa2, pa3); SBAR();
        pv_d0(o, vb0 + sl_p * SHM_V, pa0, pa1, pa2, pa3);
#undef SEG
#undef DMA_K
#undef DMA_V
#undef WAITB
#undef RESC
#undef NEGM
#undef PSM
        if (hi == 0) li_l[r32] = l_reg; asm volatile("s_waitcnt lgkmcnt(0)" ::: "memory");
        float rli[16];
#pragma unroll
        for (int r = 0; r < 16; ++r) rli[r] = __builtin_amdgcn_rcpf(li_l[crow(r, hi)]);
        { const float coef = c == 0 ? 1.f : -lam;
#pragma unroll
          for (int d0 = 0; d0 < 4; ++d0)
#pragma unroll
              for (int r = 0; r < 16; r += 2) { const int idx = (d0 * 8 + (r >> 1)) * 64 + lane; const unsigned w = c == 0 ? 0u : stash[idx];
                  stash[idx] = cvt_pk_bf16(bflo(w) + coef * o[d0][r] * rli[r], bfhi(w) + coef * o[d0][r + 1] * rli[r + 1]); } }
        __syncthreads();
    }
    stash_store(stash, QK + qrow * LDK + h * 128, LDK, lane);
    __syncthreads();
}

constexpr int MOFF_V = 0, MOFF_K = 32768, MOFF_WS = 65536, MOFF_RK = 67584, MOFF_G = 68608, MOFF_STASH = 69632;
__device__ __forceinline__ void mem_unit(int s, int mh, int qb, bf16_t* VM, const bf16_t* KVM, const float* mqn, const float* mkn, char* lds) {
    int tid = threadIdx.x; asm volatile("" : "+v"(tid));
    const int wid = __builtin_amdgcn_readfirstlane(tid >> 6), lane = tid & 63, r32 = lane & 31, hi = lane >> 5;
    const int tok0 = seq_start(s);
    char* V_lds = lds + MOFF_V; char* K_lds = lds + MOFF_K;
    float* wsf = (float*)(lds + MOFF_WS) + wid * 64; float* li_l = wsf; float* al_l = wsf + 32;
    float* rk_l = (float*)(lds + MOFF_RK); float* g_l = (float*)(lds + MOFF_G);
    const bf16_t* Kh = KVM + (size_t)(s * 256) * 2048 + mh * 256;
    const bf16_t* Vh = KVM + (size_t)(s * 256) * 2048 + 1024 + mh * 256;
    if (tid < 256) g_l[tid] = mqn[tid] * mkn[tid];
    {
        const bf16_t* kp = Kh + (size_t)(wid * 32 + r32) * 2048 + hi * 128; float ss = 0.f;
#pragma unroll
        for (int i = 0; i < 16; ++i) { const u32x4 w = *(const u32x4*)(kp + i * 8);
            ss += bflo(w.x) * bflo(w.x) + bfhi(w.x) * bfhi(w.x) + bflo(w.y) * bflo(w.y) + bfhi(w.y) * bfhi(w.y) + bflo(w.z) * bflo(w.z) + bfhi(w.z) * bfhi(w.z) + bflo(w.w) * bflo(w.w) + bfhi(w.w) * bfhi(w.w); }
        ss += __shfl_xor(ss, 32);
        if (hi == 0) rk_l[wid * 32 + r32] = rsqrtf(ss * (1.f / 256.f) + 1e-6f);
    }
    const size_t qrow = (size_t)(tok0 + qb * 256 + wid * 32);
    bf16_t* Qw = VM + (qrow + r32) * 2048 + 1024 + mh * 256 + hi * 8;
    float rqC;
    { float ss = 0.f;
#pragma unroll
      for (int i = 0; i < 16; ++i) { const u32x4 w = *(const u32x4*)(Qw + i * 16);
          ss += bflo(w.x) * bflo(w.x) + bfhi(w.x) * bfhi(w.x) + bflo(w.y) * bflo(w.y) + bfhi(w.y) * bfhi(w.y) + bflo(w.z) * bflo(w.z) + bfhi(w.z) * bfhi(w.z) + bflo(w.w) * bflo(w.w) + bfhi(w.w) * bfhi(w.w); }
      ss += __shfl_xor(ss, 32);
      rqC = rsqrtf(ss * (1.f / 256.f) + 1e-6f) * (0.0625f * 1.4426950408889634f); }
    const int sr = tid >> 4, sc = (tid & 15) * 8, vst0 = v_st(sr, sc), vst1 = v_st(32 + sr, sc);
    const int kr = tid >> 3, kc = (tid & 7) * 8, kst = KSWZ64(kr, kc * 2);
    const int vb0 = (int)(uintptr_t)V_lds + v_rd_base(lane);
    unsigned* stash = (unsigned*)(lds + MOFF_STASH) + wid * 2048;
    __syncthreads();
#pragma unroll 1
    for (int hv = 0; hv < 2; ++hv) {
    float m_reg = -1e30f, l_reg = 0.f; f32x16 o[4] = {};
#pragma unroll 1
    for (int t = 0; t < 4; ++t) {
        const int k0 = t * 64;
#pragma unroll
        for (int ds = 0; ds < 4; ++ds) { const u32x4 w = *(const u32x4*)(Kh + (size_t)(k0 + kr) * 2048 + ds * 64 + kc); const float* g = g_l + ds * 64 + kc;
            u32x4 o4; o4.x = cvt_pk_bf16(bflo(w.x) * g[0], bfhi(w.x) * g[1]); o4.y = cvt_pk_bf16(bflo(w.y) * g[2], bfhi(w.y) * g[3]);
            o4.z = cvt_pk_bf16(bflo(w.z) * g[4], bfhi(w.z) * g[5]); o4.w = cvt_pk_bf16(bflo(w.w) * g[6], bfhi(w.w) * g[7]);
            *(u32x4*)(K_lds + ds * 8192 + kst) = o4; asm volatile("" ::: "memory"); }
        *(u32x4*)(V_lds + vst0) = *(const u32x4*)(Vh + (size_t)(k0 + sr) * 2048 + hv * 128 + sc);
        *(u32x4*)(V_lds + vst1) = *(const u32x4*)(Vh + (size_t)(k0 + 32 + sr) * 2048 + hv * 128 + sc);
        __syncthreads();
        f32x16 p0 = {}, p1 = {};
#pragma unroll
        for (int ds = 0; ds < 4; ++ds) { bf16x8 qr[4];
#pragma unroll
            for (int d0 = 0; d0 < 4; ++d0) qr[d0] = *reinterpret_cast<const bf16x8*>(Qw + ds * 64 + d0 * 16);
            qkt64(p0, p1, K_lds + ds * 8192, qr, r32, hi); }
#pragma unroll
        for (int r = 0; r < 16; ++r) { p0[r] *= rk_l[k0 + crow(r, hi)] * rqC; p1[r] *= rk_l[k0 + 32 + crow(r, hi)] * rqC; }
        float pmax = p0[0];
#pragma unroll
        for (int r = 1; r < 16; ++r) pmax = fmaxf(pmax, p0[r]);
#pragma unroll
        for (int r = 0; r < 16; ++r) pmax = fmaxf(pmax, p1[r]);
        pmax = fmaxf(pmax, __shfl_xor(pmax, 32));
        const float mn = fmaxf(m_reg, pmax), alpha = __builtin_amdgcn_exp2f(m_reg - mn); m_reg = mn;
        float ps = 0.f;
#pragma unroll
        for (int r = 0; r < 16; ++r) { p0[r] = __builtin_amdgcn_exp2f(p0[r] - mn); p1[r] = __builtin_amdgcn_exp2f(p1[r] - mn); ps += p0[r] + p1[r]; }
        ps += __shfl_xor(ps, 32);
        l_reg = l_reg * alpha + ps;
        if (hi == 0) al_l[r32] = alpha; asm volatile("s_waitcnt lgkmcnt(0)" ::: "memory");
#pragma unroll
        for (int d = 0; d < 4; ++d)
#pragma unroll
            for (int r = 0; r < 16; ++r) o[d][r] *= al_l[crow(r, hi)];
        bf16x8 pa0, pa1, pa2, pa3;
#define PK4(P, BASE, OUT) do { unsigned a0 = cvt_pk_bf16(P[BASE + 0], P[BASE + 1]), a1 = cvt_pk_bf16(P[BASE + 2], P[BASE + 3]);   \
    unsigned b0 = cvt_pk_bf16(P[BASE + 4], P[BASE + 5]), b1 = cvt_pk_bf16(P[BASE + 6], P[BASE + 7]);                              \
    auto r0 = __builtin_amdgcn_permlane32_swap(a0, b0, false, false); auto r1 = __builtin_amdgcn_permlane32_swap(a1, b1, false, false); \
    u32x4 w = {r0[0], r1[0], r0[1], r1[1]}; OUT = *reinterpret_cast<bf16x8*>(&w); } while (0)
        PK4(p0, 0, pa0); PK4(p0, 8, pa1); PK4(p1, 0, pa2); PK4(p1, 8, pa3);
#undef PK4
        pv_d0(o, vb0, pa0, pa1, pa2, pa3);
        __syncthreads();
    }
    if (hi == 0) li_l[r32] = l_reg; asm volatile("s_waitcnt lgkmcnt(0)" ::: "memory");
    if (hv == 1) stash_store(stash, VM + qrow * 2048 + 1024 + mh * 256, 2048, lane);
#pragma unroll
    for (int d0 = 0; d0 < 4; ++d0)
#pragma unroll
        for (int r = 0; r < 16; r += 2) stash[(d0 * 8 + (r >> 1)) * 64 + lane] = cvt_pk_bf16(o[d0][r] * __builtin_amdgcn_rcpf(li_l[crow(r, hi)]), o[d0][r + 1] * __builtin_amdgcn_rcpf(li_l[crow(r + 1, hi)]));
    }
    stash_store(stash, VM + qrow * 2048 + 1024 + mh * 256 + 128, 2048, lane);
    __syncthreads();
}
#undef SBAR
}

namespace scan {
constexpr int TC = 32;
typedef _Float16 h2 __attribute__((ext_vector_type(2)));
typedef _Float16 h4 __attribute__((ext_vector_type(4)));
typedef _Float16 h8 __attribute__((ext_vector_type(8)));
constexpr int BUFB = 36864, O_R = 0, O_KD = 4096, O_KK = 8192, O_W = 12288, O_KA = 16384, O_V = 20480, O_Y = 28672;
constexpr int O_PRIV = 73728;
constexpr int O_TBL = 73728 + 32768;
__device__ __forceinline__ float dpp_red8(float x) {
    x += __uint_as_float(__builtin_amdgcn_update_dpp(0u, __float_as_uint(x), 0xB1, 0xf, 0xf, false));
    x += __uint_as_float(__builtin_amdgcn_update_dpp(0u, __float_as_uint(x), 0x4E, 0xf, 0xf, false));
    x += __uint_as_float(__builtin_amdgcn_update_dpp(0u, __float_as_uint(x), 0x141, 0xf, 0xf, false));
    return x;
}
template <int DIR> __device__ __forceinline__ void scan_chunk(const char* B_, h2 (&S)[2][4], int seg, int row0) {
    const char* base = B_ + seg * 16; const char* vbase = B_ + O_V + row0 * 4; char* ybase = (char*)B_ + O_Y + row0 * 4;
    u32x4 ck[2], cw[2], ca[2], cd[2], cr[2]; u32x2 cv[2];
#define LDSET(set, tl_) do { ck[set] = *(const u32x4*)(base + O_KK + (tl_) * 128); cw[set] = *(const u32x4*)(base + O_W + (tl_) * 128); ca[set] = *(const u32x4*)(base + O_KA + (tl_) * 128); \
    cd[set] = *(const u32x4*)(base + O_KD + (tl_) * 128); cr[set] = *(const u32x4*)(base + O_R + (tl_) * 128); cv[set] = *(const u32x2*)(vbase + (tl_) * 256); } while (0)
#define H2(u) __builtin_bit_cast(h2, (u))
    LDSET(0, DIR ? TC - 1 : 0);
#pragma unroll
    for (int st = 0; st < TC; ++st) {
        const int tl = DIR ? TC - 1 - st : st, cs = st & 1;
        if (st + 1 < TC) LDSET(cs ^ 1, DIR ? TC - 2 - st : st + 1);
#define SPLIT4(V, A0, A1, A2, A3) const h8 V##8 = __builtin_bit_cast(h8, V[cs]); const h2 A0 = __builtin_shufflevector(V##8, V##8, 0, 1), A1 = __builtin_shufflevector(V##8, V##8, 2, 3), \
    A2 = __builtin_shufflevector(V##8, V##8, 4, 5), A3 = __builtin_shufflevector(V##8, V##8, 6, 7)
        SPLIT4(ck, k0, k1, k2, k3); SPLIT4(cw, w0, w1, w2, w3); SPLIT4(ca, a0, a1, a2, a3); SPLIT4(cd, d0, d1, d2, d3); SPLIT4(cr, r0, r1, r2, r3);
#undef SPLIT4
        const h4 cv4 = __builtin_bit_cast(h4, cv[cs]);
        f32x2 yo;
#pragma unroll
        for (int h = 0; h < 2; ++h) {
            const h2 vv = h == 0 ? __builtin_shufflevector(cv4, cv4, 0, 1) : __builtin_shufflevector(cv4, cv4, 2, 3);
            float d = __builtin_amdgcn_fdot2(S[h][0], k0, 0.f, false); float e = __builtin_amdgcn_fdot2(S[h][2], k2, 0.f, false);
            d = __builtin_amdgcn_fdot2(S[h][1], k1, d, false); e = __builtin_amdgcn_fdot2(S[h][3], k3, e, false);
            d = dpp_red8(d + e);
            const h2 p0 = S[h][0] * w0 + vv * d0, p1 = S[h][1] * w1 + vv * d1, p2 = S[h][2] * w2 + vv * d2, p3 = S[h][3] * w3 + vv * d3;
            const _Float16 sh = (_Float16)(-d); const h2 sa = {sh, sh};
            S[h][0] = p0 + sa * a0; S[h][1] = p1 + sa * a1; S[h][2] = p2 + sa * a2; S[h][3] = p3 + sa * a3;
            float y = __builtin_amdgcn_fdot2(S[h][0], r0, 0.f, false); float z = __builtin_amdgcn_fdot2(S[h][2], r2, 0.f, false);
            y = __builtin_amdgcn_fdot2(S[h][1], r1, y, false); z = __builtin_amdgcn_fdot2(S[h][3], r3, z, false);
            yo[h] = dpp_red8(y + z);
        }
        if (seg == 0) *(f32x2*)(ybase + tl * 256) = yo;
    }
#undef LDSET
#undef H2
}
__device__ __forceinline__ unsigned pkh(float a, float b) { const h2 v = {(_Float16)a, (_Float16)b}; return __builtin_bit_cast(unsigned, v); }
struct P {
    const bf16_t* ZR; bf16_t* YB; float* BON;
    const float *mup, *mun, *w0, *w2, *a0, *a2, *kk_w, *ka_w, *rk_w;
};
__device__ __forceinline__ void job(int s, int dir, int head, const P& p, char* lds) {
    int tid = threadIdx.x; asm volatile("" : "+v"(tid));
    const int wid = __builtin_amdgcn_readfirstlane(tid >> 6), lane = tid & 63;
    const int tok0 = seq_start(s), T = seq_len(s), NCH = T / TC;
    float* TBL = (float*)(lds + O_TBL);
    float* MUP = TBL; float* MUN = TBL + 320; float* KKW = TBL + 640; float* KAW = TBL + 704; float* RKW = TBL + 768; float* BW = TBL + 832; float* BA = TBL + 896;
    __syncthreads();
    if (tid < 320) { const int which = tid >> 6, j = tid & 63; const int col = which < 3 ? which * 1024 + head * 64 + j : (which == 3 ? 3072 : 3200) + dir * 64 + j; MUP[tid] = p.mup[col]; MUN[tid] = p.mun[col]; }
    if (tid >= 320 && tid < 384) { const int j = tid - 320; KKW[j] = p.kk_w[head * 64 + j]; KAW[j] = p.ka_w[head * 64 + j]; RKW[j] = p.rk_w[head * 64 + j];
        BW[j] = p.w0[dir * 1024 + head * 64 + j]; BA[j] = p.a0[dir * 1024 + head * 64 + j]; }
    bf16_t* yb = p.YB + (size_t)dir * NT * 1024; float* bon = p.BON + (size_t)dir * NT * 16;
    if (wid >= 4) {
        const int pw = wid - 4;
        char* priv = lds + O_PRIV + pw * 8192;
        bf16_t* AWl = (bf16_t*)priv; bf16_t* AAl = AWl + 512; float* PK = (float*)(priv + 2048); float* PA = (float*)(priv + 4096); float* PR = (float*)(priv + 6144);
        bf16x8 Bf[2][4][2];
#pragma unroll
        for (int mat = 0; mat < 2; ++mat)
#pragma unroll
            for (int cbk = 0; cbk < 4; ++cbk)
#pragma unroll
                for (int ks = 0; ks < 2; ++ks) { const float* W2 = (mat == 0 ? p.w2 : p.a2) + (size_t)dir * 64 * 1024 + head * 64 + cbk * 16 + (lane & 15) + (size_t)(ks * 32 + (lane >> 4) * 8) * 1024;
                    float f[8];
#pragma unroll
                    for (int e = 0; e < 8; ++e) f[e] = W2[(size_t)e * 1024];
                    u32x4 w; w.x = cvt_pk_bf16(f[0], f[1]); w.y = cvt_pk_bf16(f[2], f[3]); w.z = cvt_pk_bf16(f[4], f[5]); w.w = cvt_pk_bf16(f[6], f[7]); Bf[mat][cbk][ks] = *reinterpret_cast<bf16x8*>(&w); }
        __syncthreads();
        const int pt = tid - 256;
        u32x4 zc[5], zm[5], zn[5];
#define PLOAD(cc) do { const int tf_ = dir ? T - TC * ((cc) + 1) : TC * (cc); \
    _Pragma("unroll") for (int k = 0; k < 5; ++k) { const int which = k, tl8 = lane >> 3, j0 = (lane & 7) * 8; \
        const int col = which < 3 ? which * 1024 + head * 64 + j0 : (which == 3 ? 3072 : 3200) + dir * 64 + j0; \
        const int t = tf_ + 8 * pw + tl8; const bf16_t* zp = p.ZR + (size_t)(tok0 + t) * ZRP + col; \
        zc[k] = *(const u32x4*)zp; zm[k] = (u32x4){0u, 0u, 0u, 0u}; zn[k] = (u32x4){0u, 0u, 0u, 0u}; \
        if (t > 0) zm[k] = *(const u32x4*)(zp - ZRP); \
        if (t < T - 1) zn[k] = *(const u32x4*)(zp + ZRP); } } while (0)
        PLOAD(0);
        for (int c = -1; c < NCH; ++c) {
            if (c >= 1) { const int cb_ = (c - 1) & 1, tf = dir ? T - TC * c : TC * (c - 1); const int tl = pt >> 3, c8 = (pt & 7) * 8;
                const float* yp = (const float*)(lds + cb_ * BUFB + O_Y) + tl * 64 + c8; const f32x4 y4 = *(const f32x4*)yp, y5 = *(const f32x4*)(yp + 4);
                u32x4 w; w.x = cvt_pk_bf16(y4[0], y4[1]); w.y = cvt_pk_bf16(y4[2], y4[3]); w.z = cvt_pk_bf16(y5[0], y5[1]); w.w = cvt_pk_bf16(y5[2], y5[3]);
                *(u32x4*)(yb + (size_t)(tok0 + tf + tl) * 1024 + head * 64 + c8) = w; }
            if (c + 1 < NCH) {
                const int nb = (c + 1) & 1, tfirst = dir ? T - TC * (c + 2) : TC * (c + 1);
                char* B_ = lds + nb * BUFB;
#pragma unroll
                for (int k = 0; k < 5; ++k) { const int which = k, tl8 = lane >> 3, j0 = (lane & 7) * 8, tl = 8 * pw + tl8;
                    const f32x4 mpa = *(const f32x4*)(MUP + which * 64 + j0), mpb = *(const f32x4*)(MUP + which * 64 + j0 + 4), mna = *(const f32x4*)(MUN + which * 64 + j0), mnb = *(const f32x4*)(MUN + which * 64 + j0 + 4);
                    const u32x4 z = zc[k], zmm = zm[k], znn = zn[k];
                    float v[8];
#define SH(i, zw, zmw, znw, lohi, mp_, mn_) { const float zz = lohi(zw), a_ = lohi(zmw), b_ = lohi(znw); v[i] = zz + mp_ * (a_ - zz) + mn_ * (b_ - zz); }
                    SH(0, z.x, zmm.x, znn.x, bflo, mpa[0], mna[0]) SH(1, z.x, zmm.x, znn.x, bfhi, mpa[1], mna[1]) SH(2, z.y, zmm.y, znn.y, bflo, mpa[2], mna[2]) SH(3, z.y, zmm.y, znn.y, bfhi, mpa[3], mna[3])
                    SH(4, z.z, zmm.z, znn.z, bflo, mpb[0], mnb[0]) SH(5, z.z, zmm.z, znn.z, bfhi, mpb[1], mnb[1]) SH(6, z.w, zmm.w, znn.w, bflo, mpb[2], mnb[2]) SH(7, z.w, zmm.w, znn.w, bfhi, mpb[3], mnb[3])
#undef SH
                    if (which < 2) { float* dst = (which == 0 ? PR : PK) + tl8 * 64 + j0;
                        *(f32x4*)dst = (f32x4){v[0], v[1], v[2], v[3]}; *(f32x4*)(dst + 4) = (f32x4){v[4], v[5], v[6], v[7]}; }
                    else if (which == 2) { unsigned* dst = (unsigned*)(B_ + O_V) + tl * 64 + j0;
                        *(u32x4*)dst = (u32x4){pkh(v[0], v[0]), pkh(v[1], v[1]), pkh(v[2], v[2]), pkh(v[3], v[3])}; *(u32x4*)(dst + 4) = (u32x4){pkh(v[4], v[4]), pkh(v[5], v[5]), pkh(v[6], v[6]), pkh(v[7], v[7])}; }
                    else { if (which == 3) {
#pragma unroll
                            for (int i = 0; i < 8; ++i) { const float e2 = __expf(2.f * v[i]); v[i] = 1.f - 2.f * __builtin_amdgcn_rcpf(e2 + 1.f); } }
                        u32x4 w; w.x = cvt_pk_bf16(v[0], v[1]); w.y = cvt_pk_bf16(v[2], v[3]); w.z = cvt_pk_bf16(v[4], v[5]); w.w = cvt_pk_bf16(v[6], v[7]);
                        *(u32x4*)((which == 3 ? AWl : AAl) + tl8 * 64 + j0) = w; }
                }
                if (c + 2 < NCH) PLOAD(c + 2);
                { const int tj = lane & 7, kq = lane >> 4;
#pragma unroll
                  for (int mat = 0; mat < 2; ++mat) { const bf16_t* Am = (mat == 0 ? AWl : AAl) + tj * 64 + kq * 8;
                      const bf16x8 y0 = *reinterpret_cast<const bf16x8*>(Am), y1 = *reinterpret_cast<const bf16x8*>(Am + 32);
#pragma unroll
                      for (int cbk = 0; cbk < 4; ++cbk) { f32x4 acc = {0.f, 0.f, 0.f, 0.f};
                          acc = __builtin_amdgcn_mfma_f32_16x16x32_bf16(Bf[mat][cbk][0], y0, acc, 0, 0, 0);
                          acc = __builtin_amdgcn_mfma_f32_16x16x32_bf16(Bf[mat][cbk][1], y1, acc, 0, 0, 0);
                          const int col = cbk * 16 + 4 * kq; const f32x4 bias = *(const f32x4*)((mat == 0 ? BW : BA) + col); f32x4 res;
#pragma unroll
                          for (int r = 0; r < 4; ++r) { const float u = acc[r] + bias[r];
                              const float sg = __builtin_amdgcn_rcpf(1.f + __expf(-u));
                              res[r] = mat == 0 ? __expf(-0.60653065971263342f * sg) : sg; }
                          if ((lane & 15) < 8) { if (mat == 0) *(u32x2*)((_Float16*)(B_ + O_W) + (8 * pw + tj) * 64 + col) = (u32x2){pkh(res[0], res[1]), pkh(res[2], res[3])};
                                                 else *(f32x4*)(PA + tj * 64 + col) = res; } } } }
                { const int t8 = lane >> 3, tl = 8 * pw + t8, c0 = (lane & 7) * 8; const int o = t8 * 64 + c0;
                  float bs = 0.f, ss = 0.f; f32x4 kr[2], k4[2], a4[2], r4[2];
#pragma unroll
                  for (int q = 0; q < 2; ++q) { k4[q] = *(const f32x4*)(PK + o + 4 * q); a4[q] = *(const f32x4*)(PA + o + 4 * q); r4[q] = *(const f32x4*)(PR + o + 4 * q);
                      kr[q] = k4[q] * *(const f32x4*)(KKW + c0 + 4 * q); ss += (kr[q][0] * kr[q][0] + kr[q][1] * kr[q][1]) + (kr[q][2] * kr[q][2] + kr[q][3] * kr[q][3]); }
                  ss = dpp_red8(ss);
                  const float inv = __builtin_amdgcn_rsqf(fmaxf(ss, 1e-24f));
                  f32x4 kk[2], kd[2], kka[2];
#pragma unroll
                  for (int q = 0; q < 2; ++q) { kk[q] = kr[q] * inv; kd[q] = k4[q] * (1.f + (a4[q] - 1.f) * *(const f32x4*)(KAW + c0 + 4 * q)); kka[q] = kk[q] * a4[q];
                      const f32x4 bb = r4[q] * kd[q] * *(const f32x4*)(RKW + c0 + 4 * q); bs += (bb[0] + bb[1]) + (bb[2] + bb[3]); }
                  const int oh = (tl * 64 + c0) * 2;
#define ST8(OFF, X) *(u32x4*)(B_ + (OFF) + oh) = (u32x4){pkh(X[0][0], X[0][1]), pkh(X[0][2], X[0][3]), pkh(X[1][0], X[1][1]), pkh(X[1][2], X[1][3])}
                  ST8(O_KK, kk); ST8(O_KD, kd); ST8(O_KA, kka); ST8(O_R, r4);
#undef ST8
                  bs = dpp_red8(bs);
                  if ((lane & 7) == 0) bon[(size_t)(tok0 + tfirst + tl) * 16 + head] = bs; }
            }
            asm volatile("s_waitcnt lgkmcnt(0)" ::: "memory"); __builtin_amdgcn_s_barrier(); asm volatile("" ::: "memory");
        }
#undef PLOAD
    } else {
        __syncthreads();
        const int row0 = wid * 16 + (lane >> 3) * 2, seg = lane & 7;
        h2 S[2][4];
#pragma unroll
        for (int h = 0; h < 2; ++h)
#pragma unroll
            for (int q = 0; q < 4; ++q) S[h][q] = (h2){(_Float16)0.f, (_Float16)0.f};
        asm volatile("s_waitcnt lgkmcnt(0)" ::: "memory"); __builtin_amdgcn_s_barrier(); asm volatile("" ::: "memory");
        for (int c = 0; c < NCH; ++c) {
            const char* B_ = lds + (c & 1) * BUFB;
            if (dir) scan_chunk<1>(B_, S, seg, row0); else scan_chunk<0>(B_, S, seg, row0);
            asm volatile("s_waitcnt lgkmcnt(0)" ::: "memory"); __builtin_amdgcn_s_barrier(); asm volatile("" ::: "memory");
        }
    }
    if (wid >= 4) {
        const int pt = tid - 256, c = NCH, cb_ = (c - 1) & 1, tf = dir ? T - TC * c : TC * (c - 1); const int tl = pt >> 3, c8 = (pt & 7) * 8;
        const float* yp = (const float*)(lds + cb_ * BUFB + O_Y) + tl * 64 + c8; const f32x4 y4 = *(const f32x4*)yp, y5 = *(const f32x4*)(yp + 4);
        u32x4 w; w.x = cvt_pk_bf16(y4[0], y4[1]); w.y = cvt_pk_bf16(y4[2], y4[3]); w.z = cvt_pk_bf16(y5[0], y5[1]); w.w = cvt_pk_bf16(y5[2], y5[3]);
        *(u32x4*)(yb + (size_t)(tok0 + tf + tl) * 1024 + head * 64 + c8) = w;
    }
    __syncthreads();
}
}

__device__ __forceinline__ void p4_post(const Args& a, char* lds, int vcu, int G) {
    const int tid = threadIdx.x, lane = tid & 63;
    unsigned char* ws = a.ws;
    const bf16_t* ZR = (const bf16_t*)a.out; bf16_t* QK = (bf16_t*)(ws + WS_QK);
    const bf16_t* Y0 = (const bf16_t*)(ws + WS_Y); const bf16_t* Y1 = Y0 + (size_t)NT * 1024;
    const float* BON = (const float*)(ws + WS_BON);
    const float* mup = a.in[13]; const float* mun = a.in[14]; const float* G2 = a.in[19]; const float* lnw = a.in[23]; const float* lnb = a.in[24]; const float* subg = a.in[12];
    bf16_t* SGh = (bf16_t*)lds; float* BL = (float*)(lds + 20480); bf16_t* GL = (bf16_t*)(lds + 24576);
    const bf16_t* G2T = (const bf16_t*)(ws + WS_G2T);
    const int wid = tid >> 6, r32 = lane & 31, hi = lane >> 5;
    for (int tile = vcu; tile < NT / 32; tile += G) {
        const int tk0 = tile * 32;
        __syncthreads();
        for (int it = tid; it < 32 * 20; it += NTHR) {
            const int tl = it / 20, j0 = (it % 20) * 8, col = 3328 + j0, tok = tk0 + tl, t = tok_pos(tok), T = tok < TP ? TP : TS;
            const bf16_t* zp = ZR + (size_t)tok * ZRP + col; const u32x4 z = *(const u32x4*)zp; u32x4 zm = {0u, 0u, 0u, 0u}, zn = {0u, 0u, 0u, 0u};
            if (t > 0) zm = *(const u32x4*)(zp - ZRP);
            if (t < T - 1) zn = *(const u32x4*)(zp + ZRP);
            float v[8];
            const f32x4 mpa = *(const f32x4*)(mup + col), mpb = *(const f32x4*)(mup + col + 4), mna = *(const f32x4*)(mun + col), mnb = *(const f32x4*)(mun + col + 4);
#define SH(i, zw, zmw, znw, lohi) { const float zz = lohi(zw), a_ = lohi(zmw), b_ = lohi(znw), mp_ = (i < 4 ? mpa[i & 3] : mpb[i & 3]), mn_ = (i < 4 ? mna[i & 3] : mnb[i & 3]); v[i] = sigmoidf_(zz + mp_ * (a_ - zz) + mn_ * (b_ - zz)); }
            SH(0, z.x, zm.x, zn.x, bflo) SH(1, z.x, zm.x, zn.x, bfhi) SH(2, z.y, zm.y, zn.y, bflo) SH(3, z.y, zm.y, zn.y, bfhi)
            SH(4, z.z, zm.z, zn.z, bflo) SH(5, z.z, zm.z, zn.z, bfhi) SH(6, z.w, zm.w, zn.w, bflo) SH(7, z.w, zm.w, zn.w, bfhi)
#undef SH
            { u32x4 w; w.x = cvt_pk_bf16(v[0], v[1]); w.y = cvt_pk_bf16(v[2], v[3]); w.z = cvt_pk_bf16(v[4], v[5]); w.w = cvt_pk_bf16(v[6], v[7]); *(u32x4*)(SGh + tl * 160 + j0) = w; }
        }
        { const int tl = tid >> 4, hd = tid & 15; BL[tid] = BON[(size_t)(tk0 + tl) * 16 + hd] + BON[(size_t)NT * 16 + (size_t)(tk0 + tl) * 16 + hd]; }
        { const int pr = tid >> 1, half = tid & 1, tl = pr >> 3, hd = pr & 7; bf16_t* op = QK + (size_t)(tk0 + tl) * 2048 + hd * 128 + half * 64;
          u32x4 w[8]; float ss = 0.f;
#pragma unroll
          for (int i = 0; i < 8; ++i) { w[i] = *(const u32x4*)(op + i * 8);
              ss += bflo(w[i].x) * bflo(w[i].x) + bfhi(w[i].x) * bfhi(w[i].x) + bflo(w[i].y) * bflo(w[i].y) + bfhi(w[i].y) * bfhi(w[i].y) + bflo(w[i].z) * bflo(w[i].z) + bfhi(w[i].z) * bfhi(w[i].z) + bflo(w[i].w) * bflo(w[i].w) + bfhi(w[i].w) * bfhi(w[i].w); }
          ss += __shfl_xor(ss, 1);
          const float rstd = rsqrtf(ss * (1.f / 128.f) + 1e-6f) * 0.8f; const float* sg = subg + half * 64;
#pragma unroll
          for (int i = 0; i < 8; ++i) { u32x4 o;
              o.x = cvt_pk_bf16(bflo(w[i].x) * rstd * sg[i * 8 + 0], bfhi(w[i].x) * rstd * sg[i * 8 + 1]); o.y = cvt_pk_bf16(bflo(w[i].y) * rstd * sg[i * 8 + 2], bfhi(w[i].y) * rstd * sg[i * 8 + 3]);
              o.z = cvt_pk_bf16(bflo(w[i].z) * rstd * sg[i * 8 + 4], bfhi(w[i].z) * rstd * sg[i * 8 + 5]); o.w = cvt_pk_bf16(bflo(w[i].w) * rstd * sg[i * 8 + 6], bfhi(w[i].w) * rstd * sg[i * 8 + 7]);
              *(u32x4*)(op + i * 8) = o; } }
        __syncthreads();
        { f32x16 gacc[4] = {};
#pragma unroll
          for (int ks = 0; ks < 10; ++ks) { const bf16x8 af = *reinterpret_cast<const bf16x8*>(SGh + r32 * 160 + ks * 16 + hi * 8);
#pragma unroll
              for (int cb = 0; cb < 4; ++cb) { const bf16x8 bfr = *reinterpret_cast<const bf16x8*>(G2T + (size_t)(wid * 128 + cb * 32 + r32) * 160 + ks * 16 + hi * 8);
                  gacc[cb] = __builtin_amdgcn_mfma_f32_32x32x16_bf16(af, bfr, gacc[cb], 0, 0, 0); } }
#pragma unroll
          for (int cb = 0; cb < 4; ++cb)
#pragma unroll
              for (int r = 0; r < 16; ++r) GL[(att::crow(r, hi)) * 1024 + wid * 128 + cb * 32 + r32] = (bf16_t)(cvt_pk_bf16(gacc[cb][r], gacc[cb][r]) & 0xffffu); }
        __syncthreads();
        const int c0 = tid * 2;
        const int hd = tid >> 5;
        const float lw0 = lnw[c0], lw1 = lnw[c0 + 1], lb0 = lnb[c0], lb1 = lnb[c0 + 1];
        const float mp0 = mup[2048 + c0], mp1 = mup[2048 + c0 + 1], mn0 = mun[2048 + c0], mn1 = mun[2048 + c0 + 1];
#pragma unroll
        for (int i = 0; i < 32; ++i) {
            const int tok = tk0 + i, t = tok_pos(tok), T = tok < TP ? TP : TS;
            const unsigned ya = *(const unsigned*)(Y0 + (size_t)tok * 1024 + c0), yb = *(const unsigned*)(Y1 + (size_t)tok * 1024 + c0);
            const float y0 = bflo(ya) + bflo(yb), y1 = bfhi(ya) + bfhi(yb);
            float s = y0 + y1, q = y0 * y0 + y1 * y1;
#pragma unroll
            for (int o = 16; o < 32; o <<= 1) { s += __shfl_xor(s, o); q += __shfl_xor(q, o); }
#define DPPADD(x, ctrl) x += __uint_as_float(__builtin_amdgcn_update_dpp(0u, __float_as_uint(x), ctrl, 0xf, 0xf, false))
            DPPADD(s, 0xB1); DPPADD(q, 0xB1); DPPADD(s, 0x4E); DPPADD(q, 0x4E); DPPADD(s, 0x141); DPPADD(q, 0x141); DPPADD(s, 0x140); DPPADD(q, 0x140);
#undef DPPADD
            const float mean = s * (1.f / 64.f), var = fmaxf(q * (1.f / 64.f) - mean * mean, 0.f), rstd = rsqrtf(var + 64e-5f);
            const bf16_t* zp = ZR + (size_t)tok * ZRP + 2048 + c0; const unsigned z = *(const unsigned*)zp;
            unsigned zm = 0u, zn = 0u;
            if (t > 0) zm = *(const unsigned*)(zp - ZRP);
            if (t < T - 1) zn = *(const unsigned*)(zp + ZRP);
            const float v0 = bflo(z) + mp0 * (bflo(zm) - bflo(z)) + mn0 * (bflo(zn) - bflo(z)), v1 = bfhi(z) + mp1 * (bfhi(zm) - bfhi(z)) + mn1 * (bfhi(zn) - bfhi(z));
            const float bo = BL[i * 16 + hd];
            const unsigned gg = *(const unsigned*)(GL + i * 1024 + c0);
            const float o0 = ((y0 - mean) * rstd * lw0 + lb0 + bo * v0) * bflo(gg), o1 = ((y1 - mean) * rstd * lw1 + lb1 + bo * v1) * bfhi(gg);
            *(unsigned*)(QK + (size_t)tok * 2048 + 1024 + c0) = cvt_pk_bf16(o0, o1);
        }
    }
    __syncthreads();
}

struct SchedMerge {
    int v, G; const char* H; const char* WG; const char* QK; const char* VM; const char* PAR; const char* PM2;
    __device__ __forceinline__ bool next(int i, Unit& u) const {
        const int ti = i / 6, kind = i - ti * 6; const long L = (long)ti * G + v; int pm, pn;
        if (!TileMap{192, 8}.get(L, pm, pn)) return false;
        u.pm = pm; u.pn = pn; u.kind = kind; u.t0 = 0; u.T = 0;
        const size_t bo = (size_t)pn * MiB;
        switch (kind) {
            case 0: u.A = H + (size_t)pm * MiB; u.B = WG + bo; u.nt = 32; break;
            case 1: u.A = QK + (size_t)pm * MiB; u.B = PAR + bo; u.nt = 16; break;
            case 2: u.A = H + (size_t)pm * MiB; u.B = WG + 8 * MiB + bo; u.nt = 32; break;
            case 3: u.A = QK + (size_t)pm * MiB + 2048; u.B = PAR + bo + 2048; u.nt = 16; break;
            case 4: u.A = H + (size_t)pm * MiB; u.B = WG + 16 * MiB + bo; u.nt = 32; break;
            default: u.A = VM + (size_t)pm * MiB + 2048; u.B = PM2 + bo; u.nt = 16; break;
        }
        return true;
    }
};
struct EpiMerge {
    u32x4* scrG; f32x4* scrP; bf16_t* MRG;
    __device__ __forceinline__ void operator()(const f32x4 (&acc)[2][2][4][2], const Unit& u, int wr, int wc, int fr, int fq) const {
        const int tid = threadIdx.x, kind = u.kind;
        u32x4* gp = scrG + tid; f32x4* pp = scrP + tid;
        if ((kind & 1) == 0) {
#pragma unroll
            for (int ai = 0; ai < 2; ++ai)
#pragma unroll
                for (int bj = 0; bj < 2; ++bj)
#pragma unroll
                    for (int m = 0; m < 4; ++m) { const f32x4 v0 = acc[ai][bj][m][0], v1 = acc[ai][bj][m][1]; u32x4 w;
                        w.x = cvt_pk_bf16(sigmoidf_(v0[0]), sigmoidf_(v0[1])); w.y = cvt_pk_bf16(sigmoidf_(v0[2]), sigmoidf_(v0[3]));
                        w.z = cvt_pk_bf16(sigmoidf_(v1[0]), sigmoidf_(v1[1])); w.w = cvt_pk_bf16(sigmoidf_(v1[2]), sigmoidf_(v1[3]));
                        *gp = w; gp += NTHR; asm volatile("" : "+v"(gp) :: "memory"); }
        } else {
            const int row0 = u.pm * 256 + wr * 64 + fr, col0 = u.pn * 256 + wc * 32 + 8 * fq;
#pragma unroll
            for (int ai = 0; ai < 2; ++ai)
#pragma unroll
                for (int bj = 0; bj < 2; ++bj) {
                    bf16_t* mp = MRG + (size_t)(row0 + ai * 128) * 2048 + col0 + bj * 128;
#pragma unroll
                    for (int m = 0; m < 4; ++m) { const u32x4 g = *gp;
                        f32x4 p0 = acc[ai][bj][m][0] * (f32x4){bflo(g.x), bfhi(g.x), bflo(g.y), bfhi(g.y)}, p1 = acc[ai][bj][m][1] * (f32x4){bflo(g.z), bfhi(g.z), bflo(g.w), bfhi(g.w)};
                        if (kind > 1) { p0 += pp[0]; p1 += pp[NTHR]; }
                        if (kind < 5) { pp[0] = p0; pp[NTHR] = p1; }
                        else { u32x4 w; w.x = cvt_pk_bf16(p0[0], p0[1]); w.y = cvt_pk_bf16(p0[2], p0[3]); w.z = cvt_pk_bf16(p1[0], p1[1]); w.w = cvt_pk_bf16(p1[2], p1[3]);
                            *(u32x4*)mp = w; }
                        gp += NTHR; pp += 2 * NTHR; mp += 16 * 2048; asm volatile("" : "+v"(gp), "+v"(pp), "+v"(mp) :: "memory"); } }
        }
    }
};

struct SchedSq {
    int v, G; const char* A; const char* B; size_t astep, bstep; int nt;
    __device__ __forceinline__ bool next(int i, Unit& u) const {
        const long L = (long)i * G + v; int pm, pn; if (!TileMap{192, 8}.get(L, pm, pn)) return false;
        u.A = A + (size_t)pm * astep; u.B = B + (size_t)pn * bstep; u.nt = nt; u.pm = pm; u.pn = pn; u.kind = 0; u.t0 = 0; u.T = 0; return true;
    }
};
struct EpiWo {
    const float* xp; const float* xs; float* out;
    __device__ __forceinline__ void operator()(const f32x4 (&acc)[2][2][4][2], const Unit& u, int wr, int wc, int fr, int fq) const {
        const int row0 = u.pm * 256 + wr * 64 + fr, col0 = u.pn * 256 + wc * 32 + 8 * fq;
#pragma unroll
        for (int ai = 0; ai < 2; ++ai)
#pragma unroll
            for (int m = 0; m < 4; ++m) { const int row = row0 + ai * 128 + m * 16;
                const float* xr = (row < TP ? xp + (size_t)row * DM : xs + (size_t)(row - TP) * DM) + col0; float* orow = out + (size_t)row * DM + col0;
#pragma unroll
                for (int bj = 0; bj < 2; ++bj) { const f32x4 x0 = *(const f32x4*)(xr + bj * 128), x1 = *(const f32x4*)(xr + bj * 128 + 4);
                    *(f32x4*)(orow + bj * 128) = x0 + acc[ai][bj][m][0]; *(f32x4*)(orow + bj * 128 + 4) = x1 + acc[ai][bj][m][1]; } }
    }
};
struct EpiDown {
    float* out;
    __device__ __forceinline__ void operator()(const f32x4 (&acc)[2][2][4][2], const Unit& u, int wr, int wc, int fr, int fq) const {
        const int row0 = u.pm * 256 + wr * 64 + fr, col0 = u.pn * 256 + wc * 32 + 8 * fq;
#pragma unroll
        for (int ai = 0; ai < 2; ++ai)
#pragma unroll
            for (int m = 0; m < 4; ++m) { float* orow = out + (size_t)(row0 + ai * 128 + m * 16) * DM + col0;
#pragma unroll
                for (int bj = 0; bj < 2; ++bj) { const f32x4 x0 = *(const f32x4*)(orow + bj * 128), x1 = *(const f32x4*)(orow + bj * 128 + 4);
                    *(f32x4*)(orow + bj * 128) = x0 + acc[ai][bj][m][0]; *(f32x4*)(orow + bj * 128 + 4) = x1 + acc[ai][bj][m][1]; } }
    }
};

struct SchedUp {
    int v, G; const char* HN; const char* WUP;
    __device__ __forceinline__ bool next(int i, Unit& u) const {
        const long L = (long)i * G + v; int pm, pn; if (!TileMap{197, 44}.get(L, pm, pn)) return false;
        int s, ti; if (pm < 65) { s = 0; ti = pm; } else { s = 1 + (pm - 65) / 33; ti = (pm - 65) % 33; }
        const int T = seq_len(s); int t0 = 254 * ti - 1; if (t0 > T - 255) t0 = T - 255;
        u.pm = seq_start(s); u.pn = pn; u.kind = 0; u.t0 = t0; u.T = T; u.nt = 32;
        u.A = HN + ((long)u.pm + t0) * 4096; u.B = WUP + (size_t)pn * MiB; return true;
    }
};
struct EpiUp {
    bf16_t* ACT; const float* cw; const float* cb; LAS float* xch;
    __device__ __forceinline__ void operator()(const f32x4 (&acc)[2][2][4][2], const Unit& u, int wr, int wc, int fr, int fq) const {
        const int lane = threadIdx.x & 63;
        const int cin = wc * 32 + 8 * fq;
#pragma unroll
        for (int ai = 0; ai < 2; ++ai) { const int rg = 2 * ai + wr;
#pragma unroll
            for (int bj = 0; bj < 2; ++bj)
#pragma unroll
                for (int n = 0; n < 2; ++n) {
                    if (fr == 0) *(LAS f32x4*)(xch + (rg * 2 + 0) * 256 + bj * 128 + cin + 4 * n) = acc[ai][bj][0][n];
                    if (fr == 15) *(LAS f32x4*)(xch + (rg * 2 + 1) * 256 + bj * 128 + cin + 4 * n) = acc[ai][bj][3][n]; } }
        asm volatile("s_waitcnt lgkmcnt(0)" ::: "memory"); __builtin_amdgcn_s_barrier(); asm volatile("" ::: "memory");
        const int gc = u.pn * 128 + cin;
#pragma unroll
        for (int n = 0; n < 2; ++n) {
            const int wcol = gc + 4 * n;
            const f32x4 g0 = *(const f32x4*)(cw + wcol), g1 = *(const f32x4*)(cw + 2 * DFF + wcol), g2 = *(const f32x4*)(cw + 4 * DFF + wcol), gb = *(const f32x4*)(cb + wcol);
            const f32x4 v0 = *(const f32x4*)(cw + DFF + wcol), v1 = *(const f32x4*)(cw + 3 * DFF + wcol), v2 = *(const f32x4*)(cw + 5 * DFF + wcol), vb = *(const f32x4*)(cb + DFF + wcol);
#pragma unroll
            for (int ai = 0; ai < 2; ++ai) { const int rg = 2 * ai + wr;
                bf16_t* ap = ACT + ((long)u.pm + u.t0 + 128 * ai + 64 * wr + fr) * DFF + gc + 4 * n;
#pragma unroll
                for (int m = 0; m < 4; ++m) {
                    const int j = 128 * ai + 64 * wr + 16 * m + fr, t = u.t0 + j;
                    f32x4 res;
#pragma unroll
                    for (int bj = 0; bj < 2; ++bj) {
                        const f32x4 cur = acc[ai][bj][m][n];
                        const f32x4 sp = (m > 0 && fr == 15) ? acc[ai][bj][m > 0 ? m - 1 : 0][n] : cur;
                        const f32x4 sn = (m < 3 && fr == 0) ? acc[ai][bj][m < 3 ? m + 1 : 3][n] : cur;
                        f32x4 pv, nv;
#pragma unroll
                        for (int i = 0; i < 4; ++i) { pv[i] = __uint_as_float(__builtin_amdgcn_update_dpp(0u, __float_as_uint(sp[i]), 0x121, 0xf, 0xf, false));
                                                       nv[i] = __uint_as_float(__builtin_amdgcn_update_dpp(0u, __float_as_uint(sn[i]), 0x12F, 0xf, 0xf, false)); }
                        if (m == 0) { const f32x4 xprev = rg > 0 ? *(const LAS f32x4*)(xch + ((rg - 1) * 2 + 1) * 256 + bj * 128 + cin + 4 * n) : (f32x4){0.f, 0.f, 0.f, 0.f}; if (fr == 0) pv = xprev; }
                        if (m == 3) { const f32x4 xnext = rg < 3 ? *(const LAS f32x4*)(xch + ((rg + 1) * 2 + 0) * 256 + bj * 128 + cin + 4 * n) : (f32x4){0.f, 0.f, 0.f, 0.f}; if (fr == 15) nv = xnext; }
                        if (t < 1) pv = (f32x4){0.f, 0.f, 0.f, 0.f};
                        if (t >= u.T - 1) nv = (f32x4){0.f, 0.f, 0.f, 0.f};
                        if (bj == 0) { const f32x4 cv = g0 * pv + g1 * cur + g2 * nv + gb; res = (f32x4){cv[0] * sigmoidf_(cv[0]), cv[1] * sigmoidf_(cv[1]), cv[2] * sigmoidf_(cv[2]), cv[3] * sigmoidf_(cv[3])}; }
                        else { const f32x4 cv = v0 * pv + v1 * cur + v2 * nv + vb; res = res * cv; }
                    }
                    if (j >= 1 && j <= 254) { u32x2 w; w.x = cvt_pk_bf16(res[0], res[1]); w.y = cvt_pk_bf16(res[2], res[3]); *(u32x2*)ap = w; }
                    ap += 16 * DFF; asm volatile("" : "+v"(ap) :: "memory");
                }
            }
        }
    }
};

constexpr int CW_BAR = 4096;
#define XB_TMO      128
#define XB_XCNT(j)  (256  + 64 * (j))
#define XB_XSUB(j)  (1280 + 64 * (j))
#define XB_XGEN(j)  (2304 + 64 * (j))
#define XB_TOP      3328
#define XB_TOPGEN   3392
#define XCD_BAR_WORDS 3456
#define XB_SPIN_CAP (1u << 18)

__device__ __forceinline__ unsigned xb_ld(unsigned* p)              { return __hip_atomic_load(p, __ATOMIC_RELAXED, __HIP_MEMORY_SCOPE_AGENT); }
__device__ __forceinline__ unsigned xb_add(unsigned* p, unsigned v) { return __hip_atomic_fetch_add(p, v, __ATOMIC_RELAXED, __HIP_MEMORY_SCOPE_AGENT); }
__device__ __forceinline__ unsigned xb_xcc_id() { return (unsigned)__builtin_amdgcn_s_getreg((3 << 11) | 20) & 0xFu; }
#define XB_SPIN(cond, bar) do { unsigned _sp = 0; while (cond) { __builtin_amdgcn_s_sleep(1); \
    if ((++_sp & 255u) == 0u) { if (xb_ld(&(bar)[XB_TMO])) break; if (_sp > XB_SPIN_CAP) { atomicAdd(&(bar)[XB_TMO], 1u); break; } } } } while (0)

struct XcdBarrier {
    unsigned* bar; unsigned x;
    volatile LAS unsigned* st;
};

__device__ __forceinline__ XcdBarrier xcd_barrier_post(unsigned* bar, volatile LAS unsigned* st) {
    XcdBarrier b; b.bar = bar; b.x = xb_xcc_id(); b.st = st;
    if (threadIdx.x == 0) (void)xb_add(&bar[XB_XCNT(b.x)], 1u);
    return b;
}
__device__ __forceinline__ void xcd_barrier_complete(unsigned* bar, unsigned x, unsigned& nloc, unsigned& nx) {
    const unsigned G = gridDim.x * gridDim.y * gridDim.z;
    unsigned sum, cnt, mine, sp = 0u;
    for (;;) {
        sum = 0u; cnt = 0u; mine = 0u;
#pragma unroll
        for (unsigned j = 0; j < 16; ++j) { const unsigned c = xb_ld(&bar[XB_XCNT(j)]); sum += c; cnt += (c > 0u) ? 1u : 0u; mine = (j == x) ? c : mine; }
        if (sum == G) break;
        __builtin_amdgcn_s_sleep(1);
        if ((++sp & 255u) == 0u) { if (xb_ld(&bar[XB_TMO])) break; if (sp > XB_SPIN_CAP) { atomicAdd(&bar[XB_TMO], 1u); break; } }
    }
    nloc = mine > 0u ? mine : 1u; nx = cnt > 0u ? cnt : 1u;
}

__device__ __forceinline__ void xcd_barrier(const XcdBarrier& b) {
    asm volatile("s_waitcnt vmcnt(0)" ::: "memory");
    __syncthreads();
    if (threadIdx.x == 0) {
        unsigned* bar = b.bar;
        __builtin_amdgcn_s_waitcnt(0);
        unsigned nloc = b.st[0], nx = b.st[1];
        if (nloc == 0u) { xcd_barrier_complete(bar, b.x, nloc, nx); b.st[0] = nloc; b.st[1] = nx; }
        const unsigned old = xb_add(&bar[XB_XSUB(b.x)], 1u);
        const unsigned gen = old / nloc;
        if (old + 1u == (gen + 1u) * nloc) {
            __builtin_amdgcn_fence(__ATOMIC_RELEASE, "agent");
            asm volatile("s_waitcnt vmcnt(0)" ::: "memory");
            const unsigned og = xb_add(&bar[XB_TOP], 1u);
            const unsigned tg = og / nx;
            if (og + 1u == (tg + 1u) * nx) xb_add(&bar[XB_TOPGEN], 1u);
            else XB_SPIN(xb_ld(&bar[XB_TOPGEN]) == tg, bar);
            __builtin_amdgcn_fence(__ATOMIC_ACQUIRE, "agent");
            xb_add(&bar[XB_XGEN(b.x)], 1u);
            asm volatile("s_waitcnt vmcnt(0)" ::: "memory");
        } else {
            XB_SPIN(xb_ld(&bar[XB_XGEN(b.x)]) == gen, bar);
            __builtin_amdgcn_fence(__ATOMIC_ACQUIRE, "agent");
            asm volatile("s_waitcnt vmcnt(0)" ::: "memory");
        }
    }
    __syncthreads();
}

__global__ void __launch_bounds__(NTHR, 2) enc_fwd(Args args) {
    extern __shared__ __attribute__((aligned(16))) unsigned char lds_raw[];
    cg::grid_group grid = cg::this_grid();
    LAS unsigned char* lds = (LAS unsigned char*)lds_raw;
    const int tid = threadIdx.x;
    const int G = gridDim.x, bx = blockIdx.x, vcu = (G % 8 == 0) ? (bx % 8) * (G / 8) + bx / 8 : bx;
    unsigned char* ws = args.ws;
    const int lo = args.ph_lo, hi = args.ph_hi;
    volatile LAS unsigned* xb_st = (volatile LAS unsigned*)(lds + LDS_MISC + 32);
    if (tid < 2) xb_st[tid] = 0u;
    __syncthreads();
#ifndef P2M
#define P2M 7
#endif
#ifndef PH_MASK
#define PH_MASK 0x1ff
#endif
#define IN(k) (((PH_MASK >> (k)) & 1) && lo <= (k) && (k) < hi)
#define SEAM(k) do { if (IN(k) && IN((k) + 1)) { if ((k) == 0) grid.sync(); else xcd_barrier(xbar); } } while (0)
#ifndef PROBE
#define PROBE 0
#endif
    unsigned long long tp0 = 0, tp1 = 0;
#define TSTAMP(v) do { if (PROBE) { v = __builtin_amdgcn_s_memrealtime(); } } while (0)

    if (IN(0)) {
        if (bx == 0) for (int u = tid; u < XCD_BAR_WORDS; u += NTHR) ((unsigned*)(ws + WS_CTL) + CW_BAR)[u] = 0u;
        p0_prologue(args, lds, vcu, G);
    }
    if (IN(0) && IN(1)) grid.sync();
    XcdBarrier xbar = xcd_barrier_post((unsigned*)(ws + WS_CTL) + CW_BAR, xb_st);
    if (IN(1)) {
        SchedIn S{vcu, G, (const char*)(ws + WS_H), (const char*)(ws + WS_WIN), (const char*)(ws + WS_MEMN), (const char*)(ws + WS_WKV)};
        EpiIn E{(bf16_t*)(ws + WS_QK), (bf16_t*)(ws + WS_VM), (bf16_t*)args.out, (bf16_t*)(ws + WS_KVM), args.in[6], args.in[7], (const float*)(ws + WS_ROPE), (const float*)(ws + WS_ROPE) + TP * 32};
        pg8::gemm_phase<EpiIn, SchedIn, true>(lds, 2048, S, E);
    }
    SEAM(1);
    if (PROBE == 1 || PROBE == 2) TSTAMP(tp0);
    if (IN(2)) {
        unsigned* ctl = (unsigned*)(ws + WS_CTL);
        volatile LAS unsigned* jobw = (volatile LAS unsigned*)(lds + LDS_MISC);
        const float lam = ((const float*)ctl)[CW_LAM];
        const bool fixref = ((const float*)ctl)[CW_SMAX] <= 30.f;
        scan::P sp{(const bf16_t*)args.out, (bf16_t*)(ws + WS_Y), (float*)(ws + WS_BON), args.in[13], args.in[14], args.in[15], args.in[16], args.in[17], args.in[18], args.in[20], args.in[21], args.in[22]};
        for (;;) {
            __syncthreads();
            if (tid == 0) jobw[0] = atomicAdd(ctl + CW_QUEUE, 1u);
            __syncthreads();
            const int jb = (int)jobw[0];
            if (jb >= 160 + 1536 + 768) break;
            if (((P2M) & 1) && jb < 160) {
                int s, r; if (jb < 32) { s = 0; r = jb; } else { s = 1 + (jb - 32) / 32; r = (jb - 32) % 32; }
                scan::job(s, r & 1, r >> 1, sp, (char*)lds_raw);
                if (PROBE == 2 && tid == 0) atomicMax((unsigned long long*)(ctl + 256), (unsigned long long)__builtin_amdgcn_s_memrealtime());
            } else if (((P2M) & 2) && jb < 160 + 1536) {
                const int a = jb - 160; int s, h, qb;
                if (a < 512) { s = 0; h = a / 64; qb = a % 64; } else { const int b = a - 512; s = 1 + b / 256; h = (b % 256) / 32; qb = b % 32; }
                if (fixref) att::diff_unit<true>(s, h, qb, (bf16_t*)(ws + WS_QK), (const bf16_t*)(ws + WS_VM), lam, (char*)lds_raw, lds);
                else att::diff_unit<false>(s, h, qb, (bf16_t*)(ws + WS_QK), (const bf16_t*)(ws + WS_VM), lam, (char*)lds_raw, lds);
            } else if ((P2M) & 4) {
                const int a = jb - 160 - 1536; int s, mh, qb;
                if (a < 256) { s = 0; mh = a / 64; qb = a % 64; } else { const int b = a - 256; s = 1 + b / 128; mh = (b % 128) / 32; qb = b % 32; }
                att::mem_unit(s, mh, qb, (bf16_t*)(ws + WS_VM), (const bf16_t*)(ws + WS_KVM), args.in[27], args.in[28], (char*)lds_raw);
            }
        }
    }
    SEAM(2);
    if (PROBE == 1) TSTAMP(tp1);
    if (IN(3)) p4_post(args, (char*)lds_raw, vcu, G);
    SEAM(3);
    if (IN(4)) {
        SchedMerge S{vcu, G, (const char*)(ws + WS_H), (const char*)(ws + WS_WG), (const char*)(ws + WS_QK), (const char*)(ws + WS_VM), (const char*)(ws + WS_PAR), (const char*)(ws + WS_PM2)};
        unsigned char* scr = (unsigned char*)args.out + (size_t)bx * (384 * 1024);
        EpiMerge E{(u32x4*)scr, (f32x4*)(scr + 128 * 1024), (bf16_t*)(ws + WS_MRG)};
        pg8::gemm_phase<EpiMerge, SchedMerge, true>(lds, 2048, S, E);
    }
    SEAM(4);
    if (IN(5)) {
        SchedSq S{vcu, G, (const char*)(ws + WS_MRG), (const char*)(ws + WS_WO), MiB, MiB, 32};
        EpiWo E{args.in[0], args.in[1], args.out};
        pg8::gemm_phase<EpiWo, SchedSq, true>(lds, 2048, S, E);
    }
    SEAM(5);
    if (IN(6)) {
        const int lane = tid & 63, gw = vcu * 8 + (tid >> 6), NGW = G * 8;
        for (int m = gw; m < NT; m += NGW) rms_row(args.out + (size_t)m * DM, args.in[33], (bf16_t*)(ws + WS_H) + (size_t)m * DM, lane);
    }
    SEAM(6);
    if (IN(7)) {
        SchedUp S{vcu, G, (const char*)(ws + WS_H), (const char*)(ws + WS_WUP)};
        EpiUp E{(bf16_t*)(ws + WS_ACT), args.in[35], args.in[36], (LAS float*)(lds + LDS_XCH)};
        pg8::gemm_phase<EpiUp, SchedUp, true>(lds, 2048, S, E);
    }
    SEAM(7);
    if (IN(8)) {
        SchedSq S{vcu, G, (const char*)(ws + WS_ACT), (const char*)(ws + WS_WDN), (size_t)256 * DFF * 2, (size_t)256 * DFF * 2, 88};
        EpiDown E{args.out};
        pg8::gemm_phase<EpiDown, SchedSq, true>(lds, DFF, S, E);
    }
    if (PROBE && bx == 0 && tid == 0) {
        if (PROBE == 2) tp1 = __hip_atomic_load((unsigned long long*)(ws + WS_CTL) + 128, __ATOMIC_RELAXED, __HIP_MEMORY_SCOPE_AGENT);
        const unsigned long long target = __builtin_amdgcn_s_memrealtime() + (tp1 > tp0 ? tp1 - tp0 : 0);
        while (__builtin_amdgcn_s_memrealtime() < target) __builtin_amdgcn_s_sleep(16);
    }
#undef IN
#undef SEAM
}

#ifndef MK_SPLIT
#define MK_SPLIT 0
#endif
extern "C" void kernel_launch(void* const* d_in, const int* in_sizes, int n_in, void* d_out, int out_size, void* d_ws, size_t ws_size, hipStream_t stream) {
    static int grid = 0;
    if (grid == 0) {
        if (n_in != 38 || out_size != NT * DM || ws_size < WS_END) { fprintf(stderr, "kernel_launch: unexpected shapes n_in %d out %d ws %zu\n", n_in, out_size, ws_size); grid = -1; return; }
        int dev = 0, cus = 0, per_cu = 0;
        hipGetDevice(&dev); hipDeviceGetAttribute(&cus, hipDeviceAttributeMultiprocessorCount, dev);
        if (hipFuncSetAttribute((const void*)enc_fwd, hipFuncAttributeMaxDynamicSharedMemorySize, LDS_BYTES) != hipSuccess) { fprintf(stderr, "kernel_launch: hipFuncSetAttribute failed\n"); grid = -1; return; }
        if (hipOccupancyMaxActiveBlocksPerMultiprocessor(&per_cu, (const void*)enc_fwd, NTHR, LDS_BYTES) != hipSuccess || per_cu < 1) { fprintf(stderr, "kernel_launch: occupancy query failed (%d)\n", per_cu); per_cu = 1; }
        (void)hipGetLastError();
        grid = cus * 1;
    }
    if (grid < 0) return;
    Args a{};
    for (int i = 0; i < 38; ++i) a.in[i] = (const float*)d_in[i];
    a.out = (float*)d_out; a.ws = (unsigned char*)d_ws;
    for (int d = 0; d < 32; ++d) a.inv_rev[d] = pow(10000.0, -(double)d / 32.0) / 6.283185307179586476925286766559;
#if MK_SPLIT
    for (int ph = 0; ph < 9; ++ph) { a.ph_lo = ph; a.ph_hi = ph + 1; void* kargs[] = {&a};
        hipError_t e = hipLaunchCooperativeKernel((const void*)enc_fwd, dim3(grid), dim3(NTHR), kargs, LDS_BYTES, stream);
        if (e != hipSuccess) { fprintf(stderr, "launch %d failed: %s\n", ph, hipGetErrorString(e)); break; } }
#else
    a.ph_lo = 0; a.ph_hi = 9;
    void* kargs[] = {&a};
    hipError_t e = hipLaunchCooperativeKernel((const void*)enc_fwd, dim3(grid), dim3(NTHR), kargs, LDS_BYTES, stream);
    if (e != hipSuccess) fprintf(stderr, "cooperative launch failed: %s (grid %d)\n", hipGetErrorString(e), grid);
#endif
}
```

```cpp
#include <hip/hip_runtime.h>
#include <hip/hip_cooperative_groups.h>
#include <cstdio>
#include <cstdint>
#include <cmath>
namespace cg = cooperative_groups;

#define LAS __attribute__((address_space(3)))
typedef unsigned short bf16_t;
typedef short bf16x8 __attribute__((ext_vector_type(8)));
typedef short s16x4 __attribute__((ext_vector_type(4)));
typedef float f32x2 __attribute__((ext_vector_type(2)));
typedef float f32x4 __attribute__((ext_vector_type(4)));
typedef float f32x16 __attribute__((ext_vector_type(16)));
typedef unsigned u32x2 __attribute__((ext_vector_type(2)));
typedef unsigned u32x4 __attribute__((ext_vector_type(4)));

constexpr int NT = 49152, DM = 2048, TP = 16384, TS = 8192, NSEQ = 5;
constexpr int ZRP = 3584;
constexpr int DFF = 5632;
constexpr int NTHR = 512;
constexpr size_t MiB = 1u << 20;
constexpr size_t WS_CTL = 0, WS_WIN = 1 * MiB, WS_WG = 31 * MiB, WS_WKV = 55 * MiB, WS_PAR = 63 * MiB, WS_PM2 = 71 * MiB, WS_WO = 79 * MiB,
                 WS_WUP = 87 * MiB, WS_WDN = 131 * MiB, WS_ROPE = 153 * MiB, WS_MEMN = 157 * MiB, WS_KVM = 162 * MiB, WS_BON = 167 * MiB,
                 WS_H = 176 * MiB, WS_QK = 370 * MiB, WS_VM = 562 * MiB, WS_Y = 754 * MiB, WS_ACT = 370 * MiB, WS_MRG = 754 * MiB, WS_END = 946 * MiB;
constexpr int CW_QUEUE = 64, CW_LAM = 128, CW_SMAX = 129;
constexpr size_t WS_G2T = 173 * MiB;
constexpr size_t WS_SSQ = 174 * MiB;
constexpr int LDS_XCH = 131072, LDS_MISC = 141312, LDS_BYTES = 141312 + 256;

__device__ __forceinline__ int seq_start(int s) { return s == 0 ? 0 : TP + (s - 1) * TS; }
__device__ __forceinline__ int seq_len(int s) { return s == 0 ? TP : TS; }
__device__ __forceinline__ int tok_pos(int tok) { return tok < TP ? tok : ((tok - TP) & (TS - 1)); }

__device__ __forceinline__ unsigned cvt_pk_bf16(float lo, float hi) { unsigned r; asm volatile("v_cvt_pk_bf16_f32 %0, %1, %2" : "=v"(r) : "v"(lo), "v"(hi)); return r; }
__device__ __forceinline__ float bflo(unsigned w) { return __uint_as_float(w << 16); }
__device__ __forceinline__ float bfhi(unsigned w) { return __uint_as_float(w & 0xffff0000u); }
__device__ __forceinline__ float bf1(bf16_t b) { return __uint_as_float((unsigned)b << 16); }
__device__ __forceinline__ float sigmoidf_(float x) { return 1.f / (1.f + __expf(-x)); }
__device__ __forceinline__ float wave_sum(float v) {
#pragma unroll
    for (int o = 1; o < 64; o <<= 1) v += __shfl_xor(v, o);
    return v;
}

namespace pg8 {
constexpr int BM = 256, BK = 64, HALF = 128, HTB = HALF * BK * 2, STAGE_BYTES = 8 * HTB;
__host__ __device__ __forceinline__ int lds_byte(int r, int c) { const int st = (r >> 4) * 2 + (c >> 5), rr = r & 15, cc = c & 31, ob = rr * 64 + cc * 2; return st * 1024 + (ob ^ (((ob >> 9) & 1) << 5)); }
__host__ __device__ __forceinline__ void stage_rc(int b, int& R, int& C) { const int st = b / 1024, sb = b % 1024, swz = sb ^ (((sb >> 9) & 1) << 5); R = (st >> 1) * 16 + swz / 64; C = (st & 1) * 32 + (swz % 64) / 2; }
__host__ __device__ __forceinline__ int perm32(int rho) { const int n = rho >> 4, i = rho & 15; return 8 * (i >> 2) + 4 * n + (i & 3); }

struct Unit { const char* A; const char* B; int nt, pm, pn, kind, t0, T; };

template <class Epi, class Sched, bool ALIGN_EPI>
__device__ __forceinline__ void gemm_phase(LAS unsigned char* lds, const int ld, const Sched& S, const Epi& E) {
    const int tid = threadIdx.x, wid = __builtin_amdgcn_readfirstlane(tid >> 6), lane = tid & 63, wr = wid >> 2, wc = wid & 3, fr = lane & 15, fq = lane >> 4;
    unsigned voffA[2], voffB[2];
#pragma unroll
    for (int i = 0; i < 2; ++i) { int R, C; stage_rc(tid * 16 + i * 8192, R, C); const int Rb = (R & ~31) + perm32(R & 31);
        voffA[i] = (unsigned)(R * ld + C) * 2u; voffB[i] = (unsigned)(Rb * ld + C) * 2u; }
    const size_t kstep = (size_t)(BK * 2);
    const size_t hstep = (size_t)HALF * ld * 2;
    const unsigned ldsw = (unsigned)wid * 1024u;
    const int aoff = lds_byte(wr * 64 + fr, fq * 8), boff = lds_byte(wc * 32 + fr, fq * 8);
#define PG8_SA(b, h) (((b) * 2 + (h)) * HTB)
#define PG8_SB(b, h) ((4 + (b) * 2 + (h)) * HTB)
#define PG8_STAGE(bufoff, gbase, voff) do { _Pragma("unroll") for (int _i = 0; _i < 2; ++_i) \
        __builtin_amdgcn_global_load_lds((const unsigned*)((const char*)(gbase) + (voff)[_i]), (LAS unsigned*)(lds + (bufoff) + ldsw + _i * 8192), 16, 0, 0); } while (0)
#define PG8_LDA(dst, b, h) do { _Pragma("unroll") for (int m = 0; m < 4; ++m) _Pragma("unroll") for (int k = 0; k < 2; ++k) dst[m][k] = *(const LAS bf16x8*)(lds + PG8_SA(b, h) + aoff + m * 2048 + k * 1024); } while (0)
#define PG8_LDB(dst, b, h) do { _Pragma("unroll") for (int n = 0; n < 2; ++n) _Pragma("unroll") for (int k = 0; k < 2; ++k) dst[n][k] = *(const LAS bf16x8*)(lds + PG8_SB(b, h) + boff + n * 2048 + k * 1024); } while (0)
#define PG8_MMA(ai, bj, At, Bt) do { __builtin_amdgcn_s_setprio(1); _Pragma("unroll") for (int m = 0; m < 4; ++m) _Pragma("unroll") for (int n = 0; n < 2; ++n) _Pragma("unroll") for (int k = 0; k < 2; ++k) \
        acc[ai][bj][m][n] = __builtin_amdgcn_mfma_f32_16x16x32_bf16(Bt[n][k], At[m][k], acc[ai][bj][m][n], 0, 0, 0); __builtin_amdgcn_s_setprio(0); } while (0)
#define PG8_WAIT_V(n) asm volatile("s_waitcnt vmcnt(" #n ")" ::: "memory")
#define PG8_WAIT_L(n) asm volatile("s_waitcnt lgkmcnt(" #n ")" ::: "memory")
#define PG8_BAR __builtin_amdgcn_s_barrier()
#define PG8_SCHED __builtin_amdgcn_sched_barrier(0)
    Unit cur, nxt; int ui = 0;
    if (!S.next(0, cur)) return;
    f32x4 acc[2][2][4][2];
#pragma unroll
    for (int a = 0; a < 2; ++a)
#pragma unroll
        for (int b = 0; b < 2; ++b)
#pragma unroll
            for (int m = 0; m < 4; ++m)
#pragma unroll
                for (int n = 0; n < 2; ++n) acc[a][b][m][n] = (f32x4){0.f, 0.f, 0.f, 0.f};
    bf16x8 At[4][2], B0[2][2], B1[2][2];
    const char* cA = cur.A; const char* cB = cur.B;
    PG8_STAGE(PG8_SB(0, 0), cB, voffB); PG8_STAGE(PG8_SB(0, 1), cB + hstep, voffB); PG8_STAGE(PG8_SA(0, 0), cA, voffA); PG8_STAGE(PG8_SA(0, 1), cA + hstep, voffA);
    if (wr == 1) PG8_BAR;
    PG8_WAIT_V(2); PG8_BAR;
    PG8_STAGE(PG8_SB(1, 0), cB + kstep, voffB); PG8_STAGE(PG8_SA(1, 0), cA + kstep, voffA); PG8_STAGE(PG8_SB(1, 1), cB + hstep + kstep, voffB);
    PG8_WAIT_V(6); PG8_BAR;
    for (;;) {
        const bool has_next = S.next(ui + 1, nxt);
        const char* nA = has_next ? nxt.A : cA; const char* nB = has_next ? nxt.B : cB;
        const int nt = cur.nt;
        for (int t = 0; t < nt; t += 2) {
            const bool last = (t == nt - 2);
            const char* a1 = cA + (size_t)(t + 1) * kstep;
            const char* a2 = last ? nA : cA + (size_t)(t + 2) * kstep; const char* b2 = last ? nB : cB + (size_t)(t + 2) * kstep;
            const char* a3 = a2 + kstep; const char* b3 = b2 + kstep;
            PG8_LDB(B0, 0, 0); PG8_LDB(B1, 0, 1); PG8_SCHED; PG8_LDA(At, 0, 0); PG8_STAGE(PG8_SA(1, 1), a1 + hstep, voffA);
            PG8_WAIT_V(8); PG8_WAIT_L(0); PG8_BAR; PG8_MMA(0, 0, At, B0); PG8_MMA(0, 1, At, B1); PG8_BAR; PG8_SCHED;
            PG8_LDA(At, 0, 1); PG8_STAGE(PG8_SB(0, 0), b2, voffB); PG8_STAGE(PG8_SB(0, 1), b2 + hstep, voffB); PG8_STAGE(PG8_SA(0, 0), a2, voffA);
            PG8_WAIT_V(8); PG8_WAIT_L(0); PG8_BAR; PG8_MMA(1, 0, At, B0); PG8_MMA(1, 1, At, B1); PG8_BAR; PG8_SCHED;
            PG8_LDB(B0, 1, 0); PG8_LDB(B1, 1, 1); PG8_SCHED; PG8_LDA(At, 1, 0); PG8_STAGE(PG8_SA(0, 1), a2 + hstep, voffA);
            PG8_WAIT_V(8); PG8_WAIT_L(0); PG8_BAR; PG8_MMA(0, 0, At, B0); PG8_MMA(0, 1, At, B1); PG8_BAR; PG8_SCHED;
            PG8_LDA(At, 1, 1); PG8_STAGE(PG8_SB(1, 0), b3, voffB); PG8_STAGE(PG8_SB(1, 1), b3 + hstep, voffB); PG8_STAGE(PG8_SA(1, 0), a3, voffA);
            PG8_WAIT_V(8); PG8_WAIT_L(0); PG8_BAR; PG8_MMA(1, 0, At, B0); PG8_MMA(1, 1, At, B1); PG8_BAR; PG8_SCHED;
        }
        if constexpr (ALIGN_EPI) { if (wr == 0) PG8_BAR; }
        E(acc, cur, wr, wc, fr, fq);
        if (!has_next) break;
#pragma unroll
        for (int a = 0; a < 2; ++a)
#pragma unroll
            for (int b = 0; b < 2; ++b)
#pragma unroll
                for (int m = 0; m < 4; ++m)
#pragma unroll
                    for (int n = 0; n < 2; ++n) acc[a][b][m][n] = (f32x4){0.f, 0.f, 0.f, 0.f};
        cur = nxt; cA = nA; cB = nB; ++ui;
        if constexpr (ALIGN_EPI) { if (wr == 1) PG8_BAR; }
    }
    PG8_WAIT_V(0);
    if constexpr (!ALIGN_EPI) { if (wr == 0) PG8_BAR; }
    PG8_BAR;
#undef PG8_SA
#undef PG8_SB
#undef PG8_STAGE
#undef PG8_LDA
#undef PG8_LDB
#undef PG8_MMA
#undef PG8_WAIT_V
#undef PG8_WAIT_L
#undef PG8_BAR
#undef PG8_SCHED
}
}
using pg8::Unit;

struct TileMap {
    int nM, nN;
    __device__ __forceinline__ bool get(long L, int& pm, int& pn) const {
        if (L >= (long)nM * nN) return false;
        const int nig = 8 * nN, gid = (int)(L / nig), fm = gid * 8, gsz = (nM - fm) < 8 ? (nM - fm) : 8, r = (int)(L % nig);
        pm = fm + r % gsz; pn = r / gsz; return true;
    }
};

struct Args {
    const float* in[38];
    float* out; unsigned char* ws;
    double inv_rev[32];
    int ph_lo, ph_hi;
};

__device__ __forceinline__ void tr_item(const float* W, int N, int src_n0, bf16_t* WT, size_t ldw, int koff, int r0, int k0, LAS float* scr, int lane) {
    if (src_n0 >= 0) {
#pragma unroll 8
        for (int i = 0; i < 32; ++i) { const int kk = 2 * i + (lane >> 5); scr[kk * 33 + (lane & 31)] = W[(size_t)(k0 + kk) * N + src_n0 + (lane & 31)]; }
    } else {
#pragma unroll 8
        for (int i = 0; i < 32; ++i) { const int kk = 2 * i + (lane >> 5); scr[kk * 33 + (lane & 31)] = 0.f; }
    }
    asm volatile("s_waitcnt lgkmcnt(0)" ::: "memory");
    const int c = lane & 7;
#pragma unroll
    for (int j = 0; j < 4; ++j) { const int n = (lane >> 3) + 8 * j; const LAS float* s = scr + (8 * c) * 33 + n;
        u32x4 o; o.x = cvt_pk_bf16(s[0 * 33], s[1 * 33]); o.y = cvt_pk_bf16(s[2 * 33], s[3 * 33]); o.z = cvt_pk_bf16(s[4 * 33], s[5 * 33]); o.w = cvt_pk_bf16(s[6 * 33], s[7 * 33]);
        *(u32x4*)(WT + (size_t)(r0 + n) * ldw + koff + k0 + 8 * c) = o; }
    asm volatile("s_waitcnt lgkmcnt(0)" ::: "memory");
}
__device__ __forceinline__ void rms_row(const float* xrow, const float* g, bf16_t* orow, int lane) {
    f32x4 v[8]; float s = 0.f;
#pragma unroll
    for (int j = 0; j < 8; ++j) { v[j] = ((const f32x4*)xrow)[64 * j + lane]; s += (v[j].x * v[j].x + v[j].y * v[j].y) + (v[j].z * v[j].z + v[j].w * v[j].w); }
    const float rstd = rsqrtf(wave_sum(s) * (1.f / DM) + 1e-6f);
#pragma unroll
    for (int j = 0; j < 8; ++j) { const f32x4 gg = ((const f32x4*)g)[64 * j + lane];
        u32x2 w; w.x = cvt_pk_bf16(v[j].x * rstd * gg.x, v[j].y * rstd * gg.y); w.y = cvt_pk_bf16(v[j].z * rstd * gg.z, v[j].w * rstd * gg.w);
        ((u32x2*)orow)[64 * j + lane] = w; }
}

__device__ __forceinline__ void p0_prologue(const Args& a, LAS unsigned char* lds, int vcu, int G) {
    const int tid = threadIdx.x, lane = tid & 63, wave = tid >> 6;
    unsigned char* ws = a.ws;
    LAS float* scr = (LAS float*)(lds + wave * 16384);
    const int gw = vcu * 8 + wave, NGW = G * 8;
    constexpr int I0 = 32 * 240, I1 = 32 * 192, I2 = 32 * 64, I3 = 16 * 64, I6 = 32 * 64, I7 = 32 * 352, I8 = 88 * 64;
    constexpr int NITEMS = I0 + I1 + I2 + 3 * I3 + I6 + I7 + I8;
    for (int it = gw; it < NITEMS; it += NGW) {
        int r = it;
        if (r < I0) { const int kb = r / 240, nb = r % 240, r0 = nb * 32; int src;
            if (r0 < 2048) { const int tile = r0 >> 8, cp = r0 & 255, h = cp >> 7, g = (cp & 127) >> 5; src = tile * 256 + 64 * g + 32 * h; }
            else if (r0 < 6560) src = r0;
            else if (r0 < 6656) src = -1;
            else src = 6560 + (r0 - 6656);
            tr_item(a.in[5], 13728, src, (bf16_t*)(ws + WS_WIN), 2048, 0, r0, kb * 64, scr, lane); continue; } r -= I0;
        if (r < I1) { const int kb = r / 192, nb = r % 192; tr_item(a.in[5], 13728, 7584 + nb * 32, (bf16_t*)(ws + WS_WG), 2048, 0, nb * 32, kb * 64, scr, lane); continue; } r -= I1;
        if (r < I2) { const int kb = r / 64, nb = r % 64; tr_item(a.in[26], 2048, nb * 32, (bf16_t*)(ws + WS_WKV), 2048, 0, nb * 32, kb * 64, scr, lane); continue; } r -= I2;
        if (r < I3) { const int kb = r / 64, nb = r % 64; tr_item(a.in[29], 2048, nb * 32, (bf16_t*)(ws + WS_PAR), 2048, 0, nb * 32, kb * 64, scr, lane); continue; } r -= I3;
        if (r < I3) { const int kb = r / 64, nb = r % 64; tr_item(a.in[30], 2048, nb * 32, (bf16_t*)(ws + WS_PAR), 2048, 1024, nb * 32, kb * 64, scr, lane); continue; } r -= I3;
        if (r < I3) { const int kb = r / 64, nb = r % 64; tr_item(a.in[31], 2048, nb * 32, (bf16_t*)(ws + WS_PM2), 2048, 0, nb * 32, kb * 64, scr, lane); continue; } r -= I3;
        if (r < I6) { const int kb = r / 64, nb = r % 64; tr_item(a.in[32], 2048, nb * 32, (bf16_t*)(ws + WS_WO), 2048, 0, nb * 32, kb * 64, scr, lane); continue; } r -= I6;
        if (r < I7) { const int kb = r / 352, nb = r % 352, r0 = nb * 32, tile = r0 >> 8, bj = (r0 & 255) >> 7, j = r0 & 127;
            tr_item(a.in[34], 2 * DFF, bj * DFF + 128 * tile + j, (bf16_t*)(ws + WS_WUP), 2048, 0, r0, kb * 64, scr, lane); continue; } r -= I7;
        { const int kb = r / 64, nb = r % 64; tr_item(a.in[37], 2048, nb * 32, (bf16_t*)(ws + WS_WDN), DFF, 0, nb * 32, kb * 64, scr, lane); }
    }
    for (int m = gw; m < NT + 1280; m += NGW) {
        if (m < NT) { const float* xr = m < TP ? a.in[0] + (size_t)m * DM : a.in[1] + (size_t)(m - TP) * DM; rms_row(xr, a.in[4], (bf16_t*)(ws + WS_H) + (size_t)m * DM, lane); }
        else { const int j = m - NT; const float* xr = j < 256 ? a.in[2] + (size_t)j * DM : a.in[3] + (size_t)(j - 256) * DM; rms_row(xr, a.in[25], (bf16_t*)(ws + WS_MEMN) + (size_t)j * DM, lane); }
    }
    { float* rc = (float*)(ws + WS_ROPE); float* rs = rc + TP * 32;
      for (int e = (vcu * NTHR + tid); e < TP * 32; e += G * NTHR) { const int t = e >> 5, d = e & 31; double rev = (double)t * a.inv_rev[d]; rev -= rint(rev); const float rf = (float)rev;
          rc[e] = __builtin_amdgcn_cosf(rf); rs[e] = __builtin_amdgcn_sinf(rf); } }
    { float* ssq = (float*)(ws + WS_SSQ); for (int e = vcu * NTHR + tid; e < NT; e += G * NTHR) ssq[e] = 0.f; }
    { bf16_t* g2t = (bf16_t*)(ws + WS_G2T); const float* G2 = a.in[19];
      for (int e = vcu * NTHR + tid; e < 1024 * 20; e += G * NTHR) { const int col = e / 20, kc = e - col * 20; float f[8];
#pragma unroll
          for (int i = 0; i < 8; ++i) f[i] = G2[(size_t)(kc * 8 + i) * 1024 + col];
          u32x4 w; w.x = cvt_pk_bf16(f[0], f[1]); w.y = cvt_pk_bf16(f[2], f[3]); w.z = cvt_pk_bf16(f[4], f[5]); w.w = cvt_pk_bf16(f[6], f[7]);
          *(u32x4*)(g2t + (size_t)col * 160 + kc * 8) = w; } }
    if (blockIdx.x == 0) {
        unsigned* ctl = (unsigned*)(ws + WS_CTL);
        if (tid < 64) {
            if (tid == 0) { ctl[CW_QUEUE] = 0u; ctl[256] = 0u; ctl[257] = 0u; }
            const float s1 = wave_sum(a.in[8][tid] * a.in[9][tid]), s2 = wave_sum(a.in[10][tid] * a.in[11][tid]);
            if (tid == 0) ((float*)ctl)[CW_LAM] = __expf(s1) - __expf(s2) + 0.2f;
            float gq = fabsf(a.in[6][tid]), gk = fabsf(a.in[7][tid]);
#pragma unroll
            for (int o = 1; o < 64; o <<= 1) { gq = fmaxf(gq, __shfl_xor(gq, o)); gk = fmaxf(gk, __shfl_xor(gk, o)); }
            if (tid == 0) ((float*)ctl)[CW_SMAX] = 64.f * 0.125f * 1.4426950408889634f * gq * gk;
        }
    }
}

struct SchedIn {
    int v, G; const char* H; const char* WIN; const char* MEMN; const char* WKV;
    __device__ __forceinline__ bool next(int i, Unit& u) const {
        long L = (long)i * G + v; int pm, pn;
        if (L < 5760) { TileMap{192, 30}.get(L, pm, pn); u.A = H + (size_t)pm * MiB; u.B = WIN + (size_t)pn * MiB; u.nt = 32; u.pm = pm; u.pn = pn; u.kind = 0; u.t0 = 0; u.T = 0; return true; }
        L -= 5760; if (L < 40) { pm = (int)(L % 5); pn = (int)(L / 5); u.A = MEMN + (size_t)pm * MiB; u.B = WKV + (size_t)pn * MiB; u.nt = 32; u.pm = pm; u.pn = pn; u.kind = 1; u.t0 = 0; u.T = 0; return true; }
        return false;
    }
};
struct EpiIn {
    bf16_t* QK; bf16_t* VM; bf16_t* ZR; bf16_t* KVM; const float* qn; const float* kn; const float* rc; const float* rs;
    __device__ __forceinline__ void plain(const f32x4 (&acc)[2][2][4][2], bf16_t* base, size_t ldc, int row0, int col0) const {
#pragma unroll
        for (int ai = 0; ai < 2; ++ai)
#pragma unroll
            for (int m = 0; m < 4; ++m) { bf16_t* rowp = base + (size_t)(row0 + ai * 128 + m * 16) * ldc + col0;
#pragma unroll
                for (int bj = 0; bj < 2; ++bj) { const f32x4 v0 = acc[ai][bj][m][0], v1 = acc[ai][bj][m][1];
                    u32x4 w; w.x = cvt_pk_bf16(v0[0], v0[1]); w.y = cvt_pk_bf16(v0[2], v0[3]); w.z = cvt_pk_bf16(v1[0], v1[1]); w.w = cvt_pk_bf16(v1[2], v1[3]);
                    *(u32x4*)(rowp + bj * 128) = w; } }
    }
    __device__ __forceinline__ void operator()(const f32x4 (&acc)[2][2][4][2], const Unit& u, int wr, int wc, int fr, int fq) const {
        const int row0 = u.pm * 256 + wr * 64 + fr, cin = wc * 32 + 8 * fq;
        if (u.kind == 1) { plain(acc, KVM, 2048, row0, u.pn * 256 + cin); return; }
        const int pn = u.pn;
        if (pn < 8) {
            const bool isq = pn < 4; const float* nw = isq ? qn : kn;
            const int Gq = (pn & 3) * 4 + wc, d0 = 8 * fq;
            const float qs = isq ? 0.125f * 1.4426950408889634f : 1.f;
            const f32x4 w1a = *(const f32x4*)(nw + d0), w1b = *(const f32x4*)(nw + d0 + 4), w2a = *(const f32x4*)(nw + 32 + d0), w2b = *(const f32x4*)(nw + 36 + d0);
            bf16_t* dst = QK + (isq ? 0 : 1024) + Gq * 64 + d0;
#pragma unroll
            for (int ai = 0; ai < 2; ++ai)
#pragma unroll
                for (int m = 0; m < 4; ++m) {
                    const int row = row0 + ai * 128 + m * 16, t = tok_pos(row);
                    const f32x4 xa = acc[ai][0][m][0], xb = acc[ai][0][m][1], ya = acc[ai][1][m][0], yb = acc[ai][1][m][1];
                    float ss = (xa[0] * xa[0] + xa[1] * xa[1]) + (xa[2] * xa[2] + xa[3] * xa[3]) + (xb[0] * xb[0] + xb[1] * xb[1]) + (xb[2] * xb[2] + xb[3] * xb[3])
                             + (ya[0] * ya[0] + ya[1] * ya[1]) + (ya[2] * ya[2] + ya[3] * ya[3]) + (yb[0] * yb[0] + yb[1] * yb[1]) + (yb[2] * yb[2] + yb[3] * yb[3]);
                    ss += __shfl_xor(ss, 16); ss += __shfl_xor(ss, 32);
                    const float rstd = rsqrtf(ss * (1.f / 64.f) + 1e-6f);
                    const f32x4 ca = *(const f32x4*)(rc + t * 32 + d0), cb = *(const f32x4*)(rc + t * 32 + d0 + 4), sa = *(const f32x4*)(rs + t * 32 + d0), sb = *(const f32x4*)(rs + t * 32 + d0 + 4);
                    const f32x4 x1a = xa * rstd * w1a, x1b = xb * rstd * w1b, x2a = ya * rstd * w2a, x2b = yb * rstd * w2b;
                    const f32x4 o1a = (x1a * ca - x2a * sa) * qs, o1b = (x1b * cb - x2b * sb) * qs, o2a = (x2a * ca + x1a * sa) * qs, o2b = (x2b * cb + x1b * sb) * qs;
                    u32x4 w; w.x = cvt_pk_bf16(o1a[0], o1a[1]); w.y = cvt_pk_bf16(o1a[2], o1a[3]); w.z = cvt_pk_bf16(o1b[0], o1b[1]); w.w = cvt_pk_bf16(o1b[2], o1b[3]);
                    *(u32x4*)(dst + (size_t)row * 2048) = w;
                    w.x = cvt_pk_bf16(o2a[0], o2a[1]); w.y = cvt_pk_bf16(o2a[2], o2a[3]); w.z = cvt_pk_bf16(o2b[0], o2b[1]); w.w = cvt_pk_bf16(o2b[2], o2b[3]);
                    *(u32x4*)(dst + (size_t)row * 2048 + 32) = w;
                }
        } else if (pn < 12) plain(acc, VM, 2048, row0, (pn - 8) * 256 + cin);
        else if (pn < 26) plain(acc, ZR, ZRP, row0, (pn - 12) * 256 + cin);
        else plain(acc, VM, 2048, row0, 1024 + (pn - 26) * 256 + cin);
    }
};

namespace att {
constexpr int SHM_V = 16384, SHM_K = 8192;
constexpr int OFF_K = 0, OFF_V = 24576, OFF_WS = 73728, OFF_STASH = 75776;
#define KSWZ64(row, colB) ((row) * 128 + ((colB) ^ (((row) & 7) << 4)))
#define SBAR() __builtin_amdgcn_sched_barrier(0)
__device__ __forceinline__ int crow(int r, int hi) { return (r & 3) + 8 * (r >> 2) + 4 * hi; }
constexpr float THRL = 8.f;
__device__ __forceinline__ void partialSM(f32x16& p0, f32x16& p1, float& m_reg, float& alpha) {
    float pmax = fmaxf(fmaxf(p0[0], p0[1]), p0[2]);
#pragma unroll
    for (int r = 3; r < 15; r += 2) pmax = fmaxf(fmaxf(pmax, p0[r]), p0[r + 1]);
    pmax = fmaxf(fmaxf(pmax, p0[15]), p1[0]);
#pragma unroll
    for (int r = 1; r < 15; r += 2) pmax = fmaxf(fmaxf(pmax, p1[r]), p1[r + 1]);
    pmax = fmaxf(pmax, p1[15]);
    { auto rr = __builtin_amdgcn_permlane32_swap(__float_as_uint(pmax), __float_as_uint(pmax), false, false);
      pmax = fmaxf(__uint_as_float(rr[0]), __uint_as_float(rr[1])); }
    if (__builtin_expect(__all(pmax <= THRL), 1)) { alpha = 1.f; }
    else { const float dl = fmaxf(pmax, 0.f); alpha = __builtin_amdgcn_exp2f(-dl); m_reg += dl;
#pragma unroll
        for (int r = 0; r < 16; ++r) { p0[r] -= dl; p1[r] -= dl; } }
#pragma unroll
    for (int r = 0; r < 16; ++r) p0[r] = __builtin_amdgcn_exp2f(p0[r]);
}
__device__ __forceinline__ void finishSM(f32x16& p0, f32x16& p1, float alpha, float& l_reg, bf16x8& pa0, bf16x8& pa1, bf16x8& pa2, bf16x8& pa3) {
#pragma unroll
    for (int r = 0; r < 16; ++r) p1[r] = __builtin_amdgcn_exp2f(p1[r]);
    f32x2 s2 = (f32x2){p0[0], p0[1]} + (f32x2){p1[0], p1[1]};
#pragma unroll
    for (int r = 2; r < 16; r += 2) { s2 = s2 + (f32x2){p0[r], p0[r + 1]}; s2 = s2 + (f32x2){p1[r], p1[r + 1]}; }
    float ps = s2[0] + s2[1];
    { auto rr = __builtin_amdgcn_permlane32_swap(__float_as_uint(ps), __float_as_uint(ps), false, false);
      ps = __uint_as_float(rr[0]) + __uint_as_float(rr[1]); }
    l_reg = l_reg * alpha + ps;
#define PK4(P, BASE, OUT) do { unsigned a0 = cvt_pk_bf16(P[BASE + 0], P[BASE + 1]), a1 = cvt_pk_bf16(P[BASE + 2], P[BASE + 3]);   \
    unsigned b0 = cvt_pk_bf16(P[BASE + 4], P[BASE + 5]), b1 = cvt_pk_bf16(P[BASE + 6], P[BASE + 7]);                              \
    auto r0 = __builtin_amdgcn_permlane32_swap(a0, b0, false, false); auto r1 = __builtin_amdgcn_permlane32_swap(a1, b1, false, false); \
    u32x4 w = {r0[0], r1[0], r0[1], r1[1]}; OUT = *reinterpret_cast<bf16x8*>(&w); } while (0)
    PK4(p0, 0, pa0); PK4(p0, 8, pa1); PK4(p1, 0, pa2); PK4(p1, 8, pa3);
#undef PK4
}
__device__ __forceinline__ void qkt64(f32x16& p0, f32x16& p1, const char* Ks, const bf16x8* qr, int r32, int hi) {
#pragma unroll
    for (int d0 = 0; d0 < 4; ++d0) { const int cb = (d0 * 16 + hi * 8) * 2;
        const bf16x8 b0 = *reinterpret_cast<const bf16x8*>(Ks + KSWZ64(r32, cb));
        const bf16x8 b1 = *reinterpret_cast<const bf16x8*>(Ks + KSWZ64(32 + r32, cb));
        p0 = __builtin_amdgcn_mfma_f32_32x32x16_bf16(b0, qr[d0], p0, 0, 0, 0);
        p1 = __builtin_amdgcn_mfma_f32_32x32x16_bf16(b1, qr[d0], p1, 0, 0, 0); }
}
__device__ __forceinline__ int v_st(int k, int c) { const int kk = (k & ~0xC) | ((k & 4) << 1) | ((k & 8) >> 1); return ((kk >> 3) * 4 + (c >> 5)) * 512 + ((kk & 7) * 32 + (c & 31)) * 2; }
__device__ __forceinline__ int v_rd_base(int lane) { return ((lane & 3) << 3) | (((lane >> 2) & 3) << 6) | (((lane >> 4) & 1) << 5) | (((lane >> 5) & 1) << 8); }
constexpr int v_rd_off(int d0, int ks, int half) { return d0 * 512 + ks * 4096 + half * 2048; }
template <int OFF> __device__ __forceinline__ s16x4 tr_read(int vb) {
    s16x4 r; asm volatile("ds_read_b64_tr_b16 %0, %1 offset:%2" : "=&v"(r) : "v"(vb), "i"(OFF) : "memory"); return r;
}
struct VFrag { s16x4 l0, h0, l1, h1, l2, h2, l3, h3; };
template <int KS> __device__ __forceinline__ void pv_read(VFrag& f, int vb) {
    f.l0 = tr_read<v_rd_off(0, KS, 0)>(vb); f.h0 = tr_read<v_rd_off(0, KS, 1)>(vb); f.l1 = tr_read<v_rd_off(1, KS, 0)>(vb); f.h1 = tr_read<v_rd_off(1, KS, 1)>(vb);
    f.l2 = tr_read<v_rd_off(2, KS, 0)>(vb); f.h2 = tr_read<v_rd_off(2, KS, 1)>(vb); f.l3 = tr_read<v_rd_off(3, KS, 0)>(vb); f.h3 = tr_read<v_rd_off(3, KS, 1)>(vb);
}
__device__ __forceinline__ void pv_mma(f32x16* o, const VFrag& f, bf16x8 pa) {
#define PK(L, H) (bf16x8){L[0], L[1], L[2], L[3], H[0], H[1], H[2], H[3]}
    o[0] = __builtin_amdgcn_mfma_f32_32x32x16_bf16(pa, PK(f.l0, f.h0), o[0], 0, 0, 0);
    o[1] = __builtin_amdgcn_mfma_f32_32x32x16_bf16(pa, PK(f.l1, f.h1), o[1], 0, 0, 0);
    o[2] = __builtin_amdgcn_mfma_f32_32x32x16_bf16(pa, PK(f.l2, f.h2), o[2], 0, 0, 0);
    o[3] = __builtin_amdgcn_mfma_f32_32x32x16_bf16(pa, PK(f.l3, f.h3), o[3], 0, 0, 0);
#undef PK
}
__device__ __forceinline__ void pv_d0(f32x16* o, int vb, bf16x8 pa0, bf16x8 pa1, bf16x8 pa2, bf16x8 pa3) {
    VFrag fa, fb;
    pv_read<0>(fa, vb);
    pv_read<1>(fb, vb); asm volatile("s_waitcnt lgkmcnt(8)" ::: "memory"); SBAR(); pv_mma(o, fa, pa0); SBAR();
    pv_read<2>(fa, vb); asm volatile("s_waitcnt lgkmcnt(8)" ::: "memory"); SBAR(); pv_mma(o, fb, pa1); SBAR();
    pv_read<3>(fb, vb); asm volatile("s_waitcnt lgkmcnt(8)" ::: "memory"); SBAR(); pv_mma(o, fa, pa2); SBAR();
    asm volatile("s_waitcnt lgkmcnt(0)" ::: "memory"); SBAR(); pv_mma(o, fb, pa3);
}

__device__ __forceinline__ void stash_store(const unsigned* stash, bf16_t* Ow, int ldo, int lane) {
#pragma unroll
    for (int i = 0; i < 8; ++i) { const int q = i * 64 + lane, rl = q >> 4, c8 = (q & 15) * 8, hh = (rl >> 2) & 1, r = (rl & 3) + 4 * (rl >> 3), d0 = c8 >> 5, cc = c8 & 31;
        const unsigned* sp = stash + (d0 * 8 + (r >> 1)) * 64 + hh * 32 + cc; const u32x4 a = *(const u32x4*)sp, b = *(const u32x4*)(sp + 4);
        u32x4 w;
        if (r & 1) { w.x = (a.x >> 16) | (a.y & 0xffff0000u); w.y = (a.z >> 16) | (a.w & 0xffff0000u); w.z = (b.x >> 16) | (b.y & 0xffff0000u); w.w = (b.z >> 16) | (b.w & 0xffff0000u); }
        else { w.x = (a.x & 0xffffu) | (a.y << 16); w.y = (a.z & 0xffffu) | (a.w << 16); w.z = (b.x & 0xffffu) | (b.y << 16); w.w = (b.z & 0xffffu) | (b.w << 16); }
        *(u32x4*)(Ow + (size_t)rl * ldo + c8) = w; }
}

template <bool FX> __device__ __forceinline__ void diff_unit(int s, int h, int qb, bf16_t* QK, const bf16_t* VM, float lam, char* lds, LAS unsigned char* ldsl) {
    constexpr int LDK = 2048;
    int tid = threadIdx.x; asm volatile("" : "+v"(tid));
    const int wid = __builtin_amdgcn_readfirstlane(tid >> 6), lane = tid & 63, r32 = lane & 31, hi = lane >> 5;
    const int tok0 = seq_start(s), T = seq_len(s), NTL = T / 64;
    char* V_lds = lds + OFF_V; char* K_lds = lds + OFF_K;
    float* wsf = (float*)(lds + OFF_WS) + wid * 64; float* li_l = wsf; float* al_l = wsf + 32;
    unsigned* stash = (unsigned*)(lds + OFF_STASH) + wid * 2048;
    const int vb0 = (int)(uintptr_t)V_lds + v_rd_base(lane);
    const bf16_t* Vh = VM + (size_t)tok0 * LDK + h * 128;
    const size_t qrow = (size_t)(tok0 + qb * 256 + wid * 32);
    const unsigned ksrc = (unsigned)((wid * 8 + (lane >> 3)) * LDK + (((lane & 7) ^ (lane >> 3)) << 3)) * 2u;
    unsigned vsrc[2];
#pragma unroll
    for (int i = 0; i < 2; ++i) { const int st = 2 * (2 * wid + i) + (lane >> 5), kk = (st >> 2) * 8 + ((lane & 31) >> 2), k = (kk & ~0xC) | ((kk & 4) << 1) | ((kk & 8) >> 1), cc = (st & 3) * 32 + (lane & 3) * 8;
        vsrc[i] = (unsigned)(k * LDK + cc) * 2u; }
#pragma unroll 1
    for (int c = 0; c < 2; ++c) {
        const bf16_t* Kh = QK + (size_t)tok0 * LDK + 1024 + h * 128 + c * 64;
        const bf16_t* Qw = QK + (qrow + r32) * LDK + h * 128 + c * 64 + hi * 8;
        bf16x8 qr[4];
#pragma unroll
        for (int d0 = 0; d0 < 4; ++d0) qr[d0] = *reinterpret_cast<const bf16x8*>(Qw + d0 * 16);
        float m_reg = 0.f, l_reg = 0; f32x16 o[4] = {};
#define NEGM(P) do { const float nm_ = FX ? 0.f : -m_reg; _Pragma("unroll") for (int r_ = 0; r_ < 16; ++r_) P[r_] = nm_; } while (0)
#define PSM(P0, P1, AL) do { if constexpr (FX) { AL = 1.f; _Pragma("unroll") for (int r_ = 0; r_ < 16; ++r_) P0[r_] = __builtin_amdgcn_exp2f(P0[r_]); } else partialSM(P0, P1, m_reg, AL); } while (0)
#define DMA_K(t, slotB) __builtin_amdgcn_global_load_lds((const unsigned*)((const char*)(Kh + (size_t)(t) * 64 * LDK) + ksrc), (LAS unsigned*)(ldsl + OFF_K + (slotB) * SHM_K + wid * 1024), 16, 0, 0)
#define DMA_V(t, slotB) do { __builtin_amdgcn_global_load_lds((const unsigned*)((const char*)(Vh + (size_t)(t) * 64 * LDK) + vsrc[0]), (LAS unsigned*)(ldsl + OFF_V + (slotB) * SHM_V + (2 * wid) * 1024), 16, 0, 0); \
    __builtin_amdgcn_global_load_lds((const unsigned*)((const char*)(Vh + (size_t)(t) * 64 * LDK) + vsrc[1]), (LAS unsigned*)(ldsl + OFF_V + (slotB) * SHM_V + (2 * wid + 1) * 1024), 16, 0, 0); } while (0)
#define WAITB(n) asm volatile("s_waitcnt vmcnt(" #n ") lgkmcnt(0)\n\ts_barrier" ::: "memory")
#define RESC(a) do { if (!FX && __any((a) < 1.f)) { if (hi == 0) al_l[r32] = (a); asm volatile("s_waitcnt lgkmcnt(0)" ::: "memory"); \
    _Pragma("unroll") for (int d = 0; d < 4; ++d) _Pragma("unroll") for (int r = 0; r < 16; ++r) o[d][r] *= al_l[crow(r, hi)]; } } while (0)
#define SEG(X0, X1, ALX, Y0, Y1, ALY, sg) do { \
        SBAR(); NEGM(X0); NEGM(X1); qkt64(X0, X1, K_lds + sl_c * SHM_K, qr, r32, hi); \
        finishSM(Y0, Y1, ALY, l_reg, pa0, pa1, pa2, pa3); SBAR(); \
        if ((sg) + 2 < NTL) DMA_K((sg) + 2, sl_p); if ((sg) + 1 < NTL) DMA_V((sg) + 1, sl_n); SBAR(); \
        pv_d0(o, vb0 + sl_p * SHM_V, pa0, pa1, pa2, pa3); PSM(X0, X1, ALX); \
        RESC(ALX); \
        if ((sg) + 2 < NTL) WAITB(3); else if ((sg) + 1 < NTL) WAITB(2); else WAITB(0); \
        { const int t_ = sl_p; sl_p = sl_c; sl_c = sl_n; sl_n = t_; } } while (0)
        f32x16 pA0, pA1, pB0, pB1; float alA, alB; bf16x8 pa0, pa1, pa2, pa3;
        int sl_p = 2, sl_c = 0, sl_n = 1;
        DMA_K(0, 0); DMA_V(0, 0); DMA_K(1, 1);
        WAITB(1);
        DMA_K(2, 2); DMA_V(1, 1);
        NEGM(pA0); NEGM(pA1); qkt64(pA0, pA1, K_lds, qr, r32, hi); PSM(pA0, pA1, alA);
        WAITB(3);
        { sl_p = 0; sl_c = 1; sl_n = 2; }
        for (int j = 1; j + 1 < NTL; j += 2) {
            SEG(pB0, pB1, alB, pA0, pA1, alA, j);
            SEG(pA0, pA1, alA, pB0, pB1, alB, j + 1);
        }
        SEG(pB0, pB1, alB, pA0, pA1, alA, NTL - 1);
        finishSM(pB0, pB1, alB, l_reg, pa0, pa1, pa2, pa3); SBAR();
        pv_d0(o, vb0 + sl_p * SHM_V, pa0, pa1, pa2, pa3);
#undef SEG
#undef DMA_K
#undef DMA_V
#undef WAITB
#undef RESC
#undef NEGM
#undef PSM
        if (hi == 0) li_l[r32] = l_reg; asm volatile("s_waitcnt lgkmcnt(0)" ::: "memory");
        float rli[16];
#pragma unroll
        for (int r = 0; r < 16; ++r) rli[r] = __builtin_amdgcn_rcpf(li_l[crow(r, hi)]);
        { const float coef = c == 0 ? 1.f : -lam;
#pragma unroll
          for (int d0 = 0; d0 < 4; ++d0)
#pragma unroll
              for (int r = 0; r < 16; r += 2) { const int idx = (d0 * 8 + (r >> 1)) * 64 + lane; const unsigned w = c == 0 ? 0u : stash[idx];
                  stash[idx] = cvt_pk_bf16(bflo(w) + coef * o[d0][r] * rli[r], bfhi(w) + coef * o[d0][r + 1] * rli[r + 1]); } }
        __syncthreads();
    }
    stash_store(stash, QK + qrow * LDK + h * 128, LDK, lane);
    __syncthreads();
}

constexpr int MOFF_V = 0, MOFF_K = 32768, MOFF_WS = 65536, MOFF_RK = 67584, MOFF_G = 68608, MOFF_STASH = 69632;
__device__ __forceinline__ void mem_unit(int s, int mh, int qb, bf16_t* VM, const bf16_t* KVM, const float* mqn, const float* mkn, char* lds) {
    int tid = threadIdx.x; asm volatile("" : "+v"(tid));
    const int wid = __builtin_amdgcn_readfirstlane(tid >> 6), lane = tid & 63, r32 = lane & 31, hi = lane >> 5;
    const int tok0 = seq_start(s);
    char* V_lds = lds + MOFF_V; char* K_lds = lds + MOFF_K;
    float* wsf = (float*)(lds + MOFF_WS) + wid * 64; float* li_l = wsf; float* al_l = wsf + 32;
    float* rk_l = (float*)(lds + MOFF_RK); float* g_l = (float*)(lds + MOFF_G);
    const bf16_t* Kh = KVM + (size_t)(s * 256) * 2048 + mh * 256;
    const bf16_t* Vh = KVM + (size_t)(s * 256) * 2048 + 1024 + mh * 256;
    if (tid < 256) g_l[tid] = mqn[tid] * mkn[tid];
    {
        const bf16_t* kp = Kh + (size_t)(wid * 32 + r32) * 2048 + hi * 128; float ss = 0.f;
#pragma unroll
        for (int i = 0; i < 16; ++i) { const u32x4 w = *(const u32x4*)(kp + i * 8);
            ss += bflo(w.x) * bflo(w.x) + bfhi(w.x) * bfhi(w.x) + bflo(w.y) * bflo(w.y) + bfhi(w.y) * bfhi(w.y) + bflo(w.z) * bflo(w.z) + bfhi(w.z) * bfhi(w.z) + bflo(w.w) * bflo(w.w) + bfhi(w.w) * bfhi(w.w); }
        ss += __shfl_xor(ss, 32);
        if (hi == 0) rk_l[wid * 32 + r32] = rsqrtf(ss * (1.f / 256.f) + 1e-6f);
    }
    const size_t qrow = (size_t)(tok0 + qb * 256 + wid * 32);
    bf16_t* Qw = VM + (qrow + r32) * 2048 + 1024 + mh * 256 + hi * 8;
    float rqC;
    { float ss = 0.f;
#pragma unroll
      for (int i = 0; i < 16; ++i) { const u32x4 w = *(const u32x4*)(Qw + i * 16);
          ss += bflo(w.x) * bflo(w.x) + bfhi(w.x) * bfhi(w.x) + bflo(w.y) * bflo(w.y) + bfhi(w.y) * bfhi(w.y) + bflo(w.z) * bflo(w.z) + bfhi(w.z) * bfhi(w.z) + bflo(w.w) * bflo(w.w) + bfhi(w.w) * bfhi(w.w); }
      ss += __shfl_xor(ss, 32);
      rqC = rsqrtf(ss * (1.f / 256.f) + 1e-6f) * (0.0625f * 1.4426950408889634f); }
    const int sr = tid >> 4, sc = (tid & 15) * 8, vst0 = v_st(sr, sc), vst1 = v_st(32 + sr, sc);
    const int kr = tid >> 3, kc = (tid & 7) * 8, kst = KSWZ64(kr, kc * 2);
    const int vb0 = (int)(uintptr_t)V_lds + v_rd_base(lane);
    unsigned* stash = (unsigned*)(lds + MOFF_STASH) + wid * 2048;
    __syncthreads();
#pragma unroll 1
    for (int hv = 0; hv < 2; ++hv) {
    float m_reg = -1e30f, l_reg = 0.f; f32x16 o[4] = {};
#pragma unroll 1
    for (int t = 0; t < 4; ++t) {
        const int k0 = t * 64;
#pragma unroll
        for (int ds = 0; ds < 4; ++ds) { const u32x4 w = *(const u32x4*)(Kh + (size_t)(k0 + kr) * 2048 + ds * 64 + kc); const float* g = g_l + ds * 64 + kc;
            u32x4 o4; o4.x = cvt_pk_bf16(bflo(w.x) * g[0], bfhi(w.x) * g[1]); o4.y = cvt_pk_bf16(bflo(w.y) * g[2], bfhi(w.y) * g[3]);
            o4.z = cvt_pk_bf16(bflo(w.z) * g[4], bfhi(w.z) * g[5]); o4.w = cvt_pk_bf16(bflo(w.w) * g[6], bfhi(w.w) * g[7]);
            *(u32x4*)(K_lds + ds * 8192 + kst) = o4; asm volatile("" ::: "memory"); }
        *(u32x4*)(V_lds + vst0) = *(const u32x4*)(Vh + (size_t)(k0 + sr) * 2048 + hv * 128 + sc);
        *(u32x4*)(V_lds + vst1) = *(const u32x4*)(Vh + (size_t)(k0 + 32 + sr) * 2048 + hv * 128 + sc);
        __syncthreads();
        f32x16 p0 = {}, p1 = {};
#pragma unroll
        for (int ds = 0; ds < 4; ++ds) { bf16x8 qr[4];
#pragma unroll
            for (int d0 = 0; d0 < 4; ++d0) qr[d0] = *reinterpret_cast<const bf16x8*>(Qw + ds * 64 + d0 * 16);
            qkt64(p0, p1, K_lds + ds * 8192, qr, r32, hi); }
#pragma unroll
        for (int r = 0; r < 16; ++r) { p0[r] *= rk_l[k0 + crow(r, hi)] * rqC; p1[r] *= rk_l[k0 + 32 + crow(r, hi)] * rqC; }
        float pmax = p0[0];
#pragma unroll
        for (int r = 1; r < 16; ++r) pmax = fmaxf(pmax, p0[r]);
#pragma unroll
        for (int r = 0; r < 16; ++r) pmax = fmaxf(pmax, p1[r]);
        pmax = fmaxf(pmax, __shfl_xor(pmax, 32));
        const float mn = fmaxf(m_reg, pmax), alpha = __builtin_amdgcn_exp2f(m_reg - mn); m_reg = mn;
        float ps = 0.f;
#pragma unroll
        for (int r = 0; r < 16; ++r) { p0[r] = __builtin_amdgcn_exp2f(p0[r] - mn); p1[r] = __builtin_amdgcn_exp2f(p1[r] - mn); ps += p0[r] + p1[r]; }
        ps += __shfl_xor(ps, 32);
        l_reg = l_reg * alpha + ps;
        if (hi == 0) al_l[r32] = alpha; asm volatile("s_waitcnt lgkmcnt(0)" ::: "memory");
#pragma unroll
        for (int d = 0; d < 4; ++d)
#pragma unroll
            for (int r = 0; r < 16; ++r) o[d][r] *= al_l[crow(r, hi)];
        bf16x8 pa0, pa1, pa2, pa3;
#define PK4(P, BASE, OUT) do { unsigned a0 = cvt_pk_bf16(P[BASE + 0], P[BASE + 1]), a1 = cvt_pk_bf16(P[BASE + 2], P[BASE + 3]);   \
    unsigned b0 = cvt_pk_bf16(P[BASE + 4], P[BASE + 5]), b1 = cvt_pk_bf16(P[BASE + 6], P[BASE + 7]);                              \
    auto r0 = __builtin_amdgcn_permlane32_swap(a0, b0, false, false); auto r1 = __builtin_amdgcn_permlane32_swap(a1, b1, false, false); \
    u32x4 w = {r0[0], r1[0], r0[1], r1[1]}; OUT = *reinterpret_cast<bf16x8*>(&w); } while (0)
        PK4(p0, 0, pa0); PK4(p0, 8, pa1); PK4(p1, 0, pa2); PK4(p1, 8, pa3);
#undef PK4
        pv_d0(o, vb0, pa0, pa1, pa2, pa3);
        __syncthreads();
    }
    if (hi == 0) li_l[r32] = l_reg; asm volatile("s_waitcnt lgkmcnt(0)" ::: "memory");
    if (hv == 1) stash_store(stash, VM + qrow * 2048 + 1024 + mh * 256, 2048, lane);
#pragma unroll
    for (int d0 = 0; d0 < 4; ++d0)
#pragma unroll
        for (int r = 0; r < 16; r += 2) stash[(d0 * 8 + (r >> 1)) * 64 + lane] = cvt_pk_bf16(o[d0][r] * __builtin_amdgcn_rcpf(li_l[crow(r, hi)]), o[d0][r + 1] * __builtin_amdgcn_rcpf(li_l[crow(r + 1, hi)]));
    }
    stash_store(stash, VM + qrow * 2048 + 1024 + mh * 256 + 128, 2048, lane);
    __syncthreads();
}
#undef SBAR
}

namespace scan {
constexpr int TC = 32;
typedef _Float16 h2 __attribute__((ext_vector_type(2)));
typedef _Float16 h4 __attribute__((ext_vector_type(4)));
typedef _Float16 h8 __attribute__((ext_vector_type(8)));
constexpr int BUFB = 36864, O_R = 0, O_KD = 4096, O_KK = 8192, O_W = 12288, O_KA = 16384, O_V = 20480, O_Y = 28672;
constexpr int O_PRIV = 73728;
constexpr int O_TBL = 73728 + 32768;
__device__ __forceinline__ float dpp_red8(float x) {
    x += __uint_as_float(__builtin_amdgcn_update_dpp(0u, __float_as_uint(x), 0xB1, 0xf, 0xf, false));
    x += __uint_as_float(__builtin_amdgcn_update_dpp(0u, __float_as_uint(x), 0x4E, 0xf, 0xf, false));
    x += __uint_as_float(__builtin_amdgcn_update_dpp(0u, __float_as_uint(x), 0x141, 0xf, 0xf, false));
    return x;
}
template <int DIR> __device__ __forceinline__ void scan_chunk(const char* B_, h2 (&S)[2][4], int seg, int row0) {
    const char* base = B_ + seg * 16; const char* vbase = B_ + O_V + row0 * 4; char* ybase = (char*)B_ + O_Y + row0 * 4;
    u32x4 ck[2], cw[2], ca[2], cd[2], cr[2]; u32x2 cv[2];
#define LDSET(set, tl_) do { ck[set] = *(const u32x4*)(base + O_KK + (tl_) * 128); cw[set] = *(const u32x4*)(base + O_W + (tl_) * 128); ca[set] = *(const u32x4*)(base + O_KA + (tl_) * 128); \
    cd[set] = *(const u32x4*)(base + O_KD + (tl_) * 128); cr[set] = *(const u32x4*)(base + O_R + (tl_) * 128); cv[set] = *(const u32x2*)(vbase + (tl_) * 256); } while (0)
#define H2(u) __builtin_bit_cast(h2, (u))
    LDSET(0, DIR ? TC - 1 : 0);
#pragma unroll
    for (int st = 0; st < TC; ++st) {
        const int tl = DIR ? TC - 1 - st : st, cs = st & 1;
        if (st + 1 < TC) LDSET(cs ^ 1, DIR ? TC - 2 - st : st + 1);
#define SPLIT4(V, A0, A1, A2, A3) const h8 V##8 = __builtin_bit_cast(h8, V[cs]); const h2 A0 = __builtin_shufflevector(V##8, V##8, 0, 1), A1 = __builtin_shufflevector(V##8, V##8, 2, 3), \
    A2 = __builtin_shufflevector(V##8, V##8, 4, 5), A3 = __builtin_shufflevector(V##8, V##8, 6, 7)
        SPLIT4(ck, k0, k1, k2, k3); SPLIT4(cw, w0, w1, w2, w3); SPLIT4(ca, a0, a1, a2, a3); SPLIT4(cd, d0, d1, d2, d3); SPLIT4(cr, r0, r1, r2, r3);
#undef SPLIT4
        const h4 cv4 = __builtin_bit_cast(h4, cv[cs]);
        f32x2 yo;
#pragma unroll
        for (int h = 0; h < 2; ++h) {
            const h2 vv = h == 0 ? __builtin_shufflevector(cv4, cv4, 0, 1) : __builtin_shufflevector(cv4, cv4, 2, 3);
            float d = __builtin_amdgcn_fdot2(S[h][0], k0, 0.f, false); float e = __builtin_amdgcn_fdot2(S[h][2], k2, 0.f, false);
            d = __builtin_amdgcn_fdot2(S[h][1], k1, d, false); e = __builtin_amdgcn_fdot2(S[h][3], k3, e, false);
            d = dpp_red8(d + e);
            const h2 p0 = S[h][0] * w0 + vv * d0, p1 = S[h][1] * w1 + vv * d1, p2 = S[h][2] * w2 + vv * d2, p3 = S[h][3] * w3 + vv * d3;
            const _Float16 sh = (_Float16)(-d); const h2 sa = {sh, sh};
            S[h][0] = p0 + sa * a0; S[h][1] = p1 + sa * a1; S[h][2] = p2 + sa * a2; S[h][3] = p3 + sa * a3;
            float y = __builtin_amdgcn_fdot2(S[h][0], r0, 0.f, false); float z = __builtin_amdgcn_fdot2(S[h][2], r2, 0.f, false);
            y = __builtin_amdgcn_fdot2(S[h][1], r1, y, false); z = __builtin_amdgcn_fdot2(S[h][3], r3, z, false);
            yo[h] = dpp_red8(y + z);
        }
        if (seg == 0) *(f32x2*)(ybase + tl * 256) = yo;
    }
#undef LDSET
#undef H2
}
__device__ __forceinline__ unsigned pkh(float a, float b) { const h2 v = {(_Float16)a, (_Float16)b}; return __builtin_bit_cast(unsigned, v); }
struct P {
    const bf16_t* ZR; bf16_t* YB; float* BON;
    const float *mup, *mun, *w0, *w2, *a0, *a2, *kk_w, *ka_w, *rk_w;
};
__device__ __forceinline__ void job(int s, int dir, int head, const P& p, char* lds) {
    int tid = threadIdx.x; asm volatile("" : "+v"(tid));
    const int wid = __builtin_amdgcn_readfirstlane(tid >> 6), lane = tid & 63;
    const int tok0 = seq_start(s), T = seq_len(s), NCH = T / TC;
    float* TBL = (float*)(lds + O_TBL);
    float* MUP = TBL; float* MUN = TBL + 320; float* KKW = TBL + 640; float* KAW = TBL + 704; float* RKW = TBL + 768; float* BW = TBL + 832; float* BA = TBL + 896;
    __syncthreads();
    if (tid < 320) { const int which = tid >> 6, j = tid & 63; const int col = which < 3 ? which * 1024 + head * 64 + j : (which == 3 ? 3072 : 3200) + dir * 64 + j; MUP[tid] = p.mup[col]; MUN[tid] = p.mun[col]; }
    if (tid >= 320 && tid < 384) { const int j = tid - 320; KKW[j] = p.kk_w[head * 64 + j]; KAW[j] = p.ka_w[head * 64 + j]; RKW[j] = p.rk_w[head * 64 + j];
        BW[j] = p.w0[dir * 1024 + head * 64 + j]; BA[j] = p.a0[dir * 1024 + head * 64 + j]; }
    bf16_t* yb = p.YB + (size_t)dir * NT * 1024; float* bon = p.BON + (size_t)dir * NT * 16;
    if (wid >= 4) {
        const int pw = wid - 4;
        char* priv = lds + O_PRIV + pw * 8192;
        bf16_t* AWl = (bf16_t*)priv; bf16_t* AAl = AWl + 512; float* PK = (float*)(priv + 2048); float* PA = (float*)(priv + 4096); float* PR = (float*)(priv + 6144);
        bf16x8 Bf[2][4][2];
#pragma unroll
        for (int mat = 0; mat < 2; ++mat)
#pragma unroll
            for (int cbk = 0; cbk < 4; ++cbk)
#pragma unroll
                for (int ks = 0; ks < 2; ++ks) { const float* W2 = (mat == 0 ? p.w2 : p.a2) + (size_t)dir * 64 * 1024 + head * 64 + cbk * 16 + (lane & 15) + (size_t)(ks * 32 + (lane >> 4) * 8) * 1024;
                    float f[8];
#pragma unroll
                    for (int e = 0; e < 8; ++e) f[e] = W2[(size_t)e * 1024];
                    u32x4 w; w.x = cvt_pk_bf16(f[0], f[1]); w.y = cvt_pk_bf16(f[2], f[3]); w.z = cvt_pk_bf16(f[4], f[5]); w.w = cvt_pk_bf16(f[6], f[7]); Bf[mat][cbk][ks] = *reinterpret_cast<bf16x8*>(&w); }
        __syncthreads();
        const int pt = tid - 256;
        u32x4 zc[5], zm[5], zn[5];
#define PLOAD(cc) do { const int tf_ = dir ? T - TC * ((cc) + 1) : TC * (cc); \
    _Pragma("unroll") for (int k = 0; k < 5; ++k) { const int which = k, tl8 = lane >> 3, j0 = (lane & 7) * 8; \
        const int col = which < 3 ? which * 1024 + head * 64 + j0 : (which == 3 ? 3072 : 3200) + dir * 64 + j0; \
        const int t = tf_ + 8 * pw + tl8; const bf16_t* zp = p.ZR + (size_t)(tok0 + t) * ZRP + col; \
        zc[k] = *(const u32x4*)zp; zm[k] = (u32x4){0u, 0u, 0u, 0u}; zn[k] = (u32x4){0u, 0u, 0u, 0u}; \
        if (t > 0) zm[k] = *(const u32x4*)(zp - ZRP); \
        if (t < T - 1) zn[k] = *(const u32x4*)(zp + ZRP); } } while (0)
        PLOAD(0);
        for (int c = -1; c < NCH; ++c) {
            if (c >= 1) { const int cb_ = (c - 1) & 1, tf = dir ? T - TC * c : TC * (c - 1); const int tl = pt >> 3, c8 = (pt & 7) * 8;
                const float* yp = (const float*)(lds + cb_ * BUFB + O_Y) + tl * 64 + c8; const f32x4 y4 = *(const f32x4*)yp, y5 = *(const f32x4*)(yp + 4);
                u32x4 w; w.x = cvt_pk_bf16(y4[0], y4[1]); w.y = cvt_pk_bf16(y4[2], y4[3]); w.z = cvt_pk_bf16(y5[0], y5[1]); w.w = cvt_pk_bf16(y5[2], y5[3]);
                *(u32x4*)(yb + (size_t)(tok0 + tf + tl) * 1024 + head * 64 + c8) = w; }
            if (c + 1 < NCH) {
                const int nb = (c + 1) & 1, tfirst = dir ? T - TC * (c + 2) : TC * (c + 1);
                char* B_ = lds + nb * BUFB;
#pragma unroll
                for (int k = 0; k < 5; ++k) { const int which = k, tl8 = lane >> 3, j0 = (lane & 7) * 8, tl = 8 * pw + tl8;
                    const f32x4 mpa = *(const f32x4*)(MUP + which * 64 + j0), mpb = *(const f32x4*)(MUP + which * 64 + j0 + 4), mna = *(const f32x4*)(MUN + which * 64 + j0), mnb = *(const f32x4*)(MUN + which * 64 + j0 + 4);
                    const u32x4 z = zc[k], zmm = zm[k], znn = zn[k];
                    float v[8];
#define SH(i, zw, zmw, znw, lohi, mp_, mn_) { const float zz = lohi(zw), a_ = lohi(zmw), b_ = lohi(znw); v[i] = zz + mp_ * (a_ - zz) + mn_ * (b_ - zz); }
                    SH(0, z.x, zmm.x, znn.x, bflo, mpa[0], mna[0]) SH(1, z.x, zmm.x, znn.x, bfhi, mpa[1], mna[1]) SH(2, z.y, zmm.y, znn.y, bflo, mpa[2], mna[2]) SH(3, z.y, zmm.y, znn.y, bfhi, mpa[3], mna[3])
                    SH(4, z.z, zmm.z, znn.z, bflo, mpb[0], mnb[0]) SH(5, z.z, zmm.z, znn.z, bfhi, mpb[1], mnb[1]) SH(6, z.w, zmm.w, znn.w, bflo, mpb[2], mnb[2]) SH(7, z.w, zmm.w, znn.w, bfhi, mpb[3], mnb[3])
#undef SH
                    if (which < 2) { float* dst = (which == 0 ? PR : PK) + tl8 * 64 + j0;
                        *(f32x4*)dst = (f32x4){v[0], v[1], v[2], v[3]}; *(f32x4*)(dst + 4) = (f32x4){v[4], v[5], v[6], v[7]}; }
                    else if (which == 2) { unsigned* dst = (unsigned*)(B_ + O_V) + tl * 64 + j0;
                        *(u32x4*)dst = (u32x4){pkh(v[0], v[0]), pkh(v[1], v[1]), pkh(v[2], v[2]), pkh(v[3], v[3])}; *(u32x4*)(dst + 4) = (u32x4){pkh(v[4], v[4]), pkh(v[5], v[5]), pkh(v[6], v[6]), pkh(v[7], v[7])}; }
                    else { if (which == 3) {
#pragma unroll
                            for (int i = 0; i < 8; ++i) { const float e2 = __expf(2.f * v[i]); v[i] = 1.f - 2.f * __builtin_amdgcn_rcpf(e2 + 1.f); } }
                        u32x4 w; w.x = cvt_pk_bf16(v[0], v[1]); w.y = cvt_pk_bf16(v[2], v[3]); w.z = cvt_pk_bf16(v[4], v[5]); w.w = cvt_pk_bf16(v[6], v[7]);
                        *(u32x4*)((which == 3 ? AWl : AAl) + tl8 * 64 + j0) = w; }
                }
                if (c + 2 < NCH) PLOAD(c + 2);
                { const int tj = lane & 7, kq = lane >> 4;
#pragma unroll
                  for (int mat = 0; mat < 2; ++mat) { const bf16_t* Am = (mat == 0 ? AWl : AAl) + tj * 64 + kq * 8;
                      const bf16x8 y0 = *reinterpret_cast<const bf16x8*>(Am), y1 = *reinterpret_cast<const bf16x8*>(Am + 32);
#pragma unroll
                      for (int cbk = 0; cbk < 4; ++cbk) { f32x4 acc = {0.f, 0.f, 0.f, 0.f};
                          acc = __builtin_amdgcn_mfma_f32_16x16x32_bf16(Bf[mat][cbk][0], y0, acc, 0, 0, 0);
                          acc = __builtin_amdgcn_mfma_f32_16x16x32_bf16(Bf[mat][cbk][1], y1, acc, 0, 0, 0);
                          const int col = cbk * 16 + 4 * kq; const f32x4 bias = *(const f32x4*)((mat == 0 ? BW : BA) + col); f32x4 res;
#pragma unroll
                          for (int r = 0; r < 4; ++r) { const float u = acc[r] + bias[r];
                              const float sg = __builtin_amdgcn_rcpf(1.f + __expf(-u));
                              res[r] = mat == 0 ? __expf(-0.60653065971263342f * sg) : sg; }
                          if ((lane & 15) < 8) { if (mat == 0) *(u32x2*)((_Float16*)(B_ + O_W) + (8 * pw + tj) * 64 + col) = (u32x2){pkh(res[0], res[1]), pkh(res[2], res[3])};
                                                 else *(f32x4*)(PA + tj * 64 + col) = res; } } } }
                { const int t8 = lane >> 3, tl = 8 * pw + t8, c0 = (lane & 7) * 8; const int o = t8 * 64 + c0;
                  float bs = 0.f, ss = 0.f; f32x4 kr[2], k4[2], a4[2], r4[2];
#pragma unroll
                  for (int q = 0; q < 2; ++q) { k4[q] = *(const f32x4*)(PK + o + 4 * q); a4[q] = *(const f32x4*)(PA + o + 4 * q); r4[q] = *(const f32x4*)(PR + o + 4 * q);
                      kr[q] = k4[q] * *(const f32x4*)(KKW + c0 + 4 * q); ss += (kr[q][0] * kr[q][0] + kr[q][1] * kr[q][1]) + (kr[q][2] * kr[q][2] + kr[q][3] * kr[q][3]); }
                  ss = dpp_red8(ss);
                  const float inv = __builtin_amdgcn_rsqf(fmaxf(ss, 1e-24f));
                  f32x4 kk[2], kd[2], kka[2];
#pragma unroll
                  for (int q = 0; q < 2; ++q) { kk[q] = kr[q] * inv; kd[q] = k4[q] * (1.f + (a4[q] - 1.f) * *(const f32x4*)(KAW + c0 + 4 * q)); kka[q] = kk[q] * a4[q];
                      const f32x4 bb = r4[q] * kd[q] * *(const f32x4*)(RKW + c0 + 4 * q); bs += (bb[0] + bb[1]) + (bb[2] + bb[3]); }
                  const int oh = (tl * 64 + c0) * 2;
#define ST8(OFF, X) *(u32x4*)(B_ + (OFF) + oh) = (u32x4){pkh(X[0][0], X[0][1]), pkh(X[0][2], X[0][3]), pkh(X[1][0], X[1][1]), pkh(X[1][2], X[1][3])}
                  ST8(O_KK, kk); ST8(O_KD, kd); ST8(O_KA, kka); ST8(O_R, r4);
#undef ST8
                  bs = dpp_red8(bs);
                  if ((lane & 7) == 0) bon[(size_t)(tok0 + tfirst + tl) * 16 + head] = bs; }
            }
            asm volatile("s_waitcnt lgkmcnt(0)" ::: "memory"); __builtin_amdgcn_s_barrier(); asm volatile("" ::: "memory");
        }
#undef PLOAD
    } else {
        __syncthreads();
        const int row0 = wid * 16 + (lane >> 3) * 2, seg = lane & 7;
        h2 S[2][4];
#pragma unroll
        for (int h = 0; h < 2; ++h)
#pragma unroll
            for (int q = 0; q < 4; ++q) S[h][q] = (h2){(_Float16)0.f, (_Float16)0.f};
        asm volatile("s_waitcnt lgkmcnt(0)" ::: "memory"); __builtin_amdgcn_s_barrier(); asm volatile("" ::: "memory");
        for (int c = 0; c < NCH; ++c) {
            const char* B_ = lds + (c & 1) * BUFB;
            if (dir) scan_chunk<1>(B_, S, seg, row0); else scan_chunk<0>(B_, S, seg, row0);
            asm volatile("s_waitcnt lgkmcnt(0)" ::: "memory"); __builtin_amdgcn_s_barrier(); asm volatile("" ::: "memory");
        }
    }
    if (wid >= 4) {
        const int pt = tid - 256, c = NCH, cb_ = (c - 1) & 1, tf = dir ? T - TC * c : TC * (c - 1); const int tl = pt >> 3, c8 = (pt & 7) * 8;
        const float* yp = (const float*)(lds + cb_ * BUFB + O_Y) + tl * 64 + c8; const f32x4 y4 = *(const f32x4*)yp, y5 = *(const f32x4*)(yp + 4);
        u32x4 w; w.x = cvt_pk_bf16(y4[0], y4[1]); w.y = cvt_pk_bf16(y4[2], y4[3]); w.z = cvt_pk_bf16(y5[0], y5[1]); w.w = cvt_pk_bf16(y5[2], y5[3]);
        *(u32x4*)(yb + (size_t)(tok0 + tf + tl) * 1024 + head * 64 + c8) = w;
    }
    __syncthreads();
}
}

__device__ __forceinline__ void p4_post(const Args& a, char* lds, int vcu, int G) {
    const int tid = threadIdx.x, lane = tid & 63;
    unsigned char* ws = a.ws;
    const bf16_t* ZR = (const bf16_t*)a.out; bf16_t* QK = (bf16_t*)(ws + WS_QK);
    const bf16_t* Y0 = (const bf16_t*)(ws + WS_Y); const bf16_t* Y1 = Y0 + (size_t)NT * 1024;
    const float* BON = (const float*)(ws + WS_BON);
    const float* mup = a.in[13]; const float* mun = a.in[14]; const float* G2 = a.in[19]; const float* lnw = a.in[23]; const float* lnb = a.in[24]; const float* subg = a.in[12];
    bf16_t* SGh = (bf16_t*)lds; float* BL = (float*)(lds + 20480); bf16_t* GL = (bf16_t*)(lds + 24576);
    const bf16_t* G2T = (const bf16_t*)(ws + WS_G2T);
    const int wid = tid >> 6, r32 = lane & 31, hi = lane >> 5;
    for (int tile = vcu; tile < NT / 32; tile += G) {
        const int tk0 = tile * 32;
        __syncthreads();
        for (int it = tid; it < 32 * 20; it += NTHR) {
            const int tl = it / 20, j0 = (it % 20) * 8, col = 3328 + j0, tok = tk0 + tl, t = tok_pos(tok), T = tok < TP ? TP : TS;
            const bf16_t* zp = ZR + (size_t)tok * ZRP + col; const u32x4 z = *(const u32x4*)zp; u32x4 zm = {0u, 0u, 0u, 0u}, zn = {0u, 0u, 0u, 0u};
            if (t > 0) zm = *(const u32x4*)(zp - ZRP);
            if (t < T - 1) zn = *(const u32x4*)(zp + ZRP);
            float v[8];
            const f32x4 mpa = *(const f32x4*)(mup + col), mpb = *(const f32x4*)(mup + col + 4), mna = *(const f32x4*)(mun + col), mnb = *(const f32x4*)(mun + col + 4);
#define SH(i, zw, zmw, znw, lohi) { const float zz = lohi(zw), a_ = lohi(zmw), b_ = lohi(znw), mp_ = (i < 4 ? mpa[i & 3] : mpb[i & 3]), mn_ = (i < 4 ? mna[i & 3] : mnb[i & 3]); v[i] = sigmoidf_(zz + mp_ * (a_ - zz) + mn_ * (b_ - zz)); }
            SH(0, z.x, zm.x, zn.x, bflo) SH(1, z.x, zm.x, zn.x, bfhi) SH(2, z.y, zm.y, zn.y, bflo) SH(3, z.y, zm.y, zn.y, bfhi)
            SH(4, z.z, zm.z, zn.z, bflo) SH(5, z.z, zm.z, zn.z, bfhi) SH(6, z.w, zm.w, zn.w, bflo) SH(7, z.w, zm.w, zn.w, bfhi)
#undef SH
            { u32x4 w; w.x = cvt_pk_bf16(v[0], v[1]); w.y = cvt_pk_bf16(v[2], v[3]); w.z = cvt_pk_bf16(v[4], v[5]); w.w = cvt_pk_bf16(v[6], v[7]); *(u32x4*)(SGh + tl * 160 + j0) = w; }
        }
        { const int tl = tid >> 4, hd = tid & 15; BL[tid] = BON[(size_t)(tk0 + tl) * 16 + hd] + BON[(size_t)NT * 16 + (size_t)(tk0 + tl) * 16 + hd]; }
        { const int pr = tid >> 1, half = tid & 1, tl = pr >> 3, hd = pr & 7; bf16_t* op = QK + (size_t)(tk0 + tl) * 2048 + hd * 128 + half * 64;
          u32x4 w[8]; float ss = 0.f;
#pragma unroll
          for (int i = 0; i < 8; ++i) { w[i] = *(const u32x4*)(op + i * 8);
              ss += bflo(w[i].x) * bflo(w[i].x) + bfhi(w[i].x) * bfhi(w[i].x) + bflo(w[i].y) * bflo(w[i].y) + bfhi(w[i].y) * bfhi(w[i].y) + bflo(w[i].z) * bflo(w[i].z) + bfhi(w[i].z) * bfhi(w[i].z) + bflo(w[i].w) * bflo(w[i].w) + bfhi(w[i].w) * bfhi(w[i].w); }
          ss += __shfl_xor(ss, 1);
          const float rstd = rsqrtf(ss * (1.f / 128.f) + 1e-6f) * 0.8f; const float* sg = subg + half * 64;
#pragma unroll
          for (int i = 0; i < 8; ++i) { u32x4 o;
              o.x = cvt_pk_bf16(bflo(w[i].x) * rstd * sg[i * 8 + 0], bfhi(w[i].x) * rstd * sg[i * 8 + 1]); o.y = cvt_pk_bf16(bflo(w[i].y) * rstd * sg[i * 8 + 2], bfhi(w[i].y) * rstd * sg[i * 8 + 3]);
              o.z = cvt_pk_bf16(bflo(w[i].z) * rstd * sg[i * 8 + 4], bfhi(w[i].z) * rstd * sg[i * 8 + 5]); o.w = cvt_pk_bf16(bflo(w[i].w) * rstd * sg[i * 8 + 6], bfhi(w[i].w) * rstd * sg[i * 8 + 7]);
              *(u32x4*)(op + i * 8) = o; } }
        __syncthreads();
        { f32x16 gacc[4] = {};
#pragma unroll
          for (int ks = 0; ks < 10; ++ks) { const bf16x8 af = *reinterpret_cast<const bf16x8*>(SGh + r32 * 160 + ks * 16 + hi * 8);
#pragma unroll
              for (int cb = 0; cb < 4; ++cb) { const bf16x8 bfr = *reinterpret_cast<const bf16x8*>(G2T + (size_t)(wid * 128 + cb * 32 + r32) * 160 + ks * 16 + hi * 8);
                  gacc[cb] = __builtin_amdgcn_mfma_f32_32x32x16_bf16(af, bfr, gacc[cb], 0, 0, 0); } }
#pragma unroll
          for (int cb = 0; cb < 4; ++cb)
#pragma unroll
              for (int r = 0; r < 16; ++r) GL[(att::crow(r, hi)) * 1024 + wid * 128 + cb * 32 + r32] = (bf16_t)(cvt_pk_bf16(gacc[cb][r], gacc[cb][r]) & 0xffffu); }
        __syncthreads();
        const int c0 = tid * 2;
        const int hd = tid >> 5;
        const float lw0 = lnw[c0], lw1 = lnw[c0 + 1], lb0 = lnb[c0], lb1 = lnb[c0 + 1];
        const float mp0 = mup[2048 + c0], mp1 = mup[2048 + c0 + 1], mn0 = mun[2048 + c0], mn1 = mun[2048 + c0 + 1];
#pragma unroll
        for (int i = 0; i < 32; ++i) {
            const int tok = tk0 + i, t = tok_pos(tok), T = tok < TP ? TP : TS;
            const unsigned ya = *(const unsigned*)(Y0 + (size_t)tok * 1024 + c0), yb = *(const unsigned*)(Y1 + (size_t)tok * 1024 + c0);
            const float y0 = bflo(ya) + bflo(yb), y1 = bfhi(ya) + bfhi(yb);
            float s = y0 + y1, q = y0 * y0 + y1 * y1;
#pragma unroll
            for (int o = 16; o < 32; o <<= 1) { s += __shfl_xor(s, o); q += __shfl_xor(q, o); }
#define DPPADD(x, ctrl) x += __uint_as_float(__builtin_amdgcn_update_dpp(0u, __float_as_uint(x), ctrl, 0xf, 0xf, false))
            DPPADD(s, 0xB1); DPPADD(q, 0xB1); DPPADD(s, 0x4E); DPPADD(q, 0x4E); DPPADD(s, 0x141); DPPADD(q, 0x141); DPPADD(s, 0x140); DPPADD(q, 0x140);
#undef DPPADD
            const float mean = s * (1.f / 64.f), var = fmaxf(q * (1.f / 64.f) - mean * mean, 0.f), rstd = rsqrtf(var + 64e-5f);
            const bf16_t* zp = ZR + (size_t)tok * ZRP + 2048 + c0; const unsigned z = *(const unsigned*)zp;
            unsigned zm = 0u, zn = 0u;
            if (t > 0) zm = *(const unsigned*)(zp - ZRP);
            if (t < T - 1) zn = *(const unsigned*)(zp + ZRP);
            const float v0 = bflo(z) + mp0 * (bflo(zm) - bflo(z)) + mn0 * (bflo(zn) - bflo(z)), v1 = bfhi(z) + mp1 * (bfhi(zm) - bfhi(z)) + mn1 * (bfhi(zn) - bfhi(z));
            const float bo = BL[i * 16 + hd];
            const unsigned gg = *(const unsigned*)(GL + i * 1024 + c0);
            const float o0 = ((y0 - mean) * rstd * lw0 + lb0 + bo * v0) * bflo(gg), o1 = ((y1 - mean) * rstd * lw1 + lb1 + bo * v1) * bfhi(gg);
            *(unsigned*)(QK + (size_t)tok * 2048 + 1024 + c0) = cvt_pk_bf16(o0, o1);
        }
    }
    __syncthreads();
}

struct SchedMerge {
    int v, G; const char* H; const char* WG; const char* QK; const char* VM; const char* PAR; const char* PM2;
    __device__ __forceinline__ bool next(int i, Unit& u) const {
        const int ti = i / 6, kind = i - ti * 6; const long L = (long)ti * G + v; int pm, pn;
        if (!TileMap{192, 8}.get(L, pm, pn)) return false;
        u.pm = pm; u.pn = pn; u.kind = kind; u.t0 = 0; u.T = 0;
        const size_t bo = (size_t)pn * MiB;
        switch (kind) {
            case 0: u.A = H + (size_t)pm * MiB; u.B = WG + bo; u.nt = 32; break;
            case 1: u.A = QK + (size_t)pm * MiB; u.B = PAR + bo; u.nt = 16; break;
            case 2: u.A = H + (size_t)pm * MiB; u.B = WG + 8 * MiB + bo; u.nt = 32; break;
            case 3: u.A = QK + (size_t)pm * MiB + 2048; u.B = PAR + bo + 2048; u.nt = 16; break;
            case 4: u.A = H + (size_t)pm * MiB; u.B = WG + 16 * MiB + bo; u.nt = 32; break;
            default: u.A = VM + (size_t)pm * MiB + 2048; u.B = PM2 + bo; u.nt = 16; break;
        }
        return true;
    }
};
struct EpiMerge {
    u32x4* scrG; f32x4* scrP; bf16_t* MRG;
    __device__ __forceinline__ void operator()(const f32x4 (&acc)[2][2][4][2], const Unit& u, int wr, int wc, int fr, int fq) const {
        const int tid = threadIdx.x, kind = u.kind;
        u32x4* gp = scrG + tid; f32x4* pp = scrP + tid;
        if ((kind & 1) == 0) {
#pragma unroll
            for (int ai = 0; ai < 2; ++ai)
#pragma unroll
                for (int bj = 0; bj < 2; ++bj)
#pragma unroll
                    for (int m = 0; m < 4; ++m) { const f32x4 v0 = acc[ai][bj][m][0], v1 = acc[ai][bj][m][1]; u32x4 w;
                        w.x = cvt_pk_bf16(sigmoidf_(v0[0]), sigmoidf_(v0[1])); w.y = cvt_pk_bf16(sigmoidf_(v0[2]), sigmoidf_(v0[3]));
                        w.z = cvt_pk_bf16(sigmoidf_(v1[0]), sigmoidf_(v1[1])); w.w = cvt_pk_bf16(sigmoidf_(v1[2]), sigmoidf_(v1[3]));
                        *gp = w; gp += NTHR; asm volatile("" : "+v"(gp) :: "memory"); }
        } else {
            const int row0 = u.pm * 256 + wr * 64 + fr, col0 = u.pn * 256 + wc * 32 + 8 * fq;
#pragma unroll
            for (int ai = 0; ai < 2; ++ai)
#pragma unroll
                for (int bj = 0; bj < 2; ++bj) {
                    bf16_t* mp = MRG + (size_t)(row0 + ai * 128) * 2048 + col0 + bj * 128;
#pragma unroll
                    for (int m = 0; m < 4; ++m) { const u32x4 g = *gp;
                        f32x4 p0 = acc[ai][bj][m][0] * (f32x4){bflo(g.x), bfhi(g.x), bflo(g.y), bfhi(g.y)}, p1 = acc[ai][bj][m][1] * (f32x4){bflo(g.z), bfhi(g.z), bflo(g.w), bfhi(g.w)};
                        if (kind > 1) { p0 += pp[0]; p1 += pp[NTHR]; }
                        if (kind < 5) { pp[0] = p0; pp[NTHR] = p1; }
                        else { u32x4 w; w.x = cvt_pk_bf16(p0[0], p0[1]); w.y = cvt_pk_bf16(p0[2], p0[3]); w.z = cvt_pk_bf16(p1[0], p1[1]); w.w = cvt_pk_bf16(p1[2], p1[3]);
                            *(u32x4*)mp = w; }
                        gp += NTHR; pp += 2 * NTHR; mp += 16 * 2048; asm volatile("" : "+v"(gp), "+v"(pp), "+v"(mp) :: "memory"); } }
        }
    }
};

struct SchedSq {
    int v, G; const char* A; const char* B; size_t astep, bstep; int nt;
    __device__ __forceinline__ bool next(int i, Unit& u) const {
        const long L = (long)i * G + v; int pm, pn; if (!TileMap{192, 8}.get(L, pm, pn)) return false;
        u.A = A + (size_t)pm * astep; u.B = B + (size_t)pn * bstep; u.nt = nt; u.pm = pm; u.pn = pn; u.kind = 0; u.t0 = 0; u.T = 0; return true;
    }
};
struct EpiWo {
    const float* xp; const float* xs; float* out; bf16_t* XG; const float* gffn; float* ssq;
    __device__ __forceinline__ void operator()(const f32x4 (&acc)[2][2][4][2], const Unit& u, int wr, int wc, int fr, int fq) const {
        const int row0 = u.pm * 256 + wr * 64 + fr, col0 = u.pn * 256 + wc * 32 + 8 * fq;
        f32x4 g[2][2];
#pragma unroll
        for (int bj = 0; bj < 2; ++bj) { g[bj][0] = *(const f32x4*)(gffn + col0 + bj * 128); g[bj][1] = *(const f32x4*)(gffn + col0 + bj * 128 + 4); }
#pragma unroll
        for (int ai = 0; ai < 2; ++ai)
#pragma unroll
            for (int m = 0; m < 4; ++m) { const int row = row0 + ai * 128 + m * 16;
                const float* xr = (row < TP ? xp + (size_t)row * DM : xs + (size_t)(row - TP) * DM) + col0; float* orow = out + (size_t)row * DM + col0; bf16_t* grow = XG + (size_t)row * DM + col0;
                float ss = 0.f;
#pragma unroll
                for (int bj = 0; bj < 2; ++bj) { const f32x4 y0 = *(const f32x4*)(xr + bj * 128) + acc[ai][bj][m][0], y1 = *(const f32x4*)(xr + bj * 128 + 4) + acc[ai][bj][m][1];
                    *(f32x4*)(orow + bj * 128) = y0; *(f32x4*)(orow + bj * 128 + 4) = y1;
                    ss += (y0[0] * y0[0] + y0[1] * y0[1]) + (y0[2] * y0[2] + y0[3] * y0[3]) + (y1[0] * y1[0] + y1[1] * y1[1]) + (y1[2] * y1[2] + y1[3] * y1[3]);
                    const f32x4 z0 = y0 * g[bj][0], z1 = y1 * g[bj][1];
                    u32x4 w; w.x = cvt_pk_bf16(z0[0], z0[1]); w.y = cvt_pk_bf16(z0[2], z0[3]); w.z = cvt_pk_bf16(z1[0], z1[1]); w.w = cvt_pk_bf16(z1[2], z1[3]);
                    *(u32x4*)(grow + bj * 128) = w; }
                ss += __shfl_xor(ss, 16); ss += __shfl_xor(ss, 32);
                if (fq == 0) atomicAdd(ssq + row, ss); }
    }
};
struct EpiDown {
    float* out;
    __device__ __forceinline__ void operator()(const f32x4 (&acc)[2][2][4][2], const Unit& u, int wr, int wc, int fr, int fq) const {
        const int row0 = u.pm * 256 + wr * 64 + fr, col0 = u.pn * 256 + wc * 32 + 8 * fq;
#pragma unroll
        for (int ai = 0; ai < 2; ++ai)
#pragma unroll
            for (int m = 0; m < 4; ++m) { float* orow = out + (size_t)(row0 + ai * 128 + m * 16) * DM + col0;
#pragma unroll
                for (int bj = 0; bj < 2; ++bj) { const f32x4 x0 = *(const f32x4*)(orow + bj * 128), x1 = *(const f32x4*)(orow + bj * 128 + 4);
                    *(f32x4*)(orow + bj * 128) = x0 + acc[ai][bj][m][0]; *(f32x4*)(orow + bj * 128 + 4) = x1 + acc[ai][bj][m][1]; } }
    }
};

struct SchedUp {
    int v, G; const char* HN; const char* WUP;
    __device__ __forceinline__ bool next(int i, Unit& u) const {
        const long L = (long)i * G + v; int pm, pn; if (!TileMap{197, 44}.get(L, pm, pn)) return false;
        int s, ti; if (pm < 65) { s = 0; ti = pm; } else { s = 1 + (pm - 65) / 33; ti = (pm - 65) % 33; }
        const int T = seq_len(s); int t0 = 254 * ti - 1; if (t0 > T - 255) t0 = T - 255;
        u.pm = seq_start(s); u.pn = pn; u.kind = 0; u.t0 = t0; u.T = T; u.nt = 32;
        u.A = HN + ((long)u.pm + t0) * 4096; u.B = WUP + (size_t)pn * MiB; return true;
    }
};
struct EpiUp {
    bf16_t* ACT; const float* cw; const float* cb; LAS float* xch; const float* ssq;
    __device__ __forceinline__ void operator()(f32x4 (&acc)[2][2][4][2], const Unit& u, int wr, int wc, int fr, int fq) const {
        const int lane = threadIdx.x & 63;
        const int cin = wc * 32 + 8 * fq;
#pragma unroll
        for (int ai = 0; ai < 2; ++ai)
#pragma unroll
            for (int m = 0; m < 4; ++m) { int tok = u.pm + u.t0 + 128 * ai + 64 * wr + 16 * m + fr; tok = tok < 0 ? 0 : (tok > NT - 1 ? NT - 1 : tok);
                const float rs = rsqrtf(ssq[tok] * (1.f / DM) + 1e-6f);
#pragma unroll
                for (int bj = 0; bj < 2; ++bj) { acc[ai][bj][m][0] *= rs; acc[ai][bj][m][1] *= rs; } }
#pragma unroll
        for (int ai = 0; ai < 2; ++ai) { const int rg = 2 * ai + wr;
#pragma unroll
            for (int bj = 0; bj < 2; ++bj)
#pragma unroll
                for (int n = 0; n < 2; ++n) {
                    if (fr == 0) *(LAS f32x4*)(xch + (rg * 2 + 0) * 256 + bj * 128 + cin + 4 * n) = acc[ai][bj][0][n];
                    if (fr == 15) *(LAS f32x4*)(xch + (rg * 2 + 1) * 256 + bj * 128 + cin + 4 * n) = acc[ai][bj][3][n]; } }
        asm volatile("s_waitcnt lgkmcnt(0)" ::: "memory"); __builtin_amdgcn_s_barrier(); asm volatile("" ::: "memory");
        const int gc = u.pn * 128 + cin;
#pragma unroll
        for (int n = 0; n < 2; ++n) {
            const int wcol = gc + 4 * n;
            const f32x4 g0 = *(const f32x4*)(cw + wcol), g1 = *(const f32x4*)(cw + 2 * DFF + wcol), g2 = *(const f32x4*)(cw + 4 * DFF + wcol), gb = *(const f32x4*)(cb + wcol);
            const f32x4 v0 = *(const f32x4*)(cw + DFF + wcol), v1 = *(const f32x4*)(cw + 3 * DFF + wcol), v2 = *(const f32x4*)(cw + 5 * DFF + wcol), vb = *(const f32x4*)(cb + DFF + wcol);
#pragma unroll
            for (int ai = 0; ai < 2; ++ai) { const int rg = 2 * ai + wr;
                bf16_t* ap = ACT + ((long)u.pm + u.t0 + 128 * ai + 64 * wr + fr) * DFF + gc + 4 * n;
#pragma unroll
                for (int m = 0; m < 4; ++m) {
                    const int j = 128 * ai + 64 * wr + 16 * m + fr, t = u.t0 + j;
                    f32x4 res;
#pragma unroll
                    for (int bj = 0; bj < 2; ++bj) {
                        const f32x4 cur = acc[ai][bj][m][n];
                        const f32x4 sp = (m > 0 && fr == 15) ? acc[ai][bj][m > 0 ? m - 1 : 0][n] : cur;
                        const f32x4 sn = (m < 3 && fr == 0) ? acc[ai][bj][m < 3 ? m + 1 : 3][n] : cur;
                        f32x4 pv, nv;
#pragma unroll
                        for (int i = 0; i < 4; ++i) { pv[i] = __uint_as_float(__builtin_amdgcn_update_dpp(0u, __float_as_uint(sp[i]), 0x121, 0xf, 0xf, false));
                                                       nv[i] = __uint_as_float(__builtin_amdgcn_update_dpp(0u, __float_as_uint(sn[i]), 0x12F, 0xf, 0xf, false)); }
                        if (m == 0) { const f32x4 xprev = rg > 0 ? *(const LAS f32x4*)(xch + ((rg - 1) * 2 + 1) * 256 + bj * 128 + cin + 4 * n) : (f32x4){0.f, 0.f, 0.f, 0.f}; if (fr == 0) pv = xprev; }
                        if (m == 3) { const f32x4 xnext = rg < 3 ? *(const LAS f32x4*)(xch + ((rg + 1) * 2 + 0) * 256 + bj * 128 + cin + 4 * n) : (f32x4){0.f, 0.f, 0.f, 0.f}; if (fr == 15) nv = xnext; }
                        if (t < 1) pv = (f32x4){0.f, 0.f, 0.f, 0.f};
                        if (t >= u.T - 1) nv = (f32x4){0.f, 0.f, 0.f, 0.f};
                        if (bj == 0) { const f32x4 cv = g0 * pv + g1 * cur + g2 * nv + gb; res = (f32x4){cv[0] * sigmoidf_(cv[0]), cv[1] * sigmoidf_(cv[1]), cv[2] * sigmoidf_(cv[2]), cv[3] * sigmoidf_(cv[3])}; }
                        else { const f32x4 cv = v0 * pv + v1 * cur + v2 * nv + vb; res = res * cv; }
                    }
                    if (j >= 1 && j <= 254) { u32x2 w; w.x = cvt_pk_bf16(res[0], res[1]); w.y = cvt_pk_bf16(res[2], res[3]); *(u32x2*)ap = w; }
                    ap += 16 * DFF; asm volatile("" : "+v"(ap) :: "memory");
                }
            }
        }
    }
};

constexpr int CW_BAR = 4096;
#define XB_TMO      128
#define XB_XCNT(j)  (256  + 64 * (j))
#define XB_XSUB(j)  (1280 + 64 * (j))
#define XB_XGEN(j)  (2304 + 64 * (j))
#define XB_TOP      3328
#define XB_TOPGEN   3392
#define XCD_BAR_WORDS 3456
#define XB_SPIN_CAP (1u << 18)

__device__ __forceinline__ unsigned xb_ld(unsigned* p)              { return __hip_atomic_load(p, __ATOMIC_RELAXED, __HIP_MEMORY_SCOPE_AGENT); }
__device__ __forceinline__ unsigned xb_add(unsigned* p, unsigned v) { return __hip_atomic_fetch_add(p, v, __ATOMIC_RELAXED, __HIP_MEMORY_SCOPE_AGENT); }
__device__ __forceinline__ unsigned xb_xcc_id() { return (unsigned)__builtin_amdgcn_s_getreg((3 << 11) | 20) & 0xFu; }
#define XB_SPIN(cond, bar) do { unsigned _sp = 0; while (cond) { __builtin_amdgcn_s_sleep(1); \
    if ((++_sp & 255u) == 0u) { if (xb_ld(&(bar)[XB_TMO])) break; if (_sp > XB_SPIN_CAP) { atomicAdd(&(bar)[XB_TMO], 1u); break; } } } } while (0)

struct XcdBarrier {
    unsigned* bar; unsigned x;
    volatile LAS unsigned* st;
};

__device__ __forceinline__ XcdBarrier xcd_barrier_post(unsigned* bar, volatile LAS unsigned* st) {
    XcdBarrier b; b.bar = bar; b.x = xb_xcc_id(); b.st = st;
    if (threadIdx.x == 0) (void)xb_add(&bar[XB_XCNT(b.x)], 1u);
    return b;
}
__device__ __forceinline__ void xcd_barrier_complete(unsigned* bar, unsigned x, unsigned& nloc, unsigned& nx) {
    const unsigned G = gridDim.x * gridDim.y * gridDim.z;
    unsigned sum, cnt, mine, sp = 0u;
    for (;;) {
        sum = 0u; cnt = 0u; mine = 0u;
#pragma unroll
        for (unsigned j = 0; j < 16; ++j) { const unsigned c = xb_ld(&bar[XB_XCNT(j)]); sum += c; cnt += (c > 0u) ? 1u : 0u; mine = (j == x) ? c : mine; }
        if (sum == G) break;
        __builtin_amdgcn_s_sleep(1);
        if ((++sp & 255u) == 0u) { if (xb_ld(&bar[XB_TMO])) break; if (sp > XB_SPIN_CAP) { atomicAdd(&bar[XB_TMO], 1u); break; } }
    }
    nloc = mine > 0u ? mine : 1u; nx = cnt > 0u ? cnt : 1u;
}

__device__ __forceinline__ void xcd_barrier(const XcdBarrier& b) {
    asm volatile("s_waitcnt vmcnt(0)" ::: "memory");
    __syncthreads();
    if (threadIdx.x == 0) {
        unsigned* bar = b.bar;
        __builtin_amdgcn_s_waitcnt(0);
        unsigned nloc = b.st[0], nx = b.st[1];
        if (nloc == 0u) { xcd_barrier_complete(bar, b.x, nloc, nx); b.st[0] = nloc; b.st[1] = nx; }
        const unsigned old = xb_add(&bar[XB_XSUB(b.x)], 1u);
        const unsigned gen = old / nloc;
        if (old + 1u == (gen + 1u) * nloc) {
            __builtin_amdgcn_fence(__ATOMIC_RELEASE, "agent");
            asm volatile("s_waitcnt vmcnt(0)" ::: "memory");
            const unsigned og = xb_add(&bar[XB_TOP], 1u);
            const unsigned tg = og / nx;
            if (og + 1u == (tg + 1u) * nx) xb_add(&bar[XB_TOPGEN], 1u);
            else XB_SPIN(xb_ld(&bar[XB_TOPGEN]) == tg, bar);
            __builtin_amdgcn_fence(__ATOMIC_ACQUIRE, "agent");
            xb_add(&bar[XB_XGEN(b.x)], 1u);
            asm volatile("s_waitcnt vmcnt(0)" ::: "memory");
        } else {
            XB_SPIN(xb_ld(&bar[XB_XGEN(b.x)]) == gen, bar);
            __builtin_amdgcn_fence(__ATOMIC_ACQUIRE, "agent");
            asm volatile("s_waitcnt vmcnt(0)" ::: "memory");
        }
    }
    __syncthreads();
}

__global__ void __launch_bounds__(NTHR, 2) enc_fwd(Args args) {
    extern __shared__ __attribute__((aligned(16))) unsigned char lds_raw[];
    cg::grid_group grid = cg::this_grid();
    LAS unsigned char* lds = (LAS unsigned char*)lds_raw;
    const int tid = threadIdx.x;
    const int G = gridDim.x, bx = blockIdx.x, vcu = (G % 8 == 0) ? (bx % 8) * (G / 8) + bx / 8 : bx;
    unsigned char* ws = args.ws;
    const int lo = args.ph_lo, hi = args.ph_hi;
    volatile LAS unsigned* xb_st = (volatile LAS unsigned*)(lds + LDS_MISC + 32);
    if (tid < 2) xb_st[tid] = 0u;
    __syncthreads();
#ifndef P2M
#define P2M 7
#endif
#ifndef PH_MASK
#define PH_MASK 0x1ff
#endif
#define IN(k) (((PH_MASK >> (k)) & 1) && lo <= (k) && (k) < hi)
#define SEAM(k) do { if (IN(k) && IN((k) + 1)) { if ((k) == 0) grid.sync(); else xcd_barrier(xbar); } } while (0)
#ifndef PROBE
#define PROBE 0
#endif
    unsigned long long tp0 = 0, tp1 = 0;
#define TSTAMP(v) do { if (PROBE) { v = __builtin_amdgcn_s_memrealtime(); } } while (0)

    if (IN(0)) {
        if (bx == 0) for (int u = tid; u < XCD_BAR_WORDS; u += NTHR) ((unsigned*)(ws + WS_CTL) + CW_BAR)[u] = 0u;
        p0_prologue(args, lds, vcu, G);
    }
    if (IN(0) && IN(1)) grid.sync();
    XcdBarrier xbar = xcd_barrier_post((unsigned*)(ws + WS_CTL) + CW_BAR, xb_st);
    if (IN(1)) {
        SchedIn S{vcu, G, (const char*)(ws + WS_H), (const char*)(ws + WS_WIN), (const char*)(ws + WS_MEMN), (const char*)(ws + WS_WKV)};
        EpiIn E{(bf16_t*)(ws + WS_QK), (bf16_t*)(ws + WS_VM), (bf16_t*)args.out, (bf16_t*)(ws + WS_KVM), args.in[6], args.in[7], (const float*)(ws + WS_ROPE), (const float*)(ws + WS_ROPE) + TP * 32};
        pg8::gemm_phase<EpiIn, SchedIn, true>(lds, 2048, S, E);
    }
    SEAM(1);
    if (PROBE == 1 || PROBE == 2) TSTAMP(tp0);
    if (IN(2)) {
        unsigned* ctl = (unsigned*)(ws + WS_CTL);
        volatile LAS unsigned* jobw = (volatile LAS unsigned*)(lds + LDS_MISC);
        const float lam = ((const float*)ctl)[CW_LAM];
        const bool fixref = ((const float*)ctl)[CW_SMAX] <= 30.f;
        scan::P sp{(const bf16_t*)args.out, (bf16_t*)(ws + WS_Y), (float*)(ws + WS_BON), args.in[13], args.in[14], args.in[15], args.in[16], args.in[17], args.in[18], args.in[20], args.in[21], args.in[22]};
        for (;;) {
            __syncthreads();
            if (tid == 0) jobw[0] = atomicAdd(ctl + CW_QUEUE, 1u);
            __syncthreads();
            const int jb = (int)jobw[0];
            if (jb >= 160 + 1536 + 768) break;
            if (((P2M) & 1) && jb < 160) {
                int s, r; if (jb < 32) { s = 0; r = jb; } else { s = 1 + (jb - 32) / 32; r = (jb - 32) % 32; }
                scan::job(s, r & 1, r >> 1, sp, (char*)lds_raw);
                if (PROBE == 2 && tid == 0) atomicMax((unsigned long long*)(ctl + 256), (unsigned long long)__builtin_amdgcn_s_memrealtime());
            } else if (((P2M) & 2) && jb < 160 + 1536) {
                const int a = jb - 160; int s, h, qb;
                if (a < 512) { s = 0; h = a / 64; qb = a % 64; } else { const int b = a - 512; s = 1 + b / 256; h = (b % 256) / 32; qb = b % 32; }
                if (fixref) att::diff_unit<true>(s, h, qb, (bf16_t*)(ws + WS_QK), (const bf16_t*)(ws + WS_VM), lam, (char*)lds_raw, lds);
                else att::diff_unit<false>(s, h, qb, (bf16_t*)(ws + WS_QK), (const bf16_t*)(ws + WS_VM), lam, (char*)lds_raw, lds);
            } else if ((P2M) & 4) {
                const int a = jb - 160 - 1536; int s, mh, qb;
                if (a < 256) { s = 0; mh = a / 64; qb = a % 64; } else { const int b = a - 256; s = 1 + b / 128; mh = (b % 128) / 32; qb = b % 32; }
                att::mem_unit(s, mh, qb, (bf16_t*)(ws + WS_VM), (const bf16_t*)(ws + WS_KVM), args.in[27], args.in[28], (char*)lds_raw);
            }
        }
    }
    SEAM(2);
    if (PROBE == 1) TSTAMP(tp1);
    if (IN(3)) p4_post(args, (char*)lds_raw, vcu, G);
    SEAM(3);
    if (IN(4)) {
        SchedMerge S{vcu, G, (const char*)(ws + WS_H), (const char*)(ws + WS_WG), (const char*)(ws + WS_QK), (const char*)(ws + WS_VM), (const char*)(ws + WS_PAR), (const char*)(ws + WS_PM2)};
        unsigned char* scr = (unsigned char*)args.out + (size_t)bx * (384 * 1024);
        EpiMerge E{(u32x4*)scr, (f32x4*)(scr + 128 * 1024), (bf16_t*)(ws + WS_MRG)};
        pg8::gemm_phase<EpiMerge, SchedMerge, true>(lds, 2048, S, E);
    }
    SEAM(4);
    if (IN(5)) {
        SchedSq S{vcu, G, (const char*)(ws + WS_MRG), (const char*)(ws + WS_WO), MiB, MiB, 32};
        EpiWo E{args.in[0], args.in[1], args.out, (bf16_t*)(ws + WS_H), args.in[33], (float*)(ws + WS_SSQ)};
        pg8::gemm_phase<EpiWo, SchedSq, true>(lds, 2048, S, E);
    }
    SEAM(5);
    if (IN(7)) {
        SchedUp S{vcu, G, (const char*)(ws + WS_H), (const char*)(ws + WS_WUP)};
        EpiUp E{(bf16_t*)(ws + WS_ACT), args.in[35], args.in[36], (LAS float*)(lds + LDS_XCH), (const float*)(ws + WS_SSQ)};
        pg8::gemm_phase<EpiUp, SchedUp, true>(lds, 2048, S, E);
    }
    SEAM(7);
    if (IN(8)) {
        SchedSq S{vcu, G, (const char*)(ws + WS_ACT), (const char*)(ws + WS_WDN), (size_t)256 * DFF * 2, (size_t)256 * DFF * 2, 88};
        EpiDown E{args.out};
        pg8::gemm_phase<EpiDown, SchedSq, true>(lds, DFF, S, E);
    }
    if (PROBE && bx == 0 && tid == 0) {
        if (PROBE == 2) tp1 = __hip_atomic_load((unsigned long long*)(ws + WS_CTL) + 128, __ATOMIC_RELAXED, __HIP_MEMORY_SCOPE_AGENT);
        const unsigned long long target = __builtin_amdgcn_s_memrealtime() + (tp1 > tp0 ? tp1 - tp0 : 0);
        while (__builtin_amdgcn_s_memrealtime() < target) __builtin_amdgcn_s_sleep(16);
    }
#undef IN
#undef SEAM
}

#ifndef MK_SPLIT
#define MK_SPLIT 0
#endif
extern "C" void kernel_launch(void* const* d_in, const int* in_sizes, int n_in, void* d_out, int out_size, void* d_ws, size_t ws_size, hipStream_t stream) {
    static int grid = 0;
    if (grid == 0) {
        if (n_in != 38 || out_size != NT * DM || ws_size < WS_END) { fprintf(stderr, "kernel_launch: unexpected shapes n_in %d out %d ws %zu\n", n_in, out_size, ws_size); grid = -1; return; }
        int dev = 0, cus = 0, per_cu = 0;
        hipGetDevice(&dev); hipDeviceGetAttribute(&cus, hipDeviceAttributeMultiprocessorCount, dev);
        if (hipFuncSetAttribute((const void*)enc_fwd, hipFuncAttributeMaxDynamicSharedMemorySize, LDS_BYTES) != hipSuccess) { fprintf(stderr, "kernel_launch: hipFuncSetAttribute failed\n"); grid = -1; return; }
        if (hipOccupancyMaxActiveBlocksPerMultiprocessor(&per_cu, (const void*)enc_fwd, NTHR, LDS_BYTES) != hipSuccess || per_cu < 1) { fprintf(stderr, "kernel_launch: occupancy query failed (%d)\n", per_cu); per_cu = 1; }
        (void)hipGetLastError();
        grid = cus * 1;
    }
    if (grid < 0) return;
    Args a{};
    for (int i = 0; i < 38; ++i) a.in[i] = (const float*)d_in[i];
    a.out = (float*)d_out; a.ws = (unsigned char*)d_ws;
    for (int d = 0; d < 32; ++d) a.inv_rev[d] = pow(10000.0, -(double)d / 32.0) / 6.283185307179586476925286766559;
#if MK_SPLIT
    for (int ph = 0; ph < 9; ++ph) { a.ph_lo = ph; a.ph_hi = ph + 1; void* kargs[] = {&a};
        hipError_t e = hipLaunchCooperativeKernel((const void*)enc_fwd, dim3(grid), dim3(NTHR), kargs, LDS_BYTES, stream);
        if (e != hipSuccess) { fprintf(stderr, "launch %d failed: %s\n", ph, hipGetErrorString(e)); break; } }
#else
    a.ph_lo = 0; a.ph_hi = 9;
    void* kargs[] = {&a};
    hipError_t e = hipLaunchCooperativeKernel((const void*)enc_fwd, dim3(grid), dim3(NTHR), kargs, LDS_BYTES, stream);
    if (e != hipSuccess) fprintf(stderr, "cooperative launch failed: %s (grid %d)\n", hipGetErrorString(e), grid);
#endif
}
```
